# Optimizing an MI355X kernel written in HIP

```python
import math
import jax, jax.numpy as jnp
from jax import lax
import numpy as np

D_MODEL = 1024
BATCH = 4
SEQ = 8192
DEPTH = 2

RWKV_WIDTH = D_MODEL // 2
RWKV_HEAD_DIM = 64
RWKV_HEADS = RWKV_WIDTH // RWKV_HEAD_DIM
W_LORA = 64
A_LORA = 64
G_LORA = 128
RWKV_PROJ = 3 * RWKV_WIDTH + W_LORA + A_LORA + G_LORA
RWKV_NORM_EPS = 64e-5
POOL_WINDOWS = (2, 4, 8, 16)
POOL_GROUPS = len(POOL_WINDOWS)
POOL_WIDTH = D_MODEL // 2
POOL_GROUP_DIM = POOL_WIDTH // POOL_GROUPS
EVEN_PROJ = RWKV_PROJ + POOL_WIDTH
CONV_CHANNELS = D_MODEL // 2
CONV_WIDTH = 31
RET_WIDTH = D_MODEL // 2
RET_HEAD_DIM = 64
RET_HEADS = RET_WIDTH // RET_HEAD_DIM
RET_CHUNK = 128
ROPE_BASE = 10000.0
ODD_PROJ = 2 * CONV_CHANNELS + 4 * RET_WIDTH
MIX_WIDTH = D_MODEL
MOE_GROUPS = 4
EXPERTS_PER_GROUP = 8
N_EXPERTS = MOE_GROUPS * EXPERTS_PER_GROUP
TOP_K_IN_GROUP = 2
D_EXPERT = 128
ALPHA = (2.0 * DEPTH) ** 0.25
BETA = (8.0 * DEPTH) ** -0.25
LN_EPS = 1e-5

kernel_name = "hybrid_rwkv7_pool_conformer_retention_hmoe"


def layer_norm(x, g, b, eps=LN_EPS):
    xf = x.astype(jnp.float32)
    mu = jnp.mean(xf, axis=-1, keepdims=True)
    var = jnp.mean(jnp.square(xf - mu), axis=-1, keepdims=True)
    return ((xf - mu) * lax.rsqrt(var + eps) * g + b).astype(x.dtype)


def head_norm(y, eps):
    yf = y.astype(jnp.float32)
    mu = jnp.mean(yf, axis=-1, keepdims=True)
    var = jnp.mean(jnp.square(yf - mu), axis=-1, keepdims=True)
    out = (yf - mu) * lax.rsqrt(var + eps)
    return out.reshape(y.shape[:-2] + (-1,))


def rwkv7_scan(r, w, k, v, kk, a):
    B, S, H, d = r.shape

    def step(state, inp):
        r_t, w_t, k_t, v_t, kk_t, a_t = inp
        sa = jnp.einsum('bhvk,bhk->bhv', state, -kk_t)
        state = (state * w_t[:, :, None, :]
                 + sa[..., None] * (kk_t * a_t)[:, :, None, :]
                 + v_t[..., None] * k_t[:, :, None, :])
        y_t = jnp.einsum('bhvk,bhk->bhv', state, r_t)
        return state, y_t

    xs = (jnp.moveaxis(r, 1, 0), jnp.moveaxis(w, 1, 0), jnp.moveaxis(k, 1, 0),
          jnp.moveaxis(v, 1, 0), jnp.moveaxis(kk, 1, 0), jnp.moveaxis(a, 1, 0))
    init = jnp.zeros((B, H, d, d), jnp.float32)
    _, y = lax.scan(step, init, xs)
    return jnp.moveaxis(y, 0, 1)


def multiscale_pool(u):
    B, S, _ = u.shape
    uf = u.astype(jnp.float32).reshape(B, S, POOL_GROUPS, POOL_GROUP_DIM)
    c = jnp.cumsum(uf, axis=1)
    t = jnp.arange(S)
    outs = []
    for gi, win in enumerate(POOL_WINDOWS):
        cg = c[:, :, gi]
        c_prev = jnp.pad(cg, ((0, 0), (win, 0), (0, 0)))[:, :S]
        count = jnp.minimum(t + 1, win).astype(jnp.float32)[None, :, None]
        outs.append((cg - c_prev) / count - uf[:, :, gi])
    return jnp.stack(outs, axis=2)


def rwkv_pool_mixer(x, w_in, mu, w0, w2, a0, a2, g2, k_k, k_a, r_k,
                    lnx_g, lnx_b, pool_w, pool_scale, w_out):
    B, S, _ = x.shape
    p = x @ w_in
    pr, u = p[..., :RWKV_PROJ], p[..., RWKV_PROJ:]
    prev = jnp.pad(pr, ((0, 0), (1, 0), (0, 0)))[:, :-1]
    z = pr + mu * (prev - pr)
    c1 = RWKV_WIDTH
    r, k, v, wlo, alo, glo = jnp.split(
        z, [c1, 2 * c1, 3 * c1, 3 * c1 + W_LORA, 3 * c1 + W_LORA + A_LORA], axis=-1)
    wl = -jax.nn.softplus(-(w0 + jnp.tanh(wlo) @ w2)) - 0.5
    decay = jnp.exp(-jnp.exp(wl.astype(jnp.float32)))
    a = jax.nn.sigmoid(a0 + alo @ a2)
    g = jax.nn.sigmoid(glo) @ g2

    def hs(t):
        return t.astype(jnp.float32).reshape(B, S, RWKV_HEADS, RWKV_HEAD_DIM)

    kk = hs(k * k_k)
    kk = kk * lax.rsqrt(jnp.maximum(jnp.sum(jnp.square(kk), -1, keepdims=True), 1e-24))
    k = k * (1.0 + (a - 1.0) * k_a)
    rh, kh, vh, ah, dh = hs(r), hs(k), hs(v), hs(a), hs(decay)
    y = rwkv7_scan(rh, dh, kh, vh, kk, ah)
    y = head_norm(y, RWKV_NORM_EPS) * lnx_g + lnx_b
    bonus = (jnp.sum(rh * kh * r_k, axis=-1, keepdims=True) * vh).reshape(B, S, RWKV_WIDTH)
    y_rwkv = ((y + bonus) * g).astype(x.dtype)

    pooled = multiscale_pool(u).astype(x.dtype)
    y_pool = jnp.einsum('bsgc,gcd->bsgd', pooled, pool_w).reshape(B, S, POOL_WIDTH) * pool_scale
    return jnp.concatenate([y_rwkv, y_pool.astype(x.dtype)], axis=-1) @ w_out


def rotary(t, pos):
    half = t.shape[-1] // 2
    inv = ROPE_BASE ** (-jnp.arange(half, dtype=jnp.float32) / half)
    ang = pos[:, None] * inv[None, :]
    cos = jnp.cos(ang)[None, :, None, :]
    sin = jnp.sin(ang)[None, :, None, :]
    t1, t2 = t[..., :half], t[..., half:]
    return jnp.concatenate([t1 * cos - t2 * sin, t1 * sin + t2 * cos], axis=-1)


def retention(q, k, v):
    B, S, _ = q.shape
    H, d, C = RET_HEADS, RET_HEAD_DIM, RET_CHUNK
    N = S // C
    pos = jnp.arange(S, dtype=jnp.float32)
    qh = rotary(q.astype(jnp.float32).reshape(B, S, H, d), pos)
    kh = rotary(k.astype(jnp.float32).reshape(B, S, H, d), pos) * (d ** -0.5)
    vh = v.astype(jnp.float32).reshape(B, S, H, d)

    def to_chunks(t):
        return t.reshape(B, N, C, H, d).transpose(0, 3, 1, 2, 4)

    qc, kc, vc = to_chunks(qh), to_chunks(kh), to_chunks(vh)
    log_gamma = jnp.log1p(-jnp.power(2.0, -5.0 - jnp.arange(H, dtype=jnp.float32)))
    idx = jnp.arange(C, dtype=jnp.float32)
    diff = idx[:, None] - idx[None, :]
    decay_mask = jnp.where(diff >= 0,
                           jnp.exp(jnp.maximum(diff, 0.0)[None] * log_gamma[:, None, None]),
                           0.0)
    scores = jnp.einsum('bhnid,bhnjd->bhnij', qc, kc) * decay_mask[None, :, None]
    intra = jnp.einsum('bhnij,bhnjd->bhnid', scores, vc)
    xi = jnp.exp((idx + 1.0)[None, :] * log_gamma[:, None])
    zeta = jnp.exp((C - 1.0 - idx)[None, :] * log_gamma[:, None])
    gamma_chunk = jnp.exp(C * log_gamma)
    kv = jnp.einsum('bhncd,bhnce->bhnde', kc * zeta[None, :, None, :, None], vc)

    def step(R, kv_n):
        return gamma_chunk[None, :, None, None] * R + kv_n, R

    _, R_prev = lax.scan(step, jnp.zeros((B, H, d, d), jnp.float32), jnp.moveaxis(kv, 2, 0))
    R_prev = jnp.moveaxis(R_prev, 0, 2)
    cross = jnp.einsum('bhncd,bhnde->bhnce', qc * xi[None, :, None, :, None], R_prev)
    return (intra + cross).transpose(0, 2, 3, 1, 4).reshape(B, S, H, d)


def conv_retention_mixer(x, w_in, conv_w, conv_b, cln_g, cln_b, gn_g, gn_b, w_out):
    p = x @ w_in
    cc, rw = CONV_CHANNELS, RET_WIDTH
    ca, cb, q, k, v, gr = jnp.split(
        p, [cc, 2 * cc, 2 * cc + rw, 2 * cc + 2 * rw, 2 * cc + 3 * rw], axis=-1)
    u = ca * jax.nn.sigmoid(cb)
    u = lax.conv_general_dilated(
        u, conv_w[:, None, :], window_strides=(1,), padding=[(CONV_WIDTH - 1, 0)],
        dimension_numbers=('NWC', 'WIO', 'NWC'), feature_group_count=CONV_CHANNELS) + conv_b
    y_conv = jax.nn.silu(layer_norm(u, cln_g, cln_b))
    ret = head_norm(retention(q, k, v), LN_EPS) * gn_g + gn_b
    y_ret = (jax.nn.silu(gr) * ret).astype(x.dtype)
    return jnp.concatenate([y_conv.astype(x.dtype), y_ret], axis=-1) @ w_out


def hier_moe(x, rg_w, rg_b, re_w, re_b, w1, w3, w2):
    B, S, D = x.shape
    xf = x.reshape(B * S, D)
    g_logits = (xf @ rg_w + rg_b).astype(jnp.float32)
    g_prob = jax.nn.softmax(g_logits, axis=-1)
    g_idx = jnp.argmax(g_logits, axis=-1)
    g_w = jnp.max(g_prob, axis=-1, keepdims=True)
    e_logits = (xf @ re_w + re_b).astype(jnp.float32).reshape(-1, MOE_GROUPS, EXPERTS_PER_GROUP)
    e_sel = jnp.einsum('nge,ng->ne', e_logits, jax.nn.one_hot(g_idx, MOE_GROUPS, dtype=jnp.float32))
    e_prob = jax.nn.softmax(e_sel, axis=-1)
    top_p, top_i = lax.top_k(e_prob, TOP_K_IN_GROUP)
    top_p = top_p / jnp.sum(top_p, axis=-1, keepdims=True)
    global_idx = g_idx[:, None] * EXPERTS_PER_GROUP + top_i
    gates = jnp.sum(jax.nn.one_hot(global_idx, N_EXPERTS, dtype=jnp.float32)
                    * (g_w * top_p)[..., None], axis=1)

    def expert(acc, params):
        w1e, w3e, w2e, ge = params
        h = jax.nn.silu(xf @ w1e) * (xf @ w3e)
        return acc + ge[:, None] * (h @ w2e), None

    out, _ = lax.scan(expert, jnp.zeros_like(xf), (w1, w3, w2, gates.T.astype(x.dtype)))
    return out.reshape(B, S, D)


def setup_inputs(seed: int = 0) -> dict:
    key = jax.random.key(seed)
    ks = iter(jax.random.split(key, 48))
    ne, no = (DEPTH + 1) // 2, DEPTH // 2
    D = D_MODEL

    def nrm(shape, scale):
        return jax.random.normal(next(ks), shape, jnp.float32) * scale

    def gain(shape):
        return 1.0 + nrm(shape, 0.02)

    lin = jnp.linspace(0.0, 1.0, RWKV_WIDTH, dtype=jnp.float32)
    return {
        "x": nrm((BATCH, SEQ, D), 1.0),
        "ev_w_in": nrm((ne, D, EVEN_PROJ), D ** -0.5),
        "ev_mu": jax.random.uniform(next(ks), (ne, RWKV_PROJ), jnp.float32, 0.2, 0.8),
        "ev_w0": -6.5 + 5.0 * lin ** 0.9 + nrm((ne, RWKV_WIDTH), 0.1),
        "ev_w2": nrm((ne, W_LORA, RWKV_WIDTH), 0.1),
        "ev_a0": nrm((ne, RWKV_WIDTH), 0.1),
        "ev_a2": nrm((ne, A_LORA, RWKV_WIDTH), A_LORA ** -0.5),
        "ev_g2": nrm((ne, G_LORA, RWKV_WIDTH), G_LORA ** -0.5),
        "ev_k_k": 0.85 + nrm((ne, RWKV_WIDTH), 0.02),
        "ev_k_a": gain((ne, RWKV_WIDTH)),
        "ev_r_k": nrm((ne, RWKV_HEADS, RWKV_HEAD_DIM), 0.1),
        "ev_lnx_g": gain((ne, RWKV_WIDTH)),
        "ev_lnx_b": nrm((ne, RWKV_WIDTH), 0.02),
        "ev_pool_w": nrm((ne, POOL_GROUPS, POOL_GROUP_DIM, POOL_GROUP_DIM), POOL_GROUP_DIM ** -0.5),
        "ev_pool_scale": gain((ne, POOL_WIDTH)),
        "ev_w_out": nrm((ne, MIX_WIDTH, D), MIX_WIDTH ** -0.5 * BETA),
        "od_w_in": nrm((no, D, ODD_PROJ), D ** -0.5),
        "od_conv_w": nrm((no, CONV_WIDTH, CONV_CHANNELS), CONV_WIDTH ** -0.5),
        "od_conv_b": nrm((no, CONV_CHANNELS), 0.02),
        "od_cln_g": gain((no, CONV_CHANNELS)),
        "od_cln_b": nrm((no, CONV_CHANNELS), 0.02),
        "od_gn_g": gain((no, RET_WIDTH)),
        "od_gn_b": nrm((no, RET_WIDTH), 0.02),
        "od_w_out": nrm((no, MIX_WIDTH, D), MIX_WIDTH ** -0.5 * BETA),
        "ln_mix_g": gain((DEPTH, D)),
        "ln_mix_b": nrm((DEPTH, D), 0.02),
        "rg_w": nrm((DEPTH, D, MOE_GROUPS), D ** -0.5),
        "rg_b": nrm((DEPTH, MOE_GROUPS), 0.01),
        "re_w": nrm((DEPTH, D, N_EXPERTS), D ** -0.5),
        "re_b": nrm((DEPTH, N_EXPERTS), 0.01),
        "e_w1": nrm((DEPTH, N_EXPERTS, D, D_EXPERT), D ** -0.5),
        "e_w3": nrm((DEPTH, N_EXPERTS, D, D_EXPERT), D ** -0.5),
        "e_w2": nrm((DEPTH, N_EXPERTS, D_EXPERT, D), D_EXPERT ** -0.5 * BETA),
        "ln_ffn_g": gain((DEPTH, D)),
        "ln_ffn_b": nrm((DEPTH, D), 0.02),
    }


def reference(x, ev_w_in, ev_mu, ev_w0, ev_w2, ev_a0, ev_a2, ev_g2, ev_k_k, ev_k_a,
              ev_r_k, ev_lnx_g, ev_lnx_b, ev_pool_w, ev_pool_scale, ev_w_out,
              od_w_in, od_conv_w, od_conv_b, od_cln_g, od_cln_b, od_gn_g, od_gn_b,
              od_w_out, ln_mix_g, ln_mix_b, rg_w, rg_b, re_w, re_b, e_w1, e_w3, e_w2,
              ln_ffn_g, ln_ffn_b):
    for i in range(DEPTH):
        j = i // 2
        if i % 2 == 0:
            h = rwkv_pool_mixer(x, ev_w_in[j], ev_mu[j], ev_w0[j], ev_w2[j], ev_a0[j],
                                ev_a2[j], ev_g2[j], ev_k_k[j], ev_k_a[j], ev_r_k[j],
                                ev_lnx_g[j], ev_lnx_b[j], ev_pool_w[j], ev_pool_scale[j],
                                ev_w_out[j])
        else:
            h = conv_retention_mixer(x, od_w_in[j], od_conv_w[j], od_conv_b[j], od_cln_g[j],
                                     od_cln_b[j], od_gn_g[j], od_gn_b[j], od_w_out[j])
        x = layer_norm(ALPHA * x + h, ln_mix_g[i], ln_mix_b[i])
        f = hier_moe(x, rg_w[i], rg_b[i], re_w[i], re_b[i], e_w1[i], e_w3[i], e_w2[i])
        x = layer_norm(ALPHA * x + f, ln_ffn_g[i], ln_ffn_b[i])
    return x
```

```cpp
#include <hip/hip_runtime.h>
#include <hip/hip_cooperative_groups.h>
#include <stdint.h>
#include <stdio.h>
namespace cg = cooperative_groups;

typedef unsigned short bf16_t;
typedef short bf16x8 __attribute__((ext_vector_type(8)));
typedef float f32x4 __attribute__((ext_vector_type(4)));

#define NT 32768
#define SEQ 8192
#define DM 1024
#define NTHREADS 256
#define ALPHA_F 1.41421356237309515f

#define MIB (1024ull * 1024ull)
#define OFF_CTRL 0ull
#define OFF_W (1ull * MIB)
#define OFF_ROPE (65ull * MIB)
#define OFF_ACTB (68ull * MIB)
#define OFF_AA (OFF_ACTB)
#define OFF_GG (OFF_ACTB + 32ull * MIB)
#define OFF_P (132ull * MIB)
#define OFF_LORA (OFF_P + 144ull * MIB)
#define OFF_POOLED (OFF_P + 160ull * MIB)
#define OFF_FS (OFF_P)
#define OFF_HBUF (OFF_P + 128ull * MIB)
#define OFF_YCAT (324ull * MIB)
#define OFF_LOGW (388ull * MIB)
#define OFF_LTOK (452ull * MIB)
#define OFF_LGATE (456ull * MIB)
#define OFF_KVT (460ull * MIB)
#define WE_IN0 0
#define WE_OUT0 2359296
#define WE_IN1 3407872
#define WE_OUT1 6553600
#define WE_W13 7602176
#define WE_W2 24379392
#define WE_LW2 32768000
#define WE_LA2 32800768
#define WE_LG2 32833536
#define WE_POOL 32899072

struct Params {
    const float* in[35];
    float* out;
    unsigned char* ws;
};

__device__ __forceinline__ bf16_t f2bf(float f) {
    unsigned u = __float_as_uint(f);
    u += 0x7fffu + ((u >> 16) & 1u);
    return (bf16_t)(u >> 16);
}
__device__ __forceinline__ float bf2f(bf16_t h) { return __uint_as_float(((unsigned)h) << 16); }
__device__ __forceinline__ unsigned pack2(float a, float b) { return (unsigned)f2bf(a) | ((unsigned)f2bf(b) << 16); }
__device__ __forceinline__ float wave_sum(float v) {
#pragma unroll
    for (int o = 32; o > 0; o >>= 1) v += __shfl_xor(v, o);
    return v;
}
__device__ __forceinline__ float sigmoidf_(float x) { return 1.0f / (1.0f + __expf(-x)); }
__device__ __forceinline__ float siluf_(float x) { return x / (1.0f + __expf(-x)); }
__device__ __forceinline__ float quad_sum(float v) {
    int iv = __float_as_int(v);
    float a = __int_as_float(__builtin_amdgcn_update_dpp(0, iv, 0xB1, 0xF, 0xF, false));
    v += a;
    iv = __float_as_int(v);
    float b = __int_as_float(__builtin_amdgcn_update_dpp(0, iv, 0x4E, 0xF, 0xF, false));
    return v + b;
}

template <bool GATHER, class Epi>
__device__ __forceinline__ void gemm_tile(const bf16_t* __restrict__ A, int lda, const int* __restrict__ gidx, int gcount,
                                          const bf16_t* __restrict__ Bt, int ldb, int K, int row0, int col0, const Epi& epi,
                                          bf16_t* smem) {
    const int tid = threadIdx.x, wid = tid >> 6, lane = tid & 63, wr = wid >> 1, wc = wid & 1, fr = lane & 15, fq = lane >> 4;
    bf16_t* SA = smem;
    bf16_t* SB = smem + 128 * 32;
    const bf16_t* ap[2];
    const bf16_t* bp[2];
#pragma unroll
    for (int i = 0; i < 2; ++i) {
        int b = tid * 16 + i * 4096;
        int r = b >> 6, c = (b & 63) >> 1;
        int ar = row0 + r;
        if (GATHER) {
            int gi = ar < gcount ? ar : gcount - 1;
            ar = gidx[gi] >> 1;
        }
        ap[i] = A + (size_t)ar * lda + c;
        bp[i] = Bt + (size_t)(col0 + r) * ldb + c;
    }
    f32x4 acc[4][4];
#pragma unroll
    for (int m = 0; m < 4; ++m)
#pragma unroll
        for (int n = 0; n < 4; ++n) acc[m][n] = (f32x4){0.f, 0.f, 0.f, 0.f};
    for (int kt = 0; kt < K; kt += 32) {
#pragma unroll
        for (int i = 0; i < 2; ++i) {
            int b = tid * 16 + i * 4096;
            __builtin_amdgcn_global_load_lds((const unsigned*)(ap[i] + kt), (__attribute__((address_space(3))) unsigned*)((char*)SA + b), 16, 0, 0);
            __builtin_amdgcn_global_load_lds((const unsigned*)(bp[i] + kt), (__attribute__((address_space(3))) unsigned*)((char*)SB + b), 16, 0, 0);
        }
        asm volatile("s_waitcnt vmcnt(0)" ::: "memory");
        __syncthreads();
        bf16x8 af[4], bfr[4];
#pragma unroll
        for (int m = 0; m < 4; ++m) af[m] = *reinterpret_cast<const bf16x8*>((const char*)SA + (wr * 64 + m * 16 + fr) * 64 + fq * 16);
#pragma unroll
        for (int n = 0; n < 4; ++n) bfr[n] = *reinterpret_cast<const bf16x8*>((const char*)SB + (wc * 64 + n * 16 + fr) * 64 + fq * 16);
#pragma unroll
        for (int m = 0; m < 4; ++m)
#pragma unroll
            for (int n = 0; n < 4; ++n) acc[m][n] = __builtin_amdgcn_mfma_f32_16x16x32_bf16(bfr[n], af[m], acc[m][n], 0, 0, 0);
        __syncthreads();
    }
    epi(acc, row0 + wr * 64, col0 + wc * 64, fr, fq);
}

template <class Epi>
__device__ __forceinline__ void gemm_phase(const bf16_t* A, int lda, const bf16_t* Bt, int ldb, int K, int mt, int nt, const Epi& epi,
                                           bf16_t* smem) {
    const int ntiles = mt * nt;
    for (int t = blockIdx.x; t < ntiles; t += gridDim.x) {
        int tm = t / nt, tn = t % nt;
        gemm_tile<false>(A, lda, nullptr, 0, Bt, ldb, K, tm * 128, tn * 128, epi, smem);
    }
}

struct EpiStoreBf16 {
    bf16_t* O; int ldo;
    __device__ __forceinline__ void operator()(f32x4 (&acc)[4][4], int rb, int cb, int fr, int fq) const {
#pragma unroll
        for (int m = 0; m < 4; ++m)
#pragma unroll
            for (int n = 0; n < 4; ++n) {
                int row = rb + m * 16 + fr, col = cb + n * 16 + fq * 4;
                uint2 w; w.x = pack2(acc[m][n][0], acc[m][n][1]); w.y = pack2(acc[m][n][2], acc[m][n][3]);
                *reinterpret_cast<uint2*>(O + (size_t)row * ldo + col) = w;
            }
    }
};
template <int MODE>
struct EpiLora {
    float* Of; bf16_t* Ob; const float* vec; int ldo; int coff;
    __device__ __forceinline__ void operator()(f32x4 (&acc)[4][4], int rb, int cb, int fr, int fq) const {
#pragma unroll
        for (int m = 0; m < 4; ++m)
#pragma unroll
            for (int n = 0; n < 4; ++n) {
                int row = rb + m * 16 + fr, col = cb + n * 16 + fq * 4;
                float v[4];
#pragma unroll
                for (int j = 0; j < 4; ++j) {
                    float a = acc[m][n][j];
                    if (MODE == 0) {
                        float t = -(vec[col + j] + a);
                        float sp = (t > 20.f) ? t : log1pf(__expf(t));
                        float wl = -sp - 0.5f;
                        v[j] = -__expf(wl);
                    } else if (MODE == 1) {
                        v[j] = sigmoidf_(vec[col + j] + a);
                    } else if (MODE == 2) {
                        v[j] = a;
                    } else {
                        v[j] = a * vec[coff + col + j];
                    }
                }
                if (MODE == 0) {
                    *reinterpret_cast<float4*>(Of + (size_t)row * ldo + col) = make_float4(v[0], v[1], v[2], v[3]);
                } else {
                    uint2 w; w.x = pack2(v[0], v[1]); w.y = pack2(v[2], v[3]);
                    *reinterpret_cast<uint2*>(Ob + (size_t)row * ldo + coff + col) = w;
                }
            }
    }
};
struct EpiOut {
    const float* Xprev; float* X;
    __device__ __forceinline__ void operator()(f32x4 (&acc)[4][4], int rb, int cb, int fr, int fq) const {
#pragma unroll
        for (int m = 0; m < 4; ++m)
#pragma unroll
            for (int n = 0; n < 4; ++n) {
                int row = rb + m * 16 + fr, col = cb + n * 16 + fq * 4;
                float4 xp = *reinterpret_cast<const float4*>(Xprev + (size_t)row * DM + col);
                float4 o;
                o.x = ALPHA_F * xp.x + acc[m][n][0]; o.y = ALPHA_F * xp.y + acc[m][n][1];
                o.z = ALPHA_F * xp.z + acc[m][n][2]; o.w = ALPHA_F * xp.w + acc[m][n][3];
                *reinterpret_cast<float4*>(X + (size_t)row * DM + col) = o;
            }
    }
};
struct EpiExp1 {
    bf16_t* H; int base; int cnt;
    __device__ __forceinline__ void operator()(f32x4 (&acc)[4][4], int rb, int cb, int fr, int fq) const {
#pragma unroll
        for (int m = 0; m < 4; ++m) {
            int li = rb + m * 16 + fr;
            if (li < cnt) {
#pragma unroll
                for (int i = 0; i < 2; ++i) {
                    int hcol = (cb >> 1) + i * 16 + fq * 4;
                    float v[4];
#pragma unroll
                    for (int j = 0; j < 4; ++j) v[j] = siluf_(acc[m][2 * i][j]) * acc[m][2 * i + 1][j];
                    uint2 w; w.x = pack2(v[0], v[1]); w.y = pack2(v[2], v[3]);
                    *reinterpret_cast<uint2*>(H + (size_t)(base + li) * 128 + hcol) = w;
                }
            }
        }
    }
};
struct EpiExp2 {
    bf16_t* FS; const int* ltok; const float* lgate; int cnt;
    __device__ __forceinline__ void operator()(f32x4 (&acc)[4][4], int rb, int cb, int fr, int fq) const {
#pragma unroll
        for (int m = 0; m < 4; ++m) {
            int li = rb + m * 16 + fr;
            if (li < cnt) {
                int pk = ltok[li]; float g = lgate[li];
                int tok = pk >> 1, j = pk & 1;
                bf16_t* o = FS + ((size_t)j * NT + tok) * DM;
#pragma unroll
                for (int n = 0; n < 4; ++n) {
                    int col = cb + n * 16 + fq * 4;
                    uint2 w; w.x = pack2(acc[m][n][0] * g, acc[m][n][1] * g); w.y = pack2(acc[m][n][2] * g, acc[m][n][3] * g);
                    *reinterpret_cast<uint2*>(o + col) = w;
                }
            }
        }
    }
};

__device__ __forceinline__ void tconv_tile(const float* __restrict__ src, int N, bf16_t* __restrict__ dst, int ldd, int k0, int n0,
                                           int mode, float* tile  ) {
    const int tid = threadIdx.x;
#pragma unroll
    for (int i = 0; i < 16; ++i) {
        int r = i * 4 + (tid >> 6), c = tid & 63;
        tile[r * 65 + c] = src[(size_t)(k0 + r) * N + n0 + c];
    }
    __syncthreads();
#pragma unroll
    for (int i = 0; i < 16; ++i) {
        int nn = i * 4 + (tid >> 6), kk = tid & 63;
        int n = n0 + nn;
        int drow = n;
        if (mode == 1) drow = (n >> 4) * 32 + (n & 15);
        else if (mode == 2) drow = (n >> 4) * 32 + 16 + (n & 15);
        dst[(size_t)drow * ldd + k0 + kk] = f2bf(tile[kk * 65 + nn]);
    }
    __syncthreads();
}

__device__ void phase_pre(const Params& p, unsigned char* smem) {
    float* tile = reinterpret_cast<float*>(smem);
    bf16_t* W = reinterpret_cast<bf16_t*>(p.ws + OFF_W);
    if (blockIdx.x == 0 && threadIdx.x < 64) reinterpret_cast<int*>(p.ws + OFF_CTRL)[threadIdx.x] = 0;
    constexpr int T0 = 576, T1 = 256, T2 = 768, T3 = 256, T4 = 2048, T5 = 2048, T6 = 2048, T7 = 8, T8 = 8, T9 = 16, T10 = 16;
    constexpr int TOT = T0 + T1 + T2 + T3 + T4 + T5 + T6 + T7 + T8 + T9 + T10;
    for (int u = blockIdx.x; u < TOT; u += gridDim.x) {
        int v = u;
        const float* src; bf16_t* dst; int K, N, mode = 0, tk, tn;
        if (v < T0) { src = p.in[1]; K = 1024; N = 2304; dst = W + WE_IN0; tk = v / 36; tn = v % 36; }
        else if ((v -= T0) < T1) { src = p.in[15]; K = 1024; N = 1024; dst = W + WE_OUT0; tk = v / 16; tn = v % 16; }
        else if ((v -= T1) < T2) { src = p.in[16]; K = 1024; N = 3072; dst = W + WE_IN1; tk = v / 48; tn = v % 48; }
        else if ((v -= T2) < T3) { src = p.in[23]; K = 1024; N = 1024; dst = W + WE_OUT1; tk = v / 16; tn = v % 16; }
        else if ((v -= T3) < T4) { int mat = v >> 5, w = v & 31; src = p.in[30] + (size_t)mat * 131072; K = 1024; N = 128; dst = W + WE_W13 + (size_t)mat * 262144; mode = 1; tk = w >> 1; tn = w & 1; }
        else if ((v -= T4) < T5) { int mat = v >> 5, w = v & 31; src = p.in[31] + (size_t)mat * 131072; K = 1024; N = 128; dst = W + WE_W13 + (size_t)mat * 262144; mode = 2; tk = w >> 1; tn = w & 1; }
        else if ((v -= T5) < T6) { int mat = v >> 5, w = v & 31; src = p.in[32] + (size_t)mat * 131072; K = 128; N = 1024; dst = W + WE_W2 + (size_t)mat * 131072; tk = w >> 4; tn = w & 15; }
        else if ((v -= T6) < T7) { src = p.in[4]; K = 64; N = 512; dst = W + WE_LW2; tk = 0; tn = v; }
        else if ((v -= T7) < T8) { src = p.in[6]; K = 64; N = 512; dst = W + WE_LA2; tk = 0; tn = v; }
        else if ((v -= T8) < T9) { src = p.in[7]; K = 128; N = 512; dst = W + WE_LG2; tk = v >> 3; tn = v & 7; }
        else { v -= T9; int mat = v >> 2, w = v & 3; src = p.in[13] + (size_t)mat * 16384; K = 128; N = 128; dst = W + WE_POOL + (size_t)mat * 16384; tk = w >> 1; tn = w & 1; }
        tconv_tile(src, N, dst, K, tk * 64, tn * 64, mode, tile);
    }
    {
        const float4* x4 = reinterpret_cast<const float4*>(p.in[0]);
        uint2* xb = reinterpret_cast<uint2*>(p.ws + OFF_ACTB);
        const size_t n4 = (size_t)NT * DM / 4;
        for (size_t i = (size_t)blockIdx.x * NTHREADS + threadIdx.x; i < n4; i += (size_t)gridDim.x * NTHREADS) {
            float4 v = x4[i];
            uint2 w; w.x = pack2(v.x, v.y); w.y = pack2(v.z, v.w);
            xb[i] = w;
        }
    }
    {
        float2* rope = reinterpret_cast<float2*>(p.ws + OFF_ROPE);
        for (int i = blockIdx.x * NTHREADS + threadIdx.x; i < SEQ * 32; i += gridDim.x * NTHREADS) {
            int pos = i >> 5, k = i & 31;
            float inv = powf(10000.0f, -(float)k / 32.0f);
            float ang = (float)pos * inv;
            float s, c;
            sincosf(ang, &s, &c);
            rope[i] = make_float2(c, s);
        }
    }
}

__device__ void phase_l0_prep(const Params& p) {
    const bf16_t* P = reinterpret_cast<const bf16_t*>(p.ws + OFF_P);
    bf16_t* LA = reinterpret_cast<bf16_t*>(p.ws + OFF_LORA);
    bf16_t* PO = reinterpret_cast<bf16_t*>(p.ws + OFF_POOLED);
    const float* mu = p.in[2];
    const int total = NT * 768;
    for (int i = blockIdx.x * NTHREADS + threadIdx.x; i < total; i += gridDim.x * NTHREADS) {
        int tok = i / 768, c = i % 768;
        int s = tok & (SEQ - 1);
        if (c < 256) {
            int col = 1536 + c;
            float pr = bf2f(P[(size_t)tok * 2304 + col]);
            float pv = (s > 0) ? bf2f(P[(size_t)(tok - 1) * 2304 + col]) : 0.f;
            float z = pr + mu[col] * (pv - pr);
            float o;
            if (c < 64) o = tanhf(z);
            else if (c < 128) o = z;
            else o = sigmoidf_(z);
            LA[(size_t)tok * 256 + c] = f2bf(o);
        } else {
            int cc = c - 256;
            int gi = cc >> 7;
            int win = 2 << gi;
            int cnt = (s + 1 < win) ? (s + 1) : win;
            float sum = 0.f;
            for (int j = 0; j < cnt; ++j) sum += bf2f(P[(size_t)(tok - j) * 2304 + 1792 + cc]);
            float u = bf2f(P[(size_t)tok * 2304 + 1792 + cc]);
            PO[(size_t)tok * 512 + cc] = f2bf(sum / (float)cnt - u);
        }
    }
}

__device__ void phase_l0_lora(const Params& p, bf16_t* smem) {
    const bf16_t* W = reinterpret_cast<const bf16_t*>(p.ws + OFF_W);
    const bf16_t* LA = reinterpret_cast<const bf16_t*>(p.ws + OFF_LORA);
    const bf16_t* PO = reinterpret_cast<const bf16_t*>(p.ws + OFF_POOLED);
    for (int t = blockIdx.x; t < 4096; t += gridDim.x) {
        int job = t >> 10, w = t & 1023;
        if (job == 0) {
            EpiLora<0> e{reinterpret_cast<float*>(p.ws + OFF_LOGW), nullptr, p.in[3], 512, 0};
            gemm_tile<false>(LA, 256, nullptr, 0, W + WE_LW2, 64, 64, (w >> 2) * 128, (w & 3) * 128, e, smem);
        } else if (job == 1) {
            EpiLora<1> e{nullptr, reinterpret_cast<bf16_t*>(p.ws + OFF_AA), p.in[5], 512, 0};
            gemm_tile<false>(LA + 64, 256, nullptr, 0, W + WE_LA2, 64, 64, (w >> 2) * 128, (w & 3) * 128, e, smem);
        } else if (job == 2) {
            EpiLora<2> e{nullptr, reinterpret_cast<bf16_t*>(p.ws + OFF_GG), nullptr, 512, 0};
            gemm_tile<false>(LA + 128, 256, nullptr, 0, W + WE_LG2, 128, 128, (w >> 2) * 128, (w & 3) * 128, e, smem);
        } else {
            int g = w & 3, tm = w >> 2;
            EpiLora<3> e{nullptr, reinterpret_cast<bf16_t*>(p.ws + OFF_YCAT), p.in[14], 1024, 512 + g * 128};
            e.vec = p.in[14] - 512;
            gemm_tile<false>(PO + g * 128, 512, nullptr, 0, W + WE_POOL + g * 16384, 128, 128, tm * 128, 0, e, smem);
        }
    }
}

#define RW_T 32
__device__ void phase_l0_scan(const Params& p, unsigned char* smem) {
    if (blockIdx.x >= 32) return;
    const int b = blockIdx.x >> 3, h = blockIdx.x & 7;
    const int tid = threadIdx.x, wv = tid >> 6, lane = tid & 63;
    float* sW = reinterpret_cast<float*>(smem);
    float* sKK = sW + RW_T * 64;
    float* sB = sKK + RW_T * 64;
    float* sKP = sB + RW_T * 64;
    float* sR = sKP + RW_T * 64;
    float* sV = sR + RW_T * 64;
    float* sY = sV + RW_T * 64;
    float* sBC = sY + RW_T * 64;
    const bf16_t* P = reinterpret_cast<const bf16_t*>(p.ws + OFF_P);
    const float* LOGW = reinterpret_cast<const float*>(p.ws + OFF_LOGW);
    const bf16_t* AA = reinterpret_cast<const bf16_t*>(p.ws + OFF_AA);
    const bf16_t* GG = reinterpret_cast<const bf16_t*>(p.ws + OFF_GG);
    bf16_t* YC = reinterpret_cast<bf16_t*>(p.ws + OFF_YCAT);
    const int c = h * 64 + lane;
    const float mu_r = p.in[2][c], mu_k = p.in[2][512 + c], mu_v = p.in[2][1024 + c];
    const float kkc = p.in[8][c], kac = p.in[9][c], rkc = p.in[10][c], lng = p.in[11][c], lnb = p.in[12][c];
    const int row = wv * 16 + (lane >> 2), kq = lane & 3;
    float s[16];
#pragma unroll
    for (int i = 0; i < 16; ++i) s[i] = 0.f;
    for (int t0 = 0; t0 < SEQ; t0 += RW_T) {
        for (int tl = wv; tl < RW_T; tl += 4) {
            int sidx = t0 + tl;
            size_t tok = (size_t)b * SEQ + sidx;
            const bf16_t* pr = P + tok * 2304;
            float r0 = bf2f(pr[c]), k0 = bf2f(pr[512 + c]), v0 = bf2f(pr[1024 + c]);
            float r1 = 0.f, k1 = 0.f, v1 = 0.f;
            if (sidx > 0) { const bf16_t* pp = pr - 2304; r1 = bf2f(pp[c]); k1 = bf2f(pp[512 + c]); v1 = bf2f(pp[1024 + c]); }
            float zr = r0 + mu_r * (r1 - r0), zk = k0 + mu_k * (k1 - k0), zv = v0 + mu_v * (v1 - v0);
            float w = __expf(LOGW[tok * 512 + c]);
            float a = bf2f(AA[tok * 512 + c]);
            float kk = zk * kkc;
            float ss = wave_sum(kk * kk);
            kk *= rsqrtf(fmaxf(ss, 1e-24f));
            float kp = zk * (1.0f + (a - 1.0f) * kac);
            float bc = wave_sum(zr * kp * rkc);
            sW[tl * 64 + lane] = w; sKK[tl * 64 + lane] = kk; sB[tl * 64 + lane] = kk * a; sKP[tl * 64 + lane] = kp;
            sR[tl * 64 + lane] = zr; sV[tl * 64 + lane] = zv;
            if (lane == 0) sBC[tl] = bc;
        }
        __syncthreads();
#pragma unroll 2
        for (int tl = 0; tl < RW_T; ++tl) {
            const float4* pk = reinterpret_cast<const float4*>(sKK + tl * 64 + kq * 16);
            const float4* pw = reinterpret_cast<const float4*>(sW + tl * 64 + kq * 16);
            const float4* pb = reinterpret_cast<const float4*>(sB + tl * 64 + kq * 16);
            const float4* pp = reinterpret_cast<const float4*>(sKP + tl * 64 + kq * 16);
            const float4* pr = reinterpret_cast<const float4*>(sR + tl * 64 + kq * 16);
            float kkv[16], wvv[16], bvv[16], kpv[16], rvv[16];
#pragma unroll
            for (int q = 0; q < 4; ++q) {
                float4 t;
                t = pk[q]; kkv[4 * q] = t.x; kkv[4 * q + 1] = t.y; kkv[4 * q + 2] = t.z; kkv[4 * q + 3] = t.w;
                t = pw[q]; wvv[4 * q] = t.x; wvv[4 * q + 1] = t.y; wvv[4 * q + 2] = t.z; wvv[4 * q + 3] = t.w;
                t = pb[q]; bvv[4 * q] = t.x; bvv[4 * q + 1] = t.y; bvv[4 * q + 2] = t.z; bvv[4 * q + 3] = t.w;
                t = pp[q]; kpv[4 * q] = t.x; kpv[4 * q + 1] = t.y; kpv[4 * q + 2] = t.z; kpv[4 * q + 3] = t.w;
                t = pr[q]; rvv[4 * q] = t.x; rvv[4 * q + 1] = t.y; rvv[4 * q + 2] = t.z; rvv[4 * q + 3] = t.w;
            }
            float vv = sV[tl * 64 + row];
            float d0 = 0.f, d1 = 0.f, d2 = 0.f, d3 = 0.f;
#pragma unroll
            for (int i = 0; i < 16; i += 4) { d0 += s[i] * kkv[i]; d1 += s[i + 1] * kkv[i + 1]; d2 += s[i + 2] * kkv[i + 2]; d3 += s[i + 3] * kkv[i + 3]; }
            float sa = -quad_sum((d0 + d1) + (d2 + d3));
            float y0 = 0.f, y1 = 0.f, y2 = 0.f, y3 = 0.f;
#pragma unroll
            for (int i = 0; i < 16; i += 4) {
                s[i] = s[i] * wvv[i] + (sa * bvv[i] + vv * kpv[i]);
                s[i + 1] = s[i + 1] * wvv[i + 1] + (sa * bvv[i + 1] + vv * kpv[i + 1]);
                s[i + 2] = s[i + 2] * wvv[i + 2] + (sa * bvv[i + 2] + vv * kpv[i + 2]);
                s[i + 3] = s[i + 3] * wvv[i + 3] + (sa * bvv[i + 3] + vv * kpv[i + 3]);
                y0 += s[i] * rvv[i]; y1 += s[i + 1] * rvv[i + 1]; y2 += s[i + 2] * rvv[i + 2]; y3 += s[i + 3] * rvv[i + 3];
            }
            float y = quad_sum((y0 + y1) + (y2 + y3));
            if (kq == 0) sY[tl * 64 + row] = y;
        }
        __syncthreads();
        for (int tl = wv; tl < RW_T; tl += 4) {
            size_t tok = (size_t)b * SEQ + t0 + tl;
            float y = sY[tl * 64 + lane];
            float mean = wave_sum(y) * (1.0f / 64.0f);
            float d = y - mean;
            float var = wave_sum(d * d) * (1.0f / 64.0f);
            float yn = d * rsqrtf(var + 64e-5f) * lng + lnb;
            float g = bf2f(GG[tok * 512 + c]);
            float o = (yn + sBC[tl] * sV[tl * 64 + lane]) * g;
            YC[tok * 1024 + c] = f2bf(o);
        }
        __syncthreads();
    }
}

__device__ void phase_ln_route(const Params& p, int layer, float* X) {
    const int tid = threadIdx.x, wv = tid >> 6, lane = tid & 63;
    const float* g = p.in[24] + layer * DM;
    const float* bb = p.in[25] + layer * DM;
    const float* rgw = p.in[26] + (size_t)layer * DM * 4;
    const float* rgb = p.in[27] + layer * 4;
    const float* rew = p.in[28] + (size_t)layer * DM * 32;
    const float* reb = p.in[29] + layer * 32;
    bf16_t* XB = reinterpret_cast<bf16_t*>(p.ws + OFF_ACTB);
    int* cnt = reinterpret_cast<int*>(p.ws + OFF_CTRL) + layer * 32;
    int* ltok = reinterpret_cast<int*>(p.ws + OFF_LTOK);
    float* lgate = reinterpret_cast<float*>(p.ws + OFF_LGATE);
    for (int row = blockIdx.x * 4 + wv; row < NT; row += gridDim.x * 4) {
        float* xr = X + (size_t)row * DM;
        float v[16];
#pragma unroll
        for (int i = 0; i < 4; ++i) {
            float4 t = *reinterpret_cast<const float4*>(xr + i * 256 + lane * 4);
            v[4 * i] = t.x; v[4 * i + 1] = t.y; v[4 * i + 2] = t.z; v[4 * i + 3] = t.w;
        }
        float sum = 0.f;
#pragma unroll
        for (int i = 0; i < 16; ++i) sum += v[i];
        float mean = wave_sum(sum) * (1.0f / DM);
        float sq = 0.f;
#pragma unroll
        for (int i = 0; i < 16; ++i) { float d = v[i] - mean; sq += d * d; }
        float rstd = rsqrtf(wave_sum(sq) * (1.0f / DM) + 1e-5f);
#pragma unroll
        for (int i = 0; i < 4; ++i) {
            int col = i * 256 + lane * 4;
            float4 gg = *reinterpret_cast<const float4*>(g + col);
            float4 bv = *reinterpret_cast<const float4*>(bb + col);
            v[4 * i] = (v[4 * i] - mean) * rstd * gg.x + bv.x;
            v[4 * i + 1] = (v[4 * i + 1] - mean) * rstd * gg.y + bv.y;
            v[4 * i + 2] = (v[4 * i + 2] - mean) * rstd * gg.z + bv.z;
            v[4 * i + 3] = (v[4 * i + 3] - mean) * rstd * gg.w + bv.w;
            *reinterpret_cast<float4*>(xr + col) = make_float4(v[4 * i], v[4 * i + 1], v[4 * i + 2], v[4 * i + 3]);
            uint2 w; w.x = pack2(v[4 * i], v[4 * i + 1]); w.y = pack2(v[4 * i + 2], v[4 * i + 3]);
            *reinterpret_cast<uint2*>(XB + (size_t)row * DM + col) = w;
        }
        float gl[4] = {0.f, 0.f, 0.f, 0.f};
#pragma unroll
        for (int i = 0; i < 4; ++i)
#pragma unroll
            for (int e = 0; e < 4; ++e) {
                int k = i * 256 + lane * 4 + e;
                float4 w = *reinterpret_cast<const float4*>(rgw + (size_t)k * 4);
                float xv = v[4 * i + e];
                gl[0] += xv * w.x; gl[1] += xv * w.y; gl[2] += xv * w.z; gl[3] += xv * w.w;
            }
#pragma unroll
        for (int j = 0; j < 4; ++j) gl[j] = wave_sum(gl[j]) + rgb[j];
        int gi = 0; float gm = gl[0];
#pragma unroll
        for (int j = 1; j < 4; ++j) if (gl[j] > gm) { gm = gl[j]; gi = j; }
        float gs = 0.f;
#pragma unroll
        for (int j = 0; j < 4; ++j) gs += __expf(gl[j] - gm);
        float gw = 1.0f / gs;
        float el[8];
#pragma unroll
        for (int j = 0; j < 8; ++j) el[j] = 0.f;
#pragma unroll
        for (int i = 0; i < 4; ++i)
#pragma unroll
            for (int e = 0; e < 4; ++e) {
                int k = i * 256 + lane * 4 + e;
                const float4* wp = reinterpret_cast<const float4*>(rew + (size_t)k * 32 + gi * 8);
                float4 w0 = wp[0], w1 = wp[1];
                float xv = v[4 * i + e];
                el[0] += xv * w0.x; el[1] += xv * w0.y; el[2] += xv * w0.z; el[3] += xv * w0.w;
                el[4] += xv * w1.x; el[5] += xv * w1.y; el[6] += xv * w1.z; el[7] += xv * w1.w;
            }
#pragma unroll
        for (int j = 0; j < 8; ++j) el[j] = wave_sum(el[j]) + reb[gi * 8 + j];
        int i1 = 0; float m1 = el[0];
#pragma unroll
        for (int j = 1; j < 8; ++j) if (el[j] > m1) { m1 = el[j]; i1 = j; }
        int i2 = -1; float m2 = -3.0e38f;
#pragma unroll
        for (int j = 0; j < 8; ++j) if (j != i1 && el[j] > m2) { m2 = el[j]; i2 = j; }
        float e2 = __expf(m2 - m1);
        float p1 = 1.0f / (1.0f + e2), p2 = e2 / (1.0f + e2);
        if (lane < 2) {
            int ex = gi * 8 + (lane == 0 ? i1 : i2);
            float gate = gw * (lane == 0 ? p1 : p2);
            int slot = atomicAdd(&cnt[ex], 1);
            ltok[(size_t)ex * NT + slot] = row * 2 + lane;
            lgate[(size_t)ex * NT + slot] = gate;
        }
    }
}

__device__ void phase_exp1(const Params& p, int layer, bf16_t* smem) {
    const int* cnt = reinterpret_cast<const int*>(p.ws + OFF_CTRL) + layer * 32;
    const int* ltok = reinterpret_cast<const int*>(p.ws + OFF_LTOK);
    const bf16_t* XB = reinterpret_cast<const bf16_t*>(p.ws + OFF_ACTB);
    const bf16_t* W13 = reinterpret_cast<const bf16_t*>(p.ws + OFF_W) + WE_W13 + (size_t)layer * 32 * 262144;
    bf16_t* H = reinterpret_cast<bf16_t*>(p.ws + OFF_HBUF);
    int t = blockIdx.x;
    int base = 0, tbase = 0;
    for (int e = 0; e < 32; ++e) {
        int c = cnt[e];
        int nt = ((c + 127) >> 7) * 2;
        while (t < tbase + nt) {
            int w = t - tbase;
            EpiExp1 epi{H, base, c};
            gemm_tile<true>(XB, DM, ltok + (size_t)e * NT, c, W13 + (size_t)e * 262144, DM, DM, (w >> 1) * 128, (w & 1) * 128, epi, smem);
            t += gridDim.x;
        }
        tbase += nt; base += c;
    }
}
__device__ void phase_exp2(const Params& p, int layer, bf16_t* smem) {
    const int* cnt = reinterpret_cast<const int*>(p.ws + OFF_CTRL) + layer * 32;
    const int* ltok = reinterpret_cast<const int*>(p.ws + OFF_LTOK);
    const float* lgate = reinterpret_cast<const float*>(p.ws + OFF_LGATE);
    const bf16_t* W2 = reinterpret_cast<const bf16_t*>(p.ws + OFF_W) + WE_W2 + (size_t)layer * 32 * 131072;
    const bf16_t* H = reinterpret_cast<const bf16_t*>(p.ws + OFF_HBUF);
    bf16_t* FS = reinterpret_cast<bf16_t*>(p.ws + OFF_FS);
    int t = blockIdx.x;
    int base = 0, tbase = 0;
    for (int e = 0; e < 32; ++e) {
        int c = cnt[e];
        int nt = ((c + 127) >> 7) * 8;
        while (t < tbase + nt) {
            int w = t - tbase;
            EpiExp2 epi{FS, ltok + (size_t)e * NT, lgate + (size_t)e * NT, c};
            gemm_tile<false>(H + (size_t)base * 128, 128, nullptr, 0, W2 + (size_t)e * 131072, 128, 128, (w >> 3) * 128, (w & 7) * 128, epi, smem);
            t += gridDim.x;
        }
        tbase += nt; base += c;
    }
}

__device__ void phase_ln_ffn(const Params& p, int layer, float* X, bool write_b) {
    const int tid = threadIdx.x, wv = tid >> 6, lane = tid & 63;
    const float* g = p.in[33] + layer * DM;
    const float* bb = p.in[34] + layer * DM;
    const bf16_t* FS = reinterpret_cast<const bf16_t*>(p.ws + OFF_FS);
    bf16_t* XB = reinterpret_cast<bf16_t*>(p.ws + OFF_ACTB);
    for (int row = blockIdx.x * 4 + wv; row < NT; row += gridDim.x * 4) {
        float* xr = X + (size_t)row * DM;
        float v[16];
#pragma unroll
        for (int i = 0; i < 4; ++i) {
            int col = i * 256 + lane * 4;
            float4 t = *reinterpret_cast<const float4*>(xr + col);
            uint2 f0 = *reinterpret_cast<const uint2*>(FS + (size_t)row * DM + col);
            uint2 f1 = *reinterpret_cast<const uint2*>(FS + ((size_t)NT + row) * DM + col);
            v[4 * i] = ALPHA_F * t.x + __uint_as_float(f0.x << 16) + __uint_as_float(f1.x << 16);
            v[4 * i + 1] = ALPHA_F * t.y + __uint_as_float(f0.x & 0xffff0000u) + __uint_as_float(f1.x & 0xffff0000u);
            v[4 * i + 2] = ALPHA_F * t.z + __uint_as_float(f0.y << 16) + __uint_as_float(f1.y << 16);
            v[4 * i + 3] = ALPHA_F * t.w + __uint_as_float(f0.y & 0xffff0000u) + __uint_as_float(f1.y & 0xffff0000u);
        }
        float sum = 0.f;
#pragma unroll
        for (int i = 0; i < 16; ++i) sum += v[i];
        float mean = wave_sum(sum) * (1.0f / DM);
        float sq = 0.f;
#pragma unroll
        for (int i = 0; i < 16; ++i) { float d = v[i] - mean; sq += d * d; }
        float rstd = rsqrtf(wave_sum(sq) * (1.0f / DM) + 1e-5f);
#pragma unroll
        for (int i = 0; i < 4; ++i) {
            int col = i * 256 + lane * 4;
            float4 gg = *reinterpret_cast<const float4*>(g + col);
            float4 bv = *reinterpret_cast<const float4*>(bb + col);
            float o0 = (v[4 * i] - mean) * rstd * gg.x + bv.x;
            float o1 = (v[4 * i + 1] - mean) * rstd * gg.y + bv.y;
            float o2 = (v[4 * i + 2] - mean) * rstd * gg.z + bv.z;
            float o3 = (v[4 * i + 3] - mean) * rstd * gg.w + bv.w;
            *reinterpret_cast<float4*>(xr + col) = make_float4(o0, o1, o2, o3);
            if (write_b) {
                uint2 w; w.x = pack2(o0, o1); w.y = pack2(o2, o3);
                *reinterpret_cast<uint2*>(XB + (size_t)row * DM + col) = w;
            }
        }
    }
}

__device__ void phase_l1_conv(const Params& p, unsigned char* smem) {
    const bf16_t* P = reinterpret_cast<const bf16_t*>(p.ws + OFF_P);
    bf16_t* YC = reinterpret_cast<bf16_t*>(p.ws + OFF_YCAT);
    float* red = reinterpret_cast<float*>(smem);
    const int tid = threadIdx.x, wv = tid >> 6, lane = tid & 63;
    const float* cw = p.in[17];
    float w0[31], w1[31];
#pragma unroll
    for (int j = 0; j < 31; ++j) { w0[j] = cw[j * 512 + tid]; w1[j] = cw[j * 512 + 256 + tid]; }
    const float cb0 = p.in[18][tid], cb1 = p.in[18][256 + tid];
    const float g0 = p.in[19][tid], g1 = p.in[19][256 + tid];
    const float b0 = p.in[20][tid], b1 = p.in[20][256 + tid];
    for (int u = blockIdx.x; u < NT / 8; u += gridDim.x) {
        const int t0 = u * 8;
        const int s0 = t0 & (SEQ - 1);
        float a0[8], a1[8];
#pragma unroll
        for (int o = 0; o < 8; ++o) { a0[o] = cb0; a1[o] = cb1; }
#pragma unroll
        for (int rr = 0; rr < 38; ++rr) {
            int srow = s0 - 30 + rr;
            float u0 = 0.f, u1 = 0.f;
            if (srow >= 0) {
                const bf16_t* pr = P + (size_t)(t0 - 30 + rr) * 3072;
                float ca0 = bf2f(pr[tid]), ca1 = bf2f(pr[256 + tid]);
                float cg0 = bf2f(pr[512 + tid]), cg1 = bf2f(pr[768 + tid]);
                u0 = ca0 * sigmoidf_(cg0); u1 = ca1 * sigmoidf_(cg1);
            }
#pragma unroll
            for (int o = 0; o < 8; ++o) {
                int j = rr - o;
                if (j >= 0 && j <= 30) { a0[o] += u0 * w0[j]; a1[o] += u1 * w1[j]; }
            }
        }
        float mean[8], rstd[8];
#pragma unroll
        for (int o = 0; o < 8; ++o) {
            float sm = wave_sum(a0[o] + a1[o]);
            if (lane == 0) red[wv * 8 + o] = sm;
        }
        __syncthreads();
#pragma unroll
        for (int o = 0; o < 8; ++o) mean[o] = (red[o] + red[8 + o] + red[16 + o] + red[24 + o]) * (1.0f / 512.0f);
        __syncthreads();
#pragma unroll
        for (int o = 0; o < 8; ++o) {
            float d0 = a0[o] - mean[o], d1 = a1[o] - mean[o];
            float sm = wave_sum(d0 * d0 + d1 * d1);
            if (lane == 0) red[wv * 8 + o] = sm;
        }
        __syncthreads();
#pragma unroll
        for (int o = 0; o < 8; ++o) rstd[o] = rsqrtf((red[o] + red[8 + o] + red[16 + o] + red[24 + o]) * (1.0f / 512.0f) + 1e-5f);
        __syncthreads();
#pragma unroll
        for (int o = 0; o < 8; ++o) {
            float y0 = (a0[o] - mean[o]) * rstd[o] * g0 + b0;
            float y1 = (a1[o] - mean[o]) * rstd[o] * g1 + b1;
            YC[(size_t)(t0 + o) * 1024 + tid] = f2bf(siluf_(y0));
            YC[(size_t)(t0 + o) * 1024 + 256 + tid] = f2bf(siluf_(y1));
        }
    }
}

__device__ __forceinline__ float ret_lg(int h) { return log1pf(-exp2f(-5.0f - (float)h)); }

#define KT_LD 136
__device__ void phase_ret_kv(const Params& p, unsigned char* smem) {
    const bf16_t* P = reinterpret_cast<const bf16_t*>(p.ws + OFF_P);
    const float2* rope = reinterpret_cast<const float2*>(p.ws + OFF_ROPE);
    float* KVT = reinterpret_cast<float*>(p.ws + OFF_KVT);
    bf16_t* sKT = reinterpret_cast<bf16_t*>(smem);
    bf16_t* sVT = sKT + 64 * KT_LD;
    const int tid = threadIdx.x, wv = tid >> 6, lane = tid & 63, fr = lane & 15, fq = lane >> 4;
    for (int u = blockIdx.x; u < 2048; u += gridDim.x) {
        const int n = u & 63, h = (u >> 6) & 7, b = u >> 9;
        const float lg = ret_lg(h);
        {
            const int c = tid >> 1, i0 = (tid & 1) * 16;
            const int sidx = n * 128 + c;
            const size_t tok = (size_t)b * SEQ + sidx;
            const bf16_t* kr = P + tok * 3072 + 1536 + h * 64;
            const bf16_t* vr = P + tok * 3072 + 2048 + h * 64;
            const float zeta = __expf((float)(127 - c) * lg) * 0.125f;
#pragma unroll
            for (int i = 0; i < 16; ++i) {
                float t1 = bf2f(kr[i0 + i]), t2 = bf2f(kr[32 + i0 + i]);
                float2 cs = rope[sidx * 32 + i0 + i];
                float o1 = (t1 * cs.x - t2 * cs.y) * zeta, o2 = (t1 * cs.y + t2 * cs.x) * zeta;
                sKT[(i0 + i) * KT_LD + c] = f2bf(o1);
                sKT[(32 + i0 + i) * KT_LD + c] = f2bf(o2);
                sVT[(i0 + i) * KT_LD + c] = vr[i0 + i];
                sVT[(32 + i0 + i) * KT_LD + c] = vr[32 + i0 + i];
            }
        }
        __syncthreads();
        f32x4 acc[4];
#pragma unroll
        for (int nn = 0; nn < 4; ++nn) acc[nn] = (f32x4){0.f, 0.f, 0.f, 0.f};
#pragma unroll
        for (int ks = 0; ks < 4; ++ks) {
            bf16x8 af = *reinterpret_cast<const bf16x8*>(sVT + (wv * 16 + fr) * KT_LD + ks * 32 + fq * 8);
#pragma unroll
            for (int nn = 0; nn < 4; ++nn) {
                bf16x8 bfr = *reinterpret_cast<const bf16x8*>(sKT + (nn * 16 + fr) * KT_LD + ks * 32 + fq * 8);
                acc[nn] = __builtin_amdgcn_mfma_f32_16x16x32_bf16(af, bfr, acc[nn], 0, 0, 0);
            }
        }
        float* o = KVT + (size_t)u * 4096;
#pragma unroll
        for (int nn = 0; nn < 4; ++nn)
#pragma unroll
            for (int j = 0; j < 4; ++j) o[(wv * 16 + fq * 4 + j) * 64 + nn * 16 + fr] = acc[nn][j];
        __syncthreads();
    }
}
__device__ void phase_ret_scan(const Params& p) {
    float* KVT = reinterpret_cast<float*>(p.ws + OFF_KVT);
    for (int i = blockIdx.x * NTHREADS + threadIdx.x; i < 32 * 4096; i += gridDim.x * NTHREADS) {
        int bh = i >> 12, ed = i & 4095, h = bh & 7;
        float gc = __expf(128.0f * ret_lg(h));
        float R = 0.f;
        float* q = KVT + (size_t)bh * 64 * 4096 + ed;
        for (int n = 0; n < 64; ++n) {
            float kv = q[(size_t)n * 4096];
            q[(size_t)n * 4096] = R;
            R = gc * R + kv;
        }
    }
}
#define Q_LD 72
__device__ void phase_ret_out(const Params& p, unsigned char* smem) {
    const bf16_t* P = reinterpret_cast<const bf16_t*>(p.ws + OFF_P);
    const float2* rope = reinterpret_cast<const float2*>(p.ws + OFF_ROPE);
    const float* KVT = reinterpret_cast<const float*>(p.ws + OFF_KVT);
    bf16_t* YC = reinterpret_cast<bf16_t*>(p.ws + OFF_YCAT);
    bf16_t* sQ = reinterpret_cast<bf16_t*>(smem);
    bf16_t* sK = sQ + 128 * Q_LD;
    bf16_t* sVT = sK + 128 * Q_LD;
    bf16_t* sRT = sVT + 64 * KT_LD;
    bf16_t* sS = sQ;
    const int tid = threadIdx.x, wv = tid >> 6, lane = tid & 63, fr = lane & 15, fq = lane >> 4;
    const float* gng = p.in[21];
    const float* gnb = p.in[22];
    for (int u = blockIdx.x; u < 2048; u += gridDim.x) {
        const int n = u & 63, h = (u >> 6) & 7, b = u >> 9;
        const float lg = ret_lg(h);
        {
            const int c = tid >> 1, i0 = (tid & 1) * 16;
            const int sidx = n * 128 + c;
            const size_t tok = (size_t)b * SEQ + sidx;
            const bf16_t* qr = P + tok * 3072 + 1024 + h * 64;
            const bf16_t* kr = P + tok * 3072 + 1536 + h * 64;
            const bf16_t* vr = P + tok * 3072 + 2048 + h * 64;
#pragma unroll
            for (int i = 0; i < 16; ++i) {
                float2 cs = rope[sidx * 32 + i0 + i];
                float q1 = bf2f(qr[i0 + i]), q2 = bf2f(qr[32 + i0 + i]);
                sQ[c * Q_LD + i0 + i] = f2bf(q1 * cs.x - q2 * cs.y);
                sQ[c * Q_LD + 32 + i0 + i] = f2bf(q1 * cs.y + q2 * cs.x);
                float k1 = bf2f(kr[i0 + i]), k2 = bf2f(kr[32 + i0 + i]);
                sK[c * Q_LD + i0 + i] = f2bf((k1 * cs.x - k2 * cs.y) * 0.125f);
                sK[c * Q_LD + 32 + i0 + i] = f2bf((k1 * cs.y + k2 * cs.x) * 0.125f);
                sVT[(i0 + i) * KT_LD + c] = vr[i0 + i];
                sVT[(32 + i0 + i) * KT_LD + c] = vr[32 + i0 + i];
            }
            const float* rp = KVT + (size_t)u * 4096;
#pragma unroll
            for (int i = 0; i < 16; ++i) {
                int idx = tid * 16 + i;
                sRT[(idx >> 6) * Q_LD + (idx & 63)] = f2bf(rp[idx]);
            }
        }
        __syncthreads();
        f32x4 accs[2][8], accc[2][4];
#pragma unroll
        for (int m = 0; m < 2; ++m) {
#pragma unroll
            for (int nn = 0; nn < 8; ++nn) accs[m][nn] = (f32x4){0.f, 0.f, 0.f, 0.f};
#pragma unroll
            for (int nn = 0; nn < 4; ++nn) accc[m][nn] = (f32x4){0.f, 0.f, 0.f, 0.f};
        }
#pragma unroll
        for (int ks = 0; ks < 2; ++ks) {
            bf16x8 af[2];
#pragma unroll
            for (int m = 0; m < 2; ++m) af[m] = *reinterpret_cast<const bf16x8*>(sQ + (wv * 32 + m * 16 + fr) * Q_LD + ks * 32 + fq * 8);
#pragma unroll
            for (int nn = 0; nn < 8; ++nn) {
                if (nn <= 2 * wv + 1) {
                    bf16x8 bfr = *reinterpret_cast<const bf16x8*>(sK + (nn * 16 + fr) * Q_LD + ks * 32 + fq * 8);
#pragma unroll
                    for (int m = 0; m < 2; ++m) accs[m][nn] = __builtin_amdgcn_mfma_f32_16x16x32_bf16(af[m], bfr, accs[m][nn], 0, 0, 0);
                }
            }
#pragma unroll
            for (int nn = 0; nn < 4; ++nn) {
                bf16x8 bfr = *reinterpret_cast<const bf16x8*>(sRT + (nn * 16 + fr) * Q_LD + ks * 32 + fq * 8);
#pragma unroll
                for (int m = 0; m < 2; ++m) accc[m][nn] = __builtin_amdgcn_mfma_f32_16x16x32_bf16(af[m], bfr, accc[m][nn], 0, 0, 0);
            }
        }
        __syncthreads();
        bf16_t* mS = sS + wv * 32 * KT_LD;
#pragma unroll
        for (int m = 0; m < 2; ++m)
#pragma unroll
            for (int nn = 0; nn < 8; ++nn)
#pragma unroll
                for (int j = 0; j < 4; ++j) {
                    int il = m * 16 + fq * 4 + j;
                    int ig = wv * 32 + il, jg = nn * 16 + fr;
                    float v = 0.f;
                    if (nn <= 2 * wv + 1 && ig >= jg) v = accs[m][nn][j] * __expf((float)(ig - jg) * lg);
                    mS[il * KT_LD + jg] = f2bf(v);
                }
        __syncthreads();
        f32x4 acco[2][4];
#pragma unroll
        for (int m = 0; m < 2; ++m)
#pragma unroll
            for (int nn = 0; nn < 4; ++nn) acco[m][nn] = (f32x4){0.f, 0.f, 0.f, 0.f};
#pragma unroll
        for (int ks = 0; ks < 4; ++ks) {
            if (ks <= wv) {
                bf16x8 af[2];
#pragma unroll
                for (int m = 0; m < 2; ++m) af[m] = *reinterpret_cast<const bf16x8*>(mS + (m * 16 + fr) * KT_LD + ks * 32 + fq * 8);
#pragma unroll
                for (int nn = 0; nn < 4; ++nn) {
                    bf16x8 bfr = *reinterpret_cast<const bf16x8*>(sVT + (nn * 16 + fr) * KT_LD + ks * 32 + fq * 8);
#pragma unroll
                    for (int m = 0; m < 2; ++m) acco[m][nn] = __builtin_amdgcn_mfma_f32_16x16x32_bf16(af[m], bfr, acco[m][nn], 0, 0, 0);
                }
            }
        }
#pragma unroll
        for (int m = 0; m < 2; ++m)
#pragma unroll
            for (int j = 0; j < 4; ++j) {
                int ig = wv * 32 + m * 16 + fq * 4 + j;
                float xi = __expf((float)(ig + 1) * lg);
                float o[4];
                float sm = 0.f;
#pragma unroll
                for (int nn = 0; nn < 4; ++nn) { o[nn] = acco[m][nn][j] + xi * accc[m][nn][j]; sm += o[nn]; }
                sm += __shfl_xor(sm, 1); sm += __shfl_xor(sm, 2); sm += __shfl_xor(sm, 4); sm += __shfl_xor(sm, 8);
                float mean = sm * (1.0f / 64.0f);
                float sq = 0.f;
#pragma unroll
                for (int nn = 0; nn < 4; ++nn) { float d = o[nn] - mean; sq += d * d; }
                sq += __shfl_xor(sq, 1); sq += __shfl_xor(sq, 2); sq += __shfl_xor(sq, 4); sq += __shfl_xor(sq, 8);
                float rstd = rsqrtf(sq * (1.0f / 64.0f) + 1e-5f);
                size_t tok = (size_t)b * SEQ + n * 128 + ig;
#pragma unroll
                for (int nn = 0; nn < 4; ++nn) {
                    int e = h * 64 + nn * 16 + fr;
                    float y = (o[nn] - mean) * rstd * gng[e] + gnb[e];
                    float gr = bf2f(P[tok * 3072 + 2560 + e]);
                    YC[tok * 1024 + 512 + e] = f2bf(siluf_(gr) * y);
                }
            }
        __syncthreads();
    }
}

#define N_PHASES 21
__device__ __forceinline__ void run_phase(const Params& p, int ph, unsigned char* smem) {
    bf16_t* sm16 = reinterpret_cast<bf16_t*>(smem);
    const bf16_t* W = reinterpret_cast<const bf16_t*>(p.ws + OFF_W);
    bf16_t* ACTB = reinterpret_cast<bf16_t*>(p.ws + OFF_ACTB);
    bf16_t* PB = reinterpret_cast<bf16_t*>(p.ws + OFF_P);
    bf16_t* YC = reinterpret_cast<bf16_t*>(p.ws + OFF_YCAT);
    switch (ph) {
        case 0: phase_pre(p, smem); break;
        case 1: { EpiStoreBf16 e{PB, 2304}; gemm_phase(ACTB, DM, W + WE_IN0, DM, DM, NT / 128, 18, e, sm16); } break;
        case 2: phase_l0_prep(p); break;
        case 3: phase_l0_lora(p, sm16); break;
        case 4: phase_l0_scan(p, smem); break;
        case 5: { EpiOut e{p.in[0], p.out}; gemm_phase(YC, DM, W + WE_OUT0, DM, DM, NT / 128, 8, e, sm16); } break;
        case 6: phase_ln_route(p, 0, p.out); break;
        case 7: phase_exp1(p, 0, sm16); break;
        case 8: phase_exp2(p, 0, sm16); break;
        case 9: phase_ln_ffn(p, 0, p.out, true); break;
        case 10: { EpiStoreBf16 e{PB, 3072}; gemm_phase(ACTB, DM, W + WE_IN1, DM, DM, NT / 128, 24, e, sm16); } break;
        case 11: phase_l1_conv(p, smem); break;
        case 12: phase_ret_kv(p, smem); break;
        case 13: phase_ret_scan(p); break;
        case 14: phase_ret_out(p, smem); break;
        case 15: { EpiOut e{p.out, p.out}; gemm_phase(YC, DM, W + WE_OUT1, DM, DM, NT / 128, 8, e, sm16); } break;
        case 16: phase_ln_route(p, 1, p.out); break;
        case 17: phase_exp1(p, 1, sm16); break;
        case 18: phase_exp2(p, 1, sm16); break;
        case 19: phase_ln_ffn(p, 1, p.out, false); break;
        default: break;
    }
}

#define SMEM_BYTES 65536
__global__ void __launch_bounds__(NTHREADS) k_phase(Params p, int ph) {
    __shared__ __attribute__((aligned(16))) unsigned char smem[SMEM_BYTES];
    run_phase(p, ph, smem);
}

extern "C" void kernel_launch(void* const* d_in, const int* in_sizes, int n_in, void* d_out, int out_size, void* d_ws, size_t ws_size,
                              hipStream_t stream) {
    Params p{};
    for (int i = 0; i < 35; ++i) p.in[i] = (const float*)d_in[i];
    p.out = (float*)d_out;
    p.ws = (unsigned char*)d_ws;
    for (int ph = 0; ph < 20; ++ph) {
        hipLaunchKernelGGL(k_phase, dim3(1024), dim3(NTHREADS), 0, stream, p, ph);
    }
}
```

```cpp
#include <hip/hip_runtime.h>
#include <hip/hip_cooperative_groups.h>
#include <stdint.h>
#include <stdio.h>
namespace cg = cooperative_groups;

typedef unsigned short bf16_t;
typedef short bf16x8 __attribute__((ext_vector_type(8)));
typedef float f32x4 __attribute__((ext_vector_type(4)));

#define NT 32768
#define SEQ 8192
#define DM 1024
#define NTHREADS 256
#define ALPHA_F 1.41421356237309515f

#define MIB (1024ull * 1024ull)
#define OFF_CTRL 0ull
#define OFF_W (1ull * MIB)
#define OFF_ROPE (65ull * MIB)
#define OFF_ACTB (68ull * MIB)
#define OFF_AA (OFF_ACTB)
#define OFF_GG (OFF_ACTB + 32ull * MIB)
#define OFF_P (132ull * MIB)
#define OFF_LORA (OFF_P + 144ull * MIB)
#define OFF_POOLED (OFF_P + 160ull * MIB)
#define OFF_FS (OFF_P)
#define OFF_HBUF (OFF_P + 128ull * MIB)
#define OFF_YCAT (324ull * MIB)
#define OFF_LOGW (388ull * MIB)
#define OFF_LTOK (452ull * MIB)
#define OFF_LGATE (456ull * MIB)
#define OFF_KVT (460ull * MIB)
#define WE_IN0 0
#define WE_OUT0 2359296
#define WE_IN1 3407872
#define WE_OUT1 6553600
#define WE_W13 7602176
#define WE_W2 24379392
#define WE_LW2 32768000
#define WE_LA2 32800768
#define WE_LG2 32833536
#define WE_POOL 32899072

struct Params {
    const float* in[35];
    float* out;
    unsigned char* ws;
};

__device__ __forceinline__ bf16_t f2bf(float f) {
    unsigned u = __float_as_uint(f);
    u += 0x7fffu + ((u >> 16) & 1u);
    return (bf16_t)(u >> 16);
}
__device__ __forceinline__ float bf2f(bf16_t h) { return __uint_as_float(((unsigned)h) << 16); }
__device__ __forceinline__ unsigned pack2(float a, float b) { return (unsigned)f2bf(a) | ((unsigned)f2bf(b) << 16); }
__device__ __forceinline__ float wave_sum(float v) {
#pragma unroll
    for (int o = 32; o > 0; o >>= 1) v += __shfl_xor(v, o);
    return v;
}
__device__ __forceinline__ float sigmoidf_(float x) { return 1.0f / (1.0f + __expf(-x)); }
__device__ __forceinline__ float siluf_(float x) { return x / (1.0f + __expf(-x)); }
__device__ __forceinline__ float quad_sum(float v) {
    int iv = __float_as_int(v);
    float a = __int_as_float(__builtin_amdgcn_update_dpp(0, iv, 0xB1, 0xF, 0xF, false));
    v += a;
    iv = __float_as_int(v);
    float b = __int_as_float(__builtin_amdgcn_update_dpp(0, iv, 0x4E, 0xF, 0xF, false));
    return v + b;
}

__device__ __forceinline__ int otid() { int t = threadIdx.x; asm volatile("" : "+v"(t)); return t; }
template <bool GATHER, class Epi>
__device__ __forceinline__ void gemm_tile(const bf16_t* __restrict__ A, int lda, const int* __restrict__ gidx, int gcount,
                                          const bf16_t* __restrict__ Bt, int ldb, int K, int row0, int col0, const Epi& epi,
                                          bf16_t* smem) {
    const int tidx = otid();
    const int tid = tidx, wid = tid >> 6, lane = tid & 63, wr = wid >> 1, wc = wid & 1, fr = lane & 15, fq = lane >> 4;
    bf16_t* SA = smem;
    bf16_t* SB = smem + 128 * 32;
    const bf16_t* ap[2];
    const bf16_t* bp[2];
#pragma unroll
    for (int i = 0; i < 2; ++i) {
        int b = tid * 16 + i * 4096;
        int r = b >> 6, c = (b & 63) >> 1;
        int ar = row0 + r;
        if (GATHER) {
            int gi = ar < gcount ? ar : gcount - 1;
            ar = gidx[gi] >> 1;
        }
        ap[i] = A + (size_t)ar * lda + c;
        bp[i] = Bt + (size_t)(col0 + r) * ldb + c;
    }
    f32x4 acc[4][4];
#pragma unroll
    for (int m = 0; m < 4; ++m)
#pragma unroll
        for (int n = 0; n < 4; ++n) acc[m][n] = (f32x4){0.f, 0.f, 0.f, 0.f};
    for (int kt = 0; kt < K; kt += 32) {
#pragma unroll
        for (int i = 0; i < 2; ++i) {
            int b = tid * 16 + i * 4096;
            __builtin_amdgcn_global_load_lds((const unsigned*)(ap[i] + kt), (__attribute__((address_space(3))) unsigned*)((char*)SA + b), 16, 0, 0);
            __builtin_amdgcn_global_load_lds((const unsigned*)(bp[i] + kt), (__attribute__((address_space(3))) unsigned*)((char*)SB + b), 16, 0, 0);
        }
        asm volatile("s_waitcnt vmcnt(0)" ::: "memory");
        __syncthreads();
        bf16x8 af[4], bfr[4];
#pragma unroll
        for (int m = 0; m < 4; ++m) af[m] = *reinterpret_cast<const bf16x8*>((const char*)SA + (wr * 64 + m * 16 + fr) * 64 + fq * 16);
#pragma unroll
        for (int n = 0; n < 4; ++n) bfr[n] = *reinterpret_cast<const bf16x8*>((const char*)SB + (wc * 64 + n * 16 + fr) * 64 + fq * 16);
#pragma unroll
        for (int m = 0; m < 4; ++m)
#pragma unroll
            for (int n = 0; n < 4; ++n) acc[m][n] = __builtin_amdgcn_mfma_f32_16x16x32_bf16(bfr[n], af[m], acc[m][n], 0, 0, 0);
        __syncthreads();
    }
    epi(acc, row0 + wr * 64, col0 + wc * 64, fr, fq);
}

template <class Epi>
__device__ __forceinline__ void gemm_phase(const bf16_t* A, int lda, const bf16_t* Bt, int ldb, int K, int mt, int nt, const Epi& epi,
                                           bf16_t* smem) {
    const int ntiles = mt * nt;
    for (int t = blockIdx.x; t < ntiles; t += gridDim.x) {
        int tm = t / nt, tn = t % nt;
        gemm_tile<false>(A, lda, nullptr, 0, Bt, ldb, K, tm * 128, tn * 128, epi, smem);
    }
}

struct EpiStoreBf16 {
    bf16_t* O; int ldo;
    __device__ __forceinline__ void operator()(f32x4 (&acc)[4][4], int rb, int cb, int fr, int fq) const {
#pragma unroll
        for (int m = 0; m < 4; ++m)
#pragma unroll
            for (int n = 0; n < 4; ++n) {
                int row = rb + m * 16 + fr, col = cb + n * 16 + fq * 4;
                uint2 w; w.x = pack2(acc[m][n][0], acc[m][n][1]); w.y = pack2(acc[m][n][2], acc[m][n][3]);
                *reinterpret_cast<uint2*>(O + (size_t)row * ldo + col) = w;
            }
    }
};
template <int MODE>
struct EpiLora {
    float* Of; bf16_t* Ob; const float* vec; int ldo; int coff;
    __device__ __forceinline__ void operator()(f32x4 (&acc)[4][4], int rb, int cb, int fr, int fq) const {
#pragma unroll
        for (int m = 0; m < 4; ++m)
#pragma unroll
            for (int n = 0; n < 4; ++n) {
                int row = rb + m * 16 + fr, col = cb + n * 16 + fq * 4;
                float v[4];
#pragma unroll
                for (int j = 0; j < 4; ++j) {
                    float a = acc[m][n][j];
                    if (MODE == 0) {
                        float t = -(vec[col + j] + a);
                        float sp = (t > 20.f) ? t : log1pf(__expf(t));
                        float wl = -sp - 0.5f;
                        v[j] = -__expf(wl);
                    } else if (MODE == 1) {
                        v[j] = sigmoidf_(vec[col + j] + a);
                    } else if (MODE == 2) {
                        v[j] = a;
                    } else {
                        v[j] = a * vec[coff + col + j];
                    }
                }
                if (MODE == 0) {
                    *reinterpret_cast<float4*>(Of + (size_t)row * ldo + col) = make_float4(v[0], v[1], v[2], v[3]);
                } else {
                    uint2 w; w.x = pack2(v[0], v[1]); w.y = pack2(v[2], v[3]);
                    *reinterpret_cast<uint2*>(Ob + (size_t)row * ldo + coff + col) = w;
                }
            }
    }
};
struct EpiOut {
    const float* Xprev; float* X;
    __device__ __forceinline__ void operator()(f32x4 (&acc)[4][4], int rb, int cb, int fr, int fq) const {
#pragma unroll
        for (int m = 0; m < 4; ++m)
#pragma unroll
            for (int n = 0; n < 4; ++n) {
                int row = rb + m * 16 + fr, col = cb + n * 16 + fq * 4;
                float4 xp = *reinterpret_cast<const float4*>(Xprev + (size_t)row * DM + col);
                float4 o;
                o.x = ALPHA_F * xp.x + acc[m][n][0]; o.y = ALPHA_F * xp.y + acc[m][n][1];
                o.z = ALPHA_F * xp.z + acc[m][n][2]; o.w = ALPHA_F * xp.w + acc[m][n][3];
                *reinterpret_cast<float4*>(X + (size_t)row * DM + col) = o;
            }
    }
};
struct EpiExp1 {
    bf16_t* H; int base; int cnt;
    __device__ __forceinline__ void operator()(f32x4 (&acc)[4][4], int rb, int cb, int fr, int fq) const {
#pragma unroll
        for (int m = 0; m < 4; ++m) {
            int li = rb + m * 16 + fr;
            if (li < cnt) {
#pragma unroll
                for (int i = 0; i < 2; ++i) {
                    int hcol = (cb >> 1) + i * 16 + fq * 4;
                    float v[4];
#pragma unroll
                    for (int j = 0; j < 4; ++j) v[j] = siluf_(acc[m][2 * i][j]) * acc[m][2 * i + 1][j];
                    uint2 w; w.x = pack2(v[0], v[1]); w.y = pack2(v[2], v[3]);
                    *reinterpret_cast<uint2*>(H + (size_t)(base + li) * 128 + hcol) = w;
                }
            }
        }
    }
};
struct EpiExp2 {
    bf16_t* FS; const int* ltok; const float* lgate; int cnt;
    __device__ __forceinline__ void operator()(f32x4 (&acc)[4][4], int rb, int cb, int fr, int fq) const {
#pragma unroll
        for (int m = 0; m < 4; ++m) {
            int li = rb + m * 16 + fr;
            if (li < cnt) {
                int pk = ltok[li]; float g = lgate[li];
                int tok = pk >> 1, j = pk & 1;
                bf16_t* o = FS + ((size_t)j * NT + tok) * DM;
#pragma unroll
                for (int n = 0; n < 4; ++n) {
                    int col = cb + n * 16 + fq * 4;
                    uint2 w; w.x = pack2(acc[m][n][0] * g, acc[m][n][1] * g); w.y = pack2(acc[m][n][2] * g, acc[m][n][3] * g);
                    *reinterpret_cast<uint2*>(o + col) = w;
                }
            }
        }
    }
};

__device__ __forceinline__ void tconv_tile(const float* __restrict__ src, int N, bf16_t* __restrict__ dst, int ldd, int k0, int n0,
                                           int mode, float* tile  ) {
    const int tidx = otid();
    const int tid = tidx;
#pragma unroll
    for (int i = 0; i < 16; ++i) {
        int r = i * 4 + (tid >> 6), c = tid & 63;
        tile[r * 65 + c] = src[(size_t)(k0 + r) * N + n0 + c];
    }
    __syncthreads();
#pragma unroll
    for (int i = 0; i < 16; ++i) {
        int nn = i * 4 + (tid >> 6), kk = tid & 63;
        int n = n0 + nn;
        int drow = n;
        if (mode == 1) drow = (n >> 4) * 32 + (n & 15);
        else if (mode == 2) drow = (n >> 4) * 32 + 16 + (n & 15);
        dst[(size_t)drow * ldd + k0 + kk] = f2bf(tile[kk * 65 + nn]);
    }
    __syncthreads();
}

__device__ void phase_pre(const Params& p, unsigned char* smem) {
    const int tidx = otid();
    float* tile = reinterpret_cast<float*>(smem);
    bf16_t* W = reinterpret_cast<bf16_t*>(p.ws + OFF_W);
    if (blockIdx.x == 0 && tidx < 64) reinterpret_cast<int*>(p.ws + OFF_CTRL)[tidx] = 0;
    constexpr int T0 = 576, T1 = 256, T2 = 768, T3 = 256, T4 = 2048, T5 = 2048, T6 = 2048, T7 = 8, T8 = 8, T9 = 16, T10 = 16;
    constexpr int TOT = T0 + T1 + T2 + T3 + T4 + T5 + T6 + T7 + T8 + T9 + T10;
    for (int u = blockIdx.x; u < TOT; u += gridDim.x) {
        int v = u;
        const float* src; bf16_t* dst; int K, N, mode = 0, tk, tn;
        if (v < T0) { src = p.in[1]; K = 1024; N = 2304; dst = W + WE_IN0; tk = v / 36; tn = v % 36; }
        else if ((v -= T0) < T1) { src = p.in[15]; K = 1024; N = 1024; dst = W + WE_OUT0; tk = v / 16; tn = v % 16; }
        else if ((v -= T1) < T2) { src = p.in[16]; K = 1024; N = 3072; dst = W + WE_IN1; tk = v / 48; tn = v % 48; }
        else if ((v -= T2) < T3) { src = p.in[23]; K = 1024; N = 1024; dst = W + WE_OUT1; tk = v / 16; tn = v % 16; }
        else if ((v -= T3) < T4) { int mat = v >> 5, w = v & 31; src = p.in[30] + (size_t)mat * 131072; K = 1024; N = 128; dst = W + WE_W13 + (size_t)mat * 262144; mode = 1; tk = w >> 1; tn = w & 1; }
        else if ((v -= T4) < T5) { int mat = v >> 5, w = v & 31; src = p.in[31] + (size_t)mat * 131072; K = 1024; N = 128; dst = W + WE_W13 + (size_t)mat * 262144; mode = 2; tk = w >> 1; tn = w & 1; }
        else if ((v -= T5) < T6) { int mat = v >> 5, w = v & 31; src = p.in[32] + (size_t)mat * 131072; K = 128; N = 1024; dst = W + WE_W2 + (size_t)mat * 131072; tk = w >> 4; tn = w & 15; }
        else if ((v -= T6) < T7) { src = p.in[4]; K = 64; N = 512; dst = W + WE_LW2; tk = 0; tn = v; }
        else if ((v -= T7) < T8) { src = p.in[6]; K = 64; N = 512; dst = W + WE_LA2; tk = 0; tn = v; }
        else if ((v -= T8) < T9) { src = p.in[7]; K = 128; N = 512; dst = W + WE_LG2; tk = v >> 3; tn = v & 7; }
        else { v -= T9; int mat = v >> 2, w = v & 3; src = p.in[13] + (size_t)mat * 16384; K = 128; N = 128; dst = W + WE_POOL + (size_t)mat * 16384; tk = w >> 1; tn = w & 1; }
        tconv_tile(src, N, dst, K, tk * 64, tn * 64, mode, tile);
    }
    {
        const float4* x4 = reinterpret_cast<const float4*>(p.in[0]);
        uint2* xb = reinterpret_cast<uint2*>(p.ws + OFF_ACTB);
        const size_t n4 = (size_t)NT * DM / 4;
        for (size_t i = (size_t)blockIdx.x * NTHREADS + tidx; i < n4; i += (size_t)gridDim.x * NTHREADS) {
            float4 v = x4[i];
            uint2 w; w.x = pack2(v.x, v.y); w.y = pack2(v.z, v.w);
            xb[i] = w;
        }
    }
    {
        float2* rope = reinterpret_cast<float2*>(p.ws + OFF_ROPE);
        for (int i = blockIdx.x * NTHREADS + tidx; i < SEQ * 32; i += gridDim.x * NTHREADS) {
            int pos = i >> 5, k = i & 31;
            float inv = powf(10000.0f, -(float)k / 32.0f);
            float ang = (float)pos * inv;
            float s, c;
            sincosf(ang, &s, &c);
            rope[i] = make_float2(c, s);
        }
    }
}

__device__ void phase_l0_prep(const Params& p) {
    const int tidx = otid();
    const bf16_t* P = reinterpret_cast<const bf16_t*>(p.ws + OFF_P);
    bf16_t* LA = reinterpret_cast<bf16_t*>(p.ws + OFF_LORA);
    bf16_t* PO = reinterpret_cast<bf16_t*>(p.ws + OFF_POOLED);
    const float* mu = p.in[2];
    const int total = NT * 768;
    for (int i = blockIdx.x * NTHREADS + tidx; i < total; i += gridDim.x * NTHREADS) {
        int tok = i / 768, c = i % 768;
        int s = tok & (SEQ - 1);
        if (c < 256) {
            int col = 1536 + c;
            float pr = bf2f(P[(size_t)tok * 2304 + col]);
            float pv = (s > 0) ? bf2f(P[(size_t)(tok - 1) * 2304 + col]) : 0.f;
            float z = pr + mu[col] * (pv - pr);
            float o;
            if (c < 64) o = tanhf(z);
            else if (c < 128) o = z;
            else o = sigmoidf_(z);
            LA[(size_t)tok * 256 + c] = f2bf(o);
        } else {
            int cc = c - 256;
            int gi = cc >> 7;
            int win = 2 << gi;
            int cnt = (s + 1 < win) ? (s + 1) : win;
            float sum = 0.f;
            for (int j = 0; j < cnt; ++j) sum += bf2f(P[(size_t)(tok - j) * 2304 + 1792 + cc]);
            float u = bf2f(P[(size_t)tok * 2304 + 1792 + cc]);
            PO[(size_t)tok * 512 + cc] = f2bf(sum / (float)cnt - u);
        }
    }
}

__device__ void phase_l0_lora(const Params& p, bf16_t* smem) {
    const bf16_t* W = reinterpret_cast<const bf16_t*>(p.ws + OFF_W);
    const bf16_t* LA = reinterpret_cast<const bf16_t*>(p.ws + OFF_LORA);
    const bf16_t* PO = reinterpret_cast<const bf16_t*>(p.ws + OFF_POOLED);
    for (int t = blockIdx.x; t < 4096; t += gridDim.x) {
        int job = t >> 10, w = t & 1023;
        if (job == 0) {
            EpiLora<0> e{reinterpret_cast<float*>(p.ws + OFF_LOGW), nullptr, p.in[3], 512, 0};
            gemm_tile<false>(LA, 256, nullptr, 0, W + WE_LW2, 64, 64, (w >> 2) * 128, (w & 3) * 128, e, smem);
        } else if (job == 1) {
            EpiLora<1> e{nullptr, reinterpret_cast<bf16_t*>(p.ws + OFF_AA), p.in[5], 512, 0};
            gemm_tile<false>(LA + 64, 256, nullptr, 0, W + WE_LA2, 64, 64, (w >> 2) * 128, (w & 3) * 128, e, smem);
        } else if (job == 2) {
            EpiLora<2> e{nullptr, reinterpret_cast<bf16_t*>(p.ws + OFF_GG), nullptr, 512, 0};
            gemm_tile<false>(LA + 128, 256, nullptr, 0, W + WE_LG2, 128, 128, (w >> 2) * 128, (w & 3) * 128, e, smem);
        } else {
            int g = w & 3, tm = w >> 2;
            EpiLora<3> e{nullptr, reinterpret_cast<bf16_t*>(p.ws + OFF_YCAT), p.in[14], 1024, 512 + g * 128};
            e.vec = p.in[14] - 512;
            gemm_tile<false>(PO + g * 128, 512, nullptr, 0, W + WE_POOL + g * 16384, 128, 128, tm * 128, 0, e, smem);
        }
    }
}

#define RW_T 32
__device__ void phase_l0_scan(const Params& p, unsigned char* smem) {
    const int tidx = otid();
    if (blockIdx.x >= 32) return;
    const int b = blockIdx.x >> 3, h = blockIdx.x & 7;
    const int tid = tidx, wv = tid >> 6, lane = tid & 63;
    float* sW = reinterpret_cast<float*>(smem);
    float* sKK = sW + RW_T * 64;
    float* sB = sKK + RW_T * 64;
    float* sKP = sB + RW_T * 64;
    float* sR = sKP + RW_T * 64;
    float* sV = sR + RW_T * 64;
    float* sY = sV + RW_T * 64;
    float* sBC = sY + RW_T * 64;
    const bf16_t* P = reinterpret_cast<const bf16_t*>(p.ws + OFF_P);
    const float* LOGW = reinterpret_cast<const float*>(p.ws + OFF_LOGW);
    const bf16_t* AA = reinterpret_cast<const bf16_t*>(p.ws + OFF_AA);
    const bf16_t* GG = reinterpret_cast<const bf16_t*>(p.ws + OFF_GG);
    bf16_t* YC = reinterpret_cast<bf16_t*>(p.ws + OFF_YCAT);
    const int c = h * 64 + lane;
    const float mu_r = p.in[2][c], mu_k = p.in[2][512 + c], mu_v = p.in[2][1024 + c];
    const float kkc = p.in[8][c], kac = p.in[9][c], rkc = p.in[10][c], lng = p.in[11][c], lnb = p.in[12][c];
    const int row = wv * 16 + (lane >> 2), kq = lane & 3;
    float s[16];
#pragma unroll
    for (int i = 0; i < 16; ++i) s[i] = 0.f;
    for (int t0 = 0; t0 < SEQ; t0 += RW_T) {
        for (int tl = wv; tl < RW_T; tl += 4) {
            int sidx = t0 + tl;
            size_t tok = (size_t)b * SEQ + sidx;
            const bf16_t* pr = P + tok * 2304;
            float r0 = bf2f(pr[c]), k0 = bf2f(pr[512 + c]), v0 = bf2f(pr[1024 + c]);
            float r1 = 0.f, k1 = 0.f, v1 = 0.f;
            if (sidx > 0) { const bf16_t* pp = pr - 2304; r1 = bf2f(pp[c]); k1 = bf2f(pp[512 + c]); v1 = bf2f(pp[1024 + c]); }
            float zr = r0 + mu_r * (r1 - r0), zk = k0 + mu_k * (k1 - k0), zv = v0 + mu_v * (v1 - v0);
            float w = __expf(LOGW[tok * 512 + c]);
            float a = bf2f(AA[tok * 512 + c]);
            float kk = zk * kkc;
            float ss = wave_sum(kk * kk);
            kk *= rsqrtf(fmaxf(ss, 1e-24f));
            float kp = zk * (1.0f + (a - 1.0f) * kac);
            float bc = wave_sum(zr * kp * rkc);
            sW[tl * 64 + lane] = w; sKK[tl * 64 + lane] = kk; sB[tl * 64 + lane] = kk * a; sKP[tl * 64 + lane] = kp;
            sR[tl * 64 + lane] = zr; sV[tl * 64 + lane] = zv;
            if (lane == 0) sBC[tl] = bc;
        }
        __syncthreads();
#pragma unroll 2
        for (int tl = 0; tl < RW_T; ++tl) {
            const float4* pk = reinterpret_cast<const float4*>(sKK + tl * 64 + kq * 16);
            const float4* pw = reinterpret_cast<const float4*>(sW + tl * 64 + kq * 16);
            const float4* pb = reinterpret_cast<const float4*>(sB + tl * 64 + kq * 16);
            const float4* pp = reinterpret_cast<const float4*>(sKP + tl * 64 + kq * 16);
            const float4* pr = reinterpret_cast<const float4*>(sR + tl * 64 + kq * 16);
            float kkv[16], wvv[16], bvv[16], kpv[16], rvv[16];
#pragma unroll
            for (int q = 0; q < 4; ++q) {
                float4 t;
                t = pk[q]; kkv[4 * q] = t.x; kkv[4 * q + 1] = t.y; kkv[4 * q + 2] = t.z; kkv[4 * q + 3] = t.w;
                t = pw[q]; wvv[4 * q] = t.x; wvv[4 * q + 1] = t.y; wvv[4 * q + 2] = t.z; wvv[4 * q + 3] = t.w;
                t = pb[q]; bvv[4 * q] = t.x; bvv[4 * q + 1] = t.y; bvv[4 * q + 2] = t.z; bvv[4 * q + 3] = t.w;
                t = pp[q]; kpv[4 * q] = t.x; kpv[4 * q + 1] = t.y; kpv[4 * q + 2] = t.z; kpv[4 * q + 3] = t.w;
                t = pr[q]; rvv[4 * q] = t.x; rvv[4 * q + 1] = t.y; rvv[4 * q + 2] = t.z; rvv[4 * q + 3] = t.w;
            }
            float vv = sV[tl * 64 + row];
            float d0 = 0.f, d1 = 0.f, d2 = 0.f, d3 = 0.f;
#pragma unroll
            for (int i = 0; i < 16; i += 4) { d0 += s[i] * kkv[i]; d1 += s[i + 1] * kkv[i + 1]; d2 += s[i + 2] * kkv[i + 2]; d3 += s[i + 3] * kkv[i + 3]; }
            float sa = -quad_sum((d0 + d1) + (d2 + d3));
            float y0 = 0.f, y1 = 0.f, y2 = 0.f, y3 = 0.f;
#pragma unroll
            for (int i = 0; i < 16; i += 4) {
                s[i] = s[i] * wvv[i] + (sa * bvv[i] + vv * kpv[i]);
                s[i + 1] = s[i + 1] * wvv[i + 1] + (sa * bvv[i + 1] + vv * kpv[i + 1]);
                s[i + 2] = s[i + 2] * wvv[i + 2] + (sa * bvv[i + 2] + vv * kpv[i + 2]);
                s[i + 3] = s[i + 3] * wvv[i + 3] + (sa * bvv[i + 3] + vv * kpv[i + 3]);
                y0 += s[i] * rvv[i]; y1 += s[i + 1] * rvv[i + 1]; y2 += s[i + 2] * rvv[i + 2]; y3 += s[i + 3] * rvv[i + 3];
            }
            float y = quad_sum((y0 + y1) + (y2 + y3));
            if (kq == 0) sY[tl * 64 + row] = y;
        }
        __syncthreads();
        for (int tl = wv; tl < RW_T; tl += 4) {
            size_t tok = (size_t)b * SEQ + t0 + tl;
            float y = sY[tl * 64 + lane];
            float mean = wave_sum(y) * (1.0f / 64.0f);
            float d = y - mean;
            float var = wave_sum(d * d) * (1.0f / 64.0f);
            float yn = d * rsqrtf(var + 64e-5f) * lng + lnb;
            float g = bf2f(GG[tok * 512 + c]);
            float o = (yn + sBC[tl] * sV[tl * 64 + lane]) * g;
            YC[tok * 1024 + c] = f2bf(o);
        }
        __syncthreads();
    }
}

__device__ void phase_ln_route(const Params& p, int layer, float* X) {
    const int tidx = otid();
    const int tid = tidx, wv = tid >> 6, lane = tid & 63;
    const float* g = p.in[24] + layer * DM;
    const float* bb = p.in[25] + layer * DM;
    const float* rgw = p.in[26] + (size_t)layer * DM * 4;
    const float* rgb = p.in[27] + layer * 4;
    const float* rew = p.in[28] + (size_t)layer * DM * 32;
    const float* reb = p.in[29] + layer * 32;
    bf16_t* XB = reinterpret_cast<bf16_t*>(p.ws + OFF_ACTB);
    int* cnt = reinterpret_cast<int*>(p.ws + OFF_CTRL) + layer * 32;
    int* ltok = reinterpret_cast<int*>(p.ws + OFF_LTOK);
    float* lgate = reinterpret_cast<float*>(p.ws + OFF_LGATE);
    for (int row = blockIdx.x * 4 + wv; row < NT; row += gridDim.x * 4) {
        float* xr = X + (size_t)row * DM;
        float v[16];
#pragma unroll
        for (int i = 0; i < 4; ++i) {
            float4 t = *reinterpret_cast<const float4*>(xr + i * 256 + lane * 4);
            v[4 * i] = t.x; v[4 * i + 1] = t.y; v[4 * i + 2] = t.z; v[4 * i + 3] = t.w;
        }
        float sum = 0.f;
#pragma unroll
        for (int i = 0; i < 16; ++i) sum += v[i];
        float mean = wave_sum(sum) * (1.0f / DM);
        float sq = 0.f;
#pragma unroll
        for (int i = 0; i < 16; ++i) { float d = v[i] - mean; sq += d * d; }
        float rstd = rsqrtf(wave_sum(sq) * (1.0f / DM) + 1e-5f);
#pragma unroll
        for (int i = 0; i < 4; ++i) {
            int col = i * 256 + lane * 4;
            float4 gg = *reinterpret_cast<const float4*>(g + col);
            float4 bv = *reinterpret_cast<const float4*>(bb + col);
            v[4 * i] = (v[4 * i] - mean) * rstd * gg.x + bv.x;
            v[4 * i + 1] = (v[4 * i + 1] - mean) * rstd * gg.y + bv.y;
            v[4 * i + 2] = (v[4 * i + 2] - mean) * rstd * gg.z + bv.z;
            v[4 * i + 3] = (v[4 * i + 3] - mean) * rstd * gg.w + bv.w;
            *reinterpret_cast<float4*>(xr + col) = make_float4(v[4 * i], v[4 * i + 1], v[4 * i + 2], v[4 * i + 3]);
            uint2 w; w.x = pack2(v[4 * i], v[4 * i + 1]); w.y = pack2(v[4 * i + 2], v[4 * i + 3]);
            *reinterpret_cast<uint2*>(XB + (size_t)row * DM + col) = w;
        }
        float gl[4] = {0.f, 0.f, 0.f, 0.f};
#pragma unroll
        for (int i = 0; i < 4; ++i)
#pragma unroll
            for (int e = 0; e < 4; ++e) {
                int k = i * 256 + lane * 4 + e;
                float4 w = *reinterpret_cast<const float4*>(rgw + (size_t)k * 4);
                float xv = v[4 * i + e];
                gl[0] += xv * w.x; gl[1] += xv * w.y; gl[2] += xv * w.z; gl[3] += xv * w.w;
            }
#pragma unroll
        for (int j = 0; j < 4; ++j) gl[j] = wave_sum(gl[j]) + rgb[j];
        int gi = 0; float gm = gl[0];
#pragma unroll
        for (int j = 1; j < 4; ++j) if (gl[j] > gm) { gm = gl[j]; gi = j; }
        float gs = 0.f;
#pragma unroll
        for (int j = 0; j < 4; ++j) gs += __expf(gl[j] - gm);
        float gw = 1.0f / gs;
        float el[8];
#pragma unroll
        for (int j = 0; j < 8; ++j) el[j] = 0.f;
#pragma unroll
        for (int i = 0; i < 4; ++i)
#pragma unroll
            for (int e = 0; e < 4; ++e) {
                int k = i * 256 + lane * 4 + e;
                const float4* wp = reinterpret_cast<const float4*>(rew + (size_t)k * 32 + gi * 8);
                float4 w0 = wp[0], w1 = wp[1];
                float xv = v[4 * i + e];
                el[0] += xv * w0.x; el[1] += xv * w0.y; el[2] += xv * w0.z; el[3] += xv * w0.w;
                el[4] += xv * w1.x; el[5] += xv * w1.y; el[6] += xv * w1.z; el[7] += xv * w1.w;
            }
#pragma unroll
        for (int j = 0; j < 8; ++j) el[j] = wave_sum(el[j]) + reb[gi * 8 + j];
        int i1 = 0; float m1 = el[0];
#pragma unroll
        for (int j = 1; j < 8; ++j) if (el[j] > m1) { m1 = el[j]; i1 = j; }
        int i2 = -1; float m2 = -3.0e38f;
#pragma unroll
        for (int j = 0; j < 8; ++j) if (j != i1 && el[j] > m2) { m2 = el[j]; i2 = j; }
        float e2 = __expf(m2 - m1);
        float p1 = 1.0f / (1.0f + e2), p2 = e2 / (1.0f + e2);
        if (lane < 2) {
            int ex = gi * 8 + (lane == 0 ? i1 : i2);
            float gate = gw * (lane == 0 ? p1 : p2);
            int slot = atomicAdd(&cnt[ex], 1);
            ltok[(size_t)ex * NT + slot] = row * 2 + lane;
            lgate[(size_t)ex * NT + slot] = gate;
        }
    }
}

__device__ void phase_exp1(const Params& p, int layer, bf16_t* smem) {
    const int* cnt = reinterpret_cast<const int*>(p.ws + OFF_CTRL) + layer * 32;
    const int* ltok = reinterpret_cast<const int*>(p.ws + OFF_LTOK);
    const bf16_t* XB = reinterpret_cast<const bf16_t*>(p.ws + OFF_ACTB);
    const bf16_t* W13 = reinterpret_cast<const bf16_t*>(p.ws + OFF_W) + WE_W13 + (size_t)layer * 32 * 262144;
    bf16_t* H = reinterpret_cast<bf16_t*>(p.ws + OFF_HBUF);
    int t = blockIdx.x;
    int base = 0, tbase = 0;
    for (int e = 0; e < 32; ++e) {
        int c = cnt[e];
        int nt = ((c + 127) >> 7) * 2;
        while (t < tbase + nt) {
            int w = t - tbase;
            EpiExp1 epi{H, base, c};
            gemm_tile<true>(XB, DM, ltok + (size_t)e * NT, c, W13 + (size_t)e * 262144, DM, DM, (w >> 1) * 128, (w & 1) * 128, epi, smem);
            t += gridDim.x;
        }
        tbase += nt; base += c;
    }
}
__device__ void phase_exp2(const Params& p, int layer, bf16_t* smem) {
    const int* cnt = reinterpret_cast<const int*>(p.ws + OFF_CTRL) + layer * 32;
    const int* ltok = reinterpret_cast<const int*>(p.ws + OFF_LTOK);
    const float* lgate = reinterpret_cast<const float*>(p.ws + OFF_LGATE);
    const bf16_t* W2 = reinterpret_cast<const bf16_t*>(p.ws + OFF_W) + WE_W2 + (size_t)layer * 32 * 131072;
    const bf16_t* H = reinterpret_cast<const bf16_t*>(p.ws + OFF_HBUF);
    bf16_t* FS = reinterpret_cast<bf16_t*>(p.ws + OFF_FS);
    int t = blockIdx.x;
    int base = 0, tbase = 0;
    for (int e = 0; e < 32; ++e) {
        int c = cnt[e];
        int nt = ((c + 127) >> 7) * 8;
        while (t < tbase + nt) {
            int w = t - tbase;
            EpiExp2 epi{FS, ltok + (size_t)e * NT, lgate + (size_t)e * NT, c};
            gemm_tile<false>(H + (size_t)base * 128, 128, nullptr, 0, W2 + (size_t)e * 131072, 128, 128, (w >> 3) * 128, (w & 7) * 128, epi, smem);
            t += gridDim.x;
        }
        tbase += nt; base += c;
    }
}

__device__ void phase_ln_ffn(const Params& p, int layer, float* X, bool write_b) {
    const int tidx = otid();
    const int tid = tidx, wv = tid >> 6, lane = tid & 63;
    const float* g = p.in[33] + layer * DM;
    const float* bb = p.in[34] + layer * DM;
    const bf16_t* FS = reinterpret_cast<const bf16_t*>(p.ws + OFF_FS);
    bf16_t* XB = reinterpret_cast<bf16_t*>(p.ws + OFF_ACTB);
    for (int row = blockIdx.x * 4 + wv; row < NT; row += gridDim.x * 4) {
        float* xr = X + (size_t)row * DM;
        float v[16];
#pragma unroll
        for (int i = 0; i < 4; ++i) {
            int col = i * 256 + lane * 4;
            float4 t = *reinterpret_cast<const float4*>(xr + col);
            uint2 f0 = *reinterpret_cast<const uint2*>(FS + (size_t)row * DM + col);
            uint2 f1 = *reinterpret_cast<const uint2*>(FS + ((size_t)NT + row) * DM + col);
            v[4 * i] = ALPHA_F * t.x + __uint_as_float(f0.x << 16) + __uint_as_float(f1.x << 16);
            v[4 * i + 1] = ALPHA_F * t.y + __uint_as_float(f0.x & 0xffff0000u) + __uint_as_float(f1.x & 0xffff0000u);
            v[4 * i + 2] = ALPHA_F * t.z + __uint_as_float(f0.y << 16) + __uint_as_float(f1.y << 16);
            v[4 * i + 3] = ALPHA_F * t.w + __uint_as_float(f0.y & 0xffff0000u) + __uint_as_float(f1.y & 0xffff0000u);
        }
        float sum = 0.f;
#pragma unroll
        for (int i = 0; i < 16; ++i) sum += v[i];
        float mean = wave_sum(sum) * (1.0f / DM);
        float sq = 0.f;
#pragma unroll
        for (int i = 0; i < 16; ++i) { float d = v[i] - mean; sq += d * d; }
        float rstd = rsqrtf(wave_sum(sq) * (1.0f / DM) + 1e-5f);
#pragma unroll
        for (int i = 0; i < 4; ++i) {
            int col = i * 256 + lane * 4;
            float4 gg = *reinterpret_cast<const float4*>(g + col);
            float4 bv = *reinterpret_cast<const float4*>(bb + col);
            float o0 = (v[4 * i] - mean) * rstd * gg.x + bv.x;
            float o1 = (v[4 * i + 1] - mean) * rstd * gg.y + bv.y;
            float o2 = (v[4 * i + 2] - mean) * rstd * gg.z + bv.z;
            float o3 = (v[4 * i + 3] - mean) * rstd * gg.w + bv.w;
            *reinterpret_cast<float4*>(xr + col) = make_float4(o0, o1, o2, o3);
            if (write_b) {
                uint2 w; w.x = pack2(o0, o1); w.y = pack2(o2, o3);
                *reinterpret_cast<uint2*>(XB + (size_t)row * DM + col) = w;
            }
        }
    }
}

__device__ void phase_l1_conv(const Params& p, unsigned char* smem) {
    const int tidx = otid();
    const bf16_t* P = reinterpret_cast<const bf16_t*>(p.ws + OFF_P);
    bf16_t* YC = reinterpret_cast<bf16_t*>(p.ws + OFF_YCAT);
    float* red = reinterpret_cast<float*>(smem);
    const int tid = tidx, wv = tid >> 6, lane = tid & 63;
    const float* cw = p.in[17];
    float w0[31], w1[31];
#pragma unroll
    for (int j = 0; j < 31; ++j) { w0[j] = cw[j * 512 + tid]; w1[j] = cw[j * 512 + 256 + tid]; }
    const float cb0 = p.in[18][tid], cb1 = p.in[18][256 + tid];
    const float g0 = p.in[19][tid], g1 = p.in[19][256 + tid];
    const float b0 = p.in[20][tid], b1 = p.in[20][256 + tid];
    for (int u = blockIdx.x; u < NT / 8; u += gridDim.x) {
        const int t0 = u * 8;
        const int s0 = t0 & (SEQ - 1);
        float a0[8], a1[8];
#pragma unroll
        for (int o = 0; o < 8; ++o) { a0[o] = cb0; a1[o] = cb1; }
#pragma unroll
        for (int rr = 0; rr < 38; ++rr) {
            int srow = s0 - 30 + rr;
            float u0 = 0.f, u1 = 0.f;
            if (srow >= 0) {
                const bf16_t* pr = P + (size_t)(t0 - 30 + rr) * 3072;
                float ca0 = bf2f(pr[tid]), ca1 = bf2f(pr[256 + tid]);
                float cg0 = bf2f(pr[512 + tid]), cg1 = bf2f(pr[768 + tid]);
                u0 = ca0 * sigmoidf_(cg0); u1 = ca1 * sigmoidf_(cg1);
            }
#pragma unroll
            for (int o = 0; o < 8; ++o) {
                int j = rr - o;
                if (j >= 0 && j <= 30) { a0[o] += u0 * w0[j]; a1[o] += u1 * w1[j]; }
            }
        }
        float mean[8], rstd[8];
#pragma unroll
        for (int o = 0; o < 8; ++o) {
            float sm = wave_sum(a0[o] + a1[o]);
            if (lane == 0) red[wv * 8 + o] = sm;
        }
        __syncthreads();
#pragma unroll
        for (int o = 0; o < 8; ++o) mean[o] = (red[o] + red[8 + o] + red[16 + o] + red[24 + o]) * (1.0f / 512.0f);
        __syncthreads();
#pragma unroll
        for (int o = 0; o < 8; ++o) {
            float d0 = a0[o] - mean[o], d1 = a1[o] - mean[o];
            float sm = wave_sum(d0 * d0 + d1 * d1);
            if (lane == 0) red[wv * 8 + o] = sm;
        }
        __syncthreads();
#pragma unroll
        for (int o = 0; o < 8; ++o) rstd[o] = rsqrtf((red[o] + red[8 + o] + red[16 + o] + red[24 + o]) * (1.0f / 512.0f) + 1e-5f);
        __syncthreads();
#pragma unroll
        for (int o = 0; o < 8; ++o) {
            float y0 = (a0[o] - mean[o]) * rstd[o] * g0 + b0;
            float y1 = (a1[o] - mean[o]) * rstd[o] * g1 + b1;
            YC[(size_t)(t0 + o) * 1024 + tid] = f2bf(siluf_(y0));
            YC[(size_t)(t0 + o) * 1024 + 256 + tid] = f2bf(siluf_(y1));
        }
    }
}

__device__ __forceinline__ float ret_lg(int h) { return log1pf(-exp2f(-5.0f - (float)h)); }

#define KT_LD 136
__device__ void phase_ret_kv(const Params& p, unsigned char* smem) {
    const int tidx = otid();
    const bf16_t* P = reinterpret_cast<const bf16_t*>(p.ws + OFF_P);
    const float2* rope = reinterpret_cast<const float2*>(p.ws + OFF_ROPE);
    float* KVT = reinterpret_cast<float*>(p.ws + OFF_KVT);
    bf16_t* sKT = reinterpret_cast<bf16_t*>(smem);
    bf16_t* sVT = sKT + 64 * KT_LD;
    const int tid = tidx, wv = tid >> 6, lane = tid & 63, fr = lane & 15, fq = lane >> 4;
    for (int u = blockIdx.x; u < 2048; u += gridDim.x) {
        const int n = u & 63, h = (u >> 6) & 7, b = u >> 9;
        const float lg = ret_lg(h);
        {
            const int c = tid >> 1, i0 = (tid & 1) * 16;
            const int sidx = n * 128 + c;
            const size_t tok = (size_t)b * SEQ + sidx;
            const bf16_t* kr = P + tok * 3072 + 1536 + h * 64;
            const bf16_t* vr = P + tok * 3072 + 2048 + h * 64;
            const float zeta = __expf((float)(127 - c) * lg) * 0.125f;
#pragma unroll
            for (int i = 0; i < 16; ++i) {
                float t1 = bf2f(kr[i0 + i]), t2 = bf2f(kr[32 + i0 + i]);
                float2 cs = rope[sidx * 32 + i0 + i];
                float o1 = (t1 * cs.x - t2 * cs.y) * zeta, o2 = (t1 * cs.y + t2 * cs.x) * zeta;
                sKT[(i0 + i) * KT_LD + c] = f2bf(o1);
                sKT[(32 + i0 + i) * KT_LD + c] = f2bf(o2);
                sVT[(i0 + i) * KT_LD + c] = vr[i0 + i];
                sVT[(32 + i0 + i) * KT_LD + c] = vr[32 + i0 + i];
            }
        }
        __syncthreads();
        f32x4 acc[4];
#pragma unroll
        for (int nn = 0; nn < 4; ++nn) acc[nn] = (f32x4){0.f, 0.f, 0.f, 0.f};
#pragma unroll
        for (int ks = 0; ks < 4; ++ks) {
            bf16x8 af = *reinterpret_cast<const bf16x8*>(sVT + (wv * 16 + fr) * KT_LD + ks * 32 + fq * 8);
#pragma unroll
            for (int nn = 0; nn < 4; ++nn) {
                bf16x8 bfr = *reinterpret_cast<const bf16x8*>(sKT + (nn * 16 + fr) * KT_LD + ks * 32 + fq * 8);
                acc[nn] = __builtin_amdgcn_mfma_f32_16x16x32_bf16(af, bfr, acc[nn], 0, 0, 0);
            }
        }
        float* o = KVT + (size_t)u * 4096;
#pragma unroll
        for (int nn = 0; nn < 4; ++nn)
#pragma unroll
            for (int j = 0; j < 4; ++j) o[(wv * 16 + fq * 4 + j) * 64 + nn * 16 + fr] = acc[nn][j];
        __syncthreads();
    }
}
__device__ void phase_ret_scan(const Params& p) {
    const int tidx = otid();
    float* KVT = reinterpret_cast<float*>(p.ws + OFF_KVT);
    for (int i = blockIdx.x * NTHREADS + tidx; i < 32 * 4096; i += gridDim.x * NTHREADS) {
        int bh = i >> 12, ed = i & 4095, h = bh & 7;
        float gc = __expf(128.0f * ret_lg(h));
        float R = 0.f;
        float* q = KVT + (size_t)bh * 64 * 4096 + ed;
        for (int n = 0; n < 64; ++n) {
            float kv = q[(size_t)n * 4096];
            q[(size_t)n * 4096] = R;
            R = gc * R + kv;
        }
    }
}
#define Q_LD 72
__device__ void phase_ret_out(const Params& p, unsigned char* smem) {
    const int tidx = otid();
    const bf16_t* P = reinterpret_cast<const bf16_t*>(p.ws + OFF_P);
    const float2* rope = reinterpret_cast<const float2*>(p.ws + OFF_ROPE);
    const float* KVT = reinterpret_cast<const float*>(p.ws + OFF_KVT);
    bf16_t* YC = reinterpret_cast<bf16_t*>(p.ws + OFF_YCAT);
    bf16_t* sQ = reinterpret_cast<bf16_t*>(smem);
    bf16_t* sK = sQ + 128 * Q_LD;
    bf16_t* sVT = sK + 128 * Q_LD;
    bf16_t* sRT = sVT + 64 * KT_LD;
    bf16_t* sS = sQ;
    const int tid = tidx, wv = tid >> 6, lane = tid & 63, fr = lane & 15, fq = lane >> 4;
    const float* gng = p.in[21];
    const float* gnb = p.in[22];
    for (int u = blockIdx.x; u < 2048; u += gridDim.x) {
        const int n = u & 63, h = (u >> 6) & 7, b = u >> 9;
        const float lg = ret_lg(h);
        {
            const int c = tid >> 1, i0 = (tid & 1) * 16;
            const int sidx = n * 128 + c;
            const size_t tok = (size_t)b * SEQ + sidx;
            const bf16_t* qr = P + tok * 3072 + 1024 + h * 64;
            const bf16_t* kr = P + tok * 3072 + 1536 + h * 64;
            const bf16_t* vr = P + tok * 3072 + 2048 + h * 64;
#pragma unroll
            for (int i = 0; i < 16; ++i) {
                float2 cs = rope[sidx * 32 + i0 + i];
                float q1 = bf2f(qr[i0 + i]), q2 = bf2f(qr[32 + i0 + i]);
                sQ[c * Q_LD + i0 + i] = f2bf(q1 * cs.x - q2 * cs.y);
                sQ[c * Q_LD + 32 + i0 + i] = f2bf(q1 * cs.y + q2 * cs.x);
                float k1 = bf2f(kr[i0 + i]), k2 = bf2f(kr[32 + i0 + i]);
                sK[c * Q_LD + i0 + i] = f2bf((k1 * cs.x - k2 * cs.y) * 0.125f);
                sK[c * Q_LD + 32 + i0 + i] = f2bf((k1 * cs.y + k2 * cs.x) * 0.125f);
                sVT[(i0 + i) * KT_LD + c] = vr[i0 + i];
                sVT[(32 + i0 + i) * KT_LD + c] = vr[32 + i0 + i];
            }
            const float* rp = KVT + (size_t)u * 4096;
#pragma unroll
            for (int i = 0; i < 16; ++i) {
                int idx = tid * 16 + i;
                sRT[(idx >> 6) * Q_LD + (idx & 63)] = f2bf(rp[idx]);
            }
        }
        __syncthreads();
        f32x4 accs[2][8], accc[2][4];
#pragma unroll
        for (int m = 0; m < 2; ++m) {
#pragma unroll
            for (int nn = 0; nn < 8; ++nn) accs[m][nn] = (f32x4){0.f, 0.f, 0.f, 0.f};
#pragma unroll
            for (int nn = 0; nn < 4; ++nn) accc[m][nn] = (f32x4){0.f, 0.f, 0.f, 0.f};
        }
#pragma unroll
        for (int ks = 0; ks < 2; ++ks) {
            bf16x8 af[2];
#pragma unroll
            for (int m = 0; m < 2; ++m) af[m] = *reinterpret_cast<const bf16x8*>(sQ + (wv * 32 + m * 16 + fr) * Q_LD + ks * 32 + fq * 8);
#pragma unroll
            for (int nn = 0; nn < 8; ++nn) {
                if (nn <= 2 * wv + 1) {
                    bf16x8 bfr = *reinterpret_cast<const bf16x8*>(sK + (nn * 16 + fr) * Q_LD + ks * 32 + fq * 8);
#pragma unroll
                    for (int m = 0; m < 2; ++m) accs[m][nn] = __builtin_amdgcn_mfma_f32_16x16x32_bf16(af[m], bfr, accs[m][nn], 0, 0, 0);
                }
            }
#pragma unroll
            for (int nn = 0; nn < 4; ++nn) {
                bf16x8 bfr = *reinterpret_cast<const bf16x8*>(sRT + (nn * 16 + fr) * Q_LD + ks * 32 + fq * 8);
#pragma unroll
                for (int m = 0; m < 2; ++m) accc[m][nn] = __builtin_amdgcn_mfma_f32_16x16x32_bf16(af[m], bfr, accc[m][nn], 0, 0, 0);
            }
        }
        __syncthreads();
        bf16_t* mS = sS + wv * 32 * KT_LD;
#pragma unroll
        for (int m = 0; m < 2; ++m)
#pragma unroll
            for (int nn = 0; nn < 8; ++nn)
#pragma unroll
                for (int j = 0; j < 4; ++j) {
                    int il = m * 16 + fq * 4 + j;
                    int ig = wv * 32 + il, jg = nn * 16 + fr;
                    float v = 0.f;
                    if (nn <= 2 * wv + 1 && ig >= jg) v = accs[m][nn][j] * __expf((float)(ig - jg) * lg);
                    mS[il * KT_LD + jg] = f2bf(v);
                }
        __syncthreads();
        f32x4 acco[2][4];
#pragma unroll
        for (int m = 0; m < 2; ++m)
#pragma unroll
            for (int nn = 0; nn < 4; ++nn) acco[m][nn] = (f32x4){0.f, 0.f, 0.f, 0.f};
#pragma unroll
        for (int ks = 0; ks < 4; ++ks) {
            if (ks <= wv) {
                bf16x8 af[2];
#pragma unroll
                for (int m = 0; m < 2; ++m) af[m] = *reinterpret_cast<const bf16x8*>(mS + (m * 16 + fr) * KT_LD + ks * 32 + fq * 8);
#pragma unroll
                for (int nn = 0; nn < 4; ++nn) {
                    bf16x8 bfr = *reinterpret_cast<const bf16x8*>(sVT + (nn * 16 + fr) * KT_LD + ks * 32 + fq * 8);
#pragma unroll
                    for (int m = 0; m < 2; ++m) acco[m][nn] = __builtin_amdgcn_mfma_f32_16x16x32_bf16(af[m], bfr, acco[m][nn], 0, 0, 0);
                }
            }
        }
#pragma unroll
        for (int m = 0; m < 2; ++m)
#pragma unroll
            for (int j = 0; j < 4; ++j) {
                int ig = wv * 32 + m * 16 + fq * 4 + j;
                float xi = __expf((float)(ig + 1) * lg);
                float o[4];
                float sm = 0.f;
#pragma unroll
                for (int nn = 0; nn < 4; ++nn) { o[nn] = acco[m][nn][j] + xi * accc[m][nn][j]; sm += o[nn]; }
                sm += __shfl_xor(sm, 1); sm += __shfl_xor(sm, 2); sm += __shfl_xor(sm, 4); sm += __shfl_xor(sm, 8);
                float mean = sm * (1.0f / 64.0f);
                float sq = 0.f;
#pragma unroll
                for (int nn = 0; nn < 4; ++nn) { float d = o[nn] - mean; sq += d * d; }
                sq += __shfl_xor(sq, 1); sq += __shfl_xor(sq, 2); sq += __shfl_xor(sq, 4); sq += __shfl_xor(sq, 8);
                float rstd = rsqrtf(sq * (1.0f / 64.0f) + 1e-5f);
                size_t tok = (size_t)b * SEQ + n * 128 + ig;
#pragma unroll
                for (int nn = 0; nn < 4; ++nn) {
                    int e = h * 64 + nn * 16 + fr;
                    float y = (o[nn] - mean) * rstd * gng[e] + gnb[e];
                    float gr = bf2f(P[tok * 3072 + 2560 + e]);
                    YC[tok * 1024 + 512 + e] = f2bf(siluf_(gr) * y);
                }
            }
        __syncthreads();
    }
}

#define N_PHASES 21
__device__ __forceinline__ void run_phase(const Params& p, int ph, unsigned char* smem) {
    bf16_t* sm16 = reinterpret_cast<bf16_t*>(smem);
    const bf16_t* W = reinterpret_cast<const bf16_t*>(p.ws + OFF_W);
    bf16_t* ACTB = reinterpret_cast<bf16_t*>(p.ws + OFF_ACTB);
    bf16_t* PB = reinterpret_cast<bf16_t*>(p.ws + OFF_P);
    bf16_t* YC = reinterpret_cast<bf16_t*>(p.ws + OFF_YCAT);
    switch (ph) {
        case 0: phase_pre(p, smem); break;
        case 1: { EpiStoreBf16 e{PB, 2304}; gemm_phase(ACTB, DM, W + WE_IN0, DM, DM, NT / 128, 18, e, sm16); } break;
        case 2: phase_l0_prep(p); break;
        case 3: phase_l0_lora(p, sm16); break;
        case 4: phase_l0_scan(p, smem); break;
        case 5: { EpiOut e{p.in[0], p.out}; gemm_phase(YC, DM, W + WE_OUT0, DM, DM, NT / 128, 8, e, sm16); } break;
        case 6: phase_ln_route(p, 0, p.out); break;
        case 7: phase_exp1(p, 0, sm16); break;
        case 8: phase_exp2(p, 0, sm16); break;
        case 9: phase_ln_ffn(p, 0, p.out, true); break;
        case 10: { EpiStoreBf16 e{PB, 3072}; gemm_phase(ACTB, DM, W + WE_IN1, DM, DM, NT / 128, 24, e, sm16); } break;
        case 11: phase_l1_conv(p, smem); break;
        case 12: phase_ret_kv(p, smem); break;
        case 13: phase_ret_scan(p); break;
        case 14: phase_ret_out(p, smem); break;
        case 15: { EpiOut e{p.out, p.out}; gemm_phase(YC, DM, W + WE_OUT1, DM, DM, NT / 128, 8, e, sm16); } break;
        case 16: phase_ln_route(p, 1, p.out); break;
        case 17: phase_exp1(p, 1, sm16); break;
        case 18: phase_exp2(p, 1, sm16); break;
        case 19: phase_ln_ffn(p, 1, p.out, false); break;
        default: break;
    }
}

#define SMEM_BYTES 65536
__global__ void __launch_bounds__(NTHREADS) k_mega(Params p) {
    __shared__ __attribute__((aligned(16))) unsigned char smem[SMEM_BYTES];
    cg::grid_group grid = cg::this_grid();
#pragma nounroll
    for (int ph = 0; ph < 20; ++ph) {
        int phv = ph;
        asm volatile("" : "+s"(phv));
        run_phase(p, phv, smem);
        if (ph < 19) grid.sync();
    }
}

extern "C" void kernel_launch(void* const* d_in, const int* in_sizes, int n_in, void* d_out, int out_size, void* d_ws, size_t ws_size,
                              hipStream_t stream) {
    static int grid_blocks = 0;
    if (!grid_blocks) {
        int dev = 0, cus = 0, per_cu = 0;
        hipGetDevice(&dev);
        hipDeviceGetAttribute(&cus, hipDeviceAttributeMultiprocessorCount, dev);
        hipOccupancyMaxActiveBlocksPerMultiprocessor(&per_cu, k_mega, NTHREADS, 0);
        if (per_cu < 1) per_cu = 1;
        grid_blocks = cus * per_cu;
    }
    Params p{};
    for (int i = 0; i < 35; ++i) p.in[i] = (const float*)d_in[i];
    p.out = (float*)d_out;
    p.ws = (unsigned char*)d_ws;
    void* args[] = {&p};
    hipError_t e = hipLaunchCooperativeKernel((void*)k_mega, dim3(grid_blocks), dim3(NTHREADS), args, 0, stream);
    if (e != hipSuccess) fprintf(stderr, "cooperative launch failed: %s (grid %d)\n", hipGetErrorString(e), grid_blocks);
}
```

```cpp
#include <hip/hip_runtime.h>
#include <hip/hip_cooperative_groups.h>
#include <stdint.h>
#include <stdio.h>
namespace cg = cooperative_groups;

typedef unsigned short bf16_t;
typedef short bf16x8 __attribute__((ext_vector_type(8)));
typedef float f32x4 __attribute__((ext_vector_type(4)));

#define NT 32768
#define SEQ 8192
#define DM 1024
#define NTHREADS 256
#define ALPHA_F 1.41421356237309515f

#define MIB (1024ull * 1024ull)
#define OFF_CTRL 0ull
#define OFF_W (1ull * MIB)
#define OFF_ROPE (65ull * MIB)
#define OFF_ACTB (68ull * MIB)
#define OFF_AA (OFF_ACTB)
#define OFF_GG (OFF_ACTB + 32ull * MIB)
#define OFF_P (132ull * MIB)
#define OFF_LORA (OFF_P + 144ull * MIB)
#define OFF_POOLED (OFF_P + 160ull * MIB)
#define OFF_FS (OFF_P)
#define OFF_HBUF (OFF_P + 128ull * MIB)
#define OFF_YCAT (324ull * MIB)
#define OFF_LOGW (388ull * MIB)
#define OFF_LTOK (452ull * MIB)
#define OFF_LGATE (456ull * MIB)
#define OFF_KVT (460ull * MIB)
#define WE_IN0 0
#define WE_OUT0 2359296
#define WE_IN1 3407872
#define WE_OUT1 6553600
#define WE_W13 7602176
#define WE_W2 24379392
#define WE_LW2 32768000
#define WE_LA2 32800768
#define WE_LG2 32833536
#define WE_POOL 32899072

struct Params {
    const float* in[35];
    float* out;
    unsigned char* ws;
};

__device__ __forceinline__ bf16_t f2bf(float f) {
    unsigned u = __float_as_uint(f);
    u += 0x7fffu + ((u >> 16) & 1u);
    return (bf16_t)(u >> 16);
}
__device__ __forceinline__ float bf2f(bf16_t h) { return __uint_as_float(((unsigned)h) << 16); }
__device__ __forceinline__ unsigned pack2(float a, float b) { return (unsigned)f2bf(a) | ((unsigned)f2bf(b) << 16); }
__device__ __forceinline__ float wave_sum(float v) {
#pragma unroll
    for (int o = 32; o > 0; o >>= 1) v += __shfl_xor(v, o);
    return v;
}
__device__ __forceinline__ float sigmoidf_(float x) { return 1.0f / (1.0f + __expf(-x)); }
__device__ __forceinline__ float siluf_(float x) { return x / (1.0f + __expf(-x)); }
__device__ __forceinline__ float quad_sum(float v) {
    int iv = __float_as_int(v);
    float a = __int_as_float(__builtin_amdgcn_update_dpp(0, iv, 0xB1, 0xF, 0xF, false));
    v += a;
    iv = __float_as_int(v);
    float b = __int_as_float(__builtin_amdgcn_update_dpp(0, iv, 0x4E, 0xF, 0xF, false));
    return v + b;
}

__device__ __forceinline__ int otid() { int t = threadIdx.x; asm volatile("" : "+v"(t)); return t; }
template <bool GATHER, class Epi>
__device__ __forceinline__ void gemm_tile(const bf16_t* __restrict__ A, int lda, const int* __restrict__ gidx, int gcount,
                                          const bf16_t* __restrict__ Bt, int ldb, int K, int row0, int col0, const Epi& epi,
                                          bf16_t* smem) {
    const int tidx = otid();
    const int tid = tidx, wid = tid >> 6, lane = tid & 63, wr = wid >> 1, wc = wid & 1, fr = lane & 15, fq = lane >> 4;
    bf16_t* SA = smem;
    bf16_t* SB = smem + 128 * 32;
    const bf16_t* ap[2];
    const bf16_t* bp[2];
#pragma unroll
    for (int i = 0; i < 2; ++i) {
        int b = tid * 16 + i * 4096;
        int r = b >> 6, c = (b & 63) >> 1;
        int ar = row0 + r;
        if (GATHER) {
            int gi = ar < gcount ? ar : gcount - 1;
            ar = gidx[gi] >> 1;
        }
        ap[i] = A + (size_t)ar * lda + c;
        bp[i] = Bt + (size_t)(col0 + r) * ldb + c;
    }
    f32x4 acc[4][4];
#pragma unroll
    for (int m = 0; m < 4; ++m)
#pragma unroll
        for (int n = 0; n < 4; ++n) acc[m][n] = (f32x4){0.f, 0.f, 0.f, 0.f};
    for (int kt = 0; kt < K; kt += 32) {
#pragma unroll
        for (int i = 0; i < 2; ++i) {
            int b = tid * 16 + i * 4096;
            __builtin_amdgcn_global_load_lds((const unsigned*)(ap[i] + kt), (__attribute__((address_space(3))) unsigned*)((char*)SA + b), 16, 0, 0);
            __builtin_amdgcn_global_load_lds((const unsigned*)(bp[i] + kt), (__attribute__((address_space(3))) unsigned*)((char*)SB + b), 16, 0, 0);
        }
        asm volatile("s_waitcnt vmcnt(0)" ::: "memory");
        __syncthreads();
        bf16x8 af[4], bfr[4];
#pragma unroll
        for (int m = 0; m < 4; ++m) af[m] = *reinterpret_cast<const bf16x8*>((const char*)SA + (wr * 64 + m * 16 + fr) * 64 + fq * 16);
#pragma unroll
        for (int n = 0; n < 4; ++n) bfr[n] = *reinterpret_cast<const bf16x8*>((const char*)SB + (wc * 64 + n * 16 + fr) * 64 + fq * 16);
#pragma unroll
        for (int m = 0; m < 4; ++m)
#pragma unroll
            for (int n = 0; n < 4; ++n) acc[m][n] = __builtin_amdgcn_mfma_f32_16x16x32_bf16(bfr[n], af[m], acc[m][n], 0, 0, 0);
        __syncthreads();
    }
    epi(acc, row0 + wr * 64, col0 + wc * 64, fr, fq);
}

template <class Epi>
__device__ __forceinline__ void gemm_phase(const bf16_t* A, int lda, const bf16_t* Bt, int ldb, int K, int mt, int nt, const Epi& epi,
                                           bf16_t* smem) {
    const int ntiles = mt * nt;
    for (int t = blockIdx.x; t < ntiles; t += gridDim.x) {
        int tm = t / nt, tn = t % nt;
        gemm_tile<false>(A, lda, nullptr, 0, Bt, ldb, K, tm * 128, tn * 128, epi, smem);
    }
}

struct EpiStoreBf16 {
    bf16_t* O; int ldo;
    __device__ __forceinline__ void operator()(f32x4 (&acc)[4][4], int rb, int cb, int fr, int fq) const {
#pragma unroll
        for (int m = 0; m < 4; ++m)
#pragma unroll
            for (int n = 0; n < 4; ++n) {
                int row = rb + m * 16 + fr, col = cb + n * 16 + fq * 4;
                uint2 w; w.x = pack2(acc[m][n][0], acc[m][n][1]); w.y = pack2(acc[m][n][2], acc[m][n][3]);
                *reinterpret_cast<uint2*>(O + (size_t)row * ldo + col) = w;
            }
    }
};
template <int MODE>
struct EpiLora {
    float* Of; bf16_t* Ob; const float* vec; int ldo; int coff;
    __device__ __forceinline__ void operator()(f32x4 (&acc)[4][4], int rb, int cb, int fr, int fq) const {
#pragma unroll
        for (int m = 0; m < 4; ++m)
#pragma unroll
            for (int n = 0; n < 4; ++n) {
                int row = rb + m * 16 + fr, col = cb + n * 16 + fq * 4;
                float v[4];
#pragma unroll
                for (int j = 0; j < 4; ++j) {
                    float a = acc[m][n][j];
                    if (MODE == 0) {
                        float t = -(vec[col + j] + a);
                        float sp = (t > 20.f) ? t : log1pf(__expf(t));
                        float wl = -sp - 0.5f;
                        v[j] = -__expf(wl);
                    } else if (MODE == 1) {
                        v[j] = sigmoidf_(vec[col + j] + a);
                    } else if (MODE == 2) {
                        v[j] = a;
                    } else {
                        v[j] = a * vec[coff + col + j];
                    }
                }
                if (MODE == 0) {
                    *reinterpret_cast<float4*>(Of + (size_t)row * ldo + col) = make_float4(v[0], v[1], v[2], v[3]);
                } else {
                    uint2 w; w.x = pack2(v[0], v[1]); w.y = pack2(v[2], v[3]);
                    *reinterpret_cast<uint2*>(Ob + (size_t)row * ldo + coff + col) = w;
                }
            }
    }
};
struct EpiOut {
    const float* Xprev; float* X;
    __device__ __forceinline__ void operator()(f32x4 (&acc)[4][4], int rb, int cb, int fr, int fq) const {
#pragma unroll
        for (int m = 0; m < 4; ++m)
#pragma unroll
            for (int n = 0; n < 4; ++n) {
                int row = rb + m * 16 + fr, col = cb + n * 16 + fq * 4;
                float4 xp = *reinterpret_cast<const float4*>(Xprev + (size_t)row * DM + col);
                float4 o;
                o.x = ALPHA_F * xp.x + acc[m][n][0]; o.y = ALPHA_F * xp.y + acc[m][n][1];
                o.z = ALPHA_F * xp.z + acc[m][n][2]; o.w = ALPHA_F * xp.w + acc[m][n][3];
                *reinterpret_cast<float4*>(X + (size_t)row * DM + col) = o;
            }
    }
};
struct EpiExp1 {
    bf16_t* H; int base; int cnt;
    __device__ __forceinline__ void operator()(f32x4 (&acc)[4][4], int rb, int cb, int fr, int fq) const {
#pragma unroll
        for (int m = 0; m < 4; ++m) {
            int li = rb + m * 16 + fr;
            if (li < cnt) {
#pragma unroll
                for (int i = 0; i < 2; ++i) {
                    int hcol = (cb >> 1) + i * 16 + fq * 4;
                    float v[4];
#pragma unroll
                    for (int j = 0; j < 4; ++j) v[j] = siluf_(acc[m][2 * i][j]) * acc[m][2 * i + 1][j];
                    uint2 w; w.x = pack2(v[0], v[1]); w.y = pack2(v[2], v[3]);
                    *reinterpret_cast<uint2*>(H + (size_t)(base + li) * 128 + hcol) = w;
                }
            }
        }
    }
};
struct EpiExp2 {
    bf16_t* FS; const int* ltok; const float* lgate; int cnt;
    __device__ __forceinline__ void operator()(f32x4 (&acc)[4][4], int rb, int cb, int fr, int fq) const {
#pragma unroll
        for (int m = 0; m < 4; ++m) {
            int li = rb + m * 16 + fr;
            if (li < cnt) {
                int pk = ltok[li]; float g = lgate[li];
                int tok = pk >> 1, j = pk & 1;
                bf16_t* o = FS + ((size_t)j * NT + tok) * DM;
#pragma unroll
                for (int n = 0; n < 4; ++n) {
                    int col = cb + n * 16 + fq * 4;
                    uint2 w; w.x = pack2(acc[m][n][0] * g, acc[m][n][1] * g); w.y = pack2(acc[m][n][2] * g, acc[m][n][3] * g);
                    *reinterpret_cast<uint2*>(o + col) = w;
                }
            }
        }
    }
};

__device__ __forceinline__ void tconv_tile(const float* __restrict__ src, int N, bf16_t* __restrict__ dst, int ldd, int k0, int n0,
                                           int mode, float* tile  ) {
    const int tidx = otid();
    const int tid = tidx;
#pragma unroll
    for (int i = 0; i < 16; ++i) {
        int r = i * 4 + (tid >> 6), c = tid & 63;
        tile[r * 65 + c] = src[(size_t)(k0 + r) * N + n0 + c];
    }
    __syncthreads();
#pragma unroll
    for (int i = 0; i < 16; ++i) {
        int nn = i * 4 + (tid >> 6), kk = tid & 63;
        int n = n0 + nn;
        int drow = n;
        if (mode == 1) drow = (n >> 4) * 32 + (n & 15);
        else if (mode == 2) drow = (n >> 4) * 32 + 16 + (n & 15);
        dst[(size_t)drow * ldd + k0 + kk] = f2bf(tile[kk * 65 + nn]);
    }
    __syncthreads();
}

__device__ void phase_pre(const Params& p, unsigned char* smem) {
    const int tidx = otid();
    float* tile = reinterpret_cast<float*>(smem);
    bf16_t* W = reinterpret_cast<bf16_t*>(p.ws + OFF_W);
    if (blockIdx.x == 0 && tidx < 64) reinterpret_cast<int*>(p.ws + OFF_CTRL)[tidx] = 0;
    constexpr int T0 = 576, T1 = 256, T2 = 768, T3 = 256, T4 = 2048, T5 = 2048, T6 = 2048, T7 = 8, T8 = 8, T9 = 16, T10 = 16;
    constexpr int TOT = T0 + T1 + T2 + T3 + T4 + T5 + T6 + T7 + T8 + T9 + T10;
    for (int u = blockIdx.x; u < TOT; u += gridDim.x) {
        int v = u;
        const float* src; bf16_t* dst; int K, N, mode = 0, tk, tn;
        if (v < T0) { src = p.in[1]; K = 1024; N = 2304; dst = W + WE_IN0; tk = v / 36; tn = v % 36; }
        else if ((v -= T0) < T1) { src = p.in[15]; K = 1024; N = 1024; dst = W + WE_OUT0; tk = v / 16; tn = v % 16; }
        else if ((v -= T1) < T2) { src = p.in[16]; K = 1024; N = 3072; dst = W + WE_IN1; tk = v / 48; tn = v % 48; }
        else if ((v -= T2) < T3) { src = p.in[23]; K = 1024; N = 1024; dst = W + WE_OUT1; tk = v / 16; tn = v % 16; }
        else if ((v -= T3) < T4) { int mat = v >> 5, w = v & 31; src = p.in[30] + (size_t)mat * 131072; K = 1024; N = 128; dst = W + WE_W13 + (size_t)mat * 262144; mode = 1; tk = w >> 1; tn = w & 1; }
        else if ((v -= T4) < T5) { int mat = v >> 5, w = v & 31; src = p.in[31] + (size_t)mat * 131072; K = 1024; N = 128; dst = W + WE_W13 + (size_t)mat * 262144; mode = 2; tk = w >> 1; tn = w & 1; }
        else if ((v -= T5) < T6) { int mat = v >> 5, w = v & 31; src = p.in[32] + (size_t)mat * 131072; K = 128; N = 1024; dst = W + WE_W2 + (size_t)mat * 131072; tk = w >> 4; tn = w & 15; }
        else if ((v -= T6) < T7) { src = p.in[4]; K = 64; N = 512; dst = W + WE_LW2; tk = 0; tn = v; }
        else if ((v -= T7) < T8) { src = p.in[6]; K = 64; N = 512; dst = W + WE_LA2; tk = 0; tn = v; }
        else if ((v -= T8) < T9) { src = p.in[7]; K = 128; N = 512; dst = W + WE_LG2; tk = v >> 3; tn = v & 7; }
        else { v -= T9; int mat = v >> 2, w = v & 3; src = p.in[13] + (size_t)mat * 16384; K = 128; N = 128; dst = W + WE_POOL + (size_t)mat * 16384; tk = w >> 1; tn = w & 1; }
        tconv_tile(src, N, dst, K, tk * 64, tn * 64, mode, tile);
    }
    {
        const float4* x4 = reinterpret_cast<const float4*>(p.in[0]);
        uint2* xb = reinterpret_cast<uint2*>(p.ws + OFF_ACTB);
        const size_t n4 = (size_t)NT * DM / 4;
        for (size_t i = (size_t)blockIdx.x * NTHREADS + tidx; i < n4; i += (size_t)gridDim.x * NTHREADS) {
            float4 v = x4[i];
            uint2 w; w.x = pack2(v.x, v.y); w.y = pack2(v.z, v.w);
            xb[i] = w;
        }
    }
    {
        float2* rope = reinterpret_cast<float2*>(p.ws + OFF_ROPE);
        for (int i = blockIdx.x * NTHREADS + tidx; i < SEQ * 32; i += gridDim.x * NTHREADS) {
            int pos = i >> 5, k = i & 31;
            float inv = powf(10000.0f, -(float)k / 32.0f);
            float ang = (float)pos * inv;
            float s, c;
            sincosf(ang, &s, &c);
            rope[i] = make_float2(c, s);
        }
    }
}

__device__ void phase_l0_prep(const Params& p) {
    const int tidx = otid();
    const bf16_t* P = reinterpret_cast<const bf16_t*>(p.ws + OFF_P);
    bf16_t* LA = reinterpret_cast<bf16_t*>(p.ws + OFF_LORA);
    bf16_t* PO = reinterpret_cast<bf16_t*>(p.ws + OFF_POOLED);
    const float* mu = p.in[2];
    const int total = NT * 768;
    for (int i = blockIdx.x * NTHREADS + tidx; i < total; i += gridDim.x * NTHREADS) {
        int tok = i / 768, c = i % 768;
        int s = tok & (SEQ - 1);
        if (c < 256) {
            int col = 1536 + c;
            float pr = bf2f(P[(size_t)tok * 2304 + col]);
            float pv = (s > 0) ? bf2f(P[(size_t)(tok - 1) * 2304 + col]) : 0.f;
            float z = pr + mu[col] * (pv - pr);
            float o;
            if (c < 64) o = tanhf(z);
            else if (c < 128) o = z;
            else o = sigmoidf_(z);
            LA[(size_t)tok * 256 + c] = f2bf(o);
        } else {
            int cc = c - 256;
            int gi = cc >> 7;
            int win = 2 << gi;
            int cnt = (s + 1 < win) ? (s + 1) : win;
            float sum = 0.f;
            for (int j = 0; j < cnt; ++j) sum += bf2f(P[(size_t)(tok - j) * 2304 + 1792 + cc]);
            float u = bf2f(P[(size_t)tok * 2304 + 1792 + cc]);
            PO[(size_t)tok * 512 + cc] = f2bf(sum / (float)cnt - u);
        }
    }
}

__device__ void phase_l0_lora(const Params& p, bf16_t* smem) {
    const bf16_t* W = reinterpret_cast<const bf16_t*>(p.ws + OFF_W);
    const bf16_t* LA = reinterpret_cast<const bf16_t*>(p.ws + OFF_LORA);
    const bf16_t* PO = reinterpret_cast<const bf16_t*>(p.ws + OFF_POOLED);
    for (int t = blockIdx.x; t < 4096; t += gridDim.x) {
        int job = t >> 10, w = t & 1023;
        if (job == 0) {
            EpiLora<0> e{reinterpret_cast<float*>(p.ws + OFF_LOGW), nullptr, p.in[3], 512, 0};
            gemm_tile<false>(LA, 256, nullptr, 0, W + WE_LW2, 64, 64, (w >> 2) * 128, (w & 3) * 128, e, smem);
        } else if (job == 1) {
            EpiLora<1> e{nullptr, reinterpret_cast<bf16_t*>(p.ws + OFF_AA), p.in[5], 512, 0};
            gemm_tile<false>(LA + 64, 256, nullptr, 0, W + WE_LA2, 64, 64, (w >> 2) * 128, (w & 3) * 128, e, smem);
        } else if (job == 2) {
            EpiLora<2> e{nullptr, reinterpret_cast<bf16_t*>(p.ws + OFF_GG), nullptr, 512, 0};
            gemm_tile<false>(LA + 128, 256, nullptr, 0, W + WE_LG2, 128, 128, (w >> 2) * 128, (w & 3) * 128, e, smem);
        } else {
            int g = w & 3, tm = w >> 2;
            EpiLora<3> e{nullptr, reinterpret_cast<bf16_t*>(p.ws + OFF_YCAT), p.in[14], 1024, 512 + g * 128};
            e.vec = p.in[14] - 512;
            gemm_tile<false>(PO + g * 128, 512, nullptr, 0, W + WE_POOL + g * 16384, 128, 128, tm * 128, 0, e, smem);
        }
    }
}

#define RW_T 32
__device__ void phase_l0_scan(const Params& p, unsigned char* smem) {
    const int tidx = otid();
    if (blockIdx.x >= 32) return;
    const int b = blockIdx.x >> 3, h = blockIdx.x & 7;
    const int tid = tidx, wv = tid >> 6, lane = tid & 63;
    float* sW = reinterpret_cast<float*>(smem);
    float* sKK = sW + RW_T * 64;
    float* sB = sKK + RW_T * 64;
    float* sKP = sB + RW_T * 64;
    float* sR = sKP + RW_T * 64;
    float* sV = sR + RW_T * 64;
    float* sY = sV + RW_T * 64;
    float* sBC = sY + RW_T * 64;
    const bf16_t* P = reinterpret_cast<const bf16_t*>(p.ws + OFF_P);
    const float* LOGW = reinterpret_cast<const float*>(p.ws + OFF_LOGW);
    const bf16_t* AA = reinterpret_cast<const bf16_t*>(p.ws + OFF_AA);
    const bf16_t* GG = reinterpret_cast<const bf16_t*>(p.ws + OFF_GG);
    bf16_t* YC = reinterpret_cast<bf16_t*>(p.ws + OFF_YCAT);
    const int c = h * 64 + lane;
    const float mu_r = p.in[2][c], mu_k = p.in[2][512 + c], mu_v = p.in[2][1024 + c];
    const float kkc = p.in[8][c], kac = p.in[9][c], rkc = p.in[10][c], lng = p.in[11][c], lnb = p.in[12][c];
    const int row = wv * 16 + (lane >> 2), kq = lane & 3;
    float s[16];
#pragma unroll
    for (int i = 0; i < 16; ++i) s[i] = 0.f;
    for (int t0 = 0; t0 < SEQ; t0 += RW_T) {
        for (int tl = wv; tl < RW_T; tl += 4) {
            int sidx = t0 + tl;
            size_t tok = (size_t)b * SEQ + sidx;
            const bf16_t* pr = P + tok * 2304;
            float r0 = bf2f(pr[c]), k0 = bf2f(pr[512 + c]), v0 = bf2f(pr[1024 + c]);
            float r1 = 0.f, k1 = 0.f, v1 = 0.f;
            if (sidx > 0) { const bf16_t* pp = pr - 2304; r1 = bf2f(pp[c]); k1 = bf2f(pp[512 + c]); v1 = bf2f(pp[1024 + c]); }
            float zr = r0 + mu_r * (r1 - r0), zk = k0 + mu_k * (k1 - k0), zv = v0 + mu_v * (v1 - v0);
            float w = __expf(LOGW[tok * 512 + c]);
            float a = bf2f(AA[tok * 512 + c]);
            float kk = zk * kkc;
            float ss = wave_sum(kk * kk);
            kk *= rsqrtf(fmaxf(ss, 1e-24f));
            float kp = zk * (1.0f + (a - 1.0f) * kac);
            float bc = wave_sum(zr * kp * rkc);
            sW[tl * 64 + lane] = w; sKK[tl * 64 + lane] = kk; sB[tl * 64 + lane] = kk * a; sKP[tl * 64 + lane] = kp;
            sR[tl * 64 + lane] = zr; sV[tl * 64 + lane] = zv;
            if (lane == 0) sBC[tl] = bc;
        }
        __syncthreads();
#pragma unroll 2
        for (int tl = 0; tl < RW_T; ++tl) {
            const float4* pk = reinterpret_cast<const float4*>(sKK + tl * 64 + kq * 16);
            const float4* pw = reinterpret_cast<const float4*>(sW + tl * 64 + kq * 16);
            const float4* pb = reinterpret_cast<const float4*>(sB + tl * 64 + kq * 16);
            const float4* pp = reinterpret_cast<const float4*>(sKP + tl * 64 + kq * 16);
            const float4* pr = reinterpret_cast<const float4*>(sR + tl * 64 + kq * 16);
            float kkv[16], wvv[16], bvv[16], kpv[16], rvv[16];
#pragma unroll
            for (int q = 0; q < 4; ++q) {
                float4 t;
                t = pk[q]; kkv[4 * q] = t.x; kkv[4 * q + 1] = t.y; kkv[4 * q + 2] = t.z; kkv[4 * q + 3] = t.w;
                t = pw[q]; wvv[4 * q] = t.x; wvv[4 * q + 1] = t.y; wvv[4 * q + 2] = t.z; wvv[4 * q + 3] = t.w;
                t = pb[q]; bvv[4 * q] = t.x; bvv[4 * q + 1] = t.y; bvv[4 * q + 2] = t.z; bvv[4 * q + 3] = t.w;
                t = pp[q]; kpv[4 * q] = t.x; kpv[4 * q + 1] = t.y; kpv[4 * q + 2] = t.z; kpv[4 * q + 3] = t.w;
                t = pr[q]; rvv[4 * q] = t.x; rvv[4 * q + 1] = t.y; rvv[4 * q + 2] = t.z; rvv[4 * q + 3] = t.w;
            }
            float vv = sV[tl * 64 + row];
            float d0 = 0.f, d1 = 0.f, d2 = 0.f, d3 = 0.f;
#pragma unroll
            for (int i = 0; i < 16; i += 4) { d0 += s[i] * kkv[i]; d1 += s[i + 1] * kkv[i + 1]; d2 += s[i + 2] * kkv[i + 2]; d3 += s[i + 3] * kkv[i + 3]; }
            float sa = -quad_sum((d0 + d1) + (d2 + d3));
            float y0 = 0.f, y1 = 0.f, y2 = 0.f, y3 = 0.f;
#pragma unroll
            for (int i = 0; i < 16; i += 4) {
                s[i] = s[i] * wvv[i] + (sa * bvv[i] + vv * kpv[i]);
                s[i + 1] = s[i + 1] * wvv[i + 1] + (sa * bvv[i + 1] + vv * kpv[i + 1]);
                s[i + 2] = s[i + 2] * wvv[i + 2] + (sa * bvv[i + 2] + vv * kpv[i + 2]);
                s[i + 3] = s[i + 3] * wvv[i + 3] + (sa * bvv[i + 3] + vv * kpv[i + 3]);
                y0 += s[i] * rvv[i]; y1 += s[i + 1] * rvv[i + 1]; y2 += s[i + 2] * rvv[i + 2]; y3 += s[i + 3] * rvv[i + 3];
            }
            float y = quad_sum((y0 + y1) + (y2 + y3));
            if (kq == 0) sY[tl * 64 + row] = y;
        }
        __syncthreads();
        for (int tl = wv; tl < RW_T; tl += 4) {
            size_t tok = (size_t)b * SEQ + t0 + tl;
            float y = sY[tl * 64 + lane];
            float mean = wave_sum(y) * (1.0f / 64.0f);
            float d = y - mean;
            float var = wave_sum(d * d) * (1.0f / 64.0f);
            float yn = d * rsqrtf(var + 64e-5f) * lng + lnb;
            float g = bf2f(GG[tok * 512 + c]);
            float o = (yn + sBC[tl] * sV[tl * 64 + lane]) * g;
            YC[tok * 1024 + c] = f2bf(o);
        }
        __syncthreads();
    }
}


#define RC_LD 72
#define RC_BUF (64 * RC_LD)
#define RC_BYTES (RC_BUF * 2)
#define OFF_TBUF OFF_KVT

__device__ __forceinline__ void mm64(f32x4 (&acc)[2][2], const bf16_t* A, const bf16_t* Bt, int wr, int wc, int fr, int fq) {
#pragma unroll
    for (int ks = 0; ks < 2; ++ks) {
        bf16x8 af[2], bq[2];
#pragma unroll
        for (int m = 0; m < 2; ++m) af[m] = *reinterpret_cast<const bf16x8*>(A + (wr * 32 + m * 16 + fr) * RC_LD + ks * 32 + fq * 8);
#pragma unroll
        for (int n = 0; n < 2; ++n) bq[n] = *reinterpret_cast<const bf16x8*>(Bt + (wc * 32 + n * 16 + fr) * RC_LD + ks * 32 + fq * 8);
#pragma unroll
        for (int m = 0; m < 2; ++m)
#pragma unroll
            for (int n = 0; n < 2; ++n) acc[m][n] = __builtin_amdgcn_mfma_f32_16x16x32_bf16(af[m], bq[n], acc[m][n], 0, 0, 0);
    }
}
template <int MASK>
__device__ __forceinline__ void store_T(bf16_t* dst, const f32x4 (&acc)[2][2], int wr, int wc, int fr, int fq) {
#pragma unroll
    for (int m = 0; m < 2; ++m)
#pragma unroll
        for (int n = 0; n < 2; ++n) {
            const int C = wc * 32 + n * 16 + fr, R0 = wr * 32 + m * 16 + fq * 4;
            float v[4];
#pragma unroll
            for (int j = 0; j < 4; ++j) {
                const int R = R0 + j;
                bool keep = true;
                if (MASK == 1) keep = R < C;
                else if (MASK == 2) keep = R <= C;
                else if (MASK == 3) keep = C < R;
                v[j] = keep ? acc[m][n][j] : 0.f;
            }
            uint2 w; w.x = pack2(v[0], v[1]); w.y = pack2(v[2], v[3]);
            *reinterpret_cast<uint2*>(dst + C * RC_LD + R0) = w;
        }
}
__device__ __forceinline__ void zero_acc(f32x4 (&acc)[2][2]) {
#pragma unroll
    for (int m = 0; m < 2; ++m)
#pragma unroll
        for (int n = 0; n < 2; ++n) acc[m][n] = (f32x4){0.f, 0.f, 0.f, 0.f};
}

template <bool FULL>
__device__ __forceinline__ void rwkv_prep(const Params& p, int b, int h, int n, int tid, bf16_t* At, bf16_t* Bt, bf16_t* Kt, bf16_t* Rt,
                                          bf16_t* BtT, bf16_t* KtT, bf16_t* VT, float* sTot, float* sBC, float* sWL) {
    const int lane = tid & 63, q = tid >> 6;
    const int c = h * 64 + lane;
    const bf16_t* P = reinterpret_cast<const bf16_t*>(p.ws + OFF_P);
    const float* LOGW = reinterpret_cast<const float*>(p.ws + OFF_LOGW);
    const bf16_t* AA = reinterpret_cast<const bf16_t*>(p.ws + OFF_AA);
    const float mu_k = p.in[2][512 + c];
    const float kkc = p.in[8][c];
    float mu_r = 0.f, mu_v = 0.f, kac = 0.f, rkc = 0.f;
    if (FULL) { mu_r = p.in[2][c]; mu_v = p.in[2][1024 + c]; kac = p.in[9][c]; rkc = p.in[10][c]; }
    const int s0 = n * 64 + q * 16;
    const size_t tok0 = (size_t)b * SEQ + s0;
    float lw[16], av[16], zk[16], zr[16], zv[16];
    float pk = 0.f, pr = 0.f, pv = 0.f;
    if (s0 > 0) {
        const bf16_t* pp = P + (tok0 - 1) * 2304;
        pk = bf2f(pp[512 + c]);
        if (FULL) { pr = bf2f(pp[c]); pv = bf2f(pp[1024 + c]); }
    }
#pragma unroll
    for (int i = 0; i < 16; ++i) {
        const bf16_t* pp = P + (tok0 + i) * 2304;
        float k0 = bf2f(pp[512 + c]);
        zk[i] = k0 + mu_k * (pk - k0); pk = k0;
        if (FULL) {
            float r0 = bf2f(pp[c]), v0 = bf2f(pp[1024 + c]);
            zr[i] = r0 + mu_r * (pr - r0); pr = r0;
            zv[i] = v0 + mu_v * (pv - v0); pv = v0;
        }
        lw[i] = LOGW[(tok0 + i) * 512 + c];
        av[i] = bf2f(AA[(tok0 + i) * 512 + c]);
    }
    float lws[16];
    float cs = 0.f;
#pragma unroll
    for (int i = 0; i < 16; ++i) { cs += lw[i]; lws[i] = cs; }
    sTot[q * 64 + lane] = cs;
    __syncthreads();
    float off = 0.f, tot = 0.f;
#pragma unroll
    for (int qq = 0; qq < 4; ++qq) { float tq = sTot[qq * 64 + lane]; if (qq < q) off += tq; tot += tq; }
    float btv[16], ktv[16];
#pragma unroll
    for (int i = 0; i < 16; ++i) {
        const int t = q * 16 + i;
        const float L = lws[i] + off;
        float kk = zk[i] * kkc;
        float ss = wave_sum(kk * kk);
        kk *= rsqrtf(fmaxf(ss, 1e-24f));
        const float e_neg = __expf(-L), e_prev = __expf(L - lw[i]);
        const float a = av[i];
        At[t * RC_LD + lane] = f2bf(-kk * e_prev);
        const float bt = kk * a * e_neg;
        Bt[t * RC_LD + lane] = f2bf(bt);
        if (FULL) {
            const float kp = zk[i] * (1.0f + (a - 1.0f) * kac);
            const float kt = kp * e_neg;
            Kt[t * RC_LD + lane] = f2bf(kt);
            Rt[t * RC_LD + lane] = f2bf(zr[i] * __expf(L));
            const float bc = wave_sum(zr[i] * kp * rkc);
            if (lane == 0) sBC[t] = bc;
            btv[i] = bt; ktv[i] = kt;
        }
    }
    if (FULL) {
        uint4 w0, w1;
        w0.x = pack2(btv[0], btv[1]); w0.y = pack2(btv[2], btv[3]); w0.z = pack2(btv[4], btv[5]); w0.w = pack2(btv[6], btv[7]);
        w1.x = pack2(btv[8], btv[9]); w1.y = pack2(btv[10], btv[11]); w1.z = pack2(btv[12], btv[13]); w1.w = pack2(btv[14], btv[15]);
        *reinterpret_cast<uint4*>(BtT + lane * RC_LD + q * 16) = w0;
        *reinterpret_cast<uint4*>(BtT + lane * RC_LD + q * 16 + 8) = w1;
        w0.x = pack2(ktv[0], ktv[1]); w0.y = pack2(ktv[2], ktv[3]); w0.z = pack2(ktv[4], ktv[5]); w0.w = pack2(ktv[6], ktv[7]);
        w1.x = pack2(ktv[8], ktv[9]); w1.y = pack2(ktv[10], ktv[11]); w1.z = pack2(ktv[12], ktv[13]); w1.w = pack2(ktv[14], ktv[15]);
        *reinterpret_cast<uint4*>(KtT + lane * RC_LD + q * 16) = w0;
        *reinterpret_cast<uint4*>(KtT + lane * RC_LD + q * 16 + 8) = w1;
        w0.x = pack2(zv[0], zv[1]); w0.y = pack2(zv[2], zv[3]); w0.z = pack2(zv[4], zv[5]); w0.w = pack2(zv[6], zv[7]);
        w1.x = pack2(zv[8], zv[9]); w1.y = pack2(zv[10], zv[11]); w1.z = pack2(zv[12], zv[13]); w1.w = pack2(zv[14], zv[15]);
        *reinterpret_cast<uint4*>(VT + lane * RC_LD + q * 16) = w0;
        *reinterpret_cast<uint4*>(VT + lane * RC_LD + q * 16 + 8) = w1;
        if (q == 0) sWL[lane] = __expf(tot);
    }
}

__device__ void phase_rwkv_T(const Params& p, unsigned char* smem) {
    const int tidx = otid();
    const int tid = tidx, wv = tid >> 6, lane = tid & 63, fr = lane & 15, fq = lane >> 4, wr = wv >> 1, wc = wv & 1;
    bf16_t* base = reinterpret_cast<bf16_t*>(smem);
    bf16_t* At = base; bf16_t* Bt = base + RC_BUF;
    bf16_t* R0 = base + 2 * RC_BUF; bf16_t* C0 = base + 3 * RC_BUF; bf16_t* R1 = base + 4 * RC_BUF; bf16_t* C1 = base + 5 * RC_BUF;
    bf16_t* Pm0 = base + 6 * RC_BUF; bf16_t* Pm1 = base + 7 * RC_BUF;
    float* sTot = reinterpret_cast<float*>(smem + 12 * RC_BYTES);
    bf16_t* Tg = reinterpret_cast<bf16_t*>(p.ws + OFF_TBUF);
    for (int u = blockIdx.x; u < 4096; u += gridDim.x) {
        const int b = u >> 10, h = (u >> 7) & 7, n = u & 127;
        rwkv_prep<false>(p, b, h, n, tid, At, Bt, nullptr, nullptr, nullptr, nullptr, nullptr, sTot, nullptr, nullptr);
        __syncthreads();
        f32x4 pacc[2][2];
        {
            f32x4 acc[2][2];
            zero_acc(acc);
            mm64(acc, At, Bt, wr, wc, fr, fq);
            store_T<3>(C0, acc, wr, wc, fr, fq);
            zero_acc(pacc);
            mm64(pacc, Bt, At, wr, wc, fr, fq);
#pragma unroll
            for (int m = 0; m < 2; ++m)
#pragma unroll
                for (int nn = 0; nn < 2; ++nn)
#pragma unroll
                    for (int j = 0; j < 4; ++j) {
                        const int R = wr * 32 + m * 16 + fq * 4 + j, C = wc * 32 + nn * 16 + fr;
                        pacc[m][nn][j] = (R < C) ? pacc[m][nn][j] : 0.f;
                    }
            store_T<0>(R0, pacc, wr, wc, fr, fq);
#pragma unroll
            for (int m = 0; m < 2; ++m)
#pragma unroll
                for (int nn = 0; nn < 2; ++nn)
#pragma unroll
                    for (int j = 0; j < 4; ++j) {
                        const int R = wr * 32 + m * 16 + fq * 4 + j, C = wc * 32 + nn * 16 + fr;
                        if (R == C) pacc[m][nn][j] += 1.0f;
                    }
            store_T<0>(Pm0, pacc, wr, wc, fr, fq);
        }
        __syncthreads();
#pragma unroll 1
        for (int j = 1; j <= 5; ++j) {
            f32x4 acc[2][2];
            if (j < 5) {
                zero_acc(acc);
                mm64(acc, C0, R0, wr, wc, fr, fq);
                store_T<0>(R1, acc, wr, wc, fr, fq);
            }
            zero_acc(acc);
            mm64(acc, R0, C0, wr, wc, fr, fq);
            store_T<0>(C1, acc, wr, wc, fr, fq);
            __syncthreads();
            zero_acc(acc);
            mm64(acc, C1, Pm0, wr, wc, fr, fq);
#pragma unroll
            for (int m = 0; m < 2; ++m)
#pragma unroll
                for (int nn = 0; nn < 2; ++nn) pacc[m][nn] += acc[m][nn];
            if (j < 5) store_T<0>(Pm1, pacc, wr, wc, fr, fq);
            __syncthreads();
            bf16_t* t0 = R0; R0 = R1; R1 = t0;
            t0 = C0; C0 = C1; C1 = t0;
            t0 = Pm0; Pm0 = Pm1; Pm1 = t0;
        }
        bf16_t* To = Tg + (size_t)u * 4096;
#pragma unroll
        for (int m = 0; m < 2; ++m)
#pragma unroll
            for (int nn = 0; nn < 2; ++nn) {
                const int C = wc * 32 + nn * 16 + fr, Rb = wr * 32 + m * 16 + fq * 4;
                uint2 w; w.x = pack2(pacc[m][nn][0], pacc[m][nn][1]); w.y = pack2(pacc[m][nn][2], pacc[m][nn][3]);
                *reinterpret_cast<uint2*>(To + C * 64 + Rb) = w;
            }
    }
}

__device__ void phase_rwkv_seq(const Params& p, unsigned char* smem) {
    const int tidx = otid();
    if (blockIdx.x >= 32) return;
    const int b = blockIdx.x >> 3, h = blockIdx.x & 7;
    const int tid = tidx, wv = tid >> 6, lane = tid & 63, fr = lane & 15, fq = lane >> 4, wr = wv >> 1, wc = wv & 1;
    bf16_t* base = reinterpret_cast<bf16_t*>(smem);
    bf16_t* At = base; bf16_t* Aak = base + RC_BUF; bf16_t* Bt = base + 2 * RC_BUF; bf16_t* Kt = base + 3 * RC_BUF;
    bf16_t* Rt = base + 4 * RC_BUF; bf16_t* BtT = base + 5 * RC_BUF; bf16_t* KtT = base + 6 * RC_BUF; bf16_t* VT = base + 7 * RC_BUF;
    bf16_t* Sb = base + 8 * RC_BUF; bf16_t* Tm = base + 9 * RC_BUF; bf16_t* Arb = base + 10 * RC_BUF; bf16_t* Ark = base + 11 * RC_BUF;
    bf16_t* XT = Bt; bf16_t* UT = Kt;
    float* Yf = reinterpret_cast<float*>(smem);
    float* sTot = reinterpret_cast<float*>(smem + 12 * RC_BYTES);
    float* sBC = sTot + 256;
    float* sWL = sBC + 64;
    const bf16_t* Tg = reinterpret_cast<const bf16_t*>(p.ws + OFF_TBUF);
    const bf16_t* GG = reinterpret_cast<const bf16_t*>(p.ws + OFF_GG);
    bf16_t* YC = reinterpret_cast<bf16_t*>(p.ws + OFF_YCAT);
    const int c = h * 64 + lane;
    const float lng = p.in[11][c], lnb = p.in[12][c];
    f32x4 sacc[2][2];
    zero_acc(sacc);
    for (int i = tid; i < RC_BUF / 2; i += NTHREADS) reinterpret_cast<unsigned*>(Sb)[i] = 0u;
#pragma unroll 1
    for (int n = 0; n < 128; ++n) {
        const int u = (b * 8 + h) * 128 + n;
        rwkv_prep<true>(p, b, h, n, tid, At, Bt, Kt, Rt, BtT, KtT, VT, sTot, sBC, sWL);
        {
            const uint4* Tu = reinterpret_cast<const uint4*>(Tg + (size_t)u * 4096);
#pragma unroll
            for (int i = 0; i < 2; ++i) {
                int idx = tid + i * 256, row = idx >> 3, ch = idx & 7;
                *reinterpret_cast<uint4*>(Tm + row * RC_LD + ch * 8) = Tu[idx];
            }
        }
        __syncthreads();
        {
            f32x4 acc[2][2];
            zero_acc(acc); mm64(acc, Kt, At, wr, wc, fr, fq); store_T<1>(Aak, acc, wr, wc, fr, fq);
            zero_acc(acc); mm64(acc, Bt, Rt, wr, wc, fr, fq); store_T<2>(Arb, acc, wr, wc, fr, fq);
            zero_acc(acc); mm64(acc, Kt, Rt, wr, wc, fr, fq); store_T<2>(Ark, acc, wr, wc, fr, fq);
        }
        __syncthreads();
        {
            f32x4 acc[2][2];
            zero_acc(acc); mm64(acc, At, Sb, wr, wc, fr, fq); mm64(acc, Aak, VT, wr, wc, fr, fq);
            store_T<0>(XT, acc, wr, wc, fr, fq);
        }
        __syncthreads();
        {
            f32x4 acc[2][2];
            zero_acc(acc); mm64(acc, Tm, XT, wr, wc, fr, fq);
            store_T<0>(UT, acc, wr, wc, fr, fq);
        }
        __syncthreads();
        {
            f32x4 acc[2][2];
            zero_acc(acc);
            mm64(acc, Rt, Sb, wr, wc, fr, fq); mm64(acc, Arb, UT, wr, wc, fr, fq); mm64(acc, Ark, VT, wr, wc, fr, fq);
#pragma unroll
            for (int m = 0; m < 2; ++m)
#pragma unroll
                for (int nn = 0; nn < 2; ++nn)
#pragma unroll
                    for (int j = 0; j < 4; ++j) Yf[(wr * 32 + m * 16 + fq * 4 + j) * 68 + wc * 32 + nn * 16 + fr] = acc[m][nn][j];
            mm64(sacc, BtT, UT, wr, wc, fr, fq); mm64(sacc, KtT, VT, wr, wc, fr, fq);
#pragma unroll
            for (int m = 0; m < 2; ++m)
#pragma unroll
                for (int j = 0; j < 4; ++j) {
                    const float wl = sWL[wr * 32 + m * 16 + fq * 4 + j];
                    sacc[m][0][j] *= wl; sacc[m][1][j] *= wl;
                }
        }
        __syncthreads();
        store_T<0>(Sb, sacc, wr, wc, fr, fq);
#pragma unroll 4
        for (int i = 0; i < 16; ++i) {
            const int t = wv * 16 + i;
            const size_t tok = (size_t)b * SEQ + n * 64 + t;
            const float y = Yf[t * 68 + lane];
            const float mean = wave_sum(y) * (1.0f / 64.0f);
            const float d = y - mean;
            const float var = wave_sum(d * d) * (1.0f / 64.0f);
            const float yn = d * rsqrtf(var + 64e-5f) * lng + lnb;
            const float g = bf2f(GG[tok * 512 + c]);
            const float vv = bf2f(VT[lane * RC_LD + t]);
            YC[tok * 1024 + c] = f2bf((yn + sBC[t] * vv) * g);
        }
        __syncthreads();
    }
}

__device__ void phase_ln_route(const Params& p, int layer, float* X) {
    const int tidx = otid();
    const int tid = tidx, wv = tid >> 6, lane = tid & 63;
    const float* g = p.in[24] + layer * DM;
    const float* bb = p.in[25] + layer * DM;
    const float* rgw = p.in[26] + (size_t)layer * DM * 4;
    const float* rgb = p.in[27] + layer * 4;
    const float* rew = p.in[28] + (size_t)layer * DM * 32;
    const float* reb = p.in[29] + layer * 32;
    bf16_t* XB = reinterpret_cast<bf16_t*>(p.ws + OFF_ACTB);
    int* cnt = reinterpret_cast<int*>(p.ws + OFF_CTRL) + layer * 32;
    int* ltok = reinterpret_cast<int*>(p.ws + OFF_LTOK);
    float* lgate = reinterpret_cast<float*>(p.ws + OFF_LGATE);
    for (int row = blockIdx.x * 4 + wv; row < NT; row += gridDim.x * 4) {
        float* xr = X + (size_t)row * DM;
        float v[16];
#pragma unroll
        for (int i = 0; i < 4; ++i) {
            float4 t = *reinterpret_cast<const float4*>(xr + i * 256 + lane * 4);
            v[4 * i] = t.x; v[4 * i + 1] = t.y; v[4 * i + 2] = t.z; v[4 * i + 3] = t.w;
        }
        float sum = 0.f;
#pragma unroll
        for (int i = 0; i < 16; ++i) sum += v[i];
        float mean = wave_sum(sum) * (1.0f / DM);
        float sq = 0.f;
#pragma unroll
        for (int i = 0; i < 16; ++i) { float d = v[i] - mean; sq += d * d; }
        float rstd = rsqrtf(wave_sum(sq) * (1.0f / DM) + 1e-5f);
#pragma unroll
        for (int i = 0; i < 4; ++i) {
            int col = i * 256 + lane * 4;
            float4 gg = *reinterpret_cast<const float4*>(g + col);
            float4 bv = *reinterpret_cast<const float4*>(bb + col);
            v[4 * i] = (v[4 * i] - mean) * rstd * gg.x + bv.x;
            v[4 * i + 1] = (v[4 * i + 1] - mean) * rstd * gg.y + bv.y;
            v[4 * i + 2] = (v[4 * i + 2] - mean) * rstd * gg.z + bv.z;
            v[4 * i + 3] = (v[4 * i + 3] - mean) * rstd * gg.w + bv.w;
            *reinterpret_cast<float4*>(xr + col) = make_float4(v[4 * i], v[4 * i + 1], v[4 * i + 2], v[4 * i + 3]);
            uint2 w; w.x = pack2(v[4 * i], v[4 * i + 1]); w.y = pack2(v[4 * i + 2], v[4 * i + 3]);
            *reinterpret_cast<uint2*>(XB + (size_t)row * DM + col) = w;
        }
        float gl[4] = {0.f, 0.f, 0.f, 0.f};
#pragma unroll
        for (int i = 0; i < 4; ++i)
#pragma unroll
            for (int e = 0; e < 4; ++e) {
                int k = i * 256 + lane * 4 + e;
                float4 w = *reinterpret_cast<const float4*>(rgw + (size_t)k * 4);
                float xv = v[4 * i + e];
                gl[0] += xv * w.x; gl[1] += xv * w.y; gl[2] += xv * w.z; gl[3] += xv * w.w;
            }
#pragma unroll
        for (int j = 0; j < 4; ++j) gl[j] = wave_sum(gl[j]) + rgb[j];
        int gi = 0; float gm = gl[0];
#pragma unroll
        for (int j = 1; j < 4; ++j) if (gl[j] > gm) { gm = gl[j]; gi = j; }
        float gs = 0.f;
#pragma unroll
        for (int j = 0; j < 4; ++j) gs += __expf(gl[j] - gm);
        float gw = 1.0f / gs;
        float el[8];
#pragma unroll
        for (int j = 0; j < 8; ++j) el[j] = 0.f;
#pragma unroll
        for (int i = 0; i < 4; ++i)
#pragma unroll
            for (int e = 0; e < 4; ++e) {
                int k = i * 256 + lane * 4 + e;
                const float4* wp = reinterpret_cast<const float4*>(rew + (size_t)k * 32 + gi * 8);
                float4 w0 = wp[0], w1 = wp[1];
                float xv = v[4 * i + e];
                el[0] += xv * w0.x; el[1] += xv * w0.y; el[2] += xv * w0.z; el[3] += xv * w0.w;
                el[4] += xv * w1.x; el[5] += xv * w1.y; el[6] += xv * w1.z; el[7] += xv * w1.w;
            }
#pragma unroll
        for (int j = 0; j < 8; ++j) el[j] = wave_sum(el[j]) + reb[gi * 8 + j];
        int i1 = 0; float m1 = el[0];
#pragma unroll
        for (int j = 1; j < 8; ++j) if (el[j] > m1) { m1 = el[j]; i1 = j; }
        int i2 = -1; float m2 = -3.0e38f;
#pragma unroll
        for (int j = 0; j < 8; ++j) if (j != i1 && el[j] > m2) { m2 = el[j]; i2 = j; }
        float e2 = __expf(m2 - m1);
        float p1 = 1.0f / (1.0f + e2), p2 = e2 / (1.0f + e2);
        if (lane < 2) {
            int ex = gi * 8 + (lane == 0 ? i1 : i2);
            float gate = gw * (lane == 0 ? p1 : p2);
            int slot = atomicAdd(&cnt[ex], 1);
            ltok[(size_t)ex * NT + slot] = row * 2 + lane;
            lgate[(size_t)ex * NT + slot] = gate;
        }
    }
}

__device__ void phase_exp1(const Params& p, int layer, bf16_t* smem) {
    const int* cnt = reinterpret_cast<const int*>(p.ws + OFF_CTRL) + layer * 32;
    const int* ltok = reinterpret_cast<const int*>(p.ws + OFF_LTOK);
    const bf16_t* XB = reinterpret_cast<const bf16_t*>(p.ws + OFF_ACTB);
    const bf16_t* W13 = reinterpret_cast<const bf16_t*>(p.ws + OFF_W) + WE_W13 + (size_t)layer * 32 * 262144;
    bf16_t* H = reinterpret_cast<bf16_t*>(p.ws + OFF_HBUF);
    int t = blockIdx.x;
    int base = 0, tbase = 0;
    for (int e = 0; e < 32; ++e) {
        int c = cnt[e];
        int nt = ((c + 127) >> 7) * 2;
        while (t < tbase + nt) {
            int w = t - tbase;
            EpiExp1 epi{H, base, c};
            gemm_tile<true>(XB, DM, ltok + (size_t)e * NT, c, W13 + (size_t)e * 262144, DM, DM, (w >> 1) * 128, (w & 1) * 128, epi, smem);
            t += gridDim.x;
        }
        tbase += nt; base += c;
    }
}
__device__ void phase_exp2(const Params& p, int layer, bf16_t* smem) {
    const int* cnt = reinterpret_cast<const int*>(p.ws + OFF_CTRL) + layer * 32;
    const int* ltok = reinterpret_cast<const int*>(p.ws + OFF_LTOK);
    const float* lgate = reinterpret_cast<const float*>(p.ws + OFF_LGATE);
    const bf16_t* W2 = reinterpret_cast<const bf16_t*>(p.ws + OFF_W) + WE_W2 + (size_t)layer * 32 * 131072;
    const bf16_t* H = reinterpret_cast<const bf16_t*>(p.ws + OFF_HBUF);
    bf16_t* FS = reinterpret_cast<bf16_t*>(p.ws + OFF_FS);
    int t = blockIdx.x;
    int base = 0, tbase = 0;
    for (int e = 0; e < 32; ++e) {
        int c = cnt[e];
        int nt = ((c + 127) >> 7) * 8;
        while (t < tbase + nt) {
            int w = t - tbase;
            EpiExp2 epi{FS, ltok + (size_t)e * NT, lgate + (size_t)e * NT, c};
            gemm_tile<false>(H + (size_t)base * 128, 128, nullptr, 0, W2 + (size_t)e * 131072, 128, 128, (w >> 3) * 128, (w & 7) * 128, epi, smem);
            t += gridDim.x;
        }
        tbase += nt; base += c;
    }
}

__device__ void phase_ln_ffn(const Params& p, int layer, float* X, bool write_b) {
    const int tidx = otid();
    const int tid = tidx, wv = tid >> 6, lane = tid & 63;
    const float* g = p.in[33] + layer * DM;
    const float* bb = p.in[34] + layer * DM;
    const bf16_t* FS = reinterpret_cast<const bf16_t*>(p.ws + OFF_FS);
    bf16_t* XB = reinterpret_cast<bf16_t*>(p.ws + OFF_ACTB);
    for (int row = blockIdx.x * 4 + wv; row < NT; row += gridDim.x * 4) {
        float* xr = X + (size_t)row * DM;
        float v[16];
#pragma unroll
        for (int i = 0; i < 4; ++i) {
            int col = i * 256 + lane * 4;
            float4 t = *reinterpret_cast<const float4*>(xr + col);
            uint2 f0 = *reinterpret_cast<const uint2*>(FS + (size_t)row * DM + col);
            uint2 f1 = *reinterpret_cast<const uint2*>(FS + ((size_t)NT + row) * DM + col);
            v[4 * i] = ALPHA_F * t.x + __uint_as_float(f0.x << 16) + __uint_as_float(f1.x << 16);
            v[4 * i + 1] = ALPHA_F * t.y + __uint_as_float(f0.x & 0xffff0000u) + __uint_as_float(f1.x & 0xffff0000u);
            v[4 * i + 2] = ALPHA_F * t.z + __uint_as_float(f0.y << 16) + __uint_as_float(f1.y << 16);
            v[4 * i + 3] = ALPHA_F * t.w + __uint_as_float(f0.y & 0xffff0000u) + __uint_as_float(f1.y & 0xffff0000u);
        }
        float sum = 0.f;
#pragma unroll
        for (int i = 0; i < 16; ++i) sum += v[i];
        float mean = wave_sum(sum) * (1.0f / DM);
        float sq = 0.f;
#pragma unroll
        for (int i = 0; i < 16; ++i) { float d = v[i] - mean; sq += d * d; }
        float rstd = rsqrtf(wave_sum(sq) * (1.0f / DM) + 1e-5f);
#pragma unroll
        for (int i = 0; i < 4; ++i) {
            int col = i * 256 + lane * 4;
            float4 gg = *reinterpret_cast<const float4*>(g + col);
            float4 bv = *reinterpret_cast<const float4*>(bb + col);
            float o0 = (v[4 * i] - mean) * rstd * gg.x + bv.x;
            float o1 = (v[4 * i + 1] - mean) * rstd * gg.y + bv.y;
            float o2 = (v[4 * i + 2] - mean) * rstd * gg.z + bv.z;
            float o3 = (v[4 * i + 3] - mean) * rstd * gg.w + bv.w;
            *reinterpret_cast<float4*>(xr + col) = make_float4(o0, o1, o2, o3);
            if (write_b) {
                uint2 w; w.x = pack2(o0, o1); w.y = pack2(o2, o3);
                *reinterpret_cast<uint2*>(XB + (size_t)row * DM + col) = w;
            }
        }
    }
}

__device__ void phase_l1_conv(const Params& p, unsigned char* smem) {
    const int tidx = otid();
    const bf16_t* P = reinterpret_cast<const bf16_t*>(p.ws + OFF_P);
    bf16_t* YC = reinterpret_cast<bf16_t*>(p.ws + OFF_YCAT);
    float* red = reinterpret_cast<float*>(smem);
    const int tid = tidx, wv = tid >> 6, lane = tid & 63;
    const float* cw = p.in[17];
    float w0[31], w1[31];
#pragma unroll
    for (int j = 0; j < 31; ++j) { w0[j] = cw[j * 512 + tid]; w1[j] = cw[j * 512 + 256 + tid]; }
    const float cb0 = p.in[18][tid], cb1 = p.in[18][256 + tid];
    const float g0 = p.in[19][tid], g1 = p.in[19][256 + tid];
    const float b0 = p.in[20][tid], b1 = p.in[20][256 + tid];
    for (int u = blockIdx.x; u < NT / 8; u += gridDim.x) {
        const int t0 = u * 8;
        const int s0 = t0 & (SEQ - 1);
        float a0[8], a1[8];
#pragma unroll
        for (int o = 0; o < 8; ++o) { a0[o] = cb0; a1[o] = cb1; }
#pragma unroll
        for (int rr = 0; rr < 38; ++rr) {
            int srow = s0 - 30 + rr;
            float u0 = 0.f, u1 = 0.f;
            if (srow >= 0) {
                const bf16_t* pr = P + (size_t)(t0 - 30 + rr) * 3072;
                float ca0 = bf2f(pr[tid]), ca1 = bf2f(pr[256 + tid]);
                float cg0 = bf2f(pr[512 + tid]), cg1 = bf2f(pr[768 + tid]);
                u0 = ca0 * sigmoidf_(cg0); u1 = ca1 * sigmoidf_(cg1);
            }
#pragma unroll
            for (int o = 0; o < 8; ++o) {
                int j = rr - o;
                if (j >= 0 && j <= 30) { a0[o] += u0 * w0[j]; a1[o] += u1 * w1[j]; }
            }
        }
        float mean[8], rstd[8];
#pragma unroll
        for (int o = 0; o < 8; ++o) {
            float sm = wave_sum(a0[o] + a1[o]);
            if (lane == 0) red[wv * 8 + o] = sm;
        }
        __syncthreads();
#pragma unroll
        for (int o = 0; o < 8; ++o) mean[o] = (red[o] + red[8 + o] + red[16 + o] + red[24 + o]) * (1.0f / 512.0f);
        __syncthreads();
#pragma unroll
        for (int o = 0; o < 8; ++o) {
            float d0 = a0[o] - mean[o], d1 = a1[o] - mean[o];
            float sm = wave_sum(d0 * d0 + d1 * d1);
            if (lane == 0) red[wv * 8 + o] = sm;
        }
        __syncthreads();
#pragma unroll
        for (int o = 0; o < 8; ++o) rstd[o] = rsqrtf((red[o] + red[8 + o] + red[16 + o] + red[24 + o]) * (1.0f / 512.0f) + 1e-5f);
        __syncthreads();
#pragma unroll
        for (int o = 0; o < 8; ++o) {
            float y0 = (a0[o] - mean[o]) * rstd[o] * g0 + b0;
            float y1 = (a1[o] - mean[o]) * rstd[o] * g1 + b1;
            YC[(size_t)(t0 + o) * 1024 + tid] = f2bf(siluf_(y0));
            YC[(size_t)(t0 + o) * 1024 + 256 + tid] = f2bf(siluf_(y1));
        }
    }
}

__device__ __forceinline__ float ret_lg(int h) { return log1pf(-exp2f(-5.0f - (float)h)); }

#define KT_LD 136
__device__ void phase_ret_kv(const Params& p, unsigned char* smem) {
    const int tidx = otid();
    const bf16_t* P = reinterpret_cast<const bf16_t*>(p.ws + OFF_P);
    const float2* rope = reinterpret_cast<const float2*>(p.ws + OFF_ROPE);
    float* KVT = reinterpret_cast<float*>(p.ws + OFF_KVT);
    bf16_t* sKT = reinterpret_cast<bf16_t*>(smem);
    bf16_t* sVT = sKT + 64 * KT_LD;
    const int tid = tidx, wv = tid >> 6, lane = tid & 63, fr = lane & 15, fq = lane >> 4;
    for (int u = blockIdx.x; u < 2048; u += gridDim.x) {
        const int n = u & 63, h = (u >> 6) & 7, b = u >> 9;
        const float lg = ret_lg(h);
        {
            const int c = tid >> 1, i0 = (tid & 1) * 16;
            const int sidx = n * 128 + c;
            const size_t tok = (size_t)b * SEQ + sidx;
            const bf16_t* kr = P + tok * 3072 + 1536 + h * 64;
            const bf16_t* vr = P + tok * 3072 + 2048 + h * 64;
            const float zeta = __expf((float)(127 - c) * lg) * 0.125f;
#pragma unroll
            for (int i = 0; i < 16; ++i) {
                float t1 = bf2f(kr[i0 + i]), t2 = bf2f(kr[32 + i0 + i]);
                float2 cs = rope[sidx * 32 + i0 + i];
                float o1 = (t1 * cs.x - t2 * cs.y) * zeta, o2 = (t1 * cs.y + t2 * cs.x) * zeta;
                sKT[(i0 + i) * KT_LD + c] = f2bf(o1);
                sKT[(32 + i0 + i) * KT_LD + c] = f2bf(o2);
                sVT[(i0 + i) * KT_LD + c] = vr[i0 + i];
                sVT[(32 + i0 + i) * KT_LD + c] = vr[32 + i0 + i];
            }
        }
        __syncthreads();
        f32x4 acc[4];
#pragma unroll
        for (int nn = 0; nn < 4; ++nn) acc[nn] = (f32x4){0.f, 0.f, 0.f, 0.f};
#pragma unroll
        for (int ks = 0; ks < 4; ++ks) {
            bf16x8 af = *reinterpret_cast<const bf16x8*>(sVT + (wv * 16 + fr) * KT_LD + ks * 32 + fq * 8);
#pragma unroll
            for (int nn = 0; nn < 4; ++nn) {
                bf16x8 bfr = *reinterpret_cast<const bf16x8*>(sKT + (nn * 16 + fr) * KT_LD + ks * 32 + fq * 8);
                acc[nn] = __builtin_amdgcn_mfma_f32_16x16x32_bf16(af, bfr, acc[nn], 0, 0, 0);
            }
        }
        float* o = KVT + (size_t)u * 4096;
#pragma unroll
        for (int nn = 0; nn < 4; ++nn)
#pragma unroll
            for (int j = 0; j < 4; ++j) o[(wv * 16 + fq * 4 + j) * 64 + nn * 16 + fr] = acc[nn][j];
        __syncthreads();
    }
}
__device__ void phase_ret_scan(const Params& p) {
    const int tidx = otid();
    float* KVT = reinterpret_cast<float*>(p.ws + OFF_KVT);
    for (int i = blockIdx.x * NTHREADS + tidx; i < 32 * 4096; i += gridDim.x * NTHREADS) {
        int bh = i >> 12, ed = i & 4095, h = bh & 7;
        float gc = __expf(128.0f * ret_lg(h));
        float R = 0.f;
        float* q = KVT + (size_t)bh * 64 * 4096 + ed;
        for (int n = 0; n < 64; ++n) {
            float kv = q[(size_t)n * 4096];
            q[(size_t)n * 4096] = R;
            R = gc * R + kv;
        }
    }
}
#define Q_LD 72
__device__ void phase_ret_out(const Params& p, unsigned char* smem) {
    const int tidx = otid();
    const bf16_t* P = reinterpret_cast<const bf16_t*>(p.ws + OFF_P);
    const float2* rope = reinterpret_cast<const float2*>(p.ws + OFF_ROPE);
    const float* KVT = reinterpret_cast<const float*>(p.ws + OFF_KVT);
    bf16_t* YC = reinterpret_cast<bf16_t*>(p.ws + OFF_YCAT);
    bf16_t* sQ = reinterpret_cast<bf16_t*>(smem);
    bf16_t* sK = sQ + 128 * Q_LD;
    bf16_t* sVT = sK + 128 * Q_LD;
    bf16_t* sRT = sVT + 64 * KT_LD;
    bf16_t* sS = sQ;
    const int tid = tidx, wv = tid >> 6, lane = tid & 63, fr = lane & 15, fq = lane >> 4;
    const float* gng = p.in[21];
    const float* gnb = p.in[22];
    for (int u = blockIdx.x; u < 2048; u += gridDim.x) {
        const int n = u & 63, h = (u >> 6) & 7, b = u >> 9;
        const float lg = ret_lg(h);
        {
            const int c = tid >> 1, i0 = (tid & 1) * 16;
            const int sidx = n * 128 + c;
            const size_t tok = (size_t)b * SEQ + sidx;
            const bf16_t* qr = P + tok * 3072 + 1024 + h * 64;
            const bf16_t* kr = P + tok * 3072 + 1536 + h * 64;
            const bf16_t* vr = P + tok * 3072 + 2048 + h * 64;
#pragma unroll
            for (int i = 0; i < 16; ++i) {
                float2 cs = rope[sidx * 32 + i0 + i];
                float q1 = bf2f(qr[i0 + i]), q2 = bf2f(qr[32 + i0 + i]);
                sQ[c * Q_LD + i0 + i] = f2bf(q1 * cs.x - q2 * cs.y);
                sQ[c * Q_LD + 32 + i0 + i] = f2bf(q1 * cs.y + q2 * cs.x);
                float k1 = bf2f(kr[i0 + i]), k2 = bf2f(kr[32 + i0 + i]);
                sK[c * Q_LD + i0 + i] = f2bf((k1 * cs.x - k2 * cs.y) * 0.125f);
                sK[c * Q_LD + 32 + i0 + i] = f2bf((k1 * cs.y + k2 * cs.x) * 0.125f);
                sVT[(i0 + i) * KT_LD + c] = vr[i0 + i];
                sVT[(32 + i0 + i) * KT_LD + c] = vr[32 + i0 + i];
            }
            const float* rp = KVT + (size_t)u * 4096;
#pragma unroll
            for (int i = 0; i < 16; ++i) {
                int idx = tid * 16 + i;
                sRT[(idx >> 6) * Q_LD + (idx & 63)] = f2bf(rp[idx]);
            }
        }
        __syncthreads();
        f32x4 accs[2][8], accc[2][4];
#pragma unroll
        for (int m = 0; m < 2; ++m) {
#pragma unroll
            for (int nn = 0; nn < 8; ++nn) accs[m][nn] = (f32x4){0.f, 0.f, 0.f, 0.f};
#pragma unroll
            for (int nn = 0; nn < 4; ++nn) accc[m][nn] = (f32x4){0.f, 0.f, 0.f, 0.f};
        }
#pragma unroll
        for (int ks = 0; ks < 2; ++ks) {
            bf16x8 af[2];
#pragma unroll
            for (int m = 0; m < 2; ++m) af[m] = *reinterpret_cast<const bf16x8*>(sQ + (wv * 32 + m * 16 + fr) * Q_LD + ks * 32 + fq * 8);
#pragma unroll
            for (int nn = 0; nn < 8; ++nn) {
                if (nn <= 2 * wv + 1) {
                    bf16x8 bfr = *reinterpret_cast<const bf16x8*>(sK + (nn * 16 + fr) * Q_LD + ks * 32 + fq * 8);
#pragma unroll
                    for (int m = 0; m < 2; ++m) accs[m][nn] = __builtin_amdgcn_mfma_f32_16x16x32_bf16(af[m], bfr, accs[m][nn], 0, 0, 0);
                }
            }
#pragma unroll
            for (int nn = 0; nn < 4; ++nn) {
                bf16x8 bfr = *reinterpret_cast<const bf16x8*>(sRT + (nn * 16 + fr) * Q_LD + ks * 32 + fq * 8);
#pragma unroll
                for (int m = 0; m < 2; ++m) accc[m][nn] = __builtin_amdgcn_mfma_f32_16x16x32_bf16(af[m], bfr, accc[m][nn], 0, 0, 0);
            }
        }
        __syncthreads();
        bf16_t* mS = sS + wv * 32 * KT_LD;
#pragma unroll
        for (int m = 0; m < 2; ++m)
#pragma unroll
            for (int nn = 0; nn < 8; ++nn)
#pragma unroll
                for (int j = 0; j < 4; ++j) {
                    int il = m * 16 + fq * 4 + j;
                    int ig = wv * 32 + il, jg = nn * 16 + fr;
                    float v = 0.f;
                    if (nn <= 2 * wv + 1 && ig >= jg) v = accs[m][nn][j] * __expf((float)(ig - jg) * lg);
                    mS[il * KT_LD + jg] = f2bf(v);
                }
        __syncthreads();
        f32x4 acco[2][4];
#pragma unroll
        for (int m = 0; m < 2; ++m)
#pragma unroll
            for (int nn = 0; nn < 4; ++nn) acco[m][nn] = (f32x4){0.f, 0.f, 0.f, 0.f};
#pragma unroll
        for (int ks = 0; ks < 4; ++ks) {
            if (ks <= wv) {
                bf16x8 af[2];
#pragma unroll
                for (int m = 0; m < 2; ++m) af[m] = *reinterpret_cast<const bf16x8*>(mS + (m * 16 + fr) * KT_LD + ks * 32 + fq * 8);
#pragma unroll
                for (int nn = 0; nn < 4; ++nn) {
                    bf16x8 bfr = *reinterpret_cast<const bf16x8*>(sVT + (nn * 16 + fr) * KT_LD + ks * 32 + fq * 8);
#pragma unroll
                    for (int m = 0; m < 2; ++m) acco[m][nn] = __builtin_amdgcn_mfma_f32_16x16x32_bf16(af[m], bfr, acco[m][nn], 0, 0, 0);
                }
            }
        }
#pragma unroll
        for (int m = 0; m < 2; ++m)
#pragma unroll
            for (int j = 0; j < 4; ++j) {
                int ig = wv * 32 + m * 16 + fq * 4 + j;
                float xi = __expf((float)(ig + 1) * lg);
                float o[4];
                float sm = 0.f;
#pragma unroll
                for (int nn = 0; nn < 4; ++nn) { o[nn] = acco[m][nn][j] + xi * accc[m][nn][j]; sm += o[nn]; }
                sm += __shfl_xor(sm, 1); sm += __shfl_xor(sm, 2); sm += __shfl_xor(sm, 4); sm += __shfl_xor(sm, 8);
                float mean = sm * (1.0f / 64.0f);
                float sq = 0.f;
#pragma unroll
                for (int nn = 0; nn < 4; ++nn) { float d = o[nn] - mean; sq += d * d; }
                sq += __shfl_xor(sq, 1); sq += __shfl_xor(sq, 2); sq += __shfl_xor(sq, 4); sq += __shfl_xor(sq, 8);
                float rstd = rsqrtf(sq * (1.0f / 64.0f) + 1e-5f);
                size_t tok = (size_t)b * SEQ + n * 128 + ig;
#pragma unroll
                for (int nn = 0; nn < 4; ++nn) {
                    int e = h * 64 + nn * 16 + fr;
                    float y = (o[nn] - mean) * rstd * gng[e] + gnb[e];
                    float gr = bf2f(P[tok * 3072 + 2560 + e]);
                    YC[tok * 1024 + 512 + e] = f2bf(siluf_(gr) * y);
                }
            }
        __syncthreads();
    }
}

#define N_PHASES 21
__device__ __forceinline__ void run_phase(const Params& p, int ph, unsigned char* smem) {
    bf16_t* sm16 = reinterpret_cast<bf16_t*>(smem);
    const bf16_t* W = reinterpret_cast<const bf16_t*>(p.ws + OFF_W);
    bf16_t* ACTB = reinterpret_cast<bf16_t*>(p.ws + OFF_ACTB);
    bf16_t* PB = reinterpret_cast<bf16_t*>(p.ws + OFF_P);
    bf16_t* YC = reinterpret_cast<bf16_t*>(p.ws + OFF_YCAT);
    switch (ph) {
        case 0: phase_pre(p, smem); break;
        case 1: { EpiStoreBf16 e{PB, 2304}; gemm_phase(ACTB, DM, W + WE_IN0, DM, DM, NT / 128, 18, e, sm16); } break;
        case 2: phase_l0_prep(p); break;
        case 3: phase_l0_lora(p, sm16); break;
        case 4: phase_rwkv_T(p, smem); break;
        case 5: phase_rwkv_seq(p, smem); break;
        case 6: { EpiOut e{p.in[0], p.out}; gemm_phase(YC, DM, W + WE_OUT0, DM, DM, NT / 128, 8, e, sm16); } break;
        case 7: phase_ln_route(p, 0, p.out); break;
        case 8: phase_exp1(p, 0, sm16); break;
        case 9: phase_exp2(p, 0, sm16); break;
        case 10: phase_ln_ffn(p, 0, p.out, true); break;
        case 11: { EpiStoreBf16 e{PB, 3072}; gemm_phase(ACTB, DM, W + WE_IN1, DM, DM, NT / 128, 24, e, sm16); } break;
        case 12: phase_l1_conv(p, smem); break;
        case 13: phase_ret_kv(p, smem); break;
        case 14: phase_ret_scan(p); break;
        case 15: phase_ret_out(p, smem); break;
        case 16: { EpiOut e{p.out, p.out}; gemm_phase(YC, DM, W + WE_OUT1, DM, DM, NT / 128, 8, e, sm16); } break;
        case 17: phase_ln_route(p, 1, p.out); break;
        case 18: phase_exp1(p, 1, sm16); break;
        case 19: phase_exp2(p, 1, sm16); break;
        case 20: phase_ln_ffn(p, 1, p.out, false); break;
        default: break;
    }
}

#define SMEM_BYTES 114688
__global__ void __launch_bounds__(NTHREADS) k_mega(Params p) {
    extern __shared__ __attribute__((aligned(16))) unsigned char smem[];
    cg::grid_group grid = cg::this_grid();
#pragma nounroll
    for (int ph = 0; ph < N_PHASES; ++ph) {
        int phv = ph;
        asm volatile("" : "+s"(phv));
        run_phase(p, phv, smem);
        if (ph < N_PHASES - 1) grid.sync();
    }
}

extern "C" void kernel_launch(void* const* d_in, const int* in_sizes, int n_in, void* d_out, int out_size, void* d_ws, size_t ws_size,
                              hipStream_t stream) {
    static int grid_blocks = 0;
    if (!grid_blocks) {
        int dev = 0, cus = 0, per_cu = 0;
        hipGetDevice(&dev);
        hipDeviceGetAttribute(&cus, hipDeviceAttributeMultiprocessorCount, dev);
        hipFuncSetAttribute((const void*)k_mega, hipFuncAttributeMaxDynamicSharedMemorySize, SMEM_BYTES);
        hipOccupancyMaxActiveBlocksPerMultiprocessor(&per_cu, (const void*)k_mega, NTHREADS, SMEM_BYTES);
        if (per_cu < 1) per_cu = 1;
        grid_blocks = cus * per_cu;
    }
    Params p{};
    for (int i = 0; i < 35; ++i) p.in[i] = (const float*)d_in[i];
    p.out = (float*)d_out;
    p.ws = (unsigned char*)d_ws;
    void* args[] = {&p};
    hipError_t e = hipLaunchCooperativeKernel((void*)k_mega, dim3(grid_blocks), dim3(NTHREADS), args, SMEM_BYTES, stream);
    if (e != hipSuccess) fprintf(stderr, "cooperative launch failed: %s (grid %d)\n", hipGetErrorString(e), grid_blocks);
}
```

```cpp
#include <hip/hip_runtime.h>
#include <hip/hip_cooperative_groups.h>
#include <stdint.h>
#include <stdio.h>
namespace cg = cooperative_groups;

typedef unsigned short bf16_t;
typedef short bf16x8 __attribute__((ext_vector_type(8)));
typedef float f32x4 __attribute__((ext_vector_type(4)));

#define NT 32768
#define SEQ 8192
#define DM 1024
#define NTHREADS 512
#define NWAVES 8
#define ALPHA_F 1.41421356237309515f

#define MIB (1024ull * 1024ull)
#define OFF_CTRL 0ull
#define OFF_W (1ull * MIB)
#define OFF_ROPE (65ull * MIB)
#define OFF_ACTB (68ull * MIB)
#define OFF_AA (OFF_ACTB)
#define OFF_GG (OFF_ACTB + 32ull * MIB)
#define OFF_P (132ull * MIB)
#define OFF_LORA (OFF_P + 144ull * MIB)
#define OFF_POOLED (OFF_P + 160ull * MIB)
#define OFF_FS (OFF_P)
#define OFF_HBUF (OFF_P + 128ull * MIB)
#define OFF_YCAT (324ull * MIB)
#define OFF_LOGW (388ull * MIB)
#define OFF_LTOK (452ull * MIB)
#define OFF_LGATE (456ull * MIB)
#define OFF_KVT (460ull * MIB)
#define WE_IN0 0
#define WE_OUT0 2359296
#define WE_IN1 3407872
#define WE_OUT1 6553600
#define WE_W13 7602176
#define WE_W2 24379392
#define WE_LW2 32768000
#define WE_LA2 32800768
#define WE_LG2 32833536
#define WE_POOL 32899072

struct Params {
    const float* in[35];
    float* out;
    unsigned char* ws;
    int wave;
    int pad_;
};

__device__ __forceinline__ bf16_t f2bf(float f) {
    unsigned u = __float_as_uint(f);
    u += 0x7fffu + ((u >> 16) & 1u);
    return (bf16_t)(u >> 16);
}
__device__ __forceinline__ float bf2f(bf16_t h) { return __uint_as_float(((unsigned)h) << 16); }
__device__ __forceinline__ unsigned pack2(float a, float b) { return (unsigned)f2bf(a) | ((unsigned)f2bf(b) << 16); }
__device__ __forceinline__ void unpack8(const uint4 v, float (&o)[8]) {
    o[0] = __uint_as_float(v.x << 16); o[1] = __uint_as_float(v.x & 0xffff0000u);
    o[2] = __uint_as_float(v.y << 16); o[3] = __uint_as_float(v.y & 0xffff0000u);
    o[4] = __uint_as_float(v.z << 16); o[5] = __uint_as_float(v.z & 0xffff0000u);
    o[6] = __uint_as_float(v.w << 16); o[7] = __uint_as_float(v.w & 0xffff0000u);
}
#define DPP_ADD(v, CTRL) ((v) + __int_as_float(__builtin_amdgcn_update_dpp(0, __float_as_int(v), (CTRL), 0xF, 0xF, false)))
__device__ __forceinline__ float row16_sum(float v) {
    v = DPP_ADD(v, 0xB1);
    v = DPP_ADD(v, 0x4E);
    v = DPP_ADD(v, 0x141);
    v = DPP_ADD(v, 0x140);
    return v;
}
__device__ __forceinline__ float wave_sum(float v) {
    v = row16_sum(v);
    const int iv = __float_as_int(v);
    const float s0 = __int_as_float(__builtin_amdgcn_readlane(iv, 0)), s1 = __int_as_float(__builtin_amdgcn_readlane(iv, 16));
    const float s2 = __int_as_float(__builtin_amdgcn_readlane(iv, 32)), s3 = __int_as_float(__builtin_amdgcn_readlane(iv, 48));
    return (s0 + s1) + (s2 + s3);
}
__device__ __forceinline__ float sigmoidf_(float x) { return 1.0f / (1.0f + __expf(-x)); }
__device__ __forceinline__ float siluf_(float x) { return x / (1.0f + __expf(-x)); }
__device__ __forceinline__ float quad_sum(float v) {
    int iv = __float_as_int(v);
    float a = __int_as_float(__builtin_amdgcn_update_dpp(0, iv, 0xB1, 0xF, 0xF, false));
    v += a;
    iv = __float_as_int(v);
    float b = __int_as_float(__builtin_amdgcn_update_dpp(0, iv, 0x4E, 0xF, 0xF, false));
    return v + b;
}

__device__ __forceinline__ int obid() { int b = (int)blockIdx.x; asm volatile("" : "+s"(b)); return b; }
__device__ __forceinline__ int ogdim() { int b = (int)gridDim.x; asm volatile("" : "+s"(b)); return b; }
__device__ __forceinline__ int otid(int wave) { int t = wave * 64 + (int)__builtin_amdgcn_mbcnt_hi(~0u, __builtin_amdgcn_mbcnt_lo(~0u, 0u)); asm volatile("" : "+v"(t)); return t; }
template <bool GATHER, class Epi>
__device__ __forceinline__ void gemm_tile(const bf16_t* __restrict__ A, int lda, const int* __restrict__ gidx, int gcount,
                                          const bf16_t* __restrict__ Bt, int ldb, int K, int row0, int col0, const Epi& epi,
                                          bf16_t* smem, int wave) {
    const int tidx = otid(wave);
    const int tid = tidx, wid = tid >> 6, lane = tid & 63, wr = wid >> 1, wc = wid & 1, fr = lane & 15, fq = lane >> 4;
    bf16_t* SA = smem;
    bf16_t* SB = smem + 256 * 32;
    const bf16_t* ap[2];
    const bf16_t* bp;
#pragma unroll
    for (int i = 0; i < 2; ++i) {
        int b = tid * 16 + i * 8192;
        int r = b >> 6, c = (b & 63) >> 1;
        int ar = row0 + r;
        if (GATHER) {
            int gi = ar < gcount ? ar : gcount - 1;
            ar = gidx[gi] >> 1;
        }
        ap[i] = A + (size_t)ar * lda + c;
    }
    {
        int b = tid * 16;
        int r = b >> 6, c = (b & 63) >> 1;
        bp = Bt + (size_t)(col0 + r) * ldb + c;
    }
    f32x4 acc[4][4];
#pragma unroll
    for (int m = 0; m < 4; ++m)
#pragma unroll
        for (int n = 0; n < 4; ++n) acc[m][n] = (f32x4){0.f, 0.f, 0.f, 0.f};
    for (int kt = 0; kt < K; kt += 32) {
#pragma unroll
        for (int i = 0; i < 2; ++i) {
            int b = tid * 16 + i * 8192;
            __builtin_amdgcn_global_load_lds((const unsigned*)(ap[i] + kt), (__attribute__((address_space(3))) unsigned*)((char*)SA + b), 16, 0, 0);
        }
        __builtin_amdgcn_global_load_lds((const unsigned*)(bp + kt), (__attribute__((address_space(3))) unsigned*)((char*)SB + tid * 16), 16, 0, 0);
        asm volatile("s_waitcnt vmcnt(0)" ::: "memory");
        __syncthreads();
        bf16x8 af[4], bfr[4];
#pragma unroll
        for (int m = 0; m < 4; ++m) af[m] = *reinterpret_cast<const bf16x8*>((const char*)SA + (wr * 64 + m * 16 + fr) * 64 + fq * 16);
#pragma unroll
        for (int n = 0; n < 4; ++n) bfr[n] = *reinterpret_cast<const bf16x8*>((const char*)SB + (wc * 64 + n * 16 + fr) * 64 + fq * 16);
#pragma unroll
        for (int m = 0; m < 4; ++m)
#pragma unroll
            for (int n = 0; n < 4; ++n) acc[m][n] = __builtin_amdgcn_mfma_f32_16x16x32_bf16(bfr[n], af[m], acc[m][n], 0, 0, 0);
        __syncthreads();
    }
    epi(acc, row0 + wr * 64, col0 + wc * 64, fr, fq);
}

struct EpiStoreBf16 {
    bf16_t* O; int ldo;
    __device__ __forceinline__ void operator()(f32x4 (&acc)[4][4], int rb, int cb, int fr, int fq) const {
#pragma unroll
        for (int m = 0; m < 4; ++m)
#pragma unroll
            for (int n = 0; n < 4; ++n) {
                int row = rb + m * 16 + fr, col = cb + n * 16 + fq * 4;
                uint2 w; w.x = pack2(acc[m][n][0], acc[m][n][1]); w.y = pack2(acc[m][n][2], acc[m][n][3]);
                *reinterpret_cast<uint2*>(O + (size_t)row * ldo + col) = w;
            }
    }
};
template <int MODE>
struct EpiLora {
    float* Of; bf16_t* Ob; const float* vec; int ldo; int coff;
    __device__ __forceinline__ void operator()(f32x4 (&acc)[4][4], int rb, int cb, int fr, int fq) const {
#pragma unroll
        for (int m = 0; m < 4; ++m)
#pragma unroll
            for (int n = 0; n < 4; ++n) {
                int row = rb + m * 16 + fr, col = cb + n * 16 + fq * 4;
                float v[4];
#pragma unroll
                for (int j = 0; j < 4; ++j) {
                    float a = acc[m][n][j];
                    if (MODE == 0) {
                        float t = -(vec[col + j] + a);
                        float sp = (t > 20.f) ? t : log1pf(__expf(t));
                        float wl = -sp - 0.5f;
                        v[j] = -__expf(wl);
                    } else if (MODE == 1) {
                        v[j] = sigmoidf_(vec[col + j] + a);
                    } else if (MODE == 2) {
                        v[j] = a;
                    } else {
                        v[j] = a * vec[coff + col + j];
                    }
                }
                {
                    uint2 w; w.x = pack2(v[0], v[1]); w.y = pack2(v[2], v[3]);
                    *reinterpret_cast<uint2*>(Ob + (size_t)row * ldo + coff + col) = w;
                }
            }
    }
};
struct EpiOut {
    const float* Xprev; float* X;
    __device__ __forceinline__ void operator()(f32x4 (&acc)[4][4], int rb, int cb, int fr, int fq) const {
#pragma unroll
        for (int m = 0; m < 4; ++m)
#pragma unroll
            for (int n = 0; n < 4; ++n) {
                int row = rb + m * 16 + fr, col = cb + n * 16 + fq * 4;
                float4 xp = *reinterpret_cast<const float4*>(Xprev + (size_t)row * DM + col);
                float4 o;
                o.x = ALPHA_F * xp.x + acc[m][n][0]; o.y = ALPHA_F * xp.y + acc[m][n][1];
                o.z = ALPHA_F * xp.z + acc[m][n][2]; o.w = ALPHA_F * xp.w + acc[m][n][3];
                *reinterpret_cast<float4*>(X + (size_t)row * DM + col) = o;
            }
    }
};
struct EpiExp1 {
    bf16_t* H; int base; int cnt;
    __device__ __forceinline__ void operator()(f32x4 (&acc)[4][4], int rb, int cb, int fr, int fq) const {
#pragma unroll
        for (int m = 0; m < 4; ++m) {
            int li = rb + m * 16 + fr;
            if (li < cnt) {
#pragma unroll
                for (int i = 0; i < 2; ++i) {
                    int hcol = (cb >> 1) + i * 16 + fq * 4;
                    float v[4];
#pragma unroll
                    for (int j = 0; j < 4; ++j) v[j] = siluf_(acc[m][2 * i][j]) * acc[m][2 * i + 1][j];
                    uint2 w; w.x = pack2(v[0], v[1]); w.y = pack2(v[2], v[3]);
                    *reinterpret_cast<uint2*>(H + (size_t)(base + li) * 128 + hcol) = w;
                }
            }
        }
    }
};
struct EpiExp2 {
    bf16_t* FS; const int* ltok; const float* lgate; int cnt;
    __device__ __forceinline__ void operator()(f32x4 (&acc)[4][4], int rb, int cb, int fr, int fq) const {
#pragma unroll
        for (int m = 0; m < 4; ++m) {
            int li = rb + m * 16 + fr;
            if (li < cnt) {
                int pk = ltok[li]; float g = lgate[li];
                int tok = pk >> 1, j = pk & 1;
                bf16_t* o = FS + ((size_t)j * NT + tok) * DM;
#pragma unroll
                for (int n = 0; n < 4; ++n) {
                    int col = cb + n * 16 + fq * 4;
                    uint2 w; w.x = pack2(acc[m][n][0] * g, acc[m][n][1] * g); w.y = pack2(acc[m][n][2] * g, acc[m][n][3] * g);
                    *reinterpret_cast<uint2*>(o + col) = w;
                }
            }
        }
    }
};

namespace pg8 {
#define PG8_LAS __attribute__((address_space(3)))
typedef unsigned short bf16_t;
typedef short bf16x8 __attribute__((ext_vector_type(8)));
typedef float f32x4 __attribute__((ext_vector_type(4)));
typedef unsigned u32x4 __attribute__((ext_vector_type(4)));
constexpr int BM = 256, BK = 64, HALF = 128, HTB = HALF * BK * 2  , STAGE_BYTES = 8 * HTB, NXCD = 8, WGM = 8;

__host__ __device__ __forceinline__ int lds_byte(int r, int c) { const int st = (r >> 4) * 2 + (c >> 5), rr = r & 15, cc = c & 31, ob = rr * 64 + cc * 2; return st * 1024 + (ob ^ (((ob >> 9) & 1) << 5)); }
__host__ __device__ __forceinline__ void stage_rc(int b, int& R, int& C) { const int st = b / 1024, sb = b % 1024, swz = sb ^ (((sb >> 9) & 1) << 5); R = (st >> 1) * 16 + swz / 64; C = (st & 1) * 32 + (swz % 64) / 2; }
__host__ __device__ __forceinline__ int perm32(int rho) { const int n = rho >> 4, i = rho & 15; return 8 * (i >> 2) + 4 * n + (i & 3); }

struct Unit { int pm, pn; };
struct Gemm { const bf16_t* A; const bf16_t* Bt; int M, N, K; };

struct StaticOrder {
    int nM, nN, nwg, G, c;
    __host__ __device__ void init(int M, int N, int G_, int c_) { nM = M / BM; nN = N / BM; nwg = nM * nN; G = G_; c = c_; }
    __host__ __device__ bool next(int i, Unit& u) const {
        const long L = (long)i * G + c; if (L >= nwg) return false;
        int wgid = (int)L; { const int q = nwg / NXCD, r = nwg % NXCD, xcd = wgid % NXCD, off = wgid / NXCD; wgid = (xcd < r ? xcd * (q + 1) : r * (q + 1) + (xcd - r) * q) + off; }
        const int nig = WGM * nN, gid = wgid / nig, fm = gid * WGM, gsz = (nM - fm) < WGM ? (nM - fm) : WGM;
        u.pm = fm + ((wgid % nig) % gsz); u.pn = (wgid % nig) / gsz; return true;
    }
    __device__ __forceinline__ void a_ready(const Unit&) const {}
    __device__ __forceinline__ void done(const Unit&) const {}
};
template <class Epi, class Sched, bool ALIGN_EPI = false, bool SP2 = false>
__device__ __forceinline__ void gemm_phase(PG8_LAS unsigned char* lds, const Gemm g, const Sched& S, const Epi& E, int wave) {
    const int tid = otid(wave), wid = __builtin_amdgcn_readfirstlane(tid >> 6), lane = tid & 63, wr = wid >> 2, wc = wid & 3, fr = lane & 15, fq = lane >> 4;
    const int K = g.K, nt = K / BK;
    unsigned voffA[2], voffB[2];
#pragma unroll
    for (int i = 0; i < 2; ++i) { int R, C; stage_rc(tid * 16 + i * 8192, R, C); const int Rb = Epi::PERM ? ((R & ~31) + perm32(R & 31)) : R;
        voffA[i] = (unsigned)(R * K + C) * 2u; voffB[i] = (unsigned)(Rb * K + C) * 2u; }
    const size_t kstep = (size_t)(BK * 2);
    const size_t hstep = (size_t)HALF * K * 2;
    const size_t tstep = 2 * hstep;
    const unsigned ldsw = (unsigned)wid * 1024u;
    const int aoff = lds_byte(wr * 64 + fr, fq * 8), boff = lds_byte(wc * 32 + fr, fq * 8);
#define PG8_SA(b, h) (((b) * 2 + (h)) * HTB)
#define PG8_SB(b, h) ((4 + (b) * 2 + (h)) * HTB)
#define PG8_STAGE(bufoff, gbase, voff) do { _Pragma("unroll") for (int _i = 0; _i < 2; ++_i) \
        __builtin_amdgcn_global_load_lds((const unsigned*)((const char*)(gbase) + (voff)[_i]), (PG8_LAS unsigned*)(lds + (bufoff) + ldsw + _i * 8192), 16, 0, 0); } while (0)
#define PG8_LDA(dst, b, h) do { _Pragma("unroll") for (int m = 0; m < 4; ++m) _Pragma("unroll") for (int k = 0; k < 2; ++k) dst[m][k] = *(const PG8_LAS bf16x8*)(lds + PG8_SA(b, h) + aoff + m * 2048 + k * 1024); } while (0)
#define PG8_LDB(dst, b, h) do { _Pragma("unroll") for (int n = 0; n < 2; ++n) _Pragma("unroll") for (int k = 0; k < 2; ++k) dst[n][k] = *(const PG8_LAS bf16x8*)(lds + PG8_SB(b, h) + boff + n * 2048 + k * 1024); } while (0)
#define PG8_MMA(ai, bj, At, Bt) do { __builtin_amdgcn_s_setprio(1); _Pragma("unroll") for (int m = 0; m < 4; ++m) _Pragma("unroll") for (int n = 0; n < 2; ++n) _Pragma("unroll") for (int k = 0; k < 2; ++k) \
        acc[ai][bj][m][n] = __builtin_amdgcn_mfma_f32_16x16x32_bf16(Bt[n][k], At[m][k], acc[ai][bj][m][n], 0, 0, 0); __builtin_amdgcn_s_setprio(0); } while (0)
#define PG8_WAIT_V(n) asm volatile("s_waitcnt vmcnt(" #n ")" ::: "memory")
#define PG8_WAIT_L(n) asm volatile("s_waitcnt lgkmcnt(" #n ")" ::: "memory")
#define PG8_BAR __builtin_amdgcn_s_barrier()
#define PG8_SCHED __builtin_amdgcn_sched_barrier(0)
    Unit cur, nxt; int ui = 0;
    if (!S.next(0, cur)) return;
    f32x4 acc[2][2][4][2];
#pragma unroll
    for (int a = 0; a < 2; ++a)
#pragma unroll
        for (int b = 0; b < 2; ++b)
#pragma unroll
            for (int m = 0; m < 4; ++m)
#pragma unroll
                for (int n = 0; n < 2; ++n) acc[a][b][m][n] = (f32x4){0.f, 0.f, 0.f, 0.f};
    bf16x8 At[4][2], B0[2][2], B1[2][2];
    const char* cA = (const char*)g.A + (size_t)cur.pm * tstep; const char* cB = (const char*)g.Bt + (size_t)cur.pn * tstep;
    S.a_ready(cur);
    if constexpr (SP2) {
        PG8_STAGE(PG8_SB(0, 0), cB, voffB); PG8_STAGE(PG8_SB(0, 1), cB + hstep, voffB); PG8_STAGE(PG8_SA(0, 0), cA, voffA); PG8_STAGE(PG8_SA(0, 1), cA + hstep, voffA);
        if (wr == 1) PG8_BAR;
        PG8_WAIT_V(2); PG8_BAR;
        PG8_STAGE(PG8_SB(1, 0), cB + kstep, voffB); PG8_STAGE(PG8_SA(1, 0), cA + kstep, voffA); PG8_STAGE(PG8_SB(1, 1), cB + hstep + kstep, voffB);
        PG8_WAIT_V(6); PG8_BAR;
    } else {
        PG8_STAGE(PG8_SB(0, 0), cB, voffB); PG8_STAGE(PG8_SA(0, 0), cA, voffA); PG8_STAGE(PG8_SB(0, 1), cB + hstep, voffB); PG8_STAGE(PG8_SA(0, 1), cA + hstep, voffA);
        if (wr == 1) PG8_BAR;
        PG8_WAIT_V(4); PG8_BAR;
        PG8_STAGE(PG8_SB(1, 0), cB + kstep, voffB); PG8_STAGE(PG8_SA(1, 0), cA + kstep, voffA); PG8_STAGE(PG8_SB(1, 1), cB + hstep + kstep, voffB);
        PG8_WAIT_V(6); PG8_BAR;
    }
    for (;;) {
        const bool has_next = S.next(ui + 1, nxt);
        const char* nA = has_next ? (const char*)g.A + (size_t)nxt.pm * tstep : cA; const char* nB = has_next ? (const char*)g.Bt + (size_t)nxt.pn * tstep : cB;
        for (int t = 0; t < nt; t += 2) {
            const bool last = (t == nt - 2);
            const char* a1 = cA + (size_t)(t + 1) * kstep;
            const char* a2 = last ? nA : cA + (size_t)(t + 2) * kstep; const char* b2 = last ? nB : cB + (size_t)(t + 2) * kstep;
            const char* a3 = a2 + kstep; const char* b3 = b2 + kstep;
            if (last && has_next) S.a_ready(nxt);
            if constexpr (SP2) {
            PG8_LDB(B0, 0, 0); PG8_LDB(B1, 0, 1); PG8_SCHED; PG8_LDA(At, 0, 0); PG8_STAGE(PG8_SA(1, 1), a1 + hstep, voffA);
            PG8_WAIT_V(8); PG8_WAIT_L(0); PG8_BAR; PG8_MMA(0, 0, At, B0); PG8_MMA(0, 1, At, B1); PG8_BAR; PG8_SCHED;
            PG8_LDA(At, 0, 1); PG8_STAGE(PG8_SB(0, 0), b2, voffB); PG8_STAGE(PG8_SB(0, 1), b2 + hstep, voffB); PG8_STAGE(PG8_SA(0, 0), a2, voffA);
            PG8_WAIT_V(8); PG8_WAIT_L(0); PG8_BAR; PG8_MMA(1, 0, At, B0); PG8_MMA(1, 1, At, B1); PG8_BAR; PG8_SCHED;
            PG8_LDB(B0, 1, 0); PG8_LDB(B1, 1, 1); PG8_SCHED; PG8_LDA(At, 1, 0); PG8_STAGE(PG8_SA(0, 1), a2 + hstep, voffA);
            PG8_WAIT_V(8); PG8_WAIT_L(0); PG8_BAR; PG8_MMA(0, 0, At, B0); PG8_MMA(0, 1, At, B1); PG8_BAR; PG8_SCHED;
            PG8_LDA(At, 1, 1); PG8_STAGE(PG8_SB(1, 0), b3, voffB); PG8_STAGE(PG8_SB(1, 1), b3 + hstep, voffB); PG8_STAGE(PG8_SA(1, 0), a3, voffA);
            PG8_WAIT_V(8); PG8_WAIT_L(0); PG8_BAR; PG8_MMA(1, 0, At, B0); PG8_MMA(1, 1, At, B1); PG8_BAR; PG8_SCHED;
            } else {
            PG8_LDB(B0, 0, 0); PG8_SCHED; PG8_LDA(At, 0, 0); PG8_STAGE(PG8_SA(1, 1), a1 + hstep, voffA);
            PG8_WAIT_L(8); PG8_BAR; PG8_WAIT_L(0); PG8_MMA(0, 0, At, B0); PG8_BAR; PG8_SCHED;
            PG8_LDB(B1, 0, 1); PG8_STAGE(PG8_SB(0, 0), b2, voffB);
            PG8_BAR; PG8_WAIT_L(0); PG8_MMA(0, 1, At, B1); PG8_BAR;
            PG8_LDA(At, 0, 1); PG8_STAGE(PG8_SA(0, 0), a2, voffA);
            PG8_BAR; PG8_WAIT_L(0); PG8_MMA(1, 0, At, B0); PG8_BAR; PG8_SCHED;
            PG8_STAGE(PG8_SB(0, 1), b2 + hstep, voffB);
            PG8_WAIT_V(6); PG8_BAR; PG8_MMA(1, 1, At, B1); PG8_BAR;
            PG8_LDB(B0, 1, 0); PG8_SCHED; PG8_LDA(At, 1, 0); PG8_STAGE(PG8_SA(0, 1), a2 + hstep, voffA);
            PG8_WAIT_L(8); PG8_BAR; PG8_WAIT_L(0); PG8_MMA(0, 0, At, B0); PG8_BAR; PG8_SCHED;
            PG8_LDB(B1, 1, 1); PG8_STAGE(PG8_SB(1, 0), b3, voffB);
            PG8_BAR; PG8_WAIT_L(0); PG8_MMA(0, 1, At, B1); PG8_BAR;
            PG8_LDA(At, 1, 1); PG8_STAGE(PG8_SA(1, 0), a3, voffA);
            PG8_BAR; PG8_WAIT_L(0); PG8_MMA(1, 0, At, B0); PG8_BAR; PG8_SCHED;
            PG8_STAGE(PG8_SB(1, 1), b3 + hstep, voffB);
            PG8_WAIT_V(6); PG8_BAR; PG8_MMA(1, 1, At, B1); PG8_BAR;
            }
        }
        if constexpr (ALIGN_EPI) { if (wr == 0) PG8_BAR; }
        if constexpr (!Epi::AFTER_DRAIN) { E(acc, cur, wr, wc, fr, fq); S.done(cur); }
        if (!has_next) break;
#pragma unroll
        for (int a = 0; a < 2; ++a)
#pragma unroll
            for (int b = 0; b < 2; ++b)
#pragma unroll
                for (int m = 0; m < 4; ++m)
#pragma unroll
                    for (int n = 0; n < 2; ++n) acc[a][b][m][n] = (f32x4){0.f, 0.f, 0.f, 0.f};
        cur = nxt; cA = nA; cB = nB; ++ui;
        if constexpr (ALIGN_EPI) { if (wr == 1) PG8_BAR; }
    }
    PG8_WAIT_V(0);
    if constexpr (!ALIGN_EPI) { if (wr == 0) PG8_BAR; }
    PG8_BAR;
    if constexpr (Epi::AFTER_DRAIN) { E.fused(acc, cur, wr, wc, fr, fq, lds, wid, lane); S.done(cur); }
#undef PG8_SA
#undef PG8_SB
#undef PG8_STAGE
#undef PG8_LDA
#undef PG8_LDB
#undef PG8_MMA
#undef PG8_WAIT_V
#undef PG8_WAIT_L
#undef PG8_BAR
#undef PG8_SCHED
}
}
struct PEpiBf16 {
    static constexpr bool PERM = true, AFTER_DRAIN = false;
    bf16_t* O; int ldo;
    __device__ __forceinline__ void operator()(const pg8::f32x4 (&acc)[2][2][4][2], const pg8::Unit& u, int wr, int wc, int fr, int fq) const {
        const int row0 = u.pm * 256 + wr * 64 + fr, col0 = u.pn * 256 + wc * 32 + 8 * fq;
#pragma unroll
        for (int ai = 0; ai < 2; ++ai)
#pragma unroll
            for (int m = 0; m < 4; ++m) {
                bf16_t* rowp = O + (size_t)(row0 + ai * 128 + m * 16) * ldo + col0;
#pragma unroll
                for (int bj = 0; bj < 2; ++bj) {
                    const pg8::f32x4 v0 = acc[ai][bj][m][0], v1 = acc[ai][bj][m][1];
                    uint4 w; w.x = pack2(v0[0], v0[1]); w.y = pack2(v0[2], v0[3]); w.z = pack2(v1[0], v1[1]); w.w = pack2(v1[2], v1[3]);
                    *reinterpret_cast<uint4*>(rowp + bj * 128) = w;
                }
            }
    }
};
struct PEpiOut {
    static constexpr bool PERM = false, AFTER_DRAIN = false;
    const float* Xprev; float* X;
    __device__ __forceinline__ void operator()(const pg8::f32x4 (&acc)[2][2][4][2], const pg8::Unit& u, int wr, int wc, int fr, int fq) const {
        const int row0 = u.pm * 256 + wr * 64 + fr, col0 = u.pn * 256 + wc * 32 + 4 * fq;
#pragma unroll
        for (int ai = 0; ai < 2; ++ai)
#pragma unroll
            for (int m = 0; m < 4; ++m) {
                const size_t ro = (size_t)(row0 + ai * 128 + m * 16) * DM + col0;
#pragma unroll
                for (int bj = 0; bj < 2; ++bj)
#pragma unroll
                    for (int n = 0; n < 2; ++n) {
                        const size_t o = ro + bj * 128 + n * 16;
                        float4 xp = *reinterpret_cast<const float4*>(Xprev + o);
                        const pg8::f32x4 a = acc[ai][bj][m][n];
                        float4 r;
                        r.x = ALPHA_F * xp.x + a[0]; r.y = ALPHA_F * xp.y + a[1]; r.z = ALPHA_F * xp.z + a[2]; r.w = ALPHA_F * xp.w + a[3];
                        *reinterpret_cast<float4*>(X + o) = r;
                    }
            }
    }
};
template <class Epi>
__device__ __forceinline__ void big_gemm(const bf16_t* A, const bf16_t* Bt, int M, int N, int K, const Epi& e, unsigned char* smem, int wave) {
    pg8::Gemm g{A, Bt, M, N, K};
    pg8::StaticOrder S;
    S.init(M, N, ogdim(), obid());
    pg8::gemm_phase<Epi, pg8::StaticOrder, false, false>((PG8_LAS unsigned char*)smem, g, S, e, wave);
}

__device__ __forceinline__ void tconv_tile(const float* __restrict__ src, int N, bf16_t* __restrict__ dst, int ldd, int k0, int n0,
                                           int mode, float* tile  , int tid) {
#pragma unroll
    for (int i = 0; i < 8; ++i) {
        int r = i * 8 + (tid >> 6), c = tid & 63;
        tile[r * 65 + c] = src[(size_t)(k0 + r) * N + n0 + c];
    }
    __syncthreads();
#pragma unroll
    for (int i = 0; i < 8; ++i) {
        int nn = i * 8 + (tid >> 6), kk = tid & 63;
        int n = n0 + nn;
        int drow = n;
        if (mode == 1) drow = (n >> 4) * 32 + (n & 15);
        else if (mode == 2) drow = (n >> 4) * 32 + 16 + (n & 15);
        dst[(size_t)drow * ldd + k0 + kk] = f2bf(tile[kk * 65 + nn]);
    }
    __syncthreads();
}

__device__ __forceinline__ void phase_pre(const Params& p, unsigned char* smem) {
    const int tidx = otid(p.wave);
    float* tile = reinterpret_cast<float*>(smem);
    bf16_t* W = reinterpret_cast<bf16_t*>(p.ws + OFF_W);
    if (obid() == 0 && tidx < 64) reinterpret_cast<int*>(p.ws + OFF_CTRL)[tidx] = 0;
    constexpr int T0 = 576, T1 = 256, T2 = 768, T3 = 256, T4 = 2048, T5 = 2048, T6 = 2048, T7 = 8, T8 = 8, T9 = 16, T10 = 16;
    constexpr int TOT = T0 + T1 + T2 + T3 + T4 + T5 + T6 + T7 + T8 + T9 + T10;
    for (int u = obid(); u < TOT; u += ogdim()) {
        int v = u;
        const float* src; bf16_t* dst; int K, N, mode = 0, tk, tn;
        if (v < T0) { src = p.in[1]; K = 1024; N = 2304; dst = W + WE_IN0; tk = v / 36; tn = v % 36; }
        else if ((v -= T0) < T1) { src = p.in[15]; K = 1024; N = 1024; dst = W + WE_OUT0; tk = v / 16; tn = v % 16; }
        else if ((v -= T1) < T2) { src = p.in[16]; K = 1024; N = 3072; dst = W + WE_IN1; tk = v / 48; tn = v % 48; }
        else if ((v -= T2) < T3) { src = p.in[23]; K = 1024; N = 1024; dst = W + WE_OUT1; tk = v / 16; tn = v % 16; }
        else if ((v -= T3) < T4) { int mat = v >> 5, w = v & 31; src = p.in[30] + (size_t)mat * 131072; K = 1024; N = 128; dst = W + WE_W13 + (size_t)mat * 262144; mode = 1; tk = w >> 1; tn = w & 1; }
        else if ((v -= T4) < T5) { int mat = v >> 5, w = v & 31; src = p.in[31] + (size_t)mat * 131072; K = 1024; N = 128; dst = W + WE_W13 + (size_t)mat * 262144; mode = 2; tk = w >> 1; tn = w & 1; }
        else if ((v -= T5) < T6) { int mat = v >> 5, w = v & 31; src = p.in[32] + (size_t)mat * 131072; K = 128; N = 1024; dst = W + WE_W2 + (size_t)mat * 131072; tk = w >> 4; tn = w & 15; }
        else if ((v -= T6) < T7) { src = p.in[4]; K = 64; N = 512; dst = W + WE_LW2; tk = 0; tn = v; }
        else if ((v -= T7) < T8) { src = p.in[6]; K = 64; N = 512; dst = W + WE_LA2; tk = 0; tn = v; }
        else if ((v -= T8) < T9) { src = p.in[7]; K = 128; N = 512; dst = W + WE_LG2; tk = v >> 3; tn = v & 7; }
        else { v -= T9; int mat = v >> 2, w = v & 3; src = p.in[13] + (size_t)mat * 16384; K = 128; N = 128; dst = W + WE_POOL + (size_t)mat * 16384; tk = w >> 1; tn = w & 1; }
        tconv_tile(src, N, dst, K, tk * 64, tn * 64, mode, tile, tidx);
    }
    {
        const float4* x4 = reinterpret_cast<const float4*>(p.in[0]);
        uint2* xb = reinterpret_cast<uint2*>(p.ws + OFF_ACTB);
        const size_t n4 = (size_t)NT * DM / 4;
        for (size_t i = (size_t)obid() * NTHREADS + tidx; i < n4; i += (size_t)ogdim() * NTHREADS) {
            float4 v = x4[i];
            uint2 w; w.x = pack2(v.x, v.y); w.y = pack2(v.z, v.w);
            xb[i] = w;
        }
    }
    {
        float2* rope = reinterpret_cast<float2*>(p.ws + OFF_ROPE);
        for (int i = obid() * NTHREADS + tidx; i < SEQ * 32; i += ogdim() * NTHREADS) {
            int pos = i >> 5, k = i & 31;
            float inv = powf(10000.0f, -(float)k / 32.0f);
            float ang = (float)pos * inv;
            float s, c;
            sincosf(ang, &s, &c);
            rope[i] = make_float2(c, s);
        }
    }
}

__device__ __forceinline__ void phase_l0_prep(const Params& p) {
    const int tidx = otid(p.wave);
    const bf16_t* P = reinterpret_cast<const bf16_t*>(p.ws + OFF_P);
    bf16_t* LA = reinterpret_cast<bf16_t*>(p.ws + OFF_LORA);
    bf16_t* PO = reinterpret_cast<bf16_t*>(p.ws + OFF_POOLED);
    const float* mu = p.in[2];
    const int total = NT * 768;
    for (int i = obid() * NTHREADS + tidx; i < total; i += ogdim() * NTHREADS) {
        int tok = i / 768, c = i % 768;
        int s = tok & (SEQ - 1);
        if (c < 256) {
            int col = 1536 + c;
            float pr = bf2f(P[(size_t)tok * 2304 + col]);
            float pv = (s > 0) ? bf2f(P[(size_t)(tok - 1) * 2304 + col]) : 0.f;
            float z = pr + mu[col] * (pv - pr);
            float o;
            if (c < 64) o = tanhf(z);
            else if (c < 128) o = z;
            else o = sigmoidf_(z);
            LA[(size_t)tok * 256 + c] = f2bf(o);
        } else {
            int cc = c - 256;
            int gi = cc >> 7;
            int win = 2 << gi;
            int cnt = (s + 1 < win) ? (s + 1) : win;
            float sum = 0.f;
            for (int j = 0; j < cnt; ++j) sum += bf2f(P[(size_t)(tok - j) * 2304 + 1792 + cc]);
            float u = bf2f(P[(size_t)tok * 2304 + 1792 + cc]);
            PO[(size_t)tok * 512 + cc] = f2bf(sum / (float)cnt - u);
        }
    }
}

__device__ __forceinline__ void phase_l0_lora(const Params& p, bf16_t* smem) {
    const bf16_t* W = reinterpret_cast<const bf16_t*>(p.ws + OFF_W);
    const bf16_t* LA = reinterpret_cast<const bf16_t*>(p.ws + OFF_LORA);
    const bf16_t* PO = reinterpret_cast<const bf16_t*>(p.ws + OFF_POOLED);
    for (int t = obid(); t < 2048; t += ogdim()) {
        int job = t >> 9, w = t & 511;
        if (job == 0) {
            EpiLora<0> e{nullptr, reinterpret_cast<bf16_t*>(p.ws + OFF_LOGW), p.in[3], 512, 0};
            gemm_tile<false>(LA, 256, nullptr, 0, W + WE_LW2, 64, 64, (w >> 2) * 256, (w & 3) * 128, e, smem, p.wave);
        } else if (job == 1) {
            EpiLora<1> e{nullptr, reinterpret_cast<bf16_t*>(p.ws + OFF_AA), p.in[5], 512, 0};
            gemm_tile<false>(LA + 64, 256, nullptr, 0, W + WE_LA2, 64, 64, (w >> 2) * 256, (w & 3) * 128, e, smem, p.wave);
        } else if (job == 2) {
            EpiLora<2> e{nullptr, reinterpret_cast<bf16_t*>(p.ws + OFF_GG), nullptr, 512, 0};
            gemm_tile<false>(LA + 128, 256, nullptr, 0, W + WE_LG2, 128, 128, (w >> 2) * 256, (w & 3) * 128, e, smem, p.wave);
        } else {
            int g = w & 3, tm = w >> 2;
            EpiLora<3> e{nullptr, reinterpret_cast<bf16_t*>(p.ws + OFF_YCAT), p.in[14] - 512, 1024, 512 + g * 128};
            gemm_tile<false>(PO + g * 128, 512, nullptr, 0, W + WE_POOL + g * 16384, 128, 128, tm * 256, 0, e, smem, p.wave);
        }
    }
}

#define RC_LD 72
#define RC_BUF (64 * RC_LD)
#define RC_BYTES (RC_BUF * 2)
#define OFF_TBUF OFF_KVT

__device__ __forceinline__ void mm64(f32x4 (&acc)[2], const bf16_t* A, const bf16_t* Bt, int mt, int nt0, int fr, int fq) {
#pragma unroll
    for (int ks = 0; ks < 2; ++ks) {
        bf16x8 af = *reinterpret_cast<const bf16x8*>(A + (mt * 16 + fr) * RC_LD + ks * 32 + fq * 8);
        bf16x8 bq[2];
#pragma unroll
        for (int n = 0; n < 2; ++n) bq[n] = *reinterpret_cast<const bf16x8*>(Bt + ((nt0 + n) * 16 + fr) * RC_LD + ks * 32 + fq * 8);
#pragma unroll
        for (int n = 0; n < 2; ++n) acc[n] = __builtin_amdgcn_mfma_f32_16x16x32_bf16(af, bq[n], acc[n], 0, 0, 0);
    }
}
template <int MASK>
__device__ __forceinline__ void store_T(bf16_t* dst, const f32x4 (&acc)[2], int mt, int nt0, int fr, int fq) {
#pragma unroll
    for (int n = 0; n < 2; ++n) {
        const int C = (nt0 + n) * 16 + fr, R0 = mt * 16 + fq * 4;
        float v[4];
#pragma unroll
        for (int j = 0; j < 4; ++j) {
            const int R = R0 + j;
            bool keep = true;
            if (MASK == 1) keep = R < C;
            else if (MASK == 2) keep = R <= C;
            else if (MASK == 3) keep = C < R;
            v[j] = keep ? acc[n][j] : 0.f;
        }
        uint2 w; w.x = pack2(v[0], v[1]); w.y = pack2(v[2], v[3]);
        *reinterpret_cast<uint2*>(dst + C * RC_LD + R0) = w;
    }
}
__device__ __forceinline__ void zero_acc(f32x4 (&acc)[2]) {
    acc[0] = (f32x4){0.f, 0.f, 0.f, 0.f};
    acc[1] = (f32x4){0.f, 0.f, 0.f, 0.f};
}

#define OFF_NTB (OFF_P + 144ull * MIB)
#define OFF_S0A (OFF_P + 176ull * MIB)
#define OFF_TB (420ull * MIB)
#define OFF_MB (452ull * MIB)
#define OFF_S0B (484ull * MIB)
#define OFF_WLB (500ull * MIB)
__device__ __forceinline__ bf16_t* s0_ptr(unsigned char* ws, int u) {
    return reinterpret_cast<bf16_t*>(ws + (u < 2048 ? OFF_S0A : OFF_S0B)) + (size_t)(u & 2047) * 4096;
}

template <int MODE>
__device__ __forceinline__ void rwkv_prep(const Params& p, int b, int h, int n, int tid, bf16_t* At, bf16_t* Bt, bf16_t* Kt, bf16_t* Rt,
                                          bf16_t* AtT, bf16_t* BtT, bf16_t* KtT, bf16_t* VT, float* sTot, float* sBC, float* sWL) {
    const int lane = tid & 63, q = tid >> 6;
    const int c = h * 64 + lane;
    const bf16_t* P = reinterpret_cast<const bf16_t*>(p.ws + OFF_P);
    const bf16_t* LOGW = reinterpret_cast<const bf16_t*>(p.ws + OFF_LOGW);
    const bf16_t* AA = reinterpret_cast<const bf16_t*>(p.ws + OFF_AA);
    const float mu_k = p.in[2][512 + c];
    const float kkc = p.in[8][c];
    const float kac = p.in[9][c];
    const float mu_v = p.in[2][1024 + c];
    float mu_r = 0.f, rkc = 0.f;
    if (MODE == 2) { mu_r = p.in[2][c]; rkc = p.in[10][c]; }
    const int s0 = n * 64 + q * 8;
    const size_t tok0 = (size_t)b * SEQ + s0;
    float lw[8], av[8], zk[8], zr[8], zv[8];
    float pk = 0.f, pr = 0.f, pv = 0.f;
    if (s0 > 0) {
        const bf16_t* pp = P + (tok0 - 1) * 2304;
        pk = bf2f(pp[512 + c]); pv = bf2f(pp[1024 + c]);
        if (MODE == 2) pr = bf2f(pp[c]);
    }
#pragma unroll
    for (int i = 0; i < 8; ++i) {
        const bf16_t* pp = P + (tok0 + i) * 2304;
        float k0 = bf2f(pp[512 + c]), v0 = bf2f(pp[1024 + c]);
        zk[i] = k0 + mu_k * (pk - k0); pk = k0;
        zv[i] = v0 + mu_v * (pv - v0); pv = v0;
        if (MODE == 2) { float r0 = bf2f(pp[c]); zr[i] = r0 + mu_r * (pr - r0); pr = r0; }
        lw[i] = bf2f(LOGW[(tok0 + i) * 512 + c]);
        av[i] = bf2f(AA[(tok0 + i) * 512 + c]);
    }
    float lws[8];
    float cs = 0.f;
#pragma unroll
    for (int i = 0; i < 8; ++i) { cs += lw[i]; lws[i] = cs; }
    sTot[q * 64 + lane] = cs;
    __syncthreads();
    float off = 0.f, tot = 0.f;
#pragma unroll
    for (int qq = 0; qq < 8; ++qq) { float tq = sTot[qq * 64 + lane]; if (qq < q) off += tq; tot += tq; }
    float atv[8], btv[8], ktv[8];
#pragma unroll
    for (int i = 0; i < 8; ++i) {
        const int t = q * 8 + i;
        const float L = lws[i] + off;
        float kk = zk[i] * kkc;
        float ss = wave_sum(kk * kk);
        kk *= rsqrtf(fmaxf(ss, 1e-24f));
        const float e_neg = __expf(-L), e_prev = __expf(L - lw[i]);
        const float a = av[i];
        const float at = -kk * e_prev;
        At[t * RC_LD + lane] = f2bf(at);
        const float bt = kk * a * e_neg;
        Bt[t * RC_LD + lane] = f2bf(bt);
        const float kp = zk[i] * (1.0f + (a - 1.0f) * kac);
        const float kt = kp * e_neg;
        Kt[t * RC_LD + lane] = f2bf(kt);
        atv[i] = at; btv[i] = bt; ktv[i] = kt;
        if (MODE == 2) {
            Rt[t * RC_LD + lane] = f2bf(zr[i] * __expf(L));
            const float bc = wave_sum(zr[i] * kp * rkc);
            if (lane == 0) sBC[t] = bc;
        }
    }
    uint4 w0;
    if (MODE == 1) {
        w0.x = pack2(atv[0], atv[1]); w0.y = pack2(atv[2], atv[3]); w0.z = pack2(atv[4], atv[5]); w0.w = pack2(atv[6], atv[7]);
        *reinterpret_cast<uint4*>(AtT + lane * RC_LD + q * 8) = w0;
        w0.x = pack2(btv[0], btv[1]); w0.y = pack2(btv[2], btv[3]); w0.z = pack2(btv[4], btv[5]); w0.w = pack2(btv[6], btv[7]);
        *reinterpret_cast<uint4*>(BtT + lane * RC_LD + q * 8) = w0;
        w0.x = pack2(ktv[0], ktv[1]); w0.y = pack2(ktv[2], ktv[3]); w0.z = pack2(ktv[4], ktv[5]); w0.w = pack2(ktv[6], ktv[7]);
        *reinterpret_cast<uint4*>(KtT + lane * RC_LD + q * 8) = w0;
        if (q == 0) sWL[lane] = __expf(tot);
    }
    w0.x = pack2(zv[0], zv[1]); w0.y = pack2(zv[2], zv[3]); w0.z = pack2(zv[4], zv[5]); w0.w = pack2(zv[6], zv[7]);
    *reinterpret_cast<uint4*>(VT + lane * RC_LD + q * 8) = w0;
}

__device__ __forceinline__ void phase_rwkv_r1(const Params& p, unsigned char* smem) {
    const int tidx = otid(p.wave);
    const int tid = tidx, wv = tid >> 6, lane = tid & 63, fr = lane & 15, fq = lane >> 4, mt = wv >> 1, nt0 = (wv & 1) * 2;
    bf16_t* base = reinterpret_cast<bf16_t*>(smem);
    bf16_t* At = base; bf16_t* Bt = base + RC_BUF; bf16_t* Kt = base + 2 * RC_BUF; bf16_t* AtT = base + 3 * RC_BUF;
    bf16_t* BtT = base + 4 * RC_BUF; bf16_t* KtT = base + 5 * RC_BUF; bf16_t* VT = base + 6 * RC_BUF;
    bf16_t* Tm = base + 7 * RC_BUF; bf16_t* Aak = base + 8 * RC_BUF; bf16_t* PT = base + 9 * RC_BUF;
    bf16_t* AkVT = base + 10 * RC_BUF; bf16_t* QT = base + 11 * RC_BUF;
    float* sTot = reinterpret_cast<float*>(smem + 13 * RC_BYTES);
    float* sWL = sTot + 512;
    bf16_t* Tg = reinterpret_cast<bf16_t*>(p.ws + OFF_TB);
    bf16_t* Mg = reinterpret_cast<bf16_t*>(p.ws + OFF_MB);
    bf16_t* Ng = reinterpret_cast<bf16_t*>(p.ws + OFF_NTB);
    float* WLg = reinterpret_cast<float*>(p.ws + OFF_WLB);
    for (int u = obid(); u < 4096; u += ogdim()) {
        const int b = u >> 10, h = (u >> 7) & 7, n = u & 127;
        bf16_t* R0 = base + 7 * RC_BUF; bf16_t* C0 = base + 8 * RC_BUF; bf16_t* R1 = base + 9 * RC_BUF; bf16_t* C1 = base + 10 * RC_BUF;
        bf16_t* Pm0 = base + 11 * RC_BUF; bf16_t* Pm1 = base + 12 * RC_BUF;
        rwkv_prep<1>(p, b, h, n, tid, At, Bt, Kt, nullptr, AtT, BtT, KtT, VT, sTot, nullptr, sWL);
        __syncthreads();
        f32x4 pacc[2];
        {
            f32x4 acc[2];
            zero_acc(acc);
            mm64(acc, At, Bt, mt, nt0, fr, fq);
            store_T<3>(C0, acc, mt, nt0, fr, fq);
            zero_acc(pacc);
            mm64(pacc, Bt, At, mt, nt0, fr, fq);
#pragma unroll
            for (int nn = 0; nn < 2; ++nn)
#pragma unroll
                for (int j = 0; j < 4; ++j) {
                    const int R = mt * 16 + fq * 4 + j, C = (nt0 + nn) * 16 + fr;
                    pacc[nn][j] = (R < C) ? pacc[nn][j] : 0.f;
                }
            store_T<0>(R0, pacc, mt, nt0, fr, fq);
#pragma unroll
            for (int nn = 0; nn < 2; ++nn)
#pragma unroll
                for (int j = 0; j < 4; ++j) {
                    const int R = mt * 16 + fq * 4 + j, C = (nt0 + nn) * 16 + fr;
                    if (R == C) pacc[nn][j] += 1.0f;
                }
            store_T<0>(Pm0, pacc, mt, nt0, fr, fq);
        }
        __syncthreads();
#pragma unroll 1
        for (int j = 1; j <= 5; ++j) {
            f32x4 acc[2];
            if (j < 5) {
                zero_acc(acc);
                mm64(acc, C0, R0, mt, nt0, fr, fq);
                store_T<0>(R1, acc, mt, nt0, fr, fq);
            }
            zero_acc(acc);
            mm64(acc, R0, C0, mt, nt0, fr, fq);
            store_T<0>(C1, acc, mt, nt0, fr, fq);
            __syncthreads();
            zero_acc(acc);
            mm64(acc, C1, Pm0, mt, nt0, fr, fq);
            pacc[0] += acc[0]; pacc[1] += acc[1];
            if (j < 5) store_T<0>(Pm1, pacc, mt, nt0, fr, fq);
            __syncthreads();
            bf16_t* t0 = R0; R0 = R1; R1 = t0;
            t0 = C0; C0 = C1; C1 = t0;
            t0 = Pm0; Pm0 = Pm1; Pm1 = t0;
        }
        store_T<0>(Tm, pacc, mt, nt0, fr, fq);
        {
            bf16_t* To = Tg + (size_t)u * 4096;
#pragma unroll
            for (int nn = 0; nn < 2; ++nn) {
                const int C = (nt0 + nn) * 16 + fr, Rb = mt * 16 + fq * 4;
                uint2 w; w.x = pack2(pacc[nn][0], pacc[nn][1]); w.y = pack2(pacc[nn][2], pacc[nn][3]);
                *reinterpret_cast<uint2*>(To + C * 64 + Rb) = w;
            }
            f32x4 acc[2];
            zero_acc(acc); mm64(acc, Kt, At, mt, nt0, fr, fq); store_T<1>(Aak, acc, mt, nt0, fr, fq);
        }
        __syncthreads();
        {
            f32x4 acc[2];
            zero_acc(acc); mm64(acc, Tm, AtT, mt, nt0, fr, fq); store_T<0>(PT, acc, mt, nt0, fr, fq);
            zero_acc(acc); mm64(acc, Aak, VT, mt, nt0, fr, fq); store_T<0>(AkVT, acc, mt, nt0, fr, fq);
        }
        __syncthreads();
        {
            f32x4 acc[2];
            zero_acc(acc); mm64(acc, Tm, AkVT, mt, nt0, fr, fq); store_T<0>(QT, acc, mt, nt0, fr, fq);
            zero_acc(acc); mm64(acc, PT, BtT, mt, nt0, fr, fq);
            bf16_t* Mo = Mg + (size_t)u * 4096;
#pragma unroll
            for (int nn = 0; nn < 2; ++nn) {
                const int C = (nt0 + nn) * 16 + fr, Rb = mt * 16 + fq * 4;
                const float wl = sWL[C];
                uint2 w; w.x = pack2(acc[nn][0] * wl, acc[nn][1] * wl); w.y = pack2(acc[nn][2] * wl, acc[nn][3] * wl);
                *reinterpret_cast<uint2*>(Mo + C * 64 + Rb) = w;
            }
        }
        __syncthreads();
        {
            f32x4 acc[2];
            zero_acc(acc); mm64(acc, BtT, QT, mt, nt0, fr, fq); mm64(acc, KtT, VT, mt, nt0, fr, fq);
            bf16_t* No = Ng + (size_t)u * 4096;
            float wl[4];
#pragma unroll
            for (int j = 0; j < 4; ++j) wl[j] = sWL[mt * 16 + fq * 4 + j];
#pragma unroll
            for (int nn = 0; nn < 2; ++nn) {
                const int C = (nt0 + nn) * 16 + fr, Rb = mt * 16 + fq * 4;
                uint2 w; w.x = pack2(acc[nn][0] * wl[0], acc[nn][1] * wl[1]); w.y = pack2(acc[nn][2] * wl[2], acc[nn][3] * wl[3]);
                *reinterpret_cast<uint2*>(No + C * 64 + Rb) = w;
            }
            if (tid < 64) WLg[(size_t)u * 64 + tid] = sWL[tid];
        }
    }
}

__device__ __forceinline__ void phase_rwkv_r2(const Params& p, unsigned char* smem) {
    const int tidx = otid(p.wave);
    if (obid() >= 32) return;
    const int bh = obid();
    const int tid = tidx, wv = tid >> 6, lane = tid & 63, fr = lane & 15, fq = lane >> 4, mt = wv >> 1, nt0 = (wv & 1) * 2;
    bf16_t* Sb0 = reinterpret_cast<bf16_t*>(smem);
    bf16_t* Sb1 = Sb0 + RC_BUF;
    const bf16_t* Mg = reinterpret_cast<const bf16_t*>(p.ws + OFF_MB);
    const bf16_t* Ng = reinterpret_cast<const bf16_t*>(p.ws + OFF_NTB);
    const float* WLg = reinterpret_cast<const float*>(p.ws + OFF_WLB);
    f32x4 sacc[2];
    zero_acc(sacc);
    for (int i = tid; i < RC_BUF / 2; i += NTHREADS) reinterpret_cast<unsigned*>(Sb0)[i] = 0u;
    const int moff = (mt * 16 + fr) * 64 + fq * 8;
    const int noff0 = ((nt0 + 0) * 16 + fr) * 64 + mt * 16 + fq * 4, noff1 = ((nt0 + 1) * 16 + fr) * 64 + mt * 16 + fq * 4;
    const int woff = mt * 16 + fq * 4;
    bf16x8 ma0, ma1; uint2 n0, n1; float4 wl;
    {
        const size_t u = (size_t)bh * 128;
        ma0 = *reinterpret_cast<const bf16x8*>(Mg + u * 4096 + moff); ma1 = *reinterpret_cast<const bf16x8*>(Mg + u * 4096 + moff + 32);
        n0 = *reinterpret_cast<const uint2*>(Ng + u * 4096 + noff0); n1 = *reinterpret_cast<const uint2*>(Ng + u * 4096 + noff1);
        wl = *reinterpret_cast<const float4*>(WLg + u * 64 + woff);
    }
    __syncthreads();
#pragma unroll 1
    for (int n = 0; n < 128; ++n) {
        const int u = bh * 128 + n;
        bf16_t* Sc = (n & 1) ? Sb1 : Sb0;
        bf16_t* Sn = (n & 1) ? Sb0 : Sb1;
        {
            bf16_t* so = s0_ptr(p.ws, u);
#pragma unroll
            for (int nn = 0; nn < 2; ++nn) {
                const int C = (nt0 + nn) * 16 + fr, Rb = mt * 16 + fq * 4;
                uint2 w; w.x = pack2(sacc[nn][0], sacc[nn][1]); w.y = pack2(sacc[nn][2], sacc[nn][3]);
                *reinterpret_cast<uint2*>(so + C * 64 + Rb) = w;
            }
        }
        const bf16x8 ca0 = ma0, ca1 = ma1; const uint2 cn0 = n0, cn1 = n1; const float4 cwl = wl;
        if (n + 1 < 128) {
            const size_t un = (size_t)u + 1;
            ma0 = *reinterpret_cast<const bf16x8*>(Mg + un * 4096 + moff); ma1 = *reinterpret_cast<const bf16x8*>(Mg + un * 4096 + moff + 32);
            n0 = *reinterpret_cast<const uint2*>(Ng + un * 4096 + noff0); n1 = *reinterpret_cast<const uint2*>(Ng + un * 4096 + noff1);
            wl = *reinterpret_cast<const float4*>(WLg + un * 64 + woff);
        }
        f32x4 acc[2];
        acc[0] = (f32x4){__uint_as_float(cn0.x << 16), __uint_as_float(cn0.x & 0xffff0000u), __uint_as_float(cn0.y << 16), __uint_as_float(cn0.y & 0xffff0000u)};
        acc[1] = (f32x4){__uint_as_float(cn1.x << 16), __uint_as_float(cn1.x & 0xffff0000u), __uint_as_float(cn1.y << 16), __uint_as_float(cn1.y & 0xffff0000u)};
        const float wls[4] = {cwl.x, cwl.y, cwl.z, cwl.w};
#pragma unroll
        for (int j = 0; j < 4; ++j) { acc[0][j] += wls[j] * sacc[0][j]; acc[1][j] += wls[j] * sacc[1][j]; }
#pragma unroll
        for (int ks = 0; ks < 2; ++ks) {
            const bf16x8 af = ks ? ca1 : ca0;
#pragma unroll
            for (int nn = 0; nn < 2; ++nn) {
                bf16x8 bq = *reinterpret_cast<const bf16x8*>(Sc + ((nt0 + nn) * 16 + fr) * RC_LD + ks * 32 + fq * 8);
                acc[nn] = __builtin_amdgcn_mfma_f32_16x16x32_bf16(af, bq, acc[nn], 0, 0, 0);
            }
        }
        sacc[0] = acc[0]; sacc[1] = acc[1];
        store_T<0>(Sn, sacc, mt, nt0, fr, fq);
        __syncthreads();
    }
}

__device__ __forceinline__ void phase_rwkv_r3(const Params& p, unsigned char* smem) {
    const int tidx = otid(p.wave);
    const int tid = tidx, wv = tid >> 6, lane = tid & 63, fr = lane & 15, fq = lane >> 4, mt = wv >> 1, nt0 = (wv & 1) * 2;
    bf16_t* base = reinterpret_cast<bf16_t*>(smem);
    bf16_t* At = base; bf16_t* Aak = base + RC_BUF; bf16_t* Bt = base + 2 * RC_BUF; bf16_t* Kt = base + 3 * RC_BUF;
    bf16_t* Rt = base + 4 * RC_BUF; bf16_t* VT = base + 5 * RC_BUF;
    bf16_t* Sb = base + 6 * RC_BUF; bf16_t* Tm = base + 7 * RC_BUF; bf16_t* Arb = base + 8 * RC_BUF; bf16_t* Ark = base + 9 * RC_BUF;
    bf16_t* XT = Bt; bf16_t* UT = Kt;
    float* Yf = reinterpret_cast<float*>(smem);
    float* sTot = reinterpret_cast<float*>(smem + 13 * RC_BYTES);
    float* sBC = sTot + 512 + 64;
    const bf16_t* Tg = reinterpret_cast<const bf16_t*>(p.ws + OFF_TB);
    const bf16_t* GG = reinterpret_cast<const bf16_t*>(p.ws + OFF_GG);
    bf16_t* YC = reinterpret_cast<bf16_t*>(p.ws + OFF_YCAT);
    for (int u = obid(); u < 4096; u += ogdim()) {
        const int b = u >> 10, h = (u >> 7) & 7, n = u & 127;
        const int c = h * 64 + lane;
        rwkv_prep<2>(p, b, h, n, tid, At, Bt, Kt, Rt, nullptr, nullptr, nullptr, VT, sTot, sBC, nullptr);
        {
            const uint4* Tu = reinterpret_cast<const uint4*>(Tg + (size_t)u * 4096);
            const uint4* Su = reinterpret_cast<const uint4*>(s0_ptr(p.ws, u));
            int row = tid >> 3, ch = tid & 7;
            *reinterpret_cast<uint4*>(Tm + row * RC_LD + ch * 8) = Tu[tid];
            *reinterpret_cast<uint4*>(Sb + row * RC_LD + ch * 8) = Su[tid];
        }
        __syncthreads();
        {
            f32x4 acc[2];
            zero_acc(acc); mm64(acc, Kt, At, mt, nt0, fr, fq); store_T<1>(Aak, acc, mt, nt0, fr, fq);
            zero_acc(acc); mm64(acc, Bt, Rt, mt, nt0, fr, fq); store_T<2>(Arb, acc, mt, nt0, fr, fq);
            zero_acc(acc); mm64(acc, Kt, Rt, mt, nt0, fr, fq); store_T<2>(Ark, acc, mt, nt0, fr, fq);
        }
        __syncthreads();
        {
            f32x4 acc[2];
            zero_acc(acc); mm64(acc, At, Sb, mt, nt0, fr, fq); mm64(acc, Aak, VT, mt, nt0, fr, fq);
            store_T<0>(XT, acc, mt, nt0, fr, fq);
        }
        __syncthreads();
        {
            f32x4 acc[2];
            zero_acc(acc); mm64(acc, Tm, XT, mt, nt0, fr, fq);
            store_T<0>(UT, acc, mt, nt0, fr, fq);
        }
        __syncthreads();
        {
            f32x4 acc[2];
            zero_acc(acc);
            mm64(acc, Rt, Sb, mt, nt0, fr, fq); mm64(acc, Arb, UT, mt, nt0, fr, fq); mm64(acc, Ark, VT, mt, nt0, fr, fq);
#pragma unroll
            for (int nn = 0; nn < 2; ++nn)
#pragma unroll
                for (int j = 0; j < 4; ++j) Yf[(mt * 16 + fq * 4 + j) * 68 + (nt0 + nn) * 16 + fr] = acc[nn][j];
        }
        __syncthreads();
        {
            const float lng = p.in[11][c], lnb = p.in[12][c];
#pragma unroll 4
            for (int i = 0; i < 8; ++i) {
                const int t = wv * 8 + i;
                const size_t tok = (size_t)b * SEQ + n * 64 + t;
                const float y = Yf[t * 68 + lane];
                const float mean = wave_sum(y) * (1.0f / 64.0f);
                const float d = y - mean;
                const float var = wave_sum(d * d) * (1.0f / 64.0f);
                const float yn = d * rsqrtf(var + 64e-5f) * lng + lnb;
                const float g = bf2f(GG[tok * 512 + c]);
                const float vv = bf2f(VT[lane * RC_LD + t]);
                YC[tok * 1024 + c] = f2bf((yn + sBC[t] * vv) * g);
            }
        }
        __syncthreads();
    }
}

__device__ __forceinline__ void phase_ln_route(const Params& p, int layer, float* X) {
    const int tidx = otid(p.wave);
    const int tid = tidx, wv = tid >> 6, lane = tid & 63;
    const float* g = p.in[24] + layer * DM;
    const float* bb = p.in[25] + layer * DM;
    const float* rgw = p.in[26] + (size_t)layer * DM * 4;
    const float* rgb = p.in[27] + layer * 4;
    const float* rew = p.in[28] + (size_t)layer * DM * 32;
    const float* reb = p.in[29] + layer * 32;
    bf16_t* XB = reinterpret_cast<bf16_t*>(p.ws + OFF_ACTB);
    int* cnt = reinterpret_cast<int*>(p.ws + OFF_CTRL) + layer * 32;
    int* ltok = reinterpret_cast<int*>(p.ws + OFF_LTOK);
    float* lgate = reinterpret_cast<float*>(p.ws + OFF_LGATE);
    for (int row = obid() * NWAVES + wv; row < NT; row += ogdim() * NWAVES) {
        float* xr = X + (size_t)row * DM;
        float v[16];
#pragma unroll
        for (int i = 0; i < 4; ++i) {
            float4 t = *reinterpret_cast<const float4*>(xr + i * 256 + lane * 4);
            v[4 * i] = t.x; v[4 * i + 1] = t.y; v[4 * i + 2] = t.z; v[4 * i + 3] = t.w;
        }
        float sum = 0.f;
#pragma unroll
        for (int i = 0; i < 16; ++i) sum += v[i];
        float mean = wave_sum(sum) * (1.0f / DM);
        float sq = 0.f;
#pragma unroll
        for (int i = 0; i < 16; ++i) { float d = v[i] - mean; sq += d * d; }
        float rstd = rsqrtf(wave_sum(sq) * (1.0f / DM) + 1e-5f);
#pragma unroll
        for (int i = 0; i < 4; ++i) {
            int col = i * 256 + lane * 4;
            float4 gg = *reinterpret_cast<const float4*>(g + col);
            float4 bv = *reinterpret_cast<const float4*>(bb + col);
            v[4 * i] = (v[4 * i] - mean) * rstd * gg.x + bv.x;
            v[4 * i + 1] = (v[4 * i + 1] - mean) * rstd * gg.y + bv.y;
            v[4 * i + 2] = (v[4 * i + 2] - mean) * rstd * gg.z + bv.z;
            v[4 * i + 3] = (v[4 * i + 3] - mean) * rstd * gg.w + bv.w;
            *reinterpret_cast<float4*>(xr + col) = make_float4(v[4 * i], v[4 * i + 1], v[4 * i + 2], v[4 * i + 3]);
            uint2 w; w.x = pack2(v[4 * i], v[4 * i + 1]); w.y = pack2(v[4 * i + 2], v[4 * i + 3]);
            *reinterpret_cast<uint2*>(XB + (size_t)row * DM + col) = w;
        }
        float gl[4] = {0.f, 0.f, 0.f, 0.f};
#pragma unroll
        for (int i = 0; i < 4; ++i)
#pragma unroll
            for (int e = 0; e < 4; ++e) {
                int k = i * 256 + lane * 4 + e;
                float4 w = *reinterpret_cast<const float4*>(rgw + (size_t)k * 4);
                float xv = v[4 * i + e];
                gl[0] += xv * w.x; gl[1] += xv * w.y; gl[2] += xv * w.z; gl[3] += xv * w.w;
            }
#pragma unroll
        for (int j = 0; j < 4; ++j) gl[j] = wave_sum(gl[j]) + rgb[j];
        int gi = 0; float gm = gl[0];
#pragma unroll
        for (int j = 1; j < 4; ++j) if (gl[j] > gm) { gm = gl[j]; gi = j; }
        float gs = 0.f;
#pragma unroll
        for (int j = 0; j < 4; ++j) gs += __expf(gl[j] - gm);
        float gw = 1.0f / gs;
        float el[8];
#pragma unroll
        for (int j = 0; j < 8; ++j) el[j] = 0.f;
#pragma unroll
        for (int i = 0; i < 4; ++i)
#pragma unroll
            for (int e = 0; e < 4; ++e) {
                int k = i * 256 + lane * 4 + e;
                const float4* wp = reinterpret_cast<const float4*>(rew + (size_t)k * 32 + gi * 8);
                float4 w0 = wp[0], w1 = wp[1];
                float xv = v[4 * i + e];
                el[0] += xv * w0.x; el[1] += xv * w0.y; el[2] += xv * w0.z; el[3] += xv * w0.w;
                el[4] += xv * w1.x; el[5] += xv * w1.y; el[6] += xv * w1.z; el[7] += xv * w1.w;
            }
#pragma unroll
        for (int j = 0; j < 8; ++j) el[j] = wave_sum(el[j]) + reb[gi * 8 + j];
        int i1 = 0; float m1 = el[0];
#pragma unroll
        for (int j = 1; j < 8; ++j) if (el[j] > m1) { m1 = el[j]; i1 = j; }
        int i2 = -1; float m2 = -3.0e38f;
#pragma unroll
        for (int j = 0; j < 8; ++j) if (j != i1 && el[j] > m2) { m2 = el[j]; i2 = j; }
        float e2 = __expf(m2 - m1);
        float p1 = 1.0f / (1.0f + e2), p2 = e2 / (1.0f + e2);
        if (lane < 2) {
            int ex = gi * 8 + (lane == 0 ? i1 : i2);
            float gate = gw * (lane == 0 ? p1 : p2);
            int slot = atomicAdd(&cnt[ex], 1);
            ltok[(size_t)ex * NT + slot] = row * 2 + lane;
            lgate[(size_t)ex * NT + slot] = gate;
        }
    }
}

__device__ __forceinline__ void phase_exp1(const Params& p, int layer, bf16_t* smem) {
    const int* cnt = reinterpret_cast<const int*>(p.ws + OFF_CTRL) + layer * 32;
    const int* ltok = reinterpret_cast<const int*>(p.ws + OFF_LTOK);
    const bf16_t* XB = reinterpret_cast<const bf16_t*>(p.ws + OFF_ACTB);
    const bf16_t* W13 = reinterpret_cast<const bf16_t*>(p.ws + OFF_W) + WE_W13 + (size_t)layer * 32 * 262144;
    bf16_t* H = reinterpret_cast<bf16_t*>(p.ws + OFF_HBUF);
    int t = obid();
    int base = 0, tbase = 0;
    for (int e = 0; e < 32; ++e) {
        int c = cnt[e];
        int nt = ((c + 255) >> 8) * 2;
        while (t < tbase + nt) {
            int w = t - tbase;
            EpiExp1 epi{H, base, c};
            gemm_tile<true>(XB, DM, ltok + (size_t)e * NT, c, W13 + (size_t)e * 262144, DM, DM, (w >> 1) * 256, (w & 1) * 128, epi, smem, p.wave);
            t += ogdim();
        }
        tbase += nt; base += c;
    }
}
__device__ __forceinline__ void phase_exp2(const Params& p, int layer, bf16_t* smem) {
    const int* cnt = reinterpret_cast<const int*>(p.ws + OFF_CTRL) + layer * 32;
    const int* ltok = reinterpret_cast<const int*>(p.ws + OFF_LTOK);
    const float* lgate = reinterpret_cast<const float*>(p.ws + OFF_LGATE);
    const bf16_t* W2 = reinterpret_cast<const bf16_t*>(p.ws + OFF_W) + WE_W2 + (size_t)layer * 32 * 131072;
    const bf16_t* H = reinterpret_cast<const bf16_t*>(p.ws + OFF_HBUF);
    bf16_t* FS = reinterpret_cast<bf16_t*>(p.ws + OFF_FS);
    int t = obid();
    int base = 0, tbase = 0;
    for (int e = 0; e < 32; ++e) {
        int c = cnt[e];
        int nt = ((c + 255) >> 8) * 8;
        while (t < tbase + nt) {
            int w = t - tbase;
            EpiExp2 epi{FS, ltok + (size_t)e * NT, lgate + (size_t)e * NT, c};
            gemm_tile<false>(H + (size_t)base * 128, 128, nullptr, 0, W2 + (size_t)e * 131072, 128, 128, (w >> 3) * 256, (w & 7) * 128, epi, smem, p.wave);
            t += ogdim();
        }
        tbase += nt; base += c;
    }
}

__device__ __forceinline__ void phase_ln_ffn(const Params& p, int layer, float* X, bool write_b) {
    const int tidx = otid(p.wave);
    const int tid = tidx, wv = tid >> 6, lane = tid & 63;
    const float* g = p.in[33] + layer * DM;
    const float* bb = p.in[34] + layer * DM;
    const bf16_t* FS = reinterpret_cast<const bf16_t*>(p.ws + OFF_FS);
    bf16_t* XB = reinterpret_cast<bf16_t*>(p.ws + OFF_ACTB);
    for (int row = obid() * NWAVES + wv; row < NT; row += ogdim() * NWAVES) {
        float* xr = X + (size_t)row * DM;
        float v[16];
#pragma unroll
        for (int i = 0; i < 4; ++i) {
            int col = i * 256 + lane * 4;
            float4 t = *reinterpret_cast<const float4*>(xr + col);
            uint2 f0 = *reinterpret_cast<const uint2*>(FS + (size_t)row * DM + col);
            uint2 f1 = *reinterpret_cast<const uint2*>(FS + ((size_t)NT + row) * DM + col);
            v[4 * i] = ALPHA_F * t.x + __uint_as_float(f0.x << 16) + __uint_as_float(f1.x << 16);
            v[4 * i + 1] = ALPHA_F * t.y + __uint_as_float(f0.x & 0xffff0000u) + __uint_as_float(f1.x & 0xffff0000u);
            v[4 * i + 2] = ALPHA_F * t.z + __uint_as_float(f0.y << 16) + __uint_as_float(f1.y << 16);
            v[4 * i + 3] = ALPHA_F * t.w + __uint_as_float(f0.y & 0xffff0000u) + __uint_as_float(f1.y & 0xffff0000u);
        }
        float sum = 0.f;
#pragma unroll
        for (int i = 0; i < 16; ++i) sum += v[i];
        float mean = wave_sum(sum) * (1.0f / DM);
        float sq = 0.f;
#pragma unroll
        for (int i = 0; i < 16; ++i) { float d = v[i] - mean; sq += d * d; }
        float rstd = rsqrtf(wave_sum(sq) * (1.0f / DM) + 1e-5f);
#pragma unroll
        for (int i = 0; i < 4; ++i) {
            int col = i * 256 + lane * 4;
            float4 gg = *reinterpret_cast<const float4*>(g + col);
            float4 bv = *reinterpret_cast<const float4*>(bb + col);
            float o0 = (v[4 * i] - mean) * rstd * gg.x + bv.x;
            float o1 = (v[4 * i + 1] - mean) * rstd * gg.y + bv.y;
            float o2 = (v[4 * i + 2] - mean) * rstd * gg.z + bv.z;
            float o3 = (v[4 * i + 3] - mean) * rstd * gg.w + bv.w;
            *reinterpret_cast<float4*>(xr + col) = make_float4(o0, o1, o2, o3);
            if (write_b) {
                uint2 w; w.x = pack2(o0, o1); w.y = pack2(o2, o3);
                *reinterpret_cast<uint2*>(XB + (size_t)row * DM + col) = w;
            }
        }
    }
}

__device__ __forceinline__ void phase_l1_conv(const Params& p, unsigned char* smem) {
    const int tidx = otid(p.wave);
    const bf16_t* P = reinterpret_cast<const bf16_t*>(p.ws + OFF_P);
    bf16_t* YC = reinterpret_cast<bf16_t*>(p.ws + OFF_YCAT);
    float* red = reinterpret_cast<float*>(smem);
    const int tid = tidx, wv = tid >> 6, lane = tid & 63;
    const float* cw = p.in[17];
    float w0[31];
#pragma unroll
    for (int j = 0; j < 31; ++j) w0[j] = cw[j * 512 + tid];
    const float cb0 = p.in[18][tid], g0 = p.in[19][tid], b0 = p.in[20][tid];
    for (int u = obid(); u < NT / 8; u += ogdim()) {
        const int t0 = u * 8;
        const int s0 = t0 & (SEQ - 1);
        float a0[8];
#pragma unroll
        for (int o = 0; o < 8; ++o) a0[o] = cb0;
#pragma unroll
        for (int rr = 0; rr < 38; ++rr) {
            int srow = s0 - 30 + rr;
            float u0 = 0.f;
            if (srow >= 0) {
                const bf16_t* pr = P + (size_t)(t0 - 30 + rr) * 3072;
                float ca0 = bf2f(pr[tid]), cg0 = bf2f(pr[512 + tid]);
                u0 = ca0 * sigmoidf_(cg0);
            }
#pragma unroll
            for (int o = 0; o < 8; ++o) {
                int j = rr - o;
                if (j >= 0 && j <= 30) a0[o] += u0 * w0[j];
            }
        }
        float mean[8], rstd[8];
#pragma unroll
        for (int o = 0; o < 8; ++o) {
            float sm = wave_sum(a0[o]);
            if (lane == 0) red[wv * 8 + o] = sm;
        }
        __syncthreads();
#pragma unroll
        for (int o = 0; o < 8; ++o) {
            float s = 0.f;
#pragma unroll
            for (int w = 0; w < 8; ++w) s += red[w * 8 + o];
            mean[o] = s * (1.0f / 512.0f);
        }
        __syncthreads();
#pragma unroll
        for (int o = 0; o < 8; ++o) {
            float d0 = a0[o] - mean[o];
            float sm = wave_sum(d0 * d0);
            if (lane == 0) red[wv * 8 + o] = sm;
        }
        __syncthreads();
#pragma unroll
        for (int o = 0; o < 8; ++o) {
            float s = 0.f;
#pragma unroll
            for (int w = 0; w < 8; ++w) s += red[w * 8 + o];
            rstd[o] = rsqrtf(s * (1.0f / 512.0f) + 1e-5f);
        }
        __syncthreads();
#pragma unroll
        for (int o = 0; o < 8; ++o) {
            float y0 = (a0[o] - mean[o]) * rstd[o] * g0 + b0;
            YC[(size_t)(t0 + o) * 1024 + tid] = f2bf(siluf_(y0));
        }
    }
}

__device__ __forceinline__ float ret_lg(int h) { return log1pf(-exp2f(-5.0f - (float)h)); }

#define KT_LD 136
__device__ __forceinline__ void phase_ret_kv(const Params& p, unsigned char* smem) {
    const int tidx = otid(p.wave);
    const bf16_t* P = reinterpret_cast<const bf16_t*>(p.ws + OFF_P);
    const float2* rope = reinterpret_cast<const float2*>(p.ws + OFF_ROPE);
    float* KVT = reinterpret_cast<float*>(p.ws + OFF_KVT);
    bf16_t* sKT = reinterpret_cast<bf16_t*>(smem);
    bf16_t* sVT = sKT + 64 * KT_LD;
    const int tid = tidx, wv = tid >> 6, lane = tid & 63, fr = lane & 15, fq = lane >> 4;
    const int et = wv >> 1, dt0 = (wv & 1) * 2;
    for (int u = obid(); u < 2048; u += ogdim()) {
        const int n = u & 63, h = (u >> 6) & 7, b = u >> 9;
        const float lg = ret_lg(h);
        {
            const int c = tid >> 2, i0 = (tid & 3) * 8;
            const int sidx = n * 128 + c;
            const size_t tok = (size_t)b * SEQ + sidx;
            const bf16_t* kr = P + tok * 3072 + 1536 + h * 64;
            const bf16_t* vr = P + tok * 3072 + 2048 + h * 64;
            const float zeta = __expf((float)(127 - c) * lg) * 0.125f;
#pragma unroll
            for (int i = 0; i < 8; ++i) {
                float t1 = bf2f(kr[i0 + i]), t2 = bf2f(kr[32 + i0 + i]);
                float2 cs = rope[sidx * 32 + i0 + i];
                float o1 = (t1 * cs.x - t2 * cs.y) * zeta, o2 = (t1 * cs.y + t2 * cs.x) * zeta;
                sKT[(i0 + i) * KT_LD + c] = f2bf(o1);
                sKT[(32 + i0 + i) * KT_LD + c] = f2bf(o2);
                sVT[(i0 + i) * KT_LD + c] = vr[i0 + i];
                sVT[(32 + i0 + i) * KT_LD + c] = vr[32 + i0 + i];
            }
        }
        __syncthreads();
        f32x4 acc[2];
        acc[0] = (f32x4){0.f, 0.f, 0.f, 0.f}; acc[1] = (f32x4){0.f, 0.f, 0.f, 0.f};
#pragma unroll
        for (int ks = 0; ks < 4; ++ks) {
            bf16x8 af = *reinterpret_cast<const bf16x8*>(sVT + (et * 16 + fr) * KT_LD + ks * 32 + fq * 8);
#pragma unroll
            for (int nn = 0; nn < 2; ++nn) {
                bf16x8 bfr = *reinterpret_cast<const bf16x8*>(sKT + ((dt0 + nn) * 16 + fr) * KT_LD + ks * 32 + fq * 8);
                acc[nn] = __builtin_amdgcn_mfma_f32_16x16x32_bf16(af, bfr, acc[nn], 0, 0, 0);
            }
        }
        float* o = KVT + (size_t)u * 4096;
#pragma unroll
        for (int nn = 0; nn < 2; ++nn)
#pragma unroll
            for (int j = 0; j < 4; ++j) o[(et * 16 + fq * 4 + j) * 64 + (dt0 + nn) * 16 + fr] = acc[nn][j];
        __syncthreads();
    }
}
__device__ __forceinline__ void phase_ret_scan(const Params& p) {
    const int tidx = otid(p.wave);
    float* KVT = reinterpret_cast<float*>(p.ws + OFF_KVT);
    for (int i = obid() * NTHREADS + tidx; i < 32 * 4096; i += ogdim() * NTHREADS) {
        int bh = i >> 12, ed = i & 4095, h = bh & 7;
        float gc = __expf(128.0f * ret_lg(h));
        float R = 0.f;
        float* q = KVT + (size_t)bh * 64 * 4096 + ed;
        for (int n = 0; n < 64; ++n) {
            float kv = q[(size_t)n * 4096];
            q[(size_t)n * 4096] = R;
            R = gc * R + kv;
        }
    }
}
#define Q_LD 72
__device__ __forceinline__ void phase_ret_out(const Params& p, unsigned char* smem) {
    const int tidx = otid(p.wave);
    const bf16_t* P = reinterpret_cast<const bf16_t*>(p.ws + OFF_P);
    const float2* rope = reinterpret_cast<const float2*>(p.ws + OFF_ROPE);
    const float* KVT = reinterpret_cast<const float*>(p.ws + OFF_KVT);
    bf16_t* YC = reinterpret_cast<bf16_t*>(p.ws + OFF_YCAT);
    bf16_t* sQ = reinterpret_cast<bf16_t*>(smem);
    bf16_t* sK = sQ + 128 * Q_LD;
    bf16_t* sVT = sK + 128 * Q_LD;
    bf16_t* sRT = sVT + 64 * KT_LD;
    bf16_t* sS = sQ;
    const int tid = tidx, wv = tid >> 6, lane = tid & 63, fr = lane & 15, fq = lane >> 4;
    const float* gng = p.in[21];
    const float* gnb = p.in[22];
    for (int u = obid(); u < 2048; u += ogdim()) {
        const int n = u & 63, h = (u >> 6) & 7, b = u >> 9;
        const float lg = ret_lg(h);
        {
            const int c = tid >> 2, i0 = (tid & 3) * 8;
            const int sidx = n * 128 + c;
            const size_t tok = (size_t)b * SEQ + sidx;
            const bf16_t* qr = P + tok * 3072 + 1024 + h * 64;
            const bf16_t* kr = P + tok * 3072 + 1536 + h * 64;
            const bf16_t* vr = P + tok * 3072 + 2048 + h * 64;
            {
                float qa[8], qb[8], ka[8], kb[8];
                float q1[8], q2[8], k1[8], k2[8];
                unpack8(*reinterpret_cast<const uint4*>(qr + i0), q1); unpack8(*reinterpret_cast<const uint4*>(qr + 32 + i0), q2);
                unpack8(*reinterpret_cast<const uint4*>(kr + i0), k1); unpack8(*reinterpret_cast<const uint4*>(kr + 32 + i0), k2);
#pragma unroll
                for (int i = 0; i < 8; ++i) {
                    const float2 cs = rope[sidx * 32 + i0 + i];
                    qa[i] = q1[i] * cs.x - q2[i] * cs.y; qb[i] = q1[i] * cs.y + q2[i] * cs.x;
                    ka[i] = (k1[i] * cs.x - k2[i] * cs.y) * 0.125f; kb[i] = (k1[i] * cs.y + k2[i] * cs.x) * 0.125f;
                    sVT[(i0 + i) * KT_LD + c] = vr[i0 + i];
                    sVT[(32 + i0 + i) * KT_LD + c] = vr[32 + i0 + i];
                }
                uint4 w;
                w.x = pack2(qa[0], qa[1]); w.y = pack2(qa[2], qa[3]); w.z = pack2(qa[4], qa[5]); w.w = pack2(qa[6], qa[7]);
                *reinterpret_cast<uint4*>(sQ + c * Q_LD + i0) = w;
                w.x = pack2(qb[0], qb[1]); w.y = pack2(qb[2], qb[3]); w.z = pack2(qb[4], qb[5]); w.w = pack2(qb[6], qb[7]);
                *reinterpret_cast<uint4*>(sQ + c * Q_LD + 32 + i0) = w;
                w.x = pack2(ka[0], ka[1]); w.y = pack2(ka[2], ka[3]); w.z = pack2(ka[4], ka[5]); w.w = pack2(ka[6], ka[7]);
                *reinterpret_cast<uint4*>(sK + c * Q_LD + i0) = w;
                w.x = pack2(kb[0], kb[1]); w.y = pack2(kb[2], kb[3]); w.z = pack2(kb[4], kb[5]); w.w = pack2(kb[6], kb[7]);
                *reinterpret_cast<uint4*>(sK + c * Q_LD + 32 + i0) = w;
            }
            {
                const float* rp = KVT + (size_t)u * 4096 + tid * 8;
                const float4 r0 = *reinterpret_cast<const float4*>(rp), r1 = *reinterpret_cast<const float4*>(rp + 4);
                uint4 w;
                w.x = pack2(r0.x, r0.y); w.y = pack2(r0.z, r0.w); w.z = pack2(r1.x, r1.y); w.w = pack2(r1.z, r1.w);
                *reinterpret_cast<uint4*>(sRT + (tid >> 3) * Q_LD + (tid & 7) * 8) = w;
            }
        }
        __syncthreads();
        f32x4 accs[8], accc[4];
#pragma unroll
        for (int nn = 0; nn < 8; ++nn) accs[nn] = (f32x4){0.f, 0.f, 0.f, 0.f};
#pragma unroll
        for (int nn = 0; nn < 4; ++nn) accc[nn] = (f32x4){0.f, 0.f, 0.f, 0.f};
#pragma unroll
        for (int ks = 0; ks < 2; ++ks) {
            bf16x8 af = *reinterpret_cast<const bf16x8*>(sQ + (wv * 16 + fr) * Q_LD + ks * 32 + fq * 8);
#pragma unroll
            for (int nn = 0; nn < 8; ++nn) {
                bf16x8 bfr = *reinterpret_cast<const bf16x8*>(sK + (nn * 16 + fr) * Q_LD + ks * 32 + fq * 8);
                accs[nn] = __builtin_amdgcn_mfma_f32_16x16x32_bf16(af, bfr, accs[nn], 0, 0, 0);
            }
#pragma unroll
            for (int nn = 0; nn < 4; ++nn) {
                bf16x8 bfr = *reinterpret_cast<const bf16x8*>(sRT + (nn * 16 + fr) * Q_LD + ks * 32 + fq * 8);
                accc[nn] = __builtin_amdgcn_mfma_f32_16x16x32_bf16(af, bfr, accc[nn], 0, 0, 0);
            }
        }
        __syncthreads();
        bf16_t* mS = sS + wv * 16 * KT_LD;
        {
            float e1[4], e1m[4];
#pragma unroll
            for (int j = 0; j < 4; ++j) {
                e1[j] = __expf((float)(fq * 4 + j - fr) * lg);
                e1m[j] = (fq * 4 + j >= fr) ? e1[j] : 0.f;
            }
#pragma unroll
            for (int nn = 0; nn < 8; ++nn) {
                const float e2 = (nn < wv) ? __expf((float)(16 * (wv - nn)) * lg) : 0.f;
                const bool diag = (nn == wv);
                float v[4];
#pragma unroll
                for (int j = 0; j < 4; ++j) v[j] = accs[nn][j] * (diag ? e1m[j] : e2 * e1[j]);
#pragma unroll
                for (int j = 0; j < 4; ++j) mS[(fq * 4 + j) * KT_LD + nn * 16 + fr] = f2bf(v[j]);
            }
        }
        __syncthreads();
        f32x4 acco[4];
#pragma unroll
        for (int nn = 0; nn < 4; ++nn) acco[nn] = (f32x4){0.f, 0.f, 0.f, 0.f};
#pragma unroll
        for (int ks = 0; ks < 4; ++ks) {
            bf16x8 af = *reinterpret_cast<const bf16x8*>(mS + fr * KT_LD + ks * 32 + fq * 8);
#pragma unroll
            for (int nn = 0; nn < 4; ++nn) {
                bf16x8 bfr = *reinterpret_cast<const bf16x8*>(sVT + (nn * 16 + fr) * KT_LD + ks * 32 + fq * 8);
                acco[nn] = __builtin_amdgcn_mfma_f32_16x16x32_bf16(af, bfr, acco[nn], 0, 0, 0);
            }
        }
#pragma unroll
        for (int j = 0; j < 4; ++j) {
            int ig = wv * 16 + fq * 4 + j;
            float xi = __expf((float)(ig + 1) * lg);
            float o[4];
            float sm = 0.f;
#pragma unroll
            for (int nn = 0; nn < 4; ++nn) { o[nn] = acco[nn][j] + xi * accc[nn][j]; sm += o[nn]; }
            sm = row16_sum(sm);
            float mean = sm * (1.0f / 64.0f);
            float sq = 0.f;
#pragma unroll
            for (int nn = 0; nn < 4; ++nn) { float d = o[nn] - mean; sq += d * d; }
            sq = row16_sum(sq);
            float rstd = rsqrtf(sq * (1.0f / 64.0f) + 1e-5f);
            size_t tok = (size_t)b * SEQ + n * 128 + ig;
#pragma unroll
            for (int nn = 0; nn < 4; ++nn) {
                int e = h * 64 + nn * 16 + fr;
                float y = (o[nn] - mean) * rstd * gng[e] + gnb[e];
                float gr = bf2f(P[tok * 3072 + 2560 + e]);
                YC[tok * 1024 + 512 + e] = f2bf(siluf_(gr) * y);
            }
        }
        __syncthreads();
    }
}

#define N_PHASES 22
__device__ __forceinline__ void run_phase(const Params& p, int ph, unsigned char* smem) {
    bf16_t* sm16 = reinterpret_cast<bf16_t*>(smem);
    const bf16_t* W = reinterpret_cast<const bf16_t*>(p.ws + OFF_W);
    bf16_t* ACTB = reinterpret_cast<bf16_t*>(p.ws + OFF_ACTB);
    bf16_t* PB = reinterpret_cast<bf16_t*>(p.ws + OFF_P);
    bf16_t* YC = reinterpret_cast<bf16_t*>(p.ws + OFF_YCAT);
    switch (ph) {
        case 0: phase_pre(p, smem); break;
        case 1: { PEpiBf16 e{PB, 2304}; big_gemm(ACTB, W + WE_IN0, NT, 2304, DM, e, smem, p.wave); } break;
        case 2: phase_l0_prep(p); break;
        case 3: phase_l0_lora(p, sm16); break;
        case 4: phase_rwkv_r1(p, smem); break;
        case 5: phase_rwkv_r2(p, smem); break;
        case 6: phase_rwkv_r3(p, smem); break;
        case 7: { PEpiOut e{p.in[0], p.out}; big_gemm(YC, W + WE_OUT0, NT, DM, DM, e, smem, p.wave); } break;
        case 8: phase_ln_route(p, 0, p.out); break;
        case 9: phase_exp1(p, 0, sm16); break;
        case 10: phase_exp2(p, 0, sm16); break;
        case 11: phase_ln_ffn(p, 0, p.out, true); break;
        case 12: { PEpiBf16 e{PB, 3072}; big_gemm(ACTB, W + WE_IN1, NT, 3072, DM, e, smem, p.wave); } break;
        case 13: phase_l1_conv(p, smem); break;
        case 14: phase_ret_kv(p, smem); break;
        case 15: phase_ret_scan(p); break;
        case 16: phase_ret_out(p, smem); break;
        case 17: { PEpiOut e{p.out, p.out}; big_gemm(YC, W + WE_OUT1, NT, DM, DM, e, smem, p.wave); } break;
        case 18: phase_ln_route(p, 1, p.out); break;
        case 19: phase_exp1(p, 1, sm16); break;
        case 20: phase_exp2(p, 1, sm16); break;
        case 21: phase_ln_ffn(p, 1, p.out, false); break;
        default: break;
    }
}

#define SMEM_BYTES 132096
__global__ void __launch_bounds__(NTHREADS) k_mega(Params p) {
    extern __shared__ __attribute__((aligned(16))) unsigned char smem[];
    cg::grid_group grid = cg::this_grid();
    const int wave_s = __builtin_amdgcn_readfirstlane((int)(threadIdx.x >> 6));
#pragma nounroll
    for (int ph = 0; ph < N_PHASES; ++ph) {
        int phv = ph;
        asm volatile("" : "+s"(phv));
        typedef const __attribute__((address_space(4))) Params* KP;
        KP pp = (KP)__builtin_amdgcn_kernarg_segment_ptr();
        asm volatile("" : "+s"(pp));
        Params pl;
        __builtin_memcpy(&pl, (const Params*)pp, sizeof(Params));
        pl.wave = wave_s;
        run_phase(pl, phv, smem);
        if (ph < N_PHASES - 1) grid.sync();
    }
}

extern "C" void kernel_launch(void* const* d_in, const int* in_sizes, int n_in, void* d_out, int out_size, void* d_ws, size_t ws_size,
                              hipStream_t stream) {
    static int grid_blocks = 0;
    if (!grid_blocks) {
        int dev = 0, cus = 0, per_cu = 0;
        hipGetDevice(&dev);
        hipDeviceGetAttribute(&cus, hipDeviceAttributeMultiprocessorCount, dev);
        hipFuncSetAttribute((const void*)k_mega, hipFuncAttributeMaxDynamicSharedMemorySize, SMEM_BYTES);
        hipOccupancyMaxActiveBlocksPerMultiprocessor(&per_cu, (const void*)k_mega, NTHREADS, SMEM_BYTES);
        if (per_cu < 1) per_cu = 1;
        grid_blocks = cus * per_cu;
    }
    Params p{};
    for (int i = 0; i < 35; ++i) p.in[i] = (const float*)d_in[i];
    p.out = (float*)d_out;
    p.ws = (unsigned char*)d_ws;
    void* args[] = {&p};
    hipError_t e = hipLaunchCooperativeKernel((void*)k_mega, dim3(grid_blocks), dim3(NTHREADS), args, SMEM_BYTES, stream);
    if (e != hipSuccess) fprintf(stderr, "cooperative launch failed: %s (grid %d)\n", hipGetErrorString(e), grid_blocks);
}
```

```cpp
#include <hip/hip_runtime.h>
#include <hip/hip_cooperative_groups.h>
#include <stdint.h>
#include <stdio.h>
namespace cg = cooperative_groups;

typedef unsigned short bf16_t;
typedef short bf16x8 __attribute__((ext_vector_type(8)));
typedef float f32x4 __attribute__((ext_vector_type(4)));

#define NT 32768
#define SEQ 8192
#define DM 1024
#define NTHREADS 512
#define XCD_BAR_WORDS 3456
#define NWAVES 8
#define ALPHA_F 1.41421356237309515f

#define MIB (1024ull * 1024ull)
#define OFF_CTRL 0ull
#define OFF_W (1ull * MIB)
#define OFF_ROPE (65ull * MIB)
#define OFF_ACTB (68ull * MIB)
#define OFF_AA (OFF_ACTB)
#define OFF_GG (OFF_ACTB + 32ull * MIB)
#define OFF_P (132ull * MIB)
#define OFF_LORA (OFF_P + 144ull * MIB)
#define OFF_POOLED (OFF_P + 160ull * MIB)
#define OFF_FS (OFF_P)
#define OFF_HBUF (OFF_P + 128ull * MIB)
#define OFF_YCAT (324ull * MIB)
#define OFF_LOGW (388ull * MIB)
#define OFF_LTOK (452ull * MIB)
#define OFF_LGATE (456ull * MIB)
#define OFF_KVT (460ull * MIB)
#define WE_IN0 0
#define WE_OUT0 2359296
#define WE_IN1 3407872
#define WE_OUT1 6553600
#define WE_W13 7602176
#define WE_W2 24379392
#define WE_LW2 32768000
#define WE_LA2 32800768
#define WE_LG2 32833536
#define WE_POOL 32899072

struct Params {
    const float* in[35];
    float* out;
    unsigned char* ws;
    int wave;
    int pad_;
};

__device__ __forceinline__ bf16_t f2bf(float f) {
    unsigned u = __float_as_uint(f);
    u += 0x7fffu + ((u >> 16) & 1u);
    return (bf16_t)(u >> 16);
}
__device__ __forceinline__ float bf2f(bf16_t h) { return __uint_as_float(((unsigned)h) << 16); }
__device__ __forceinline__ unsigned pack2(float a, float b) { return (unsigned)f2bf(a) | ((unsigned)f2bf(b) << 16); }
__device__ __forceinline__ void unpack8(const uint4 v, float (&o)[8]) {
    o[0] = __uint_as_float(v.x << 16); o[1] = __uint_as_float(v.x & 0xffff0000u);
    o[2] = __uint_as_float(v.y << 16); o[3] = __uint_as_float(v.y & 0xffff0000u);
    o[4] = __uint_as_float(v.z << 16); o[5] = __uint_as_float(v.z & 0xffff0000u);
    o[6] = __uint_as_float(v.w << 16); o[7] = __uint_as_float(v.w & 0xffff0000u);
}
#define DPP_ADD(v, CTRL) ((v) + __int_as_float(__builtin_amdgcn_update_dpp(0, __float_as_int(v), (CTRL), 0xF, 0xF, false)))
__device__ __forceinline__ float row16_sum(float v) {
    v = DPP_ADD(v, 0xB1);
    v = DPP_ADD(v, 0x4E);
    v = DPP_ADD(v, 0x141);
    v = DPP_ADD(v, 0x140);
    return v;
}
__device__ __forceinline__ float wave_sum(float v) {
    v = row16_sum(v);
    const int iv = __float_as_int(v);
    const float s0 = __int_as_float(__builtin_amdgcn_readlane(iv, 0)), s1 = __int_as_float(__builtin_amdgcn_readlane(iv, 16));
    const float s2 = __int_as_float(__builtin_amdgcn_readlane(iv, 32)), s3 = __int_as_float(__builtin_amdgcn_readlane(iv, 48));
    return (s0 + s1) + (s2 + s3);
}
__device__ __forceinline__ float sigmoidf_(float x) { return 1.0f / (1.0f + __expf(-x)); }
__device__ __forceinline__ float siluf_(float x) { return x / (1.0f + __expf(-x)); }
__device__ __forceinline__ float quad_sum(float v) {
    int iv = __float_as_int(v);
    float a = __int_as_float(__builtin_amdgcn_update_dpp(0, iv, 0xB1, 0xF, 0xF, false));
    v += a;
    iv = __float_as_int(v);
    float b = __int_as_float(__builtin_amdgcn_update_dpp(0, iv, 0x4E, 0xF, 0xF, false));
    return v + b;
}

__device__ __forceinline__ int obid() { int b = (int)blockIdx.x; asm volatile("" : "+s"(b)); return b; }
__device__ __forceinline__ int ogdim() { int b = (int)gridDim.x; asm volatile("" : "+s"(b)); return b; }
__device__ __forceinline__ int otid(int wave) { int t = wave * 64 + (int)__builtin_amdgcn_mbcnt_hi(~0u, __builtin_amdgcn_mbcnt_lo(~0u, 0u)); asm volatile("" : "+v"(t)); return t; }
template <bool GATHER, class Epi>
__device__ __forceinline__ void gemm_tile(const bf16_t* __restrict__ A, int lda, const int* __restrict__ gidx, int gcount,
                                          const bf16_t* __restrict__ Bt, int ldb, int K, int row0, int col0, const Epi& epi,
                                          bf16_t* smem, int wave) {
    const int tidx = otid(wave);
    const int tid = tidx, wid = tid >> 6, lane = tid & 63, wr = wid >> 1, wc = wid & 1, fr = lane & 15, fq = lane >> 4;
    bf16_t* SA = smem;
    bf16_t* SB = smem + 256 * 32;
    const bf16_t* ap[2];
    const bf16_t* bp;
#pragma unroll
    for (int i = 0; i < 2; ++i) {
        int b = tid * 16 + i * 8192;
        int r = b >> 6, c = (b & 63) >> 1;
        int ar = row0 + r;
        if (GATHER) {
            int gi = ar < gcount ? ar : gcount - 1;
            ar = gidx[gi] >> 1;
        }
        ap[i] = A + (size_t)ar * lda + c;
    }
    {
        int b = tid * 16;
        int r = b >> 6, c = (b & 63) >> 1;
        bp = Bt + (size_t)(col0 + r) * ldb + c;
    }
    f32x4 acc[4][4];
#pragma unroll
    for (int m = 0; m < 4; ++m)
#pragma unroll
        for (int n = 0; n < 4; ++n) acc[m][n] = (f32x4){0.f, 0.f, 0.f, 0.f};
    for (int kt = 0; kt < K; kt += 32) {
#pragma unroll
        for (int i = 0; i < 2; ++i) {
            int b = tid * 16 + i * 8192;
            __builtin_amdgcn_global_load_lds((const unsigned*)(ap[i] + kt), (__attribute__((address_space(3))) unsigned*)((char*)SA + b), 16, 0, 0);
        }
        __builtin_amdgcn_global_load_lds((const unsigned*)(bp + kt), (__attribute__((address_space(3))) unsigned*)((char*)SB + tid * 16), 16, 0, 0);
        asm volatile("s_waitcnt vmcnt(0)" ::: "memory");
        __syncthreads();
        bf16x8 af[4], bfr[4];
#pragma unroll
        for (int m = 0; m < 4; ++m) af[m] = *reinterpret_cast<const bf16x8*>((const char*)SA + (wr * 64 + m * 16 + fr) * 64 + fq * 16);
#pragma unroll
        for (int n = 0; n < 4; ++n) bfr[n] = *reinterpret_cast<const bf16x8*>((const char*)SB + (wc * 64 + n * 16 + fr) * 64 + fq * 16);
#pragma unroll
        for (int m = 0; m < 4; ++m)
#pragma unroll
            for (int n = 0; n < 4; ++n) acc[m][n] = __builtin_amdgcn_mfma_f32_16x16x32_bf16(bfr[n], af[m], acc[m][n], 0, 0, 0);
        __syncthreads();
    }
    epi(acc, row0 + wr * 64, col0 + wc * 64, fr, fq);
}

struct EpiStoreBf16 {
    bf16_t* O; int ldo;
    __device__ __forceinline__ void operator()(f32x4 (&acc)[4][4], int rb, int cb, int fr, int fq) const {
#pragma unroll
        for (int m = 0; m < 4; ++m)
#pragma unroll
            for (int n = 0; n < 4; ++n) {
                int row = rb + m * 16 + fr, col = cb + n * 16 + fq * 4;
                uint2 w; w.x = pack2(acc[m][n][0], acc[m][n][1]); w.y = pack2(acc[m][n][2], acc[m][n][3]);
                *reinterpret_cast<uint2*>(O + (size_t)row * ldo + col) = w;
            }
    }
};
template <int MODE>
struct EpiLora {
    float* Of; bf16_t* Ob; const float* vec; int ldo; int coff;
    __device__ __forceinline__ void operator()(f32x4 (&acc)[4][4], int rb, int cb, int fr, int fq) const {
#pragma unroll
        for (int m = 0; m < 4; ++m)
#pragma unroll
            for (int n = 0; n < 4; ++n) {
                int row = rb + m * 16 + fr, col = cb + n * 16 + fq * 4;
                float v[4];
#pragma unroll
                for (int j = 0; j < 4; ++j) {
                    float a = acc[m][n][j];
                    if (MODE == 0) {
                        float t = -(vec[col + j] + a);
                        float sp = (t > 20.f) ? t : log1pf(__expf(t));
                        float wl = -sp - 0.5f;
                        v[j] = -__expf(wl);
                    } else if (MODE == 1) {
                        v[j] = sigmoidf_(vec[col + j] + a);
                    } else if (MODE == 2) {
                        v[j] = a;
                    } else {
                        v[j] = a * vec[coff + col + j];
                    }
                }
                {
                    uint2 w; w.x = pack2(v[0], v[1]); w.y = pack2(v[2], v[3]);
                    *reinterpret_cast<uint2*>(Ob + (size_t)row * ldo + coff + col) = w;
                }
            }
    }
};
struct EpiOut {
    const float* Xprev; float* X;
    __device__ __forceinline__ void operator()(f32x4 (&acc)[4][4], int rb, int cb, int fr, int fq) const {
#pragma unroll
        for (int m = 0; m < 4; ++m)
#pragma unroll
            for (int n = 0; n < 4; ++n) {
                int row = rb + m * 16 + fr, col = cb + n * 16 + fq * 4;
                float4 xp = *reinterpret_cast<const float4*>(Xprev + (size_t)row * DM + col);
                float4 o;
                o.x = ALPHA_F * xp.x + acc[m][n][0]; o.y = ALPHA_F * xp.y + acc[m][n][1];
                o.z = ALPHA_F * xp.z + acc[m][n][2]; o.w = ALPHA_F * xp.w + acc[m][n][3];
                *reinterpret_cast<float4*>(X + (size_t)row * DM + col) = o;
            }
    }
};
struct EpiExp1 {
    bf16_t* H; int base; int cnt;
    __device__ __forceinline__ void operator()(f32x4 (&acc)[4][4], int rb, int cb, int fr, int fq) const {
#pragma unroll
        for (int m = 0; m < 4; ++m) {
            int li = rb + m * 16 + fr;
            if (li < cnt) {
#pragma unroll
                for (int i = 0; i < 2; ++i) {
                    int hcol = (cb >> 1) + i * 16 + fq * 4;
                    float v[4];
#pragma unroll
                    for (int j = 0; j < 4; ++j) v[j] = siluf_(acc[m][2 * i][j]) * acc[m][2 * i + 1][j];
                    uint2 w; w.x = pack2(v[0], v[1]); w.y = pack2(v[2], v[3]);
                    *reinterpret_cast<uint2*>(H + (size_t)(base + li) * 128 + hcol) = w;
                }
            }
        }
    }
};
struct EpiExp2 {
    bf16_t* FS; const int* ltok; const float* lgate; int cnt;
    __device__ __forceinline__ void operator()(f32x4 (&acc)[4][4], int rb, int cb, int fr, int fq) const {
#pragma unroll
        for (int m = 0; m < 4; ++m) {
            int li = rb + m * 16 + fr;
            if (li < cnt) {
                int pk = ltok[li]; float g = lgate[li];
                int tok = pk >> 1, j = pk & 1;
                bf16_t* o = FS + ((size_t)j * NT + tok) * DM;
#pragma unroll
                for (int n = 0; n < 4; ++n) {
                    int col = cb + n * 16 + fq * 4;
                    uint2 w; w.x = pack2(acc[m][n][0] * g, acc[m][n][1] * g); w.y = pack2(acc[m][n][2] * g, acc[m][n][3] * g);
                    *reinterpret_cast<uint2*>(o + col) = w;
                }
            }
        }
    }
};

namespace pg8 {
#define PG8_LAS __attribute__((address_space(3)))
typedef unsigned short bf16_t;
typedef short bf16x8 __attribute__((ext_vector_type(8)));
typedef float f32x4 __attribute__((ext_vector_type(4)));
typedef unsigned u32x4 __attribute__((ext_vector_type(4)));
constexpr int BM = 256, BK = 64, HALF = 128, HTB = HALF * BK * 2  , STAGE_BYTES = 8 * HTB, NXCD = 8, WGM = 8;

__host__ __device__ __forceinline__ int lds_byte(int r, int c) { const int st = (r >> 4) * 2 + (c >> 5), rr = r & 15, cc = c & 31, ob = rr * 64 + cc * 2; return st * 1024 + (ob ^ (((ob >> 9) & 1) << 5)); }
__host__ __device__ __forceinline__ void stage_rc(int b, int& R, int& C) { const int st = b / 1024, sb = b % 1024, swz = sb ^ (((sb >> 9) & 1) << 5); R = (st >> 1) * 16 + swz / 64; C = (st & 1) * 32 + (swz % 64) / 2; }
__host__ __device__ __forceinline__ int perm32(int rho) { const int n = rho >> 4, i = rho & 15; return 8 * (i >> 2) + 4 * n + (i & 3); }

struct Unit { int pm, pn; };
struct Gemm { const bf16_t* A; const bf16_t* Bt; int M, N, K; };

struct StaticOrder {
    int nM, nN, nwg, G, c;
    __host__ __device__ void init(int M, int N, int G_, int c_) { nM = M / BM; nN = N / BM; nwg = nM * nN; G = G_; c = c_; }
    __host__ __device__ bool next(int i, Unit& u) const {
        const long L = (long)i * G + c; if (L >= nwg) return false;
        int wgid = (int)L; { const int q = nwg / NXCD, r = nwg % NXCD, xcd = wgid % NXCD, off = wgid / NXCD; wgid = (xcd < r ? xcd * (q + 1) : r * (q + 1) + (xcd - r) * q) + off; }
        const int nig = WGM * nN, gid = wgid / nig, fm = gid * WGM, gsz = (nM - fm) < WGM ? (nM - fm) : WGM;
        u.pm = fm + ((wgid % nig) % gsz); u.pn = (wgid % nig) / gsz; return true;
    }
    __device__ __forceinline__ void a_ready(const Unit&) const {}
    __device__ __forceinline__ void done(const Unit&) const {}
};
template <class Epi, class Sched, bool ALIGN_EPI = false, bool SP2 = false>
__device__ __forceinline__ void gemm_phase(PG8_LAS unsigned char* lds, const Gemm g, const Sched& S, const Epi& E, int wave) {
    const int tid = otid(wave), wid = __builtin_amdgcn_readfirstlane(tid >> 6), lane = tid & 63, wr = wid >> 2, wc = wid & 3, fr = lane & 15, fq = lane >> 4;
    const int K = g.K, nt = K / BK;
    unsigned voffA[2], voffB[2];
#pragma unroll
    for (int i = 0; i < 2; ++i) { int R, C; stage_rc(tid * 16 + i * 8192, R, C); const int Rb = Epi::PERM ? ((R & ~31) + perm32(R & 31)) : R;
        voffA[i] = (unsigned)(R * K + C) * 2u; voffB[i] = (unsigned)(Rb * K + C) * 2u; }
    const size_t kstep = (size_t)(BK * 2);
    const size_t hstep = (size_t)HALF * K * 2;
    const size_t tstep = 2 * hstep;
    const unsigned ldsw = (unsigned)wid * 1024u;
    const int aoff = lds_byte(wr * 64 + fr, fq * 8), boff = lds_byte(wc * 32 + fr, fq * 8);
#define PG8_SA(b, h) (((b) * 2 + (h)) * HTB)
#define PG8_SB(b, h) ((4 + (b) * 2 + (h)) * HTB)
#define PG8_STAGE(bufoff, gbase, voff) do { _Pragma("unroll") for (int _i = 0; _i < 2; ++_i) \
        __builtin_amdgcn_global_load_lds((const unsigned*)((const char*)(gbase) + (voff)[_i]), (PG8_LAS unsigned*)(lds + (bufoff) + ldsw + _i * 8192), 16, 0, 0); } while (0)
#define PG8_LDA(dst, b, h) do { _Pragma("unroll") for (int m = 0; m < 4; ++m) _Pragma("unroll") for (int k = 0; k < 2; ++k) dst[m][k] = *(const PG8_LAS bf16x8*)(lds + PG8_SA(b, h) + aoff + m * 2048 + k * 1024); } while (0)
#define PG8_LDB(dst, b, h) do { _Pragma("unroll") for (int n = 0; n < 2; ++n) _Pragma("unroll") for (int k = 0; k < 2; ++k) dst[n][k] = *(const PG8_LAS bf16x8*)(lds + PG8_SB(b, h) + boff + n * 2048 + k * 1024); } while (0)
#define PG8_MMA(ai, bj, At, Bt) do { __builtin_amdgcn_s_setprio(1); _Pragma("unroll") for (int m = 0; m < 4; ++m) _Pragma("unroll") for (int n = 0; n < 2; ++n) _Pragma("unroll") for (int k = 0; k < 2; ++k) \
        acc[ai][bj][m][n] = __builtin_amdgcn_mfma_f32_16x16x32_bf16(Bt[n][k], At[m][k], acc[ai][bj][m][n], 0, 0, 0); __builtin_amdgcn_s_setprio(0); } while (0)
#define PG8_WAIT_V(n) asm volatile("s_waitcnt vmcnt(" #n ")" ::: "memory")
#define PG8_WAIT_L(n) asm volatile("s_waitcnt lgkmcnt(" #n ")" ::: "memory")
#define PG8_BAR __builtin_amdgcn_s_barrier()
#define PG8_SCHED __builtin_amdgcn_sched_barrier(0)
    Unit cur, nxt; int ui = 0;
    if (!S.next(0, cur)) return;
    f32x4 acc[2][2][4][2];
#pragma unroll
    for (int a = 0; a < 2; ++a)
#pragma unroll
        for (int b = 0; b < 2; ++b)
#pragma unroll
            for (int m = 0; m < 4; ++m)
#pragma unroll
                for (int n = 0; n < 2; ++n) acc[a][b][m][n] = (f32x4){0.f, 0.f, 0.f, 0.f};
    bf16x8 At[4][2], B0[2][2], B1[2][2];
    const char* cA = (const char*)g.A + (size_t)cur.pm * tstep; const char* cB = (const char*)g.Bt + (size_t)cur.pn * tstep;
    S.a_ready(cur);
    if constexpr (SP2) {
        PG8_STAGE(PG8_SB(0, 0), cB, voffB); PG8_STAGE(PG8_SB(0, 1), cB + hstep, voffB); PG8_STAGE(PG8_SA(0, 0), cA, voffA); PG8_STAGE(PG8_SA(0, 1), cA + hstep, voffA);
        if (wr == 1) PG8_BAR;
        PG8_WAIT_V(2); PG8_BAR;
        PG8_STAGE(PG8_SB(1, 0), cB + kstep, voffB); PG8_STAGE(PG8_SA(1, 0), cA + kstep, voffA); PG8_STAGE(PG8_SB(1, 1), cB + hstep + kstep, voffB);
        PG8_WAIT_V(6); PG8_BAR;
    } else {
        PG8_STAGE(PG8_SB(0, 0), cB, voffB); PG8_STAGE(PG8_SA(0, 0), cA, voffA); PG8_STAGE(PG8_SB(0, 1), cB + hstep, voffB); PG8_STAGE(PG8_SA(0, 1), cA + hstep, voffA);
        if (wr == 1) PG8_BAR;
        PG8_WAIT_V(4); PG8_BAR;
        PG8_STAGE(PG8_SB(1, 0), cB + kstep, voffB); PG8_STAGE(PG8_SA(1, 0), cA + kstep, voffA); PG8_STAGE(PG8_SB(1, 1), cB + hstep + kstep, voffB);
        PG8_WAIT_V(6); PG8_BAR;
    }
    for (;;) {
        const bool has_next = S.next(ui + 1, nxt);
        const char* nA = has_next ? (const char*)g.A + (size_t)nxt.pm * tstep : cA; const char* nB = has_next ? (const char*)g.Bt + (size_t)nxt.pn * tstep : cB;
        for (int t = 0; t < nt; t += 2) {
            const bool last = (t == nt - 2);
            const char* a1 = cA + (size_t)(t + 1) * kstep;
            const char* a2 = last ? nA : cA + (size_t)(t + 2) * kstep; const char* b2 = last ? nB : cB + (size_t)(t + 2) * kstep;
            const char* a3 = a2 + kstep; const char* b3 = b2 + kstep;
            if (last && has_next) S.a_ready(nxt);
            if constexpr (SP2) {
            PG8_LDB(B0, 0, 0); PG8_LDB(B1, 0, 1); PG8_SCHED; PG8_LDA(At, 0, 0); PG8_STAGE(PG8_SA(1, 1), a1 + hstep, voffA);
            PG8_WAIT_V(8); PG8_WAIT_L(0); PG8_BAR; PG8_MMA(0, 0, At, B0); PG8_MMA(0, 1, At, B1); PG8_BAR; PG8_SCHED;
            PG8_LDA(At, 0, 1); PG8_STAGE(PG8_SB(0, 0), b2, voffB); PG8_STAGE(PG8_SB(0, 1), b2 + hstep, voffB); PG8_STAGE(PG8_SA(0, 0), a2, voffA);
            PG8_WAIT_V(8); PG8_WAIT_L(0); PG8_BAR; PG8_MMA(1, 0, At, B0); PG8_MMA(1, 1, At, B1); PG8_BAR; PG8_SCHED;
            PG8_LDB(B0, 1, 0); PG8_LDB(B1, 1, 1); PG8_SCHED; PG8_LDA(At, 1, 0); PG8_STAGE(PG8_SA(0, 1), a2 + hstep, voffA);
            PG8_WAIT_V(8); PG8_WAIT_L(0); PG8_BAR; PG8_MMA(0, 0, At, B0); PG8_MMA(0, 1, At, B1); PG8_BAR; PG8_SCHED;
            PG8_LDA(At, 1, 1); PG8_STAGE(PG8_SB(1, 0), b3, voffB); PG8_STAGE(PG8_SB(1, 1), b3 + hstep, voffB); PG8_STAGE(PG8_SA(1, 0), a3, voffA);
            PG8_WAIT_V(8); PG8_WAIT_L(0); PG8_BAR; PG8_MMA(1, 0, At, B0); PG8_MMA(1, 1, At, B1); PG8_BAR; PG8_SCHED;
            } else {
            PG8_LDB(B0, 0, 0); PG8_SCHED; PG8_LDA(At, 0, 0); PG8_STAGE(PG8_SA(1, 1), a1 + hstep, voffA);
            PG8_WAIT_L(8); PG8_BAR; PG8_WAIT_L(0); PG8_MMA(0, 0, At, B0); PG8_BAR; PG8_SCHED;
            PG8_LDB(B1, 0, 1); PG8_STAGE(PG8_SB(0, 0), b2, voffB);
            PG8_BAR; PG8_WAIT_L(0); PG8_MMA(0, 1, At, B1); PG8_BAR;
            PG8_LDA(At, 0, 1); PG8_STAGE(PG8_SA(0, 0), a2, voffA);
            PG8_BAR; PG8_WAIT_L(0); PG8_MMA(1, 0, At, B0); PG8_BAR; PG8_SCHED;
            PG8_STAGE(PG8_SB(0, 1), b2 + hstep, voffB);
            PG8_WAIT_V(6); PG8_BAR; PG8_MMA(1, 1, At, B1); PG8_BAR;
            PG8_LDB(B0, 1, 0); PG8_SCHED; PG8_LDA(At, 1, 0); PG8_STAGE(PG8_SA(0, 1), a2 + hstep, voffA);
            PG8_WAIT_L(8); PG8_BAR; PG8_WAIT_L(0); PG8_MMA(0, 0, At, B0); PG8_BAR; PG8_SCHED;
            PG8_LDB(B1, 1, 1); PG8_STAGE(PG8_SB(1, 0), b3, voffB);
            PG8_BAR; PG8_WAIT_L(0); PG8_MMA(0, 1, At, B1); PG8_BAR;
            PG8_LDA(At, 1, 1); PG8_STAGE(PG8_SA(1, 0), a3, voffA);
            PG8_BAR; PG8_WAIT_L(0); PG8_MMA(1, 0, At, B0); PG8_BAR; PG8_SCHED;
            PG8_STAGE(PG8_SB(1, 1), b3 + hstep, voffB);
            PG8_WAIT_V(6); PG8_BAR; PG8_MMA(1, 1, At, B1); PG8_BAR;
            }
        }
        if constexpr (ALIGN_EPI) { if (wr == 0) PG8_BAR; }
        if constexpr (!Epi::AFTER_DRAIN) { E(acc, cur, wr, wc, fr, fq); S.done(cur); }
        if (!has_next) break;
#pragma unroll
        for (int a = 0; a < 2; ++a)
#pragma unroll
            for (int b = 0; b < 2; ++b)
#pragma unroll
                for (int m = 0; m < 4; ++m)
#pragma unroll
                    for (int n = 0; n < 2; ++n) acc[a][b][m][n] = (f32x4){0.f, 0.f, 0.f, 0.f};
        cur = nxt; cA = nA; cB = nB; ++ui;
        if constexpr (ALIGN_EPI) { if (wr == 1) PG8_BAR; }
    }
    PG8_WAIT_V(0);
    if constexpr (!ALIGN_EPI) { if (wr == 0) PG8_BAR; }
    PG8_BAR;
    if constexpr (Epi::AFTER_DRAIN) { E.fused(acc, cur, wr, wc, fr, fq, lds, wid, lane); S.done(cur); }
#undef PG8_SA
#undef PG8_SB
#undef PG8_STAGE
#undef PG8_LDA
#undef PG8_LDB
#undef PG8_MMA
#undef PG8_WAIT_V
#undef PG8_WAIT_L
#undef PG8_BAR
#undef PG8_SCHED
}
}
struct PEpiBf16 {
    static constexpr bool PERM = true, AFTER_DRAIN = false;
    bf16_t* O; int ldo;
    __device__ __forceinline__ void operator()(const pg8::f32x4 (&acc)[2][2][4][2], const pg8::Unit& u, int wr, int wc, int fr, int fq) const {
        const int row0 = u.pm * 256 + wr * 64 + fr, col0 = u.pn * 256 + wc * 32 + 8 * fq;
#pragma unroll
        for (int ai = 0; ai < 2; ++ai)
#pragma unroll
            for (int m = 0; m < 4; ++m) {
                bf16_t* rowp = O + (size_t)(row0 + ai * 128 + m * 16) * ldo + col0;
#pragma unroll
                for (int bj = 0; bj < 2; ++bj) {
                    const pg8::f32x4 v0 = acc[ai][bj][m][0], v1 = acc[ai][bj][m][1];
                    uint4 w; w.x = pack2(v0[0], v0[1]); w.y = pack2(v0[2], v0[3]); w.z = pack2(v1[0], v1[1]); w.w = pack2(v1[2], v1[3]);
                    *reinterpret_cast<uint4*>(rowp + bj * 128) = w;
                }
            }
    }
};
struct PEpiOut {
    static constexpr bool PERM = false, AFTER_DRAIN = false;
    const float* Xprev; float* X;
    __device__ __forceinline__ void operator()(const pg8::f32x4 (&acc)[2][2][4][2], const pg8::Unit& u, int wr, int wc, int fr, int fq) const {
        const int row0 = u.pm * 256 + wr * 64 + fr, col0 = u.pn * 256 + wc * 32 + 4 * fq;
#pragma unroll
        for (int ai = 0; ai < 2; ++ai)
#pragma unroll
            for (int m = 0; m < 4; ++m) {
                const size_t ro = (size_t)(row0 + ai * 128 + m * 16) * DM + col0;
#pragma unroll
                for (int bj = 0; bj < 2; ++bj)
#pragma unroll
                    for (int n = 0; n < 2; ++n) {
                        const size_t o = ro + bj * 128 + n * 16;
                        float4 xp = *reinterpret_cast<const float4*>(Xprev + o);
                        const pg8::f32x4 a = acc[ai][bj][m][n];
                        float4 r;
                        r.x = ALPHA_F * xp.x + a[0]; r.y = ALPHA_F * xp.y + a[1]; r.z = ALPHA_F * xp.z + a[2]; r.w = ALPHA_F * xp.w + a[3];
                        *reinterpret_cast<float4*>(X + o) = r;
                    }
            }
    }
};
template <class Epi>
__device__ __forceinline__ void big_gemm(const bf16_t* A, const bf16_t* Bt, int M, int N, int K, const Epi& e, unsigned char* smem, int wave) {
    pg8::Gemm g{A, Bt, M, N, K};
    pg8::StaticOrder S;
    S.init(M, N, ogdim(), obid());
    pg8::gemm_phase<Epi, pg8::StaticOrder, false, false>((PG8_LAS unsigned char*)smem, g, S, e, wave);
}

__device__ __forceinline__ void tconv_tile(const float* __restrict__ src, int N, bf16_t* __restrict__ dst, int ldd, int k0, int n0,
                                           int mode, float* tile  , int tid) {
#pragma unroll
    for (int i = 0; i < 8; ++i) {
        int r = i * 8 + (tid >> 6), c = tid & 63;
        tile[r * 65 + c] = src[(size_t)(k0 + r) * N + n0 + c];
    }
    __syncthreads();
#pragma unroll
    for (int i = 0; i < 8; ++i) {
        int nn = i * 8 + (tid >> 6), kk = tid & 63;
        int n = n0 + nn;
        int drow = n;
        if (mode == 1) drow = (n >> 4) * 32 + (n & 15);
        else if (mode == 2) drow = (n >> 4) * 32 + 16 + (n & 15);
        dst[(size_t)drow * ldd + k0 + kk] = f2bf(tile[kk * 65 + nn]);
    }
    __syncthreads();
}

__device__ __forceinline__ void phase_pre(const Params& p, unsigned char* smem) {
    const int tidx = otid(p.wave);
    float* tile = reinterpret_cast<float*>(smem);
    bf16_t* W = reinterpret_cast<bf16_t*>(p.ws + OFF_W);
    if (obid() == 0) {
        if (tidx < 64) reinterpret_cast<int*>(p.ws + OFF_CTRL)[tidx] = 0;
        unsigned* bar = reinterpret_cast<unsigned*>(p.ws + OFF_CTRL + 4096);
        for (int i = tidx; i < XCD_BAR_WORDS; i += NTHREADS) bar[i] = 0u;
    }
    constexpr int T0 = 576, T1 = 256, T2 = 768, T3 = 256, T4 = 2048, T5 = 2048, T6 = 2048, T7 = 8, T8 = 8, T9 = 16, T10 = 16;
    constexpr int TOT = T0 + T1 + T2 + T3 + T4 + T5 + T6 + T7 + T8 + T9 + T10;
    for (int u = obid(); u < TOT; u += ogdim()) {
        int v = u;
        const float* src; bf16_t* dst; int K, N, mode = 0, tk, tn;
        if (v < T0) { src = p.in[1]; K = 1024; N = 2304; dst = W + WE_IN0; tk = v / 36; tn = v % 36; }
        else if ((v -= T0) < T1) { src = p.in[15]; K = 1024; N = 1024; dst = W + WE_OUT0; tk = v / 16; tn = v % 16; }
        else if ((v -= T1) < T2) { src = p.in[16]; K = 1024; N = 3072; dst = W + WE_IN1; tk = v / 48; tn = v % 48; }
        else if ((v -= T2) < T3) { src = p.in[23]; K = 1024; N = 1024; dst = W + WE_OUT1; tk = v / 16; tn = v % 16; }
        else if ((v -= T3) < T4) { int mat = v >> 5, w = v & 31; src = p.in[30] + (size_t)mat * 131072; K = 1024; N = 128; dst = W + WE_W13 + (size_t)mat * 262144; mode = 1; tk = w >> 1; tn = w & 1; }
        else if ((v -= T4) < T5) { int mat = v >> 5, w = v & 31; src = p.in[31] + (size_t)mat * 131072; K = 1024; N = 128; dst = W + WE_W13 + (size_t)mat * 262144; mode = 2; tk = w >> 1; tn = w & 1; }
        else if ((v -= T5) < T6) { int mat = v >> 5, w = v & 31; src = p.in[32] + (size_t)mat * 131072; K = 128; N = 1024; dst = W + WE_W2 + (size_t)mat * 131072; tk = w >> 4; tn = w & 15; }
        else if ((v -= T6) < T7) { src = p.in[4]; K = 64; N = 512; dst = W + WE_LW2; tk = 0; tn = v; }
        else if ((v -= T7) < T8) { src = p.in[6]; K = 64; N = 512; dst = W + WE_LA2; tk = 0; tn = v; }
        else if ((v -= T8) < T9) { src = p.in[7]; K = 128; N = 512; dst = W + WE_LG2; tk = v >> 3; tn = v & 7; }
        else { v -= T9; int mat = v >> 2, w = v & 3; src = p.in[13] + (size_t)mat * 16384; K = 128; N = 128; dst = W + WE_POOL + (size_t)mat * 16384; tk = w >> 1; tn = w & 1; }
        tconv_tile(src, N, dst, K, tk * 64, tn * 64, mode, tile, tidx);
    }
    {
        const float4* x4 = reinterpret_cast<const float4*>(p.in[0]);
        uint2* xb = reinterpret_cast<uint2*>(p.ws + OFF_ACTB);
        const size_t n4 = (size_t)NT * DM / 4;
        for (size_t i = (size_t)obid() * NTHREADS + tidx; i < n4; i += (size_t)ogdim() * NTHREADS) {
            float4 v = x4[i];
            uint2 w; w.x = pack2(v.x, v.y); w.y = pack2(v.z, v.w);
            xb[i] = w;
        }
    }
    {
        float2* rope = reinterpret_cast<float2*>(p.ws + OFF_ROPE);
        for (int i = obid() * NTHREADS + tidx; i < SEQ * 32; i += ogdim() * NTHREADS) {
            int pos = i >> 5, k = i & 31;
            float inv = powf(10000.0f, -(float)k / 32.0f);
            float ang = (float)pos * inv;
            float s, c;
            sincosf(ang, &s, &c);
            rope[i] = make_float2(c, s);
        }
    }
}

__device__ __forceinline__ void phase_l0_prep(const Params& p) {
    const int tidx = otid(p.wave);
    const bf16_t* P = reinterpret_cast<const bf16_t*>(p.ws + OFF_P);
    bf16_t* LA = reinterpret_cast<bf16_t*>(p.ws + OFF_LORA);
    bf16_t* PO = reinterpret_cast<bf16_t*>(p.ws + OFF_POOLED);
    const float* mu = p.in[2];
    const int total = NT * 768;
    for (int i = obid() * NTHREADS + tidx; i < total; i += ogdim() * NTHREADS) {
        int tok = i / 768, c = i % 768;
        int s = tok & (SEQ - 1);
        if (c < 256) {
            int col = 1536 + c;
            float pr = bf2f(P[(size_t)tok * 2304 + col]);
            float pv = (s > 0) ? bf2f(P[(size_t)(tok - 1) * 2304 + col]) : 0.f;
            float z = pr + mu[col] * (pv - pr);
            float o;
            if (c < 64) o = tanhf(z);
            else if (c < 128) o = z;
            else o = sigmoidf_(z);
            LA[(size_t)tok * 256 + c] = f2bf(o);
        } else {
            int cc = c - 256;
            int gi = cc >> 7;
            int win = 2 << gi;
            int cnt = (s + 1 < win) ? (s + 1) : win;
            float sum = 0.f;
            for (int j = 0; j < cnt; ++j) sum += bf2f(P[(size_t)(tok - j) * 2304 + 1792 + cc]);
            float u = bf2f(P[(size_t)tok * 2304 + 1792 + cc]);
            PO[(size_t)tok * 512 + cc] = f2bf(sum / (float)cnt - u);
        }
    }
}

__device__ __forceinline__ void phase_l0_lora(const Params& p, bf16_t* smem) {
    const bf16_t* W = reinterpret_cast<const bf16_t*>(p.ws + OFF_W);
    const bf16_t* LA = reinterpret_cast<const bf16_t*>(p.ws + OFF_LORA);
    const bf16_t* PO = reinterpret_cast<const bf16_t*>(p.ws + OFF_POOLED);
    for (int t = obid(); t < 2048; t += ogdim()) {
        int job = t >> 9, w = t & 511;
        if (job == 0) {
            EpiLora<0> e{nullptr, reinterpret_cast<bf16_t*>(p.ws + OFF_LOGW), p.in[3], 512, 0};
            gemm_tile<false>(LA, 256, nullptr, 0, W + WE_LW2, 64, 64, (w >> 2) * 256, (w & 3) * 128, e, smem, p.wave);
        } else if (job == 1) {
            EpiLora<1> e{nullptr, reinterpret_cast<bf16_t*>(p.ws + OFF_AA), p.in[5], 512, 0};
            gemm_tile<false>(LA + 64, 256, nullptr, 0, W + WE_LA2, 64, 64, (w >> 2) * 256, (w & 3) * 128, e, smem, p.wave);
        } else if (job == 2) {
            EpiLora<2> e{nullptr, reinterpret_cast<bf16_t*>(p.ws + OFF_GG), nullptr, 512, 0};
            gemm_tile<false>(LA + 128, 256, nullptr, 0, W + WE_LG2, 128, 128, (w >> 2) * 256, (w & 3) * 128, e, smem, p.wave);
        } else {
            int g = w & 3, tm = w >> 2;
            EpiLora<3> e{nullptr, reinterpret_cast<bf16_t*>(p.ws + OFF_YCAT), p.in[14] - 512, 1024, 512 + g * 128};
            gemm_tile<false>(PO + g * 128, 512, nullptr, 0, W + WE_POOL + g * 16384, 128, 128, tm * 256, 0, e, smem, p.wave);
        }
    }
}

#define RC_LD 72
#define RC_BUF (64 * RC_LD)
#define RC_BYTES (RC_BUF * 2)
#define OFF_TBUF OFF_KVT

__device__ __forceinline__ void mm64(f32x4 (&acc)[2], const bf16_t* A, const bf16_t* Bt, int mt, int nt0, int fr, int fq) {
#pragma unroll
    for (int ks = 0; ks < 2; ++ks) {
        bf16x8 af = *reinterpret_cast<const bf16x8*>(A + (mt * 16 + fr) * RC_LD + ks * 32 + fq * 8);
        bf16x8 bq[2];
#pragma unroll
        for (int n = 0; n < 2; ++n) bq[n] = *reinterpret_cast<const bf16x8*>(Bt + ((nt0 + n) * 16 + fr) * RC_LD + ks * 32 + fq * 8);
#pragma unroll
        for (int n = 0; n < 2; ++n) acc[n] = __builtin_amdgcn_mfma_f32_16x16x32_bf16(af, bq[n], acc[n], 0, 0, 0);
    }
}
template <int MASK>
__device__ __forceinline__ void store_T(bf16_t* dst, const f32x4 (&acc)[2], int mt, int nt0, int fr, int fq) {
#pragma unroll
    for (int n = 0; n < 2; ++n) {
        const int C = (nt0 + n) * 16 + fr, R0 = mt * 16 + fq * 4;
        float v[4];
#pragma unroll
        for (int j = 0; j < 4; ++j) {
            const int R = R0 + j;
            bool keep = true;
            if (MASK == 1) keep = R < C;
            else if (MASK == 2) keep = R <= C;
            else if (MASK == 3) keep = C < R;
            v[j] = keep ? acc[n][j] : 0.f;
        }
        uint2 w; w.x = pack2(v[0], v[1]); w.y = pack2(v[2], v[3]);
        *reinterpret_cast<uint2*>(dst + C * RC_LD + R0) = w;
    }
}
__device__ __forceinline__ void zero_acc(f32x4 (&acc)[2]) {
    acc[0] = (f32x4){0.f, 0.f, 0.f, 0.f};
    acc[1] = (f32x4){0.f, 0.f, 0.f, 0.f};
}

#define OFF_NTB (OFF_P + 144ull * MIB)
#define OFF_S0A (OFF_P + 176ull * MIB)
#define OFF_TB (420ull * MIB)
#define OFF_MB (452ull * MIB)
#define OFF_S0B (484ull * MIB)
#define OFF_WLB (500ull * MIB)
__device__ __forceinline__ bf16_t* s0_ptr(unsigned char* ws, int u) {
    return reinterpret_cast<bf16_t*>(ws + (u < 2048 ? OFF_S0A : OFF_S0B)) + (size_t)(u & 2047) * 4096;
}

template <int MODE>
__device__ __forceinline__ void rwkv_prep(const Params& p, int b, int h, int n, int tid, bf16_t* At, bf16_t* Bt, bf16_t* Kt, bf16_t* Rt,
                                          bf16_t* AtT, bf16_t* BtT, bf16_t* KtT, bf16_t* VT, float* sTot, float* sBC, float* sWL) {
    const int lane = tid & 63, q = tid >> 6;
    const int c = h * 64 + lane;
    const bf16_t* P = reinterpret_cast<const bf16_t*>(p.ws + OFF_P);
    const bf16_t* LOGW = reinterpret_cast<const bf16_t*>(p.ws + OFF_LOGW);
    const bf16_t* AA = reinterpret_cast<const bf16_t*>(p.ws + OFF_AA);
    const float mu_k = p.in[2][512 + c];
    const float kkc = p.in[8][c];
    const float kac = p.in[9][c];
    const float mu_v = p.in[2][1024 + c];
    float mu_r = 0.f, rkc = 0.f;
    if (MODE == 2) { mu_r = p.in[2][c]; rkc = p.in[10][c]; }
    const int s0 = n * 64 + q * 8;
    const size_t tok0 = (size_t)b * SEQ + s0;
    float lw[8], av[8], zk[8], zr[8], zv[8];
    float pk = 0.f, pr = 0.f, pv = 0.f;
    if (s0 > 0) {
        const bf16_t* pp = P + (tok0 - 1) * 2304;
        pk = bf2f(pp[512 + c]); pv = bf2f(pp[1024 + c]);
        if (MODE == 2) pr = bf2f(pp[c]);
    }
#pragma unroll
    for (int i = 0; i < 8; ++i) {
        const bf16_t* pp = P + (tok0 + i) * 2304;
        float k0 = bf2f(pp[512 + c]), v0 = bf2f(pp[1024 + c]);
        zk[i] = k0 + mu_k * (pk - k0); pk = k0;
        zv[i] = v0 + mu_v * (pv - v0); pv = v0;
        if (MODE == 2) { float r0 = bf2f(pp[c]); zr[i] = r0 + mu_r * (pr - r0); pr = r0; }
        lw[i] = bf2f(LOGW[(tok0 + i) * 512 + c]);
        av[i] = bf2f(AA[(tok0 + i) * 512 + c]);
    }
    float lws[8];
    float cs = 0.f;
#pragma unroll
    for (int i = 0; i < 8; ++i) { cs += lw[i]; lws[i] = cs; }
    sTot[q * 64 + lane] = cs;
    __syncthreads();
    float off = 0.f, tot = 0.f;
#pragma unroll
    for (int qq = 0; qq < 8; ++qq) { float tq = sTot[qq * 64 + lane]; if (qq < q) off += tq; tot += tq; }
    float atv[8], btv[8], ktv[8];
#pragma unroll
    for (int i = 0; i < 8; ++i) {
        const int t = q * 8 + i;
        const float L = lws[i] + off;
        float kk = zk[i] * kkc;
        float ss = wave_sum(kk * kk);
        kk *= rsqrtf(fmaxf(ss, 1e-24f));
        const float e_neg = __expf(-L), e_prev = __expf(L - lw[i]);
        const float a = av[i];
        const float at = -kk * e_prev;
        At[t * RC_LD + lane] = f2bf(at);
        const float bt = kk * a * e_neg;
        Bt[t * RC_LD + lane] = f2bf(bt);
        const float kp = zk[i] * (1.0f + (a - 1.0f) * kac);
        const float kt = kp * e_neg;
        Kt[t * RC_LD + lane] = f2bf(kt);
        atv[i] = at; btv[i] = bt; ktv[i] = kt;
        if (MODE == 2) {
            Rt[t * RC_LD + lane] = f2bf(zr[i] * __expf(L));
            const float bc = wave_sum(zr[i] * kp * rkc);
            if (lane == 0) sBC[t] = bc;
        }
    }
    uint4 w0;
    if (MODE == 1) {
        w0.x = pack2(atv[0], atv[1]); w0.y = pack2(atv[2], atv[3]); w0.z = pack2(atv[4], atv[5]); w0.w = pack2(atv[6], atv[7]);
        *reinterpret_cast<uint4*>(AtT + lane * RC_LD + q * 8) = w0;
        w0.x = pack2(btv[0], btv[1]); w0.y = pack2(btv[2], btv[3]); w0.z = pack2(btv[4], btv[5]); w0.w = pack2(btv[6], btv[7]);
        *reinterpret_cast<uint4*>(BtT + lane * RC_LD + q * 8) = w0;
        w0.x = pack2(ktv[0], ktv[1]); w0.y = pack2(ktv[2], ktv[3]); w0.z = pack2(ktv[4], ktv[5]); w0.w = pack2(ktv[6], ktv[7]);
        *reinterpret_cast<uint4*>(KtT + lane * RC_LD + q * 8) = w0;
        if (q == 0) sWL[lane] = __expf(tot);
    }
    w0.x = pack2(zv[0], zv[1]); w0.y = pack2(zv[2], zv[3]); w0.z = pack2(zv[4], zv[5]); w0.w = pack2(zv[6], zv[7]);
    *reinterpret_cast<uint4*>(VT + lane * RC_LD + q * 8) = w0;
}

__device__ __forceinline__ void phase_rwkv_r1(const Params& p, unsigned char* smem) {
    const int tidx = otid(p.wave);
    const int tid = tidx, wv = tid >> 6, lane = tid & 63, fr = lane & 15, fq = lane >> 4, mt = wv >> 1, nt0 = (wv & 1) * 2;
    bf16_t* base = reinterpret_cast<bf16_t*>(smem);
    bf16_t* At = base; bf16_t* Bt = base + RC_BUF; bf16_t* Kt = base + 2 * RC_BUF; bf16_t* AtT = base + 3 * RC_BUF;
    bf16_t* BtT = base + 4 * RC_BUF; bf16_t* KtT = base + 5 * RC_BUF; bf16_t* VT = base + 6 * RC_BUF;
    bf16_t* Tm = base + 7 * RC_BUF; bf16_t* Aak = base + 8 * RC_BUF; bf16_t* PT = base + 9 * RC_BUF;
    bf16_t* AkVT = base + 10 * RC_BUF; bf16_t* QT = base + 11 * RC_BUF;
    float* sTot = reinterpret_cast<float*>(smem + 13 * RC_BYTES);
    float* sWL = sTot + 512;
    bf16_t* Tg = reinterpret_cast<bf16_t*>(p.ws + OFF_TB);
    bf16_t* Mg = reinterpret_cast<bf16_t*>(p.ws + OFF_MB);
    bf16_t* Ng = reinterpret_cast<bf16_t*>(p.ws + OFF_NTB);
    float* WLg = reinterpret_cast<float*>(p.ws + OFF_WLB);
    for (int u = obid(); u < 4096; u += ogdim()) {
        const int b = u >> 10, h = (u >> 7) & 7, n = u & 127;
        bf16_t* R0 = base + 7 * RC_BUF; bf16_t* C0 = base + 8 * RC_BUF; bf16_t* R1 = base + 9 * RC_BUF; bf16_t* C1 = base + 10 * RC_BUF;
        bf16_t* Pm0 = base + 11 * RC_BUF; bf16_t* Pm1 = base + 12 * RC_BUF;
        rwkv_prep<1>(p, b, h, n, tid, At, Bt, Kt, nullptr, AtT, BtT, KtT, VT, sTot, nullptr, sWL);
        __syncthreads();
        f32x4 pacc[2];
        {
            f32x4 acc[2];
            zero_acc(acc);
            mm64(acc, At, Bt, mt, nt0, fr, fq);
            store_T<3>(C0, acc, mt, nt0, fr, fq);
            zero_acc(pacc);
            mm64(pacc, Bt, At, mt, nt0, fr, fq);
#pragma unroll
            for (int nn = 0; nn < 2; ++nn)
#pragma unroll
                for (int j = 0; j < 4; ++j) {
                    const int R = mt * 16 + fq * 4 + j, C = (nt0 + nn) * 16 + fr;
                    pacc[nn][j] = (R < C) ? pacc[nn][j] : 0.f;
                }
            store_T<0>(R0, pacc, mt, nt0, fr, fq);
#pragma unroll
            for (int nn = 0; nn < 2; ++nn)
#pragma unroll
                for (int j = 0; j < 4; ++j) {
                    const int R = mt * 16 + fq * 4 + j, C = (nt0 + nn) * 16 + fr;
                    if (R == C) pacc[nn][j] += 1.0f;
                }
            store_T<0>(Pm0, pacc, mt, nt0, fr, fq);
        }
        __syncthreads();
#pragma unroll 1
        for (int j = 1; j <= 5; ++j) {
            f32x4 acc[2];
            if (j < 5) {
                zero_acc(acc);
                mm64(acc, C0, R0, mt, nt0, fr, fq);
                store_T<0>(R1, acc, mt, nt0, fr, fq);
            }
            zero_acc(acc);
            mm64(acc, R0, C0, mt, nt0, fr, fq);
            store_T<0>(C1, acc, mt, nt0, fr, fq);
            __syncthreads();
            zero_acc(acc);
            mm64(acc, C1, Pm0, mt, nt0, fr, fq);
            pacc[0] += acc[0]; pacc[1] += acc[1];
            if (j < 5) store_T<0>(Pm1, pacc, mt, nt0, fr, fq);
            __syncthreads();
            bf16_t* t0 = R0; R0 = R1; R1 = t0;
            t0 = C0; C0 = C1; C1 = t0;
            t0 = Pm0; Pm0 = Pm1; Pm1 = t0;
        }
        store_T<0>(Tm, pacc, mt, nt0, fr, fq);
        {
            bf16_t* To = Tg + (size_t)u * 4096;
#pragma unroll
            for (int nn = 0; nn < 2; ++nn) {
                const int C = (nt0 + nn) * 16 + fr, Rb = mt * 16 + fq * 4;
                uint2 w; w.x = pack2(pacc[nn][0], pacc[nn][1]); w.y = pack2(pacc[nn][2], pacc[nn][3]);
                *reinterpret_cast<uint2*>(To + C * 64 + Rb) = w;
            }
            f32x4 acc[2];
            zero_acc(acc); mm64(acc, Kt, At, mt, nt0, fr, fq); store_T<1>(Aak, acc, mt, nt0, fr, fq);
        }
        __syncthreads();
        {
            f32x4 acc[2];
            zero_acc(acc); mm64(acc, Tm, AtT, mt, nt0, fr, fq); store_T<0>(PT, acc, mt, nt0, fr, fq);
            zero_acc(acc); mm64(acc, Aak, VT, mt, nt0, fr, fq); store_T<0>(AkVT, acc, mt, nt0, fr, fq);
        }
        __syncthreads();
        {
            f32x4 acc[2];
            zero_acc(acc); mm64(acc, Tm, AkVT, mt, nt0, fr, fq); store_T<0>(QT, acc, mt, nt0, fr, fq);
            zero_acc(acc); mm64(acc, PT, BtT, mt, nt0, fr, fq);
            bf16_t* Mo = Mg + (size_t)u * 4096;
#pragma unroll
            for (int nn = 0; nn < 2; ++nn) {
                const int C = (nt0 + nn) * 16 + fr, Rb = mt * 16 + fq * 4;
                const float wl = sWL[C];
                uint2 w; w.x = pack2(acc[nn][0] * wl, acc[nn][1] * wl); w.y = pack2(acc[nn][2] * wl, acc[nn][3] * wl);
                *reinterpret_cast<uint2*>(Mo + C * 64 + Rb) = w;
            }
        }
        __syncthreads();
        {
            f32x4 acc[2];
            zero_acc(acc); mm64(acc, BtT, QT, mt, nt0, fr, fq); mm64(acc, KtT, VT, mt, nt0, fr, fq);
            bf16_t* No = Ng + (size_t)u * 4096;
            float wl[4];
#pragma unroll
            for (int j = 0; j < 4; ++j) wl[j] = sWL[mt * 16 + fq * 4 + j];
#pragma unroll
            for (int nn = 0; nn < 2; ++nn) {
                const int C = (nt0 + nn) * 16 + fr, Rb = mt * 16 + fq * 4;
                uint2 w; w.x = pack2(acc[nn][0] * wl[0], acc[nn][1] * wl[1]); w.y = pack2(acc[nn][2] * wl[2], acc[nn][3] * wl[3]);
                *reinterpret_cast<uint2*>(No + C * 64 + Rb) = w;
            }
            if (tid < 64) WLg[(size_t)u * 64 + tid] = sWL[tid];
        }
    }
}

__device__ __forceinline__ void phase_rwkv_r2(const Params& p, unsigned char* smem) {
    const int tidx = otid(p.wave);
    if (obid() >= 32) return;
    const int bh = obid();
    const int tid = tidx, wv = tid >> 6, lane = tid & 63, fr = lane & 15, fq = lane >> 4, mt = wv >> 1, nt0 = (wv & 1) * 2;
    bf16_t* Sb0 = reinterpret_cast<bf16_t*>(smem);
    bf16_t* Sb1 = Sb0 + RC_BUF;
    const bf16_t* Mg = reinterpret_cast<const bf16_t*>(p.ws + OFF_MB);
    const bf16_t* Ng = reinterpret_cast<const bf16_t*>(p.ws + OFF_NTB);
    const float* WLg = reinterpret_cast<const float*>(p.ws + OFF_WLB);
    f32x4 sacc[2];
    zero_acc(sacc);
    for (int i = tid; i < RC_BUF / 2; i += NTHREADS) reinterpret_cast<unsigned*>(Sb0)[i] = 0u;
    const int moff = (mt * 16 + fr) * 64 + fq * 8;
    const int noff0 = ((nt0 + 0) * 16 + fr) * 64 + mt * 16 + fq * 4, noff1 = ((nt0 + 1) * 16 + fr) * 64 + mt * 16 + fq * 4;
    const int woff = mt * 16 + fq * 4;
    bf16x8 ma0, ma1; uint2 n0, n1; float4 wl;
    {
        const size_t u = (size_t)bh * 128;
        ma0 = *reinterpret_cast<const bf16x8*>(Mg + u * 4096 + moff); ma1 = *reinterpret_cast<const bf16x8*>(Mg + u * 4096 + moff + 32);
        n0 = *reinterpret_cast<const uint2*>(Ng + u * 4096 + noff0); n1 = *reinterpret_cast<const uint2*>(Ng + u * 4096 + noff1);
        wl = *reinterpret_cast<const float4*>(WLg + u * 64 + woff);
    }
    __syncthreads();
#pragma unroll 1
    for (int n = 0; n < 128; ++n) {
        const int u = bh * 128 + n;
        bf16_t* Sc = (n & 1) ? Sb1 : Sb0;
        bf16_t* Sn = (n & 1) ? Sb0 : Sb1;
        {
            bf16_t* so = s0_ptr(p.ws, u);
#pragma unroll
            for (int nn = 0; nn < 2; ++nn) {
                const int C = (nt0 + nn) * 16 + fr, Rb = mt * 16 + fq * 4;
                uint2 w; w.x = pack2(sacc[nn][0], sacc[nn][1]); w.y = pack2(sacc[nn][2], sacc[nn][3]);
                *reinterpret_cast<uint2*>(so + C * 64 + Rb) = w;
            }
        }
        const bf16x8 ca0 = ma0, ca1 = ma1; const uint2 cn0 = n0, cn1 = n1; const float4 cwl = wl;
        if (n + 1 < 128) {
            const size_t un = (size_t)u + 1;
            ma0 = *reinterpret_cast<const bf16x8*>(Mg + un * 4096 + moff); ma1 = *reinterpret_cast<const bf16x8*>(Mg + un * 4096 + moff + 32);
            n0 = *reinterpret_cast<const uint2*>(Ng + un * 4096 + noff0); n1 = *reinterpret_cast<const uint2*>(Ng + un * 4096 + noff1);
            wl = *reinterpret_cast<const float4*>(WLg + un * 64 + woff);
        }
        f32x4 acc[2];
        acc[0] = (f32x4){__uint_as_float(cn0.x << 16), __uint_as_float(cn0.x & 0xffff0000u), __uint_as_float(cn0.y << 16), __uint_as_float(cn0.y & 0xffff0000u)};
        acc[1] = (f32x4){__uint_as_float(cn1.x << 16), __uint_as_float(cn1.x & 0xffff0000u), __uint_as_float(cn1.y << 16), __uint_as_float(cn1.y & 0xffff0000u)};
        const float wls[4] = {cwl.x, cwl.y, cwl.z, cwl.w};
#pragma unroll
        for (int j = 0; j < 4; ++j) { acc[0][j] += wls[j] * sacc[0][j]; acc[1][j] += wls[j] * sacc[1][j]; }
#pragma unroll
        for (int ks = 0; ks < 2; ++ks) {
            const bf16x8 af = ks ? ca1 : ca0;
#pragma unroll
            for (int nn = 0; nn < 2; ++nn) {
                bf16x8 bq = *reinterpret_cast<const bf16x8*>(Sc + ((nt0 + nn) * 16 + fr) * RC_LD + ks * 32 + fq * 8);
                acc[nn] = __builtin_amdgcn_mfma_f32_16x16x32_bf16(af, bq, acc[nn], 0, 0, 0);
            }
        }
        sacc[0] = acc[0]; sacc[1] = acc[1];
        store_T<0>(Sn, sacc, mt, nt0, fr, fq);
        __syncthreads();
    }
}

__device__ __forceinline__ void phase_rwkv_r3(const Params& p, unsigned char* smem) {
    const int tidx = otid(p.wave);
    const int tid = tidx, wv = tid >> 6, lane = tid & 63, fr = lane & 15, fq = lane >> 4, mt = wv >> 1, nt0 = (wv & 1) * 2;
    bf16_t* base = reinterpret_cast<bf16_t*>(smem);
    bf16_t* At = base; bf16_t* Aak = base + RC_BUF; bf16_t* Bt = base + 2 * RC_BUF; bf16_t* Kt = base + 3 * RC_BUF;
    bf16_t* Rt = base + 4 * RC_BUF; bf16_t* VT = base + 5 * RC_BUF;
    bf16_t* Sb = base + 6 * RC_BUF; bf16_t* Tm = base + 7 * RC_BUF; bf16_t* Arb = base + 8 * RC_BUF; bf16_t* Ark = base + 9 * RC_BUF;
    bf16_t* XT = Bt; bf16_t* UT = Kt;
    float* Yf = reinterpret_cast<float*>(smem);
    float* sTot = reinterpret_cast<float*>(smem + 13 * RC_BYTES);
    float* sBC = sTot + 512 + 64;
    const bf16_t* Tg = reinterpret_cast<const bf16_t*>(p.ws + OFF_TB);
    const bf16_t* GG = reinterpret_cast<const bf16_t*>(p.ws + OFF_GG);
    bf16_t* YC = reinterpret_cast<bf16_t*>(p.ws + OFF_YCAT);
    for (int u = obid(); u < 4096; u += ogdim()) {
        const int b = u >> 10, h = (u >> 7) & 7, n = u & 127;
        const int c = h * 64 + lane;
        rwkv_prep<2>(p, b, h, n, tid, At, Bt, Kt, Rt, nullptr, nullptr, nullptr, VT, sTot, sBC, nullptr);
        {
            const uint4* Tu = reinterpret_cast<const uint4*>(Tg + (size_t)u * 4096);
            const uint4* Su = reinterpret_cast<const uint4*>(s0_ptr(p.ws, u));
            int row = tid >> 3, ch = tid & 7;
            *reinterpret_cast<uint4*>(Tm + row * RC_LD + ch * 8) = Tu[tid];
            *reinterpret_cast<uint4*>(Sb + row * RC_LD + ch * 8) = Su[tid];
        }
        __syncthreads();
        {
            f32x4 acc[2];
            zero_acc(acc); mm64(acc, Kt, At, mt, nt0, fr, fq); store_T<1>(Aak, acc, mt, nt0, fr, fq);
            zero_acc(acc); mm64(acc, Bt, Rt, mt, nt0, fr, fq); store_T<2>(Arb, acc, mt, nt0, fr, fq);
            zero_acc(acc); mm64(acc, Kt, Rt, mt, nt0, fr, fq); store_T<2>(Ark, acc, mt, nt0, fr, fq);
        }
        __syncthreads();
        {
            f32x4 acc[2];
            zero_acc(acc); mm64(acc, At, Sb, mt, nt0, fr, fq); mm64(acc, Aak, VT, mt, nt0, fr, fq);
            store_T<0>(XT, acc, mt, nt0, fr, fq);
        }
        __syncthreads();
        {
            f32x4 acc[2];
            zero_acc(acc); mm64(acc, Tm, XT, mt, nt0, fr, fq);
            store_T<0>(UT, acc, mt, nt0, fr, fq);
        }
        __syncthreads();
        {
            f32x4 acc[2];
            zero_acc(acc);
            mm64(acc, Rt, Sb, mt, nt0, fr, fq); mm64(acc, Arb, UT, mt, nt0, fr, fq); mm64(acc, Ark, VT, mt, nt0, fr, fq);
#pragma unroll
            for (int nn = 0; nn < 2; ++nn)
#pragma unroll
                for (int j = 0; j < 4; ++j) Yf[(mt * 16 + fq * 4 + j) * 68 + (nt0 + nn) * 16 + fr] = acc[nn][j];
        }
        __syncthreads();
        {
            const float lng = p.in[11][c], lnb = p.in[12][c];
#pragma unroll 4
            for (int i = 0; i < 8; ++i) {
                const int t = wv * 8 + i;
                const size_t tok = (size_t)b * SEQ + n * 64 + t;
                const float y = Yf[t * 68 + lane];
                const float mean = wave_sum(y) * (1.0f / 64.0f);
                const float d = y - mean;
                const float var = wave_sum(d * d) * (1.0f / 64.0f);
                const float yn = d * rsqrtf(var + 64e-5f) * lng + lnb;
                const float g = bf2f(GG[tok * 512 + c]);
                const float vv = bf2f(VT[lane * RC_LD + t]);
                YC[tok * 1024 + c] = f2bf((yn + sBC[t] * vv) * g);
            }
        }
        __syncthreads();
    }
}

__device__ __forceinline__ void phase_ln_route(const Params& p, int layer, float* X) {
    const int tidx = otid(p.wave);
    const int tid = tidx, wv = tid >> 6, lane = tid & 63;
    const float* g = p.in[24] + layer * DM;
    const float* bb = p.in[25] + layer * DM;
    const float* rgw = p.in[26] + (size_t)layer * DM * 4;
    const float* rgb = p.in[27] + layer * 4;
    const float* rew = p.in[28] + (size_t)layer * DM * 32;
    const float* reb = p.in[29] + layer * 32;
    bf16_t* XB = reinterpret_cast<bf16_t*>(p.ws + OFF_ACTB);
    int* cnt = reinterpret_cast<int*>(p.ws + OFF_CTRL) + layer * 32;
    int* ltok = reinterpret_cast<int*>(p.ws + OFF_LTOK);
    float* lgate = reinterpret_cast<float*>(p.ws + OFF_LGATE);
    for (int row = obid() * NWAVES + wv; row < NT; row += ogdim() * NWAVES) {
        float* xr = X + (size_t)row * DM;
        float v[16];
#pragma unroll
        for (int i = 0; i < 4; ++i) {
            float4 t = *reinterpret_cast<const float4*>(xr + i * 256 + lane * 4);
            v[4 * i] = t.x; v[4 * i + 1] = t.y; v[4 * i + 2] = t.z; v[4 * i + 3] = t.w;
        }
        float sum = 0.f;
#pragma unroll
        for (int i = 0; i < 16; ++i) sum += v[i];
        float mean = wave_sum(sum) * (1.0f / DM);
        float sq = 0.f;
#pragma unroll
        for (int i = 0; i < 16; ++i) { float d = v[i] - mean; sq += d * d; }
        float rstd = rsqrtf(wave_sum(sq) * (1.0f / DM) + 1e-5f);
#pragma unroll
        for (int i = 0; i < 4; ++i) {
            int col = i * 256 + lane * 4;
            float4 gg = *reinterpret_cast<const float4*>(g + col);
            float4 bv = *reinterpret_cast<const float4*>(bb + col);
            v[4 * i] = (v[4 * i] - mean) * rstd * gg.x + bv.x;
            v[4 * i + 1] = (v[4 * i + 1] - mean) * rstd * gg.y + bv.y;
            v[4 * i + 2] = (v[4 * i + 2] - mean) * rstd * gg.z + bv.z;
            v[4 * i + 3] = (v[4 * i + 3] - mean) * rstd * gg.w + bv.w;
            *reinterpret_cast<float4*>(xr + col) = make_float4(v[4 * i], v[4 * i + 1], v[4 * i + 2], v[4 * i + 3]);
            uint2 w; w.x = pack2(v[4 * i], v[4 * i + 1]); w.y = pack2(v[4 * i + 2], v[4 * i + 3]);
            *reinterpret_cast<uint2*>(XB + (size_t)row * DM + col) = w;
        }
        float gl[4] = {0.f, 0.f, 0.f, 0.f};
#pragma unroll
        for (int i = 0; i < 4; ++i)
#pragma unroll
            for (int e = 0; e < 4; ++e) {
                int k = i * 256 + lane * 4 + e;
                float4 w = *reinterpret_cast<const float4*>(rgw + (size_t)k * 4);
                float xv = v[4 * i + e];
                gl[0] += xv * w.x; gl[1] += xv * w.y; gl[2] += xv * w.z; gl[3] += xv * w.w;
            }
#pragma unroll
        for (int j = 0; j < 4; ++j) gl[j] = wave_sum(gl[j]) + rgb[j];
        int gi = 0; float gm = gl[0];
#pragma unroll
        for (int j = 1; j < 4; ++j) if (gl[j] > gm) { gm = gl[j]; gi = j; }
        float gs = 0.f;
#pragma unroll
        for (int j = 0; j < 4; ++j) gs += __expf(gl[j] - gm);
        float gw = 1.0f / gs;
        float el[8];
#pragma unroll
        for (int j = 0; j < 8; ++j) el[j] = 0.f;
#pragma unroll
        for (int i = 0; i < 4; ++i)
#pragma unroll
            for (int e = 0; e < 4; ++e) {
                int k = i * 256 + lane * 4 + e;
                const float4* wp = reinterpret_cast<const float4*>(rew + (size_t)k * 32 + gi * 8);
                float4 w0 = wp[0], w1 = wp[1];
                float xv = v[4 * i + e];
                el[0] += xv * w0.x; el[1] += xv * w0.y; el[2] += xv * w0.z; el[3] += xv * w0.w;
                el[4] += xv * w1.x; el[5] += xv * w1.y; el[6] += xv * w1.z; el[7] += xv * w1.w;
            }
#pragma unroll
        for (int j = 0; j < 8; ++j) el[j] = wave_sum(el[j]) + reb[gi * 8 + j];
        int i1 = 0; float m1 = el[0];
#pragma unroll
        for (int j = 1; j < 8; ++j) if (el[j] > m1) { m1 = el[j]; i1 = j; }
        int i2 = -1; float m2 = -3.0e38f;
#pragma unroll
        for (int j = 0; j < 8; ++j) if (j != i1 && el[j] > m2) { m2 = el[j]; i2 = j; }
        float e2 = __expf(m2 - m1);
        float p1 = 1.0f / (1.0f + e2), p2 = e2 / (1.0f + e2);
        if (lane < 2) {
            int ex = gi * 8 + (lane == 0 ? i1 : i2);
            float gate = gw * (lane == 0 ? p1 : p2);
            int slot = atomicAdd(&cnt[ex], 1);
            ltok[(size_t)ex * NT + slot] = row * 2 + lane;
            lgate[(size_t)ex * NT + slot] = gate;
        }
    }
}

__device__ __forceinline__ void phase_exp1(const Params& p, int layer, bf16_t* smem) {
    const int* cnt = reinterpret_cast<const int*>(p.ws + OFF_CTRL) + layer * 32;
    const int* ltok = reinterpret_cast<const int*>(p.ws + OFF_LTOK);
    const bf16_t* XB = reinterpret_cast<const bf16_t*>(p.ws + OFF_ACTB);
    const bf16_t* W13 = reinterpret_cast<const bf16_t*>(p.ws + OFF_W) + WE_W13 + (size_t)layer * 32 * 262144;
    bf16_t* H = reinterpret_cast<bf16_t*>(p.ws + OFF_HBUF);
    int t = obid();
    int base = 0, tbase = 0;
    for (int e = 0; e < 32; ++e) {
        int c = cnt[e];
        int nt = ((c + 255) >> 8) * 2;
        while (t < tbase + nt) {
            int w = t - tbase;
            EpiExp1 epi{H, base, c};
            gemm_tile<true>(XB, DM, ltok + (size_t)e * NT, c, W13 + (size_t)e * 262144, DM, DM, (w >> 1) * 256, (w & 1) * 128, epi, smem, p.wave);
            t += ogdim();
        }
        tbase += nt; base += c;
    }
}
__device__ __forceinline__ void phase_exp2(const Params& p, int layer, bf16_t* smem) {
    const int* cnt = reinterpret_cast<const int*>(p.ws + OFF_CTRL) + layer * 32;
    const int* ltok = reinterpret_cast<const int*>(p.ws + OFF_LTOK);
    const float* lgate = reinterpret_cast<const float*>(p.ws + OFF_LGATE);
    const bf16_t* W2 = reinterpret_cast<const bf16_t*>(p.ws + OFF_W) + WE_W2 + (size_t)layer * 32 * 131072;
    const bf16_t* H = reinterpret_cast<const bf16_t*>(p.ws + OFF_HBUF);
    bf16_t* FS = reinterpret_cast<bf16_t*>(p.ws + OFF_FS);
    int t = obid();
    int base = 0, tbase = 0;
    for (int e = 0; e < 32; ++e) {
        int c = cnt[e];
        int nt = ((c + 255) >> 8) * 8;
        while (t < tbase + nt) {
            int w = t - tbase;
            EpiExp2 epi{FS, ltok + (size_t)e * NT, lgate + (size_t)e * NT, c};
            gemm_tile<false>(H + (size_t)base * 128, 128, nullptr, 0, W2 + (size_t)e * 131072, 128, 128, (w >> 3) * 256, (w & 7) * 128, epi, smem, p.wave);
            t += ogdim();
        }
        tbase += nt; base += c;
    }
}

__device__ __forceinline__ void phase_ln_ffn(const Params& p, int layer, float* X, bool write_b) {
    const int tidx = otid(p.wave);
    const int tid = tidx, wv = tid >> 6, lane = tid & 63;
    const float* g = p.in[33] + layer * DM;
    const float* bb = p.in[34] + layer * DM;
    const bf16_t* FS = reinterpret_cast<const bf16_t*>(p.ws + OFF_FS);
    bf16_t* XB = reinterpret_cast<bf16_t*>(p.ws + OFF_ACTB);
    for (int row = obid() * NWAVES + wv; row < NT; row += ogdim() * NWAVES) {
        float* xr = X + (size_t)row * DM;
        float v[16];
#pragma unroll
        for (int i = 0; i < 4; ++i) {
            int col = i * 256 + lane * 4;
            float4 t = *reinterpret_cast<const float4*>(xr + col);
            uint2 f0 = *reinterpret_cast<const uint2*>(FS + (size_t)row * DM + col);
            uint2 f1 = *reinterpret_cast<const uint2*>(FS + ((size_t)NT + row) * DM + col);
            v[4 * i] = ALPHA_F * t.x + __uint_as_float(f0.x << 16) + __uint_as_float(f1.x << 16);
            v[4 * i + 1] = ALPHA_F * t.y + __uint_as_float(f0.x & 0xffff0000u) + __uint_as_float(f1.x & 0xffff0000u);
            v[4 * i + 2] = ALPHA_F * t.z + __uint_as_float(f0.y << 16) + __uint_as_float(f1.y << 16);
            v[4 * i + 3] = ALPHA_F * t.w + __uint_as_float(f0.y & 0xffff0000u) + __uint_as_float(f1.y & 0xffff0000u);
        }
        float sum = 0.f;
#pragma unroll
        for (int i = 0; i < 16; ++i) sum += v[i];
        float mean = wave_sum(sum) * (1.0f / DM);
        float sq = 0.f;
#pragma unroll
        for (int i = 0; i < 16; ++i) { float d = v[i] - mean; sq += d * d; }
        float rstd = rsqrtf(wave_sum(sq) * (1.0f / DM) + 1e-5f);
#pragma unroll
        for (int i = 0; i < 4; ++i) {
            int col = i * 256 + lane * 4;
            float4 gg = *reinterpret_cast<const float4*>(g + col);
            float4 bv = *reinterpret_cast<const float4*>(bb + col);
            float o0 = (v[4 * i] - mean) * rstd * gg.x + bv.x;
            float o1 = (v[4 * i + 1] - mean) * rstd * gg.y + bv.y;
            float o2 = (v[4 * i + 2] - mean) * rstd * gg.z + bv.z;
            float o3 = (v[4 * i + 3] - mean) * rstd * gg.w + bv.w;
            *reinterpret_cast<float4*>(xr + col) = make_float4(o0, o1, o2, o3);
            if (write_b) {
                uint2 w; w.x = pack2(o0, o1); w.y = pack2(o2, o3);
                *reinterpret_cast<uint2*>(XB + (size_t)row * DM + col) = w;
            }
        }
    }
}

__device__ __forceinline__ void phase_l1_conv(const Params& p, unsigned char* smem) {
    const int tidx = otid(p.wave);
    const bf16_t* P = reinterpret_cast<const bf16_t*>(p.ws + OFF_P);
    bf16_t* YC = reinterpret_cast<bf16_t*>(p.ws + OFF_YCAT);
    float* red = reinterpret_cast<float*>(smem);
    const int tid = tidx, wv = tid >> 6, lane = tid & 63;
    const float* cw = p.in[17];
    float w0[31];
#pragma unroll
    for (int j = 0; j < 31; ++j) w0[j] = cw[j * 512 + tid];
    const float cb0 = p.in[18][tid], g0 = p.in[19][tid], b0 = p.in[20][tid];
    for (int u = obid(); u < NT / 8; u += ogdim()) {
        const int t0 = u * 8;
        const int s0 = t0 & (SEQ - 1);
        float a0[8];
#pragma unroll
        for (int o = 0; o < 8; ++o) a0[o] = cb0;
#pragma unroll
        for (int rr = 0; rr < 38; ++rr) {
            int srow = s0 - 30 + rr;
            float u0 = 0.f;
            if (srow >= 0) {
                const bf16_t* pr = P + (size_t)(t0 - 30 + rr) * 3072;
                float ca0 = bf2f(pr[tid]), cg0 = bf2f(pr[512 + tid]);
                u0 = ca0 * sigmoidf_(cg0);
            }
#pragma unroll
            for (int o = 0; o < 8; ++o) {
                int j = rr - o;
                if (j >= 0 && j <= 30) a0[o] += u0 * w0[j];
            }
        }
        float mean[8], rstd[8];
#pragma unroll
        for (int o = 0; o < 8; ++o) {
            float sm = wave_sum(a0[o]);
            if (lane == 0) red[wv * 8 + o] = sm;
        }
        __syncthreads();
#pragma unroll
        for (int o = 0; o < 8; ++o) {
            float s = 0.f;
#pragma unroll
            for (int w = 0; w < 8; ++w) s += red[w * 8 + o];
            mean[o] = s * (1.0f / 512.0f);
        }
        __syncthreads();
#pragma unroll
        for (int o = 0; o < 8; ++o) {
            float d0 = a0[o] - mean[o];
            float sm = wave_sum(d0 * d0);
            if (lane == 0) red[wv * 8 + o] = sm;
        }
        __syncthreads();
#pragma unroll
        for (int o = 0; o < 8; ++o) {
            float s = 0.f;
#pragma unroll
            for (int w = 0; w < 8; ++w) s += red[w * 8 + o];
            rstd[o] = rsqrtf(s * (1.0f / 512.0f) + 1e-5f);
        }
        __syncthreads();
#pragma unroll
        for (int o = 0; o < 8; ++o) {
            float y0 = (a0[o] - mean[o]) * rstd[o] * g0 + b0;
            YC[(size_t)(t0 + o) * 1024 + tid] = f2bf(siluf_(y0));
        }
    }
}

__device__ __forceinline__ float ret_lg(int h) { return log1pf(-exp2f(-5.0f - (float)h)); }

#define KT_LD 136
__device__ __forceinline__ void phase_ret_kv(const Params& p, unsigned char* smem) {
    const int tidx = otid(p.wave);
    const bf16_t* P = reinterpret_cast<const bf16_t*>(p.ws + OFF_P);
    const float2* rope = reinterpret_cast<const float2*>(p.ws + OFF_ROPE);
    float* KVT = reinterpret_cast<float*>(p.ws + OFF_KVT);
    bf16_t* sKT = reinterpret_cast<bf16_t*>(smem);
    bf16_t* sVT = sKT + 64 * KT_LD;
    const int tid = tidx, wv = tid >> 6, lane = tid & 63, fr = lane & 15, fq = lane >> 4;
    const int et = wv >> 1, dt0 = (wv & 1) * 2;
    for (int u = obid(); u < 2048; u += ogdim()) {
        const int n = u & 63, h = (u >> 6) & 7, b = u >> 9;
        const float lg = ret_lg(h);
        {
            const int c = tid >> 2, i0 = (tid & 3) * 8;
            const int sidx = n * 128 + c;
            const size_t tok = (size_t)b * SEQ + sidx;
            const bf16_t* kr = P + tok * 3072 + 1536 + h * 64;
            const bf16_t* vr = P + tok * 3072 + 2048 + h * 64;
            const float zeta = __expf((float)(127 - c) * lg) * 0.125f;
#pragma unroll
            for (int i = 0; i < 8; ++i) {
                float t1 = bf2f(kr[i0 + i]), t2 = bf2f(kr[32 + i0 + i]);
                float2 cs = rope[sidx * 32 + i0 + i];
                float o1 = (t1 * cs.x - t2 * cs.y) * zeta, o2 = (t1 * cs.y + t2 * cs.x) * zeta;
                sKT[(i0 + i) * KT_LD + c] = f2bf(o1);
                sKT[(32 + i0 + i) * KT_LD + c] = f2bf(o2);
                sVT[(i0 + i) * KT_LD + c] = vr[i0 + i];
                sVT[(32 + i0 + i) * KT_LD + c] = vr[32 + i0 + i];
            }
        }
        __syncthreads();
        f32x4 acc[2];
        acc[0] = (f32x4){0.f, 0.f, 0.f, 0.f}; acc[1] = (f32x4){0.f, 0.f, 0.f, 0.f};
#pragma unroll
        for (int ks = 0; ks < 4; ++ks) {
            bf16x8 af = *reinterpret_cast<const bf16x8*>(sVT + (et * 16 + fr) * KT_LD + ks * 32 + fq * 8);
#pragma unroll
            for (int nn = 0; nn < 2; ++nn) {
                bf16x8 bfr = *reinterpret_cast<const bf16x8*>(sKT + ((dt0 + nn) * 16 + fr) * KT_LD + ks * 32 + fq * 8);
                acc[nn] = __builtin_amdgcn_mfma_f32_16x16x32_bf16(af, bfr, acc[nn], 0, 0, 0);
            }
        }
        float* o = KVT + (size_t)u * 4096;
#pragma unroll
        for (int nn = 0; nn < 2; ++nn)
#pragma unroll
            for (int j = 0; j < 4; ++j) o[(et * 16 + fq * 4 + j) * 64 + (dt0 + nn) * 16 + fr] = acc[nn][j];
        __syncthreads();
    }
}
__device__ __forceinline__ void phase_ret_scan(const Params& p) {
    const int tidx = otid(p.wave);
    float* KVT = reinterpret_cast<float*>(p.ws + OFF_KVT);
    for (int i = obid() * NTHREADS + tidx; i < 32 * 4096; i += ogdim() * NTHREADS) {
        int bh = i >> 12, ed = i & 4095, h = bh & 7;
        float gc = __expf(128.0f * ret_lg(h));
        float R = 0.f;
        float* q = KVT + (size_t)bh * 64 * 4096 + ed;
        for (int n = 0; n < 64; ++n) {
            float kv = q[(size_t)n * 4096];
            q[(size_t)n * 4096] = R;
            R = gc * R + kv;
        }
    }
}
#define Q_LD 72
__device__ __forceinline__ void phase_ret_out(const Params& p, unsigned char* smem) {
    const int tidx = otid(p.wave);
    const bf16_t* P = reinterpret_cast<const bf16_t*>(p.ws + OFF_P);
    const float2* rope = reinterpret_cast<const float2*>(p.ws + OFF_ROPE);
    const float* KVT = reinterpret_cast<const float*>(p.ws + OFF_KVT);
    bf16_t* YC = reinterpret_cast<bf16_t*>(p.ws + OFF_YCAT);
    bf16_t* sQ = reinterpret_cast<bf16_t*>(smem);
    bf16_t* sK = sQ + 128 * Q_LD;
    bf16_t* sVT = sK + 128 * Q_LD;
    bf16_t* sRT = sVT + 64 * KT_LD;
    bf16_t* sS = sQ;
    const int tid = tidx, wv = tid >> 6, lane = tid & 63, fr = lane & 15, fq = lane >> 4;
    const float* gng = p.in[21];
    const float* gnb = p.in[22];
    for (int u = obid(); u < 2048; u += ogdim()) {
        const int n = u & 63, h = (u >> 6) & 7, b = u >> 9;
        const float lg = ret_lg(h);
        {
            const int c = tid >> 2, i0 = (tid & 3) * 8;
            const int sidx = n * 128 + c;
            const size_t tok = (size_t)b * SEQ + sidx;
            const bf16_t* qr = P + tok * 3072 + 1024 + h * 64;
            const bf16_t* kr = P + tok * 3072 + 1536 + h * 64;
            const bf16_t* vr = P + tok * 3072 + 2048 + h * 64;
            {
                float qa[8], qb[8], ka[8], kb[8];
                float q1[8], q2[8], k1[8], k2[8];
                unpack8(*reinterpret_cast<const uint4*>(qr + i0), q1); unpack8(*reinterpret_cast<const uint4*>(qr + 32 + i0), q2);
                unpack8(*reinterpret_cast<const uint4*>(kr + i0), k1); unpack8(*reinterpret_cast<const uint4*>(kr + 32 + i0), k2);
#pragma unroll
                for (int i = 0; i < 8; ++i) {
                    const float2 cs = rope[sidx * 32 + i0 + i];
                    qa[i] = q1[i] * cs.x - q2[i] * cs.y; qb[i] = q1[i] * cs.y + q2[i] * cs.x;
                    ka[i] = (k1[i] * cs.x - k2[i] * cs.y) * 0.125f; kb[i] = (k1[i] * cs.y + k2[i] * cs.x) * 0.125f;
                    sVT[(i0 + i) * KT_LD + c] = vr[i0 + i];
                    sVT[(32 + i0 + i) * KT_LD + c] = vr[32 + i0 + i];
                }
                uint4 w;
                w.x = pack2(qa[0], qa[1]); w.y = pack2(qa[2], qa[3]); w.z = pack2(qa[4], qa[5]); w.w = pack2(qa[6], qa[7]);
                *reinterpret_cast<uint4*>(sQ + c * Q_LD + i0) = w;
                w.x = pack2(qb[0], qb[1]); w.y = pack2(qb[2], qb[3]); w.z = pack2(qb[4], qb[5]); w.w = pack2(qb[6], qb[7]);
                *reinterpret_cast<uint4*>(sQ + c * Q_LD + 32 + i0) = w;
                w.x = pack2(ka[0], ka[1]); w.y = pack2(ka[2], ka[3]); w.z = pack2(ka[4], ka[5]); w.w = pack2(ka[6], ka[7]);
                *reinterpret_cast<uint4*>(sK + c * Q_LD + i0) = w;
                w.x = pack2(kb[0], kb[1]); w.y = pack2(kb[2], kb[3]); w.z = pack2(kb[4], kb[5]); w.w = pack2(kb[6], kb[7]);
                *reinterpret_cast<uint4*>(sK + c * Q_LD + 32 + i0) = w;
            }
            {
                const float* rp = KVT + (size_t)u * 4096 + tid * 8;
                const float4 r0 = *reinterpret_cast<const float4*>(rp), r1 = *reinterpret_cast<const float4*>(rp + 4);
                uint4 w;
                w.x = pack2(r0.x, r0.y); w.y = pack2(r0.z, r0.w); w.z = pack2(r1.x, r1.y); w.w = pack2(r1.z, r1.w);
                *reinterpret_cast<uint4*>(sRT + (tid >> 3) * Q_LD + (tid & 7) * 8) = w;
            }
        }
        __syncthreads();
        f32x4 accs[8], accc[4];
#pragma unroll
        for (int nn = 0; nn < 8; ++nn) accs[nn] = (f32x4){0.f, 0.f, 0.f, 0.f};
#pragma unroll
        for (int nn = 0; nn < 4; ++nn) accc[nn] = (f32x4){0.f, 0.f, 0.f, 0.f};
#pragma unroll
        for (int ks = 0; ks < 2; ++ks) {
            bf16x8 af = *reinterpret_cast<const bf16x8*>(sQ + (wv * 16 + fr) * Q_LD + ks * 32 + fq * 8);
#pragma unroll
            for (int nn = 0; nn < 8; ++nn) {
                bf16x8 bfr = *reinterpret_cast<const bf16x8*>(sK + (nn * 16 + fr) * Q_LD + ks * 32 + fq * 8);
                accs[nn] = __builtin_amdgcn_mfma_f32_16x16x32_bf16(af, bfr, accs[nn], 0, 0, 0);
            }
#pragma unroll
            for (int nn = 0; nn < 4; ++nn) {
                bf16x8 bfr = *reinterpret_cast<const bf16x8*>(sRT + (nn * 16 + fr) * Q_LD + ks * 32 + fq * 8);
                accc[nn] = __builtin_amdgcn_mfma_f32_16x16x32_bf16(af, bfr, accc[nn], 0, 0, 0);
            }
        }
        __syncthreads();
        bf16_t* mS = sS + wv * 16 * KT_LD;
        {
            float e1[4], e1m[4];
#pragma unroll
            for (int j = 0; j < 4; ++j) {
                e1[j] = __expf((float)(fq * 4 + j - fr) * lg);
                e1m[j] = (fq * 4 + j >= fr) ? e1[j] : 0.f;
            }
#pragma unroll
            for (int nn = 0; nn < 8; ++nn) {
                const float e2 = (nn < wv) ? __expf((float)(16 * (wv - nn)) * lg) : 0.f;
                const bool diag = (nn == wv);
                float v[4];
#pragma unroll
                for (int j = 0; j < 4; ++j) v[j] = accs[nn][j] * (diag ? e1m[j] : e2 * e1[j]);
#pragma unroll
                for (int j = 0; j < 4; ++j) mS[(fq * 4 + j) * KT_LD + nn * 16 + fr] = f2bf(v[j]);
            }
        }
        __syncthreads();
        f32x4 acco[4];
#pragma unroll
        for (int nn = 0; nn < 4; ++nn) acco[nn] = (f32x4){0.f, 0.f, 0.f, 0.f};
#pragma unroll
        for (int ks = 0; ks < 4; ++ks) {
            bf16x8 af = *reinterpret_cast<const bf16x8*>(mS + fr * KT_LD + ks * 32 + fq * 8);
#pragma unroll
            for (int nn = 0; nn < 4; ++nn) {
                bf16x8 bfr = *reinterpret_cast<const bf16x8*>(sVT + (nn * 16 + fr) * KT_LD + ks * 32 + fq * 8);
                acco[nn] = __builtin_amdgcn_mfma_f32_16x16x32_bf16(af, bfr, acco[nn], 0, 0, 0);
            }
        }
#pragma unroll
        for (int j = 0; j < 4; ++j) {
            int ig = wv * 16 + fq * 4 + j;
            float xi = __expf((float)(ig + 1) * lg);
            float o[4];
            float sm = 0.f;
#pragma unroll
            for (int nn = 0; nn < 4; ++nn) { o[nn] = acco[nn][j] + xi * accc[nn][j]; sm += o[nn]; }
            sm = row16_sum(sm);
            float mean = sm * (1.0f / 64.0f);
            float sq = 0.f;
#pragma unroll
            for (int nn = 0; nn < 4; ++nn) { float d = o[nn] - mean; sq += d * d; }
            sq = row16_sum(sq);
            float rstd = rsqrtf(sq * (1.0f / 64.0f) + 1e-5f);
            size_t tok = (size_t)b * SEQ + n * 128 + ig;
#pragma unroll
            for (int nn = 0; nn < 4; ++nn) {
                int e = h * 64 + nn * 16 + fr;
                float y = (o[nn] - mean) * rstd * gng[e] + gnb[e];
                float gr = bf2f(P[tok * 3072 + 2560 + e]);
                YC[tok * 1024 + 512 + e] = f2bf(siluf_(gr) * y);
            }
        }
        __syncthreads();
    }
}

#define XB_TMO      128
#define XB_XCNT(j)  (256  + 64 * (j))
#define XB_XSUB(j)  (1280 + 64 * (j))
#define XB_XGEN(j)  (2304 + 64 * (j))
#define XB_TOP      3328
#define XB_TOPGEN   3392
#define XB_SPIN_CAP (1u << 18)

__device__ __forceinline__ unsigned xb_ld(unsigned* p)              { return __hip_atomic_load(p, __ATOMIC_RELAXED, __HIP_MEMORY_SCOPE_AGENT); }
__device__ __forceinline__ unsigned xb_add(unsigned* p, unsigned v) { return __hip_atomic_fetch_add(p, v, __ATOMIC_RELAXED, __HIP_MEMORY_SCOPE_AGENT); }
__device__ __forceinline__ unsigned xb_xcc_id() { return (unsigned)__builtin_amdgcn_s_getreg((3 << 11) | 20) & 0xFu; }
#define XB_SPIN(cond, bar) do { unsigned _sp = 0; while (cond) { __builtin_amdgcn_s_sleep(1); \
    if ((++_sp & 255u) == 0u) { if (xb_ld(&(bar)[XB_TMO])) break; if (_sp > XB_SPIN_CAP) { atomicAdd(&(bar)[XB_TMO], 1u); break; } } } } while (0)

struct XcdBarrier {
    unsigned* bar; unsigned x;
    volatile __attribute__((address_space(3))) unsigned* st;
};

__device__ __forceinline__ XcdBarrier xcd_barrier_post(unsigned* bar, volatile __attribute__((address_space(3))) unsigned* st, int tid) {
    XcdBarrier b; b.bar = bar; b.x = xb_xcc_id(); b.st = st;
    if (tid == 0) (void)xb_add(&bar[XB_XCNT(b.x)], 1u);
    return b;
}
__device__ __forceinline__ void xcd_barrier_complete(unsigned* bar, unsigned x, unsigned& nloc, unsigned& nx) {
    const unsigned G = (unsigned)ogdim();
    unsigned sum, cnt, mine, sp = 0u;
    for (;;) {
        sum = 0u; cnt = 0u; mine = 0u;
#pragma unroll
        for (unsigned j = 0; j < 16; ++j) { const unsigned c = xb_ld(&bar[XB_XCNT(j)]); sum += c; cnt += (c > 0u) ? 1u : 0u; mine = (j == x) ? c : mine; }
        if (sum == G) break;
        __builtin_amdgcn_s_sleep(1);
        if ((++sp & 255u) == 0u) { if (xb_ld(&bar[XB_TMO])) break; if (sp > XB_SPIN_CAP) { atomicAdd(&bar[XB_TMO], 1u); break; } }
    }
    nloc = mine > 0u ? mine : 1u; nx = cnt > 0u ? cnt : 1u;
}

__device__ __forceinline__ void xcd_barrier(const XcdBarrier& b, int tid) {
    asm volatile("s_waitcnt vmcnt(0)" ::: "memory");
    __syncthreads();
    if (tid == 0) {
        unsigned* bar = b.bar;
        __builtin_amdgcn_s_waitcnt(0);
        unsigned nloc = b.st[0], nx = b.st[1];
        if (nloc == 0u) { xcd_barrier_complete(bar, b.x, nloc, nx); b.st[0] = nloc; b.st[1] = nx; }
        const unsigned old = xb_add(&bar[XB_XSUB(b.x)], 1u);
        const unsigned gen = old / nloc;
        if (old + 1u == (gen + 1u) * nloc) {
            __builtin_amdgcn_fence(__ATOMIC_RELEASE, "agent");
            asm volatile("s_waitcnt vmcnt(0)" ::: "memory");
            const unsigned og = xb_add(&bar[XB_TOP], 1u);
            const unsigned tg = og / nx;
            if (og + 1u == (tg + 1u) * nx) xb_add(&bar[XB_TOPGEN], 1u);
            else XB_SPIN(xb_ld(&bar[XB_TOPGEN]) == tg, bar);
            __builtin_amdgcn_fence(__ATOMIC_ACQUIRE, "agent");
            xb_add(&bar[XB_XGEN(b.x)], 1u);
            asm volatile("s_waitcnt vmcnt(0)" ::: "memory");
        } else {
            XB_SPIN(xb_ld(&bar[XB_XGEN(b.x)]) == gen, bar);
            __builtin_amdgcn_fence(__ATOMIC_ACQUIRE, "agent");
            asm volatile("s_waitcnt vmcnt(0)" ::: "memory");
        }
    }
    __syncthreads();
}


#define N_PHASES 22
__device__ __forceinline__ void run_phase(const Params& p, int ph, unsigned char* smem) {
    bf16_t* sm16 = reinterpret_cast<bf16_t*>(smem);
    const bf16_t* W = reinterpret_cast<const bf16_t*>(p.ws + OFF_W);
    bf16_t* ACTB = reinterpret_cast<bf16_t*>(p.ws + OFF_ACTB);
    bf16_t* PB = reinterpret_cast<bf16_t*>(p.ws + OFF_P);
    bf16_t* YC = reinterpret_cast<bf16_t*>(p.ws + OFF_YCAT);
    switch (ph) {
        case 0: phase_pre(p, smem); break;
        case 1: { PEpiBf16 e{PB, 2304}; big_gemm(ACTB, W + WE_IN0, NT, 2304, DM, e, smem, p.wave); } break;
        case 2: phase_l0_prep(p); break;
        case 3: phase_l0_lora(p, sm16); break;
        case 4: phase_rwkv_r1(p, smem); break;
        case 5: phase_rwkv_r2(p, smem); break;
        case 6: phase_rwkv_r3(p, smem); break;
        case 7: { PEpiOut e{p.in[0], p.out}; big_gemm(YC, W + WE_OUT0, NT, DM, DM, e, smem, p.wave); } break;
        case 8: phase_ln_route(p, 0, p.out); break;
        case 9: phase_exp1(p, 0, sm16); break;
        case 10: phase_exp2(p, 0, sm16); break;
        case 11: phase_ln_ffn(p, 0, p.out, true); break;
        case 12: { PEpiBf16 e{PB, 3072}; big_gemm(ACTB, W + WE_IN1, NT, 3072, DM, e, smem, p.wave); } break;
        case 13: phase_l1_conv(p, smem); break;
        case 14: phase_ret_kv(p, smem); break;
        case 15: phase_ret_scan(p); break;
        case 16: phase_ret_out(p, smem); break;
        case 17: { PEpiOut e{p.out, p.out}; big_gemm(YC, W + WE_OUT1, NT, DM, DM, e, smem, p.wave); } break;
        case 18: phase_ln_route(p, 1, p.out); break;
        case 19: phase_exp1(p, 1, sm16); break;
        case 20: phase_exp2(p, 1, sm16); break;
        case 21: phase_ln_ffn(p, 1, p.out, false); break;
        default: break;
    }
}

#define SMEM_BYTES 132096
__global__ void __launch_bounds__(NTHREADS) k_mega(Params p) {
    extern __shared__ __attribute__((aligned(16))) unsigned char smem[];
    cg::grid_group grid = cg::this_grid();
    const int wave_s = __builtin_amdgcn_readfirstlane((int)(threadIdx.x >> 6));
    volatile __attribute__((address_space(3))) unsigned* st = (volatile __attribute__((address_space(3))) unsigned*)(smem + 131584);
    {
        const int t0 = otid(wave_s);
        if (t0 < 2) st[t0] = 0u;
    }
    XcdBarrier xb;
#pragma nounroll
    for (int ph = 0; ph < N_PHASES; ++ph) {
        int phv = ph;
        asm volatile("" : "+s"(phv));
        typedef const __attribute__((address_space(4))) Params* KP;
        KP pp = (KP)__builtin_amdgcn_kernarg_segment_ptr();
        asm volatile("" : "+s"(pp));
        Params pl;
        __builtin_memcpy(&pl, (const Params*)pp, sizeof(Params));
        pl.wave = wave_s;
        run_phase(pl, phv, smem);
        if (ph == 0) {
            grid.sync();
            xb = xcd_barrier_post(reinterpret_cast<unsigned*>(pl.ws + OFF_CTRL + 4096), st, otid(wave_s));
        } else if (ph < N_PHASES - 1) {
            xcd_barrier(xb, otid(wave_s));
        }
    }
}

extern "C" void kernel_launch(void* const* d_in, const int* in_sizes, int n_in, void* d_out, int out_size, void* d_ws, size_t ws_size,
                              hipStream_t stream) {
    static int grid_blocks = 0;
    if (!grid_blocks) {
        int dev = 0, cus = 0, per_cu = 0;
        hipGetDevice(&dev);
        hipDeviceGetAttribute(&cus, hipDeviceAttributeMultiprocessorCount, dev);
        hipFuncSetAttribute((const void*)k_mega, hipFuncAttributeMaxDynamicSharedMemorySize, SMEM_BYTES);
        hipOccupancyMaxActiveBlocksPerMultiprocessor(&per_cu, (const void*)k_mega, NTHREADS, SMEM_BYTES);
        if (per_cu < 1) per_cu = 1;
        grid_blocks = cus * per_cu;
    }
    Params p{};
    for (int i = 0; i < 35; ++i) p.in[i] = (const float*)d_in[i];
    p.out = (float*)d_out;
    p.ws = (unsigned char*)d_ws;
    void* args[] = {&p};
    hipError_t e = hipLaunchCooperativeKernel((void*)k_mega, dim3(grid_blocks), dim3(NTHREADS), args, SMEM_BYTES, stream);
    if (e != hipSuccess) fprintf(stderr, "cooperative launch failed: %s (grid %d)\n", hipGetErrorString(e), grid_blocks);
}
```

```cpp
#include <hip/hip_runtime.h>
#include <hip/hip_cooperative_groups.h>
#include <stdint.h>
#include <stdio.h>
namespace cg = cooperative_groups;

typedef unsigned short bf16_t;
typedef short bf16x8 __attribute__((ext_vector_type(8)));
typedef float f32x4 __attribute__((ext_vector_type(4)));

#define NT 32768
#define SEQ 8192
#define DM 1024
#define NTHREADS 512
#define XCD_BAR_WORDS 3456
#define NWAVES 8
#define ALPHA_F 1.41421356237309515f

#define MIB (1024ull * 1024ull)
#define OFF_CTRL 0ull
#define OFF_W (1ull * MIB)
#define OFF_ROPE (65ull * MIB)
#define OFF_ACTB (68ull * MIB)
#define OFF_AA (OFF_ACTB)
#define OFF_GG (OFF_ACTB + 32ull * MIB)
#define OFF_P (132ull * MIB)
#define OFF_LORA (OFF_P + 144ull * MIB)
#define OFF_POOLED (OFF_P + 160ull * MIB)
#define OFF_FS (OFF_P)
#define OFF_HBUF (OFF_P + 128ull * MIB)
#define OFF_YCAT (324ull * MIB)
#define OFF_LOGW (388ull * MIB)
#define OFF_LTOK (452ull * MIB)
#define OFF_LGATE (456ull * MIB)
#define OFF_KVT (460ull * MIB)
#define WE_IN0 0
#define WE_OUT0 2359296
#define WE_IN1 3407872
#define WE_OUT1 6553600
#define WE_W13 7602176
#define WE_W2 24379392
#define WE_LW2 32768000
#define WE_LA2 32800768
#define WE_LG2 32833536
#define WE_POOL 32899072
#define WE_RT_HI 32964608
#define WE_RT_LO 33062912

struct Params {
    const float* in[35];
    float* out;
    unsigned char* ws;
    int wave;
    int pad_;
};

__device__ __forceinline__ bf16_t f2bf(float f) {
    unsigned u = __float_as_uint(f);
    u += 0x7fffu + ((u >> 16) & 1u);
    return (bf16_t)(u >> 16);
}
__device__ __forceinline__ float bf2f(bf16_t h) { return __uint_as_float(((unsigned)h) << 16); }
__device__ __forceinline__ unsigned pack2(float a, float b) { return (unsigned)f2bf(a) | ((unsigned)f2bf(b) << 16); }
__device__ __forceinline__ void unpack8(const uint4 v, float (&o)[8]) {
    o[0] = __uint_as_float(v.x << 16); o[1] = __uint_as_float(v.x & 0xffff0000u);
    o[2] = __uint_as_float(v.y << 16); o[3] = __uint_as_float(v.y & 0xffff0000u);
    o[4] = __uint_as_float(v.z << 16); o[5] = __uint_as_float(v.z & 0xffff0000u);
    o[6] = __uint_as_float(v.w << 16); o[7] = __uint_as_float(v.w & 0xffff0000u);
}
#define DPP_ADD(v, CTRL) ((v) + __int_as_float(__builtin_amdgcn_update_dpp(0, __float_as_int(v), (CTRL), 0xF, 0xF, false)))
__device__ __forceinline__ float row16_sum(float v) {
    v = DPP_ADD(v, 0xB1);
    v = DPP_ADD(v, 0x4E);
    v = DPP_ADD(v, 0x141);
    v = DPP_ADD(v, 0x140);
    return v;
}
__device__ __forceinline__ float wave_sum(float v) {
    v = row16_sum(v);
    const int iv = __float_as_int(v);
    const float s0 = __int_as_float(__builtin_amdgcn_readlane(iv, 0)), s1 = __int_as_float(__builtin_amdgcn_readlane(iv, 16));
    const float s2 = __int_as_float(__builtin_amdgcn_readlane(iv, 32)), s3 = __int_as_float(__builtin_amdgcn_readlane(iv, 48));
    return (s0 + s1) + (s2 + s3);
}
__device__ __forceinline__ float sigmoidf_(float x) { return 1.0f / (1.0f + __expf(-x)); }
__device__ __forceinline__ float siluf_(float x) { return x / (1.0f + __expf(-x)); }
__device__ __forceinline__ float quad_sum(float v) {
    int iv = __float_as_int(v);
    float a = __int_as_float(__builtin_amdgcn_update_dpp(0, iv, 0xB1, 0xF, 0xF, false));
    v += a;
    iv = __float_as_int(v);
    float b = __int_as_float(__builtin_amdgcn_update_dpp(0, iv, 0x4E, 0xF, 0xF, false));
    return v + b;
}

__device__ __forceinline__ void lds_barrier() {
    asm volatile("s_waitcnt lgkmcnt(0)" ::: "memory");
    __builtin_amdgcn_s_barrier();
    asm volatile("" ::: "memory");
}
__device__ __forceinline__ int obid() { int b = (int)blockIdx.x; asm volatile("" : "+s"(b)); return b; }
__device__ __forceinline__ int ogdim() { int b = (int)gridDim.x; asm volatile("" : "+s"(b)); return b; }
__device__ __forceinline__ int otid(int wave) { int t = wave * 64 + (int)__builtin_amdgcn_mbcnt_hi(~0u, __builtin_amdgcn_mbcnt_lo(~0u, 0u)); asm volatile("" : "+v"(t)); return t; }
template <bool GATHER, class Epi>
__device__ __forceinline__ void gemm_tile(const bf16_t* __restrict__ A, int lda, const int* __restrict__ gidx, int gcount,
                                          const bf16_t* __restrict__ Bt, int ldb, int K, int row0, int col0, const Epi& epi,
                                          bf16_t* smem, int wave) {
    const int tidx = otid(wave);
    const int tid = tidx, wid = tid >> 6, lane = tid & 63, wr = wid >> 1, wc = wid & 1, fr = lane & 15, fq = lane >> 4;
    bf16_t* SA = smem;
    bf16_t* SB = smem + 256 * 32;
    const bf16_t* ap[2];
    const bf16_t* bp;
#pragma unroll
    for (int i = 0; i < 2; ++i) {
        int b = tid * 16 + i * 8192;
        int r = b >> 6, c = (b & 63) >> 1;
        int ar = row0 + r;
        if (GATHER) {
            int gi = ar < gcount ? ar : gcount - 1;
            ar = gidx[gi] >> 1;
        }
        ap[i] = A + (size_t)ar * lda + c;
    }
    {
        int b = tid * 16;
        int r = b >> 6, c = (b & 63) >> 1;
        bp = Bt + (size_t)(col0 + r) * ldb + c;
    }
    f32x4 acc[4][4];
#pragma unroll
    for (int m = 0; m < 4; ++m)
#pragma unroll
        for (int n = 0; n < 4; ++n) acc[m][n] = (f32x4){0.f, 0.f, 0.f, 0.f};
    for (int kt = 0; kt < K; kt += 32) {
#pragma unroll
        for (int i = 0; i < 2; ++i) {
            int b = tid * 16 + i * 8192;
            __builtin_amdgcn_global_load_lds((const unsigned*)(ap[i] + kt), (__attribute__((address_space(3))) unsigned*)((char*)SA + b), 16, 0, 0);
        }
        __builtin_amdgcn_global_load_lds((const unsigned*)(bp + kt), (__attribute__((address_space(3))) unsigned*)((char*)SB + tid * 16), 16, 0, 0);
        asm volatile("s_waitcnt vmcnt(0)" ::: "memory");
        __syncthreads();
        bf16x8 af[4], bfr[4];
#pragma unroll
        for (int m = 0; m < 4; ++m) af[m] = *reinterpret_cast<const bf16x8*>((const char*)SA + (wr * 64 + m * 16 + fr) * 64 + fq * 16);
#pragma unroll
        for (int n = 0; n < 4; ++n) bfr[n] = *reinterpret_cast<const bf16x8*>((const char*)SB + (wc * 64 + n * 16 + fr) * 64 + fq * 16);
#pragma unroll
        for (int m = 0; m < 4; ++m)
#pragma unroll
            for (int n = 0; n < 4; ++n) acc[m][n] = __builtin_amdgcn_mfma_f32_16x16x32_bf16(bfr[n], af[m], acc[m][n], 0, 0, 0);
        __syncthreads();
    }
    epi(acc, row0 + wr * 64, col0 + wc * 64, fr, fq);
}

struct EpiStoreBf16 {
    bf16_t* O; int ldo;
    __device__ __forceinline__ void operator()(f32x4 (&acc)[4][4], int rb, int cb, int fr, int fq) const {
#pragma unroll
        for (int m = 0; m < 4; ++m)
#pragma unroll
            for (int n = 0; n < 4; ++n) {
                int row = rb + m * 16 + fr, col = cb + n * 16 + fq * 4;
                uint2 w; w.x = pack2(acc[m][n][0], acc[m][n][1]); w.y = pack2(acc[m][n][2], acc[m][n][3]);
                *reinterpret_cast<uint2*>(O + (size_t)row * ldo + col) = w;
            }
    }
};
template <int MODE>
struct EpiLora {
    float* Of; bf16_t* Ob; const float* vec; int ldo; int coff;
    __device__ __forceinline__ void operator()(f32x4 (&acc)[4][4], int rb, int cb, int fr, int fq) const {
#pragma unroll
        for (int m = 0; m < 4; ++m)
#pragma unroll
            for (int n = 0; n < 4; ++n) {
                int row = rb + m * 16 + fr, col = cb + n * 16 + fq * 4;
                float v[4];
#pragma unroll
                for (int j = 0; j < 4; ++j) {
                    float a = acc[m][n][j];
                    if (MODE == 0) {
                        float t = -(vec[col + j] + a);
                        float sp = (t > 20.f) ? t : log1pf(__expf(t));
                        float wl = -sp - 0.5f;
                        v[j] = -__expf(wl);
                    } else if (MODE == 1) {
                        v[j] = sigmoidf_(vec[col + j] + a);
                    } else if (MODE == 2) {
                        v[j] = a;
                    } else {
                        v[j] = a * vec[coff + col + j];
                    }
                }
                {
                    uint2 w; w.x = pack2(v[0], v[1]); w.y = pack2(v[2], v[3]);
                    *reinterpret_cast<uint2*>(Ob + (size_t)row * ldo + coff + col) = w;
                }
            }
    }
};
struct EpiOut {
    const float* Xprev; float* X;
    __device__ __forceinline__ void operator()(f32x4 (&acc)[4][4], int rb, int cb, int fr, int fq) const {
#pragma unroll
        for (int m = 0; m < 4; ++m)
#pragma unroll
            for (int n = 0; n < 4; ++n) {
                int row = rb + m * 16 + fr, col = cb + n * 16 + fq * 4;
                float4 xp = *reinterpret_cast<const float4*>(Xprev + (size_t)row * DM + col);
                float4 o;
                o.x = ALPHA_F * xp.x + acc[m][n][0]; o.y = ALPHA_F * xp.y + acc[m][n][1];
                o.z = ALPHA_F * xp.z + acc[m][n][2]; o.w = ALPHA_F * xp.w + acc[m][n][3];
                *reinterpret_cast<float4*>(X + (size_t)row * DM + col) = o;
            }
    }
};
struct EpiExp1 {
    bf16_t* H; int base; int cnt;
    __device__ __forceinline__ void operator()(f32x4 (&acc)[4][4], int rb, int cb, int fr, int fq) const {
#pragma unroll
        for (int m = 0; m < 4; ++m) {
            int li = rb + m * 16 + fr;
            if (li < cnt) {
#pragma unroll
                for (int i = 0; i < 2; ++i) {
                    int hcol = (cb >> 1) + i * 16 + fq * 4;
                    float v[4];
#pragma unroll
                    for (int j = 0; j < 4; ++j) v[j] = siluf_(acc[m][2 * i][j]) * acc[m][2 * i + 1][j];
                    uint2 w; w.x = pack2(v[0], v[1]); w.y = pack2(v[2], v[3]);
                    *reinterpret_cast<uint2*>(H + (size_t)(base + li) * 128 + hcol) = w;
                }
            }
        }
    }
};
struct EpiExp2 {
    bf16_t* FS; const int* ltok; const float* lgate; int cnt;
    __device__ __forceinline__ void operator()(f32x4 (&acc)[4][4], int rb, int cb, int fr, int fq) const {
#pragma unroll
        for (int m = 0; m < 4; ++m) {
            int li = rb + m * 16 + fr;
            if (li < cnt) {
                int pk = ltok[li]; float g = lgate[li];
                int tok = pk >> 1, j = pk & 1;
                bf16_t* o = FS + ((size_t)j * NT + tok) * DM;
#pragma unroll
                for (int n = 0; n < 4; ++n) {
                    int col = cb + n * 16 + fq * 4;
                    uint2 w; w.x = pack2(acc[m][n][0] * g, acc[m][n][1] * g); w.y = pack2(acc[m][n][2] * g, acc[m][n][3] * g);
                    *reinterpret_cast<uint2*>(o + col) = w;
                }
            }
        }
    }
};

namespace pg8 {
#define PG8_LAS __attribute__((address_space(3)))
typedef unsigned short bf16_t;
typedef short bf16x8 __attribute__((ext_vector_type(8)));
typedef float f32x4 __attribute__((ext_vector_type(4)));
typedef unsigned u32x4 __attribute__((ext_vector_type(4)));
constexpr int BM = 256, BK = 64, HALF = 128, HTB = HALF * BK * 2  , STAGE_BYTES = 8 * HTB, NXCD = 8, WGM = 8;

__host__ __device__ __forceinline__ int lds_byte(int r, int c) { const int st = (r >> 4) * 2 + (c >> 5), rr = r & 15, cc = c & 31, ob = rr * 64 + cc * 2; return st * 1024 + (ob ^ (((ob >> 9) & 1) << 5)); }
__host__ __device__ __forceinline__ void stage_rc(int b, int& R, int& C) { const int st = b / 1024, sb = b % 1024, swz = sb ^ (((sb >> 9) & 1) << 5); R = (st >> 1) * 16 + swz / 64; C = (st & 1) * 32 + (swz % 64) / 2; }
__host__ __device__ __forceinline__ int perm32(int rho) { const int n = rho >> 4, i = rho & 15; return 8 * (i >> 2) + 4 * n + (i & 3); }

struct Unit { int pm, pn; };
struct Gemm { const bf16_t* A; const bf16_t* Bt; int M, N, K; };

struct StaticOrder {
    int nM, nN, nwg, G, c;
    __host__ __device__ void init(int M, int N, int G_, int c_) { nM = M / BM; nN = N / BM; nwg = nM * nN; G = G_; c = c_; }
    __host__ __device__ bool next(int i, Unit& u) const {
        const long L = (long)i * G + c; if (L >= nwg) return false;
        int wgid = (int)L; { const int q = nwg / NXCD, r = nwg % NXCD, xcd = wgid % NXCD, off = wgid / NXCD; wgid = (xcd < r ? xcd * (q + 1) : r * (q + 1) + (xcd - r) * q) + off; }
        const int nig = WGM * nN, gid = wgid / nig, fm = gid * WGM, gsz = (nM - fm) < WGM ? (nM - fm) : WGM;
        u.pm = fm + ((wgid % nig) % gsz); u.pn = (wgid % nig) / gsz; return true;
    }
    __device__ __forceinline__ void a_ready(const Unit&) const {}
    __device__ __forceinline__ void done(const Unit&) const {}
};
template <class Epi, class Sched, bool ALIGN_EPI = false, bool SP2 = false>
__device__ __forceinline__ void gemm_phase(PG8_LAS unsigned char* lds, const Gemm g, const Sched& S, const Epi& E, int wave) {
    const int tid = otid(wave), wid = __builtin_amdgcn_readfirstlane(tid >> 6), lane = tid & 63, wr = wid >> 2, wc = wid & 3, fr = lane & 15, fq = lane >> 4;
    const int K = g.K, nt = K / BK;
    unsigned voffA[2], voffB[2];
#pragma unroll
    for (int i = 0; i < 2; ++i) { int R, C; stage_rc(tid * 16 + i * 8192, R, C); const int Rb = Epi::PERM ? ((R & ~31) + perm32(R & 31)) : R;
        voffA[i] = (unsigned)(R * K + C) * 2u; voffB[i] = (unsigned)(Rb * K + C) * 2u; }
    const size_t kstep = (size_t)(BK * 2);
    const size_t hstep = (size_t)HALF * K * 2;
    const size_t tstep = 2 * hstep;
    const unsigned ldsw = (unsigned)wid * 1024u;
    const int aoff = lds_byte(wr * 64 + fr, fq * 8), boff = lds_byte(wc * 32 + fr, fq * 8);
#define PG8_SA(b, h) (((b) * 2 + (h)) * HTB)
#define PG8_SB(b, h) ((4 + (b) * 2 + (h)) * HTB)
#define PG8_STAGE(bufoff, gbase, voff) do { _Pragma("unroll") for (int _i = 0; _i < 2; ++_i) \
        __builtin_amdgcn_global_load_lds((const unsigned*)((const char*)(gbase) + (voff)[_i]), (PG8_LAS unsigned*)(lds + (bufoff) + ldsw + _i * 8192), 16, 0, 0); } while (0)
#define PG8_LDA(dst, b, h) do { _Pragma("unroll") for (int m = 0; m < 4; ++m) _Pragma("unroll") for (int k = 0; k < 2; ++k) dst[m][k] = *(const PG8_LAS bf16x8*)(lds + PG8_SA(b, h) + aoff + m * 2048 + k * 1024); } while (0)
#define PG8_LDB(dst, b, h) do { _Pragma("unroll") for (int n = 0; n < 2; ++n) _Pragma("unroll") for (int k = 0; k < 2; ++k) dst[n][k] = *(const PG8_LAS bf16x8*)(lds + PG8_SB(b, h) + boff + n * 2048 + k * 1024); } while (0)
#define PG8_MMA(ai, bj, At, Bt) do { __builtin_amdgcn_s_setprio(1); _Pragma("unroll") for (int m = 0; m < 4; ++m) _Pragma("unroll") for (int n = 0; n < 2; ++n) _Pragma("unroll") for (int k = 0; k < 2; ++k) \
        acc[ai][bj][m][n] = __builtin_amdgcn_mfma_f32_16x16x32_bf16(Bt[n][k], At[m][k], acc[ai][bj][m][n], 0, 0, 0); __builtin_amdgcn_s_setprio(0); } while (0)
#define PG8_WAIT_V(n) asm volatile("s_waitcnt vmcnt(" #n ")" ::: "memory")
#define PG8_WAIT_L(n) asm volatile("s_waitcnt lgkmcnt(" #n ")" ::: "memory")
#define PG8_BAR __builtin_amdgcn_s_barrier()
#define PG8_SCHED __builtin_amdgcn_sched_barrier(0)
    Unit cur, nxt; int ui = 0;
    if (!S.next(0, cur)) return;
    f32x4 acc[2][2][4][2];
#pragma unroll
    for (int a = 0; a < 2; ++a)
#pragma unroll
        for (int b = 0; b < 2; ++b)
#pragma unroll
            for (int m = 0; m < 4; ++m)
#pragma unroll
                for (int n = 0; n < 2; ++n) acc[a][b][m][n] = (f32x4){0.f, 0.f, 0.f, 0.f};
    bf16x8 At[4][2], B0[2][2], B1[2][2];
    const char* cA = (const char*)g.A + (size_t)cur.pm * tstep; const char* cB = (const char*)g.Bt + (size_t)cur.pn * tstep;
    S.a_ready(cur);
    if constexpr (SP2) {
        PG8_STAGE(PG8_SB(0, 0), cB, voffB); PG8_STAGE(PG8_SB(0, 1), cB + hstep, voffB); PG8_STAGE(PG8_SA(0, 0), cA, voffA); PG8_STAGE(PG8_SA(0, 1), cA + hstep, voffA);
        if (wr == 1) PG8_BAR;
        PG8_WAIT_V(2); PG8_BAR;
        PG8_STAGE(PG8_SB(1, 0), cB + kstep, voffB); PG8_STAGE(PG8_SA(1, 0), cA + kstep, voffA); PG8_STAGE(PG8_SB(1, 1), cB + hstep + kstep, voffB);
        PG8_WAIT_V(6); PG8_BAR;
    } else {
        PG8_STAGE(PG8_SB(0, 0), cB, voffB); PG8_STAGE(PG8_SA(0, 0), cA, voffA); PG8_STAGE(PG8_SB(0, 1), cB + hstep, voffB); PG8_STAGE(PG8_SA(0, 1), cA + hstep, voffA);
        if (wr == 1) PG8_BAR;
        PG8_WAIT_V(4); PG8_BAR;
        PG8_STAGE(PG8_SB(1, 0), cB + kstep, voffB); PG8_STAGE(PG8_SA(1, 0), cA + kstep, voffA); PG8_STAGE(PG8_SB(1, 1), cB + hstep + kstep, voffB);
        PG8_WAIT_V(6); PG8_BAR;
    }
    for (;;) {
        const bool has_next = S.next(ui + 1, nxt);
        const char* nA = has_next ? (const char*)g.A + (size_t)nxt.pm * tstep : cA; const char* nB = has_next ? (const char*)g.Bt + (size_t)nxt.pn * tstep : cB;
        for (int t = 0; t < nt; t += 2) {
            const bool last = (t == nt - 2);
            const char* a1 = cA + (size_t)(t + 1) * kstep;
            const char* a2 = last ? nA : cA + (size_t)(t + 2) * kstep; const char* b2 = last ? nB : cB + (size_t)(t + 2) * kstep;
            const char* a3 = a2 + kstep; const char* b3 = b2 + kstep;
            if (last && has_next) S.a_ready(nxt);
            if constexpr (SP2) {
            PG8_LDB(B0, 0, 0); PG8_LDB(B1, 0, 1); PG8_SCHED; PG8_LDA(At, 0, 0); PG8_STAGE(PG8_SA(1, 1), a1 + hstep, voffA);
            PG8_WAIT_V(8); PG8_WAIT_L(0); PG8_BAR; PG8_MMA(0, 0, At, B0); PG8_MMA(0, 1, At, B1); PG8_BAR; PG8_SCHED;
            PG8_LDA(At, 0, 1); PG8_STAGE(PG8_SB(0, 0), b2, voffB); PG8_STAGE(PG8_SB(0, 1), b2 + hstep, voffB); PG8_STAGE(PG8_SA(0, 0), a2, voffA);
            PG8_WAIT_V(8); PG8_WAIT_L(0); PG8_BAR; PG8_MMA(1, 0, At, B0); PG8_MMA(1, 1, At, B1); PG8_BAR; PG8_SCHED;
            PG8_LDB(B0, 1, 0); PG8_LDB(B1, 1, 1); PG8_SCHED; PG8_LDA(At, 1, 0); PG8_STAGE(PG8_SA(0, 1), a2 + hstep, voffA);
            PG8_WAIT_V(8); PG8_WAIT_L(0); PG8_BAR; PG8_MMA(0, 0, At, B0); PG8_MMA(0, 1, At, B1); PG8_BAR; PG8_SCHED;
            PG8_LDA(At, 1, 1); PG8_STAGE(PG8_SB(1, 0), b3, voffB); PG8_STAGE(PG8_SB(1, 1), b3 + hstep, voffB); PG8_STAGE(PG8_SA(1, 0), a3, voffA);
            PG8_WAIT_V(8); PG8_WAIT_L(0); PG8_BAR; PG8_MMA(1, 0, At, B0); PG8_MMA(1, 1, At, B1); PG8_BAR; PG8_SCHED;
            } else {
            PG8_LDB(B0, 0, 0); PG8_SCHED; PG8_LDA(At, 0, 0); PG8_STAGE(PG8_SA(1, 1), a1 + hstep, voffA);
            PG8_WAIT_L(8); PG8_BAR; PG8_WAIT_L(0); PG8_MMA(0, 0, At, B0); PG8_BAR; PG8_SCHED;
            PG8_LDB(B1, 0, 1); PG8_STAGE(PG8_SB(0, 0), b2, voffB);
            PG8_BAR; PG8_WAIT_L(0); PG8_MMA(0, 1, At, B1); PG8_BAR;
            PG8_LDA(At, 0, 1); PG8_STAGE(PG8_SA(0, 0), a2, voffA);
            PG8_BAR; PG8_WAIT_L(0); PG8_MMA(1, 0, At, B0); PG8_BAR; PG8_SCHED;
            PG8_STAGE(PG8_SB(0, 1), b2 + hstep, voffB);
            PG8_WAIT_V(6); PG8_BAR; PG8_MMA(1, 1, At, B1); PG8_BAR;
            PG8_LDB(B0, 1, 0); PG8_SCHED; PG8_LDA(At, 1, 0); PG8_STAGE(PG8_SA(0, 1), a2 + hstep, voffA);
            PG8_WAIT_L(8); PG8_BAR; PG8_WAIT_L(0); PG8_MMA(0, 0, At, B0); PG8_BAR; PG8_SCHED;
            PG8_LDB(B1, 1, 1); PG8_STAGE(PG8_SB(1, 0), b3, voffB);
            PG8_BAR; PG8_WAIT_L(0); PG8_MMA(0, 1, At, B1); PG8_BAR;
            PG8_LDA(At, 1, 1); PG8_STAGE(PG8_SA(1, 0), a3, voffA);
            PG8_BAR; PG8_WAIT_L(0); PG8_MMA(1, 0, At, B0); PG8_BAR; PG8_SCHED;
            PG8_STAGE(PG8_SB(1, 1), b3 + hstep, voffB);
            PG8_WAIT_V(6); PG8_BAR; PG8_MMA(1, 1, At, B1); PG8_BAR;
            }
        }
        if constexpr (ALIGN_EPI) { if (wr == 0) PG8_BAR; }
        if constexpr (!Epi::AFTER_DRAIN) { E(acc, cur, wr, wc, fr, fq); S.done(cur); }
        if (!has_next) break;
#pragma unroll
        for (int a = 0; a < 2; ++a)
#pragma unroll
            for (int b = 0; b < 2; ++b)
#pragma unroll
                for (int m = 0; m < 4; ++m)
#pragma unroll
                    for (int n = 0; n < 2; ++n) acc[a][b][m][n] = (f32x4){0.f, 0.f, 0.f, 0.f};
        cur = nxt; cA = nA; cB = nB; ++ui;
        if constexpr (ALIGN_EPI) { if (wr == 1) PG8_BAR; }
    }
    PG8_WAIT_V(0);
    if constexpr (!ALIGN_EPI) { if (wr == 0) PG8_BAR; }
    PG8_BAR;
    if constexpr (Epi::AFTER_DRAIN) { E.fused(acc, cur, wr, wc, fr, fq, lds, wid, lane); S.done(cur); }
#undef PG8_SA
#undef PG8_SB
#undef PG8_STAGE
#undef PG8_LDA
#undef PG8_LDB
#undef PG8_MMA
#undef PG8_WAIT_V
#undef PG8_WAIT_L
#undef PG8_BAR
#undef PG8_SCHED
}
}
struct PEpiBf16 {
    static constexpr bool PERM = true, AFTER_DRAIN = false;
    bf16_t* O; int ldo;
    __device__ __forceinline__ void operator()(const pg8::f32x4 (&acc)[2][2][4][2], const pg8::Unit& u, int wr, int wc, int fr, int fq) const {
        const int row0 = u.pm * 256 + wr * 64 + fr, col0 = u.pn * 256 + wc * 32 + 8 * fq;
#pragma unroll
        for (int ai = 0; ai < 2; ++ai)
#pragma unroll
            for (int m = 0; m < 4; ++m) {
                bf16_t* rowp = O + (size_t)(row0 + ai * 128 + m * 16) * ldo + col0;
#pragma unroll
                for (int bj = 0; bj < 2; ++bj) {
                    const pg8::f32x4 v0 = acc[ai][bj][m][0], v1 = acc[ai][bj][m][1];
                    uint4 w; w.x = pack2(v0[0], v0[1]); w.y = pack2(v0[2], v0[3]); w.z = pack2(v1[0], v1[1]); w.w = pack2(v1[2], v1[3]);
                    *reinterpret_cast<uint4*>(rowp + bj * 128) = w;
                }
            }
    }
};
struct PEpiOut {
    static constexpr bool PERM = false, AFTER_DRAIN = false;
    const float* Xprev; float* X;
    __device__ __forceinline__ void operator()(const pg8::f32x4 (&acc)[2][2][4][2], const pg8::Unit& u, int wr, int wc, int fr, int fq) const {
        const int row0 = u.pm * 256 + wr * 64 + fr, col0 = u.pn * 256 + wc * 32 + 4 * fq;
#pragma unroll
        for (int ai = 0; ai < 2; ++ai)
#pragma unroll
            for (int m = 0; m < 4; ++m) {
                const size_t ro = (size_t)(row0 + ai * 128 + m * 16) * DM + col0;
#pragma unroll
                for (int bj = 0; bj < 2; ++bj)
#pragma unroll
                    for (int n = 0; n < 2; ++n) {
                        const size_t o = ro + bj * 128 + n * 16;
                        float4 xp = *reinterpret_cast<const float4*>(Xprev + o);
                        const pg8::f32x4 a = acc[ai][bj][m][n];
                        float4 r;
                        r.x = ALPHA_F * xp.x + a[0]; r.y = ALPHA_F * xp.y + a[1]; r.z = ALPHA_F * xp.z + a[2]; r.w = ALPHA_F * xp.w + a[3];
                        *reinterpret_cast<float4*>(X + o) = r;
                    }
            }
    }
};
template <class Epi>
__device__ __forceinline__ void big_gemm(const bf16_t* A, const bf16_t* Bt, int M, int N, int K, const Epi& e, unsigned char* smem, int wave) {
    pg8::Gemm g{A, Bt, M, N, K};
    pg8::StaticOrder S;
    S.init(M, N, ogdim(), obid());
    pg8::gemm_phase<Epi, pg8::StaticOrder, false, false>((PG8_LAS unsigned char*)smem, g, S, e, wave);
}

__device__ __forceinline__ void tconv_tile(const float* __restrict__ src, int N, bf16_t* __restrict__ dst, int ldd, int k0, int n0,
                                           int mode, float* tile  , int tid) {
#pragma unroll
    for (int i = 0; i < 8; ++i) {
        int r = i * 8 + (tid >> 6), c = tid & 63;
        tile[r * 65 + c] = src[(size_t)(k0 + r) * N + n0 + c];
    }
    __syncthreads();
#pragma unroll
    for (int i = 0; i < 8; ++i) {
        int nn = i * 8 + (tid >> 6), kk = tid & 63;
        int n = n0 + nn;
        int drow = n;
        if (mode == 1) drow = (n >> 4) * 32 + (n & 15);
        else if (mode == 2) drow = (n >> 4) * 32 + 16 + (n & 15);
        dst[(size_t)drow * ldd + k0 + kk] = f2bf(tile[kk * 65 + nn]);
    }
    __syncthreads();
}

__device__ __forceinline__ void phase_pre(const Params& p, unsigned char* smem) {
    const int tidx = otid(p.wave);
    float* tile = reinterpret_cast<float*>(smem);
    bf16_t* W = reinterpret_cast<bf16_t*>(p.ws + OFF_W);
    if (obid() == 0) {
        if (tidx < 64) reinterpret_cast<int*>(p.ws + OFF_CTRL)[tidx] = 0;
        unsigned* bar = reinterpret_cast<unsigned*>(p.ws + OFF_CTRL + 4096);
        for (int i = tidx; i < XCD_BAR_WORDS; i += NTHREADS) bar[i] = 0u;
    }
    constexpr int T0 = 576, T1 = 256, T2 = 768, T3 = 256, T4 = 2048, T5 = 2048, T6 = 2048, T7 = 8, T8 = 8, T9 = 16, T10 = 16;
    constexpr int TOT = T0 + T1 + T2 + T3 + T4 + T5 + T6 + T7 + T8 + T9 + T10;
    for (int u = obid(); u < TOT; u += ogdim()) {
        int v = u;
        const float* src; bf16_t* dst; int K, N, mode = 0, tk, tn;
        if (v < T0) { src = p.in[1]; K = 1024; N = 2304; dst = W + WE_IN0; tk = v / 36; tn = v % 36; }
        else if ((v -= T0) < T1) { src = p.in[15]; K = 1024; N = 1024; dst = W + WE_OUT0; tk = v / 16; tn = v % 16; }
        else if ((v -= T1) < T2) { src = p.in[16]; K = 1024; N = 3072; dst = W + WE_IN1; tk = v / 48; tn = v % 48; }
        else if ((v -= T2) < T3) { src = p.in[23]; K = 1024; N = 1024; dst = W + WE_OUT1; tk = v / 16; tn = v % 16; }
        else if ((v -= T3) < T4) { int mat = v >> 5, w = v & 31; src = p.in[30] + (size_t)mat * 131072; K = 1024; N = 128; dst = W + WE_W13 + (size_t)mat * 262144; mode = 1; tk = w >> 1; tn = w & 1; }
        else if ((v -= T4) < T5) { int mat = v >> 5, w = v & 31; src = p.in[31] + (size_t)mat * 131072; K = 1024; N = 128; dst = W + WE_W13 + (size_t)mat * 262144; mode = 2; tk = w >> 1; tn = w & 1; }
        else if ((v -= T5) < T6) { int mat = v >> 5, w = v & 31; src = p.in[32] + (size_t)mat * 131072; K = 128; N = 1024; dst = W + WE_W2 + (size_t)mat * 131072; tk = w >> 4; tn = w & 15; }
        else if ((v -= T6) < T7) { src = p.in[4]; K = 64; N = 512; dst = W + WE_LW2; tk = 0; tn = v; }
        else if ((v -= T7) < T8) { src = p.in[6]; K = 64; N = 512; dst = W + WE_LA2; tk = 0; tn = v; }
        else if ((v -= T8) < T9) { src = p.in[7]; K = 128; N = 512; dst = W + WE_LG2; tk = v >> 3; tn = v & 7; }
        else { v -= T9; int mat = v >> 2, w = v & 3; src = p.in[13] + (size_t)mat * 16384; K = 128; N = 128; dst = W + WE_POOL + (size_t)mat * 16384; tk = w >> 1; tn = w & 1; }
        tconv_tile(src, N, dst, K, tk * 64, tn * 64, mode, tile, tidx);
    }
    {
        const float4* x4 = reinterpret_cast<const float4*>(p.in[0]);
        uint2* xb = reinterpret_cast<uint2*>(p.ws + OFF_ACTB);
        const size_t n4 = (size_t)NT * DM / 4;
        for (size_t i = (size_t)obid() * NTHREADS + tidx; i < n4; i += (size_t)ogdim() * NTHREADS) {
            float4 v = x4[i];
            uint2 w; w.x = pack2(v.x, v.y); w.y = pack2(v.z, v.w);
            xb[i] = w;
        }
    }
    {
        bf16_t* RH = W + WE_RT_HI; bf16_t* RL = W + WE_RT_LO;
        for (int i = obid() * NTHREADS + tidx; i < 2 * 48 * 1024; i += ogdim() * NTHREADS) {
            const int l = i / (48 * 1024), r = i - l * 48 * 1024, n = r >> 10, k = r & 1023;
            float w = 0.f;
            if (n < 4) w = p.in[26][((size_t)l * 1024 + k) * 4 + n];
            else if (n < 36) w = p.in[28][((size_t)l * 1024 + k) * 32 + (n - 4)];
            const bf16_t h = f2bf(w);
            RH[i] = h; RL[i] = f2bf(w - bf2f(h));
        }
    }
    {
        float2* rope = reinterpret_cast<float2*>(p.ws + OFF_ROPE);
        for (int i = obid() * NTHREADS + tidx; i < SEQ * 32; i += ogdim() * NTHREADS) {
            int pos = i >> 5, k = i & 31;
            float inv = powf(10000.0f, -(float)k / 32.0f);
            float ang = (float)pos * inv;
            float s, c;
            sincosf(ang, &s, &c);
            rope[i] = make_float2(c, s);
        }
    }
}

__device__ __forceinline__ void phase_l0_prep(const Params& p) {
    const int tidx = otid(p.wave);
    const bf16_t* P = reinterpret_cast<const bf16_t*>(p.ws + OFF_P);
    bf16_t* LA = reinterpret_cast<bf16_t*>(p.ws + OFF_LORA);
    bf16_t* PO = reinterpret_cast<bf16_t*>(p.ws + OFF_POOLED);
    const float* mu = p.in[2];
    const int total = NT * 96;
    for (int it = obid() * NTHREADS + tidx; it < total; it += ogdim() * NTHREADS) {
        const int tok = it / 96, j = it - tok * 96;
        const int s = tok & (SEQ - 1);
        if (j < 32) {
            const int col = 1536 + j * 8;
            float cur[8], prv[8];
            unpack8(*reinterpret_cast<const uint4*>(P + (size_t)tok * 2304 + col), cur);
            if (s > 0) unpack8(*reinterpret_cast<const uint4*>(P + (size_t)(tok - 1) * 2304 + col), prv);
            else {
#pragma unroll
                for (int i = 0; i < 8; ++i) prv[i] = 0.f;
            }
            const float4 m0 = *reinterpret_cast<const float4*>(mu + col), m1 = *reinterpret_cast<const float4*>(mu + col + 4);
            const float mm[8] = {m0.x, m0.y, m0.z, m0.w, m1.x, m1.y, m1.z, m1.w};
            float o[8];
#pragma unroll
            for (int i = 0; i < 8; ++i) {
                const float z = cur[i] + mm[i] * (prv[i] - cur[i]);
                o[i] = (j < 8) ? tanhf(z) : ((j < 16) ? z : sigmoidf_(z));
            }
            uint4 w; w.x = pack2(o[0], o[1]); w.y = pack2(o[2], o[3]); w.z = pack2(o[4], o[5]); w.w = pack2(o[6], o[7]);
            *reinterpret_cast<uint4*>(LA + (size_t)tok * 256 + j * 8) = w;
        } else {
            const int cc = (j - 32) * 8;
            const int gi = cc >> 7;
            const int win = 2 << gi;
            const int cnt = (s + 1 < win) ? (s + 1) : win;
            const bf16_t* src = P + (size_t)tok * 2304 + 1792 + cc;
            float u[8], sum[8];
            unpack8(*reinterpret_cast<const uint4*>(src), u);
#pragma unroll
            for (int i = 0; i < 8; ++i) sum[i] = u[i];
            for (int r = 1; r < cnt; ++r) {
                float t[8];
                unpack8(*reinterpret_cast<const uint4*>(src - (size_t)r * 2304), t);
#pragma unroll
                for (int i = 0; i < 8; ++i) sum[i] += t[i];
            }
            const float inv = 1.0f / (float)cnt;
            uint4 w;
            w.x = pack2(sum[0] * inv - u[0], sum[1] * inv - u[1]); w.y = pack2(sum[2] * inv - u[2], sum[3] * inv - u[3]);
            w.z = pack2(sum[4] * inv - u[4], sum[5] * inv - u[5]); w.w = pack2(sum[6] * inv - u[6], sum[7] * inv - u[7]);
            *reinterpret_cast<uint4*>(PO + (size_t)tok * 512 + cc) = w;
        }
    }
}

__device__ __forceinline__ void phase_l0_lora(const Params& p, bf16_t* smem) {
    const bf16_t* W = reinterpret_cast<const bf16_t*>(p.ws + OFF_W);
    const bf16_t* LA = reinterpret_cast<const bf16_t*>(p.ws + OFF_LORA);
    const bf16_t* PO = reinterpret_cast<const bf16_t*>(p.ws + OFF_POOLED);
    for (int t = obid(); t < 2048; t += ogdim()) {
        int job = t >> 9, w = t & 511;
        if (job == 0) {
            EpiLora<0> e{nullptr, reinterpret_cast<bf16_t*>(p.ws + OFF_LOGW), p.in[3], 512, 0};
            gemm_tile<false>(LA, 256, nullptr, 0, W + WE_LW2, 64, 64, (w >> 2) * 256, (w & 3) * 128, e, smem, p.wave);
        } else if (job == 1) {
            EpiLora<1> e{nullptr, reinterpret_cast<bf16_t*>(p.ws + OFF_AA), p.in[5], 512, 0};
            gemm_tile<false>(LA + 64, 256, nullptr, 0, W + WE_LA2, 64, 64, (w >> 2) * 256, (w & 3) * 128, e, smem, p.wave);
        } else if (job == 2) {
            EpiLora<2> e{nullptr, reinterpret_cast<bf16_t*>(p.ws + OFF_GG), nullptr, 512, 0};
            gemm_tile<false>(LA + 128, 256, nullptr, 0, W + WE_LG2, 128, 128, (w >> 2) * 256, (w & 3) * 128, e, smem, p.wave);
        } else {
            int g = w & 3, tm = w >> 2;
            EpiLora<3> e{nullptr, reinterpret_cast<bf16_t*>(p.ws + OFF_YCAT), p.in[14] - 512, 1024, 512 + g * 128};
            gemm_tile<false>(PO + g * 128, 512, nullptr, 0, W + WE_POOL + g * 16384, 128, 128, tm * 256, 0, e, smem, p.wave);
        }
    }
}

#define RC_LD 72
#define RC_BUF (64 * RC_LD)
#define RC_BYTES (RC_BUF * 2)
#define OFF_TBUF OFF_KVT

__device__ __forceinline__ void mm64(f32x4 (&acc)[2], const bf16_t* A, const bf16_t* Bt, int mt, int nt0, int fr, int fq) {
#pragma unroll
    for (int ks = 0; ks < 2; ++ks) {
        bf16x8 af = *reinterpret_cast<const bf16x8*>(A + (mt * 16 + fr) * RC_LD + ks * 32 + fq * 8);
        bf16x8 bq[2];
#pragma unroll
        for (int n = 0; n < 2; ++n) bq[n] = *reinterpret_cast<const bf16x8*>(Bt + ((nt0 + n) * 16 + fr) * RC_LD + ks * 32 + fq * 8);
#pragma unroll
        for (int n = 0; n < 2; ++n) acc[n] = __builtin_amdgcn_mfma_f32_16x16x32_bf16(af, bq[n], acc[n], 0, 0, 0);
    }
}
template <int MASK>
__device__ __forceinline__ void store_T(bf16_t* dst, const f32x4 (&acc)[2], int mt, int nt0, int fr, int fq) {
#pragma unroll
    for (int n = 0; n < 2; ++n) {
        const int C = (nt0 + n) * 16 + fr, R0 = mt * 16 + fq * 4;
        float v[4];
#pragma unroll
        for (int j = 0; j < 4; ++j) {
            const int R = R0 + j;
            bool keep = true;
            if (MASK == 1) keep = R < C;
            else if (MASK == 2) keep = R <= C;
            else if (MASK == 3) keep = C < R;
            v[j] = keep ? acc[n][j] : 0.f;
        }
        uint2 w; w.x = pack2(v[0], v[1]); w.y = pack2(v[2], v[3]);
        *reinterpret_cast<uint2*>(dst + C * RC_LD + R0) = w;
    }
}
__device__ __forceinline__ void zero_acc(f32x4 (&acc)[2]) {
    acc[0] = (f32x4){0.f, 0.f, 0.f, 0.f};
    acc[1] = (f32x4){0.f, 0.f, 0.f, 0.f};
}

#define OFF_NTB (OFF_P + 144ull * MIB)
#define OFF_S0A (OFF_P + 176ull * MIB)
#define OFF_TB (420ull * MIB)
#define OFF_MB (452ull * MIB)
#define OFF_S0B (484ull * MIB)
#define OFF_WLB (500ull * MIB)
__device__ __forceinline__ bf16_t* s0_ptr(unsigned char* ws, int u) {
    return reinterpret_cast<bf16_t*>(ws + (u < 2048 ? OFF_S0A : OFF_S0B)) + (size_t)(u & 2047) * 4096;
}

template <int MODE>
__device__ __forceinline__ void rwkv_prep(const Params& p, int b, int h, int n, int tid, bf16_t* At, bf16_t* Bt, bf16_t* Kt, bf16_t* Rt,
                                          bf16_t* AtT, bf16_t* BtT, bf16_t* KtT, bf16_t* VT, float* sTot, float* sBC, float* sWL) {
    const int lane = tid & 63, q = tid >> 6;
    const int c = h * 64 + lane;
    const bf16_t* P = reinterpret_cast<const bf16_t*>(p.ws + OFF_P);
    const bf16_t* LOGW = reinterpret_cast<const bf16_t*>(p.ws + OFF_LOGW);
    const bf16_t* AA = reinterpret_cast<const bf16_t*>(p.ws + OFF_AA);
    const float mu_k = p.in[2][512 + c];
    const float kkc = p.in[8][c];
    const float kac = p.in[9][c];
    const float mu_v = p.in[2][1024 + c];
    float mu_r = 0.f, rkc = 0.f;
    if (MODE == 2) { mu_r = p.in[2][c]; rkc = p.in[10][c]; }
    const int s0 = n * 64 + q * 8;
    const size_t tok0 = (size_t)b * SEQ + s0;
    float lw[8], av[8], zk[8], zr[8], zv[8];
    float pk = 0.f, pr = 0.f, pv = 0.f;
    if (s0 > 0) {
        const bf16_t* pp = P + (tok0 - 1) * 2304;
        pk = bf2f(pp[512 + c]); pv = bf2f(pp[1024 + c]);
        if (MODE == 2) pr = bf2f(pp[c]);
    }
#pragma unroll
    for (int i = 0; i < 8; ++i) {
        const bf16_t* pp = P + (tok0 + i) * 2304;
        float k0 = bf2f(pp[512 + c]), v0 = bf2f(pp[1024 + c]);
        zk[i] = k0 + mu_k * (pk - k0); pk = k0;
        zv[i] = v0 + mu_v * (pv - v0); pv = v0;
        if (MODE == 2) { float r0 = bf2f(pp[c]); zr[i] = r0 + mu_r * (pr - r0); pr = r0; }
        lw[i] = bf2f(LOGW[(tok0 + i) * 512 + c]);
        av[i] = bf2f(AA[(tok0 + i) * 512 + c]);
    }
    float lws[8];
    float cs = 0.f;
#pragma unroll
    for (int i = 0; i < 8; ++i) { cs += lw[i]; lws[i] = cs; }
    sTot[q * 64 + lane] = cs;
    __syncthreads();
    float off = 0.f, tot = 0.f;
#pragma unroll
    for (int qq = 0; qq < 8; ++qq) { float tq = sTot[qq * 64 + lane]; if (qq < q) off += tq; tot += tq; }
    float atv[8], btv[8], ktv[8];
#pragma unroll
    for (int i = 0; i < 8; ++i) {
        const int t = q * 8 + i;
        const float L = lws[i] + off;
        float kk = zk[i] * kkc;
        float ss = wave_sum(kk * kk);
        kk *= rsqrtf(fmaxf(ss, 1e-24f));
        const float e_neg = __expf(-L), e_prev = __expf(L - lw[i]);
        const float a = av[i];
        const float at = -kk * e_prev;
        At[t * RC_LD + lane] = f2bf(at);
        const float bt = kk * a * e_neg;
        Bt[t * RC_LD + lane] = f2bf(bt);
        const float kp = zk[i] * (1.0f + (a - 1.0f) * kac);
        const float kt = kp * e_neg;
        Kt[t * RC_LD + lane] = f2bf(kt);
        atv[i] = at; btv[i] = bt; ktv[i] = kt;
        if (MODE == 2) {
            Rt[t * RC_LD + lane] = f2bf(zr[i] * __expf(L));
            const float bc = wave_sum(zr[i] * kp * rkc);
            if (lane == 0) sBC[t] = bc;
        }
    }
    uint4 w0;
    if (MODE == 1) {
        w0.x = pack2(atv[0], atv[1]); w0.y = pack2(atv[2], atv[3]); w0.z = pack2(atv[4], atv[5]); w0.w = pack2(atv[6], atv[7]);
        *reinterpret_cast<uint4*>(AtT + lane * RC_LD + q * 8) = w0;
        w0.x = pack2(btv[0], btv[1]); w0.y = pack2(btv[2], btv[3]); w0.z = pack2(btv[4], btv[5]); w0.w = pack2(btv[6], btv[7]);
        *reinterpret_cast<uint4*>(BtT + lane * RC_LD + q * 8) = w0;
        w0.x = pack2(ktv[0], ktv[1]); w0.y = pack2(ktv[2], ktv[3]); w0.z = pack2(ktv[4], ktv[5]); w0.w = pack2(ktv[6], ktv[7]);
        *reinterpret_cast<uint4*>(KtT + lane * RC_LD + q * 8) = w0;
        if (q == 0) sWL[lane] = __expf(tot);
    }
    w0.x = pack2(zv[0], zv[1]); w0.y = pack2(zv[2], zv[3]); w0.z = pack2(zv[4], zv[5]); w0.w = pack2(zv[6], zv[7]);
    *reinterpret_cast<uint4*>(VT + lane * RC_LD + q * 8) = w0;
}

__device__ __forceinline__ void phase_rwkv_r1(const Params& p, unsigned char* smem) {
    const int tidx = otid(p.wave);
    const int tid = tidx, wv = tid >> 6, lane = tid & 63, fr = lane & 15, fq = lane >> 4, mt = wv >> 1, nt0 = (wv & 1) * 2;
    bf16_t* base = reinterpret_cast<bf16_t*>(smem);
    bf16_t* At = base; bf16_t* Bt = base + RC_BUF; bf16_t* Kt = base + 2 * RC_BUF; bf16_t* AtT = base + 3 * RC_BUF;
    bf16_t* BtT = base + 4 * RC_BUF; bf16_t* KtT = base + 5 * RC_BUF; bf16_t* VT = base + 6 * RC_BUF;
    bf16_t* Tm = base + 7 * RC_BUF; bf16_t* Aak = base + 8 * RC_BUF; bf16_t* PT = base + 9 * RC_BUF;
    bf16_t* AkVT = base + 10 * RC_BUF; bf16_t* QT = base + 11 * RC_BUF;
    float* sTot = reinterpret_cast<float*>(smem + 13 * RC_BYTES);
    float* sWL = sTot + 512;
    bf16_t* Tg = reinterpret_cast<bf16_t*>(p.ws + OFF_TB);
    bf16_t* Mg = reinterpret_cast<bf16_t*>(p.ws + OFF_MB);
    bf16_t* Ng = reinterpret_cast<bf16_t*>(p.ws + OFF_NTB);
    float* WLg = reinterpret_cast<float*>(p.ws + OFF_WLB);
    for (int u = obid(); u < 4096; u += ogdim()) {
        const int b = u >> 10, h = (u >> 7) & 7, n = u & 127;
        bf16_t* R0 = base + 7 * RC_BUF; bf16_t* C0 = base + 8 * RC_BUF; bf16_t* R1 = base + 9 * RC_BUF; bf16_t* C1 = base + 10 * RC_BUF;
        bf16_t* Pm0 = base + 11 * RC_BUF; bf16_t* Pm1 = base + 12 * RC_BUF;
        rwkv_prep<1>(p, b, h, n, tid, At, Bt, Kt, nullptr, AtT, BtT, KtT, VT, sTot, nullptr, sWL);
        __syncthreads();
        f32x4 pacc[2];
        {
            f32x4 acc[2];
            zero_acc(acc);
            mm64(acc, At, Bt, mt, nt0, fr, fq);
            store_T<3>(C0, acc, mt, nt0, fr, fq);
            zero_acc(pacc);
            mm64(pacc, Bt, At, mt, nt0, fr, fq);
#pragma unroll
            for (int nn = 0; nn < 2; ++nn)
#pragma unroll
                for (int j = 0; j < 4; ++j) {
                    const int R = mt * 16 + fq * 4 + j, C = (nt0 + nn) * 16 + fr;
                    pacc[nn][j] = (R < C) ? pacc[nn][j] : 0.f;
                }
            store_T<0>(R0, pacc, mt, nt0, fr, fq);
#pragma unroll
            for (int nn = 0; nn < 2; ++nn)
#pragma unroll
                for (int j = 0; j < 4; ++j) {
                    const int R = mt * 16 + fq * 4 + j, C = (nt0 + nn) * 16 + fr;
                    if (R == C) pacc[nn][j] += 1.0f;
                }
            store_T<0>(Pm0, pacc, mt, nt0, fr, fq);
        }
        __syncthreads();
#pragma unroll 1
        for (int j = 1; j <= 5; ++j) {
            f32x4 acc[2];
            if (j < 5) {
                zero_acc(acc);
                mm64(acc, C0, R0, mt, nt0, fr, fq);
                store_T<0>(R1, acc, mt, nt0, fr, fq);
            }
            zero_acc(acc);
            mm64(acc, R0, C0, mt, nt0, fr, fq);
            store_T<0>(C1, acc, mt, nt0, fr, fq);
            __syncthreads();
            zero_acc(acc);
            mm64(acc, C1, Pm0, mt, nt0, fr, fq);
            pacc[0] += acc[0]; pacc[1] += acc[1];
            if (j < 5) store_T<0>(Pm1, pacc, mt, nt0, fr, fq);
            __syncthreads();
            bf16_t* t0 = R0; R0 = R1; R1 = t0;
            t0 = C0; C0 = C1; C1 = t0;
            t0 = Pm0; Pm0 = Pm1; Pm1 = t0;
        }
        store_T<0>(Tm, pacc, mt, nt0, fr, fq);
        {
            bf16_t* To = Tg + (size_t)u * 4096;
#pragma unroll
            for (int nn = 0; nn < 2; ++nn) {
                const int C = (nt0 + nn) * 16 + fr, Rb = mt * 16 + fq * 4;
                uint2 w; w.x = pack2(pacc[nn][0], pacc[nn][1]); w.y = pack2(pacc[nn][2], pacc[nn][3]);
                *reinterpret_cast<uint2*>(To + C * 64 + Rb) = w;
            }
            f32x4 acc[2];
            zero_acc(acc); mm64(acc, Kt, At, mt, nt0, fr, fq); store_T<1>(Aak, acc, mt, nt0, fr, fq);
        }
        __syncthreads();
        {
            f32x4 acc[2];
            zero_acc(acc); mm64(acc, Tm, AtT, mt, nt0, fr, fq); store_T<0>(PT, acc, mt, nt0, fr, fq);
            zero_acc(acc); mm64(acc, Aak, VT, mt, nt0, fr, fq); store_T<0>(AkVT, acc, mt, nt0, fr, fq);
        }
        __syncthreads();
        {
            f32x4 acc[2];
            zero_acc(acc); mm64(acc, Tm, AkVT, mt, nt0, fr, fq); store_T<0>(QT, acc, mt, nt0, fr, fq);
            zero_acc(acc); mm64(acc, PT, BtT, mt, nt0, fr, fq);
            bf16_t* Mo = Mg + (size_t)u * 4096;
#pragma unroll
            for (int nn = 0; nn < 2; ++nn) {
                const int C = (nt0 + nn) * 16 + fr, Rb = mt * 16 + fq * 4;
                const float wl = sWL[C];
                uint2 w; w.x = pack2(acc[nn][0] * wl, acc[nn][1] * wl); w.y = pack2(acc[nn][2] * wl, acc[nn][3] * wl);
                *reinterpret_cast<uint2*>(Mo + C * 64 + Rb) = w;
            }
        }
        __syncthreads();
        {
            f32x4 acc[2];
            zero_acc(acc); mm64(acc, BtT, QT, mt, nt0, fr, fq); mm64(acc, KtT, VT, mt, nt0, fr, fq);
            bf16_t* No = Ng + (size_t)u * 4096;
            float wl[4];
#pragma unroll
            for (int j = 0; j < 4; ++j) wl[j] = sWL[mt * 16 + fq * 4 + j];
#pragma unroll
            for (int nn = 0; nn < 2; ++nn) {
                const int C = (nt0 + nn) * 16 + fr, Rb = mt * 16 + fq * 4;
                uint2 w; w.x = pack2(acc[nn][0] * wl[0], acc[nn][1] * wl[1]); w.y = pack2(acc[nn][2] * wl[2], acc[nn][3] * wl[3]);
                *reinterpret_cast<uint2*>(No + C * 64 + Rb) = w;
            }
            if (tid < 64) WLg[(size_t)u * 64 + tid] = sWL[tid];
        }
    }
}

struct R2Slot { bf16x8 ma0, ma1; uint2 n0, n1; float4 wl; };
__device__ __forceinline__ void r2_load(R2Slot& s, const bf16_t* Mg, const bf16_t* Ng, const float* WLg, size_t u, int moff, int noff0, int noff1, int woff) {
    s.ma0 = *reinterpret_cast<const bf16x8*>(Mg + u * 4096 + moff); s.ma1 = *reinterpret_cast<const bf16x8*>(Mg + u * 4096 + moff + 32);
    s.n0 = *reinterpret_cast<const uint2*>(Ng + u * 4096 + noff0); s.n1 = *reinterpret_cast<const uint2*>(Ng + u * 4096 + noff1);
    s.wl = *reinterpret_cast<const float4*>(WLg + u * 64 + woff);
}
__device__ __forceinline__ void r2_step(const R2Slot& s, f32x4 (&sacc)[2], const bf16_t* Sc, bf16_t* Sn, bf16_t* so, int mt, int nt0, int fr, int fq) {
#pragma unroll
    for (int nn = 0; nn < 2; ++nn) {
        const int C = (nt0 + nn) * 16 + fr, Rb = mt * 16 + fq * 4;
        uint2 w; w.x = pack2(sacc[nn][0], sacc[nn][1]); w.y = pack2(sacc[nn][2], sacc[nn][3]);
        *reinterpret_cast<uint2*>(so + C * 64 + Rb) = w;
    }
    f32x4 acc[2];
    acc[0] = (f32x4){__uint_as_float(s.n0.x << 16), __uint_as_float(s.n0.x & 0xffff0000u), __uint_as_float(s.n0.y << 16), __uint_as_float(s.n0.y & 0xffff0000u)};
    acc[1] = (f32x4){__uint_as_float(s.n1.x << 16), __uint_as_float(s.n1.x & 0xffff0000u), __uint_as_float(s.n1.y << 16), __uint_as_float(s.n1.y & 0xffff0000u)};
    acc[0][0] += s.wl.x * sacc[0][0]; acc[0][1] += s.wl.y * sacc[0][1]; acc[0][2] += s.wl.z * sacc[0][2]; acc[0][3] += s.wl.w * sacc[0][3];
    acc[1][0] += s.wl.x * sacc[1][0]; acc[1][1] += s.wl.y * sacc[1][1]; acc[1][2] += s.wl.z * sacc[1][2]; acc[1][3] += s.wl.w * sacc[1][3];
#pragma unroll
    for (int nn = 0; nn < 2; ++nn) {
        bf16x8 bq = *reinterpret_cast<const bf16x8*>(Sc + ((nt0 + nn) * 16 + fr) * RC_LD + fq * 8);
        acc[nn] = __builtin_amdgcn_mfma_f32_16x16x32_bf16(s.ma0, bq, acc[nn], 0, 0, 0);
        bq = *reinterpret_cast<const bf16x8*>(Sc + ((nt0 + nn) * 16 + fr) * RC_LD + 32 + fq * 8);
        acc[nn] = __builtin_amdgcn_mfma_f32_16x16x32_bf16(s.ma1, bq, acc[nn], 0, 0, 0);
    }
    sacc[0] = acc[0]; sacc[1] = acc[1];
    store_T<0>(Sn, sacc, mt, nt0, fr, fq);
}
__device__ __forceinline__ void phase_rwkv_r2(const Params& p, unsigned char* smem) {
    const int tidx = otid(p.wave);
    if (obid() >= 32) return;
    const int bh = obid();
    const int tid = tidx, wv = tid >> 6, lane = tid & 63, fr = lane & 15, fq = lane >> 4, mt = wv >> 1, nt0 = (wv & 1) * 2;
    bf16_t* Sb0 = reinterpret_cast<bf16_t*>(smem);
    bf16_t* Sb1 = Sb0 + RC_BUF;
    const bf16_t* Mg = reinterpret_cast<const bf16_t*>(p.ws + OFF_MB);
    const bf16_t* Ng = reinterpret_cast<const bf16_t*>(p.ws + OFF_NTB);
    const float* WLg = reinterpret_cast<const float*>(p.ws + OFF_WLB);
    f32x4 sacc[2];
    zero_acc(sacc);
    for (int i = tid; i < RC_BUF / 2; i += NTHREADS) reinterpret_cast<unsigned*>(Sb0)[i] = 0u;
    const int moff = (mt * 16 + fr) * 64 + fq * 8;
    const int noff0 = ((nt0 + 0) * 16 + fr) * 64 + mt * 16 + fq * 4, noff1 = ((nt0 + 1) * 16 + fr) * 64 + mt * 16 + fq * 4;
    const int woff = mt * 16 + fq * 4;
    const size_t ub = (size_t)bh * 128;
    R2Slot s0, s1, s2, s3;
    r2_load(s0, Mg, Ng, WLg, ub + 0, moff, noff0, noff1, woff);
    r2_load(s1, Mg, Ng, WLg, ub + 1, moff, noff0, noff1, woff);
    r2_load(s2, Mg, Ng, WLg, ub + 2, moff, noff0, noff1, woff);
    r2_load(s3, Mg, Ng, WLg, ub + 3, moff, noff0, noff1, woff);
    __syncthreads();
#pragma unroll 1
    for (int n = 0; n < 128; n += 4) {
        const bool more = (n + 4 < 128);
        const size_t nx = ub + n + 4;
        { R2Slot c = s0; if (more) r2_load(s0, Mg, Ng, WLg, nx + 0, moff, noff0, noff1, woff);
          r2_step(c, sacc, Sb0, Sb1, s0_ptr(p.ws, (int)ub + n + 0), mt, nt0, fr, fq); lds_barrier(); }
        { R2Slot c = s1; if (more) r2_load(s1, Mg, Ng, WLg, nx + 1, moff, noff0, noff1, woff);
          r2_step(c, sacc, Sb1, Sb0, s0_ptr(p.ws, (int)ub + n + 1), mt, nt0, fr, fq); lds_barrier(); }
        { R2Slot c = s2; if (more) r2_load(s2, Mg, Ng, WLg, nx + 2, moff, noff0, noff1, woff);
          r2_step(c, sacc, Sb0, Sb1, s0_ptr(p.ws, (int)ub + n + 2), mt, nt0, fr, fq); lds_barrier(); }
        { R2Slot c = s3; if (more) r2_load(s3, Mg, Ng, WLg, nx + 3, moff, noff0, noff1, woff);
          r2_step(c, sacc, Sb1, Sb0, s0_ptr(p.ws, (int)ub + n + 3), mt, nt0, fr, fq); lds_barrier(); }
    }
}

__device__ __forceinline__ void phase_rwkv_r3(const Params& p, unsigned char* smem) {
    const int tidx = otid(p.wave);
    const int tid = tidx, wv = tid >> 6, lane = tid & 63, fr = lane & 15, fq = lane >> 4, mt = wv >> 1, nt0 = (wv & 1) * 2;
    bf16_t* base = reinterpret_cast<bf16_t*>(smem);
    bf16_t* At = base; bf16_t* Aak = base + RC_BUF; bf16_t* Bt = base + 2 * RC_BUF; bf16_t* Kt = base + 3 * RC_BUF;
    bf16_t* Rt = base + 4 * RC_BUF; bf16_t* VT = base + 5 * RC_BUF;
    bf16_t* Sb = base + 6 * RC_BUF; bf16_t* Tm = base + 7 * RC_BUF; bf16_t* Arb = base + 8 * RC_BUF; bf16_t* Ark = base + 9 * RC_BUF;
    bf16_t* XT = Bt; bf16_t* UT = Kt;
    float* Yf = reinterpret_cast<float*>(smem);
    float* sTot = reinterpret_cast<float*>(smem + 13 * RC_BYTES);
    float* sBC = sTot + 512 + 64;
    const bf16_t* Tg = reinterpret_cast<const bf16_t*>(p.ws + OFF_TB);
    const bf16_t* GG = reinterpret_cast<const bf16_t*>(p.ws + OFF_GG);
    bf16_t* YC = reinterpret_cast<bf16_t*>(p.ws + OFF_YCAT);
    for (int u = obid(); u < 4096; u += ogdim()) {
        const int b = u >> 10, h = (u >> 7) & 7, n = u & 127;
        const int c = h * 64 + lane;
        rwkv_prep<2>(p, b, h, n, tid, At, Bt, Kt, Rt, nullptr, nullptr, nullptr, VT, sTot, sBC, nullptr);
        {
            const uint4* Tu = reinterpret_cast<const uint4*>(Tg + (size_t)u * 4096);
            const uint4* Su = reinterpret_cast<const uint4*>(s0_ptr(p.ws, u));
            int row = tid >> 3, ch = tid & 7;
            *reinterpret_cast<uint4*>(Tm + row * RC_LD + ch * 8) = Tu[tid];
            *reinterpret_cast<uint4*>(Sb + row * RC_LD + ch * 8) = Su[tid];
        }
        __syncthreads();
        {
            f32x4 acc[2];
            zero_acc(acc); mm64(acc, Kt, At, mt, nt0, fr, fq); store_T<1>(Aak, acc, mt, nt0, fr, fq);
            zero_acc(acc); mm64(acc, Bt, Rt, mt, nt0, fr, fq); store_T<2>(Arb, acc, mt, nt0, fr, fq);
            zero_acc(acc); mm64(acc, Kt, Rt, mt, nt0, fr, fq); store_T<2>(Ark, acc, mt, nt0, fr, fq);
        }
        __syncthreads();
        {
            f32x4 acc[2];
            zero_acc(acc); mm64(acc, At, Sb, mt, nt0, fr, fq); mm64(acc, Aak, VT, mt, nt0, fr, fq);
            store_T<0>(XT, acc, mt, nt0, fr, fq);
        }
        __syncthreads();
        {
            f32x4 acc[2];
            zero_acc(acc); mm64(acc, Tm, XT, mt, nt0, fr, fq);
            store_T<0>(UT, acc, mt, nt0, fr, fq);
        }
        __syncthreads();
        {
            f32x4 acc[2];
            zero_acc(acc);
            mm64(acc, Rt, Sb, mt, nt0, fr, fq); mm64(acc, Arb, UT, mt, nt0, fr, fq); mm64(acc, Ark, VT, mt, nt0, fr, fq);
#pragma unroll
            for (int nn = 0; nn < 2; ++nn)
#pragma unroll
                for (int j = 0; j < 4; ++j) Yf[(mt * 16 + fq * 4 + j) * 68 + (nt0 + nn) * 16 + fr] = acc[nn][j];
        }
        __syncthreads();
        {
            const float lng = p.in[11][c], lnb = p.in[12][c];
#pragma unroll 4
            for (int i = 0; i < 8; ++i) {
                const int t = wv * 8 + i;
                const size_t tok = (size_t)b * SEQ + n * 64 + t;
                const float y = Yf[t * 68 + lane];
                const float mean = wave_sum(y) * (1.0f / 64.0f);
                const float d = y - mean;
                const float var = wave_sum(d * d) * (1.0f / 64.0f);
                const float yn = d * rsqrtf(var + 64e-5f) * lng + lnb;
                const float g = bf2f(GG[tok * 512 + c]);
                const float vv = bf2f(VT[lane * RC_LD + t]);
                YC[tok * 1024 + c] = f2bf((yn + sBC[t] * vv) * g);
            }
        }
        __syncthreads();
    }
}

#define LR_LD 1032
__device__ __forceinline__ void phase_ln_route(const Params& p, int layer, float* X, unsigned char* smem) {
    const int tidx = otid(p.wave);
    const int tid = tidx, wv = tid >> 6, lane = tid & 63, fr = lane & 15, fq = lane >> 4;
    const float* g = p.in[24] + layer * DM;
    const float* bb = p.in[25] + layer * DM;
    const float* rgb = p.in[27] + layer * 4;
    const float* reb = p.in[29] + layer * 32;
    const bf16_t* RH = reinterpret_cast<const bf16_t*>(p.ws + OFF_W) + WE_RT_HI + (size_t)layer * 48 * 1024;
    const bf16_t* RL = reinterpret_cast<const bf16_t*>(p.ws + OFF_W) + WE_RT_LO + (size_t)layer * 48 * 1024;
    bf16_t* XB = reinterpret_cast<bf16_t*>(p.ws + OFF_ACTB);
    int* cnt = reinterpret_cast<int*>(p.ws + OFF_CTRL) + layer * 32;
    int* ltok = reinterpret_cast<int*>(p.ws + OFF_LTOK);
    float* lgate = reinterpret_cast<float*>(p.ws + OFF_LGATE);
    bf16_t* sXH = reinterpret_cast<bf16_t*>(smem);
    bf16_t* sXL = sXH + 16 * LR_LD;
    float* sRed = reinterpret_cast<float*>(smem + 2 * 16 * LR_LD * 2);
    float* sLog = sRed + 8 * 16 * 48;
    bf16x8 bh[4][3], bl[4][3];
#pragma unroll
    for (int ks = 0; ks < 4; ++ks)
#pragma unroll
        for (int nt = 0; nt < 3; ++nt) {
            const int k0 = wv * 128 + ks * 32 + fq * 8;
            bh[ks][nt] = *reinterpret_cast<const bf16x8*>(RH + (size_t)(nt * 16 + fr) * 1024 + k0);
            bl[ks][nt] = *reinterpret_cast<const bf16x8*>(RL + (size_t)(nt * 16 + fr) * 1024 + k0);
        }
    float4 pre[2][4];
    {
        const int tile0 = obid();
        if (tile0 < NT / 16) {
#pragma unroll
            for (int rr = 0; rr < 2; ++rr)
#pragma unroll
                for (int i = 0; i < 4; ++i)
                    pre[rr][i] = *reinterpret_cast<const float4*>(X + (size_t)(tile0 * 16 + wv * 2 + rr) * DM + i * 256 + lane * 4);
        }
    }
    for (int tile = obid(); tile < NT / 16; tile += ogdim()) {
        float4 cur[2][4];
#pragma unroll
        for (int rr = 0; rr < 2; ++rr)
#pragma unroll
            for (int i = 0; i < 4; ++i) cur[rr][i] = pre[rr][i];
        {
            const int tn = tile + ogdim();
            if (tn < NT / 16) {
#pragma unroll
                for (int rr = 0; rr < 2; ++rr)
#pragma unroll
                    for (int i = 0; i < 4; ++i)
                        pre[rr][i] = *reinterpret_cast<const float4*>(X + (size_t)(tn * 16 + wv * 2 + rr) * DM + i * 256 + lane * 4);
            }
        }
#pragma unroll
        for (int rr = 0; rr < 2; ++rr) {
            const int rl = wv * 2 + rr;
            const int row = tile * 16 + rl;
            float* xr = X + (size_t)row * DM;
            float v[16];
#pragma unroll
            for (int i = 0; i < 4; ++i) {
                const float4 t = cur[rr][i];
                v[4 * i] = t.x; v[4 * i + 1] = t.y; v[4 * i + 2] = t.z; v[4 * i + 3] = t.w;
            }
            float sum = 0.f;
#pragma unroll
            for (int i = 0; i < 16; ++i) sum += v[i];
            const float mean = wave_sum(sum) * (1.0f / DM);
            float sq = 0.f;
#pragma unroll
            for (int i = 0; i < 16; ++i) { float d = v[i] - mean; sq += d * d; }
            const float rstd = rsqrtf(wave_sum(sq) * (1.0f / DM) + 1e-5f);
#pragma unroll
            for (int i = 0; i < 4; ++i) {
                const int col = i * 256 + lane * 4;
                const float4 gg = *reinterpret_cast<const float4*>(g + col);
                const float4 bv = *reinterpret_cast<const float4*>(bb + col);
                const float o0 = (v[4 * i] - mean) * rstd * gg.x + bv.x;
                const float o1 = (v[4 * i + 1] - mean) * rstd * gg.y + bv.y;
                const float o2 = (v[4 * i + 2] - mean) * rstd * gg.z + bv.z;
                const float o3 = (v[4 * i + 3] - mean) * rstd * gg.w + bv.w;
                *reinterpret_cast<float4*>(xr + col) = make_float4(o0, o1, o2, o3);
                const bf16_t h0 = f2bf(o0), h1 = f2bf(o1), h2 = f2bf(o2), h3 = f2bf(o3);
                uint2 wh; wh.x = (unsigned)h0 | ((unsigned)h1 << 16); wh.y = (unsigned)h2 | ((unsigned)h3 << 16);
                *reinterpret_cast<uint2*>(XB + (size_t)row * DM + col) = wh;
                *reinterpret_cast<uint2*>(sXH + rl * LR_LD + col) = wh;
                uint2 wl; wl.x = pack2(o0 - bf2f(h0), o1 - bf2f(h1)); wl.y = pack2(o2 - bf2f(h2), o3 - bf2f(h3));
                *reinterpret_cast<uint2*>(sXL + rl * LR_LD + col) = wl;
            }
        }
        lds_barrier();
        {
            f32x4 acc[3];
#pragma unroll
            for (int nt = 0; nt < 3; ++nt) acc[nt] = (f32x4){0.f, 0.f, 0.f, 0.f};
#pragma unroll
            for (int ks = 0; ks < 4; ++ks) {
                const int k0 = wv * 128 + ks * 32 + fq * 8;
                const bf16x8 ah = *reinterpret_cast<const bf16x8*>(sXH + fr * LR_LD + k0);
                const bf16x8 al = *reinterpret_cast<const bf16x8*>(sXL + fr * LR_LD + k0);
#pragma unroll
                for (int nt = 0; nt < 3; ++nt) {
                    acc[nt] = __builtin_amdgcn_mfma_f32_16x16x32_bf16(ah, bh[ks][nt], acc[nt], 0, 0, 0);
                    acc[nt] = __builtin_amdgcn_mfma_f32_16x16x32_bf16(al, bh[ks][nt], acc[nt], 0, 0, 0);
                    acc[nt] = __builtin_amdgcn_mfma_f32_16x16x32_bf16(ah, bl[ks][nt], acc[nt], 0, 0, 0);
                }
            }
#pragma unroll
            for (int nt = 0; nt < 3; ++nt)
#pragma unroll
                for (int j = 0; j < 4; ++j) sRed[(wv * 16 + fq * 4 + j) * 48 + nt * 16 + fr] = acc[nt][j];
        }
        lds_barrier();
        for (int idx = tid; idx < 16 * 48; idx += NTHREADS) {
            float s = 0.f;
#pragma unroll
            for (int w = 0; w < 8; ++w) s += sRed[w * 16 * 48 + idx];
            sLog[idx] = s;
        }
        lds_barrier();
        if (tid < 16) {
            const int row = tile * 16 + tid;
            const float* lg = sLog + tid * 48;
            float gl[4];
#pragma unroll
            for (int j = 0; j < 4; ++j) gl[j] = lg[j] + rgb[j];
            int gi = 0; float gm = gl[0];
#pragma unroll
            for (int j = 1; j < 4; ++j) if (gl[j] > gm) { gm = gl[j]; gi = j; }
            float gs = 0.f;
#pragma unroll
            for (int j = 0; j < 4; ++j) gs += __expf(gl[j] - gm);
            const float gw = 1.0f / gs;
            float el[8];
#pragma unroll
            for (int j = 0; j < 8; ++j) el[j] = lg[4 + gi * 8 + j] + reb[gi * 8 + j];
            int i1 = 0; float m1 = el[0];
#pragma unroll
            for (int j = 1; j < 8; ++j) if (el[j] > m1) { m1 = el[j]; i1 = j; }
            int i2 = -1; float m2 = -3.0e38f;
#pragma unroll
            for (int j = 0; j < 8; ++j) if (j != i1 && el[j] > m2) { m2 = el[j]; i2 = j; }
            const float e2 = __expf(m2 - m1);
            const float p1 = 1.0f / (1.0f + e2), p2 = e2 / (1.0f + e2);
            const int ex1 = gi * 8 + i1, ex2 = gi * 8 + i2;
            const int slot1 = atomicAdd(&cnt[ex1], 1);
            const int slot2 = atomicAdd(&cnt[ex2], 1);
            ltok[(size_t)ex1 * NT + slot1] = row * 2;
            lgate[(size_t)ex1 * NT + slot1] = gw * p1;
            ltok[(size_t)ex2 * NT + slot2] = row * 2 + 1;
            lgate[(size_t)ex2 * NT + slot2] = gw * p2;
        }
    }
    __syncthreads();
}

__device__ __forceinline__ void phase_exp1(const Params& p, int layer, bf16_t* smem) {
    const int* cnt = reinterpret_cast<const int*>(p.ws + OFF_CTRL) + layer * 32;
    const int* ltok = reinterpret_cast<const int*>(p.ws + OFF_LTOK);
    const bf16_t* XB = reinterpret_cast<const bf16_t*>(p.ws + OFF_ACTB);
    const bf16_t* W13 = reinterpret_cast<const bf16_t*>(p.ws + OFF_W) + WE_W13 + (size_t)layer * 32 * 262144;
    bf16_t* H = reinterpret_cast<bf16_t*>(p.ws + OFF_HBUF);
    int t = obid();
    int base = 0, tbase = 0;
    for (int e = 0; e < 32; ++e) {
        int c = cnt[e];
        int nt = ((c + 255) >> 8) * 2;
        while (t < tbase + nt) {
            int w = t - tbase;
            EpiExp1 epi{H, base, c};
            gemm_tile<true>(XB, DM, ltok + (size_t)e * NT, c, W13 + (size_t)e * 262144, DM, DM, (w >> 1) * 256, (w & 1) * 128, epi, smem, p.wave);
            t += ogdim();
        }
        tbase += nt; base += c;
    }
}
__device__ __forceinline__ void phase_exp2(const Params& p, int layer, bf16_t* smem) {
    const int* cnt = reinterpret_cast<const int*>(p.ws + OFF_CTRL) + layer * 32;
    const int* ltok = reinterpret_cast<const int*>(p.ws + OFF_LTOK);
    const float* lgate = reinterpret_cast<const float*>(p.ws + OFF_LGATE);
    const bf16_t* W2 = reinterpret_cast<const bf16_t*>(p.ws + OFF_W) + WE_W2 + (size_t)layer * 32 * 131072;
    const bf16_t* H = reinterpret_cast<const bf16_t*>(p.ws + OFF_HBUF);
    bf16_t* FS = reinterpret_cast<bf16_t*>(p.ws + OFF_FS);
    int t = obid();
    int base = 0, tbase = 0;
    for (int e = 0; e < 32; ++e) {
        int c = cnt[e];
        int nt = ((c + 255) >> 8) * 8;
        while (t < tbase + nt) {
            int w = t - tbase;
            EpiExp2 epi{FS, ltok + (size_t)e * NT, lgate + (size_t)e * NT, c};
            gemm_tile<false>(H + (size_t)base * 128, 128, nullptr, 0, W2 + (size_t)e * 131072, 128, 128, (w >> 3) * 256, (w & 7) * 128, epi, smem, p.wave);
            t += ogdim();
        }
        tbase += nt; base += c;
    }
}

__device__ __forceinline__ void phase_ln_ffn(const Params& p, int layer, float* X, bool write_b) {
    const int tidx = otid(p.wave);
    const int tid = tidx, wv = tid >> 6, lane = tid & 63;
    const float* g = p.in[33] + layer * DM;
    const float* bb = p.in[34] + layer * DM;
    const bf16_t* FS = reinterpret_cast<const bf16_t*>(p.ws + OFF_FS);
    bf16_t* XB = reinterpret_cast<bf16_t*>(p.ws + OFF_ACTB);
    for (int row = obid() * NWAVES + wv; row < NT; row += ogdim() * NWAVES) {
        float* xr = X + (size_t)row * DM;
        float v[16];
#pragma unroll
        for (int i = 0; i < 4; ++i) {
            int col = i * 256 + lane * 4;
            float4 t = *reinterpret_cast<const float4*>(xr + col);
            uint2 f0 = *reinterpret_cast<const uint2*>(FS + (size_t)row * DM + col);
            uint2 f1 = *reinterpret_cast<const uint2*>(FS + ((size_t)NT + row) * DM + col);
            v[4 * i] = ALPHA_F * t.x + __uint_as_float(f0.x << 16) + __uint_as_float(f1.x << 16);
            v[4 * i + 1] = ALPHA_F * t.y + __uint_as_float(f0.x & 0xffff0000u) + __uint_as_float(f1.x & 0xffff0000u);
            v[4 * i + 2] = ALPHA_F * t.z + __uint_as_float(f0.y << 16) + __uint_as_float(f1.y << 16);
            v[4 * i + 3] = ALPHA_F * t.w + __uint_as_float(f0.y & 0xffff0000u) + __uint_as_float(f1.y & 0xffff0000u);
        }
        float sum = 0.f;
#pragma unroll
        for (int i = 0; i < 16; ++i) sum += v[i];
        float mean = wave_sum(sum) * (1.0f / DM);
        float sq = 0.f;
#pragma unroll
        for (int i = 0; i < 16; ++i) { float d = v[i] - mean; sq += d * d; }
        float rstd = rsqrtf(wave_sum(sq) * (1.0f / DM) + 1e-5f);
#pragma unroll
        for (int i = 0; i < 4; ++i) {
            int col = i * 256 + lane * 4;
            float4 gg = *reinterpret_cast<const float4*>(g + col);
            float4 bv = *reinterpret_cast<const float4*>(bb + col);
            float o0 = (v[4 * i] - mean) * rstd * gg.x + bv.x;
            float o1 = (v[4 * i + 1] - mean) * rstd * gg.y + bv.y;
            float o2 = (v[4 * i + 2] - mean) * rstd * gg.z + bv.z;
            float o3 = (v[4 * i + 3] - mean) * rstd * gg.w + bv.w;
            *reinterpret_cast<float4*>(xr + col) = make_float4(o0, o1, o2, o3);
            if (write_b) {
                uint2 w; w.x = pack2(o0, o1); w.y = pack2(o2, o3);
                *reinterpret_cast<uint2*>(XB + (size_t)row * DM + col) = w;
            }
        }
    }
}

#define CV_T 64
#define CV_ROWS (CV_T + 30)
template <int OB>
__device__ __forceinline__ void conv_blk(float (&acc)[CV_T], const bf16_t* sU, int tid, const float (&w0)[31]) {
#pragma unroll
    for (int rr = 0; rr < 38; ++rr) {
        const float uv = bf2f(sU[(OB * 8 + rr) * 512 + tid]);
#pragma unroll
        for (int oo = 0; oo < 8; ++oo) {
            const int j = rr - oo;
            if (j >= 0 && j <= 30) acc[OB * 8 + oo] += uv * w0[j];
        }
    }
}
__device__ __forceinline__ void phase_l1_conv(const Params& p, unsigned char* smem) {
    const int tidx = otid(p.wave);
    const bf16_t* P = reinterpret_cast<const bf16_t*>(p.ws + OFF_P);
    bf16_t* YC = reinterpret_cast<bf16_t*>(p.ws + OFF_YCAT);
    bf16_t* sU = reinterpret_cast<bf16_t*>(smem);
    float* red = reinterpret_cast<float*>(smem + CV_ROWS * 512 * 2);
    float* stat = red + 8 * 64 * 2;
    const int tid = tidx, wv = tid >> 6, lane = tid & 63;
    const float* cw = p.in[17];
    float w0[31];
#pragma unroll
    for (int j = 0; j < 31; ++j) w0[j] = cw[j * 512 + tid];
    const float cb0 = p.in[18][tid], g0 = p.in[19][tid], b0 = p.in[20][tid];
    for (int u = obid(); u < NT / CV_T; u += ogdim()) {
        const int t0 = u * CV_T;
        const int s0 = t0 & (SEQ - 1);
        for (int it = tid; it < CV_ROWS * 64; it += NTHREADS) {
            const int r = it >> 6, c8 = (it & 63) * 8;
            uint4 w = make_uint4(0u, 0u, 0u, 0u);
            if (s0 - 30 + r >= 0) {
                const bf16_t* pr = P + (size_t)(t0 - 30 + r) * 3072 + c8;
                float a[8], gte[8];
                unpack8(*reinterpret_cast<const uint4*>(pr), a);
                unpack8(*reinterpret_cast<const uint4*>(pr + 512), gte);
#pragma unroll
                for (int i = 0; i < 8; ++i) a[i] = a[i] * sigmoidf_(gte[i]);
                w.x = pack2(a[0], a[1]); w.y = pack2(a[2], a[3]); w.z = pack2(a[4], a[5]); w.w = pack2(a[6], a[7]);
            }
            *reinterpret_cast<uint4*>(sU + r * 512 + c8) = w;
        }
        __syncthreads();
        float acc[CV_T];
#pragma unroll
        for (int o = 0; o < CV_T; ++o) acc[o] = cb0;
        conv_blk<0>(acc, sU, tid, w0); conv_blk<1>(acc, sU, tid, w0); conv_blk<2>(acc, sU, tid, w0); conv_blk<3>(acc, sU, tid, w0);
        conv_blk<4>(acc, sU, tid, w0); conv_blk<5>(acc, sU, tid, w0); conv_blk<6>(acc, sU, tid, w0); conv_blk<7>(acc, sU, tid, w0);
#pragma unroll
        for (int o = 0; o < CV_T; ++o) {
            const float s1 = wave_sum(acc[o]);
            const float s2 = wave_sum(acc[o] * acc[o]);
            if (lane == 0) { red[(wv * 64 + o) * 2] = s1; red[(wv * 64 + o) * 2 + 1] = s2; }
        }
        __syncthreads();
        if (tid < 64) {
            float s1 = 0.f, s2 = 0.f;
#pragma unroll
            for (int w = 0; w < 8; ++w) { s1 += red[(w * 64 + tid) * 2]; s2 += red[(w * 64 + tid) * 2 + 1]; }
            const float mean = s1 * (1.0f / 512.0f);
            const float var = fmaxf(s2 * (1.0f / 512.0f) - mean * mean, 0.f);
            stat[tid * 2] = mean; stat[tid * 2 + 1] = rsqrtf(var + 1e-5f);
        }
        __syncthreads();
#pragma unroll
        for (int o = 0; o < CV_T; ++o) {
            const float mean = stat[o * 2], rstd = stat[o * 2 + 1];
            const float y0 = (acc[o] - mean) * rstd * g0 + b0;
            YC[(size_t)(t0 + o) * 1024 + tid] = f2bf(siluf_(y0));
        }
    }
}

__device__ __forceinline__ float ret_lg(int h) { return log1pf(-exp2f(-5.0f - (float)h)); }

#define KT_LD 136
__device__ __forceinline__ void phase_ret_kv(const Params& p, unsigned char* smem) {
    const int tidx = otid(p.wave);
    const bf16_t* P = reinterpret_cast<const bf16_t*>(p.ws + OFF_P);
    const float2* rope = reinterpret_cast<const float2*>(p.ws + OFF_ROPE);
    float* KVT = reinterpret_cast<float*>(p.ws + OFF_KVT);
    bf16_t* sKT = reinterpret_cast<bf16_t*>(smem);
    bf16_t* sVT = sKT + 64 * KT_LD;
    const int tid = tidx, wv = tid >> 6, lane = tid & 63, fr = lane & 15, fq = lane >> 4;
    const int et = wv >> 1, dt0 = (wv & 1) * 2;
    for (int u = obid(); u < 2048; u += ogdim()) {
        const int n = u & 63, h = (u >> 6) & 7, b = u >> 9;
        const float lg = ret_lg(h);
        {
            const int c = tid >> 2, i0 = (tid & 3) * 8;
            const int sidx = n * 128 + c;
            const size_t tok = (size_t)b * SEQ + sidx;
            const bf16_t* kr = P + tok * 3072 + 1536 + h * 64;
            const bf16_t* vr = P + tok * 3072 + 2048 + h * 64;
            const float zeta = __expf((float)(127 - c) * lg) * 0.125f;
#pragma unroll
            for (int i = 0; i < 8; ++i) {
                float t1 = bf2f(kr[i0 + i]), t2 = bf2f(kr[32 + i0 + i]);
                float2 cs = rope[sidx * 32 + i0 + i];
                float o1 = (t1 * cs.x - t2 * cs.y) * zeta, o2 = (t1 * cs.y + t2 * cs.x) * zeta;
                sKT[(i0 + i) * KT_LD + c] = f2bf(o1);
                sKT[(32 + i0 + i) * KT_LD + c] = f2bf(o2);
                sVT[(i0 + i) * KT_LD + c] = vr[i0 + i];
                sVT[(32 + i0 + i) * KT_LD + c] = vr[32 + i0 + i];
            }
        }
        __syncthreads();
        f32x4 acc[2];
        acc[0] = (f32x4){0.f, 0.f, 0.f, 0.f}; acc[1] = (f32x4){0.f, 0.f, 0.f, 0.f};
#pragma unroll
        for (int ks = 0; ks < 4; ++ks) {
            bf16x8 af = *reinterpret_cast<const bf16x8*>(sVT + (et * 16 + fr) * KT_LD + ks * 32 + fq * 8);
#pragma unroll
            for (int nn = 0; nn < 2; ++nn) {
                bf16x8 bfr = *reinterpret_cast<const bf16x8*>(sKT + ((dt0 + nn) * 16 + fr) * KT_LD + ks * 32 + fq * 8);
                acc[nn] = __builtin_amdgcn_mfma_f32_16x16x32_bf16(af, bfr, acc[nn], 0, 0, 0);
            }
        }
        float* o = KVT + (size_t)u * 4096;
#pragma unroll
        for (int nn = 0; nn < 2; ++nn)
#pragma unroll
            for (int j = 0; j < 4; ++j) o[(et * 16 + fq * 4 + j) * 64 + (dt0 + nn) * 16 + fr] = acc[nn][j];
        __syncthreads();
    }
}
__device__ __forceinline__ void phase_ret_scan(const Params& p) {
    const int tidx = otid(p.wave);
    float* KVT = reinterpret_cast<float*>(p.ws + OFF_KVT);
    for (int i = obid() * NTHREADS + tidx; i < 32 * 4096; i += ogdim() * NTHREADS) {
        int bh = i >> 12, ed = i & 4095, h = bh & 7;
        float gc = __expf(128.0f * ret_lg(h));
        float R = 0.f;
        float* q = KVT + (size_t)bh * 64 * 4096 + ed;
        for (int n = 0; n < 64; ++n) {
            float kv = q[(size_t)n * 4096];
            q[(size_t)n * 4096] = R;
            R = gc * R + kv;
        }
    }
}
#define Q_LD 72
__device__ __forceinline__ void phase_ret_out(const Params& p, unsigned char* smem) {
    const int tidx = otid(p.wave);
    const bf16_t* P = reinterpret_cast<const bf16_t*>(p.ws + OFF_P);
    const float2* rope = reinterpret_cast<const float2*>(p.ws + OFF_ROPE);
    const float* KVT = reinterpret_cast<const float*>(p.ws + OFF_KVT);
    bf16_t* YC = reinterpret_cast<bf16_t*>(p.ws + OFF_YCAT);
    bf16_t* sQ = reinterpret_cast<bf16_t*>(smem);
    bf16_t* sK = sQ + 128 * Q_LD;
    bf16_t* sVT = sK + 128 * Q_LD;
    bf16_t* sRT = sVT + 64 * KT_LD;
    bf16_t* sS = sQ;
    const int tid = tidx, wv = tid >> 6, lane = tid & 63, fr = lane & 15, fq = lane >> 4;
    const float* gng = p.in[21];
    const float* gnb = p.in[22];
    for (int u = obid(); u < 2048; u += ogdim()) {
        const int n = u & 63, h = (u >> 6) & 7, b = u >> 9;
        const float lg = ret_lg(h);
        {
            const int c = tid >> 2, i0 = (tid & 3) * 8;
            const int sidx = n * 128 + c;
            const size_t tok = (size_t)b * SEQ + sidx;
            const bf16_t* qr = P + tok * 3072 + 1024 + h * 64;
            const bf16_t* kr = P + tok * 3072 + 1536 + h * 64;
            const bf16_t* vr = P + tok * 3072 + 2048 + h * 64;
            {
                float qa[8], qb[8], ka[8], kb[8];
                float q1[8], q2[8], k1[8], k2[8];
                unpack8(*reinterpret_cast<const uint4*>(qr + i0), q1); unpack8(*reinterpret_cast<const uint4*>(qr + 32 + i0), q2);
                unpack8(*reinterpret_cast<const uint4*>(kr + i0), k1); unpack8(*reinterpret_cast<const uint4*>(kr + 32 + i0), k2);
#pragma unroll
                for (int i = 0; i < 8; ++i) {
                    const float2 cs = rope[sidx * 32 + i0 + i];
                    qa[i] = q1[i] * cs.x - q2[i] * cs.y; qb[i] = q1[i] * cs.y + q2[i] * cs.x;
                    ka[i] = (k1[i] * cs.x - k2[i] * cs.y) * 0.125f; kb[i] = (k1[i] * cs.y + k2[i] * cs.x) * 0.125f;
                    sVT[(i0 + i) * KT_LD + c] = vr[i0 + i];
                    sVT[(32 + i0 + i) * KT_LD + c] = vr[32 + i0 + i];
                }
                uint4 w;
                w.x = pack2(qa[0], qa[1]); w.y = pack2(qa[2], qa[3]); w.z = pack2(qa[4], qa[5]); w.w = pack2(qa[6], qa[7]);
                *reinterpret_cast<uint4*>(sQ + c * Q_LD + i0) = w;
                w.x = pack2(qb[0], qb[1]); w.y = pack2(qb[2], qb[3]); w.z = pack2(qb[4], qb[5]); w.w = pack2(qb[6], qb[7]);
                *reinterpret_cast<uint4*>(sQ + c * Q_LD + 32 + i0) = w;
                w.x = pack2(ka[0], ka[1]); w.y = pack2(ka[2], ka[3]); w.z = pack2(ka[4], ka[5]); w.w = pack2(ka[6], ka[7]);
                *reinterpret_cast<uint4*>(sK + c * Q_LD + i0) = w;
                w.x = pack2(kb[0], kb[1]); w.y = pack2(kb[2], kb[3]); w.z = pack2(kb[4], kb[5]); w.w = pack2(kb[6], kb[7]);
                *reinterpret_cast<uint4*>(sK + c * Q_LD + 32 + i0) = w;
            }
            {
                const float* rp = KVT + (size_t)u * 4096 + tid * 8;
                const float4 r0 = *reinterpret_cast<const float4*>(rp), r1 = *reinterpret_cast<const float4*>(rp + 4);
                uint4 w;
                w.x = pack2(r0.x, r0.y); w.y = pack2(r0.z, r0.w); w.z = pack2(r1.x, r1.y); w.w = pack2(r1.z, r1.w);
                *reinterpret_cast<uint4*>(sRT + (tid >> 3) * Q_LD + (tid & 7) * 8) = w;
            }
        }
        __syncthreads();
        f32x4 accs[8], accc[4];
#pragma unroll
        for (int nn = 0; nn < 8; ++nn) accs[nn] = (f32x4){0.f, 0.f, 0.f, 0.f};
#pragma unroll
        for (int nn = 0; nn < 4; ++nn) accc[nn] = (f32x4){0.f, 0.f, 0.f, 0.f};
#pragma unroll
        for (int ks = 0; ks < 2; ++ks) {
            bf16x8 af = *reinterpret_cast<const bf16x8*>(sQ + (wv * 16 + fr) * Q_LD + ks * 32 + fq * 8);
#pragma unroll
            for (int nn = 0; nn < 8; ++nn) {
                bf16x8 bfr = *reinterpret_cast<const bf16x8*>(sK + (nn * 16 + fr) * Q_LD + ks * 32 + fq * 8);
                accs[nn] = __builtin_amdgcn_mfma_f32_16x16x32_bf16(af, bfr, accs[nn], 0, 0, 0);
            }
#pragma unroll
            for (int nn = 0; nn < 4; ++nn) {
                bf16x8 bfr = *reinterpret_cast<const bf16x8*>(sRT + (nn * 16 + fr) * Q_LD + ks * 32 + fq * 8);
                accc[nn] = __builtin_amdgcn_mfma_f32_16x16x32_bf16(af, bfr, accc[nn], 0, 0, 0);
            }
        }
        __syncthreads();
        bf16_t* mS = sS + wv * 16 * KT_LD;
        {
            float e1[4], e1m[4];
#pragma unroll
            for (int j = 0; j < 4; ++j) {
                e1[j] = __expf((float)(fq * 4 + j - fr) * lg);
                e1m[j] = (fq * 4 + j >= fr) ? e1[j] : 0.f;
            }
#pragma unroll
            for (int nn = 0; nn < 8; ++nn) {
                const float e2 = (nn < wv) ? __expf((float)(16 * (wv - nn)) * lg) : 0.f;
                const bool diag = (nn == wv);
                float v[4];
#pragma unroll
                for (int j = 0; j < 4; ++j) v[j] = accs[nn][j] * (diag ? e1m[j] : e2 * e1[j]);
#pragma unroll
                for (int j = 0; j < 4; ++j) mS[(fq * 4 + j) * KT_LD + nn * 16 + fr] = f2bf(v[j]);
            }
        }
        __syncthreads();
        f32x4 acco[4];
#pragma unroll
        for (int nn = 0; nn < 4; ++nn) acco[nn] = (f32x4){0.f, 0.f, 0.f, 0.f};
#pragma unroll
        for (int ks = 0; ks < 4; ++ks) {
            bf16x8 af = *reinterpret_cast<const bf16x8*>(mS + fr * KT_LD + ks * 32 + fq * 8);
#pragma unroll
            for (int nn = 0; nn < 4; ++nn) {
                bf16x8 bfr = *reinterpret_cast<const bf16x8*>(sVT + (nn * 16 + fr) * KT_LD + ks * 32 + fq * 8);
                acco[nn] = __builtin_amdgcn_mfma_f32_16x16x32_bf16(af, bfr, acco[nn], 0, 0, 0);
            }
        }
#pragma unroll
        for (int j = 0; j < 4; ++j) {
            int ig = wv * 16 + fq * 4 + j;
            float xi = __expf((float)(ig + 1) * lg);
            float o[4];
            float sm = 0.f;
#pragma unroll
            for (int nn = 0; nn < 4; ++nn) { o[nn] = acco[nn][j] + xi * accc[nn][j]; sm += o[nn]; }
            sm = row16_sum(sm);
            float mean = sm * (1.0f / 64.0f);
            float sq = 0.f;
#pragma unroll
            for (int nn = 0; nn < 4; ++nn) { float d = o[nn] - mean; sq += d * d; }
            sq = row16_sum(sq);
            float rstd = rsqrtf(sq * (1.0f / 64.0f) + 1e-5f);
            size_t tok = (size_t)b * SEQ + n * 128 + ig;
#pragma unroll
            for (int nn = 0; nn < 4; ++nn) {
                int e = h * 64 + nn * 16 + fr;
                float y = (o[nn] - mean) * rstd * gng[e] + gnb[e];
                float gr = bf2f(P[tok * 3072 + 2560 + e]);
                YC[tok * 1024 + 512 + e] = f2bf(siluf_(gr) * y);
            }
        }
        __syncthreads();
    }
}

#define XB_TMO      128
#define XB_XCNT(j)  (256  + 64 * (j))
#define XB_XSUB(j)  (1280 + 64 * (j))
#define XB_XGEN(j)  (2304 + 64 * (j))
#define XB_TOP      3328
#define XB_TOPGEN   3392
#define XB_SPIN_CAP (1u << 18)

__device__ __forceinline__ unsigned xb_ld(unsigned* p)              { return __hip_atomic_load(p, __ATOMIC_RELAXED, __HIP_MEMORY_SCOPE_AGENT); }
__device__ __forceinline__ unsigned xb_add(unsigned* p, unsigned v) { return __hip_atomic_fetch_add(p, v, __ATOMIC_RELAXED, __HIP_MEMORY_SCOPE_AGENT); }
__device__ __forceinline__ unsigned xb_xcc_id() { return (unsigned)__builtin_amdgcn_s_getreg((3 << 11) | 20) & 0xFu; }
#define XB_SPIN(cond, bar) do { unsigned _sp = 0; while (cond) { __builtin_amdgcn_s_sleep(1); \
    if ((++_sp & 255u) == 0u) { if (xb_ld(&(bar)[XB_TMO])) break; if (_sp > XB_SPIN_CAP) { atomicAdd(&(bar)[XB_TMO], 1u); break; } } } } while (0)

struct XcdBarrier {
    unsigned* bar; unsigned x;
    volatile __attribute__((address_space(3))) unsigned* st;
};

__device__ __forceinline__ XcdBarrier xcd_barrier_post(unsigned* bar, volatile __attribute__((address_space(3))) unsigned* st, int tid) {
    XcdBarrier b; b.bar = bar; b.x = xb_xcc_id(); b.st = st;
    if (tid == 0) (void)xb_add(&bar[XB_XCNT(b.x)], 1u);
    return b;
}
__device__ __forceinline__ void xcd_barrier_complete(unsigned* bar, unsigned x, unsigned& nloc, unsigned& nx) {
    const unsigned G = (unsigned)ogdim();
    unsigned sum, cnt, mine, sp = 0u;
    for (;;) {
        sum = 0u; cnt = 0u; mine = 0u;
#pragma unroll
        for (unsigned j = 0; j < 16; ++j) { const unsigned c = xb_ld(&bar[XB_XCNT(j)]); sum += c; cnt += (c > 0u) ? 1u : 0u; mine = (j == x) ? c : mine; }
        if (sum == G) break;
        __builtin_amdgcn_s_sleep(1);
        if ((++sp & 255u) == 0u) { if (xb_ld(&bar[XB_TMO])) break; if (sp > XB_SPIN_CAP) { atomicAdd(&bar[XB_TMO], 1u); break; } }
    }
    nloc = mine > 0u ? mine : 1u; nx = cnt > 0u ? cnt : 1u;
}

__device__ __forceinline__ void xcd_barrier(const XcdBarrier& b, int tid) {
    asm volatile("s_waitcnt vmcnt(0)" ::: "memory");
    __syncthreads();
    if (tid == 0) {
        unsigned* bar = b.bar;
        __builtin_amdgcn_s_waitcnt(0);
        unsigned nloc = b.st[0], nx = b.st[1];
        if (nloc == 0u) { xcd_barrier_complete(bar, b.x, nloc, nx); b.st[0] = nloc; b.st[1] = nx; }
        const unsigned old = xb_add(&bar[XB_XSUB(b.x)], 1u);
        const unsigned gen = old / nloc;
        if (old + 1u == (gen + 1u) * nloc) {
            __builtin_amdgcn_fence(__ATOMIC_RELEASE, "agent");
            asm volatile("s_waitcnt vmcnt(0)" ::: "memory");
            const unsigned og = xb_add(&bar[XB_TOP], 1u);
            const unsigned tg = og / nx;
            if (og + 1u == (tg + 1u) * nx) xb_add(&bar[XB_TOPGEN], 1u);
            else XB_SPIN(xb_ld(&bar[XB_TOPGEN]) == tg, bar);
            __builtin_amdgcn_fence(__ATOMIC_ACQUIRE, "agent");
            xb_add(&bar[XB_XGEN(b.x)], 1u);
            asm volatile("s_waitcnt vmcnt(0)" ::: "memory");
        } else {
            XB_SPIN(xb_ld(&bar[XB_XGEN(b.x)]) == gen, bar);
            __builtin_amdgcn_fence(__ATOMIC_ACQUIRE, "agent");
            asm volatile("s_waitcnt vmcnt(0)" ::: "memory");
        }
    }
    __syncthreads();
}


#define N_PHASES 22
__device__ __forceinline__ void run_phase(const Params& p, int ph, unsigned char* smem) {
    bf16_t* sm16 = reinterpret_cast<bf16_t*>(smem);
    const bf16_t* W = reinterpret_cast<const bf16_t*>(p.ws + OFF_W);
    bf16_t* ACTB = reinterpret_cast<bf16_t*>(p.ws + OFF_ACTB);
    bf16_t* PB = reinterpret_cast<bf16_t*>(p.ws + OFF_P);
    bf16_t* YC = reinterpret_cast<bf16_t*>(p.ws + OFF_YCAT);
    switch (ph) {
        case 0: phase_pre(p, smem); break;
        case 1: { PEpiBf16 e{PB, 2304}; big_gemm(ACTB, W + WE_IN0, NT, 2304, DM, e, smem, p.wave); } break;
        case 2: phase_l0_prep(p); break;
        case 3: phase_l0_lora(p, sm16); break;
        case 4: phase_rwkv_r1(p, smem); break;
        case 5: phase_rwkv_r2(p, smem); break;
        case 6: phase_rwkv_r3(p, smem); break;
        case 7: { PEpiOut e{p.in[0], p.out}; big_gemm(YC, W + WE_OUT0, NT, DM, DM, e, smem, p.wave); } break;
        case 8: phase_ln_route(p, 0, p.out, smem); break;
        case 9: phase_exp1(p, 0, sm16); break;
        case 10: phase_exp2(p, 0, sm16); break;
        case 11: phase_ln_ffn(p, 0, p.out, true); break;
        case 12: { PEpiBf16 e{PB, 3072}; big_gemm(ACTB, W + WE_IN1, NT, 3072, DM, e, smem, p.wave); } break;
        case 13: phase_l1_conv(p, smem); break;
        case 14: phase_ret_kv(p, smem); break;
        case 15: phase_ret_scan(p); break;
        case 16: phase_ret_out(p, smem); break;
        case 17: { PEpiOut e{p.out, p.out}; big_gemm(YC, W + WE_OUT1, NT, DM, DM, e, smem, p.wave); } break;
        case 18: phase_ln_route(p, 1, p.out, smem); break;
        case 19: phase_exp1(p, 1, sm16); break;
        case 20: phase_exp2(p, 1, sm16); break;
        case 21: phase_ln_ffn(p, 1, p.out, false); break;
        default: break;
    }
}

#define SMEM_BYTES 132096
__global__ void __launch_bounds__(NTHREADS) k_mega(Params p) {
    extern __shared__ __attribute__((aligned(16))) unsigned char smem[];
    cg::grid_group grid = cg::this_grid();
    const int wave_s = __builtin_amdgcn_readfirstlane((int)(threadIdx.x >> 6));
    volatile __attribute__((address_space(3))) unsigned* st = (volatile __attribute__((address_space(3))) unsigned*)(smem + 131584);
    {
        const int t0 = otid(wave_s);
        if (t0 < 2) st[t0] = 0u;
    }
    XcdBarrier xb;
#pragma nounroll
    for (int ph = 0; ph < N_PHASES; ++ph) {
        int phv = ph;
        asm volatile("" : "+s"(phv));
        typedef const __attribute__((address_space(4))) Params* KP;
        KP pp = (KP)__builtin_amdgcn_kernarg_segment_ptr();
        asm volatile("" : "+s"(pp));
        Params pl;
        __builtin_memcpy(&pl, (const Params*)pp, sizeof(Params));
        pl.wave = wave_s;
        run_phase(pl, phv, smem);
        if (ph == 0) {
            grid.sync();
            xb = xcd_barrier_post(reinterpret_cast<unsigned*>(pl.ws + OFF_CTRL + 4096), st, otid(wave_s));
        } else if (ph < N_PHASES - 1) {
            xcd_barrier(xb, otid(wave_s));
        }
    }
}

extern "C" void kernel_launch(void* const* d_in, const int* in_sizes, int n_in, void* d_out, int out_size, void* d_ws, size_t ws_size,
                              hipStream_t stream) {
    static int grid_blocks = 0;
    if (!grid_blocks) {
        int dev = 0, cus = 0, per_cu = 0;
        hipGetDevice(&dev);
        hipDeviceGetAttribute(&cus, hipDeviceAttributeMultiprocessorCount, dev);
        hipFuncSetAttribute((const void*)k_mega, hipFuncAttributeMaxDynamicSharedMemorySize, SMEM_BYTES);
        hipOccupancyMaxActiveBlocksPerMultiprocessor(&per_cu, (const void*)k_mega, NTHREADS, SMEM_BYTES);
        if (per_cu < 1) per_cu = 1;
        grid_blocks = cus * per_cu;
    }
    Params p{};
    for (int i = 0; i < 35; ++i) p.in[i] = (const float*)d_in[i];
    p.out = (float*)d_out;
    p.ws = (unsigned char*)d_ws;
    void* args[] = {&p};
    hipError_t e = hipLaunchCooperativeKernel((void*)k_mega, dim3(grid_blocks), dim3(NTHREADS), args, SMEM_BYTES, stream);
    if (e != hipSuccess) fprintf(stderr, "cooperative launch failed: %s (grid %d)\n", hipGetErrorString(e), grid_blocks);
}
```

```cpp
#include <hip/hip_runtime.h>
#include <hip/hip_cooperative_groups.h>
#include <stdint.h>
#include <stdio.h>
namespace cg = cooperative_groups;

typedef unsigned short bf16_t;
typedef short bf16x8 __attribute__((ext_vector_type(8)));
typedef float f32x4 __attribute__((ext_vector_type(4)));

#define NT 32768
#define SEQ 8192
#define DM 1024
#define NTHREADS 512
#define XCD_BAR_WORDS 3456
#define NWAVES 8
#define ALPHA_F 1.41421356237309515f

#define MIB (1024ull * 1024ull)
#define OFF_CTRL 0ull
#define OFF_W (1ull * MIB)
#define OFF_ROPE (65ull * MIB)
#define OFF_ACTB (68ull * MIB)
#define OFF_AA (OFF_ACTB)
#define OFF_GG (OFF_ACTB + 32ull * MIB)
#define OFF_P (132ull * MIB)
#define OFF_LORA (OFF_P + 144ull * MIB)
#define OFF_POOLED (OFF_P + 160ull * MIB)
#define OFF_FS (OFF_P)
#define OFF_HBUF (OFF_P + 128ull * MIB)
#define OFF_YCAT (324ull * MIB)
#define OFF_LOGW (388ull * MIB)
#define OFF_LTOK (452ull * MIB)
#define OFF_LGATE (456ull * MIB)
#define OFF_KVT (460ull * MIB)
#define WE_IN0 0
#define WE_OUT0 2359296
#define WE_IN1 3407872
#define WE_OUT1 6553600
#define WE_W13 7602176
#define WE_W2 24379392
#define WE_LW2 32768000
#define WE_LA2 32800768
#define WE_LG2 32833536
#define WE_POOL 32899072
#define WE_RT_HI 32964608
#define WE_RT_LO 33062912

struct Params {
    const float* in[35];
    float* out;
    unsigned char* ws;
    int wave;
    int pad_;
};

typedef __bf16 hw_bf16x2 __attribute__((ext_vector_type(2)));
typedef float hw_f32x2 __attribute__((ext_vector_type(2)));
__device__ __forceinline__ unsigned pack2(float a, float b) {
    hw_f32x2 v = {a, b};
    hw_bf16x2 r = __builtin_convertvector(v, hw_bf16x2);
    return __builtin_bit_cast(unsigned, r);
}
__device__ __forceinline__ bf16_t f2bf(float f) { return (bf16_t)(pack2(f, 0.f) & 0xffffu); }
__device__ __forceinline__ float bf2f(bf16_t h) { return __uint_as_float(((unsigned)h) << 16); }
__device__ __forceinline__ void unpack8(const uint4 v, float (&o)[8]) {
    o[0] = __uint_as_float(v.x << 16); o[1] = __uint_as_float(v.x & 0xffff0000u);
    o[2] = __uint_as_float(v.y << 16); o[3] = __uint_as_float(v.y & 0xffff0000u);
    o[4] = __uint_as_float(v.z << 16); o[5] = __uint_as_float(v.z & 0xffff0000u);
    o[6] = __uint_as_float(v.w << 16); o[7] = __uint_as_float(v.w & 0xffff0000u);
}
#define DPP_ADD(v, CTRL) ((v) + __int_as_float(__builtin_amdgcn_update_dpp(0, __float_as_int(v), (CTRL), 0xF, 0xF, false)))
__device__ __forceinline__ float row16_sum(float v) {
    v = DPP_ADD(v, 0xB1);
    v = DPP_ADD(v, 0x4E);
    v = DPP_ADD(v, 0x141);
    v = DPP_ADD(v, 0x140);
    return v;
}
__device__ __forceinline__ float wave_sum(float v) {
    v = row16_sum(v);
    const int iv = __float_as_int(v);
    const float s0 = __int_as_float(__builtin_amdgcn_readlane(iv, 0)), s1 = __int_as_float(__builtin_amdgcn_readlane(iv, 16));
    const float s2 = __int_as_float(__builtin_amdgcn_readlane(iv, 32)), s3 = __int_as_float(__builtin_amdgcn_readlane(iv, 48));
    return (s0 + s1) + (s2 + s3);
}
__device__ __forceinline__ float sigmoidf_(float x) { return 1.0f / (1.0f + __expf(-x)); }
__device__ __forceinline__ float siluf_(float x) { return x / (1.0f + __expf(-x)); }
__device__ __forceinline__ float quad_sum(float v) {
    int iv = __float_as_int(v);
    float a = __int_as_float(__builtin_amdgcn_update_dpp(0, iv, 0xB1, 0xF, 0xF, false));
    v += a;
    iv = __float_as_int(v);
    float b = __int_as_float(__builtin_amdgcn_update_dpp(0, iv, 0x4E, 0xF, 0xF, false));
    return v + b;
}

__device__ __forceinline__ void lds_barrier() {
    asm volatile("s_waitcnt lgkmcnt(0)" ::: "memory");
    __builtin_amdgcn_s_barrier();
    asm volatile("" ::: "memory");
}
__device__ __forceinline__ int obid() { int b = (int)blockIdx.x; asm volatile("" : "+s"(b)); return b; }
__device__ __forceinline__ int ogdim() { int b = (int)gridDim.x; asm volatile("" : "+s"(b)); return b; }
__device__ __forceinline__ int otid(int wave) { int t = wave * 64 + (int)__builtin_amdgcn_mbcnt_hi(~0u, __builtin_amdgcn_mbcnt_lo(~0u, 0u)); asm volatile("" : "+v"(t)); return t; }
template <bool GATHER, class Epi>
__device__ __forceinline__ void gemm_tile(const bf16_t* __restrict__ A, int lda, const int* __restrict__ gidx, int gcount,
                                          const bf16_t* __restrict__ Bt, int ldb, int K, int row0, int col0, const Epi& epi,
                                          bf16_t* smem, int wave) {
    const int tidx = otid(wave);
    const int tid = tidx, wid = tid >> 6, lane = tid & 63, wr = wid >> 1, wc = wid & 1, fr = lane & 15, fq = lane >> 4;
    unsigned char* sm = reinterpret_cast<unsigned char*>(smem);
    const bf16_t* ap[4];
    const bf16_t* bp[2];
#pragma unroll
    for (int i = 0; i < 4; ++i) {
        const int pch = tid + i * 512;
        const int r = pch >> 3, c = (pch & 7) ^ (r & 7);
        int ar = row0 + r;
        if (GATHER) {
            int gi = ar < gcount ? ar : gcount - 1;
            ar = gidx[gi] >> 1;
        }
        ap[i] = A + (size_t)ar * lda + c * 8;
    }
#pragma unroll
    for (int i = 0; i < 2; ++i) {
        const int pch = tid + i * 512;
        const int r = pch >> 3, c = (pch & 7) ^ (r & 7);
        bp[i] = Bt + (size_t)(col0 + r) * ldb + c * 8;
    }
    f32x4 acc[4][4];
#pragma unroll
    for (int m = 0; m < 4; ++m)
#pragma unroll
        for (int n = 0; n < 4; ++n) acc[m][n] = (f32x4){0.f, 0.f, 0.f, 0.f};
    const int nk = K >> 6;
#define GT_STAGE(kt, buf) do { _Pragma("unroll") for (int i_ = 0; i_ < 4; ++i_) \
        __builtin_amdgcn_global_load_lds((const unsigned*)(ap[i_] + (kt) * 64), (__attribute__((address_space(3))) unsigned*)(sm + (buf) * 49152 + (tid + i_ * 512) * 16), 16, 0, 0); \
        _Pragma("unroll") for (int i_ = 0; i_ < 2; ++i_) \
        __builtin_amdgcn_global_load_lds((const unsigned*)(bp[i_] + (kt) * 64), (__attribute__((address_space(3))) unsigned*)(sm + (buf) * 49152 + 32768 + (tid + i_ * 512) * 16), 16, 0, 0); } while (0)
    GT_STAGE(0, 0);
    for (int kt = 0; kt < nk; ++kt) {
        const int buf = kt & 1;
        if (kt + 1 < nk) {
            GT_STAGE(kt + 1, buf ^ 1);
            asm volatile("s_waitcnt vmcnt(6)" ::: "memory");
        } else {
            asm volatile("s_waitcnt vmcnt(0)" ::: "memory");
        }
        __builtin_amdgcn_s_barrier();
        asm volatile("" ::: "memory");
        const unsigned char* SA = sm + buf * 49152;
        const unsigned char* SB = SA + 32768;
#pragma unroll
        for (int ks = 0; ks < 2; ++ks) {
            bf16x8 af[4], bfr[4];
            const int cs = ((ks * 4 + fq) ^ (fr & 7)) * 16;
#pragma unroll
            for (int m = 0; m < 4; ++m) af[m] = *reinterpret_cast<const bf16x8*>(SA + (wr * 64 + m * 16 + fr) * 128 + cs);
#pragma unroll
            for (int n = 0; n < 4; ++n) bfr[n] = *reinterpret_cast<const bf16x8*>(SB + (wc * 64 + n * 16 + fr) * 128 + cs);
#pragma unroll
            for (int m = 0; m < 4; ++m)
#pragma unroll
                for (int n = 0; n < 4; ++n) acc[m][n] = __builtin_amdgcn_mfma_f32_16x16x32_bf16(bfr[n], af[m], acc[m][n], 0, 0, 0);
        }
        asm volatile("s_waitcnt lgkmcnt(0)" ::: "memory");
        __builtin_amdgcn_s_barrier();
        asm volatile("" ::: "memory");
    }
#undef GT_STAGE
    epi(acc, row0 + wr * 64, col0 + wc * 64, fr, fq);
}

struct EpiStoreBf16 {
    bf16_t* O; int ldo;
    __device__ __forceinline__ void operator()(f32x4 (&acc)[4][4], int rb, int cb, int fr, int fq) const {
#pragma unroll
        for (int m = 0; m < 4; ++m)
#pragma unroll
            for (int n = 0; n < 4; ++n) {
                int row = rb + m * 16 + fr, col = cb + n * 16 + fq * 4;
                uint2 w; w.x = pack2(acc[m][n][0], acc[m][n][1]); w.y = pack2(acc[m][n][2], acc[m][n][3]);
                *reinterpret_cast<uint2*>(O + (size_t)row * ldo + col) = w;
            }
    }
};
template <int MODE>
struct EpiLora {
    float* Of; bf16_t* Ob; const float* vec; int ldo; int coff;
    __device__ __forceinline__ void operator()(f32x4 (&acc)[4][4], int rb, int cb, int fr, int fq) const {
#pragma unroll
        for (int m = 0; m < 4; ++m)
#pragma unroll
            for (int n = 0; n < 4; ++n) {
                int row = rb + m * 16 + fr, col = cb + n * 16 + fq * 4;
                float v[4];
#pragma unroll
                for (int j = 0; j < 4; ++j) {
                    float a = acc[m][n][j];
                    if (MODE == 0) {
                        float t = -(vec[col + j] + a);
                        float sp = (t > 20.f) ? t : log1pf(__expf(t));
                        float wl = -sp - 0.5f;
                        v[j] = -__expf(wl);
                    } else if (MODE == 1) {
                        v[j] = sigmoidf_(vec[col + j] + a);
                    } else if (MODE == 2) {
                        v[j] = a;
                    } else {
                        v[j] = a * vec[coff + col + j];
                    }
                }
                {
                    uint2 w; w.x = pack2(v[0], v[1]); w.y = pack2(v[2], v[3]);
                    *reinterpret_cast<uint2*>(Ob + (size_t)row * ldo + coff + col) = w;
                }
            }
    }
};
struct EpiOut {
    const float* Xprev; float* X;
    __device__ __forceinline__ void operator()(f32x4 (&acc)[4][4], int rb, int cb, int fr, int fq) const {
#pragma unroll
        for (int m = 0; m < 4; ++m)
#pragma unroll
            for (int n = 0; n < 4; ++n) {
                int row = rb + m * 16 + fr, col = cb + n * 16 + fq * 4;
                float4 xp = *reinterpret_cast<const float4*>(Xprev + (size_t)row * DM + col);
                float4 o;
                o.x = ALPHA_F * xp.x + acc[m][n][0]; o.y = ALPHA_F * xp.y + acc[m][n][1];
                o.z = ALPHA_F * xp.z + acc[m][n][2]; o.w = ALPHA_F * xp.w + acc[m][n][3];
                *reinterpret_cast<float4*>(X + (size_t)row * DM + col) = o;
            }
    }
};
struct EpiExp1 {
    bf16_t* H; int base; int cnt;
    __device__ __forceinline__ void operator()(f32x4 (&acc)[4][4], int rb, int cb, int fr, int fq) const {
#pragma unroll
        for (int m = 0; m < 4; ++m) {
            int li = rb + m * 16 + fr;
            if (li < cnt) {
#pragma unroll
                for (int i = 0; i < 2; ++i) {
                    int hcol = (cb >> 1) + i * 16 + fq * 4;
                    float v[4];
#pragma unroll
                    for (int j = 0; j < 4; ++j) v[j] = siluf_(acc[m][2 * i][j]) * acc[m][2 * i + 1][j];
                    uint2 w; w.x = pack2(v[0], v[1]); w.y = pack2(v[2], v[3]);
                    *reinterpret_cast<uint2*>(H + (size_t)(base + li) * 128 + hcol) = w;
                }
            }
        }
    }
};
struct EpiExp2 {
    bf16_t* FS; const int* ltok; const float* lgate; int cnt;
    __device__ __forceinline__ void operator()(f32x4 (&acc)[4][4], int rb, int cb, int fr, int fq) const {
#pragma unroll
        for (int m = 0; m < 4; ++m) {
            int li = rb + m * 16 + fr;
            if (li < cnt) {
                int pk = ltok[li]; float g = lgate[li];
                int tok = pk >> 1, j = pk & 1;
                bf16_t* o = FS + ((size_t)j * NT + tok) * DM;
#pragma unroll
                for (int n = 0; n < 4; ++n) {
                    int col = cb + n * 16 + fq * 4;
                    uint2 w; w.x = pack2(acc[m][n][0] * g, acc[m][n][1] * g); w.y = pack2(acc[m][n][2] * g, acc[m][n][3] * g);
                    *reinterpret_cast<uint2*>(o + col) = w;
                }
            }
        }
    }
};

namespace pg8 {
#define PG8_LAS __attribute__((address_space(3)))
typedef unsigned short bf16_t;
typedef short bf16x8 __attribute__((ext_vector_type(8)));
typedef float f32x4 __attribute__((ext_vector_type(4)));
typedef unsigned u32x4 __attribute__((ext_vector_type(4)));
constexpr int BM = 256, BK = 64, HALF = 128, HTB = HALF * BK * 2  , STAGE_BYTES = 8 * HTB, NXCD = 8, WGM = 8;

__host__ __device__ __forceinline__ int lds_byte(int r, int c) { const int st = (r >> 4) * 2 + (c >> 5), rr = r & 15, cc = c & 31, ob = rr * 64 + cc * 2; return st * 1024 + (ob ^ (((ob >> 9) & 1) << 5)); }
__host__ __device__ __forceinline__ void stage_rc(int b, int& R, int& C) { const int st = b / 1024, sb = b % 1024, swz = sb ^ (((sb >> 9) & 1) << 5); R = (st >> 1) * 16 + swz / 64; C = (st & 1) * 32 + (swz % 64) / 2; }
__host__ __device__ __forceinline__ int perm32(int rho) { const int n = rho >> 4, i = rho & 15; return 8 * (i >> 2) + 4 * n + (i & 3); }

struct Unit { int pm, pn; };
struct Gemm { const bf16_t* A; const bf16_t* Bt; int M, N, K; };

struct StaticOrder {
    int nM, nN, nwg, G, c;
    __host__ __device__ void init(int M, int N, int G_, int c_) { nM = M / BM; nN = N / BM; nwg = nM * nN; G = G_; c = c_; }
    __host__ __device__ bool next(int i, Unit& u) const {
        const long L = (long)i * G + c; if (L >= nwg) return false;
        int wgid = (int)L; { const int q = nwg / NXCD, r = nwg % NXCD, xcd = wgid % NXCD, off = wgid / NXCD; wgid = (xcd < r ? xcd * (q + 1) : r * (q + 1) + (xcd - r) * q) + off; }
        const int nig = WGM * nN, gid = wgid / nig, fm = gid * WGM, gsz = (nM - fm) < WGM ? (nM - fm) : WGM;
        u.pm = fm + ((wgid % nig) % gsz); u.pn = (wgid % nig) / gsz; return true;
    }
    __device__ __forceinline__ void a_ready(const Unit&) const {}
    __device__ __forceinline__ void done(const Unit&) const {}
};
template <class Epi, class Sched, bool ALIGN_EPI = false, bool SP2 = false>
__device__ __forceinline__ void gemm_phase(PG8_LAS unsigned char* lds, const Gemm g, const Sched& S, const Epi& E, int wave) {
    const int tid = otid(wave), wid = __builtin_amdgcn_readfirstlane(tid >> 6), lane = tid & 63, wr = wid >> 2, wc = wid & 3, fr = lane & 15, fq = lane >> 4;
    const int K = g.K, nt = K / BK;
    unsigned voffA[2], voffB[2];
#pragma unroll
    for (int i = 0; i < 2; ++i) { int R, C; stage_rc(tid * 16 + i * 8192, R, C); const int Rb = Epi::PERM ? ((R & ~31) + perm32(R & 31)) : R;
        voffA[i] = (unsigned)(R * K + C) * 2u; voffB[i] = (unsigned)(Rb * K + C) * 2u; }
    const size_t kstep = (size_t)(BK * 2);
    const size_t hstep = (size_t)HALF * K * 2;
    const size_t tstep = 2 * hstep;
    const unsigned ldsw = (unsigned)wid * 1024u;
    const int aoff = lds_byte(wr * 64 + fr, fq * 8), boff = lds_byte(wc * 32 + fr, fq * 8);
#define PG8_SA(b, h) (((b) * 2 + (h)) * HTB)
#define PG8_SB(b, h) ((4 + (b) * 2 + (h)) * HTB)
#define PG8_STAGE(bufoff, gbase, voff) do { _Pragma("unroll") for (int _i = 0; _i < 2; ++_i) \
        __builtin_amdgcn_global_load_lds((const unsigned*)((const char*)(gbase) + (voff)[_i]), (PG8_LAS unsigned*)(lds + (bufoff) + ldsw + _i * 8192), 16, 0, 0); } while (0)
#define PG8_LDA(dst, b, h) do { _Pragma("unroll") for (int m = 0; m < 4; ++m) _Pragma("unroll") for (int k = 0; k < 2; ++k) dst[m][k] = *(const PG8_LAS bf16x8*)(lds + PG8_SA(b, h) + aoff + m * 2048 + k * 1024); } while (0)
#define PG8_LDB(dst, b, h) do { _Pragma("unroll") for (int n = 0; n < 2; ++n) _Pragma("unroll") for (int k = 0; k < 2; ++k) dst[n][k] = *(const PG8_LAS bf16x8*)(lds + PG8_SB(b, h) + boff + n * 2048 + k * 1024); } while (0)
#define PG8_MMA(ai, bj, At, Bt) do { __builtin_amdgcn_s_setprio(1); _Pragma("unroll") for (int m = 0; m < 4; ++m) _Pragma("unroll") for (int n = 0; n < 2; ++n) _Pragma("unroll") for (int k = 0; k < 2; ++k) \
        acc[ai][bj][m][n] = __builtin_amdgcn_mfma_f32_16x16x32_bf16(Bt[n][k], At[m][k], acc[ai][bj][m][n], 0, 0, 0); __builtin_amdgcn_s_setprio(0); } while (0)
#define PG8_WAIT_V(n) asm volatile("s_waitcnt vmcnt(" #n ")" ::: "memory")
#define PG8_WAIT_L(n) asm volatile("s_waitcnt lgkmcnt(" #n ")" ::: "memory")
#define PG8_BAR __builtin_amdgcn_s_barrier()
#define PG8_SCHED __builtin_amdgcn_sched_barrier(0)
    Unit cur, nxt; int ui = 0;
    if (!S.next(0, cur)) return;
    f32x4 acc[2][2][4][2];
#pragma unroll
    for (int a = 0; a < 2; ++a)
#pragma unroll
        for (int b = 0; b < 2; ++b)
#pragma unroll
            for (int m = 0; m < 4; ++m)
#pragma unroll
                for (int n = 0; n < 2; ++n) acc[a][b][m][n] = (f32x4){0.f, 0.f, 0.f, 0.f};
    bf16x8 At[4][2], B0[2][2], B1[2][2];
    const char* cA = (const char*)g.A + (size_t)cur.pm * tstep; const char* cB = (const char*)g.Bt + (size_t)cur.pn * tstep;
    S.a_ready(cur);
    if constexpr (SP2) {
        PG8_STAGE(PG8_SB(0, 0), cB, voffB); PG8_STAGE(PG8_SB(0, 1), cB + hstep, voffB); PG8_STAGE(PG8_SA(0, 0), cA, voffA); PG8_STAGE(PG8_SA(0, 1), cA + hstep, voffA);
        if (wr == 1) PG8_BAR;
        PG8_WAIT_V(2); PG8_BAR;
        PG8_STAGE(PG8_SB(1, 0), cB + kstep, voffB); PG8_STAGE(PG8_SA(1, 0), cA + kstep, voffA); PG8_STAGE(PG8_SB(1, 1), cB + hstep + kstep, voffB);
        PG8_WAIT_V(6); PG8_BAR;
    } else {
        PG8_STAGE(PG8_SB(0, 0), cB, voffB); PG8_STAGE(PG8_SA(0, 0), cA, voffA); PG8_STAGE(PG8_SB(0, 1), cB + hstep, voffB); PG8_STAGE(PG8_SA(0, 1), cA + hstep, voffA);
        if (wr == 1) PG8_BAR;
        PG8_WAIT_V(4); PG8_BAR;
        PG8_STAGE(PG8_SB(1, 0), cB + kstep, voffB); PG8_STAGE(PG8_SA(1, 0), cA + kstep, voffA); PG8_STAGE(PG8_SB(1, 1), cB + hstep + kstep, voffB);
        PG8_WAIT_V(6); PG8_BAR;
    }
    for (;;) {
        const bool has_next = S.next(ui + 1, nxt);
        const char* nA = has_next ? (const char*)g.A + (size_t)nxt.pm * tstep : cA; const char* nB = has_next ? (const char*)g.Bt + (size_t)nxt.pn * tstep : cB;
        for (int t = 0; t < nt; t += 2) {
            const bool last = (t == nt - 2);
            const char* a1 = cA + (size_t)(t + 1) * kstep;
            const char* a2 = last ? nA : cA + (size_t)(t + 2) * kstep; const char* b2 = last ? nB : cB + (size_t)(t + 2) * kstep;
            const char* a3 = a2 + kstep; const char* b3 = b2 + kstep;
            if (last && has_next) S.a_ready(nxt);
            if constexpr (SP2) {
            PG8_LDB(B0, 0, 0); PG8_LDB(B1, 0, 1); PG8_SCHED; PG8_LDA(At, 0, 0); PG8_STAGE(PG8_SA(1, 1), a1 + hstep, voffA);
            PG8_WAIT_V(8); PG8_WAIT_L(0); PG8_BAR; PG8_MMA(0, 0, At, B0); PG8_MMA(0, 1, At, B1); PG8_BAR; PG8_SCHED;
            PG8_LDA(At, 0, 1); PG8_STAGE(PG8_SB(0, 0), b2, voffB); PG8_STAGE(PG8_SB(0, 1), b2 + hstep, voffB); PG8_STAGE(PG8_SA(0, 0), a2, voffA);
            PG8_WAIT_V(8); PG8_WAIT_L(0); PG8_BAR; PG8_MMA(1, 0, At, B0); PG8_MMA(1, 1, At, B1); PG8_BAR; PG8_SCHED;
            PG8_LDB(B0, 1, 0); PG8_LDB(B1, 1, 1); PG8_SCHED; PG8_LDA(At, 1, 0); PG8_STAGE(PG8_SA(0, 1), a2 + hstep, voffA);
            PG8_WAIT_V(8); PG8_WAIT_L(0); PG8_BAR; PG8_MMA(0, 0, At, B0); PG8_MMA(0, 1, At, B1); PG8_BAR; PG8_SCHED;
            PG8_LDA(At, 1, 1); PG8_STAGE(PG8_SB(1, 0), b3, voffB); PG8_STAGE(PG8_SB(1, 1), b3 + hstep, voffB); PG8_STAGE(PG8_SA(1, 0), a3, voffA);
            PG8_WAIT_V(8); PG8_WAIT_L(0); PG8_BAR; PG8_MMA(1, 0, At, B0); PG8_MMA(1, 1, At, B1); PG8_BAR; PG8_SCHED;
            } else {
            PG8_LDB(B0, 0, 0); PG8_SCHED; PG8_LDA(At, 0, 0); PG8_STAGE(PG8_SA(1, 1), a1 + hstep, voffA);
            PG8_WAIT_L(8); PG8_BAR; PG8_WAIT_L(0); PG8_MMA(0, 0, At, B0); PG8_BAR; PG8_SCHED;
            PG8_LDB(B1, 0, 1); PG8_STAGE(PG8_SB(0, 0), b2, voffB);
            PG8_BAR; PG8_WAIT_L(0); PG8_MMA(0, 1, At, B1); PG8_BAR;
            PG8_LDA(At, 0, 1); PG8_STAGE(PG8_SA(0, 0), a2, voffA);
            PG8_BAR; PG8_WAIT_L(0); PG8_MMA(1, 0, At, B0); PG8_BAR; PG8_SCHED;
            PG8_STAGE(PG8_SB(0, 1), b2 + hstep, voffB);
            PG8_WAIT_V(6); PG8_BAR; PG8_MMA(1, 1, At, B1); PG8_BAR;
            PG8_LDB(B0, 1, 0); PG8_SCHED; PG8_LDA(At, 1, 0); PG8_STAGE(PG8_SA(0, 1), a2 + hstep, voffA);
            PG8_WAIT_L(8); PG8_BAR; PG8_WAIT_L(0); PG8_MMA(0, 0, At, B0); PG8_BAR; PG8_SCHED;
            PG8_LDB(B1, 1, 1); PG8_STAGE(PG8_SB(1, 0), b3, voffB);
            PG8_BAR; PG8_WAIT_L(0); PG8_MMA(0, 1, At, B1); PG8_BAR;
            PG8_LDA(At, 1, 1); PG8_STAGE(PG8_SA(1, 0), a3, voffA);
            PG8_BAR; PG8_WAIT_L(0); PG8_MMA(1, 0, At, B0); PG8_BAR; PG8_SCHED;
            PG8_STAGE(PG8_SB(1, 1), b3 + hstep, voffB);
            PG8_WAIT_V(6); PG8_BAR; PG8_MMA(1, 1, At, B1); PG8_BAR;
            }
        }
        if constexpr (ALIGN_EPI) { if (wr == 0) PG8_BAR; }
        if constexpr (!Epi::AFTER_DRAIN) { E(acc, cur, wr, wc, fr, fq); S.done(cur); }
        if (!has_next) break;
#pragma unroll
        for (int a = 0; a < 2; ++a)
#pragma unroll
            for (int b = 0; b < 2; ++b)
#pragma unroll
                for (int m = 0; m < 4; ++m)
#pragma unroll
                    for (int n = 0; n < 2; ++n) acc[a][b][m][n] = (f32x4){0.f, 0.f, 0.f, 0.f};
        cur = nxt; cA = nA; cB = nB; ++ui;
        if constexpr (ALIGN_EPI) { if (wr == 1) PG8_BAR; }
    }
    PG8_WAIT_V(0);
    if constexpr (!ALIGN_EPI) { if (wr == 0) PG8_BAR; }
    PG8_BAR;
    if constexpr (Epi::AFTER_DRAIN) { E.fused(acc, cur, wr, wc, fr, fq, lds, wid, lane); S.done(cur); }
#undef PG8_SA
#undef PG8_SB
#undef PG8_STAGE
#undef PG8_LDA
#undef PG8_LDB
#undef PG8_MMA
#undef PG8_WAIT_V
#undef PG8_WAIT_L
#undef PG8_BAR
#undef PG8_SCHED
}
}
struct PEpiBf16 {
    static constexpr bool PERM = true, AFTER_DRAIN = false;
    bf16_t* O; int ldo;
    __device__ __forceinline__ void operator()(const pg8::f32x4 (&acc)[2][2][4][2], const pg8::Unit& u, int wr, int wc, int fr, int fq) const {
        const int row0 = u.pm * 256 + wr * 64 + fr, col0 = u.pn * 256 + wc * 32 + 8 * fq;
#pragma unroll
        for (int ai = 0; ai < 2; ++ai)
#pragma unroll
            for (int m = 0; m < 4; ++m) {
                bf16_t* rowp = O + (size_t)(row0 + ai * 128 + m * 16) * ldo + col0;
#pragma unroll
                for (int bj = 0; bj < 2; ++bj) {
                    const pg8::f32x4 v0 = acc[ai][bj][m][0], v1 = acc[ai][bj][m][1];
                    uint4 w; w.x = pack2(v0[0], v0[1]); w.y = pack2(v0[2], v0[3]); w.z = pack2(v1[0], v1[1]); w.w = pack2(v1[2], v1[3]);
                    *reinterpret_cast<uint4*>(rowp + bj * 128) = w;
                }
            }
    }
};
template <bool PREV_BF16>
struct PEpiOut {
    static constexpr bool PERM = false, AFTER_DRAIN = false;
    const float* Xprev; const bf16_t* XprevB; float* X;
    __device__ __forceinline__ void operator()(const pg8::f32x4 (&acc)[2][2][4][2], const pg8::Unit& u, int wr, int wc, int fr, int fq) const {
        const int row0 = u.pm * 256 + wr * 64 + fr, col0 = u.pn * 256 + wc * 32 + 4 * fq;
#pragma unroll
        for (int ai = 0; ai < 2; ++ai)
#pragma unroll
            for (int m = 0; m < 4; ++m) {
                const size_t ro = (size_t)(row0 + ai * 128 + m * 16) * DM + col0;
#pragma unroll
                for (int bj = 0; bj < 2; ++bj)
#pragma unroll
                    for (int n = 0; n < 2; ++n) {
                        const size_t o = ro + bj * 128 + n * 16;
                        float4 xp;
                        if (PREV_BF16) {
                            const uint2 t = *reinterpret_cast<const uint2*>(XprevB + o);
                            xp.x = __uint_as_float(t.x << 16); xp.y = __uint_as_float(t.x & 0xffff0000u);
                            xp.z = __uint_as_float(t.y << 16); xp.w = __uint_as_float(t.y & 0xffff0000u);
                        } else {
                            xp = *reinterpret_cast<const float4*>(Xprev + o);
                        }
                        const pg8::f32x4 a = acc[ai][bj][m][n];
                        float4 r;
                        r.x = ALPHA_F * xp.x + a[0]; r.y = ALPHA_F * xp.y + a[1]; r.z = ALPHA_F * xp.z + a[2]; r.w = ALPHA_F * xp.w + a[3];
                        *reinterpret_cast<float4*>(X + o) = r;
                    }
            }
    }
};
template <class Epi>
__device__ __forceinline__ void big_gemm(const bf16_t* A, const bf16_t* Bt, int M, int N, int K, const Epi& e, unsigned char* smem, int wave) {
    pg8::Gemm g{A, Bt, M, N, K};
    pg8::StaticOrder S;
    S.init(M, N, ogdim(), obid());
    pg8::gemm_phase<Epi, pg8::StaticOrder, true, true>((PG8_LAS unsigned char*)smem, g, S, e, wave);
}

__device__ __forceinline__ void tconv_wave(const float* __restrict__ src, int N, bf16_t* __restrict__ dst, int ldd, int k0, int n0,
                                           int mode, float* tile, int lane) {
#pragma unroll
    for (int i = 0; i < 8; ++i) {
        const int r = i * 8 + (lane >> 3), c4 = (lane & 7) * 4;
        const float4 v = *reinterpret_cast<const float4*>(src + (size_t)(k0 + r) * N + n0 + c4);
        tile[r * 33 + c4] = v.x; tile[r * 33 + c4 + 1] = v.y; tile[r * 33 + c4 + 2] = v.z; tile[r * 33 + c4 + 3] = v.w;
    }
    asm volatile("s_waitcnt lgkmcnt(0)" ::: "memory");
#pragma unroll 8
    for (int nn = 0; nn < 32; ++nn) {
        const int n = n0 + nn;
        int drow = n;
        if (mode == 1) drow = (n >> 4) * 32 + (n & 15);
        else if (mode == 2) drow = (n >> 4) * 32 + 16 + (n & 15);
        dst[(size_t)drow * ldd + k0 + lane] = f2bf(tile[lane * 33 + nn]);
    }
    asm volatile("s_waitcnt lgkmcnt(0)" ::: "memory");
}

__device__ __forceinline__ void phase_pre(const Params& p, unsigned char* smem, int part, int bid, int nb) {
    const int tidx = otid(p.wave);
    const int wv = tidx >> 6, lane = tidx & 63;
    float* tile = reinterpret_cast<float*>(smem) + wv * (64 * 33);
    bf16_t* W = reinterpret_cast<bf16_t*>(p.ws + OFF_W);
    constexpr int T0 = 1152, T1 = 512, T7 = 16, T8 = 16, T9 = 32, T10 = 32;
    constexpr int T2 = 1536, T3 = 512, T4 = 4096, T5 = 4096, T6 = 4096;
    if (part == 0) {
        if (bid == 0) {
            if (tidx < 64) reinterpret_cast<int*>(p.ws + OFF_CTRL)[tidx] = 0;
            unsigned* bar = reinterpret_cast<unsigned*>(p.ws + OFF_CTRL + 4096);
            for (int i = tidx; i < XCD_BAR_WORDS; i += NTHREADS) bar[i] = 0u;
        }
        constexpr int TOT = T0 + T1 + T7 + T8 + T9 + T10;
        for (int u = bid * NWAVES + wv; u < TOT; u += nb * NWAVES) {
            int v = u;
            const float* src; bf16_t* dst; int K, N, tk, tn;
            if (v < T0) { src = p.in[1]; K = 1024; N = 2304; dst = W + WE_IN0; tk = v / 72; tn = v % 72; }
            else if ((v -= T0) < T1) { src = p.in[15]; K = 1024; N = 1024; dst = W + WE_OUT0; tk = v / 32; tn = v % 32; }
            else if ((v -= T1) < T7) { src = p.in[4]; K = 64; N = 512; dst = W + WE_LW2; tk = 0; tn = v; }
            else if ((v -= T7) < T8) { src = p.in[6]; K = 64; N = 512; dst = W + WE_LA2; tk = 0; tn = v; }
            else if ((v -= T8) < T9) { src = p.in[7]; K = 128; N = 512; dst = W + WE_LG2; tk = v >> 4; tn = v & 15; }
            else { v -= T9; int mat = v >> 3, w = v & 7; src = p.in[13] + (size_t)mat * 16384; K = 128; N = 128; dst = W + WE_POOL + (size_t)mat * 16384; tk = w >> 2; tn = w & 3; }
            tconv_wave(src, N, dst, K, tk * 64, tn * 32, 0, tile, lane);
        }
        const float4* x4 = reinterpret_cast<const float4*>(p.in[0]);
        uint2* xb = reinterpret_cast<uint2*>(p.ws + OFF_ACTB);
        const size_t n4 = (size_t)NT * DM / 4;
        const size_t stride = (size_t)nb * NTHREADS;
        for (size_t i = (size_t)bid * NTHREADS + tidx; i < n4; i += 8 * stride) {
            float4 v[8];
#pragma unroll
            for (int j = 0; j < 8; ++j) if (i + j * stride < n4) v[j] = x4[i + j * stride];
#pragma unroll
            for (int j = 0; j < 8; ++j) if (i + j * stride < n4) {
                uint2 w; w.x = pack2(v[j].x, v[j].y); w.y = pack2(v[j].z, v[j].w);
                xb[i + j * stride] = w;
            }
        }
    } else {
        constexpr int TOT = T2 + T3 + T4 + T5 + T6;
        for (int u = bid * NWAVES + wv; u < TOT; u += nb * NWAVES) {
            int v = u;
            const float* src; bf16_t* dst; int K, N, mode = 0, tk, tn;
            if (v < T2) { src = p.in[16]; K = 1024; N = 3072; dst = W + WE_IN1; tk = v / 96; tn = v % 96; }
            else if ((v -= T2) < T3) { src = p.in[23]; K = 1024; N = 1024; dst = W + WE_OUT1; tk = v / 32; tn = v % 32; }
            else if ((v -= T3) < T4) { int mat = v >> 6, w = v & 63; src = p.in[30] + (size_t)mat * 131072; K = 1024; N = 128; dst = W + WE_W13 + (size_t)mat * 262144; mode = 1; tk = w >> 2; tn = w & 3; }
            else if ((v -= T4) < T5) { int mat = v >> 6, w = v & 63; src = p.in[31] + (size_t)mat * 131072; K = 1024; N = 128; dst = W + WE_W13 + (size_t)mat * 262144; mode = 2; tk = w >> 2; tn = w & 3; }
            else { v -= T5; int mat = v >> 6, w = v & 63; src = p.in[32] + (size_t)mat * 131072; K = 128; N = 1024; dst = W + WE_W2 + (size_t)mat * 131072; tk = w >> 5; tn = w & 31; }
            tconv_wave(src, N, dst, K, tk * 64, tn * 32, mode, tile, lane);
        }
        {
            bf16_t* RH = W + WE_RT_HI; bf16_t* RL = W + WE_RT_LO;
            for (int i = bid * NTHREADS + tidx; i < 2 * 48 * 1024; i += nb * NTHREADS) {
                const int l = i / (48 * 1024), r = i - l * 48 * 1024, n = r >> 10, k = r & 1023;
                float w = 0.f;
                if (n < 4) w = p.in[26][((size_t)l * 1024 + k) * 4 + n];
                else if (n < 36) w = p.in[28][((size_t)l * 1024 + k) * 32 + (n - 4)];
                const bf16_t h = f2bf(w);
                RH[i] = h; RL[i] = f2bf(w - bf2f(h));
            }
        }
        {
            float2* rope = reinterpret_cast<float2*>(p.ws + OFF_ROPE);
            for (int i = bid * NTHREADS + tidx; i < SEQ * 32; i += nb * NTHREADS) {
                int pos = i >> 5, k = i & 31;
                float inv = powf(10000.0f, -(float)k / 32.0f);
                float ang = (float)pos * inv;
                const double a = (double)ang;
                const double q = rint(a * 0.15915494309189535);
                const float rr = (float)(a - q * 6.283185307179586);
                float s, c;
                sincosf(rr, &s, &c);
                rope[i] = make_float2(c, s);
            }
        }
    }
}

__device__ __forceinline__ void phase_l0_prep(const Params& p) {
    const int tidx = otid(p.wave);
    const bf16_t* P = reinterpret_cast<const bf16_t*>(p.ws + OFF_P);
    bf16_t* LA = reinterpret_cast<bf16_t*>(p.ws + OFF_LORA);
    bf16_t* PO = reinterpret_cast<bf16_t*>(p.ws + OFF_POOLED);
    const float* mu = p.in[2];
    const int total = NT * 96;
    for (int it = obid() * NTHREADS + tidx; it < total; it += ogdim() * NTHREADS) {
        const int tok = it / 96, j = it - tok * 96;
        const int s = tok & (SEQ - 1);
        if (j < 32) {
            const int col = 1536 + j * 8;
            float cur[8], prv[8];
            unpack8(*reinterpret_cast<const uint4*>(P + (size_t)tok * 2304 + col), cur);
            if (s > 0) unpack8(*reinterpret_cast<const uint4*>(P + (size_t)(tok - 1) * 2304 + col), prv);
            else {
#pragma unroll
                for (int i = 0; i < 8; ++i) prv[i] = 0.f;
            }
            const float4 m0 = *reinterpret_cast<const float4*>(mu + col), m1 = *reinterpret_cast<const float4*>(mu + col + 4);
            const float mm[8] = {m0.x, m0.y, m0.z, m0.w, m1.x, m1.y, m1.z, m1.w};
            float o[8];
#pragma unroll
            for (int i = 0; i < 8; ++i) {
                const float z = cur[i] + mm[i] * (prv[i] - cur[i]);
                o[i] = (j < 8) ? tanhf(z) : ((j < 16) ? z : sigmoidf_(z));
            }
            uint4 w; w.x = pack2(o[0], o[1]); w.y = pack2(o[2], o[3]); w.z = pack2(o[4], o[5]); w.w = pack2(o[6], o[7]);
            *reinterpret_cast<uint4*>(LA + (size_t)tok * 256 + j * 8) = w;
        } else {
            const int cc = (j - 32) * 8;
            const int gi = cc >> 7;
            const int win = 2 << gi;
            const int cnt = (s + 1 < win) ? (s + 1) : win;
            const bf16_t* src = P + (size_t)tok * 2304 + 1792 + cc;
            float u[8], sum[8];
            uint4 rows[16];
#pragma unroll
            for (int r = 0; r < 16; ++r) {
                rows[r] = make_uint4(0u, 0u, 0u, 0u);
                if (r < cnt) rows[r] = *reinterpret_cast<const uint4*>(src - (size_t)r * 2304);
            }
            unpack8(rows[0], u);
#pragma unroll
            for (int i = 0; i < 8; ++i) sum[i] = u[i];
#pragma unroll
            for (int r = 1; r < 16; ++r) {
                float t[8];
                unpack8(rows[r], t);
#pragma unroll
                for (int i = 0; i < 8; ++i) sum[i] += t[i];
            }
            const float inv = 1.0f / (float)cnt;
            uint4 w;
            w.x = pack2(sum[0] * inv - u[0], sum[1] * inv - u[1]); w.y = pack2(sum[2] * inv - u[2], sum[3] * inv - u[3]);
            w.z = pack2(sum[4] * inv - u[4], sum[5] * inv - u[5]); w.w = pack2(sum[6] * inv - u[6], sum[7] * inv - u[7]);
            *reinterpret_cast<uint4*>(PO + (size_t)tok * 512 + cc) = w;
        }
    }
}

__device__ __forceinline__ void phase_l0_lora(const Params& p, bf16_t* smem) {
    const bf16_t* W = reinterpret_cast<const bf16_t*>(p.ws + OFF_W);
    const bf16_t* LA = reinterpret_cast<const bf16_t*>(p.ws + OFF_LORA);
    const bf16_t* PO = reinterpret_cast<const bf16_t*>(p.ws + OFF_POOLED);
    for (int t = obid(); t < 2048; t += ogdim()) {
        int job = t >> 9, w = t & 511;
        if (job == 0) {
            EpiLora<0> e{nullptr, reinterpret_cast<bf16_t*>(p.ws + OFF_LOGW), p.in[3], 512, 0};
            gemm_tile<false>(LA, 256, nullptr, 0, W + WE_LW2, 64, 64, (w >> 2) * 256, (w & 3) * 128, e, smem, p.wave);
        } else if (job == 1) {
            EpiLora<1> e{nullptr, reinterpret_cast<bf16_t*>(p.ws + OFF_AA), p.in[5], 512, 0};
            gemm_tile<false>(LA + 64, 256, nullptr, 0, W + WE_LA2, 64, 64, (w >> 2) * 256, (w & 3) * 128, e, smem, p.wave);
        } else if (job == 2) {
            EpiLora<2> e{nullptr, reinterpret_cast<bf16_t*>(p.ws + OFF_GG), nullptr, 512, 0};
            gemm_tile<false>(LA + 128, 256, nullptr, 0, W + WE_LG2, 128, 128, (w >> 2) * 256, (w & 3) * 128, e, smem, p.wave);
        } else {
            int g = w & 3, tm = w >> 2;
            EpiLora<3> e{nullptr, reinterpret_cast<bf16_t*>(p.ws + OFF_YCAT), p.in[14] - 512, 1024, 512 + g * 128};
            gemm_tile<false>(PO + g * 128, 512, nullptr, 0, W + WE_POOL + g * 16384, 128, 128, tm * 256, 0, e, smem, p.wave);
        }
    }
}

#define RC_LD 72
#define RC_BUF (64 * RC_LD)
#define RC_BYTES (RC_BUF * 2)
#define OFF_TBUF OFF_KVT

__device__ __forceinline__ void mm64(f32x4 (&acc)[2], const bf16_t* A, const bf16_t* Bt, int mt, int nt0, int fr, int fq) {
#pragma unroll
    for (int ks = 0; ks < 2; ++ks) {
        bf16x8 af = *reinterpret_cast<const bf16x8*>(A + (mt * 16 + fr) * RC_LD + ks * 32 + fq * 8);
        bf16x8 bq[2];
#pragma unroll
        for (int n = 0; n < 2; ++n) bq[n] = *reinterpret_cast<const bf16x8*>(Bt + ((nt0 + n) * 16 + fr) * RC_LD + ks * 32 + fq * 8);
#pragma unroll
        for (int n = 0; n < 2; ++n) acc[n] = __builtin_amdgcn_mfma_f32_16x16x32_bf16(af, bq[n], acc[n], 0, 0, 0);
    }
}
template <int MASK>
__device__ __forceinline__ void store_T(bf16_t* dst, const f32x4 (&acc)[2], int mt, int nt0, int fr, int fq) {
#pragma unroll
    for (int n = 0; n < 2; ++n) {
        const int C = (nt0 + n) * 16 + fr, R0 = mt * 16 + fq * 4;
        float v[4];
#pragma unroll
        for (int j = 0; j < 4; ++j) {
            const int R = R0 + j;
            bool keep = true;
            if (MASK == 1) keep = R < C;
            else if (MASK == 2) keep = R <= C;
            else if (MASK == 3) keep = C < R;
            v[j] = keep ? acc[n][j] : 0.f;
        }
        uint2 w; w.x = pack2(v[0], v[1]); w.y = pack2(v[2], v[3]);
        *reinterpret_cast<uint2*>(dst + C * RC_LD + R0) = w;
    }
}
__device__ __forceinline__ void zero_acc(f32x4 (&acc)[2]) {
    acc[0] = (f32x4){0.f, 0.f, 0.f, 0.f};
    acc[1] = (f32x4){0.f, 0.f, 0.f, 0.f};
}

#define OFF_NTB (OFF_P + 144ull * MIB)
#define OFF_S0A (OFF_P + 176ull * MIB)
#define OFF_TB (420ull * MIB)
#define OFF_MB (452ull * MIB)
#define OFF_S0B (484ull * MIB)
#define OFF_WLB (500ull * MIB)
__device__ __forceinline__ bf16_t* s0_ptr(unsigned char* ws, int u) {
    return reinterpret_cast<bf16_t*>(ws + (u < 2048 ? OFF_S0A : OFF_S0B)) + (size_t)(u & 2047) * 4096;
}

struct PrepIn {
    unsigned short k[8], v[8], r[8], lw[8], a[8];
    unsigned short pk, pv, pr;
};
template <int MODE>
__device__ __forceinline__ void prep_load(PrepIn& in, const Params& p, int u, int tid) {
    const int b = u >> 10, h = (u >> 7) & 7, n = u & 127;
    const int lane = tid & 63, q = tid >> 6;
    const int c = h * 64 + lane;
    const bf16_t* P = reinterpret_cast<const bf16_t*>(p.ws + OFF_P);
    const bf16_t* LOGW = reinterpret_cast<const bf16_t*>(p.ws + OFF_LOGW);
    const bf16_t* AA = reinterpret_cast<const bf16_t*>(p.ws + OFF_AA);
    const int s0 = n * 64 + q * 8;
    const size_t tok0 = (size_t)b * SEQ + s0;
    in.pk = 0; in.pv = 0; in.pr = 0;
    if (s0 > 0) {
        const bf16_t* pp = P + (tok0 - 1) * 2304;
        in.pk = pp[512 + c]; in.pv = pp[1024 + c];
        if (MODE == 2) in.pr = pp[c];
    }
#pragma unroll
    for (int i = 0; i < 8; ++i) {
        const bf16_t* pp = P + (tok0 + i) * 2304;
        in.k[i] = pp[512 + c]; in.v[i] = pp[1024 + c];
        if (MODE == 2) in.r[i] = pp[c]; else in.r[i] = 0;
        in.lw[i] = LOGW[(tok0 + i) * 512 + c];
        in.a[i] = AA[(tok0 + i) * 512 + c];
    }
}
struct PrepC { float mu_k, kkc, kac, mu_v, mu_r, rkc, lng, lnb; };
template <int MODE>
__device__ __forceinline__ PrepC prep_consts(const Params& p, int h, int lane) {
    PrepC c_;
    const int c = h * 64 + lane;
    c_.mu_k = p.in[2][512 + c]; c_.kkc = p.in[8][c]; c_.kac = p.in[9][c]; c_.mu_v = p.in[2][1024 + c];
    c_.mu_r = 0.f; c_.rkc = 0.f; c_.lng = 0.f; c_.lnb = 0.f;
    if (MODE == 2) { c_.mu_r = p.in[2][c]; c_.rkc = p.in[10][c]; c_.lng = p.in[11][c]; c_.lnb = p.in[12][c]; }
    return c_;
}
template <int MODE>
__device__ __forceinline__ void rwkv_prep(const PrepIn& in, const PrepC& pc, int tid, bf16_t* At, bf16_t* Bt, bf16_t* Kt, bf16_t* Rt,
                                          bf16_t* AtT, bf16_t* BtT, bf16_t* KtT, bf16_t* VT, float* sTot, float* sBC, float* sWL) {
    const int lane = tid & 63, q = tid >> 6;
    const float mu_k = pc.mu_k, kkc = pc.kkc, kac = pc.kac, mu_v = pc.mu_v, mu_r = pc.mu_r, rkc = pc.rkc;
    float lw[8], av[8], zk[8], zr[8], zv[8];
    float pk = bf2f(in.pk), pr = bf2f(in.pr), pv = bf2f(in.pv);
#pragma unroll
    for (int i = 0; i < 8; ++i) {
        const float k0 = bf2f(in.k[i]), v0 = bf2f(in.v[i]);
        zk[i] = k0 + mu_k * (pk - k0); pk = k0;
        zv[i] = v0 + mu_v * (pv - v0); pv = v0;
        if (MODE == 2) { const float r0 = bf2f(in.r[i]); zr[i] = r0 + mu_r * (pr - r0); pr = r0; }
        lw[i] = bf2f(in.lw[i]);
        av[i] = bf2f(in.a[i]);
    }
    float lws[8];
    float cs = 0.f;
#pragma unroll
    for (int i = 0; i < 8; ++i) { cs += lw[i]; lws[i] = cs; }
    sTot[q * 64 + lane] = cs;
    lds_barrier();
    float off = 0.f, tot = 0.f;
#pragma unroll
    for (int qq = 0; qq < 8; ++qq) { float tq = sTot[qq * 64 + lane]; if (qq < q) off += tq; tot += tq; }
    float atv[8], btv[8], ktv[8];
#pragma unroll
    for (int i = 0; i < 8; ++i) {
        const int t = q * 8 + i;
        const float L = lws[i] + off;
        float kk = zk[i] * kkc;
        float ss = wave_sum(kk * kk);
        kk *= rsqrtf(fmaxf(ss, 1e-24f));
        const float e_neg = __expf(-L), e_prev = __expf(L - lw[i]);
        const float a = av[i];
        const float at = -kk * e_prev;
        At[t * RC_LD + lane] = f2bf(at);
        const float bt = kk * a * e_neg;
        Bt[t * RC_LD + lane] = f2bf(bt);
        const float kp = zk[i] * (1.0f + (a - 1.0f) * kac);
        const float kt = kp * e_neg;
        Kt[t * RC_LD + lane] = f2bf(kt);
        atv[i] = at; btv[i] = bt; ktv[i] = kt;
        if (MODE == 2) {
            Rt[t * RC_LD + lane] = f2bf(zr[i] * __expf(L));
            const float bc = wave_sum(zr[i] * kp * rkc);
            if (lane == 0) sBC[t] = bc;
        }
    }
    uint4 w0;
    if (MODE == 1) {
        w0.x = pack2(atv[0], atv[1]); w0.y = pack2(atv[2], atv[3]); w0.z = pack2(atv[4], atv[5]); w0.w = pack2(atv[6], atv[7]);
        *reinterpret_cast<uint4*>(AtT + lane * RC_LD + q * 8) = w0;
        w0.x = pack2(btv[0], btv[1]); w0.y = pack2(btv[2], btv[3]); w0.z = pack2(btv[4], btv[5]); w0.w = pack2(btv[6], btv[7]);
        *reinterpret_cast<uint4*>(BtT + lane * RC_LD + q * 8) = w0;
        w0.x = pack2(ktv[0], ktv[1]); w0.y = pack2(ktv[2], ktv[3]); w0.z = pack2(ktv[4], ktv[5]); w0.w = pack2(ktv[6], ktv[7]);
        *reinterpret_cast<uint4*>(KtT + lane * RC_LD + q * 8) = w0;
        if (q == 0) sWL[lane] = __expf(tot);
    }
    w0.x = pack2(zv[0], zv[1]); w0.y = pack2(zv[2], zv[3]); w0.z = pack2(zv[4], zv[5]); w0.w = pack2(zv[6], zv[7]);
    *reinterpret_cast<uint4*>(VT + lane * RC_LD + q * 8) = w0;
}

__device__ __forceinline__ void phase_rwkv_r1(const Params& p, unsigned char* smem) {
    const int tidx = otid(p.wave);
    const int tid = tidx, wv = tid >> 6, lane = tid & 63, fr = lane & 15, fq = lane >> 4, mt = wv >> 1, nt0 = (wv & 1) * 2;
    bf16_t* base = reinterpret_cast<bf16_t*>(smem);
    bf16_t* At = base; bf16_t* Bt = base + RC_BUF; bf16_t* Kt = base + 2 * RC_BUF; bf16_t* AtT = base + 3 * RC_BUF;
    bf16_t* BtT = base + 4 * RC_BUF; bf16_t* KtT = base + 5 * RC_BUF; bf16_t* VT = base + 6 * RC_BUF;
    bf16_t* Tm = base + 7 * RC_BUF; bf16_t* Aak = base + 8 * RC_BUF; bf16_t* PT = base + 9 * RC_BUF;
    bf16_t* AkVT = base + 10 * RC_BUF; bf16_t* QT = base + 11 * RC_BUF;
    float* sTot = reinterpret_cast<float*>(smem + 13 * RC_BYTES);
    float* sWL = sTot + 512;
    bf16_t* Tg = reinterpret_cast<bf16_t*>(p.ws + OFF_TB);
    bf16_t* Mg = reinterpret_cast<bf16_t*>(p.ws + OFF_MB);
    bf16_t* Ng = reinterpret_cast<bf16_t*>(p.ws + OFF_NTB);
    float* WLg = reinterpret_cast<float*>(p.ws + OFF_WLB);
    PrepIn cur, nxt;
    if (obid() < 4096) prep_load<1>(cur, p, obid(), tid);
    nxt = cur;
    for (int u = obid(); u < 4096; u += ogdim()) {
        const int h = (u >> 7) & 7;
        PrepC pc = prep_consts<1>(p, h, lane);
        asm volatile("" : "+v"(pc.mu_k), "+v"(pc.kkc), "+v"(pc.kac), "+v"(pc.mu_v));
        if (u + ogdim() < 4096) prep_load<1>(nxt, p, u + ogdim(), tid);
        bf16_t* R0 = base + 7 * RC_BUF; bf16_t* C0 = base + 8 * RC_BUF; bf16_t* R1 = base + 9 * RC_BUF; bf16_t* C1 = base + 10 * RC_BUF;
        bf16_t* Pm0 = base + 11 * RC_BUF; bf16_t* Pm1 = base + 12 * RC_BUF;
        rwkv_prep<1>(cur, pc, tid, At, Bt, Kt, nullptr, AtT, BtT, KtT, VT, sTot, nullptr, sWL);
        lds_barrier();
        f32x4 pacc[2];
        {
            f32x4 acc[2];
            zero_acc(acc);
            mm64(acc, At, Bt, mt, nt0, fr, fq);
            store_T<3>(C0, acc, mt, nt0, fr, fq);
            zero_acc(pacc);
            mm64(pacc, Bt, At, mt, nt0, fr, fq);
#pragma unroll
            for (int nn = 0; nn < 2; ++nn)
#pragma unroll
                for (int j = 0; j < 4; ++j) {
                    const int R = mt * 16 + fq * 4 + j, C = (nt0 + nn) * 16 + fr;
                    pacc[nn][j] = (R < C) ? pacc[nn][j] : 0.f;
                }
            store_T<0>(R0, pacc, mt, nt0, fr, fq);
#pragma unroll
            for (int nn = 0; nn < 2; ++nn)
#pragma unroll
                for (int j = 0; j < 4; ++j) {
                    const int R = mt * 16 + fq * 4 + j, C = (nt0 + nn) * 16 + fr;
                    if (R == C) pacc[nn][j] += 1.0f;
                }
            store_T<0>(Pm0, pacc, mt, nt0, fr, fq);
        }
        lds_barrier();
#pragma unroll 1
        for (int j = 1; j <= 5; ++j) {
            f32x4 acc[2];
            if (j < 5) {
                zero_acc(acc);
                mm64(acc, C0, R0, mt, nt0, fr, fq);
                store_T<0>(R1, acc, mt, nt0, fr, fq);
            }
            zero_acc(acc);
            mm64(acc, R0, C0, mt, nt0, fr, fq);
            store_T<0>(C1, acc, mt, nt0, fr, fq);
            lds_barrier();
            zero_acc(acc);
            mm64(acc, C1, Pm0, mt, nt0, fr, fq);
            pacc[0] += acc[0]; pacc[1] += acc[1];
            if (j < 5) store_T<0>(Pm1, pacc, mt, nt0, fr, fq);
            lds_barrier();
            bf16_t* t0 = R0; R0 = R1; R1 = t0;
            t0 = C0; C0 = C1; C1 = t0;
            t0 = Pm0; Pm0 = Pm1; Pm1 = t0;
        }
        store_T<0>(Tm, pacc, mt, nt0, fr, fq);
        {
            bf16_t* To = Tg + (size_t)u * 4096;
#pragma unroll
            for (int nn = 0; nn < 2; ++nn) {
                const int C = (nt0 + nn) * 16 + fr, Rb = mt * 16 + fq * 4;
                uint2 w; w.x = pack2(pacc[nn][0], pacc[nn][1]); w.y = pack2(pacc[nn][2], pacc[nn][3]);
                *reinterpret_cast<uint2*>(To + C * 64 + Rb) = w;
            }
            f32x4 acc[2];
            zero_acc(acc); mm64(acc, Kt, At, mt, nt0, fr, fq); store_T<1>(Aak, acc, mt, nt0, fr, fq);
        }
        lds_barrier();
        {
            f32x4 acc[2];
            zero_acc(acc); mm64(acc, Tm, AtT, mt, nt0, fr, fq); store_T<0>(PT, acc, mt, nt0, fr, fq);
            zero_acc(acc); mm64(acc, Aak, VT, mt, nt0, fr, fq); store_T<0>(AkVT, acc, mt, nt0, fr, fq);
        }
        lds_barrier();
        {
            f32x4 acc[2];
            zero_acc(acc); mm64(acc, Tm, AkVT, mt, nt0, fr, fq); store_T<0>(QT, acc, mt, nt0, fr, fq);
            zero_acc(acc); mm64(acc, PT, BtT, mt, nt0, fr, fq);
            bf16_t* Mo = Mg + (size_t)u * 4096;
#pragma unroll
            for (int nn = 0; nn < 2; ++nn) {
                const int C = (nt0 + nn) * 16 + fr, Rb = mt * 16 + fq * 4;
                const float wl = sWL[C];
                uint2 w; w.x = pack2(acc[nn][0] * wl, acc[nn][1] * wl); w.y = pack2(acc[nn][2] * wl, acc[nn][3] * wl);
                const int pos = (Rb & ~12) | ((Rb & 4) << 1) | ((Rb & 8) >> 1);
                const int posw = ((((pos >> 3) ^ (C & 7)) << 3) | (pos & 7));
                *reinterpret_cast<uint2*>(Mo + C * 64 + posw) = w;
            }
        }
        lds_barrier();
        {
            f32x4 acc[2];
            zero_acc(acc); mm64(acc, BtT, QT, mt, nt0, fr, fq); mm64(acc, KtT, VT, mt, nt0, fr, fq);
            bf16_t* No = Ng + (size_t)u * 4096;
            float wl[4];
#pragma unroll
            for (int j = 0; j < 4; ++j) wl[j] = sWL[mt * 16 + fq * 4 + j];
#pragma unroll
            for (int nn = 0; nn < 2; ++nn) {
                const int C = (nt0 + nn) * 16 + fr, Rb = mt * 16 + fq * 4;
                uint2 w; w.x = pack2(acc[nn][0] * wl[0], acc[nn][1] * wl[1]); w.y = pack2(acc[nn][2] * wl[2], acc[nn][3] * wl[3]);
                const int posw = ((((Rb >> 3) ^ (C & 7)) << 3) | (Rb & 7));
                *reinterpret_cast<uint2*>(No + C * 64 + posw) = w;
            }
            if (tid < 64) WLg[(size_t)u * 64 + tid] = sWL[tid];
        }
        cur = nxt;
        lds_barrier();
    }
}

typedef float f32x16 __attribute__((ext_vector_type(16)));
#define R2_SLOT 12800
__device__ __forceinline__ void r2_issue(const unsigned char* Mg, const unsigned char* Ng, const unsigned char* WLg, size_t u, int J, int lane,
                                         unsigned char* slot) {
#pragma unroll
    for (int i = 0; i < 8; ++i)
        __builtin_amdgcn_global_load_lds((const unsigned*)(Mg + u * 8192 + i * 1024 + lane * 16),
                                         (__attribute__((address_space(3))) unsigned*)(slot + i * 1024), 16, 0, 0);
#pragma unroll
    for (int i = 0; i < 4; ++i)
        __builtin_amdgcn_global_load_lds((const unsigned*)(Ng + u * 8192 + J * 4096 + i * 1024 + lane * 16),
                                         (__attribute__((address_space(3))) unsigned*)(slot + 8192 + i * 1024), 16, 0, 0);
    __builtin_amdgcn_global_load_lds((const unsigned*)(WLg + u * 256 + lane * 4),
                                     (__attribute__((address_space(3))) unsigned*)(slot + 12288), 4, 0, 0);
}
template <int WAITN>
__device__ __forceinline__ void r2_chunk(f32x16 (&S)[2], const unsigned char* slot, bf16_t* so, int r, int h) {
    unsigned pk[2][8];
#pragma unroll
    for (int K = 0; K < 2; ++K)
#pragma unroll
        for (int q = 0; q < 8; ++q) pk[K][q] = pack2(S[K][2 * q], S[K][2 * q + 1]);
#pragma unroll
    for (int I = 0; I < 2; ++I) {
        uint4 w0, w1;
        w0.x = pk[I][0]; w0.y = pk[I][1]; w0.z = pk[I][2]; w0.w = pk[I][3];
        w1.x = pk[I][4]; w1.y = pk[I][5]; w1.z = pk[I][6]; w1.w = pk[I][7];
        *reinterpret_cast<uint4*>(so + r * 64 + I * 32 + h * 16) = w0;
        *reinterpret_cast<uint4*>(so + r * 64 + I * 32 + h * 16 + 8) = w1;
    }
    if (WAITN == 51) asm volatile("s_waitcnt vmcnt(51)" ::: "memory");
    else if (WAITN == 39) asm volatile("s_waitcnt vmcnt(39)" ::: "memory");
    else asm volatile("s_waitcnt vmcnt(0)" ::: "memory");
    bf16x8 bfrag[2][2];
#pragma unroll
    for (int K = 0; K < 2; ++K)
#pragma unroll
        for (int s = 0; s < 2; ++s) {
            union { bf16x8 v; unsigned u[4]; } cvt;
#pragma unroll
            for (int q = 0; q < 4; ++q) cvt.u[q] = pk[K][4 * s + q];
            bfrag[K][s] = cvt.v;
        }
#pragma unroll
    for (int I = 0; I < 2; ++I) {
        const int k = I * 32 + r;
        bf16x8 af[2][2];
#pragma unroll
        for (int K = 0; K < 2; ++K)
#pragma unroll
            for (int s = 0; s < 2; ++s)
                af[K][s] = *reinterpret_cast<const bf16x8*>(slot + k * 128 + (((K * 4 + s * 2 + h) ^ (r & 7)) * 16));
        f32x16 acc;
#pragma unroll
        for (int g = 0; g < 4; ++g) {
            const uint2 nv = *reinterpret_cast<const uint2*>(slot + 8192 + r * 128 + (((I * 4 + g) ^ (r & 7)) * 16) + h * 8);
            const float4 wl = *reinterpret_cast<const float4*>(slot + 12288 + (I * 32 + 8 * g + 4 * h) * 4);
            acc[4 * g + 0] = __uint_as_float(nv.x << 16) + wl.x * S[I][4 * g + 0];
            acc[4 * g + 1] = __uint_as_float(nv.x & 0xffff0000u) + wl.y * S[I][4 * g + 1];
            acc[4 * g + 2] = __uint_as_float(nv.y << 16) + wl.z * S[I][4 * g + 2];
            acc[4 * g + 3] = __uint_as_float(nv.y & 0xffff0000u) + wl.w * S[I][4 * g + 3];
        }
#pragma unroll
        for (int K = 0; K < 2; ++K)
#pragma unroll
            for (int s = 0; s < 2; ++s) acc = __builtin_amdgcn_mfma_f32_32x32x16_bf16(af[K][s], bfrag[K][s], acc, 0, 0, 0);
        S[I] = acc;
    }
}
__device__ __forceinline__ void phase_rwkv_r2(const Params& p, unsigned char* smem) {
    const int tidx = otid(p.wave);
    if (obid() >= 64) { phase_pre(p, smem, 1, obid() - 64, ogdim() - 64); return; }
    if (p.wave != 0) return;
    const int task = obid(), bh = task >> 1, J = task & 1;
    const int lane = tidx & 63, r = lane & 31, h = lane >> 5;
    const unsigned char* Mg = p.ws + OFF_MB;
    const unsigned char* Ng = p.ws + OFF_NTB;
    const unsigned char* WLg = p.ws + OFF_WLB;
    f32x16 S[2];
#pragma unroll
    for (int i = 0; i < 16; ++i) { S[0][i] = 0.f; S[1][i] = 0.f; }
    const size_t ub = (size_t)bh * 128;
    r2_issue(Mg, Ng, WLg, ub + 0, J, lane, smem + 0 * R2_SLOT);
    r2_issue(Mg, Ng, WLg, ub + 1, J, lane, smem + 1 * R2_SLOT);
    r2_issue(Mg, Ng, WLg, ub + 2, J, lane, smem + 2 * R2_SLOT);
#define R2_STEP(n_, SL, W) do { \
        const int n2 = (n_); \
        if (n2 + 3 < 128) r2_issue(Mg, Ng, WLg, ub + n2 + 3, J, lane, smem + (((SL) + 3) & 3) * R2_SLOT); \
        r2_chunk<W>(S, smem + (SL) * R2_SLOT, s0_ptr(p.ws, (int)ub + n2) + (size_t)J * 32 * 64, r, h); \
        asm volatile("s_waitcnt lgkmcnt(0)" ::: "memory"); } while (0)
    R2_STEP(0, 0, 39); R2_STEP(1, 1, 39); R2_STEP(2, 2, 51); R2_STEP(3, 3, 51);
#pragma unroll 1
    for (int n = 4; n < 124; n += 4) {
        R2_STEP(n, 0, 51); R2_STEP(n + 1, 1, 51); R2_STEP(n + 2, 2, 51); R2_STEP(n + 3, 3, 51);
    }
    R2_STEP(124, 0, 51); R2_STEP(125, 1, 0); R2_STEP(126, 2, 0); R2_STEP(127, 3, 0);
#undef R2_STEP
}

__device__ __forceinline__ void phase_rwkv_r3(const Params& p, unsigned char* smem) {
    const int tidx = otid(p.wave);
    const int tid = tidx, wv = tid >> 6, lane = tid & 63, fr = lane & 15, fq = lane >> 4, mt = wv >> 1, nt0 = (wv & 1) * 2;
    bf16_t* base = reinterpret_cast<bf16_t*>(smem);
    bf16_t* At = base; bf16_t* Aak = base + RC_BUF; bf16_t* Bt = base + 2 * RC_BUF; bf16_t* Kt = base + 3 * RC_BUF;
    bf16_t* Rt = base + 4 * RC_BUF; bf16_t* VT = base + 5 * RC_BUF;
    bf16_t* Sb = base + 6 * RC_BUF; bf16_t* Tm = base + 7 * RC_BUF; bf16_t* Arb = base + 8 * RC_BUF; bf16_t* Ark = base + 9 * RC_BUF;
    bf16_t* XT = Bt; bf16_t* UT = Kt;
    float* Yf = reinterpret_cast<float*>(smem);
    float* sTot = reinterpret_cast<float*>(smem + 13 * RC_BYTES);
    float* sBC = sTot + 512 + 64;
    const bf16_t* Tg = reinterpret_cast<const bf16_t*>(p.ws + OFF_TB);
    const bf16_t* GG = reinterpret_cast<const bf16_t*>(p.ws + OFF_GG);
    bf16_t* YC = reinterpret_cast<bf16_t*>(p.ws + OFF_YCAT);
    PrepIn cur, nxt;
    uint4 cT = make_uint4(0u, 0u, 0u, 0u), cS = cT, nT = cT, nS = cT;
    unsigned short cg[8], ng[8];
#pragma unroll
    for (int i = 0; i < 8; ++i) { cg[i] = 0; ng[i] = 0; }
    if (obid() < 4096) {
        const int u0 = obid();
        prep_load<2>(cur, p, u0, tid);
        cT = reinterpret_cast<const uint4*>(Tg + (size_t)u0 * 4096)[tid];
        cS = reinterpret_cast<const uint4*>(s0_ptr(p.ws, u0))[tid];
        const int b0 = u0 >> 10, h0 = (u0 >> 7) & 7, n0 = u0 & 127;
#pragma unroll
        for (int i = 0; i < 8; ++i) cg[i] = GG[((size_t)b0 * SEQ + n0 * 64 + wv * 8 + i) * 512 + h0 * 64 + lane];
    }
    nxt = cur;
    for (int u = obid(); u < 4096; u += ogdim()) {
        const int b = u >> 10, h = (u >> 7) & 7, n = u & 127;
        const int c = h * 64 + lane;
        PrepC pc = prep_consts<2>(p, h, lane);
        asm volatile("" : "+v"(pc.mu_k), "+v"(pc.kkc), "+v"(pc.kac), "+v"(pc.mu_v), "+v"(pc.mu_r), "+v"(pc.rkc), "+v"(pc.lng), "+v"(pc.lnb));
        if (u + ogdim() < 4096) {
            const int un = u + ogdim();
            prep_load<2>(nxt, p, un, tid);
            nT = reinterpret_cast<const uint4*>(Tg + (size_t)un * 4096)[tid];
            nS = reinterpret_cast<const uint4*>(s0_ptr(p.ws, un))[tid];
            const int b1 = un >> 10, h1 = (un >> 7) & 7, n1 = un & 127;
#pragma unroll
            for (int i = 0; i < 8; ++i) ng[i] = GG[((size_t)b1 * SEQ + n1 * 64 + wv * 8 + i) * 512 + h1 * 64 + lane];
        }
        rwkv_prep<2>(cur, pc, tid, At, Bt, Kt, Rt, nullptr, nullptr, nullptr, VT, sTot, sBC, nullptr);
        {
            int row = tid >> 3, ch = tid & 7;
            *reinterpret_cast<uint4*>(Tm + row * RC_LD + ch * 8) = cT;
            {
                const int I = ch >> 2, hh = (ch >> 1) & 1, g0 = (ch & 1) * 2;
                const int k0 = I * 32 + 8 * g0 + 4 * hh;
                uint2 lo; lo.x = cS.x; lo.y = cS.y;
                uint2 hi; hi.x = cS.z; hi.y = cS.w;
                *reinterpret_cast<uint2*>(Sb + row * RC_LD + k0) = lo;
                *reinterpret_cast<uint2*>(Sb + row * RC_LD + k0 + 8) = hi;
            }
        }
        lds_barrier();
        {
            f32x4 acc[2];
            zero_acc(acc); mm64(acc, Kt, At, mt, nt0, fr, fq); store_T<1>(Aak, acc, mt, nt0, fr, fq);
            zero_acc(acc); mm64(acc, Bt, Rt, mt, nt0, fr, fq); store_T<2>(Arb, acc, mt, nt0, fr, fq);
            zero_acc(acc); mm64(acc, Kt, Rt, mt, nt0, fr, fq); store_T<2>(Ark, acc, mt, nt0, fr, fq);
        }
        lds_barrier();
        {
            f32x4 acc[2];
            zero_acc(acc); mm64(acc, At, Sb, mt, nt0, fr, fq); mm64(acc, Aak, VT, mt, nt0, fr, fq);
            store_T<0>(XT, acc, mt, nt0, fr, fq);
        }
        lds_barrier();
        {
            f32x4 acc[2];
            zero_acc(acc); mm64(acc, Tm, XT, mt, nt0, fr, fq);
            store_T<0>(UT, acc, mt, nt0, fr, fq);
        }
        lds_barrier();
        {
            f32x4 acc[2];
            zero_acc(acc);
            mm64(acc, Rt, Sb, mt, nt0, fr, fq); mm64(acc, Arb, UT, mt, nt0, fr, fq); mm64(acc, Ark, VT, mt, nt0, fr, fq);
#pragma unroll
            for (int nn = 0; nn < 2; ++nn)
#pragma unroll
                for (int j = 0; j < 4; ++j) Yf[(mt * 16 + fq * 4 + j) * 68 + (nt0 + nn) * 16 + fr] = acc[nn][j];
        }
        lds_barrier();
        {
            const float lng = pc.lng, lnb = pc.lnb;
#pragma unroll
            for (int i = 0; i < 8; ++i) {
                const int t = wv * 8 + i;
                const size_t tok = (size_t)b * SEQ + n * 64 + t;
                const float y = Yf[t * 68 + lane];
                const float mean = wave_sum(y) * (1.0f / 64.0f);
                const float d = y - mean;
                const float var = wave_sum(d * d) * (1.0f / 64.0f);
                const float yn = d * rsqrtf(var + 64e-5f) * lng + lnb;
                const float g = bf2f(cg[i]);
                const float vv = bf2f(VT[lane * RC_LD + t]);
                YC[tok * 1024 + c] = f2bf((yn + sBC[t] * vv) * g);
            }
        }
        cur = nxt; cT = nT; cS = nS;
#pragma unroll
        for (int i = 0; i < 8; ++i) cg[i] = ng[i];
        lds_barrier();
    }
}

#define LR_LD 1032
__device__ __forceinline__ void phase_ln_route(const Params& p, int layer, float* X, unsigned char* smem) {
    const int tidx = otid(p.wave);
    const int tid = tidx, wv = tid >> 6, lane = tid & 63, fr = lane & 15, fq = lane >> 4;
    const float* g = p.in[24] + layer * DM;
    const float* bb = p.in[25] + layer * DM;
    const float* rgb = p.in[27] + layer * 4;
    const float* reb = p.in[29] + layer * 32;
    const bf16_t* RH = reinterpret_cast<const bf16_t*>(p.ws + OFF_W) + WE_RT_HI + (size_t)layer * 48 * 1024;
    const bf16_t* RL = reinterpret_cast<const bf16_t*>(p.ws + OFF_W) + WE_RT_LO + (size_t)layer * 48 * 1024;
    bf16_t* XB = reinterpret_cast<bf16_t*>(p.ws + OFF_ACTB);
    int* cnt = reinterpret_cast<int*>(p.ws + OFF_CTRL) + layer * 32;
    int* ltok = reinterpret_cast<int*>(p.ws + OFF_LTOK);
    float* lgate = reinterpret_cast<float*>(p.ws + OFF_LGATE);
    bf16_t* sXH = reinterpret_cast<bf16_t*>(smem);
    bf16_t* sXL = sXH + 16 * LR_LD;
    float* sRed = reinterpret_cast<float*>(smem + 2 * 16 * LR_LD * 2);
    float* sLog = sRed + 8 * 16 * 48;
    bf16x8 bh[4][3], bl[4][3];
#pragma unroll
    for (int ks = 0; ks < 4; ++ks)
#pragma unroll
        for (int nt = 0; nt < 3; ++nt) {
            const int k0 = wv * 128 + ks * 32 + fq * 8;
            bh[ks][nt] = *reinterpret_cast<const bf16x8*>(RH + (size_t)(nt * 16 + fr) * 1024 + k0);
            bl[ks][nt] = *reinterpret_cast<const bf16x8*>(RL + (size_t)(nt * 16 + fr) * 1024 + k0);
        }
    float4 gg[4], bv[4];
#pragma unroll
    for (int i = 0; i < 4; ++i) {
        gg[i] = *reinterpret_cast<const float4*>(g + i * 256 + lane * 4);
        bv[i] = *reinterpret_cast<const float4*>(bb + i * 256 + lane * 4);
    }
    int* sCnt = reinterpret_cast<int*>(sLog + 16 * 48);
    int* sBase = sCnt + 32;
    int* sDecE = sBase + 32;
    int* sDecP = sDecE + 256;
    float* sDecG = reinterpret_cast<float*>(sDecP + 256);
    int* sDecR = reinterpret_cast<int*>(sDecG + 256);
    if (tid < 32) sCnt[tid] = 0;
    float4 pre[2][4];
    {
        const int tile0 = obid();
        if (tile0 < NT / 16) {
#pragma unroll
            for (int rr = 0; rr < 2; ++rr)
#pragma unroll
                for (int i = 0; i < 4; ++i)
                    pre[rr][i] = *reinterpret_cast<const float4*>(X + (size_t)(tile0 * 16 + wv * 2 + rr) * DM + i * 256 + lane * 4);
        }
    }
    __syncthreads();
    int nloc = 0;
    for (int tile = obid(); tile < NT / 16; tile += ogdim(), ++nloc) {
        float4 cur[2][4];
#pragma unroll
        for (int rr = 0; rr < 2; ++rr)
#pragma unroll
            for (int i = 0; i < 4; ++i) cur[rr][i] = pre[rr][i];
        {
            const int tn = tile + ogdim();
            if (tn < NT / 16) {
#pragma unroll
                for (int rr = 0; rr < 2; ++rr)
#pragma unroll
                    for (int i = 0; i < 4; ++i)
                        pre[rr][i] = *reinterpret_cast<const float4*>(X + (size_t)(tn * 16 + wv * 2 + rr) * DM + i * 256 + lane * 4);
            }
        }
#pragma unroll
        for (int rr = 0; rr < 2; ++rr) {
            const int rl = wv * 2 + rr;
            const int row = tile * 16 + rl;
            float v[16];
#pragma unroll
            for (int i = 0; i < 4; ++i) {
                const float4 t = cur[rr][i];
                v[4 * i] = t.x; v[4 * i + 1] = t.y; v[4 * i + 2] = t.z; v[4 * i + 3] = t.w;
            }
            float sum = 0.f;
#pragma unroll
            for (int i = 0; i < 16; ++i) sum += v[i];
            const float mean = wave_sum(sum) * (1.0f / DM);
            float sq = 0.f;
#pragma unroll
            for (int i = 0; i < 16; ++i) { float d = v[i] - mean; sq += d * d; }
            const float rstd = rsqrtf(wave_sum(sq) * (1.0f / DM) + 1e-5f);
#pragma unroll
            for (int i = 0; i < 4; ++i) {
                const int col = i * 256 + lane * 4;
                const float o0 = (v[4 * i] - mean) * rstd * gg[i].x + bv[i].x;
                const float o1 = (v[4 * i + 1] - mean) * rstd * gg[i].y + bv[i].y;
                const float o2 = (v[4 * i + 2] - mean) * rstd * gg[i].z + bv[i].z;
                const float o3 = (v[4 * i + 3] - mean) * rstd * gg[i].w + bv[i].w;
                const bf16_t h0 = f2bf(o0), h1 = f2bf(o1), h2 = f2bf(o2), h3 = f2bf(o3);
                uint2 wh; wh.x = (unsigned)h0 | ((unsigned)h1 << 16); wh.y = (unsigned)h2 | ((unsigned)h3 << 16);
                *reinterpret_cast<uint2*>(XB + (size_t)row * DM + col) = wh;
                *reinterpret_cast<uint2*>(sXH + rl * LR_LD + col) = wh;
                uint2 wl; wl.x = pack2(o0 - bf2f(h0), o1 - bf2f(h1)); wl.y = pack2(o2 - bf2f(h2), o3 - bf2f(h3));
                *reinterpret_cast<uint2*>(sXL + rl * LR_LD + col) = wl;
            }
        }
        lds_barrier();
        {
            f32x4 acc[3];
#pragma unroll
            for (int nt = 0; nt < 3; ++nt) acc[nt] = (f32x4){0.f, 0.f, 0.f, 0.f};
#pragma unroll
            for (int ks = 0; ks < 4; ++ks) {
                const int k0 = wv * 128 + ks * 32 + fq * 8;
                const bf16x8 ah = *reinterpret_cast<const bf16x8*>(sXH + fr * LR_LD + k0);
                const bf16x8 al = *reinterpret_cast<const bf16x8*>(sXL + fr * LR_LD + k0);
#pragma unroll
                for (int nt = 0; nt < 3; ++nt) {
                    acc[nt] = __builtin_amdgcn_mfma_f32_16x16x32_bf16(ah, bh[ks][nt], acc[nt], 0, 0, 0);
                    acc[nt] = __builtin_amdgcn_mfma_f32_16x16x32_bf16(al, bh[ks][nt], acc[nt], 0, 0, 0);
                    acc[nt] = __builtin_amdgcn_mfma_f32_16x16x32_bf16(ah, bl[ks][nt], acc[nt], 0, 0, 0);
                }
            }
#pragma unroll
            for (int nt = 0; nt < 3; ++nt)
#pragma unroll
                for (int j = 0; j < 4; ++j) sRed[(wv * 16 + fq * 4 + j) * 48 + nt * 16 + fr] = acc[nt][j];
        }
        lds_barrier();
        for (int idx = tid; idx < 16 * 48; idx += NTHREADS) {
            float s = 0.f;
#pragma unroll
            for (int w = 0; w < 8; ++w) s += sRed[w * 16 * 48 + idx];
            sLog[idx] = s;
        }
        lds_barrier();
        if (tid < 16) {
            const int row = tile * 16 + tid;
            const float* lg = sLog + tid * 48;
            float gl[4];
#pragma unroll
            for (int j = 0; j < 4; ++j) gl[j] = lg[j] + rgb[j];
            int gi = 0; float gm = gl[0];
#pragma unroll
            for (int j = 1; j < 4; ++j) if (gl[j] > gm) { gm = gl[j]; gi = j; }
            float gs = 0.f;
#pragma unroll
            for (int j = 0; j < 4; ++j) gs += __expf(gl[j] - gm);
            const float gw = 1.0f / gs;
            float el[8];
#pragma unroll
            for (int j = 0; j < 8; ++j) el[j] = lg[4 + gi * 8 + j] + reb[gi * 8 + j];
            int i1 = 0; float m1 = el[0];
#pragma unroll
            for (int j = 1; j < 8; ++j) if (el[j] > m1) { m1 = el[j]; i1 = j; }
            int i2 = (i1 == 0) ? 1 : 0; float m2 = el[i2];
#pragma unroll
            for (int j = 0; j < 8; ++j) if (j != i1 && el[j] > m2) { m2 = el[j]; i2 = j; }
            const float e2 = __expf(m2 - m1);
            const float p1 = 1.0f / (1.0f + e2), p2 = e2 / (1.0f + e2);
            const int ex1 = gi * 8 + i1, ex2 = gi * 8 + i2;
            const int d0 = (nloc * 16 + tid) * 2;
            sDecE[d0] = ex1; sDecP[d0] = atomicAdd(&sCnt[ex1], 1); sDecG[d0] = gw * p1; sDecR[d0] = row * 2;
            sDecE[d0 + 1] = ex2; sDecP[d0 + 1] = atomicAdd(&sCnt[ex2], 1); sDecG[d0 + 1] = gw * p2; sDecR[d0 + 1] = row * 2 + 1;
        }
    }
    __syncthreads();
    if (tid < 32) sBase[tid] = atomicAdd(&cnt[tid], sCnt[tid]);
    __syncthreads();
    if (tid < nloc * 32) {
        const int ex = sDecE[tid];
        const size_t pos = (size_t)ex * NT + sBase[ex] + sDecP[tid];
        ltok[pos] = sDecR[tid];
        lgate[pos] = sDecG[tid];
    }
    __syncthreads();
}

__device__ __forceinline__ void phase_exp1(const Params& p, int layer, bf16_t* smem) {
    const int* cnt = reinterpret_cast<const int*>(p.ws + OFF_CTRL) + layer * 32;
    const int* ltok = reinterpret_cast<const int*>(p.ws + OFF_LTOK);
    const bf16_t* XB = reinterpret_cast<const bf16_t*>(p.ws + OFF_ACTB);
    const bf16_t* W13 = reinterpret_cast<const bf16_t*>(p.ws + OFF_W) + WE_W13 + (size_t)layer * 32 * 262144;
    bf16_t* H = reinterpret_cast<bf16_t*>(p.ws + OFF_HBUF);
    int t = obid();
    int base = 0, tbase = 0;
    for (int e = 0; e < 32; ++e) {
        int c = cnt[e];
        int nt = ((c + 255) >> 8) * 2;
        while (t < tbase + nt) {
            int w = t - tbase;
            EpiExp1 epi{H, base, c};
            gemm_tile<true>(XB, DM, ltok + (size_t)e * NT, c, W13 + (size_t)e * 262144, DM, DM, (w >> 1) * 256, (w & 1) * 128, epi, smem, p.wave);
            t += ogdim();
        }
        tbase += nt; base += c;
    }
}
__device__ __forceinline__ void phase_exp2(const Params& p, int layer, bf16_t* smem) {
    const int* cnt = reinterpret_cast<const int*>(p.ws + OFF_CTRL) + layer * 32;
    const int* ltok = reinterpret_cast<const int*>(p.ws + OFF_LTOK);
    const float* lgate = reinterpret_cast<const float*>(p.ws + OFF_LGATE);
    const bf16_t* W2 = reinterpret_cast<const bf16_t*>(p.ws + OFF_W) + WE_W2 + (size_t)layer * 32 * 131072;
    const bf16_t* H = reinterpret_cast<const bf16_t*>(p.ws + OFF_HBUF);
    bf16_t* FS = reinterpret_cast<bf16_t*>(p.ws + OFF_FS);
    int t = obid();
    int base = 0, tbase = 0;
    for (int e = 0; e < 32; ++e) {
        int c = cnt[e];
        int nt = ((c + 255) >> 8) * 8;
        while (t < tbase + nt) {
            int w = t - tbase;
            EpiExp2 epi{FS, ltok + (size_t)e * NT, lgate + (size_t)e * NT, c};
            gemm_tile<false>(H + (size_t)base * 128, 128, nullptr, 0, W2 + (size_t)e * 131072, 128, 128, (w >> 3) * 256, (w & 7) * 128, epi, smem, p.wave);
            t += ogdim();
        }
        tbase += nt; base += c;
    }
}

__device__ __forceinline__ void phase_ln_ffn(const Params& p, int layer, float* Xout, bool last) {
    const int tidx = otid(p.wave);
    const int tid = tidx, wv = tid >> 6, lane = tid & 63;
    const float* g = p.in[33] + layer * DM;
    const float* bb = p.in[34] + layer * DM;
    const bf16_t* FS = reinterpret_cast<const bf16_t*>(p.ws + OFF_FS);
    bf16_t* XB = reinterpret_cast<bf16_t*>(p.ws + OFF_ACTB);
    for (int row = obid() * NWAVES + wv; row < NT; row += ogdim() * NWAVES) {
        float v[16];
#pragma unroll
        for (int i = 0; i < 4; ++i) {
            int col = i * 256 + lane * 4;
            uint2 t = *reinterpret_cast<const uint2*>(XB + (size_t)row * DM + col);
            uint2 f0 = *reinterpret_cast<const uint2*>(FS + (size_t)row * DM + col);
            uint2 f1 = *reinterpret_cast<const uint2*>(FS + ((size_t)NT + row) * DM + col);
            v[4 * i] = ALPHA_F * __uint_as_float(t.x << 16) + __uint_as_float(f0.x << 16) + __uint_as_float(f1.x << 16);
            v[4 * i + 1] = ALPHA_F * __uint_as_float(t.x & 0xffff0000u) + __uint_as_float(f0.x & 0xffff0000u) + __uint_as_float(f1.x & 0xffff0000u);
            v[4 * i + 2] = ALPHA_F * __uint_as_float(t.y << 16) + __uint_as_float(f0.y << 16) + __uint_as_float(f1.y << 16);
            v[4 * i + 3] = ALPHA_F * __uint_as_float(t.y & 0xffff0000u) + __uint_as_float(f0.y & 0xffff0000u) + __uint_as_float(f1.y & 0xffff0000u);
        }
        float sum = 0.f;
#pragma unroll
        for (int i = 0; i < 16; ++i) sum += v[i];
        float mean = wave_sum(sum) * (1.0f / DM);
        float sq = 0.f;
#pragma unroll
        for (int i = 0; i < 16; ++i) { float d = v[i] - mean; sq += d * d; }
        float rstd = rsqrtf(wave_sum(sq) * (1.0f / DM) + 1e-5f);
#pragma unroll
        for (int i = 0; i < 4; ++i) {
            int col = i * 256 + lane * 4;
            float4 gg = *reinterpret_cast<const float4*>(g + col);
            float4 bv = *reinterpret_cast<const float4*>(bb + col);
            float o0 = (v[4 * i] - mean) * rstd * gg.x + bv.x;
            float o1 = (v[4 * i + 1] - mean) * rstd * gg.y + bv.y;
            float o2 = (v[4 * i + 2] - mean) * rstd * gg.z + bv.z;
            float o3 = (v[4 * i + 3] - mean) * rstd * gg.w + bv.w;
            if (last) {
                *reinterpret_cast<float4*>(Xout + (size_t)row * DM + col) = make_float4(o0, o1, o2, o3);
            } else {
                uint2 w; w.x = pack2(o0, o1); w.y = pack2(o2, o3);
                *reinterpret_cast<uint2*>(XB + (size_t)row * DM + col) = w;
            }
        }
    }
}

#define CV_T 64
#define CV_ROWS (CV_T + 30)
template <int OB>
__device__ __forceinline__ void conv_blk(float (&acc)[CV_T], const bf16_t* sU, int tid, const float (&w0)[31]) {
#pragma unroll
    for (int rr = 0; rr < 38; ++rr) {
        const float uv = bf2f(sU[(OB * 8 + rr) * 512 + tid]);
#pragma unroll
        for (int oo = 0; oo < 8; ++oo) {
            const int j = rr - oo;
            if (j >= 0 && j <= 30) acc[OB * 8 + oo] += uv * w0[j];
        }
    }
}
__device__ __forceinline__ void phase_l1_conv(const Params& p, unsigned char* smem) {
    const int tidx = otid(p.wave);
    const bf16_t* P = reinterpret_cast<const bf16_t*>(p.ws + OFF_P);
    bf16_t* YC = reinterpret_cast<bf16_t*>(p.ws + OFF_YCAT);
    bf16_t* sU = reinterpret_cast<bf16_t*>(smem);
    float* red = reinterpret_cast<float*>(smem + CV_ROWS * 512 * 2);
    float* stat = red + 8 * 64 * 2;
    const int tid = tidx, wv = tid >> 6, lane = tid & 63;
    const float* cw = p.in[17];
    float w0[31];
#pragma unroll
    for (int j = 0; j < 31; ++j) w0[j] = cw[j * 512 + tid];
    const float cb0 = p.in[18][tid], g0 = p.in[19][tid], b0 = p.in[20][tid];
    for (int u = obid(); u < NT / CV_T; u += ogdim()) {
        const int t0 = u * CV_T;
        const int s0 = t0 & (SEQ - 1);
        for (int it = tid; it < CV_ROWS * 64; it += NTHREADS) {
            const int r = it >> 6, c8 = (it & 63) * 8;
            uint4 w = make_uint4(0u, 0u, 0u, 0u);
            if (s0 - 30 + r >= 0) {
                const bf16_t* pr = P + (size_t)(t0 - 30 + r) * 3072 + c8;
                float a[8], gte[8];
                unpack8(*reinterpret_cast<const uint4*>(pr), a);
                unpack8(*reinterpret_cast<const uint4*>(pr + 512), gte);
#pragma unroll
                for (int i = 0; i < 8; ++i) a[i] = a[i] * sigmoidf_(gte[i]);
                w.x = pack2(a[0], a[1]); w.y = pack2(a[2], a[3]); w.z = pack2(a[4], a[5]); w.w = pack2(a[6], a[7]);
            }
            *reinterpret_cast<uint4*>(sU + r * 512 + c8) = w;
        }
        __syncthreads();
        float acc[CV_T];
#pragma unroll
        for (int o = 0; o < CV_T; ++o) acc[o] = cb0;
        conv_blk<0>(acc, sU, tid, w0); conv_blk<1>(acc, sU, tid, w0); conv_blk<2>(acc, sU, tid, w0); conv_blk<3>(acc, sU, tid, w0);
        conv_blk<4>(acc, sU, tid, w0); conv_blk<5>(acc, sU, tid, w0); conv_blk<6>(acc, sU, tid, w0); conv_blk<7>(acc, sU, tid, w0);
#pragma unroll
        for (int o = 0; o < CV_T; ++o) {
            const float s1 = wave_sum(acc[o]);
            const float s2 = wave_sum(acc[o] * acc[o]);
            if (lane == 0) { red[(wv * 64 + o) * 2] = s1; red[(wv * 64 + o) * 2 + 1] = s2; }
        }
        __syncthreads();
        if (tid < 64) {
            float s1 = 0.f, s2 = 0.f;
#pragma unroll
            for (int w = 0; w < 8; ++w) { s1 += red[(w * 64 + tid) * 2]; s2 += red[(w * 64 + tid) * 2 + 1]; }
            const float mean = s1 * (1.0f / 512.0f);
            const float var = fmaxf(s2 * (1.0f / 512.0f) - mean * mean, 0.f);
            stat[tid * 2] = mean; stat[tid * 2 + 1] = rsqrtf(var + 1e-5f);
        }
        __syncthreads();
#pragma unroll
        for (int o = 0; o < CV_T; ++o) {
            const float mean = stat[o * 2], rstd = stat[o * 2 + 1];
            const float y0 = (acc[o] - mean) * rstd * g0 + b0;
            YC[(size_t)(t0 + o) * 1024 + tid] = f2bf(siluf_(y0));
        }
    }
}

__device__ __forceinline__ float ret_lg(int h) { return log1pf(-exp2f(-5.0f - (float)h)); }

#define KT_LD 136
struct RetIn { uint4 k1, k2, v1, v2; };
__device__ __forceinline__ void ret_load_kv(RetIn& in, const bf16_t* P, int u, int tid) {
    const int n = u & 63, h = (u >> 6) & 7, b = u >> 9;
    const int c = tid >> 2, i0 = (tid & 3) * 8;
    const size_t tok = (size_t)b * SEQ + n * 128 + c;
    const bf16_t* kr = P + tok * 3072 + 1536 + h * 64;
    const bf16_t* vr = P + tok * 3072 + 2048 + h * 64;
    in.k1 = *reinterpret_cast<const uint4*>(kr + i0); in.k2 = *reinterpret_cast<const uint4*>(kr + 32 + i0);
    in.v1 = *reinterpret_cast<const uint4*>(vr + i0); in.v2 = *reinterpret_cast<const uint4*>(vr + 32 + i0);
}
__device__ __forceinline__ void st_col8(bf16_t* dst, int ld, const uint4 v) {
    dst[0 * ld] = (bf16_t)(v.x & 0xffffu); dst[1 * ld] = (bf16_t)(v.x >> 16);
    dst[2 * ld] = (bf16_t)(v.y & 0xffffu); dst[3 * ld] = (bf16_t)(v.y >> 16);
    dst[4 * ld] = (bf16_t)(v.z & 0xffffu); dst[5 * ld] = (bf16_t)(v.z >> 16);
    dst[6 * ld] = (bf16_t)(v.w & 0xffffu); dst[7 * ld] = (bf16_t)(v.w >> 16);
}
__device__ __forceinline__ void phase_ret_kv(const Params& p, unsigned char* smem) {
    const int tidx = otid(p.wave);
    const bf16_t* P = reinterpret_cast<const bf16_t*>(p.ws + OFF_P);
    const float2* rope = reinterpret_cast<const float2*>(p.ws + OFF_ROPE);
    float* KVT = reinterpret_cast<float*>(p.ws + OFF_KVT);
    bf16_t* sKT = reinterpret_cast<bf16_t*>(smem);
    bf16_t* sVT = sKT + 64 * KT_LD;
    const int tid = tidx, wv = tid >> 6, lane = tid & 63, fr = lane & 15, fq = lane >> 4;
    const int et = wv >> 1, dt0 = (wv & 1) * 2;
    RetIn cur, nxt;
    if (obid() < 2048) ret_load_kv(cur, P, obid(), tid);
    nxt = cur;
    for (int u = obid(); u < 2048; u += ogdim()) {
        const int n = u & 63, h = (u >> 6) & 7;
        const float lg = ret_lg(h);
        const int c = tid >> 2, i0 = (tid & 3) * 8;
        const int sidx = n * 128 + c;
        float2 cs[8];
#pragma unroll
        for (int i = 0; i < 8; ++i) cs[i] = rope[sidx * 32 + i0 + i];
        asm volatile("" : "+v"(cs[0].x), "+v"(cs[7].y));
        if (u + ogdim() < 2048) ret_load_kv(nxt, P, u + ogdim(), tid);
        {
            const float zeta = __expf((float)(127 - c) * lg) * 0.125f;
            float k1[8], k2[8];
            unpack8(cur.k1, k1); unpack8(cur.k2, k2);
#pragma unroll
            for (int i = 0; i < 8; ++i) {
                float o1 = (k1[i] * cs[i].x - k2[i] * cs[i].y) * zeta, o2 = (k1[i] * cs[i].y + k2[i] * cs[i].x) * zeta;
                sKT[(i0 + i) * KT_LD + c] = f2bf(o1);
                sKT[(32 + i0 + i) * KT_LD + c] = f2bf(o2);
            }
            st_col8(sVT + i0 * KT_LD + c, KT_LD, cur.v1);
            st_col8(sVT + (32 + i0) * KT_LD + c, KT_LD, cur.v2);
        }
        lds_barrier();
        f32x4 acc[2];
        acc[0] = (f32x4){0.f, 0.f, 0.f, 0.f}; acc[1] = (f32x4){0.f, 0.f, 0.f, 0.f};
#pragma unroll
        for (int ks = 0; ks < 4; ++ks) {
            bf16x8 af = *reinterpret_cast<const bf16x8*>(sVT + (et * 16 + fr) * KT_LD + ks * 32 + fq * 8);
#pragma unroll
            for (int nn = 0; nn < 2; ++nn) {
                bf16x8 bfr = *reinterpret_cast<const bf16x8*>(sKT + ((dt0 + nn) * 16 + fr) * KT_LD + ks * 32 + fq * 8);
                acc[nn] = __builtin_amdgcn_mfma_f32_16x16x32_bf16(af, bfr, acc[nn], 0, 0, 0);
            }
        }
        float* o = KVT + (size_t)u * 4096;
#pragma unroll
        for (int nn = 0; nn < 2; ++nn)
#pragma unroll
            for (int j = 0; j < 4; ++j) o[(et * 16 + fq * 4 + j) * 64 + (dt0 + nn) * 16 + fr] = acc[nn][j];
        cur = nxt;
        lds_barrier();
    }
}
__device__ __forceinline__ void phase_ret_scan(const Params& p) {
    const int tidx = otid(p.wave);
    float* KVT = reinterpret_cast<float*>(p.ws + OFF_KVT);
    for (int i = obid() * NTHREADS + tidx; i < 32 * 4096; i += ogdim() * NTHREADS) {
        int bh = i >> 12, ed = i & 4095, h = bh & 7;
        float gc = __expf(128.0f * ret_lg(h));
        float R = 0.f;
        float* q = KVT + (size_t)bh * 64 * 4096 + ed;
#pragma unroll 1
        for (int n0 = 0; n0 < 64; n0 += 16) {
            float kv[16];
#pragma unroll
            for (int j = 0; j < 16; ++j) kv[j] = q[(size_t)(n0 + j) * 4096];
#pragma unroll
            for (int j = 0; j < 16; ++j) { q[(size_t)(n0 + j) * 4096] = R; R = gc * R + kv[j]; }
        }
    }
}
#define Q_LD 72
struct RetOutIn { uint4 q1, q2, k1, k2, v1, v2; float4 r0, r1; unsigned short gr[16]; };
__device__ __forceinline__ void ret_load_out(RetOutIn& in, const bf16_t* P, const float* KVT, int u, int tid) {
    const int n = u & 63, h = (u >> 6) & 7, b = u >> 9;
    const int c = tid >> 2, i0 = (tid & 3) * 8;
    const size_t tok = (size_t)b * SEQ + n * 128 + c;
    const bf16_t* qr = P + tok * 3072 + 1024 + h * 64;
    in.q1 = *reinterpret_cast<const uint4*>(qr + i0); in.q2 = *reinterpret_cast<const uint4*>(qr + 32 + i0);
    in.k1 = *reinterpret_cast<const uint4*>(qr + 512 + i0); in.k2 = *reinterpret_cast<const uint4*>(qr + 512 + 32 + i0);
    in.v1 = *reinterpret_cast<const uint4*>(qr + 1024 + i0); in.v2 = *reinterpret_cast<const uint4*>(qr + 1024 + 32 + i0);
    const float* rp = KVT + (size_t)u * 4096 + tid * 8;
    in.r0 = *reinterpret_cast<const float4*>(rp); in.r1 = *reinterpret_cast<const float4*>(rp + 4);
    const int wv = tid >> 6, lane = tid & 63, fr = lane & 15, fq = lane >> 4;
#pragma unroll
    for (int j = 0; j < 4; ++j)
#pragma unroll
        for (int nn = 0; nn < 4; ++nn)
            in.gr[j * 4 + nn] = P[((size_t)b * SEQ + n * 128 + wv * 16 + fq * 4 + j) * 3072 + 2560 + h * 64 + nn * 16 + fr];
}
__device__ __forceinline__ void phase_ret_out(const Params& p, unsigned char* smem) {
    const int tidx = otid(p.wave);
    const bf16_t* P = reinterpret_cast<const bf16_t*>(p.ws + OFF_P);
    const float2* rope = reinterpret_cast<const float2*>(p.ws + OFF_ROPE);
    const float* KVT = reinterpret_cast<const float*>(p.ws + OFF_KVT);
    bf16_t* YC = reinterpret_cast<bf16_t*>(p.ws + OFF_YCAT);
    bf16_t* sQ = reinterpret_cast<bf16_t*>(smem);
    bf16_t* sK = sQ + 128 * Q_LD;
    bf16_t* sVT = sK + 128 * Q_LD;
    bf16_t* sRT = sVT + 64 * KT_LD;
    bf16_t* sS = sQ;
    const int tid = tidx, wv = tid >> 6, lane = tid & 63, fr = lane & 15, fq = lane >> 4;
    RetOutIn cur, nxt;
    if (obid() < 2048) ret_load_out(cur, P, KVT, obid(), tid);
    nxt = cur;
    for (int u = obid(); u < 2048; u += ogdim()) {
        const int n = u & 63, h = (u >> 6) & 7, b = u >> 9;
        const float lg = ret_lg(h);
        const int c = tid >> 2, i0 = (tid & 3) * 8;
        const int sidx = n * 128 + c;
        float2 cs[8];
#pragma unroll
        for (int i = 0; i < 8; ++i) cs[i] = rope[sidx * 32 + i0 + i];
        float gng[4], gnb[4];
#pragma unroll
        for (int nn = 0; nn < 4; ++nn) { gng[nn] = p.in[21][h * 64 + nn * 16 + fr]; gnb[nn] = p.in[22][h * 64 + nn * 16 + fr]; }
        asm volatile("" : "+v"(cs[0].x), "+v"(cs[7].y), "+v"(gng[0]), "+v"(gnb[3]));
        if (u + ogdim() < 2048) ret_load_out(nxt, P, KVT, u + ogdim(), tid);
        {
            float qa[8], qb[8], ka[8], kb[8];
            float q1[8], q2[8], k1[8], k2[8];
            unpack8(cur.q1, q1); unpack8(cur.q2, q2); unpack8(cur.k1, k1); unpack8(cur.k2, k2);
#pragma unroll
            for (int i = 0; i < 8; ++i) {
                qa[i] = q1[i] * cs[i].x - q2[i] * cs[i].y; qb[i] = q1[i] * cs[i].y + q2[i] * cs[i].x;
                ka[i] = (k1[i] * cs[i].x - k2[i] * cs[i].y) * 0.125f; kb[i] = (k1[i] * cs[i].y + k2[i] * cs[i].x) * 0.125f;
            }
            st_col8(sVT + i0 * KT_LD + c, KT_LD, cur.v1);
            st_col8(sVT + (32 + i0) * KT_LD + c, KT_LD, cur.v2);
            uint4 w;
            w.x = pack2(qa[0], qa[1]); w.y = pack2(qa[2], qa[3]); w.z = pack2(qa[4], qa[5]); w.w = pack2(qa[6], qa[7]);
            *reinterpret_cast<uint4*>(sQ + c * Q_LD + i0) = w;
            w.x = pack2(qb[0], qb[1]); w.y = pack2(qb[2], qb[3]); w.z = pack2(qb[4], qb[5]); w.w = pack2(qb[6], qb[7]);
            *reinterpret_cast<uint4*>(sQ + c * Q_LD + 32 + i0) = w;
            w.x = pack2(ka[0], ka[1]); w.y = pack2(ka[2], ka[3]); w.z = pack2(ka[4], ka[5]); w.w = pack2(ka[6], ka[7]);
            *reinterpret_cast<uint4*>(sK + c * Q_LD + i0) = w;
            w.x = pack2(kb[0], kb[1]); w.y = pack2(kb[2], kb[3]); w.z = pack2(kb[4], kb[5]); w.w = pack2(kb[6], kb[7]);
            *reinterpret_cast<uint4*>(sK + c * Q_LD + 32 + i0) = w;
            w.x = pack2(cur.r0.x, cur.r0.y); w.y = pack2(cur.r0.z, cur.r0.w); w.z = pack2(cur.r1.x, cur.r1.y); w.w = pack2(cur.r1.z, cur.r1.w);
            *reinterpret_cast<uint4*>(sRT + (tid >> 3) * Q_LD + (tid & 7) * 8) = w;
        }
        lds_barrier();
        f32x4 accs[8], accc[4];
#pragma unroll
        for (int nn = 0; nn < 8; ++nn) accs[nn] = (f32x4){0.f, 0.f, 0.f, 0.f};
#pragma unroll
        for (int nn = 0; nn < 4; ++nn) accc[nn] = (f32x4){0.f, 0.f, 0.f, 0.f};
#pragma unroll
        for (int ks = 0; ks < 2; ++ks) {
            bf16x8 af = *reinterpret_cast<const bf16x8*>(sQ + (wv * 16 + fr) * Q_LD + ks * 32 + fq * 8);
#pragma unroll
            for (int nn = 0; nn < 8; ++nn) {
                bf16x8 bfr = *reinterpret_cast<const bf16x8*>(sK + (nn * 16 + fr) * Q_LD + ks * 32 + fq * 8);
                accs[nn] = __builtin_amdgcn_mfma_f32_16x16x32_bf16(af, bfr, accs[nn], 0, 0, 0);
            }
#pragma unroll
            for (int nn = 0; nn < 4; ++nn) {
                bf16x8 bfr = *reinterpret_cast<const bf16x8*>(sRT + (nn * 16 + fr) * Q_LD + ks * 32 + fq * 8);
                accc[nn] = __builtin_amdgcn_mfma_f32_16x16x32_bf16(af, bfr, accc[nn], 0, 0, 0);
            }
        }
        lds_barrier();
        bf16_t* mS = sS + wv * 16 * KT_LD;
        {
            float e1[4], e1m[4];
#pragma unroll
            for (int j = 0; j < 4; ++j) {
                e1[j] = __expf((float)(fq * 4 + j - fr) * lg);
                e1m[j] = (fq * 4 + j >= fr) ? e1[j] : 0.f;
            }
#pragma unroll
            for (int nn = 0; nn < 8; ++nn) {
                const float e2 = (nn < wv) ? __expf((float)(16 * (wv - nn)) * lg) : 0.f;
                const bool diag = (nn == wv);
                float v[4];
#pragma unroll
                for (int j = 0; j < 4; ++j) v[j] = accs[nn][j] * (diag ? e1m[j] : e2 * e1[j]);
#pragma unroll
                for (int j = 0; j < 4; ++j) mS[(fq * 4 + j) * KT_LD + nn * 16 + fr] = f2bf(v[j]);
            }
        }
        lds_barrier();
        f32x4 acco[4];
#pragma unroll
        for (int nn = 0; nn < 4; ++nn) acco[nn] = (f32x4){0.f, 0.f, 0.f, 0.f};
#pragma unroll
        for (int ks = 0; ks < 4; ++ks) {
            bf16x8 af = *reinterpret_cast<const bf16x8*>(mS + fr * KT_LD + ks * 32 + fq * 8);
#pragma unroll
            for (int nn = 0; nn < 4; ++nn) {
                bf16x8 bfr = *reinterpret_cast<const bf16x8*>(sVT + (nn * 16 + fr) * KT_LD + ks * 32 + fq * 8);
                acco[nn] = __builtin_amdgcn_mfma_f32_16x16x32_bf16(af, bfr, acco[nn], 0, 0, 0);
            }
        }
#pragma unroll
        for (int j = 0; j < 4; ++j) {
            int ig = wv * 16 + fq * 4 + j;
            float xi = __expf((float)(ig + 1) * lg);
            float o[4];
            float sm = 0.f;
#pragma unroll
            for (int nn = 0; nn < 4; ++nn) { o[nn] = acco[nn][j] + xi * accc[nn][j]; sm += o[nn]; }
            sm = row16_sum(sm);
            float mean = sm * (1.0f / 64.0f);
            float sq = 0.f;
#pragma unroll
            for (int nn = 0; nn < 4; ++nn) { float d = o[nn] - mean; sq += d * d; }
            sq = row16_sum(sq);
            float rstd = rsqrtf(sq * (1.0f / 64.0f) + 1e-5f);
            size_t tok = (size_t)b * SEQ + n * 128 + ig;
#pragma unroll
            for (int nn = 0; nn < 4; ++nn) {
                int e = h * 64 + nn * 16 + fr;
                float y = (o[nn] - mean) * rstd * gng[nn] + gnb[nn];
                float gr = bf2f(cur.gr[j * 4 + nn]);
                YC[tok * 1024 + 512 + e] = f2bf(siluf_(gr) * y);
            }
        }
        cur = nxt;
        lds_barrier();
    }
}

#define XB_TMO      128
#define XB_XCNT(j)  (256  + 64 * (j))
#define XB_XSUB(j)  (1280 + 64 * (j))
#define XB_XGEN(j)  (2304 + 64 * (j))
#define XB_TOP      3328
#define XB_TOPGEN   3392
#define XB_SPIN_CAP (1u << 18)

__device__ __forceinline__ unsigned xb_ld(unsigned* p)              { return __hip_atomic_load(p, __ATOMIC_RELAXED, __HIP_MEMORY_SCOPE_AGENT); }
__device__ __forceinline__ unsigned xb_add(unsigned* p, unsigned v) { return __hip_atomic_fetch_add(p, v, __ATOMIC_RELAXED, __HIP_MEMORY_SCOPE_AGENT); }
__device__ __forceinline__ unsigned xb_xcc_id() { return (unsigned)__builtin_amdgcn_s_getreg((3 << 11) | 20) & 0xFu; }
#define XB_SPIN(cond, bar) do { unsigned _sp = 0; while (cond) { __builtin_amdgcn_s_sleep(1); \
    if ((++_sp & 255u) == 0u) { if (xb_ld(&(bar)[XB_TMO])) break; if (_sp > XB_SPIN_CAP) { atomicAdd(&(bar)[XB_TMO], 1u); break; } } } } while (0)

struct XcdBarrier {
    unsigned* bar; unsigned x;
    volatile __attribute__((address_space(3))) unsigned* st;
};

__device__ __forceinline__ XcdBarrier xcd_barrier_post(unsigned* bar, volatile __attribute__((address_space(3))) unsigned* st, int tid) {
    XcdBarrier b; b.bar = bar; b.x = xb_xcc_id(); b.st = st;
    if (tid == 0) (void)xb_add(&bar[XB_XCNT(b.x)], 1u);
    return b;
}
__device__ __forceinline__ void xcd_barrier_complete(unsigned* bar, unsigned x, unsigned& nloc, unsigned& nx) {
    const unsigned G = (unsigned)ogdim();
    unsigned sum, cnt, mine, sp = 0u;
    for (;;) {
        sum = 0u; cnt = 0u; mine = 0u;
#pragma unroll
        for (unsigned j = 0; j < 16; ++j) { const unsigned c = xb_ld(&bar[XB_XCNT(j)]); sum += c; cnt += (c > 0u) ? 1u : 0u; mine = (j == x) ? c : mine; }
        if (sum == G) break;
        __builtin_amdgcn_s_sleep(1);
        if ((++sp & 255u) == 0u) { if (xb_ld(&bar[XB_TMO])) break; if (sp > XB_SPIN_CAP) { atomicAdd(&bar[XB_TMO], 1u); break; } }
    }
    nloc = mine > 0u ? mine : 1u; nx = cnt > 0u ? cnt : 1u;
}

__device__ __forceinline__ void xcd_barrier(const XcdBarrier& b, int tid) {
    asm volatile("s_waitcnt vmcnt(0)" ::: "memory");
    __syncthreads();
    if (tid == 0) {
        unsigned* bar = b.bar;
        __builtin_amdgcn_s_waitcnt(0);
        unsigned nloc = b.st[0], nx = b.st[1];
        if (nloc == 0u) { xcd_barrier_complete(bar, b.x, nloc, nx); b.st[0] = nloc; b.st[1] = nx; }
        const unsigned old = xb_add(&bar[XB_XSUB(b.x)], 1u);
        const unsigned gen = old / nloc;
        if (old + 1u == (gen + 1u) * nloc) {
            __builtin_amdgcn_fence(__ATOMIC_RELEASE, "agent");
            asm volatile("s_waitcnt vmcnt(0)" ::: "memory");
            const unsigned og = xb_add(&bar[XB_TOP], 1u);
            const unsigned tg = og / nx;
            if (og + 1u == (tg + 1u) * nx) xb_add(&bar[XB_TOPGEN], 1u);
            else XB_SPIN(xb_ld(&bar[XB_TOPGEN]) == tg, bar);
            __builtin_amdgcn_fence(__ATOMIC_ACQUIRE, "agent");
            xb_add(&bar[XB_XGEN(b.x)], 1u);
            asm volatile("s_waitcnt vmcnt(0)" ::: "memory");
        } else {
            XB_SPIN(xb_ld(&bar[XB_XGEN(b.x)]) == gen, bar);
            __builtin_amdgcn_fence(__ATOMIC_ACQUIRE, "agent");
            asm volatile("s_waitcnt vmcnt(0)" ::: "memory");
        }
    }
    __syncthreads();
}


#define N_PHASES 22
__device__ __forceinline__ void run_phase(const Params& p, int ph, unsigned char* smem) {
    bf16_t* sm16 = reinterpret_cast<bf16_t*>(smem);
    const bf16_t* W = reinterpret_cast<const bf16_t*>(p.ws + OFF_W);
    bf16_t* ACTB = reinterpret_cast<bf16_t*>(p.ws + OFF_ACTB);
    bf16_t* PB = reinterpret_cast<bf16_t*>(p.ws + OFF_P);
    bf16_t* YC = reinterpret_cast<bf16_t*>(p.ws + OFF_YCAT);
    switch (ph) {
        case 0: phase_pre(p, smem, 0, obid(), ogdim()); break;
        case 1: { PEpiBf16 e{PB, 2304}; big_gemm(ACTB, W + WE_IN0, NT, 2304, DM, e, smem, p.wave); } break;
        case 2: phase_l0_prep(p); break;
        case 3: phase_l0_lora(p, sm16); break;
        case 4: phase_rwkv_r1(p, smem); break;
        case 5: phase_rwkv_r2(p, smem); break;
        case 6: phase_rwkv_r3(p, smem); break;
        case 7: { PEpiOut<false> e{p.in[0], nullptr, p.out}; big_gemm(YC, W + WE_OUT0, NT, DM, DM, e, smem, p.wave); } break;
        case 8: phase_ln_route(p, 0, p.out, smem); break;
        case 9: phase_exp1(p, 0, sm16); break;
        case 10: phase_exp2(p, 0, sm16); break;
        case 11: phase_ln_ffn(p, 0, p.out, false); break;
        case 12: { PEpiBf16 e{PB, 3072}; big_gemm(ACTB, W + WE_IN1, NT, 3072, DM, e, smem, p.wave); } break;
        case 13: phase_l1_conv(p, smem); break;
        case 14: phase_ret_kv(p, smem); break;
        case 15: phase_ret_scan(p); break;
        case 16: phase_ret_out(p, smem); break;
        case 17: { PEpiOut<true> e{nullptr, ACTB, p.out}; big_gemm(YC, W + WE_OUT1, NT, DM, DM, e, smem, p.wave); } break;
        case 18: phase_ln_route(p, 1, p.out, smem); break;
        case 19: phase_exp1(p, 1, sm16); break;
        case 20: phase_exp2(p, 1, sm16); break;
        case 21: phase_ln_ffn(p, 1, p.out, true); break;
        default: break;
    }
}

#define SMEM_BYTES 132096
__global__ void __launch_bounds__(NTHREADS) k_mega(Params p) {
    extern __shared__ __attribute__((aligned(16))) unsigned char smem[];
    cg::grid_group grid = cg::this_grid();
    const int wave_s = __builtin_amdgcn_readfirstlane((int)(threadIdx.x >> 6));
    volatile __attribute__((address_space(3))) unsigned* st = (volatile __attribute__((address_space(3))) unsigned*)(smem + 131584);
    {
        const int t0 = otid(wave_s);
        if (t0 < 2) st[t0] = 0u;
    }
    XcdBarrier xb;
#pragma nounroll
    for (int ph = 0; ph < N_PHASES; ++ph) {
        int phv = ph;
        asm volatile("" : "+s"(phv));
        typedef const __attribute__((address_space(4))) Params* KP;
        KP pp = (KP)__builtin_amdgcn_kernarg_segment_ptr();
        asm volatile("" : "+s"(pp));
        Params pl;
        __builtin_memcpy(&pl, (const Params*)pp, sizeof(Params));
        pl.wave = wave_s;
        run_phase(pl, phv, smem);
        if (ph == 0) {
            grid.sync();
            xb = xcd_barrier_post(reinterpret_cast<unsigned*>(pl.ws + OFF_CTRL + 4096), st, otid(wave_s));
        } else if (ph < N_PHASES - 1) {
            xcd_barrier(xb, otid(wave_s));
        }
    }
}

extern "C" void kernel_launch(void* const* d_in, const int* in_sizes, int n_in, void* d_out, int out_size, void* d_ws, size_t ws_size,
                              hipStream_t stream) {
    static int grid_blocks = 0;
    if (!grid_blocks) {
        int dev = 0, cus = 0, per_cu = 0;
        hipGetDevice(&dev);
        hipDeviceGetAttribute(&cus, hipDeviceAttributeMultiprocessorCount, dev);
        hipFuncSetAttribute((const void*)k_mega, hipFuncAttributeMaxDynamicSharedMemorySize, SMEM_BYTES);
        hipOccupancyMaxActiveBlocksPerMultiprocessor(&per_cu, (const void*)k_mega, NTHREADS, SMEM_BYTES);
        if (per_cu < 1) per_cu = 1;
        grid_blocks = cus * per_cu;
    }
    Params p{};
    for (int i = 0; i < 35; ++i) p.in[i] = (const float*)d_in[i];
    p.out = (float*)d_out;
    p.ws = (unsigned char*)d_ws;
    void* args[] = {&p};
    hipError_t e = hipLaunchCooperativeKernel((void*)k_mega, dim3(grid_blocks), dim3(NTHREADS), args, SMEM_BYTES, stream);
    if (e != hipSuccess) fprintf(stderr, "cooperative launch failed: %s (grid %d)\n", hipGetErrorString(e), grid_blocks);
}
```

```cpp
#include <hip/hip_runtime.h>
#include <hip/hip_cooperative_groups.h>
#include <stdint.h>
#include <stdio.h>
namespace cg = cooperative_groups;

typedef unsigned short bf16_t;
typedef short bf16x8 __attribute__((ext_vector_type(8)));
typedef float f32x4 __attribute__((ext_vector_type(4)));

#define NT 32768
#define SEQ 8192
#define DM 1024
#define NTHREADS 512
#define XCD_BAR_WORDS 3456
#define NWAVES 8
#define ALPHA_F 1.41421356237309515f

#define MIB (1024ull * 1024ull)
#define OFF_CTRL 0ull
#define OFF_W (1ull * MIB)
#define OFF_ROPE (65ull * MIB)
#define OFF_ACTB (68ull * MIB)
#define OFF_AA (OFF_ACTB)
#define OFF_GG (OFF_ACTB + 32ull * MIB)
#define OFF_P (132ull * MIB)
#define OFF_LORA (OFF_P + 144ull * MIB)
#define OFF_POOLED (OFF_P + 160ull * MIB)
#define OFF_FS (OFF_P)
#define OFF_HBUF (OFF_P + 128ull * MIB)
#define OFF_YCAT (324ull * MIB)
#define OFF_LOGW (388ull * MIB)
#define OFF_LTOK (452ull * MIB)
#define OFF_LGATE (456ull * MIB)
#define OFF_KVT (460ull * MIB)
#define WE_IN0 0
#define WE_OUT0 2359296
#define WE_IN1 3407872
#define WE_OUT1 6553600
#define WE_W13 7602176
#define WE_W2 24379392
#define WE_LW2 32768000
#define WE_LA2 32800768
#define WE_LG2 32833536
#define WE_POOL 32899072
#define WE_RT_HI 32964608
#define WE_RT_LO 33062912

struct Params {
    const float* in[35];
    float* out;
    unsigned char* ws;
    int wave;
    int pad_;
};

typedef __bf16 hw_bf16x2 __attribute__((ext_vector_type(2)));
typedef float hw_f32x2 __attribute__((ext_vector_type(2)));
__device__ __forceinline__ unsigned pack2(float a, float b) {
    hw_f32x2 v = {a, b};
    hw_bf16x2 r = __builtin_convertvector(v, hw_bf16x2);
    return __builtin_bit_cast(unsigned, r);
}
__device__ __forceinline__ bf16_t f2bf(float f) { return (bf16_t)(pack2(f, 0.f) & 0xffffu); }
__device__ __forceinline__ float bf2f(bf16_t h) { return __uint_as_float(((unsigned)h) << 16); }
__device__ __forceinline__ void unpack8(const uint4 v, float (&o)[8]) {
    o[0] = __uint_as_float(v.x << 16); o[1] = __uint_as_float(v.x & 0xffff0000u);
    o[2] = __uint_as_float(v.y << 16); o[3] = __uint_as_float(v.y & 0xffff0000u);
    o[4] = __uint_as_float(v.z << 16); o[5] = __uint_as_float(v.z & 0xffff0000u);
    o[6] = __uint_as_float(v.w << 16); o[7] = __uint_as_float(v.w & 0xffff0000u);
}
#define DPP_ADD(v, CTRL) ((v) + __int_as_float(__builtin_amdgcn_update_dpp(0, __float_as_int(v), (CTRL), 0xF, 0xF, false)))
__device__ __forceinline__ float row16_sum(float v) {
    v = DPP_ADD(v, 0xB1);
    v = DPP_ADD(v, 0x4E);
    v = DPP_ADD(v, 0x141);
    v = DPP_ADD(v, 0x140);
    return v;
}
__device__ __forceinline__ float wave_sum(float v) {
    v = row16_sum(v);
    const int iv = __float_as_int(v);
    const float s0 = __int_as_float(__builtin_amdgcn_readlane(iv, 0)), s1 = __int_as_float(__builtin_amdgcn_readlane(iv, 16));
    const float s2 = __int_as_float(__builtin_amdgcn_readlane(iv, 32)), s3 = __int_as_float(__builtin_amdgcn_readlane(iv, 48));
    return (s0 + s1) + (s2 + s3);
}
__device__ __forceinline__ float sigmoidf_(float x) { return 1.0f / (1.0f + __expf(-x)); }
__device__ __forceinline__ float siluf_(float x) { return x / (1.0f + __expf(-x)); }
__device__ __forceinline__ float quad_sum(float v) {
    int iv = __float_as_int(v);
    float a = __int_as_float(__builtin_amdgcn_update_dpp(0, iv, 0xB1, 0xF, 0xF, false));
    v += a;
    iv = __float_as_int(v);
    float b = __int_as_float(__builtin_amdgcn_update_dpp(0, iv, 0x4E, 0xF, 0xF, false));
    return v + b;
}

__device__ __forceinline__ void lds_barrier() {
    asm volatile("s_waitcnt lgkmcnt(0)" ::: "memory");
    __builtin_amdgcn_s_barrier();
    asm volatile("" ::: "memory");
}
__device__ __forceinline__ int obid() { int b = (int)blockIdx.x; asm volatile("" : "+s"(b)); return b; }
__device__ __forceinline__ int ogdim() { int b = (int)gridDim.x; asm volatile("" : "+s"(b)); return b; }
__device__ __forceinline__ int otid(int wave) { int t = wave * 64 + (int)__builtin_amdgcn_mbcnt_hi(~0u, __builtin_amdgcn_mbcnt_lo(~0u, 0u)); asm volatile("" : "+v"(t)); return t; }
template <bool GATHER, class Epi>
__device__ __forceinline__ void gemm_tile(const bf16_t* __restrict__ A, int lda, const int* __restrict__ gidx, int gcount,
                                          const bf16_t* __restrict__ Bt, int ldb, int K, int row0, int col0, const Epi& epi,
                                          bf16_t* smem, int wave) {
    const int tidx = otid(wave);
    const int tid = tidx, wid = tid >> 6, lane = tid & 63, wr = wid >> 1, wc = wid & 1, fr = lane & 15, fq = lane >> 4;
    unsigned char* sm = reinterpret_cast<unsigned char*>(smem);
    const bf16_t* ap[4];
    const bf16_t* bp[2];
#pragma unroll
    for (int i = 0; i < 4; ++i) {
        const int pch = tid + i * 512;
        const int r = pch >> 3, c = (pch & 7) ^ (r & 7);
        int ar = row0 + r;
        if (GATHER) {
            int gi = ar < gcount ? ar : gcount - 1;
            ar = gidx[gi] >> 1;
        }
        ap[i] = A + (size_t)ar * lda + c * 8;
    }
#pragma unroll
    for (int i = 0; i < 2; ++i) {
        const int pch = tid + i * 512;
        const int r = pch >> 3, c = (pch & 7) ^ (r & 7);
        bp[i] = Bt + (size_t)(col0 + r) * ldb + c * 8;
    }
    f32x4 acc[4][4];
#pragma unroll
    for (int m = 0; m < 4; ++m)
#pragma unroll
        for (int n = 0; n < 4; ++n) acc[m][n] = (f32x4){0.f, 0.f, 0.f, 0.f};
    const int nk = K >> 6;
#define GT_STAGE(kt, buf) do { _Pragma("unroll") for (int i_ = 0; i_ < 4; ++i_) \
        __builtin_amdgcn_global_load_lds((const unsigned*)(ap[i_] + (kt) * 64), (__attribute__((address_space(3))) unsigned*)(sm + (buf) * 49152 + (tid + i_ * 512) * 16), 16, 0, 0); \
        _Pragma("unroll") for (int i_ = 0; i_ < 2; ++i_) \
        __builtin_amdgcn_global_load_lds((const unsigned*)(bp[i_] + (kt) * 64), (__attribute__((address_space(3))) unsigned*)(sm + (buf) * 49152 + 32768 + (tid + i_ * 512) * 16), 16, 0, 0); } while (0)
    GT_STAGE(0, 0);
    for (int kt = 0; kt < nk; ++kt) {
        const int buf = kt & 1;
        if (kt + 1 < nk) {
            GT_STAGE(kt + 1, buf ^ 1);
            asm volatile("s_waitcnt vmcnt(6)" ::: "memory");
        } else {
            asm volatile("s_waitcnt vmcnt(0)" ::: "memory");
        }
        __builtin_amdgcn_s_barrier();
        asm volatile("" ::: "memory");
        const unsigned char* SA = sm + buf * 49152;
        const unsigned char* SB = SA + 32768;
#pragma unroll
        for (int ks = 0; ks < 2; ++ks) {
            bf16x8 af[4], bfr[4];
            const int cs = ((ks * 4 + fq) ^ (fr & 7)) * 16;
#pragma unroll
            for (int m = 0; m < 4; ++m) af[m] = *reinterpret_cast<const bf16x8*>(SA + (wr * 64 + m * 16 + fr) * 128 + cs);
#pragma unroll
            for (int n = 0; n < 4; ++n) bfr[n] = *reinterpret_cast<const bf16x8*>(SB + (wc * 64 + n * 16 + fr) * 128 + cs);
#pragma unroll
            for (int m = 0; m < 4; ++m)
#pragma unroll
                for (int n = 0; n < 4; ++n) acc[m][n] = __builtin_amdgcn_mfma_f32_16x16x32_bf16(bfr[n], af[m], acc[m][n], 0, 0, 0);
        }
        asm volatile("s_waitcnt lgkmcnt(0)" ::: "memory");
        __builtin_amdgcn_s_barrier();
        asm volatile("" ::: "memory");
    }
#undef GT_STAGE
    epi(acc, row0 + wr * 64, col0 + wc * 64, fr, fq);
}

struct EpiStoreBf16 {
    bf16_t* O; int ldo;
    __device__ __forceinline__ void operator()(f32x4 (&acc)[4][4], int rb, int cb, int fr, int fq) const {
#pragma unroll
        for (int m = 0; m < 4; ++m)
#pragma unroll
            for (int n = 0; n < 4; ++n) {
                int row = rb + m * 16 + fr, col = cb + n * 16 + fq * 4;
                uint2 w; w.x = pack2(acc[m][n][0], acc[m][n][1]); w.y = pack2(acc[m][n][2], acc[m][n][3]);
                *reinterpret_cast<uint2*>(O + (size_t)row * ldo + col) = w;
            }
    }
};
template <int MODE>
struct EpiLora {
    float* Of; bf16_t* Ob; const float* vec; int ldo; int coff;
    __device__ __forceinline__ void operator()(f32x4 (&acc)[4][4], int rb, int cb, int fr, int fq) const {
#pragma unroll
        for (int m = 0; m < 4; ++m)
#pragma unroll
            for (int n = 0; n < 4; ++n) {
                int row = rb + m * 16 + fr, col = cb + n * 16 + fq * 4;
                float v[4];
#pragma unroll
                for (int j = 0; j < 4; ++j) {
                    float a = acc[m][n][j];
                    if (MODE == 0) {
                        float t = -(vec[col + j] + a);
                        float sp = (t > 20.f) ? t : log1pf(__expf(t));
                        float wl = -sp - 0.5f;
                        v[j] = -__expf(wl);
                    } else if (MODE == 1) {
                        v[j] = sigmoidf_(vec[col + j] + a);
                    } else if (MODE == 2) {
                        v[j] = a;
                    } else {
                        v[j] = a * vec[coff + col + j];
                    }
                }
                {
                    uint2 w; w.x = pack2(v[0], v[1]); w.y = pack2(v[2], v[3]);
                    *reinterpret_cast<uint2*>(Ob + (size_t)row * ldo + coff + col) = w;
                }
            }
    }
};
struct EpiOut {
    const float* Xprev; float* X;
    __device__ __forceinline__ void operator()(f32x4 (&acc)[4][4], int rb, int cb, int fr, int fq) const {
#pragma unroll
        for (int m = 0; m < 4; ++m)
#pragma unroll
            for (int n = 0; n < 4; ++n) {
                int row = rb + m * 16 + fr, col = cb + n * 16 + fq * 4;
                float4 xp = *reinterpret_cast<const float4*>(Xprev + (size_t)row * DM + col);
                float4 o;
                o.x = ALPHA_F * xp.x + acc[m][n][0]; o.y = ALPHA_F * xp.y + acc[m][n][1];
                o.z = ALPHA_F * xp.z + acc[m][n][2]; o.w = ALPHA_F * xp.w + acc[m][n][3];
                *reinterpret_cast<float4*>(X + (size_t)row * DM + col) = o;
            }
    }
};
struct EpiExp1 {
    bf16_t* H; int base; int cnt;
    __device__ __forceinline__ void operator()(f32x4 (&acc)[4][4], int rb, int cb, int fr, int fq) const {
#pragma unroll
        for (int m = 0; m < 4; ++m) {
            int li = rb + m * 16 + fr;
            if (li < cnt) {
#pragma unroll
                for (int i = 0; i < 2; ++i) {
                    int hcol = (cb >> 1) + i * 16 + fq * 4;
                    float v[4];
#pragma unroll
                    for (int j = 0; j < 4; ++j) v[j] = siluf_(acc[m][2 * i][j]) * acc[m][2 * i + 1][j];
                    uint2 w; w.x = pack2(v[0], v[1]); w.y = pack2(v[2], v[3]);
                    *reinterpret_cast<uint2*>(H + (size_t)(base + li) * 128 + hcol) = w;
                }
            }
        }
    }
};
struct EpiExp2 {
    bf16_t* FS; const int* ltok; const float* lgate; int cnt;
    __device__ __forceinline__ void operator()(f32x4 (&acc)[4][4], int rb, int cb, int fr, int fq) const {
#pragma unroll
        for (int m = 0; m < 4; ++m) {
            int li = rb + m * 16 + fr;
            if (li < cnt) {
                int pk = ltok[li]; float g = lgate[li];
                int tok = pk >> 1, j = pk & 1;
                bf16_t* o = FS + ((size_t)j * NT + tok) * DM;
#pragma unroll
                for (int n = 0; n < 4; ++n) {
                    int col = cb + n * 16 + fq * 4;
                    uint2 w; w.x = pack2(acc[m][n][0] * g, acc[m][n][1] * g); w.y = pack2(acc[m][n][2] * g, acc[m][n][3] * g);
                    *reinterpret_cast<uint2*>(o + col) = w;
                }
            }
        }
    }
};

namespace pg8 {
#define PG8_LAS __attribute__((address_space(3)))
typedef unsigned short bf16_t;
typedef short bf16x8 __attribute__((ext_vector_type(8)));
typedef float f32x4 __attribute__((ext_vector_type(4)));
typedef unsigned u32x4 __attribute__((ext_vector_type(4)));
constexpr int BM = 256, BK = 64, HALF = 128, HTB = HALF * BK * 2  , STAGE_BYTES = 8 * HTB, NXCD = 8, WGM = 8;

__host__ __device__ __forceinline__ int lds_byte(int r, int c) { const int st = (r >> 4) * 2 + (c >> 5), rr = r & 15, cc = c & 31, ob = rr * 64 + cc * 2; return st * 1024 + (ob ^ (((ob >> 9) & 1) << 5)); }
__host__ __device__ __forceinline__ void stage_rc(int b, int& R, int& C) { const int st = b / 1024, sb = b % 1024, swz = sb ^ (((sb >> 9) & 1) << 5); R = (st >> 1) * 16 + swz / 64; C = (st & 1) * 32 + (swz % 64) / 2; }
__host__ __device__ __forceinline__ int perm32(int rho) { const int n = rho >> 4, i = rho & 15; return 8 * (i >> 2) + 4 * n + (i & 3); }

struct Unit { int pm, pn; };
struct Gemm { const bf16_t* A; const bf16_t* Bt; int M, N, K; };

struct StaticOrder {
    int nM, nN, nwg, G, c;
    __host__ __device__ void init(int M, int N, int G_, int c_) { nM = M / BM; nN = N / BM; nwg = nM * nN; G = G_; c = c_; }
    __host__ __device__ bool next(int i, Unit& u) const {
        const long L = (long)i * G + c; if (L >= nwg) return false;
        int wgid = (int)L; { const int q = nwg / NXCD, r = nwg % NXCD, xcd = wgid % NXCD, off = wgid / NXCD; wgid = (xcd < r ? xcd * (q + 1) : r * (q + 1) + (xcd - r) * q) + off; }
        const int nig = WGM * nN, gid = wgid / nig, fm = gid * WGM, gsz = (nM - fm) < WGM ? (nM - fm) : WGM;
        u.pm = fm + ((wgid % nig) % gsz); u.pn = (wgid % nig) / gsz; return true;
    }
    __device__ __forceinline__ void a_ready(const Unit&) const {}
    __device__ __forceinline__ void done(const Unit&) const {}
};
template <class Epi, class Sched, bool ALIGN_EPI = false, bool SP2 = false>
__device__ __forceinline__ void gemm_phase(PG8_LAS unsigned char* lds, const Gemm g, const Sched& S, const Epi& E, int wave) {
    const int tid = otid(wave), wid = __builtin_amdgcn_readfirstlane(tid >> 6), lane = tid & 63, wr = wid >> 2, wc = wid & 3, fr = lane & 15, fq = lane >> 4;
    const int K = g.K, nt = K / BK;
    unsigned voffA[2], voffB[2];
#pragma unroll
    for (int i = 0; i < 2; ++i) { int R, C; stage_rc(tid * 16 + i * 8192, R, C); const int Rb = Epi::PERM ? ((R & ~31) + perm32(R & 31)) : R;
        voffA[i] = (unsigned)(R * K + C) * 2u; voffB[i] = (unsigned)(Rb * K + C) * 2u; }
    const size_t kstep = (size_t)(BK * 2);
    const size_t hstep = (size_t)HALF * K * 2;
    const size_t tstep = 2 * hstep;
    const unsigned ldsw = (unsigned)wid * 1024u;
    const int aoff = lds_byte(wr * 64 + fr, fq * 8), boff = lds_byte(wc * 32 + fr, fq * 8);
#define PG8_SA(b, h) (((b) * 2 + (h)) * HTB)
#define PG8_SB(b, h) ((4 + (b) * 2 + (h)) * HTB)
#define PG8_STAGE(bufoff, gbase, voff) do { _Pragma("unroll") for (int _i = 0; _i < 2; ++_i) \
        __builtin_amdgcn_global_load_lds((const unsigned*)((const char*)(gbase) + (voff)[_i]), (PG8_LAS unsigned*)(lds + (bufoff) + ldsw + _i * 8192), 16, 0, 0); } while (0)
#define PG8_LDA(dst, b, h) do { _Pragma("unroll") for (int m = 0; m < 4; ++m) _Pragma("unroll") for (int k = 0; k < 2; ++k) dst[m][k] = *(const PG8_LAS bf16x8*)(lds + PG8_SA(b, h) + aoff + m * 2048 + k * 1024); } while (0)
#define PG8_LDB(dst, b, h) do { _Pragma("unroll") for (int n = 0; n < 2; ++n) _Pragma("unroll") for (int k = 0; k < 2; ++k) dst[n][k] = *(const PG8_LAS bf16x8*)(lds + PG8_SB(b, h) + boff + n * 2048 + k * 1024); } while (0)
#define PG8_MMA(ai, bj, At, Bt) do { __builtin_amdgcn_s_setprio(1); _Pragma("unroll") for (int m = 0; m < 4; ++m) _Pragma("unroll") for (int n = 0; n < 2; ++n) _Pragma("unroll") for (int k = 0; k < 2; ++k) \
        acc[ai][bj][m][n] = __builtin_amdgcn_mfma_f32_16x16x32_bf16(Bt[n][k], At[m][k], acc[ai][bj][m][n], 0, 0, 0); __builtin_amdgcn_s_setprio(0); } while (0)
#define PG8_WAIT_V(n) asm volatile("s_waitcnt vmcnt(" #n ")" ::: "memory")
#define PG8_WAIT_L(n) asm volatile("s_waitcnt lgkmcnt(" #n ")" ::: "memory")
#define PG8_BAR __builtin_amdgcn_s_barrier()
#define PG8_SCHED __builtin_amdgcn_sched_barrier(0)
    Unit cur, nxt; int ui = 0;
    if (!S.next(0, cur)) return;
    f32x4 acc[2][2][4][2];
#pragma unroll
    for (int a = 0; a < 2; ++a)
#pragma unroll
        for (int b = 0; b < 2; ++b)
#pragma unroll
            for (int m = 0; m < 4; ++m)
#pragma unroll
                for (int n = 0; n < 2; ++n) acc[a][b][m][n] = (f32x4){0.f, 0.f, 0.f, 0.f};
    bf16x8 At[4][2], B0[2][2], B1[2][2];
    const char* cA = (const char*)g.A + (size_t)cur.pm * tstep; const char* cB = (const char*)g.Bt + (size_t)cur.pn * tstep;
    S.a_ready(cur);
    if constexpr (SP2) {
        PG8_STAGE(PG8_SB(0, 0), cB, voffB); PG8_STAGE(PG8_SB(0, 1), cB + hstep, voffB); PG8_STAGE(PG8_SA(0, 0), cA, voffA); PG8_STAGE(PG8_SA(0, 1), cA + hstep, voffA);
        if (wr == 1) PG8_BAR;
        PG8_WAIT_V(2); PG8_BAR;
        PG8_STAGE(PG8_SB(1, 0), cB + kstep, voffB); PG8_STAGE(PG8_SA(1, 0), cA + kstep, voffA); PG8_STAGE(PG8_SB(1, 1), cB + hstep + kstep, voffB);
        PG8_WAIT_V(6); PG8_BAR;
    } else {
        PG8_STAGE(PG8_SB(0, 0), cB, voffB); PG8_STAGE(PG8_SA(0, 0), cA, voffA); PG8_STAGE(PG8_SB(0, 1), cB + hstep, voffB); PG8_STAGE(PG8_SA(0, 1), cA + hstep, voffA);
        if (wr == 1) PG8_BAR;
        PG8_WAIT_V(4); PG8_BAR;
        PG8_STAGE(PG8_SB(1, 0), cB + kstep, voffB); PG8_STAGE(PG8_SA(1, 0), cA + kstep, voffA); PG8_STAGE(PG8_SB(1, 1), cB + hstep + kstep, voffB);
        PG8_WAIT_V(6); PG8_BAR;
    }
    for (;;) {
        const bool has_next = S.next(ui + 1, nxt);
        const char* nA = has_next ? (const char*)g.A + (size_t)nxt.pm * tstep : cA; const char* nB = has_next ? (const char*)g.Bt + (size_t)nxt.pn * tstep : cB;
        for (int t = 0; t < nt; t += 2) {
            const bool last = (t == nt - 2);
            const char* a1 = cA + (size_t)(t + 1) * kstep;
            const char* a2 = last ? nA : cA + (size_t)(t + 2) * kstep; const char* b2 = last ? nB : cB + (size_t)(t + 2) * kstep;
            const char* a3 = a2 + kstep; const char* b3 = b2 + kstep;
            if (last && has_next) S.a_ready(nxt);
            if constexpr (SP2) {
            PG8_LDB(B0, 0, 0); PG8_LDB(B1, 0, 1); PG8_SCHED; PG8_LDA(At, 0, 0); PG8_STAGE(PG8_SA(1, 1), a1 + hstep, voffA);
            PG8_WAIT_V(8); PG8_WAIT_L(0); PG8_BAR; PG8_MMA(0, 0, At, B0); PG8_MMA(0, 1, At, B1); PG8_BAR; PG8_SCHED;
            PG8_LDA(At, 0, 1); PG8_STAGE(PG8_SB(0, 0), b2, voffB); PG8_STAGE(PG8_SB(0, 1), b2 + hstep, voffB); PG8_STAGE(PG8_SA(0, 0), a2, voffA);
            PG8_WAIT_V(8); PG8_WAIT_L(0); PG8_BAR; PG8_MMA(1, 0, At, B0); PG8_MMA(1, 1, At, B1); PG8_BAR; PG8_SCHED;
            PG8_LDB(B0, 1, 0); PG8_LDB(B1, 1, 1); PG8_SCHED; PG8_LDA(At, 1, 0); PG8_STAGE(PG8_SA(0, 1), a2 + hstep, voffA);
            PG8_WAIT_V(8); PG8_WAIT_L(0); PG8_BAR; PG8_MMA(0, 0, At, B0); PG8_MMA(0, 1, At, B1); PG8_BAR; PG8_SCHED;
            PG8_LDA(At, 1, 1); PG8_STAGE(PG8_SB(1, 0), b3, voffB); PG8_STAGE(PG8_SB(1, 1), b3 + hstep, voffB); PG8_STAGE(PG8_SA(1, 0), a3, voffA);
            PG8_WAIT_V(8); PG8_WAIT_L(0); PG8_BAR; PG8_MMA(1, 0, At, B0); PG8_MMA(1, 1, At, B1); PG8_BAR; PG8_SCHED;
            } else {
            PG8_LDB(B0, 0, 0); PG8_SCHED; PG8_LDA(At, 0, 0); PG8_STAGE(PG8_SA(1, 1), a1 + hstep, voffA);
            PG8_WAIT_L(8); PG8_BAR; PG8_WAIT_L(0); PG8_MMA(0, 0, At, B0); PG8_BAR; PG8_SCHED;
            PG8_LDB(B1, 0, 1); PG8_STAGE(PG8_SB(0, 0), b2, voffB);
            PG8_BAR; PG8_WAIT_L(0); PG8_MMA(0, 1, At, B1); PG8_BAR;
            PG8_LDA(At, 0, 1); PG8_STAGE(PG8_SA(0, 0), a2, voffA);
            PG8_BAR; PG8_WAIT_L(0); PG8_MMA(1, 0, At, B0); PG8_BAR; PG8_SCHED;
            PG8_STAGE(PG8_SB(0, 1), b2 + hstep, voffB);
            PG8_WAIT_V(6); PG8_BAR; PG8_MMA(1, 1, At, B1); PG8_BAR;
            PG8_LDB(B0, 1, 0); PG8_SCHED; PG8_LDA(At, 1, 0); PG8_STAGE(PG8_SA(0, 1), a2 + hstep, voffA);
            PG8_WAIT_L(8); PG8_BAR; PG8_WAIT_L(0); PG8_MMA(0, 0, At, B0); PG8_BAR; PG8_SCHED;
            PG8_LDB(B1, 1, 1); PG8_STAGE(PG8_SB(1, 0), b3, voffB);
            PG8_BAR; PG8_WAIT_L(0); PG8_MMA(0, 1, At, B1); PG8_BAR;
            PG8_LDA(At, 1, 1); PG8_STAGE(PG8_SA(1, 0), a3, voffA);
            PG8_BAR; PG8_WAIT_L(0); PG8_MMA(1, 0, At, B0); PG8_BAR; PG8_SCHED;
            PG8_STAGE(PG8_SB(1, 1), b3 + hstep, voffB);
            PG8_WAIT_V(6); PG8_BAR; PG8_MMA(1, 1, At, B1); PG8_BAR;
            }
        }
        if constexpr (ALIGN_EPI) { if (wr == 0) PG8_BAR; }
        if constexpr (!Epi::AFTER_DRAIN) { E(acc, cur, wr, wc, fr, fq); S.done(cur); }
        if (!has_next) break;
#pragma unroll
        for (int a = 0; a < 2; ++a)
#pragma unroll
            for (int b = 0; b < 2; ++b)
#pragma unroll
                for (int m = 0; m < 4; ++m)
#pragma unroll
                    for (int n = 0; n < 2; ++n) acc[a][b][m][n] = (f32x4){0.f, 0.f, 0.f, 0.f};
        cur = nxt; cA = nA; cB = nB; ++ui;
        if constexpr (ALIGN_EPI) { if (wr == 1) PG8_BAR; }
    }
    PG8_WAIT_V(0);
    if constexpr (!ALIGN_EPI) { if (wr == 0) PG8_BAR; }
    PG8_BAR;
    if constexpr (Epi::AFTER_DRAIN) { E.fused(acc, cur, wr, wc, fr, fq, lds, wid, lane); S.done(cur); }
#undef PG8_SA
#undef PG8_SB
#undef PG8_STAGE
#undef PG8_LDA
#undef PG8_LDB
#undef PG8_MMA
#undef PG8_WAIT_V
#undef PG8_WAIT_L
#undef PG8_BAR
#undef PG8_SCHED
}
}
struct PEpiBf16 {
    static constexpr bool PERM = true, AFTER_DRAIN = false;
    bf16_t* O; int ldo;
    __device__ __forceinline__ void operator()(const pg8::f32x4 (&acc)[2][2][4][2], const pg8::Unit& u, int wr, int wc, int fr, int fq) const {
        const int row0 = u.pm * 256 + wr * 64 + fr, col0 = u.pn * 256 + wc * 32 + 8 * fq;
#pragma unroll
        for (int ai = 0; ai < 2; ++ai)
#pragma unroll
            for (int m = 0; m < 4; ++m) {
                bf16_t* rowp = O + (size_t)(row0 + ai * 128 + m * 16) * ldo + col0;
#pragma unroll
                for (int bj = 0; bj < 2; ++bj) {
                    const pg8::f32x4 v0 = acc[ai][bj][m][0], v1 = acc[ai][bj][m][1];
                    uint4 w; w.x = pack2(v0[0], v0[1]); w.y = pack2(v0[2], v0[3]); w.z = pack2(v1[0], v1[1]); w.w = pack2(v1[2], v1[3]);
                    *reinterpret_cast<uint4*>(rowp + bj * 128) = w;
                }
            }
    }
};
template <bool PREV_BF16>
struct PEpiOut {
    static constexpr bool PERM = true, AFTER_DRAIN = false;
    const float* Xprev; const bf16_t* XprevB; bf16_t* T;
    __device__ __forceinline__ void operator()(const pg8::f32x4 (&acc)[2][2][4][2], const pg8::Unit& u, int wr, int wc, int fr, int fq) const {
        const int row0 = u.pm * 256 + wr * 64 + fr, col0 = u.pn * 256 + wc * 32 + 8 * fq;
#pragma unroll
        for (int ai = 0; ai < 2; ++ai)
#pragma unroll
            for (int m = 0; m < 4; ++m) {
                const size_t ro = (size_t)(row0 + ai * 128 + m * 16) * DM + col0;
#pragma unroll
                for (int bj = 0; bj < 2; ++bj) {
                    const size_t o = ro + bj * 128;
                    float xp[8];
                    if (PREV_BF16) {
                        unpack8(*reinterpret_cast<const uint4*>(XprevB + o), xp);
                    } else {
                        const float4 a = *reinterpret_cast<const float4*>(Xprev + o), b = *reinterpret_cast<const float4*>(Xprev + o + 4);
                        xp[0] = a.x; xp[1] = a.y; xp[2] = a.z; xp[3] = a.w; xp[4] = b.x; xp[5] = b.y; xp[6] = b.z; xp[7] = b.w;
                    }
                    const pg8::f32x4 v0 = acc[ai][bj][m][0], v1 = acc[ai][bj][m][1];
                    uint4 w;
                    w.x = pack2(ALPHA_F * xp[0] + v0[0], ALPHA_F * xp[1] + v0[1]); w.y = pack2(ALPHA_F * xp[2] + v0[2], ALPHA_F * xp[3] + v0[3]);
                    w.z = pack2(ALPHA_F * xp[4] + v1[0], ALPHA_F * xp[5] + v1[1]); w.w = pack2(ALPHA_F * xp[6] + v1[2], ALPHA_F * xp[7] + v1[3]);
                    *reinterpret_cast<uint4*>(T + o) = w;
                }
            }
    }
};
template <class Epi>
__device__ __forceinline__ void big_gemm(const bf16_t* A, const bf16_t* Bt, int M, int N, int K, const Epi& e, unsigned char* smem, int wave) {
    pg8::Gemm g{A, Bt, M, N, K};
    pg8::StaticOrder S;
    S.init(M, N, ogdim(), obid());
    pg8::gemm_phase<Epi, pg8::StaticOrder, true, true>((PG8_LAS unsigned char*)smem, g, S, e, wave);
}

__device__ __forceinline__ void tconv_wave(const float* __restrict__ src, int N, bf16_t* __restrict__ dst, int ldd, int k0, int n0,
                                           int mode, float* tile, int lane) {
#pragma unroll
    for (int i = 0; i < 8; ++i) {
        const int r = i * 8 + (lane >> 3), c4 = (lane & 7) * 4;
        const float4 v = *reinterpret_cast<const float4*>(src + (size_t)(k0 + r) * N + n0 + c4);
        tile[r * 33 + c4] = v.x; tile[r * 33 + c4 + 1] = v.y; tile[r * 33 + c4 + 2] = v.z; tile[r * 33 + c4 + 3] = v.w;
    }
    asm volatile("s_waitcnt lgkmcnt(0)" ::: "memory");
#pragma unroll 8
    for (int nn = 0; nn < 32; ++nn) {
        const int n = n0 + nn;
        int drow = n;
        if (mode == 1) drow = (n >> 4) * 32 + (n & 15);
        else if (mode == 2) drow = (n >> 4) * 32 + 16 + (n & 15);
        dst[(size_t)drow * ldd + k0 + lane] = f2bf(tile[lane * 33 + nn]);
    }
    asm volatile("s_waitcnt lgkmcnt(0)" ::: "memory");
}

__device__ __forceinline__ void phase_pre(const Params& p, unsigned char* smem, int part, int bid, int nb) {
    const int tidx = otid(p.wave);
    const int wv = tidx >> 6, lane = tidx & 63;
    float* tile = reinterpret_cast<float*>(smem) + wv * (64 * 33);
    bf16_t* W = reinterpret_cast<bf16_t*>(p.ws + OFF_W);
    constexpr int T0 = 1152, T1 = 512, T7 = 16, T8 = 16, T9 = 32, T10 = 32;
    constexpr int T2 = 1536, T3 = 512, T4 = 4096, T5 = 4096, T6 = 4096;
    if (part == 0) {
        if (bid == 0) {
            if (tidx < 64) reinterpret_cast<int*>(p.ws + OFF_CTRL)[tidx] = 0;
            unsigned* bar = reinterpret_cast<unsigned*>(p.ws + OFF_CTRL + 4096);
            for (int i = tidx; i < XCD_BAR_WORDS; i += NTHREADS) bar[i] = 0u;
        }
        constexpr int TOT = T0 + T1 + T7 + T8 + T9 + T10;
        for (int u = bid * NWAVES + wv; u < TOT; u += nb * NWAVES) {
            int v = u;
            const float* src; bf16_t* dst; int K, N, tk, tn;
            if (v < T0) { src = p.in[1]; K = 1024; N = 2304; dst = W + WE_IN0; tk = v / 72; tn = v % 72; }
            else if ((v -= T0) < T1) { src = p.in[15]; K = 1024; N = 1024; dst = W + WE_OUT0; tk = v / 32; tn = v % 32; }
            else if ((v -= T1) < T7) { src = p.in[4]; K = 64; N = 512; dst = W + WE_LW2; tk = 0; tn = v; }
            else if ((v -= T7) < T8) { src = p.in[6]; K = 64; N = 512; dst = W + WE_LA2; tk = 0; tn = v; }
            else if ((v -= T8) < T9) { src = p.in[7]; K = 128; N = 512; dst = W + WE_LG2; tk = v >> 4; tn = v & 15; }
            else { v -= T9; int mat = v >> 3, w = v & 7; src = p.in[13] + (size_t)mat * 16384; K = 128; N = 128; dst = W + WE_POOL + (size_t)mat * 16384; tk = w >> 2; tn = w & 3; }
            tconv_wave(src, N, dst, K, tk * 64, tn * 32, 0, tile, lane);
        }
        const float4* x4 = reinterpret_cast<const float4*>(p.in[0]);
        uint2* xb = reinterpret_cast<uint2*>(p.ws + OFF_ACTB);
        const size_t n4 = (size_t)NT * DM / 4;
        const size_t stride = (size_t)nb * NTHREADS;
        for (size_t i = (size_t)bid * NTHREADS + tidx; i < n4; i += 8 * stride) {
            float4 v[8];
#pragma unroll
            for (int j = 0; j < 8; ++j) if (i + j * stride < n4) v[j] = x4[i + j * stride];
#pragma unroll
            for (int j = 0; j < 8; ++j) if (i + j * stride < n4) {
                uint2 w; w.x = pack2(v[j].x, v[j].y); w.y = pack2(v[j].z, v[j].w);
                xb[i + j * stride] = w;
            }
        }
    } else {
        constexpr int TOT = T2 + T3 + T4 + T5 + T6;
        for (int u = bid * NWAVES + wv; u < TOT; u += nb * NWAVES) {
            int v = u;
            const float* src; bf16_t* dst; int K, N, mode = 0, tk, tn;
            if (v < T2) { src = p.in[16]; K = 1024; N = 3072; dst = W + WE_IN1; tk = v / 96; tn = v % 96; }
            else if ((v -= T2) < T3) { src = p.in[23]; K = 1024; N = 1024; dst = W + WE_OUT1; tk = v / 32; tn = v % 32; }
            else if ((v -= T3) < T4) { int mat = v >> 6, w = v & 63; src = p.in[30] + (size_t)mat * 131072; K = 1024; N = 128; dst = W + WE_W13 + (size_t)mat * 262144; mode = 1; tk = w >> 2; tn = w & 3; }
            else if ((v -= T4) < T5) { int mat = v >> 6, w = v & 63; src = p.in[31] + (size_t)mat * 131072; K = 1024; N = 128; dst = W + WE_W13 + (size_t)mat * 262144; mode = 2; tk = w >> 2; tn = w & 3; }
            else { v -= T5; int mat = v >> 6, w = v & 63; src = p.in[32] + (size_t)mat * 131072; K = 128; N = 1024; dst = W + WE_W2 + (size_t)mat * 131072; tk = w >> 5; tn = w & 31; }
            tconv_wave(src, N, dst, K, tk * 64, tn * 32, mode, tile, lane);
        }
        {
            bf16_t* RH = W + WE_RT_HI; bf16_t* RL = W + WE_RT_LO;
            for (int i = bid * NTHREADS + tidx; i < 2 * 48 * 1024; i += nb * NTHREADS) {
                const int l = i / (48 * 1024), r = i - l * 48 * 1024, n = r >> 10, k = r & 1023;
                float w = 0.f;
                if (n < 4) w = p.in[26][((size_t)l * 1024 + k) * 4 + n];
                else if (n < 36) w = p.in[28][((size_t)l * 1024 + k) * 32 + (n - 4)];
                const bf16_t h = f2bf(w);
                RH[i] = h; RL[i] = f2bf(w - bf2f(h));
            }
        }
        {
            float2* rope = reinterpret_cast<float2*>(p.ws + OFF_ROPE);
            for (int i = bid * NTHREADS + tidx; i < SEQ * 32; i += nb * NTHREADS) {
                int pos = i >> 5, k = i & 31;
                float inv = powf(10000.0f, -(float)k / 32.0f);
                float ang = (float)pos * inv;
                const double a = (double)ang;
                const double q = rint(a * 0.15915494309189535);
                const float rr = (float)(a - q * 6.283185307179586);
                float s, c;
                sincosf(rr, &s, &c);
                rope[i] = make_float2(c, s);
            }
        }
    }
}

__device__ __forceinline__ void phase_l0_prep(const Params& p) {
    const int tidx = otid(p.wave);
    const bf16_t* P = reinterpret_cast<const bf16_t*>(p.ws + OFF_P);
    bf16_t* LA = reinterpret_cast<bf16_t*>(p.ws + OFF_LORA);
    bf16_t* PO = reinterpret_cast<bf16_t*>(p.ws + OFF_POOLED);
    const float* mu = p.in[2];
    const int total = NT * 96;
    for (int it = obid() * NTHREADS + tidx; it < total; it += ogdim() * NTHREADS) {
        const int tok = it / 96, j = it - tok * 96;
        const int s = tok & (SEQ - 1);
        if (j < 32) {
            const int col = 1536 + j * 8;
            float cur[8], prv[8];
            unpack8(*reinterpret_cast<const uint4*>(P + (size_t)tok * 2304 + col), cur);
            if (s > 0) unpack8(*reinterpret_cast<const uint4*>(P + (size_t)(tok - 1) * 2304 + col), prv);
            else {
#pragma unroll
                for (int i = 0; i < 8; ++i) prv[i] = 0.f;
            }
            const float4 m0 = *reinterpret_cast<const float4*>(mu + col), m1 = *reinterpret_cast<const float4*>(mu + col + 4);
            const float mm[8] = {m0.x, m0.y, m0.z, m0.w, m1.x, m1.y, m1.z, m1.w};
            float o[8];
#pragma unroll
            for (int i = 0; i < 8; ++i) {
                const float z = cur[i] + mm[i] * (prv[i] - cur[i]);
                o[i] = (j < 8) ? tanhf(z) : ((j < 16) ? z : sigmoidf_(z));
            }
            uint4 w; w.x = pack2(o[0], o[1]); w.y = pack2(o[2], o[3]); w.z = pack2(o[4], o[5]); w.w = pack2(o[6], o[7]);
            *reinterpret_cast<uint4*>(LA + (size_t)tok * 256 + j * 8) = w;
        } else {
            const int cc = (j - 32) * 8;
            const int gi = cc >> 7;
            const int win = 2 << gi;
            const int cnt = (s + 1 < win) ? (s + 1) : win;
            const bf16_t* src = P + (size_t)tok * 2304 + 1792 + cc;
            float u[8], sum[8];
            uint4 rows[16];
#pragma unroll
            for (int r = 0; r < 16; ++r) {
                rows[r] = make_uint4(0u, 0u, 0u, 0u);
                if (r < cnt) rows[r] = *reinterpret_cast<const uint4*>(src - (size_t)r * 2304);
            }
            unpack8(rows[0], u);
#pragma unroll
            for (int i = 0; i < 8; ++i) sum[i] = u[i];
#pragma unroll
            for (int r = 1; r < 16; ++r) {
                float t[8];
                unpack8(rows[r], t);
#pragma unroll
                for (int i = 0; i < 8; ++i) sum[i] += t[i];
            }
            const float inv = 1.0f / (float)cnt;
            uint4 w;
            w.x = pack2(sum[0] * inv - u[0], sum[1] * inv - u[1]); w.y = pack2(sum[2] * inv - u[2], sum[3] * inv - u[3]);
            w.z = pack2(sum[4] * inv - u[4], sum[5] * inv - u[5]); w.w = pack2(sum[6] * inv - u[6], sum[7] * inv - u[7]);
            *reinterpret_cast<uint4*>(PO + (size_t)tok * 512 + cc) = w;
        }
    }
}

__device__ __forceinline__ void phase_l0_lora(const Params& p, bf16_t* smem) {
    const bf16_t* W = reinterpret_cast<const bf16_t*>(p.ws + OFF_W);
    const bf16_t* LA = reinterpret_cast<const bf16_t*>(p.ws + OFF_LORA);
    const bf16_t* PO = reinterpret_cast<const bf16_t*>(p.ws + OFF_POOLED);
    for (int t = obid(); t < 2048; t += ogdim()) {
        int job = t >> 9, w = t & 511;
        if (job == 0) {
            EpiLora<0> e{nullptr, reinterpret_cast<bf16_t*>(p.ws + OFF_LOGW), p.in[3], 512, 0};
            gemm_tile<false>(LA, 256, nullptr, 0, W + WE_LW2, 64, 64, (w >> 2) * 256, (w & 3) * 128, e, smem, p.wave);
        } else if (job == 1) {
            EpiLora<1> e{nullptr, reinterpret_cast<bf16_t*>(p.ws + OFF_AA), p.in[5], 512, 0};
            gemm_tile<false>(LA + 64, 256, nullptr, 0, W + WE_LA2, 64, 64, (w >> 2) * 256, (w & 3) * 128, e, smem, p.wave);
        } else if (job == 2) {
            EpiLora<2> e{nullptr, reinterpret_cast<bf16_t*>(p.ws + OFF_GG), nullptr, 512, 0};
            gemm_tile<false>(LA + 128, 256, nullptr, 0, W + WE_LG2, 128, 128, (w >> 2) * 256, (w & 3) * 128, e, smem, p.wave);
        } else {
            int g = w & 3, tm = w >> 2;
            EpiLora<3> e{nullptr, reinterpret_cast<bf16_t*>(p.ws + OFF_YCAT), p.in[14] - 512, 1024, 512 + g * 128};
            gemm_tile<false>(PO + g * 128, 512, nullptr, 0, W + WE_POOL + g * 16384, 128, 128, tm * 256, 0, e, smem, p.wave);
        }
    }
}

#define RC_LD 72
#define RC_BUF (64 * RC_LD)
#define RC_BYTES (RC_BUF * 2)
#define OFF_TBUF OFF_KVT

__device__ __forceinline__ void mm64(f32x4 (&acc)[2], const bf16_t* A, const bf16_t* Bt, int mt, int nt0, int fr, int fq) {
#pragma unroll
    for (int ks = 0; ks < 2; ++ks) {
        bf16x8 af = *reinterpret_cast<const bf16x8*>(A + (mt * 16 + fr) * RC_LD + ks * 32 + fq * 8);
        bf16x8 bq[2];
#pragma unroll
        for (int n = 0; n < 2; ++n) bq[n] = *reinterpret_cast<const bf16x8*>(Bt + ((nt0 + n) * 16 + fr) * RC_LD + ks * 32 + fq * 8);
#pragma unroll
        for (int n = 0; n < 2; ++n) acc[n] = __builtin_amdgcn_mfma_f32_16x16x32_bf16(af, bq[n], acc[n], 0, 0, 0);
    }
}
template <int MASK>
__device__ __forceinline__ void store_T(bf16_t* dst, const f32x4 (&acc)[2], int mt, int nt0, int fr, int fq) {
#pragma unroll
    for (int n = 0; n < 2; ++n) {
        const int C = (nt0 + n) * 16 + fr, R0 = mt * 16 + fq * 4;
        float v[4];
#pragma unroll
        for (int j = 0; j < 4; ++j) {
            const int R = R0 + j;
            bool keep = true;
            if (MASK == 1) keep = R < C;
            else if (MASK == 2) keep = R <= C;
            else if (MASK == 3) keep = C < R;
            v[j] = keep ? acc[n][j] : 0.f;
        }
        uint2 w; w.x = pack2(v[0], v[1]); w.y = pack2(v[2], v[3]);
        *reinterpret_cast<uint2*>(dst + C * RC_LD + R0) = w;
    }
}
__device__ __forceinline__ void zero_acc(f32x4 (&acc)[2]) {
    acc[0] = (f32x4){0.f, 0.f, 0.f, 0.f};
    acc[1] = (f32x4){0.f, 0.f, 0.f, 0.f};
}

#define OFF_NTB (OFF_P + 144ull * MIB)
#define OFF_S0A (OFF_P + 176ull * MIB)
#define OFF_TB (420ull * MIB)
#define OFF_MB (452ull * MIB)
#define OFF_S0B (484ull * MIB)
#define OFF_WLB (500ull * MIB)
#define OFF_BCB (501ull * MIB)
__device__ __forceinline__ bf16_t* s0_ptr(unsigned char* ws, int u) {
    return reinterpret_cast<bf16_t*>(ws + (u < 2048 ? OFF_S0A : OFF_S0B)) + (size_t)(u & 2047) * 4096;
}

struct PrepIn {
    unsigned short k[8], v[8], r[8], lw[8], a[8];
    unsigned short pk, pv, pr;
};
template <int MODE>
__device__ __forceinline__ void prep_load(PrepIn& in, const Params& p, int u, int tid) {
    const int b = u >> 10, h = (u >> 7) & 7, n = u & 127;
    const int lane = tid & 63, q = tid >> 6;
    const int c = h * 64 + lane;
    const bf16_t* P = reinterpret_cast<const bf16_t*>(p.ws + OFF_P);
    const bf16_t* LOGW = reinterpret_cast<const bf16_t*>(p.ws + OFF_LOGW);
    const bf16_t* AA = reinterpret_cast<const bf16_t*>(p.ws + OFF_AA);
    const int s0 = n * 64 + q * 8;
    const size_t tok0 = (size_t)b * SEQ + s0;
    in.pk = 0; in.pv = 0; in.pr = 0;
    if (s0 > 0) {
        const bf16_t* pp = P + (tok0 - 1) * 2304;
        in.pk = pp[512 + c]; in.pv = pp[1024 + c];
        in.pr = pp[c];
    }
#pragma unroll
    for (int i = 0; i < 8; ++i) {
        const bf16_t* pp = P + (tok0 + i) * 2304;
        in.k[i] = pp[512 + c]; in.v[i] = pp[1024 + c];
        in.r[i] = pp[c];
        in.lw[i] = LOGW[(tok0 + i) * 512 + c];
        in.a[i] = AA[(tok0 + i) * 512 + c];
    }
}
struct PrepC { float mu_k, kkc, kac, mu_v, mu_r, rkc, lng, lnb; };
template <int MODE>
__device__ __forceinline__ PrepC prep_consts(const Params& p, int h, int lane) {
    PrepC c_;
    const int c = h * 64 + lane;
    c_.mu_k = p.in[2][512 + c]; c_.kkc = p.in[8][c]; c_.kac = p.in[9][c]; c_.mu_v = p.in[2][1024 + c];
    c_.mu_r = 0.f; c_.rkc = 0.f; c_.lng = 0.f; c_.lnb = 0.f;
    c_.mu_r = p.in[2][c]; c_.rkc = p.in[10][c];
    if (MODE == 2) { c_.lng = p.in[11][c]; c_.lnb = p.in[12][c]; }
    return c_;
}
template <int MODE>
__device__ __forceinline__ void rwkv_prep(const PrepIn& in, const PrepC& pc, int tid, bf16_t* At, bf16_t* Bt, bf16_t* Kt, bf16_t* Rt,
                                          bf16_t* AtT, bf16_t* BtT, bf16_t* KtT, bf16_t* VT, float* sTot, float* sBC, float* sWL) {
    const int lane = tid & 63, q = tid >> 6;
    const float mu_k = pc.mu_k, kkc = pc.kkc, kac = pc.kac, mu_v = pc.mu_v, mu_r = pc.mu_r, rkc = pc.rkc;
    float lw[8], av[8], zk[8], zr[8], zv[8];
    float pk = bf2f(in.pk), pr = bf2f(in.pr), pv = bf2f(in.pv);
#pragma unroll
    for (int i = 0; i < 8; ++i) {
        const float k0 = bf2f(in.k[i]), v0 = bf2f(in.v[i]);
        zk[i] = k0 + mu_k * (pk - k0); pk = k0;
        zv[i] = v0 + mu_v * (pv - v0); pv = v0;
        { const float r0 = bf2f(in.r[i]); zr[i] = r0 + mu_r * (pr - r0); pr = r0; }
        lw[i] = bf2f(in.lw[i]);
        av[i] = bf2f(in.a[i]);
    }
    float lws[8];
    float cs = 0.f;
#pragma unroll
    for (int i = 0; i < 8; ++i) { cs += lw[i]; lws[i] = cs; }
    sTot[q * 64 + lane] = cs;
    lds_barrier();
    float off = 0.f, tot = 0.f;
#pragma unroll
    for (int qq = 0; qq < 8; ++qq) { float tq = sTot[qq * 64 + lane]; if (qq < q) off += tq; tot += tq; }
    float atv[8], btv[8], ktv[8];
#pragma unroll
    for (int i = 0; i < 8; ++i) {
        const int t = q * 8 + i;
        const float L = lws[i] + off;
        float kk = zk[i] * kkc;
        float ss = wave_sum(kk * kk);
        kk *= rsqrtf(fmaxf(ss, 1e-24f));
        const float e_neg = __expf(-L), e_prev = __expf(L - lw[i]);
        const float a = av[i];
        const float at = -kk * e_prev;
        At[t * RC_LD + lane] = f2bf(at);
        const float bt = kk * a * e_neg;
        Bt[t * RC_LD + lane] = f2bf(bt);
        const float kp = zk[i] * (1.0f + (a - 1.0f) * kac);
        const float kt = kp * e_neg;
        Kt[t * RC_LD + lane] = f2bf(kt);
        atv[i] = at; btv[i] = bt; ktv[i] = kt;
        {
            Rt[t * RC_LD + lane] = f2bf(zr[i] * __expf(L));
            const float bc = wave_sum(zr[i] * kp * rkc);
            if (lane == 0) sBC[t] = bc;
        }
    }
    uint4 w0;
    if (MODE == 1) {
        w0.x = pack2(atv[0], atv[1]); w0.y = pack2(atv[2], atv[3]); w0.z = pack2(atv[4], atv[5]); w0.w = pack2(atv[6], atv[7]);
        *reinterpret_cast<uint4*>(AtT + lane * RC_LD + q * 8) = w0;
        w0.x = pack2(btv[0], btv[1]); w0.y = pack2(btv[2], btv[3]); w0.z = pack2(btv[4], btv[5]); w0.w = pack2(btv[6], btv[7]);
        *reinterpret_cast<uint4*>(BtT + lane * RC_LD + q * 8) = w0;
        w0.x = pack2(ktv[0], ktv[1]); w0.y = pack2(ktv[2], ktv[3]); w0.z = pack2(ktv[4], ktv[5]); w0.w = pack2(ktv[6], ktv[7]);
        *reinterpret_cast<uint4*>(KtT + lane * RC_LD + q * 8) = w0;
        if (q == 0) sWL[lane] = __expf(tot);
    }
    w0.x = pack2(zv[0], zv[1]); w0.y = pack2(zv[2], zv[3]); w0.z = pack2(zv[4], zv[5]); w0.w = pack2(zv[6], zv[7]);
    *reinterpret_cast<uint4*>(VT + lane * RC_LD + q * 8) = w0;
}

__device__ __forceinline__ void phase_rwkv_r1(const Params& p, unsigned char* smem) {
    const int tidx = otid(p.wave);
    const int tid = tidx, wv = tid >> 6, lane = tid & 63, fr = lane & 15, fq = lane >> 4, mt = wv >> 1, nt0 = (wv & 1) * 2;
    bf16_t* base = reinterpret_cast<bf16_t*>(smem);
    bf16_t* At = base; bf16_t* Bt = base + RC_BUF; bf16_t* Kt = base + 2 * RC_BUF; bf16_t* AtT = base + 3 * RC_BUF;
    bf16_t* BtT = base + 4 * RC_BUF; bf16_t* KtT = base + 5 * RC_BUF; bf16_t* VT = base + 6 * RC_BUF;
    bf16_t* Tm = base + 7 * RC_BUF; bf16_t* Aak = base + 8 * RC_BUF; bf16_t* PT = base + 9 * RC_BUF;
    bf16_t* AkVT = base + 10 * RC_BUF; bf16_t* QT = base + 11 * RC_BUF; bf16_t* Arb = base + 12 * RC_BUF;
    bf16_t* Rt = base + 13 * RC_BUF; bf16_t* Ark = base + 14 * RC_BUF;
    float* sTot = reinterpret_cast<float*>(smem + 15 * RC_BYTES);
    float* sWL = sTot + 512;
    float* sBC = sWL + 64;
    bf16_t* PRg = reinterpret_cast<bf16_t*>(p.ws + OFF_AA);
    bf16_t* YQg = reinterpret_cast<bf16_t*>(p.ws + OFF_LOGW);
    float* BCg = reinterpret_cast<float*>(p.ws + OFF_BCB);
    bf16_t* Mg = reinterpret_cast<bf16_t*>(p.ws + OFF_MB);
    bf16_t* Ng = reinterpret_cast<bf16_t*>(p.ws + OFF_NTB);
    float* WLg = reinterpret_cast<float*>(p.ws + OFF_WLB);
    PrepIn cur, nxt;
    if (obid() < 4096) prep_load<1>(cur, p, obid(), tid);
    nxt = cur;
    for (int u = obid(); u < 4096; u += ogdim()) {
        const int h = (u >> 7) & 7, b = u >> 10, n = u & 127;
        PrepC pc = prep_consts<1>(p, h, lane);
        asm volatile("" : "+v"(pc.mu_k), "+v"(pc.kkc), "+v"(pc.kac), "+v"(pc.mu_v), "+v"(pc.mu_r), "+v"(pc.rkc));
        if (u + ogdim() < 4096) prep_load<1>(nxt, p, u + ogdim(), tid);
        bf16_t* R0 = base + 7 * RC_BUF; bf16_t* C0 = base + 8 * RC_BUF; bf16_t* R1 = base + 9 * RC_BUF; bf16_t* C1 = base + 10 * RC_BUF;
        bf16_t* Pm0 = base + 11 * RC_BUF; bf16_t* Pm1 = base + 12 * RC_BUF;
        rwkv_prep<1>(cur, pc, tid, At, Bt, Kt, Rt, AtT, BtT, KtT, VT, sTot, sBC, sWL);
        lds_barrier();
        f32x4 pacc[2];
        {
            f32x4 acc[2];
            zero_acc(acc);
            mm64(acc, At, Bt, mt, nt0, fr, fq);
            store_T<3>(C0, acc, mt, nt0, fr, fq);
            zero_acc(pacc);
            mm64(pacc, Bt, At, mt, nt0, fr, fq);
#pragma unroll
            for (int nn = 0; nn < 2; ++nn)
#pragma unroll
                for (int j = 0; j < 4; ++j) {
                    const int R = mt * 16 + fq * 4 + j, C = (nt0 + nn) * 16 + fr;
                    pacc[nn][j] = (R < C) ? pacc[nn][j] : 0.f;
                }
            store_T<0>(R0, pacc, mt, nt0, fr, fq);
#pragma unroll
            for (int nn = 0; nn < 2; ++nn)
#pragma unroll
                for (int j = 0; j < 4; ++j) {
                    const int R = mt * 16 + fq * 4 + j, C = (nt0 + nn) * 16 + fr;
                    if (R == C) pacc[nn][j] += 1.0f;
                }
            store_T<0>(Pm0, pacc, mt, nt0, fr, fq);
        }
        lds_barrier();
#pragma unroll 1
        for (int j = 1; j <= 5; ++j) {
            f32x4 acc[2];
            if (j < 5) {
                zero_acc(acc);
                mm64(acc, C0, R0, mt, nt0, fr, fq);
                store_T<0>(R1, acc, mt, nt0, fr, fq);
            }
            zero_acc(acc);
            mm64(acc, R0, C0, mt, nt0, fr, fq);
            store_T<0>(C1, acc, mt, nt0, fr, fq);
            lds_barrier();
            zero_acc(acc);
            mm64(acc, C1, Pm0, mt, nt0, fr, fq);
            pacc[0] += acc[0]; pacc[1] += acc[1];
            if (j < 5) store_T<0>(Pm1, pacc, mt, nt0, fr, fq);
            lds_barrier();
            bf16_t* t0 = R0; R0 = R1; R1 = t0;
            t0 = C0; C0 = C1; C1 = t0;
            t0 = Pm0; Pm0 = Pm1; Pm1 = t0;
        }
        store_T<0>(Tm, pacc, mt, nt0, fr, fq);
        {
            f32x4 acc[2];
            zero_acc(acc); mm64(acc, Kt, At, mt, nt0, fr, fq); store_T<1>(Aak, acc, mt, nt0, fr, fq);
            zero_acc(acc); mm64(acc, Bt, Rt, mt, nt0, fr, fq); store_T<2>(Arb, acc, mt, nt0, fr, fq);
            zero_acc(acc); mm64(acc, Kt, Rt, mt, nt0, fr, fq); store_T<2>(Ark, acc, mt, nt0, fr, fq);
        }
        lds_barrier();
        {
            f32x4 acc[2];
            zero_acc(acc); mm64(acc, Tm, AtT, mt, nt0, fr, fq); store_T<0>(PT, acc, mt, nt0, fr, fq);
            zero_acc(acc); mm64(acc, Aak, VT, mt, nt0, fr, fq); store_T<0>(AkVT, acc, mt, nt0, fr, fq);
        }
        lds_barrier();
        {
            f32x4 acc[2];
            zero_acc(acc); mm64(acc, Tm, AkVT, mt, nt0, fr, fq); store_T<0>(QT, acc, mt, nt0, fr, fq);
            zero_acc(acc); mm64(acc, PT, BtT, mt, nt0, fr, fq);
            bf16_t* Mo = Mg + (size_t)u * 4096;
#pragma unroll
            for (int nn = 0; nn < 2; ++nn) {
                const int C = (nt0 + nn) * 16 + fr, Rb = mt * 16 + fq * 4;
                const float wl = sWL[C];
                uint2 w; w.x = pack2(acc[nn][0] * wl, acc[nn][1] * wl); w.y = pack2(acc[nn][2] * wl, acc[nn][3] * wl);
                const int pos = (Rb & ~12) | ((Rb & 4) << 1) | ((Rb & 8) >> 1);
                const int posw = ((((pos >> 3) ^ (C & 7)) << 3) | (pos & 7));
                *reinterpret_cast<uint2*>(Mo + C * 64 + posw) = w;
            }
        }
        lds_barrier();
        {
            f32x4 acc[2];
            zero_acc(acc); mm64(acc, BtT, QT, mt, nt0, fr, fq); mm64(acc, KtT, VT, mt, nt0, fr, fq);
            bf16_t* No = Ng + (size_t)u * 4096;
            float wl[4];
#pragma unroll
            for (int j = 0; j < 4; ++j) wl[j] = sWL[mt * 16 + fq * 4 + j];
#pragma unroll
            for (int nn = 0; nn < 2; ++nn) {
                const int C = (nt0 + nn) * 16 + fr, Rb = mt * 16 + fq * 4;
                uint2 w; w.x = pack2(acc[nn][0] * wl[0], acc[nn][1] * wl[1]); w.y = pack2(acc[nn][2] * wl[2], acc[nn][3] * wl[3]);
                const int posw = ((((Rb >> 3) ^ (C & 7)) << 3) | (Rb & 7));
                *reinterpret_cast<uint2*>(No + C * 64 + posw) = w;
            }
            if (tid < 64) { WLg[(size_t)u * 64 + tid] = sWL[tid]; BCg[(size_t)u * 64 + tid] = sBC[tid]; }
            const size_t tok0 = (size_t)b * SEQ + n * 64;
            zero_acc(acc); mm64(acc, PT, Arb, mt, nt0, fr, fq);
#pragma unroll
            for (int nn = 0; nn < 2; ++nn) {
                const int C = (nt0 + nn) * 16 + fr, Rb = mt * 16 + fq * 4;
                const uint2 rt = *reinterpret_cast<const uint2*>(Rt + C * RC_LD + Rb);
                uint2 w;
                w.x = pack2(acc[nn][0] + __uint_as_float(rt.x << 16), acc[nn][1] + __uint_as_float(rt.x & 0xffff0000u));
                w.y = pack2(acc[nn][2] + __uint_as_float(rt.y << 16), acc[nn][3] + __uint_as_float(rt.y & 0xffff0000u));
                *reinterpret_cast<uint2*>(PRg + (tok0 + C) * 512 + h * 64 + Rb) = w;
            }
            zero_acc(acc); mm64(acc, QT, Arb, mt, nt0, fr, fq); mm64(acc, VT, Ark, mt, nt0, fr, fq);
#pragma unroll
            for (int nn = 0; nn < 2; ++nn) {
                const int C = (nt0 + nn) * 16 + fr, Rb = mt * 16 + fq * 4;
                uint2 w; w.x = pack2(acc[nn][0], acc[nn][1]); w.y = pack2(acc[nn][2], acc[nn][3]);
                *reinterpret_cast<uint2*>(YQg + (tok0 + C) * 512 + h * 64 + Rb) = w;
            }
        }
        cur = nxt;
        lds_barrier();
    }
}

typedef float f32x16 __attribute__((ext_vector_type(16)));
#define R2_SLOT 12800
__device__ __forceinline__ void r2_issue(const unsigned char* Mg, const unsigned char* Ng, const unsigned char* WLg, size_t u, int J, int lane,
                                         unsigned char* slot) {
#pragma unroll
    for (int i = 0; i < 8; ++i)
        __builtin_amdgcn_global_load_lds((const unsigned*)(Mg + u * 8192 + i * 1024 + lane * 16),
                                         (__attribute__((address_space(3))) unsigned*)(slot + i * 1024), 16, 0, 0);
#pragma unroll
    for (int i = 0; i < 4; ++i)
        __builtin_amdgcn_global_load_lds((const unsigned*)(Ng + u * 8192 + J * 4096 + i * 1024 + lane * 16),
                                         (__attribute__((address_space(3))) unsigned*)(slot + 8192 + i * 1024), 16, 0, 0);
    __builtin_amdgcn_global_load_lds((const unsigned*)(WLg + u * 256 + lane * 4),
                                     (__attribute__((address_space(3))) unsigned*)(slot + 12288), 4, 0, 0);
}
template <int WAITN>
__device__ __forceinline__ void r2_chunk(f32x16 (&S)[2], const unsigned char* slot, bf16_t* so, int r, int h) {
    unsigned pk[2][8];
#pragma unroll
    for (int K = 0; K < 2; ++K)
#pragma unroll
        for (int q = 0; q < 8; ++q) pk[K][q] = pack2(S[K][2 * q], S[K][2 * q + 1]);
#pragma unroll
    for (int I = 0; I < 2; ++I) {
        uint4 w0, w1;
        w0.x = pk[I][0]; w0.y = pk[I][1]; w0.z = pk[I][2]; w0.w = pk[I][3];
        w1.x = pk[I][4]; w1.y = pk[I][5]; w1.z = pk[I][6]; w1.w = pk[I][7];
        *reinterpret_cast<uint4*>(so + r * 64 + I * 32 + h * 16) = w0;
        *reinterpret_cast<uint4*>(so + r * 64 + I * 32 + h * 16 + 8) = w1;
    }
    if (WAITN == 51) asm volatile("s_waitcnt vmcnt(51)" ::: "memory");
    else if (WAITN == 39) asm volatile("s_waitcnt vmcnt(39)" ::: "memory");
    else asm volatile("s_waitcnt vmcnt(0)" ::: "memory");
    bf16x8 bfrag[2][2];
#pragma unroll
    for (int K = 0; K < 2; ++K)
#pragma unroll
        for (int s = 0; s < 2; ++s) {
            union { bf16x8 v; unsigned u[4]; } cvt;
#pragma unroll
            for (int q = 0; q < 4; ++q) cvt.u[q] = pk[K][4 * s + q];
            bfrag[K][s] = cvt.v;
        }
#pragma unroll
    for (int I = 0; I < 2; ++I) {
        const int k = I * 32 + r;
        bf16x8 af[2][2];
#pragma unroll
        for (int K = 0; K < 2; ++K)
#pragma unroll
            for (int s = 0; s < 2; ++s)
                af[K][s] = *reinterpret_cast<const bf16x8*>(slot + k * 128 + (((K * 4 + s * 2 + h) ^ (r & 7)) * 16));
        f32x16 acc;
#pragma unroll
        for (int g = 0; g < 4; ++g) {
            const uint2 nv = *reinterpret_cast<const uint2*>(slot + 8192 + r * 128 + (((I * 4 + g) ^ (r & 7)) * 16) + h * 8);
            const float4 wl = *reinterpret_cast<const float4*>(slot + 12288 + (I * 32 + 8 * g + 4 * h) * 4);
            acc[4 * g + 0] = __uint_as_float(nv.x << 16) + wl.x * S[I][4 * g + 0];
            acc[4 * g + 1] = __uint_as_float(nv.x & 0xffff0000u) + wl.y * S[I][4 * g + 1];
            acc[4 * g + 2] = __uint_as_float(nv.y << 16) + wl.z * S[I][4 * g + 2];
            acc[4 * g + 3] = __uint_as_float(nv.y & 0xffff0000u) + wl.w * S[I][4 * g + 3];
        }
#pragma unroll
        for (int K = 0; K < 2; ++K)
#pragma unroll
            for (int s = 0; s < 2; ++s) acc = __builtin_amdgcn_mfma_f32_32x32x16_bf16(af[K][s], bfrag[K][s], acc, 0, 0, 0);
        S[I] = acc;
    }
}
__device__ __forceinline__ void phase_rwkv_r2(const Params& p, unsigned char* smem) {
    const int tidx = otid(p.wave);
    if (obid() >= 64) { phase_pre(p, smem, 1, obid() - 64, ogdim() - 64); return; }
    if (p.wave != 0) return;
    const int task = obid(), bh = task >> 1, J = task & 1;
    const int lane = tidx & 63, r = lane & 31, h = lane >> 5;
    const unsigned char* Mg = p.ws + OFF_MB;
    const unsigned char* Ng = p.ws + OFF_NTB;
    const unsigned char* WLg = p.ws + OFF_WLB;
    f32x16 S[2];
#pragma unroll
    for (int i = 0; i < 16; ++i) { S[0][i] = 0.f; S[1][i] = 0.f; }
    const size_t ub = (size_t)bh * 128;
    r2_issue(Mg, Ng, WLg, ub + 0, J, lane, smem + 0 * R2_SLOT);
    r2_issue(Mg, Ng, WLg, ub + 1, J, lane, smem + 1 * R2_SLOT);
    r2_issue(Mg, Ng, WLg, ub + 2, J, lane, smem + 2 * R2_SLOT);
#define R2_STEP(n_, SL, W) do { \
        const int n2 = (n_); \
        if (n2 + 3 < 128) r2_issue(Mg, Ng, WLg, ub + n2 + 3, J, lane, smem + (((SL) + 3) & 3) * R2_SLOT); \
        r2_chunk<W>(S, smem + (SL) * R2_SLOT, s0_ptr(p.ws, (int)ub + n2) + (size_t)J * 32 * 64, r, h); \
        asm volatile("s_waitcnt lgkmcnt(0)" ::: "memory"); } while (0)
    R2_STEP(0, 0, 39); R2_STEP(1, 1, 39); R2_STEP(2, 2, 51); R2_STEP(3, 3, 51);
#pragma unroll 1
    for (int n = 4; n < 124; n += 4) {
        R2_STEP(n, 0, 51); R2_STEP(n + 1, 1, 51); R2_STEP(n + 2, 2, 51); R2_STEP(n + 3, 3, 51);
    }
    R2_STEP(124, 0, 51); R2_STEP(125, 1, 0); R2_STEP(126, 2, 0); R2_STEP(127, 3, 0);
#undef R2_STEP
}

struct R3In { uint4 pr, s0; uint2 yq[2]; unsigned short v[8], g[8]; unsigned short pv; float bc[8]; };
__device__ __forceinline__ void r3_load(R3In& in, const Params& p, int u, int tid) {
    const int b = u >> 10, h = (u >> 7) & 7, n = u & 127;
    const int wv = tid >> 6, lane = tid & 63, fr = lane & 15, fq = lane >> 4, mt = wv >> 1, nt0 = (wv & 1) * 2;
    const size_t tok0 = (size_t)b * SEQ + n * 64;
    const bf16_t* PRg = reinterpret_cast<const bf16_t*>(p.ws + OFF_AA);
    const bf16_t* YQg = reinterpret_cast<const bf16_t*>(p.ws + OFF_LOGW);
    const bf16_t* GG = reinterpret_cast<const bf16_t*>(p.ws + OFF_GG);
    const bf16_t* P = reinterpret_cast<const bf16_t*>(p.ws + OFF_P);
    const float* BCg = reinterpret_cast<const float*>(p.ws + OFF_BCB);
    const int row = tid >> 3, ch = tid & 7;
    in.pr = *reinterpret_cast<const uint4*>(PRg + (tok0 + row) * 512 + h * 64 + ch * 8);
    in.s0 = reinterpret_cast<const uint4*>(s0_ptr(p.ws, u))[tid];
#pragma unroll
    for (int nn = 0; nn < 2; ++nn) in.yq[nn] = *reinterpret_cast<const uint2*>(YQg + (tok0 + (nt0 + nn) * 16 + fr) * 512 + h * 64 + mt * 16 + fq * 4);
    const int c = h * 64 + lane;
    const int s0i = n * 64 + wv * 8;
    in.pv = (s0i > 0) ? P[(tok0 + wv * 8 - 1) * 2304 + 1024 + c] : (unsigned short)0;
#pragma unroll
    for (int i = 0; i < 8; ++i) {
        in.v[i] = P[(tok0 + wv * 8 + i) * 2304 + 1024 + c];
        in.g[i] = GG[(tok0 + wv * 8 + i) * 512 + c];
        in.bc[i] = BCg[(size_t)u * 64 + wv * 8 + i];
    }
}
__device__ __forceinline__ void phase_rwkv_r3(const Params& p, unsigned char* smem) {
    const int tidx = otid(p.wave);
    const int tid = tidx, wv = tid >> 6, lane = tid & 63, fr = lane & 15, fq = lane >> 4, mt = wv >> 1, nt0 = (wv & 1) * 2;
    bf16_t* base = reinterpret_cast<bf16_t*>(smem);
    bf16_t* Prs = base; bf16_t* Sb = base + RC_BUF;
    float* Yf = reinterpret_cast<float*>(smem + 2 * RC_BYTES);
    bf16_t* YC = reinterpret_cast<bf16_t*>(p.ws + OFF_YCAT);
    R3In cur, nxt;
    if (obid() < 4096) r3_load(cur, p, obid(), tid);
    nxt = cur;
    for (int u = obid(); u < 4096; u += ogdim()) {
        const int b = u >> 10, h = (u >> 7) & 7, n = u & 127;
        const int c = h * 64 + lane;
        float mu_v = p.in[2][1024 + c], lng = p.in[11][c], lnb = p.in[12][c];
        asm volatile("" : "+v"(mu_v), "+v"(lng), "+v"(lnb));
        if (u + ogdim() < 4096) r3_load(nxt, p, u + ogdim(), tid);
        {
            const int row = tid >> 3, ch = tid & 7;
            *reinterpret_cast<uint4*>(Prs + row * RC_LD + ch * 8) = cur.pr;
            const int I = ch >> 2, hh = (ch >> 1) & 1, g0 = (ch & 1) * 2;
            const int k0 = I * 32 + 8 * g0 + 4 * hh;
            uint2 lo; lo.x = cur.s0.x; lo.y = cur.s0.y;
            uint2 hi; hi.x = cur.s0.z; hi.y = cur.s0.w;
            *reinterpret_cast<uint2*>(Sb + row * RC_LD + k0) = lo;
            *reinterpret_cast<uint2*>(Sb + row * RC_LD + k0 + 8) = hi;
        }
        lds_barrier();
        {
            f32x4 acc[2];
            zero_acc(acc);
            mm64(acc, Sb, Prs, mt, nt0, fr, fq);
#pragma unroll
            for (int nn = 0; nn < 2; ++nn) {
                const int C = (nt0 + nn) * 16 + fr, Rb = mt * 16 + fq * 4;
                const uint2 q = cur.yq[nn];
                float4 o;
                o.x = acc[nn][0] + __uint_as_float(q.x << 16); o.y = acc[nn][1] + __uint_as_float(q.x & 0xffff0000u);
                o.z = acc[nn][2] + __uint_as_float(q.y << 16); o.w = acc[nn][3] + __uint_as_float(q.y & 0xffff0000u);
                *reinterpret_cast<float4*>(Yf + C * 68 + Rb) = o;
            }
        }
        lds_barrier();
        {
            float pv = bf2f(cur.pv);
#pragma unroll
            for (int i = 0; i < 8; ++i) {
                const int t = wv * 8 + i;
                const size_t tok = (size_t)b * SEQ + n * 64 + t;
                const float y = Yf[t * 68 + lane];
                const float mean = wave_sum(y) * (1.0f / 64.0f);
                const float d = y - mean;
                const float var = wave_sum(d * d) * (1.0f / 64.0f);
                const float yn = d * rsqrtf(var + 64e-5f) * lng + lnb;
                const float g = bf2f(cur.g[i]);
                const float v0 = bf2f(cur.v[i]);
                const float vv = bf2f(f2bf(v0 + mu_v * (pv - v0)));
                pv = v0;
                YC[tok * 1024 + c] = f2bf((yn + cur.bc[i] * vv) * g);
            }
        }
        cur = nxt;
    }
}

#define LR_LD 1032
__device__ __forceinline__ void phase_ln_route(const Params& p, int layer, unsigned char* smem) {
    const bf16_t* X = reinterpret_cast<const bf16_t*>(p.ws + OFF_P);
    const int tidx = otid(p.wave);
    const int tid = tidx, wv = tid >> 6, lane = tid & 63, fr = lane & 15, fq = lane >> 4;
    const float* g = p.in[24] + layer * DM;
    const float* bb = p.in[25] + layer * DM;
    const float* rgb = p.in[27] + layer * 4;
    const float* reb = p.in[29] + layer * 32;
    const bf16_t* RH = reinterpret_cast<const bf16_t*>(p.ws + OFF_W) + WE_RT_HI + (size_t)layer * 48 * 1024;
    const bf16_t* RL = reinterpret_cast<const bf16_t*>(p.ws + OFF_W) + WE_RT_LO + (size_t)layer * 48 * 1024;
    bf16_t* XB = reinterpret_cast<bf16_t*>(p.ws + OFF_ACTB);
    int* cnt = reinterpret_cast<int*>(p.ws + OFF_CTRL) + layer * 32;
    int* ltok = reinterpret_cast<int*>(p.ws + OFF_LTOK);
    float* lgate = reinterpret_cast<float*>(p.ws + OFF_LGATE);
    bf16_t* sXH = reinterpret_cast<bf16_t*>(smem);
    bf16_t* sXL = sXH + 16 * LR_LD;
    float* sRed = reinterpret_cast<float*>(smem + 2 * 16 * LR_LD * 2);
    float* sLog = sRed + 8 * 16 * 48;
    bf16x8 bh[4][3], bl[4][3];
#pragma unroll
    for (int ks = 0; ks < 4; ++ks)
#pragma unroll
        for (int nt = 0; nt < 3; ++nt) {
            const int k0 = wv * 128 + ks * 32 + fq * 8;
            bh[ks][nt] = *reinterpret_cast<const bf16x8*>(RH + (size_t)(nt * 16 + fr) * 1024 + k0);
            bl[ks][nt] = *reinterpret_cast<const bf16x8*>(RL + (size_t)(nt * 16 + fr) * 1024 + k0);
        }
    float4 gg[4], bv[4];
#pragma unroll
    for (int i = 0; i < 4; ++i) {
        gg[i] = *reinterpret_cast<const float4*>(g + i * 256 + lane * 4);
        bv[i] = *reinterpret_cast<const float4*>(bb + i * 256 + lane * 4);
    }
    int* sCnt = reinterpret_cast<int*>(sLog + 16 * 48);
    int* sBase = sCnt + 32;
    int* sDecE = sBase + 32;
    int* sDecP = sDecE + 256;
    float* sDecG = reinterpret_cast<float*>(sDecP + 256);
    int* sDecR = reinterpret_cast<int*>(sDecG + 256);
    if (tid < 32) sCnt[tid] = 0;
    uint2 pre[2][4];
    {
        const int tile0 = obid();
        if (tile0 < NT / 16) {
#pragma unroll
            for (int rr = 0; rr < 2; ++rr)
#pragma unroll
                for (int i = 0; i < 4; ++i)
                    pre[rr][i] = *reinterpret_cast<const uint2*>(X + (size_t)(tile0 * 16 + wv * 2 + rr) * DM + i * 256 + lane * 4);
        }
    }
    __syncthreads();
    int nloc = 0;
    for (int tile = obid(); tile < NT / 16; tile += ogdim(), ++nloc) {
        uint2 cur[2][4];
#pragma unroll
        for (int rr = 0; rr < 2; ++rr)
#pragma unroll
            for (int i = 0; i < 4; ++i) cur[rr][i] = pre[rr][i];
        {
            const int tn = tile + ogdim();
            if (tn < NT / 16) {
#pragma unroll
                for (int rr = 0; rr < 2; ++rr)
#pragma unroll
                    for (int i = 0; i < 4; ++i)
                        pre[rr][i] = *reinterpret_cast<const uint2*>(X + (size_t)(tn * 16 + wv * 2 + rr) * DM + i * 256 + lane * 4);
            }
        }
#pragma unroll
        for (int rr = 0; rr < 2; ++rr) {
            const int rl = wv * 2 + rr;
            const int row = tile * 16 + rl;
            float v[16];
#pragma unroll
            for (int i = 0; i < 4; ++i) {
                const uint2 t = cur[rr][i];
                v[4 * i] = __uint_as_float(t.x << 16); v[4 * i + 1] = __uint_as_float(t.x & 0xffff0000u);
                v[4 * i + 2] = __uint_as_float(t.y << 16); v[4 * i + 3] = __uint_as_float(t.y & 0xffff0000u);
            }
            float sum = 0.f;
#pragma unroll
            for (int i = 0; i < 16; ++i) sum += v[i];
            const float mean = wave_sum(sum) * (1.0f / DM);
            float sq = 0.f;
#pragma unroll
            for (int i = 0; i < 16; ++i) { float d = v[i] - mean; sq += d * d; }
            const float rstd = rsqrtf(wave_sum(sq) * (1.0f / DM) + 1e-5f);
#pragma unroll
            for (int i = 0; i < 4; ++i) {
                const int col = i * 256 + lane * 4;
                const float o0 = (v[4 * i] - mean) * rstd * gg[i].x + bv[i].x;
                const float o1 = (v[4 * i + 1] - mean) * rstd * gg[i].y + bv[i].y;
                const float o2 = (v[4 * i + 2] - mean) * rstd * gg[i].z + bv[i].z;
                const float o3 = (v[4 * i + 3] - mean) * rstd * gg[i].w + bv[i].w;
                const bf16_t h0 = f2bf(o0), h1 = f2bf(o1), h2 = f2bf(o2), h3 = f2bf(o3);
                uint2 wh; wh.x = (unsigned)h0 | ((unsigned)h1 << 16); wh.y = (unsigned)h2 | ((unsigned)h3 << 16);
                *reinterpret_cast<uint2*>(XB + (size_t)row * DM + col) = wh;
                *reinterpret_cast<uint2*>(sXH + rl * LR_LD + col) = wh;
                uint2 wl; wl.x = pack2(o0 - bf2f(h0), o1 - bf2f(h1)); wl.y = pack2(o2 - bf2f(h2), o3 - bf2f(h3));
                *reinterpret_cast<uint2*>(sXL + rl * LR_LD + col) = wl;
            }
        }
        lds_barrier();
        {
            f32x4 acc[3];
#pragma unroll
            for (int nt = 0; nt < 3; ++nt) acc[nt] = (f32x4){0.f, 0.f, 0.f, 0.f};
#pragma unroll
            for (int ks = 0; ks < 4; ++ks) {
                const int k0 = wv * 128 + ks * 32 + fq * 8;
                const bf16x8 ah = *reinterpret_cast<const bf16x8*>(sXH + fr * LR_LD + k0);
                const bf16x8 al = *reinterpret_cast<const bf16x8*>(sXL + fr * LR_LD + k0);
#pragma unroll
                for (int nt = 0; nt < 3; ++nt) {
                    acc[nt] = __builtin_amdgcn_mfma_f32_16x16x32_bf16(ah, bh[ks][nt], acc[nt], 0, 0, 0);
                    acc[nt] = __builtin_amdgcn_mfma_f32_16x16x32_bf16(al, bh[ks][nt], acc[nt], 0, 0, 0);
                    acc[nt] = __builtin_amdgcn_mfma_f32_16x16x32_bf16(ah, bl[ks][nt], acc[nt], 0, 0, 0);
                }
            }
#pragma unroll
            for (int nt = 0; nt < 3; ++nt)
#pragma unroll
                for (int j = 0; j < 4; ++j) sRed[(wv * 16 + fq * 4 + j) * 48 + nt * 16 + fr] = acc[nt][j];
        }
        lds_barrier();
        for (int idx = tid; idx < 16 * 48; idx += NTHREADS) {
            float s = 0.f;
#pragma unroll
            for (int w = 0; w < 8; ++w) s += sRed[w * 16 * 48 + idx];
            sLog[idx] = s;
        }
        lds_barrier();
        if (tid < 16) {
            const int row = tile * 16 + tid;
            const float* lg = sLog + tid * 48;
            float gl[4];
#pragma unroll
            for (int j = 0; j < 4; ++j) gl[j] = lg[j] + rgb[j];
            int gi = 0; float gm = gl[0];
#pragma unroll
            for (int j = 1; j < 4; ++j) if (gl[j] > gm) { gm = gl[j]; gi = j; }
            float gs = 0.f;
#pragma unroll
            for (int j = 0; j < 4; ++j) gs += __expf(gl[j] - gm);
            const float gw = 1.0f / gs;
            float el[8];
#pragma unroll
            for (int j = 0; j < 8; ++j) el[j] = lg[4 + gi * 8 + j] + reb[gi * 8 + j];
            int i1 = 0; float m1 = el[0];
#pragma unroll
            for (int j = 1; j < 8; ++j) if (el[j] > m1) { m1 = el[j]; i1 = j; }
            int i2 = (i1 == 0) ? 1 : 0; float m2 = el[i2];
#pragma unroll
            for (int j = 0; j < 8; ++j) if (j != i1 && el[j] > m2) { m2 = el[j]; i2 = j; }
            const float e2 = __expf(m2 - m1);
            const float p1 = 1.0f / (1.0f + e2), p2 = e2 / (1.0f + e2);
            const int ex1 = gi * 8 + i1, ex2 = gi * 8 + i2;
            const int d0 = (nloc * 16 + tid) * 2;
            sDecE[d0] = ex1; sDecP[d0] = atomicAdd(&sCnt[ex1], 1); sDecG[d0] = gw * p1; sDecR[d0] = row * 2;
            sDecE[d0 + 1] = ex2; sDecP[d0 + 1] = atomicAdd(&sCnt[ex2], 1); sDecG[d0 + 1] = gw * p2; sDecR[d0 + 1] = row * 2 + 1;
        }
    }
    __syncthreads();
    if (tid < 32) sBase[tid] = atomicAdd(&cnt[tid], sCnt[tid]);
    __syncthreads();
    if (tid < nloc * 32) {
        const int ex = sDecE[tid];
        const size_t pos = (size_t)ex * NT + sBase[ex] + sDecP[tid];
        ltok[pos] = sDecR[tid];
        lgate[pos] = sDecG[tid];
    }
    __syncthreads();
}

__device__ __forceinline__ void phase_exp1(const Params& p, int layer, bf16_t* smem) {
    const int* cnt = reinterpret_cast<const int*>(p.ws + OFF_CTRL) + layer * 32;
    const int* ltok = reinterpret_cast<const int*>(p.ws + OFF_LTOK);
    const bf16_t* XB = reinterpret_cast<const bf16_t*>(p.ws + OFF_ACTB);
    const bf16_t* W13 = reinterpret_cast<const bf16_t*>(p.ws + OFF_W) + WE_W13 + (size_t)layer * 32 * 262144;
    bf16_t* H = reinterpret_cast<bf16_t*>(p.ws + OFF_HBUF);
    int t = obid();
    int base = 0, tbase = 0;
    for (int e = 0; e < 32; ++e) {
        int c = cnt[e];
        int nt = ((c + 255) >> 8) * 2;
        while (t < tbase + nt) {
            int w = t - tbase;
            EpiExp1 epi{H, base, c};
            gemm_tile<true>(XB, DM, ltok + (size_t)e * NT, c, W13 + (size_t)e * 262144, DM, DM, (w >> 1) * 256, (w & 1) * 128, epi, smem, p.wave);
            t += ogdim();
        }
        tbase += nt; base += c;
    }
}
__device__ __forceinline__ void phase_exp2(const Params& p, int layer, bf16_t* smem) {
    const int* cnt = reinterpret_cast<const int*>(p.ws + OFF_CTRL) + layer * 32;
    const int* ltok = reinterpret_cast<const int*>(p.ws + OFF_LTOK);
    const float* lgate = reinterpret_cast<const float*>(p.ws + OFF_LGATE);
    const bf16_t* W2 = reinterpret_cast<const bf16_t*>(p.ws + OFF_W) + WE_W2 + (size_t)layer * 32 * 131072;
    const bf16_t* H = reinterpret_cast<const bf16_t*>(p.ws + OFF_HBUF);
    bf16_t* FS = reinterpret_cast<bf16_t*>(p.ws + OFF_FS);
    int t = obid();
    int base = 0, tbase = 0;
    for (int e = 0; e < 32; ++e) {
        int c = cnt[e];
        int nt = ((c + 255) >> 8) * 8;
        while (t < tbase + nt) {
            int w = t - tbase;
            EpiExp2 epi{FS, ltok + (size_t)e * NT, lgate + (size_t)e * NT, c};
            gemm_tile<false>(H + (size_t)base * 128, 128, nullptr, 0, W2 + (size_t)e * 131072, 128, 128, (w >> 3) * 256, (w & 7) * 128, epi, smem, p.wave);
            t += ogdim();
        }
        tbase += nt; base += c;
    }
}

__device__ __forceinline__ void phase_ln_ffn(const Params& p, int layer, float* Xout, bool last) {
    const int tidx = otid(p.wave);
    const int tid = tidx, wv = tid >> 6, lane = tid & 63;
    const float* g = p.in[33] + layer * DM;
    const float* bb = p.in[34] + layer * DM;
    const bf16_t* FS = reinterpret_cast<const bf16_t*>(p.ws + OFF_FS);
    bf16_t* XB = reinterpret_cast<bf16_t*>(p.ws + OFF_ACTB);
    for (int row = obid() * NWAVES + wv; row < NT; row += ogdim() * NWAVES) {
        float v[16];
#pragma unroll
        for (int i = 0; i < 4; ++i) {
            int col = i * 256 + lane * 4;
            uint2 t = *reinterpret_cast<const uint2*>(XB + (size_t)row * DM + col);
            uint2 f0 = *reinterpret_cast<const uint2*>(FS + (size_t)row * DM + col);
            uint2 f1 = *reinterpret_cast<const uint2*>(FS + ((size_t)NT + row) * DM + col);
            v[4 * i] = ALPHA_F * __uint_as_float(t.x << 16) + __uint_as_float(f0.x << 16) + __uint_as_float(f1.x << 16);
            v[4 * i + 1] = ALPHA_F * __uint_as_float(t.x & 0xffff0000u) + __uint_as_float(f0.x & 0xffff0000u) + __uint_as_float(f1.x & 0xffff0000u);
            v[4 * i + 2] = ALPHA_F * __uint_as_float(t.y << 16) + __uint_as_float(f0.y << 16) + __uint_as_float(f1.y << 16);
            v[4 * i + 3] = ALPHA_F * __uint_as_float(t.y & 0xffff0000u) + __uint_as_float(f0.y & 0xffff0000u) + __uint_as_float(f1.y & 0xffff0000u);
        }
        float sum = 0.f;
#pragma unroll
        for (int i = 0; i < 16; ++i) sum += v[i];
        float mean = wave_sum(sum) * (1.0f / DM);
        float sq = 0.f;
#pragma unroll
        for (int i = 0; i < 16; ++i) { float d = v[i] - mean; sq += d * d; }
        float rstd = rsqrtf(wave_sum(sq) * (1.0f / DM) + 1e-5f);
#pragma unroll
        for (int i = 0; i < 4; ++i) {
            int col = i * 256 + lane * 4;
            float4 gg = *reinterpret_cast<const float4*>(g + col);
            float4 bv = *reinterpret_cast<const float4*>(bb + col);
            float o0 = (v[4 * i] - mean) * rstd * gg.x + bv.x;
            float o1 = (v[4 * i + 1] - mean) * rstd * gg.y + bv.y;
            float o2 = (v[4 * i + 2] - mean) * rstd * gg.z + bv.z;
            float o3 = (v[4 * i + 3] - mean) * rstd * gg.w + bv.w;
            if (last) {
                *reinterpret_cast<float4*>(Xout + (size_t)row * DM + col) = make_float4(o0, o1, o2, o3);
            } else {
                uint2 w; w.x = pack2(o0, o1); w.y = pack2(o2, o3);
                *reinterpret_cast<uint2*>(XB + (size_t)row * DM + col) = w;
            }
        }
    }
}

#define CV_T 64
#define CV_ROWS (CV_T + 30)
template <int OB>
__device__ __forceinline__ void conv_blk(float (&acc)[CV_T], const bf16_t* sU, int tid, const float (&w0)[31]) {
#pragma unroll
    for (int rr = 0; rr < 38; ++rr) {
        const float uv = bf2f(sU[(OB * 8 + rr) * 512 + tid]);
#pragma unroll
        for (int oo = 0; oo < 8; ++oo) {
            const int j = rr - oo;
            if (j >= 0 && j <= 30) acc[OB * 8 + oo] += uv * w0[j];
        }
    }
}
__device__ __forceinline__ void phase_l1_conv(const Params& p, unsigned char* smem) {
    const int tidx = otid(p.wave);
    const bf16_t* P = reinterpret_cast<const bf16_t*>(p.ws + OFF_P);
    bf16_t* YC = reinterpret_cast<bf16_t*>(p.ws + OFF_YCAT);
    bf16_t* sU = reinterpret_cast<bf16_t*>(smem);
    float* red = reinterpret_cast<float*>(smem + CV_ROWS * 512 * 2);
    float* stat = red + 8 * 64 * 2;
    const int tid = tidx, wv = tid >> 6, lane = tid & 63;
    const float* cw = p.in[17];
    float w0[31];
#pragma unroll
    for (int j = 0; j < 31; ++j) w0[j] = cw[j * 512 + tid];
    const float cb0 = p.in[18][tid], g0 = p.in[19][tid], b0 = p.in[20][tid];
    for (int u = obid(); u < NT / CV_T; u += ogdim()) {
        const int t0 = u * CV_T;
        const int s0 = t0 & (SEQ - 1);
#pragma unroll 1
        for (int base = 0; base < CV_ROWS * 64; base += 6 * NTHREADS) {
            uint4 av[6], gv[6];
#pragma unroll
            for (int j = 0; j < 6; ++j) {
                const int it = base + j * NTHREADS + tid;
                const int r = it >> 6, c8 = (it & 63) * 8;
                av[j] = make_uint4(0u, 0u, 0u, 0u); gv[j] = av[j];
                if (it < CV_ROWS * 64 && s0 - 30 + r >= 0) {
                    const bf16_t* pr = P + (size_t)(t0 - 30 + r) * 3072 + c8;
                    av[j] = *reinterpret_cast<const uint4*>(pr);
                    gv[j] = *reinterpret_cast<const uint4*>(pr + 512);
                }
            }
#pragma unroll
            for (int j = 0; j < 6; ++j) {
                const int it = base + j * NTHREADS + tid;
                if (it < CV_ROWS * 64) {
                    const int r = it >> 6, c8 = (it & 63) * 8;
                    float a[8], gte[8];
                    unpack8(av[j], a); unpack8(gv[j], gte);
#pragma unroll
                    for (int i = 0; i < 8; ++i) a[i] = a[i] * sigmoidf_(gte[i]);
                    uint4 w;
                    w.x = pack2(a[0], a[1]); w.y = pack2(a[2], a[3]); w.z = pack2(a[4], a[5]); w.w = pack2(a[6], a[7]);
                    *reinterpret_cast<uint4*>(sU + r * 512 + c8) = w;
                }
            }
        }
        __syncthreads();
        float acc[CV_T];
#pragma unroll
        for (int o = 0; o < CV_T; ++o) acc[o] = cb0;
        conv_blk<0>(acc, sU, tid, w0); conv_blk<1>(acc, sU, tid, w0); conv_blk<2>(acc, sU, tid, w0); conv_blk<3>(acc, sU, tid, w0);
        conv_blk<4>(acc, sU, tid, w0); conv_blk<5>(acc, sU, tid, w0); conv_blk<6>(acc, sU, tid, w0); conv_blk<7>(acc, sU, tid, w0);
#pragma unroll
        for (int o = 0; o < CV_T; ++o) {
            const float s1 = wave_sum(acc[o]);
            const float s2 = wave_sum(acc[o] * acc[o]);
            if (lane == 0) { red[(wv * 64 + o) * 2] = s1; red[(wv * 64 + o) * 2 + 1] = s2; }
        }
        __syncthreads();
        if (tid < 64) {
            float s1 = 0.f, s2 = 0.f;
#pragma unroll
            for (int w = 0; w < 8; ++w) { s1 += red[(w * 64 + tid) * 2]; s2 += red[(w * 64 + tid) * 2 + 1]; }
            const float mean = s1 * (1.0f / 512.0f);
            const float var = fmaxf(s2 * (1.0f / 512.0f) - mean * mean, 0.f);
            stat[tid * 2] = mean; stat[tid * 2 + 1] = rsqrtf(var + 1e-5f);
        }
        __syncthreads();
#pragma unroll
        for (int o = 0; o < CV_T; ++o) {
            const float mean = stat[o * 2], rstd = stat[o * 2 + 1];
            const float y0 = (acc[o] - mean) * rstd * g0 + b0;
            YC[(size_t)(t0 + o) * 1024 + tid] = f2bf(siluf_(y0));
        }
    }
}

__device__ __forceinline__ float ret_lg(int h) { return log1pf(-exp2f(-5.0f - (float)h)); }

#define KT_LD 136
struct RetIn { uint4 k1, k2, v1, v2; };
__device__ __forceinline__ void ret_load_kv(RetIn& in, const bf16_t* P, int u, int tid) {
    const int n = u & 63, h = (u >> 6) & 7, b = u >> 9;
    const int c = tid >> 2, i0 = (tid & 3) * 8;
    const size_t tok = (size_t)b * SEQ + n * 128 + c;
    const bf16_t* kr = P + tok * 3072 + 1536 + h * 64;
    const bf16_t* vr = P + tok * 3072 + 2048 + h * 64;
    in.k1 = *reinterpret_cast<const uint4*>(kr + i0); in.k2 = *reinterpret_cast<const uint4*>(kr + 32 + i0);
    in.v1 = *reinterpret_cast<const uint4*>(vr + i0); in.v2 = *reinterpret_cast<const uint4*>(vr + 32 + i0);
}
__device__ __forceinline__ void st_col8(bf16_t* dst, int ld, const uint4 v) {
    dst[0 * ld] = (bf16_t)(v.x & 0xffffu); dst[1 * ld] = (bf16_t)(v.x >> 16);
    dst[2 * ld] = (bf16_t)(v.y & 0xffffu); dst[3 * ld] = (bf16_t)(v.y >> 16);
    dst[4 * ld] = (bf16_t)(v.z & 0xffffu); dst[5 * ld] = (bf16_t)(v.z >> 16);
    dst[6 * ld] = (bf16_t)(v.w & 0xffffu); dst[7 * ld] = (bf16_t)(v.w >> 16);
}
__device__ __forceinline__ void phase_ret_kv(const Params& p, unsigned char* smem) {
    const int tidx = otid(p.wave);
    const bf16_t* P = reinterpret_cast<const bf16_t*>(p.ws + OFF_P);
    const float2* rope = reinterpret_cast<const float2*>(p.ws + OFF_ROPE);
    float* KVT = reinterpret_cast<float*>(p.ws + OFF_KVT);
    bf16_t* sKT = reinterpret_cast<bf16_t*>(smem);
    bf16_t* sVT = sKT + 64 * KT_LD;
    const int tid = tidx, wv = tid >> 6, lane = tid & 63, fr = lane & 15, fq = lane >> 4;
    const int et = wv >> 1, dt0 = (wv & 1) * 2;
    RetIn cur, nxt;
    if (obid() < 2048) ret_load_kv(cur, P, obid(), tid);
    nxt = cur;
    for (int u = obid(); u < 2048; u += ogdim()) {
        const int n = u & 63, h = (u >> 6) & 7;
        const float lg = ret_lg(h);
        const int c = tid >> 2, i0 = (tid & 3) * 8;
        const int sidx = n * 128 + c;
        float2 cs[8];
#pragma unroll
        for (int i = 0; i < 8; ++i) cs[i] = rope[sidx * 32 + i0 + i];
        asm volatile("" : "+v"(cs[0].x), "+v"(cs[7].y));
        if (u + ogdim() < 2048) ret_load_kv(nxt, P, u + ogdim(), tid);
        {
            const float zeta = __expf((float)(127 - c) * lg) * 0.125f;
            float k1[8], k2[8];
            unpack8(cur.k1, k1); unpack8(cur.k2, k2);
#pragma unroll
            for (int i = 0; i < 8; ++i) {
                float o1 = (k1[i] * cs[i].x - k2[i] * cs[i].y) * zeta, o2 = (k1[i] * cs[i].y + k2[i] * cs[i].x) * zeta;
                sKT[(i0 + i) * KT_LD + c] = f2bf(o1);
                sKT[(32 + i0 + i) * KT_LD + c] = f2bf(o2);
            }
            st_col8(sVT + i0 * KT_LD + c, KT_LD, cur.v1);
            st_col8(sVT + (32 + i0) * KT_LD + c, KT_LD, cur.v2);
        }
        lds_barrier();
        f32x4 acc[2];
        acc[0] = (f32x4){0.f, 0.f, 0.f, 0.f}; acc[1] = (f32x4){0.f, 0.f, 0.f, 0.f};
#pragma unroll
        for (int ks = 0; ks < 4; ++ks) {
            bf16x8 af = *reinterpret_cast<const bf16x8*>(sVT + (et * 16 + fr) * KT_LD + ks * 32 + fq * 8);
#pragma unroll
            for (int nn = 0; nn < 2; ++nn) {
                bf16x8 bfr = *reinterpret_cast<const bf16x8*>(sKT + ((dt0 + nn) * 16 + fr) * KT_LD + ks * 32 + fq * 8);
                acc[nn] = __builtin_amdgcn_mfma_f32_16x16x32_bf16(af, bfr, acc[nn], 0, 0, 0);
            }
        }
        float* o = KVT + (size_t)u * 4096;
#pragma unroll
        for (int nn = 0; nn < 2; ++nn)
#pragma unroll
            for (int j = 0; j < 4; ++j) o[(et * 16 + fq * 4 + j) * 64 + (dt0 + nn) * 16 + fr] = acc[nn][j];
        cur = nxt;
        lds_barrier();
    }
}
__device__ __forceinline__ void phase_ret_scan(const Params& p) {
    const int tidx = otid(p.wave);
    float* KVT = reinterpret_cast<float*>(p.ws + OFF_KVT);
    for (int i = obid() * NTHREADS + tidx; i < 32 * 4096; i += ogdim() * NTHREADS) {
        int bh = i >> 12, ed = i & 4095, h = bh & 7;
        float gc = __expf(128.0f * ret_lg(h));
        float R = 0.f;
        float* q = KVT + (size_t)bh * 64 * 4096 + ed;
#pragma unroll 1
        for (int n0 = 0; n0 < 64; n0 += 16) {
            float kv[16];
#pragma unroll
            for (int j = 0; j < 16; ++j) kv[j] = q[(size_t)(n0 + j) * 4096];
#pragma unroll
            for (int j = 0; j < 16; ++j) { q[(size_t)(n0 + j) * 4096] = R; R = gc * R + kv[j]; }
        }
    }
}
#define Q_LD 72
struct RetOutIn { uint4 q1, q2, k1, k2, v1, v2; float4 r0, r1; unsigned short gr[16]; };
__device__ __forceinline__ void ret_load_out(RetOutIn& in, const bf16_t* P, const float* KVT, int u, int tid) {
    const int n = u & 63, h = (u >> 6) & 7, b = u >> 9;
    const int c = tid >> 2, i0 = (tid & 3) * 8;
    const size_t tok = (size_t)b * SEQ + n * 128 + c;
    const bf16_t* qr = P + tok * 3072 + 1024 + h * 64;
    in.q1 = *reinterpret_cast<const uint4*>(qr + i0); in.q2 = *reinterpret_cast<const uint4*>(qr + 32 + i0);
    in.k1 = *reinterpret_cast<const uint4*>(qr + 512 + i0); in.k2 = *reinterpret_cast<const uint4*>(qr + 512 + 32 + i0);
    in.v1 = *reinterpret_cast<const uint4*>(qr + 1024 + i0); in.v2 = *reinterpret_cast<const uint4*>(qr + 1024 + 32 + i0);
    const float* rp = KVT + (size_t)u * 4096 + tid * 8;
    in.r0 = *reinterpret_cast<const float4*>(rp); in.r1 = *reinterpret_cast<const float4*>(rp + 4);
    const int wv = tid >> 6, lane = tid & 63, fr = lane & 15, fq = lane >> 4;
#pragma unroll
    for (int j = 0; j < 4; ++j)
#pragma unroll
        for (int nn = 0; nn < 4; ++nn)
            in.gr[j * 4 + nn] = P[((size_t)b * SEQ + n * 128 + wv * 16 + fq * 4 + j) * 3072 + 2560 + h * 64 + nn * 16 + fr];
}
__device__ __forceinline__ void phase_ret_out(const Params& p, unsigned char* smem) {
    const int tidx = otid(p.wave);
    const bf16_t* P = reinterpret_cast<const bf16_t*>(p.ws + OFF_P);
    const float2* rope = reinterpret_cast<const float2*>(p.ws + OFF_ROPE);
    const float* KVT = reinterpret_cast<const float*>(p.ws + OFF_KVT);
    bf16_t* YC = reinterpret_cast<bf16_t*>(p.ws + OFF_YCAT);
    bf16_t* sQ = reinterpret_cast<bf16_t*>(smem);
    bf16_t* sK = sQ + 128 * Q_LD;
    bf16_t* sVT = sK + 128 * Q_LD;
    bf16_t* sRT = sVT + 64 * KT_LD;
    bf16_t* sS = sQ;
    const int tid = tidx, wv = tid >> 6, lane = tid & 63, fr = lane & 15, fq = lane >> 4;
    RetOutIn cur, nxt;
    if (obid() < 2048) ret_load_out(cur, P, KVT, obid(), tid);
    nxt = cur;
    for (int u = obid(); u < 2048; u += ogdim()) {
        const int n = u & 63, h = (u >> 6) & 7, b = u >> 9;
        const float lg = ret_lg(h);
        const int c = tid >> 2, i0 = (tid & 3) * 8;
        const int sidx = n * 128 + c;
        float2 cs[8];
#pragma unroll
        for (int i = 0; i < 8; ++i) cs[i] = rope[sidx * 32 + i0 + i];
        float gng[4], gnb[4];
#pragma unroll
        for (int nn = 0; nn < 4; ++nn) { gng[nn] = p.in[21][h * 64 + nn * 16 + fr]; gnb[nn] = p.in[22][h * 64 + nn * 16 + fr]; }
        asm volatile("" : "+v"(cs[0].x), "+v"(cs[7].y), "+v"(gng[0]), "+v"(gnb[3]));
        if (u + ogdim() < 2048) ret_load_out(nxt, P, KVT, u + ogdim(), tid);
        {
            float qa[8], qb[8], ka[8], kb[8];
            float q1[8], q2[8], k1[8], k2[8];
            unpack8(cur.q1, q1); unpack8(cur.q2, q2); unpack8(cur.k1, k1); unpack8(cur.k2, k2);
#pragma unroll
            for (int i = 0; i < 8; ++i) {
                qa[i] = q1[i] * cs[i].x - q2[i] * cs[i].y; qb[i] = q1[i] * cs[i].y + q2[i] * cs[i].x;
                ka[i] = (k1[i] * cs[i].x - k2[i] * cs[i].y) * 0.125f; kb[i] = (k1[i] * cs[i].y + k2[i] * cs[i].x) * 0.125f;
            }
            st_col8(sVT + i0 * KT_LD + c, KT_LD, cur.v1);
            st_col8(sVT + (32 + i0) * KT_LD + c, KT_LD, cur.v2);
            uint4 w;
            w.x = pack2(qa[0], qa[1]); w.y = pack2(qa[2], qa[3]); w.z = pack2(qa[4], qa[5]); w.w = pack2(qa[6], qa[7]);
            *reinterpret_cast<uint4*>(sQ + c * Q_LD + i0) = w;
            w.x = pack2(qb[0], qb[1]); w.y = pack2(qb[2], qb[3]); w.z = pack2(qb[4], qb[5]); w.w = pack2(qb[6], qb[7]);
            *reinterpret_cast<uint4*>(sQ + c * Q_LD + 32 + i0) = w;
            w.x = pack2(ka[0], ka[1]); w.y = pack2(ka[2], ka[3]); w.z = pack2(ka[4], ka[5]); w.w = pack2(ka[6], ka[7]);
            *reinterpret_cast<uint4*>(sK + c * Q_LD + i0) = w;
            w.x = pack2(kb[0], kb[1]); w.y = pack2(kb[2], kb[3]); w.z = pack2(kb[4], kb[5]); w.w = pack2(kb[6], kb[7]);
            *reinterpret_cast<uint4*>(sK + c * Q_LD + 32 + i0) = w;
            w.x = pack2(cur.r0.x, cur.r0.y); w.y = pack2(cur.r0.z, cur.r0.w); w.z = pack2(cur.r1.x, cur.r1.y); w.w = pack2(cur.r1.z, cur.r1.w);
            *reinterpret_cast<uint4*>(sRT + (tid >> 3) * Q_LD + (tid & 7) * 8) = w;
        }
        lds_barrier();
        f32x4 accs[8], accc[4];
#pragma unroll
        for (int nn = 0; nn < 8; ++nn) accs[nn] = (f32x4){0.f, 0.f, 0.f, 0.f};
#pragma unroll
        for (int nn = 0; nn < 4; ++nn) accc[nn] = (f32x4){0.f, 0.f, 0.f, 0.f};
#pragma unroll
        for (int ks = 0; ks < 2; ++ks) {
            bf16x8 af = *reinterpret_cast<const bf16x8*>(sQ + (wv * 16 + fr) * Q_LD + ks * 32 + fq * 8);
#pragma unroll
            for (int nn = 0; nn < 8; ++nn) {
                bf16x8 bfr = *reinterpret_cast<const bf16x8*>(sK + (nn * 16 + fr) * Q_LD + ks * 32 + fq * 8);
                accs[nn] = __builtin_amdgcn_mfma_f32_16x16x32_bf16(af, bfr, accs[nn], 0, 0, 0);
            }
#pragma unroll
            for (int nn = 0; nn < 4; ++nn) {
                bf16x8 bfr = *reinterpret_cast<const bf16x8*>(sRT + (nn * 16 + fr) * Q_LD + ks * 32 + fq * 8);
                accc[nn] = __builtin_amdgcn_mfma_f32_16x16x32_bf16(af, bfr, accc[nn], 0, 0, 0);
            }
        }
        lds_barrier();
        bf16_t* mS = sS + wv * 16 * KT_LD;
        {
            float e1[4], e1m[4];
#pragma unroll
            for (int j = 0; j < 4; ++j) {
                e1[j] = __expf((float)(fq * 4 + j - fr) * lg);
                e1m[j] = (fq * 4 + j >= fr) ? e1[j] : 0.f;
            }
#pragma unroll
            for (int nn = 0; nn < 8; ++nn) {
                const float e2 = (nn < wv) ? __expf((float)(16 * (wv - nn)) * lg) : 0.f;
                const bool diag = (nn == wv);
                float v[4];
#pragma unroll
                for (int j = 0; j < 4; ++j) v[j] = accs[nn][j] * (diag ? e1m[j] : e2 * e1[j]);
#pragma unroll
                for (int j = 0; j < 4; ++j) mS[(fq * 4 + j) * KT_LD + nn * 16 + fr] = f2bf(v[j]);
            }
        }
        lds_barrier();
        f32x4 acco[4];
#pragma unroll
        for (int nn = 0; nn < 4; ++nn) acco[nn] = (f32x4){0.f, 0.f, 0.f, 0.f};
#pragma unroll
        for (int ks = 0; ks < 4; ++ks) {
            bf16x8 af = *reinterpret_cast<const bf16x8*>(mS + fr * KT_LD + ks * 32 + fq * 8);
#pragma unroll
            for (int nn = 0; nn < 4; ++nn) {
                bf16x8 bfr = *reinterpret_cast<const bf16x8*>(sVT + (nn * 16 + fr) * KT_LD + ks * 32 + fq * 8);
                acco[nn] = __builtin_amdgcn_mfma_f32_16x16x32_bf16(af, bfr, acco[nn], 0, 0, 0);
            }
        }
#pragma unroll
        for (int j = 0; j < 4; ++j) {
            int ig = wv * 16 + fq * 4 + j;
            float xi = __expf((float)(ig + 1) * lg);
            float o[4];
            float sm = 0.f;
#pragma unroll
            for (int nn = 0; nn < 4; ++nn) { o[nn] = acco[nn][j] + xi * accc[nn][j]; sm += o[nn]; }
            sm = row16_sum(sm);
            float mean = sm * (1.0f / 64.0f);
            float sq = 0.f;
#pragma unroll
            for (int nn = 0; nn < 4; ++nn) { float d = o[nn] - mean; sq += d * d; }
            sq = row16_sum(sq);
            float rstd = rsqrtf(sq * (1.0f / 64.0f) + 1e-5f);
            size_t tok = (size_t)b * SEQ + n * 128 + ig;
#pragma unroll
            for (int nn = 0; nn < 4; ++nn) {
                int e = h * 64 + nn * 16 + fr;
                float y = (o[nn] - mean) * rstd * gng[nn] + gnb[nn];
                float gr = bf2f(cur.gr[j * 4 + nn]);
                YC[tok * 1024 + 512 + e] = f2bf(siluf_(gr) * y);
            }
        }
        cur = nxt;
        lds_barrier();
    }
}

#define XB_TMO      128
#define XB_XCNT(j)  (256  + 64 * (j))
#define XB_XSUB(j)  (1280 + 64 * (j))
#define XB_XGEN(j)  (2304 + 64 * (j))
#define XB_TOP      3328
#define XB_TOPGEN   3392
#define XB_SPIN_CAP (1u << 18)

__device__ __forceinline__ unsigned xb_ld(unsigned* p)              { return __hip_atomic_load(p, __ATOMIC_RELAXED, __HIP_MEMORY_SCOPE_AGENT); }
__device__ __forceinline__ unsigned xb_add(unsigned* p, unsigned v) { return __hip_atomic_fetch_add(p, v, __ATOMIC_RELAXED, __HIP_MEMORY_SCOPE_AGENT); }
__device__ __forceinline__ unsigned xb_xcc_id() { return (unsigned)__builtin_amdgcn_s_getreg((3 << 11) | 20) & 0xFu; }
#define XB_SPIN(cond, bar) do { unsigned _sp = 0; while (cond) { __builtin_amdgcn_s_sleep(1); \
    if ((++_sp & 255u) == 0u) { if (xb_ld(&(bar)[XB_TMO])) break; if (_sp > XB_SPIN_CAP) { atomicAdd(&(bar)[XB_TMO], 1u); break; } } } } while (0)

struct XcdBarrier {
    unsigned* bar; unsigned x;
    volatile __attribute__((address_space(3))) unsigned* st;
};

__device__ __forceinline__ XcdBarrier xcd_barrier_post(unsigned* bar, volatile __attribute__((address_space(3))) unsigned* st, int tid) {
    XcdBarrier b; b.bar = bar; b.x = xb_xcc_id(); b.st = st;
    if (tid == 0) (void)xb_add(&bar[XB_XCNT(b.x)], 1u);
    return b;
}
__device__ __forceinline__ void xcd_barrier_complete(unsigned* bar, unsigned x, unsigned& nloc, unsigned& nx) {
    const unsigned G = (unsigned)ogdim();
    unsigned sum, cnt, mine, sp = 0u;
    for (;;) {
        sum = 0u; cnt = 0u; mine = 0u;
#pragma unroll
        for (unsigned j = 0; j < 16; ++j) { const unsigned c = xb_ld(&bar[XB_XCNT(j)]); sum += c; cnt += (c > 0u) ? 1u : 0u; mine = (j == x) ? c : mine; }
        if (sum == G) break;
        __builtin_amdgcn_s_sleep(1);
        if ((++sp & 255u) == 0u) { if (xb_ld(&bar[XB_TMO])) break; if (sp > XB_SPIN_CAP) { atomicAdd(&bar[XB_TMO], 1u); break; } }
    }
    nloc = mine > 0u ? mine : 1u; nx = cnt > 0u ? cnt : 1u;
}

__device__ __forceinline__ void xcd_barrier(const XcdBarrier& b, int tid) {
    asm volatile("s_waitcnt vmcnt(0)" ::: "memory");
    __syncthreads();
    if (tid == 0) {
        unsigned* bar = b.bar;
        __builtin_amdgcn_s_waitcnt(0);
        unsigned nloc = b.st[0], nx = b.st[1];
        if (nloc == 0u) { xcd_barrier_complete(bar, b.x, nloc, nx); b.st[0] = nloc; b.st[1] = nx; }
        const unsigned old = xb_add(&bar[XB_XSUB(b.x)], 1u);
        const unsigned gen = old / nloc;
        if (old + 1u == (gen + 1u) * nloc) {
            __builtin_amdgcn_fence(__ATOMIC_RELEASE, "agent");
            asm volatile("s_waitcnt vmcnt(0)" ::: "memory");
            const unsigned og = xb_add(&bar[XB_TOP], 1u);
            const unsigned tg = og / nx;
            if (og + 1u == (tg + 1u) * nx) xb_add(&bar[XB_TOPGEN], 1u);
            else XB_SPIN(xb_ld(&bar[XB_TOPGEN]) == tg, bar);
            __builtin_amdgcn_fence(__ATOMIC_ACQUIRE, "agent");
            xb_add(&bar[XB_XGEN(b.x)], 1u);
            asm volatile("s_waitcnt vmcnt(0)" ::: "memory");
        } else {
            XB_SPIN(xb_ld(&bar[XB_XGEN(b.x)]) == gen, bar);
            __builtin_amdgcn_fence(__ATOMIC_ACQUIRE, "agent");
            asm volatile("s_waitcnt vmcnt(0)" ::: "memory");
        }
    }
    __syncthreads();
}


#define N_PHASES 22
__device__ __forceinline__ void run_phase(const Params& p, int ph, unsigned char* smem) {
    bf16_t* sm16 = reinterpret_cast<bf16_t*>(smem);
    const bf16_t* W = reinterpret_cast<const bf16_t*>(p.ws + OFF_W);
    bf16_t* ACTB = reinterpret_cast<bf16_t*>(p.ws + OFF_ACTB);
    bf16_t* PB = reinterpret_cast<bf16_t*>(p.ws + OFF_P);
    bf16_t* YC = reinterpret_cast<bf16_t*>(p.ws + OFF_YCAT);
    switch (ph) {
        case 0: phase_pre(p, smem, 0, obid(), ogdim()); break;
        case 1: { PEpiBf16 e{PB, 2304}; big_gemm(ACTB, W + WE_IN0, NT, 2304, DM, e, smem, p.wave); } break;
        case 2: phase_l0_prep(p); break;
        case 3: phase_l0_lora(p, sm16); break;
        case 4: phase_rwkv_r1(p, smem); break;
        case 5: phase_rwkv_r2(p, smem); break;
        case 6: phase_rwkv_r3(p, smem); break;
        case 7: { PEpiOut<false> e{p.in[0], nullptr, PB}; big_gemm(YC, W + WE_OUT0, NT, DM, DM, e, smem, p.wave); } break;
        case 8: phase_ln_route(p, 0, smem); break;
        case 9: phase_exp1(p, 0, sm16); break;
        case 10: phase_exp2(p, 0, sm16); break;
        case 11: phase_ln_ffn(p, 0, p.out, false); break;
        case 12: { PEpiBf16 e{PB, 3072}; big_gemm(ACTB, W + WE_IN1, NT, 3072, DM, e, smem, p.wave); } break;
        case 13: phase_l1_conv(p, smem); break;
        case 14: phase_ret_kv(p, smem); break;
        case 15: phase_ret_scan(p); break;
        case 16: phase_ret_out(p, smem); break;
        case 17: { PEpiOut<true> e{nullptr, ACTB, PB}; big_gemm(YC, W + WE_OUT1, NT, DM, DM, e, smem, p.wave); } break;
        case 18: phase_ln_route(p, 1, smem); break;
        case 19: phase_exp1(p, 1, sm16); break;
        case 20: phase_exp2(p, 1, sm16); break;
        case 21: phase_ln_ffn(p, 1, p.out, true); break;
        default: break;
    }
}

#define SMEM_BYTES 147456
__global__ void __launch_bounds__(NTHREADS) k_mega(Params p) {
    extern __shared__ __attribute__((aligned(16))) unsigned char smem[];
    cg::grid_group grid = cg::this_grid();
    const int wave_s = __builtin_amdgcn_readfirstlane((int)(threadIdx.x >> 6));
    volatile __attribute__((address_space(3))) unsigned* st = (volatile __attribute__((address_space(3))) unsigned*)(smem + 146944);
    {
        const int t0 = otid(wave_s);
        if (t0 < 2) st[t0] = 0u;
    }
    XcdBarrier xb;
#pragma nounroll
    for (int ph = 0; ph < N_PHASES; ++ph) {
        int phv = ph;
        asm volatile("" : "+s"(phv));
        typedef const __attribute__((address_space(4))) Params* KP;
        KP pp = (KP)__builtin_amdgcn_kernarg_segment_ptr();
        asm volatile("" : "+s"(pp));
        Params pl;
        __builtin_memcpy(&pl, (const Params*)pp, sizeof(Params));
        pl.wave = wave_s;
        run_phase(pl, phv, smem);
        if (ph == 0) {
            grid.sync();
            xb = xcd_barrier_post(reinterpret_cast<unsigned*>(pl.ws + OFF_CTRL + 4096), st, otid(wave_s));
        } else if (ph < N_PHASES - 1) {
            xcd_barrier(xb, otid(wave_s));
        }
    }
}

extern "C" void kernel_launch(void* const* d_in, const int* in_sizes, int n_in, void* d_out, int out_size, void* d_ws, size_t ws_size,
                              hipStream_t stream) {
    static int grid_blocks = 0;
    if (!grid_blocks) {
        int dev = 0, cus = 0, per_cu = 0;
        hipGetDevice(&dev);
        hipDeviceGetAttribute(&cus, hipDeviceAttributeMultiprocessorCount, dev);
        hipFuncSetAttribute((const void*)k_mega, hipFuncAttributeMaxDynamicSharedMemorySize, SMEM_BYTES);
        hipOccupancyMaxActiveBlocksPerMultiprocessor(&per_cu, (const void*)k_mega, NTHREADS, SMEM_BYTES);
        if (per_cu < 1) per_cu = 1;
        grid_blocks = cus * per_cu;
    }
    Params p{};
    for (int i = 0; i < 35; ++i) p.in[i] = (const float*)d_in[i];
    p.out = (float*)d_out;
    p.ws = (unsigned char*)d_ws;
    void* args[] = {&p};
    hipError_t e = hipLaunchCooperativeKernel((void*)k_mega, dim3(grid_blocks), dim3(NTHREADS), args, SMEM_BYTES, stream);
    if (e != hipSuccess) fprintf(stderr, "cooperative launch failed: %s (grid %d)\n", hipGetErrorString(e), grid_blocks);
}
```

```cpp
#include <hip/hip_runtime.h>
#include <hip/hip_cooperative_groups.h>
#include <stdint.h>
#include <stdio.h>
namespace cg = cooperative_groups;

typedef unsigned short bf16_t;
typedef short bf16x8 __attribute__((ext_vector_type(8)));
typedef float f32x4 __attribute__((ext_vector_type(4)));

#define NT 32768
#define SEQ 8192
#define DM 1024
#define NTHREADS 512
#define XCD_BAR_WORDS 3456
#define NWAVES 8
#define ALPHA_F 1.41421356237309515f

#define MIB (1024ull * 1024ull)
#define OFF_CTRL 0ull
#define OFF_W (1ull * MIB)
#define OFF_ROPE (65ull * MIB)
#define OFF_ACTB (68ull * MIB)
#define OFF_AA (OFF_ACTB)
#define OFF_GG (OFF_ACTB + 32ull * MIB)
#define OFF_P (132ull * MIB)
#define OFF_LORA (OFF_P + 144ull * MIB)
#define OFF_POOLED (OFF_P + 160ull * MIB)
#define OFF_FS (OFF_P)
#define OFF_HBUF (OFF_P + 128ull * MIB)
#define OFF_YCAT (324ull * MIB)
#define OFF_LOGW (388ull * MIB)
#define OFF_LTOK (452ull * MIB)
#define OFF_LGATE (456ull * MIB)
#define OFF_KVT (460ull * MIB)
#define WE_IN0 0
#define WE_OUT0 2359296
#define WE_IN1 3407872
#define WE_OUT1 6553600
#define WE_W13 7602176
#define WE_W2 24379392
#define WE_LW2 32768000
#define WE_LA2 32800768
#define WE_LG2 32833536
#define WE_POOL 32899072
#define WE_RT_HI 32964608
#define WE_RT_LO 33062912

struct Params {
    const float* in[35];
    float* out;
    unsigned char* ws;
    int wave;
    int pad_;
};

typedef __bf16 hw_bf16x2 __attribute__((ext_vector_type(2)));
typedef float hw_f32x2 __attribute__((ext_vector_type(2)));
__device__ __forceinline__ unsigned pack2(float a, float b) {
    hw_f32x2 v = {a, b};
    hw_bf16x2 r = __builtin_convertvector(v, hw_bf16x2);
    return __builtin_bit_cast(unsigned, r);
}
__device__ __forceinline__ bf16_t f2bf(float f) { return (bf16_t)(pack2(f, 0.f) & 0xffffu); }
__device__ __forceinline__ float bf2f(bf16_t h) { return __uint_as_float(((unsigned)h) << 16); }
__device__ __forceinline__ void unpack8(const uint4 v, float (&o)[8]) {
    o[0] = __uint_as_float(v.x << 16); o[1] = __uint_as_float(v.x & 0xffff0000u);
    o[2] = __uint_as_float(v.y << 16); o[3] = __uint_as_float(v.y & 0xffff0000u);
    o[4] = __uint_as_float(v.z << 16); o[5] = __uint_as_float(v.z & 0xffff0000u);
    o[6] = __uint_as_float(v.w << 16); o[7] = __uint_as_float(v.w & 0xffff0000u);
}
#define DPP_ADD(v, CTRL) ((v) + __int_as_float(__builtin_amdgcn_update_dpp(0, __float_as_int(v), (CTRL), 0xF, 0xF, false)))
__device__ __forceinline__ float row16_sum(float v) {
    v = DPP_ADD(v, 0xB1);
    v = DPP_ADD(v, 0x4E);
    v = DPP_ADD(v, 0x141);
    v = DPP_ADD(v, 0x140);
    return v;
}
__device__ __forceinline__ float wave_sum(float v) {
    v = row16_sum(v);
    const int iv = __float_as_int(v);
    const float s0 = __int_as_float(__builtin_amdgcn_readlane(iv, 0)), s1 = __int_as_float(__builtin_amdgcn_readlane(iv, 16));
    const float s2 = __int_as_float(__builtin_amdgcn_readlane(iv, 32)), s3 = __int_as_float(__builtin_amdgcn_readlane(iv, 48));
    return (s0 + s1) + (s2 + s3);
}
__device__ __forceinline__ float sigmoidf_(float x) { return 1.0f / (1.0f + __expf(-x)); }
__device__ __forceinline__ float siluf_(float x) { return x / (1.0f + __expf(-x)); }
__device__ __forceinline__ float quad_sum(float v) {
    int iv = __float_as_int(v);
    float a = __int_as_float(__builtin_amdgcn_update_dpp(0, iv, 0xB1, 0xF, 0xF, false));
    v += a;
    iv = __float_as_int(v);
    float b = __int_as_float(__builtin_amdgcn_update_dpp(0, iv, 0x4E, 0xF, 0xF, false));
    return v + b;
}

__device__ __forceinline__ void lds_barrier() {
    asm volatile("s_waitcnt lgkmcnt(0)" ::: "memory");
    __builtin_amdgcn_s_barrier();
    asm volatile("" ::: "memory");
}
__device__ __forceinline__ int obid() { int b = (int)blockIdx.x; asm volatile("" : "+s"(b)); return b; }
__device__ __forceinline__ int ogdim() { int b = (int)gridDim.x; asm volatile("" : "+s"(b)); return b; }
__device__ __forceinline__ int otid(int wave) { int t = wave * 64 + (int)__builtin_amdgcn_mbcnt_hi(~0u, __builtin_amdgcn_mbcnt_lo(~0u, 0u)); asm volatile("" : "+v"(t)); return t; }
template <bool GATHER, class Epi>
__device__ __forceinline__ void gemm_tile(const bf16_t* __restrict__ A, int lda, const int* __restrict__ gidx, int gcount,
                                          const bf16_t* __restrict__ Bt, int ldb, int K, int row0, int col0, const Epi& epi,
                                          bf16_t* smem, int wave) {
    const int tidx = otid(wave);
    const int tid = tidx, wid = tid >> 6, lane = tid & 63, wr = wid >> 1, wc = wid & 1, fr = lane & 15, fq = lane >> 4;
    unsigned char* sm = reinterpret_cast<unsigned char*>(smem);
    const bf16_t* ap[4];
    const bf16_t* bp[2];
#pragma unroll
    for (int i = 0; i < 4; ++i) {
        const int pch = tid + i * 512;
        const int r = pch >> 3, c = (pch & 7) ^ (r & 7);
        int ar = row0 + r;
        if (GATHER) {
            int gi = ar < gcount ? ar : gcount - 1;
            ar = gidx[gi] >> 1;
        }
        ap[i] = A + (size_t)ar * lda + c * 8;
    }
#pragma unroll
    for (int i = 0; i < 2; ++i) {
        const int pch = tid + i * 512;
        const int r = pch >> 3, c = (pch & 7) ^ (r & 7);
        bp[i] = Bt + (size_t)(col0 + r) * ldb + c * 8;
    }
    f32x4 acc[4][4];
#pragma unroll
    for (int m = 0; m < 4; ++m)
#pragma unroll
        for (int n = 0; n < 4; ++n) acc[m][n] = (f32x4){0.f, 0.f, 0.f, 0.f};
    const int nk = K >> 6;
#define GT_STAGE(kt, buf) do { _Pragma("unroll") for (int i_ = 0; i_ < 4; ++i_) \
        __builtin_amdgcn_global_load_lds((const unsigned*)(ap[i_] + (kt) * 64), (__attribute__((address_space(3))) unsigned*)(sm + (buf) * 49152 + (tid + i_ * 512) * 16), 16, 0, 0); \
        _Pragma("unroll") for (int i_ = 0; i_ < 2; ++i_) \
        __builtin_amdgcn_global_load_lds((const unsigned*)(bp[i_] + (kt) * 64), (__attribute__((address_space(3))) unsigned*)(sm + (buf) * 49152 + 32768 + (tid + i_ * 512) * 16), 16, 0, 0); } while (0)
    GT_STAGE(0, 0);
    for (int kt = 0; kt < nk; ++kt) {
        const int buf = kt & 1;
        if (kt + 1 < nk) {
            GT_STAGE(kt + 1, buf ^ 1);
            asm volatile("s_waitcnt vmcnt(6)" ::: "memory");
        } else {
            asm volatile("s_waitcnt vmcnt(0)" ::: "memory");
        }
        __builtin_amdgcn_s_barrier();
        asm volatile("" ::: "memory");
        const unsigned char* SA = sm + buf * 49152;
        const unsigned char* SB = SA + 32768;
#pragma unroll
        for (int ks = 0; ks < 2; ++ks) {
            bf16x8 af[4], bfr[4];
            const int cs = ((ks * 4 + fq) ^ (fr & 7)) * 16;
#pragma unroll
            for (int m = 0; m < 4; ++m) af[m] = *reinterpret_cast<const bf16x8*>(SA + (wr * 64 + m * 16 + fr) * 128 + cs);
#pragma unroll
            for (int n = 0; n < 4; ++n) bfr[n] = *reinterpret_cast<const bf16x8*>(SB + (wc * 64 + n * 16 + fr) * 128 + cs);
#pragma unroll
            for (int m = 0; m < 4; ++m)
#pragma unroll
                for (int n = 0; n < 4; ++n) acc[m][n] = __builtin_amdgcn_mfma_f32_16x16x32_bf16(bfr[n], af[m], acc[m][n], 0, 0, 0);
        }
        asm volatile("s_waitcnt lgkmcnt(0)" ::: "memory");
        __builtin_amdgcn_s_barrier();
        asm volatile("" ::: "memory");
    }
#undef GT_STAGE
    epi(acc, row0 + wr * 64, col0 + wc * 64, fr, fq);
}

struct EpiStoreBf16 {
    bf16_t* O; int ldo;
    __device__ __forceinline__ void operator()(f32x4 (&acc)[4][4], int rb, int cb, int fr, int fq) const {
#pragma unroll
        for (int m = 0; m < 4; ++m)
#pragma unroll
            for (int n = 0; n < 4; ++n) {
                int row = rb + m * 16 + fr, col = cb + n * 16 + fq * 4;
                uint2 w; w.x = pack2(acc[m][n][0], acc[m][n][1]); w.y = pack2(acc[m][n][2], acc[m][n][3]);
                *reinterpret_cast<uint2*>(O + (size_t)row * ldo + col) = w;
            }
    }
};
template <int MODE>
struct EpiLora {
    float* Of; bf16_t* Ob; const float* vec; int ldo; int coff;
    __device__ __forceinline__ void operator()(f32x4 (&acc)[4][4], int rb, int cb, int fr, int fq) const {
        float4 pv[4];
#pragma unroll
        for (int n = 0; n < 4; ++n) {
            pv[n] = make_float4(0.f, 0.f, 0.f, 0.f);
            if (MODE == 0 || MODE == 1) pv[n] = *reinterpret_cast<const float4*>(vec + cb + n * 16 + fq * 4);
            else if (MODE == 3) pv[n] = *reinterpret_cast<const float4*>(vec + coff + cb + n * 16 + fq * 4);
        }
#pragma unroll
        for (int m = 0; m < 4; ++m)
#pragma unroll
            for (int n = 0; n < 4; ++n) {
                int row = rb + m * 16 + fr, col = cb + n * 16 + fq * 4;
                const float pvv[4] = {pv[n].x, pv[n].y, pv[n].z, pv[n].w};
                float v[4];
#pragma unroll
                for (int j = 0; j < 4; ++j) {
                    float a = acc[m][n][j];
                    if (MODE == 0) {
                        const float t = -(pvv[j] + a);
                        const float sp = (t > 15.f) ? t : __logf(1.0f + __expf(t));
                        v[j] = -__expf(-sp - 0.5f);
                    } else if (MODE == 1) {
                        v[j] = sigmoidf_(pvv[j] + a);
                    } else if (MODE == 2) {
                        v[j] = a;
                    } else {
                        v[j] = a * pvv[j];
                    }
                }
                uint2 w; w.x = pack2(v[0], v[1]); w.y = pack2(v[2], v[3]);
                *reinterpret_cast<uint2*>(Ob + (size_t)row * ldo + coff + col) = w;
            }
    }
};
struct EpiOut {
    const float* Xprev; float* X;
    __device__ __forceinline__ void operator()(f32x4 (&acc)[4][4], int rb, int cb, int fr, int fq) const {
#pragma unroll
        for (int m = 0; m < 4; ++m)
#pragma unroll
            for (int n = 0; n < 4; ++n) {
                int row = rb + m * 16 + fr, col = cb + n * 16 + fq * 4;
                float4 xp = *reinterpret_cast<const float4*>(Xprev + (size_t)row * DM + col);
                float4 o;
                o.x = ALPHA_F * xp.x + acc[m][n][0]; o.y = ALPHA_F * xp.y + acc[m][n][1];
                o.z = ALPHA_F * xp.z + acc[m][n][2]; o.w = ALPHA_F * xp.w + acc[m][n][3];
                *reinterpret_cast<float4*>(X + (size_t)row * DM + col) = o;
            }
    }
};
struct EpiExp1 {
    bf16_t* H; int base; int cnt;
    __device__ __forceinline__ void operator()(f32x4 (&acc)[4][4], int rb, int cb, int fr, int fq) const {
#pragma unroll
        for (int m = 0; m < 4; ++m) {
            int li = rb + m * 16 + fr;
            if (li < cnt) {
#pragma unroll
                for (int i = 0; i < 2; ++i) {
                    int hcol = (cb >> 1) + i * 16 + fq * 4;
                    float v[4];
#pragma unroll
                    for (int j = 0; j < 4; ++j) v[j] = siluf_(acc[m][2 * i][j]) * acc[m][2 * i + 1][j];
                    uint2 w; w.x = pack2(v[0], v[1]); w.y = pack2(v[2], v[3]);
                    *reinterpret_cast<uint2*>(H + (size_t)(base + li) * 128 + hcol) = w;
                }
            }
        }
    }
};
struct EpiExp2 {
    bf16_t* FS; int pk[4]; float g[4]; int cnt;
    __device__ __forceinline__ void operator()(f32x4 (&acc)[4][4], int rb, int cb, int fr, int fq) const {
#pragma unroll
        for (int m = 0; m < 4; ++m) {
            int li = rb + m * 16 + fr;
            if (li < cnt) {
                const float gg = g[m];
                int tok = pk[m] >> 1, j = pk[m] & 1;
                bf16_t* o = FS + ((size_t)j * NT + tok) * DM;
#pragma unroll
                for (int n = 0; n < 4; ++n) {
                    int col = cb + n * 16 + fq * 4;
                    uint2 w; w.x = pack2(acc[m][n][0] * gg, acc[m][n][1] * gg); w.y = pack2(acc[m][n][2] * gg, acc[m][n][3] * gg);
                    *reinterpret_cast<uint2*>(o + col) = w;
                }
            }
        }
    }
};


namespace pg8 {
#define PG8_LAS __attribute__((address_space(3)))
typedef unsigned short bf16_t;
typedef short bf16x8 __attribute__((ext_vector_type(8)));
typedef float f32x4 __attribute__((ext_vector_type(4)));
typedef unsigned u32x4 __attribute__((ext_vector_type(4)));
constexpr int BM = 256, BK = 64, HALF = 128, HTB = HALF * BK * 2  , STAGE_BYTES = 8 * HTB, NXCD = 8, WGM = 8;

__host__ __device__ __forceinline__ int lds_byte(int r, int c) { const int st = (r >> 4) * 2 + (c >> 5), rr = r & 15, cc = c & 31, ob = rr * 64 + cc * 2; return st * 1024 + (ob ^ (((ob >> 9) & 1) << 5)); }
__host__ __device__ __forceinline__ void stage_rc(int b, int& R, int& C) { const int st = b / 1024, sb = b % 1024, swz = sb ^ (((sb >> 9) & 1) << 5); R = (st >> 1) * 16 + swz / 64; C = (st & 1) * 32 + (swz % 64) / 2; }
__host__ __device__ __forceinline__ int perm32(int rho) { const int n = rho >> 4, i = rho & 15; return 8 * (i >> 2) + 4 * n + (i & 3); }

struct Unit { int pm, pn; };
struct Gemm { const bf16_t* A; const bf16_t* Bt; int M, N, K; };

struct StaticOrder {
    int nM, nN, nwg, G, c;
    __host__ __device__ void init(int M, int N, int G_, int c_) { nM = M / BM; nN = N / BM; nwg = nM * nN; G = G_; c = c_; }
    __host__ __device__ bool next(int i, Unit& u) const {
        const long L = (long)i * G + c; if (L >= nwg) return false;
        int wgid = (int)L; { const int q = nwg / NXCD, r = nwg % NXCD, xcd = wgid % NXCD, off = wgid / NXCD; wgid = (xcd < r ? xcd * (q + 1) : r * (q + 1) + (xcd - r) * q) + off; }
        const int nig = WGM * nN, gid = wgid / nig, fm = gid * WGM, gsz = (nM - fm) < WGM ? (nM - fm) : WGM;
        u.pm = fm + ((wgid % nig) % gsz); u.pn = (wgid % nig) / gsz; return true;
    }
    __device__ __forceinline__ void a_ready(const Unit&) const {}
    __device__ __forceinline__ void done(const Unit&) const {}
};
template <class Epi, class Sched, bool ALIGN_EPI = false, bool SP2 = false>
__device__ __forceinline__ void gemm_phase(PG8_LAS unsigned char* lds, const Gemm g, const Sched& S, const Epi& E, int wave) {
    const int tid = otid(wave), wid = __builtin_amdgcn_readfirstlane(tid >> 6), lane = tid & 63, wr = wid >> 2, wc = wid & 3, fr = lane & 15, fq = lane >> 4;
    const int K = g.K, nt = K / BK;
    unsigned voffA[2], voffB[2];
#pragma unroll
    for (int i = 0; i < 2; ++i) { int R, C; stage_rc(tid * 16 + i * 8192, R, C); const int Rb = Epi::PERM ? ((R & ~31) + perm32(R & 31)) : R;
        voffA[i] = (unsigned)(R * K + C) * 2u; voffB[i] = (unsigned)(Rb * K + C) * 2u; }
    const size_t kstep = (size_t)(BK * 2);
    const size_t hstep = (size_t)HALF * K * 2;
    const size_t tstep = 2 * hstep;
    const unsigned ldsw = (unsigned)wid * 1024u;
    const int aoff = lds_byte(wr * 64 + fr, fq * 8), boff = lds_byte(wc * 32 + fr, fq * 8);
#define PG8_SA(b, h) (((b) * 2 + (h)) * HTB)
#define PG8_SB(b, h) ((4 + (b) * 2 + (h)) * HTB)
#define PG8_STAGE(bufoff, gbase, voff) do { _Pragma("unroll") for (int _i = 0; _i < 2; ++_i) \
        __builtin_amdgcn_global_load_lds((const unsigned*)((const char*)(gbase) + (voff)[_i]), (PG8_LAS unsigned*)(lds + (bufoff) + ldsw + _i * 8192), 16, 0, 0); } while (0)
#define PG8_LDA(dst, b, h) do { _Pragma("unroll") for (int m = 0; m < 4; ++m) _Pragma("unroll") for (int k = 0; k < 2; ++k) dst[m][k] = *(const PG8_LAS bf16x8*)(lds + PG8_SA(b, h) + aoff + m * 2048 + k * 1024); } while (0)
#define PG8_LDB(dst, b, h) do { _Pragma("unroll") for (int n = 0; n < 2; ++n) _Pragma("unroll") for (int k = 0; k < 2; ++k) dst[n][k] = *(const PG8_LAS bf16x8*)(lds + PG8_SB(b, h) + boff + n * 2048 + k * 1024); } while (0)
#define PG8_MMA(ai, bj, At, Bt) do { __builtin_amdgcn_s_setprio(1); _Pragma("unroll") for (int m = 0; m < 4; ++m) _Pragma("unroll") for (int n = 0; n < 2; ++n) _Pragma("unroll") for (int k = 0; k < 2; ++k) \
        acc[ai][bj][m][n] = __builtin_amdgcn_mfma_f32_16x16x32_bf16(Bt[n][k], At[m][k], acc[ai][bj][m][n], 0, 0, 0); __builtin_amdgcn_s_setprio(0); } while (0)
#define PG8_WAIT_V(n) asm volatile("s_waitcnt vmcnt(" #n ")" ::: "memory")
#define PG8_WAIT_L(n) asm volatile("s_waitcnt lgkmcnt(" #n ")" ::: "memory")
#define PG8_BAR __builtin_amdgcn_s_barrier()
#define PG8_SCHED __builtin_amdgcn_sched_barrier(0)
    Unit cur, nxt; int ui = 0;
    if (!S.next(0, cur)) return;
    f32x4 acc[2][2][4][2];
#pragma unroll
    for (int a = 0; a < 2; ++a)
#pragma unroll
        for (int b = 0; b < 2; ++b)
#pragma unroll
            for (int m = 0; m < 4; ++m)
#pragma unroll
                for (int n = 0; n < 2; ++n) acc[a][b][m][n] = (f32x4){0.f, 0.f, 0.f, 0.f};
    bf16x8 At[4][2], B0[2][2], B1[2][2];
    const char* cA = (const char*)g.A + (size_t)cur.pm * tstep; const char* cB = (const char*)g.Bt + (size_t)cur.pn * tstep;
    S.a_ready(cur);
    if constexpr (SP2) {
        PG8_STAGE(PG8_SB(0, 0), cB, voffB); PG8_STAGE(PG8_SB(0, 1), cB + hstep, voffB); PG8_STAGE(PG8_SA(0, 0), cA, voffA); PG8_STAGE(PG8_SA(0, 1), cA + hstep, voffA);
        if (wr == 1) PG8_BAR;
        PG8_WAIT_V(2); PG8_BAR;
        PG8_STAGE(PG8_SB(1, 0), cB + kstep, voffB); PG8_STAGE(PG8_SA(1, 0), cA + kstep, voffA); PG8_STAGE(PG8_SB(1, 1), cB + hstep + kstep, voffB);
        PG8_WAIT_V(6); PG8_BAR;
    } else {
        PG8_STAGE(PG8_SB(0, 0), cB, voffB); PG8_STAGE(PG8_SA(0, 0), cA, voffA); PG8_STAGE(PG8_SB(0, 1), cB + hstep, voffB); PG8_STAGE(PG8_SA(0, 1), cA + hstep, voffA);
        if (wr == 1) PG8_BAR;
        PG8_WAIT_V(4); PG8_BAR;
        PG8_STAGE(PG8_SB(1, 0), cB + kstep, voffB); PG8_STAGE(PG8_SA(1, 0), cA + kstep, voffA); PG8_STAGE(PG8_SB(1, 1), cB + hstep + kstep, voffB);
        PG8_WAIT_V(6); PG8_BAR;
    }
    for (;;) {
        const bool has_next = S.next(ui + 1, nxt);
        const char* nA = has_next ? (const char*)g.A + (size_t)nxt.pm * tstep : cA; const char* nB = has_next ? (const char*)g.Bt + (size_t)nxt.pn * tstep : cB;
        for (int t = 0; t < nt; t += 2) {
            const bool last = (t == nt - 2);
            const char* a1 = cA + (size_t)(t + 1) * kstep;
            const char* a2 = last ? nA : cA + (size_t)(t + 2) * kstep; const char* b2 = last ? nB : cB + (size_t)(t + 2) * kstep;
            const char* a3 = a2 + kstep; const char* b3 = b2 + kstep;
            if (last && has_next) S.a_ready(nxt);
            if constexpr (SP2) {
            PG8_LDB(B0, 0, 0); PG8_LDB(B1, 0, 1); PG8_SCHED; PG8_LDA(At, 0, 0); PG8_STAGE(PG8_SA(1, 1), a1 + hstep, voffA);
            PG8_WAIT_V(8); PG8_WAIT_L(0); PG8_BAR; PG8_MMA(0, 0, At, B0); PG8_MMA(0, 1, At, B1); PG8_BAR; PG8_SCHED;
            PG8_LDA(At, 0, 1); PG8_STAGE(PG8_SB(0, 0), b2, voffB); PG8_STAGE(PG8_SB(0, 1), b2 + hstep, voffB); PG8_STAGE(PG8_SA(0, 0), a2, voffA);
            PG8_WAIT_V(8); PG8_WAIT_L(0); PG8_BAR; PG8_MMA(1, 0, At, B0); PG8_MMA(1, 1, At, B1); PG8_BAR; PG8_SCHED;
            PG8_LDB(B0, 1, 0); PG8_LDB(B1, 1, 1); PG8_SCHED; PG8_LDA(At, 1, 0); PG8_STAGE(PG8_SA(0, 1), a2 + hstep, voffA);
            PG8_WAIT_V(8); PG8_WAIT_L(0); PG8_BAR; PG8_MMA(0, 0, At, B0); PG8_MMA(0, 1, At, B1); PG8_BAR; PG8_SCHED;
            PG8_LDA(At, 1, 1); PG8_STAGE(PG8_SB(1, 0), b3, voffB); PG8_STAGE(PG8_SB(1, 1), b3 + hstep, voffB); PG8_STAGE(PG8_SA(1, 0), a3, voffA);
            PG8_WAIT_V(8); PG8_WAIT_L(0); PG8_BAR; PG8_MMA(1, 0, At, B0); PG8_MMA(1, 1, At, B1); PG8_BAR; PG8_SCHED;
            } else {
            PG8_LDB(B0, 0, 0); PG8_SCHED; PG8_LDA(At, 0, 0); PG8_STAGE(PG8_SA(1, 1), a1 + hstep, voffA);
            PG8_WAIT_L(8); PG8_BAR; PG8_WAIT_L(0); PG8_MMA(0, 0, At, B0); PG8_BAR; PG8_SCHED;
            PG8_LDB(B1, 0, 1); PG8_STAGE(PG8_SB(0, 0), b2, voffB);
            PG8_BAR; PG8_WAIT_L(0); PG8_MMA(0, 1, At, B1); PG8_BAR;
            PG8_LDA(At, 0, 1); PG8_STAGE(PG8_SA(0, 0), a2, voffA);
            PG8_BAR; PG8_WAIT_L(0); PG8_MMA(1, 0, At, B0); PG8_BAR; PG8_SCHED;
            PG8_STAGE(PG8_SB(0, 1), b2 + hstep, voffB);
            PG8_WAIT_V(6); PG8_BAR; PG8_MMA(1, 1, At, B1); PG8_BAR;
            PG8_LDB(B0, 1, 0); PG8_SCHED; PG8_LDA(At, 1, 0); PG8_STAGE(PG8_SA(0, 1), a2 + hstep, voffA);
            PG8_WAIT_L(8); PG8_BAR; PG8_WAIT_L(0); PG8_MMA(0, 0, At, B0); PG8_BAR; PG8_SCHED;
            PG8_LDB(B1, 1, 1); PG8_STAGE(PG8_SB(1, 0), b3, voffB);
            PG8_BAR; PG8_WAIT_L(0); PG8_MMA(0, 1, At, B1); PG8_BAR;
            PG8_LDA(At, 1, 1); PG8_STAGE(PG8_SA(1, 0), a3, voffA);
            PG8_BAR; PG8_WAIT_L(0); PG8_MMA(1, 0, At, B0); PG8_BAR; PG8_SCHED;
            PG8_STAGE(PG8_SB(1, 1), b3 + hstep, voffB);
            PG8_WAIT_V(6); PG8_BAR; PG8_MMA(1, 1, At, B1); PG8_BAR;
            }
        }
        if constexpr (ALIGN_EPI) { if (wr == 0) PG8_BAR; }
        if constexpr (!Epi::AFTER_DRAIN) { E(acc, cur, wr, wc, fr, fq); S.done(cur); }
        if (!has_next) break;
#pragma unroll
        for (int a = 0; a < 2; ++a)
#pragma unroll
            for (int b = 0; b < 2; ++b)
#pragma unroll
                for (int m = 0; m < 4; ++m)
#pragma unroll
                    for (int n = 0; n < 2; ++n) acc[a][b][m][n] = (f32x4){0.f, 0.f, 0.f, 0.f};
        cur = nxt; cA = nA; cB = nB; ++ui;
        if constexpr (ALIGN_EPI) { if (wr == 1) PG8_BAR; }
    }
    PG8_WAIT_V(0);
    if constexpr (!ALIGN_EPI) { if (wr == 0) PG8_BAR; }
    PG8_BAR;
    if constexpr (Epi::AFTER_DRAIN) { E.fused(acc, cur, wr, wc, fr, fq, lds, wid, lane); S.done(cur); }
#undef PG8_SA
#undef PG8_SB
#undef PG8_STAGE
#undef PG8_LDA
#undef PG8_LDB
#undef PG8_MMA
#undef PG8_WAIT_V
#undef PG8_WAIT_L
#undef PG8_BAR
#undef PG8_SCHED
}
}
struct PEpiBf16 {
    static constexpr bool PERM = true, AFTER_DRAIN = false;
    bf16_t* O; int ldo;
    __device__ __forceinline__ void operator()(const pg8::f32x4 (&acc)[2][2][4][2], const pg8::Unit& u, int wr, int wc, int fr, int fq) const {
        const int row0 = u.pm * 256 + wr * 64 + fr, col0 = u.pn * 256 + wc * 32 + 8 * fq;
#pragma unroll
        for (int ai = 0; ai < 2; ++ai)
#pragma unroll
            for (int m = 0; m < 4; ++m) {
                bf16_t* rowp = O + (size_t)(row0 + ai * 128 + m * 16) * ldo + col0;
#pragma unroll
                for (int bj = 0; bj < 2; ++bj) {
                    const pg8::f32x4 v0 = acc[ai][bj][m][0], v1 = acc[ai][bj][m][1];
                    uint4 w; w.x = pack2(v0[0], v0[1]); w.y = pack2(v0[2], v0[3]); w.z = pack2(v1[0], v1[1]); w.w = pack2(v1[2], v1[3]);
                    *reinterpret_cast<uint4*>(rowp + bj * 128) = w;
                }
            }
    }
};
template <bool PREV_BF16>
struct PEpiOut {
    static constexpr bool PERM = true, AFTER_DRAIN = false;
    const float* Xprev; const bf16_t* XprevB; bf16_t* T;
    __device__ __forceinline__ void operator()(const pg8::f32x4 (&acc)[2][2][4][2], const pg8::Unit& u, int wr, int wc, int fr, int fq) const {
        const int row0 = u.pm * 256 + wr * 64 + fr, col0 = u.pn * 256 + wc * 32 + 8 * fq;
#pragma unroll
        for (int ai = 0; ai < 2; ++ai)
#pragma unroll
            for (int m = 0; m < 4; ++m) {
                const size_t ro = (size_t)(row0 + ai * 128 + m * 16) * DM + col0;
#pragma unroll
                for (int bj = 0; bj < 2; ++bj) {
                    const size_t o = ro + bj * 128;
                    float xp[8];
                    if (PREV_BF16) {
                        unpack8(*reinterpret_cast<const uint4*>(XprevB + o), xp);
                    } else {
                        const float4 a = *reinterpret_cast<const float4*>(Xprev + o), b = *reinterpret_cast<const float4*>(Xprev + o + 4);
                        xp[0] = a.x; xp[1] = a.y; xp[2] = a.z; xp[3] = a.w; xp[4] = b.x; xp[5] = b.y; xp[6] = b.z; xp[7] = b.w;
                    }
                    const pg8::f32x4 v0 = acc[ai][bj][m][0], v1 = acc[ai][bj][m][1];
                    uint4 w;
                    w.x = pack2(ALPHA_F * xp[0] + v0[0], ALPHA_F * xp[1] + v0[1]); w.y = pack2(ALPHA_F * xp[2] + v0[2], ALPHA_F * xp[3] + v0[3]);
                    w.z = pack2(ALPHA_F * xp[4] + v1[0], ALPHA_F * xp[5] + v1[1]); w.w = pack2(ALPHA_F * xp[6] + v1[2], ALPHA_F * xp[7] + v1[3]);
                    *reinterpret_cast<uint4*>(T + o) = w;
                }
            }
    }
};
template <class Epi>
__device__ __forceinline__ void big_gemm(const bf16_t* A, const bf16_t* Bt, int M, int N, int K, const Epi& e, unsigned char* smem, int wave) {
    pg8::Gemm g{A, Bt, M, N, K};
    pg8::StaticOrder S;
    S.init(M, N, ogdim(), obid());
    pg8::gemm_phase<Epi, pg8::StaticOrder, true, true>((PG8_LAS unsigned char*)smem, g, S, e, wave);
}

__device__ __forceinline__ void tconv_wave(const float* __restrict__ src, int N, bf16_t* __restrict__ dst, int ldd, int k0, int n0,
                                           int mode, float* tile, int lane) {
#pragma unroll
    for (int i = 0; i < 8; ++i) {
        const int r = i * 8 + (lane >> 3), c4 = (lane & 7) * 4;
        const float4 v = *reinterpret_cast<const float4*>(src + (size_t)(k0 + r) * N + n0 + c4);
        tile[r * 33 + c4] = v.x; tile[r * 33 + c4 + 1] = v.y; tile[r * 33 + c4 + 2] = v.z; tile[r * 33 + c4 + 3] = v.w;
    }
    asm volatile("s_waitcnt lgkmcnt(0)" ::: "memory");
#pragma unroll 8
    for (int nn = 0; nn < 32; ++nn) {
        const int n = n0 + nn;
        int drow = n;
        if (mode == 1) drow = (n >> 4) * 32 + (n & 15);
        else if (mode == 2) drow = (n >> 4) * 32 + 16 + (n & 15);
        dst[(size_t)drow * ldd + k0 + lane] = f2bf(tile[lane * 33 + nn]);
    }
    asm volatile("s_waitcnt lgkmcnt(0)" ::: "memory");
}

__device__ __forceinline__ void phase_pre(const Params& p, unsigned char* smem, int part, int bid, int nb) {
    const int tidx = otid(p.wave);
    const int wv = tidx >> 6, lane = tidx & 63;
    float* tile = reinterpret_cast<float*>(smem) + wv * (64 * 33);
    bf16_t* W = reinterpret_cast<bf16_t*>(p.ws + OFF_W);
    constexpr int T0 = 896, T1 = 512, T7 = 16, T8 = 16, T9 = 32;
    constexpr int T2 = 1536, T3 = 512, T4 = 4096, T5 = 4096, T6 = 4096;
    if (part == 0) {
        if (bid == 0) {
            if (tidx < 64) reinterpret_cast<int*>(p.ws + OFF_CTRL)[tidx] = 0;
            unsigned* bar = reinterpret_cast<unsigned*>(p.ws + OFF_CTRL + 4096);
            for (int i = tidx; i < XCD_BAR_WORDS; i += NTHREADS) bar[i] = 0u;
        }
        constexpr int TOT = T0 + T1 + T7 + T8 + T9;
        for (int u = bid * NWAVES + wv; u < TOT; u += nb * NWAVES) {
            int v = u;
            const float* src; bf16_t* dst; int K, N, tk, tn;
            if (v < T0) { src = p.in[1]; K = 1024; N = 2304; dst = W + WE_IN0; tk = v / 56; tn = v % 56; }
            else if ((v -= T0) < T1) { src = p.in[15]; K = 1024; N = 1024; dst = W + WE_OUT0; tk = v / 32; tn = v % 32; }
            else if ((v -= T1) < T7) { src = p.in[4]; K = 64; N = 512; dst = W + WE_LW2; tk = 0; tn = v; }
            else if ((v -= T7) < T8) { src = p.in[6]; K = 64; N = 512; dst = W + WE_LA2; tk = 0; tn = v; }
            else { v -= T8; src = p.in[7]; K = 128; N = 512; dst = W + WE_LG2; tk = v >> 4; tn = v & 15; }
            tconv_wave(src, N, dst, K, tk * 64, tn * 32, 0, tile, lane);
        }
        __syncthreads();
        {
            float* sWu = reinterpret_cast<float*>(smem);
            float* sPw = sWu + 16 * 128;
            for (int bt = bid; bt < 256; bt += nb) {
                const int g = bt >> 6, k0 = (bt & 63) * 16;
                {
                    const int r = tidx >> 5, c4 = (tidx & 31) * 4;
                    *reinterpret_cast<float4*>(sWu + r * 128 + c4) = *reinterpret_cast<const float4*>(p.in[1] + (size_t)(k0 + r) * 2304 + 1792 + g * 128 + c4);
                }
                for (int i = tidx; i < 128 * 32; i += NTHREADS) {
                    const int r = i >> 5, c4 = (i & 31) * 4;
                    *reinterpret_cast<float4*>(sPw + r * 128 + c4) = *reinterpret_cast<const float4*>(p.in[13] + (size_t)g * 16384 + r * 128 + c4);
                }
                __syncthreads();
                const int k = tidx >> 5, d0 = (tidx & 31) * 4;
                float acc[4] = {0.f, 0.f, 0.f, 0.f};
#pragma unroll 8
                for (int c = 0; c < 128; ++c) {
                    const float a = sWu[k * 128 + c];
                    const float4 bq = *reinterpret_cast<const float4*>(sPw + c * 128 + d0);
                    acc[0] += a * bq.x; acc[1] += a * bq.y; acc[2] += a * bq.z; acc[3] += a * bq.w;
                }
                bf16_t* dstp = W + WE_IN0 + (size_t)(1792 + g * 128 + d0) * 1024 + k0 + k;
#pragma unroll
                for (int j = 0; j < 4; ++j) dstp[(size_t)j * 1024] = f2bf(acc[j]);
                __syncthreads();
            }
        }
        const float4* x4 = reinterpret_cast<const float4*>(p.in[0]);
        uint2* xb = reinterpret_cast<uint2*>(p.ws + OFF_ACTB);
        const size_t n4 = (size_t)NT * DM / 4;
        const size_t stride = (size_t)nb * NTHREADS;
        for (size_t i = (size_t)bid * NTHREADS + tidx; i < n4; i += 8 * stride) {
            float4 v[8];
#pragma unroll
            for (int j = 0; j < 8; ++j) if (i + j * stride < n4) v[j] = x4[i + j * stride];
#pragma unroll
            for (int j = 0; j < 8; ++j) if (i + j * stride < n4) {
                uint2 w; w.x = pack2(v[j].x, v[j].y); w.y = pack2(v[j].z, v[j].w);
                xb[i + j * stride] = w;
            }
        }
    } else {
        constexpr int TOT = T2 + T3 + T4 + T5 + T6;
        for (int u = bid * NWAVES + wv; u < TOT; u += nb * NWAVES) {
            int v = u;
            const float* src; bf16_t* dst; int K, N, mode = 0, tk, tn;
            if (v < T2) { src = p.in[16]; K = 1024; N = 3072; dst = W + WE_IN1; tk = v / 96; tn = v % 96; }
            else if ((v -= T2) < T3) { src = p.in[23]; K = 1024; N = 1024; dst = W + WE_OUT1; tk = v / 32; tn = v % 32; }
            else if ((v -= T3) < T4) { int mat = v >> 6, w = v & 63; src = p.in[30] + (size_t)mat * 131072; K = 1024; N = 128; dst = W + WE_W13 + (size_t)mat * 262144; mode = 1; tk = w >> 2; tn = w & 3; }
            else if ((v -= T4) < T5) { int mat = v >> 6, w = v & 63; src = p.in[31] + (size_t)mat * 131072; K = 1024; N = 128; dst = W + WE_W13 + (size_t)mat * 262144; mode = 2; tk = w >> 2; tn = w & 3; }
            else { v -= T5; int mat = v >> 6, w = v & 63; src = p.in[32] + (size_t)mat * 131072; K = 128; N = 1024; dst = W + WE_W2 + (size_t)mat * 131072; tk = w >> 5; tn = w & 31; }
            tconv_wave(src, N, dst, K, tk * 64, tn * 32, mode, tile, lane);
        }
        {
            bf16_t* RH = W + WE_RT_HI; bf16_t* RL = W + WE_RT_LO;
            for (int i = bid * NTHREADS + tidx; i < 2 * 48 * 1024; i += nb * NTHREADS) {
                const int l = i / (48 * 1024), r = i - l * 48 * 1024, n = r >> 10, k = r & 1023;
                float w = 0.f;
                if (n < 4) w = p.in[26][((size_t)l * 1024 + k) * 4 + n];
                else if (n < 36) w = p.in[28][((size_t)l * 1024 + k) * 32 + (n - 4)];
                const bf16_t h = f2bf(w);
                RH[i] = h; RL[i] = f2bf(w - bf2f(h));
            }
        }
        {
            float2* rope = reinterpret_cast<float2*>(p.ws + OFF_ROPE);
            for (int i = bid * NTHREADS + tidx; i < SEQ * 32; i += nb * NTHREADS) {
                int pos = i >> 5, k = i & 31;
                float inv = powf(10000.0f, -(float)k / 32.0f);
                float ang = (float)pos * inv;
                const double a = (double)ang;
                const double q = rint(a * 0.15915494309189535);
                const float rr = (float)(a - q * 6.283185307179586);
                float s, c;
                sincosf(rr, &s, &c);
                rope[i] = make_float2(c, s);
            }
        }
    }
}

__device__ __forceinline__ void phase_l0_prep(const Params& p) {
    const int tidx = otid(p.wave);
    const bf16_t* P = reinterpret_cast<const bf16_t*>(p.ws + OFF_P);
    bf16_t* LA = reinterpret_cast<bf16_t*>(p.ws + OFF_LORA);
    bf16_t* PO = reinterpret_cast<bf16_t*>(p.ws + OFF_POOLED);
    const float* mu = p.in[2];
    const int total = NT * 96;
    for (int it = obid() * NTHREADS + tidx; it < total; it += ogdim() * NTHREADS) {
        const int tok = it / 96, j = it - tok * 96;
        const int s = tok & (SEQ - 1);
        if (j < 32) {
            const int col = 1536 + j * 8;
            float cur[8], prv[8];
            unpack8(*reinterpret_cast<const uint4*>(P + (size_t)tok * 2304 + col), cur);
            if (s > 0) unpack8(*reinterpret_cast<const uint4*>(P + (size_t)(tok - 1) * 2304 + col), prv);
            else {
#pragma unroll
                for (int i = 0; i < 8; ++i) prv[i] = 0.f;
            }
            const float4 m0 = *reinterpret_cast<const float4*>(mu + col), m1 = *reinterpret_cast<const float4*>(mu + col + 4);
            const float mm[8] = {m0.x, m0.y, m0.z, m0.w, m1.x, m1.y, m1.z, m1.w};
            float o[8];
#pragma unroll
            for (int i = 0; i < 8; ++i) {
                const float z = cur[i] + mm[i] * (prv[i] - cur[i]);
                o[i] = (j < 8) ? (1.0f - 2.0f / (1.0f + __expf(2.0f * z))) : ((j < 16) ? z : sigmoidf_(z));
            }
            uint4 w; w.x = pack2(o[0], o[1]); w.y = pack2(o[2], o[3]); w.z = pack2(o[4], o[5]); w.w = pack2(o[6], o[7]);
            *reinterpret_cast<uint4*>(LA + (size_t)tok * 256 + j * 8) = w;
        } else {
            const int cc = (j - 32) * 8;
            const int gi = cc >> 7;
            const int win = 2 << gi;
            const int cnt = (s + 1 < win) ? (s + 1) : win;
            const bf16_t* src = P + (size_t)tok * 2304 + 1792 + cc;
            float u[8], sum[8];
            uint4 rows[16];
#pragma unroll
            for (int r = 0; r < 16; ++r) {
                rows[r] = make_uint4(0u, 0u, 0u, 0u);
                if (r < cnt) rows[r] = *reinterpret_cast<const uint4*>(src - (size_t)r * 2304);
            }
            unpack8(rows[0], u);
#pragma unroll
            for (int i = 0; i < 8; ++i) sum[i] = u[i];
#pragma unroll
            for (int r = 1; r < 16; ++r) {
                float t[8];
                unpack8(rows[r], t);
#pragma unroll
                for (int i = 0; i < 8; ++i) sum[i] += t[i];
            }
            const float inv = 1.0f / (float)cnt;
            const float4 ps0 = *reinterpret_cast<const float4*>(p.in[14] + cc), ps1 = *reinterpret_cast<const float4*>(p.in[14] + cc + 4);
            uint4 w;
            w.x = pack2((sum[0] * inv - u[0]) * ps0.x, (sum[1] * inv - u[1]) * ps0.y); w.y = pack2((sum[2] * inv - u[2]) * ps0.z, (sum[3] * inv - u[3]) * ps0.w);
            w.z = pack2((sum[4] * inv - u[4]) * ps1.x, (sum[5] * inv - u[5]) * ps1.y); w.w = pack2((sum[6] * inv - u[6]) * ps1.z, (sum[7] * inv - u[7]) * ps1.w);
            *reinterpret_cast<uint4*>(reinterpret_cast<bf16_t*>(p.ws + OFF_YCAT) + (size_t)tok * 1024 + 512 + cc) = w;
        }
    }
}

__device__ __forceinline__ void phase_l0_lora(const Params& p, bf16_t* smem) {
    const bf16_t* W = reinterpret_cast<const bf16_t*>(p.ws + OFF_W);
    const bf16_t* LA = reinterpret_cast<const bf16_t*>(p.ws + OFF_LORA);
    const bf16_t* PO = reinterpret_cast<const bf16_t*>(p.ws + OFF_POOLED);
    for (int t = obid(); t < 1536; t += ogdim()) {
        int job = t >> 9, w = t & 511;
        if (job == 0) {
            EpiLora<0> e{nullptr, reinterpret_cast<bf16_t*>(p.ws + OFF_LOGW), p.in[3], 512, 0};
            gemm_tile<false>(LA, 256, nullptr, 0, W + WE_LW2, 64, 64, (w >> 2) * 256, (w & 3) * 128, e, smem, p.wave);
        } else if (job == 1) {
            EpiLora<1> e{nullptr, reinterpret_cast<bf16_t*>(p.ws + OFF_AA), p.in[5], 512, 0};
            gemm_tile<false>(LA + 64, 256, nullptr, 0, W + WE_LA2, 64, 64, (w >> 2) * 256, (w & 3) * 128, e, smem, p.wave);
        } else {
            EpiLora<2> e{nullptr, reinterpret_cast<bf16_t*>(p.ws + OFF_GG), nullptr, 512, 0};
            gemm_tile<false>(LA + 128, 256, nullptr, 0, W + WE_LG2, 128, 128, (w >> 2) * 256, (w & 3) * 128, e, smem, p.wave);
        }
    }
}

#define RC_LD 72
#define RC_BUF (64 * RC_LD)
#define RC_BYTES (RC_BUF * 2)
#define OFF_TBUF OFF_KVT

__device__ __forceinline__ void mm64(f32x4 (&acc)[2], const bf16_t* A, const bf16_t* Bt, int mt, int nt0, int fr, int fq) {
#pragma unroll
    for (int ks = 0; ks < 2; ++ks) {
        bf16x8 af = *reinterpret_cast<const bf16x8*>(A + (mt * 16 + fr) * RC_LD + ks * 32 + fq * 8);
        bf16x8 bq[2];
#pragma unroll
        for (int n = 0; n < 2; ++n) bq[n] = *reinterpret_cast<const bf16x8*>(Bt + ((nt0 + n) * 16 + fr) * RC_LD + ks * 32 + fq * 8);
#pragma unroll
        for (int n = 0; n < 2; ++n) acc[n] = __builtin_amdgcn_mfma_f32_16x16x32_bf16(af, bq[n], acc[n], 0, 0, 0);
    }
}
template <int MASK>
__device__ __forceinline__ void store_T(bf16_t* dst, const f32x4 (&acc)[2], int mt, int nt0, int fr, int fq) {
#pragma unroll
    for (int n = 0; n < 2; ++n) {
        const int C = (nt0 + n) * 16 + fr, R0 = mt * 16 + fq * 4;
        float v[4];
#pragma unroll
        for (int j = 0; j < 4; ++j) {
            const int R = R0 + j;
            bool keep = true;
            if (MASK == 1) keep = R < C;
            else if (MASK == 2) keep = R <= C;
            else if (MASK == 3) keep = C < R;
            v[j] = keep ? acc[n][j] : 0.f;
        }
        uint2 w; w.x = pack2(v[0], v[1]); w.y = pack2(v[2], v[3]);
        *reinterpret_cast<uint2*>(dst + C * RC_LD + R0) = w;
    }
}
__device__ __forceinline__ void zero_acc(f32x4 (&acc)[2]) {
    acc[0] = (f32x4){0.f, 0.f, 0.f, 0.f};
    acc[1] = (f32x4){0.f, 0.f, 0.f, 0.f};
}

#define OFF_NTB (OFF_P + 144ull * MIB)
#define OFF_S0A (OFF_P + 176ull * MIB)
#define OFF_TB (420ull * MIB)
#define OFF_MB (452ull * MIB)
#define OFF_S0B (484ull * MIB)
#define OFF_WLB (500ull * MIB)
#define OFF_BCB (501ull * MIB)
__device__ __forceinline__ bf16_t* s0_ptr(unsigned char* ws, int u) {
    return reinterpret_cast<bf16_t*>(ws + (u < 2048 ? OFF_S0A : OFF_S0B)) + (size_t)(u & 2047) * 4096;
}

struct PrepIn {
    unsigned short k[8], v[8], r[8], lw[8], a[8];
    unsigned short pk, pv, pr;
};
template <int MODE>
__device__ __forceinline__ void prep_load(PrepIn& in, const Params& p, int u, int tid) {
    const int b = u >> 10, h = (u >> 7) & 7, n = u & 127;
    const int lane = tid & 63, q = tid >> 6;
    const int c = h * 64 + lane;
    const bf16_t* P = reinterpret_cast<const bf16_t*>(p.ws + OFF_P);
    const bf16_t* LOGW = reinterpret_cast<const bf16_t*>(p.ws + OFF_LOGW);
    const bf16_t* AA = reinterpret_cast<const bf16_t*>(p.ws + OFF_AA);
    const int s0 = n * 64 + q * 8;
    const size_t tok0 = (size_t)b * SEQ + s0;
    in.pk = 0; in.pv = 0; in.pr = 0;
    if (s0 > 0) {
        const bf16_t* pp = P + (tok0 - 1) * 2304;
        in.pk = pp[512 + c]; in.pv = pp[1024 + c];
        in.pr = pp[c];
    }
#pragma unroll
    for (int i = 0; i < 8; ++i) {
        const bf16_t* pp = P + (tok0 + i) * 2304;
        in.k[i] = pp[512 + c]; in.v[i] = pp[1024 + c];
        in.r[i] = pp[c];
        in.lw[i] = LOGW[(tok0 + i) * 512 + c];
        in.a[i] = AA[(tok0 + i) * 512 + c];
    }
}
struct PrepC { float mu_k, kkc, kac, mu_v, mu_r, rkc, lng, lnb; };
template <int MODE>
__device__ __forceinline__ PrepC prep_consts(const Params& p, int h, int lane) {
    PrepC c_;
    const int c = h * 64 + lane;
    c_.mu_k = p.in[2][512 + c]; c_.kkc = p.in[8][c]; c_.kac = p.in[9][c]; c_.mu_v = p.in[2][1024 + c];
    c_.mu_r = 0.f; c_.rkc = 0.f; c_.lng = 0.f; c_.lnb = 0.f;
    c_.mu_r = p.in[2][c]; c_.rkc = p.in[10][c];
    if (MODE == 2) { c_.lng = p.in[11][c]; c_.lnb = p.in[12][c]; }
    return c_;
}
template <int MODE>
__device__ __forceinline__ void rwkv_prep(const PrepIn& in, const PrepC& pc, int tid, bf16_t* At, bf16_t* Bt, bf16_t* Kt, bf16_t* Rt,
                                          bf16_t* AtT, bf16_t* BtT, bf16_t* KtT, bf16_t* VT, float* sTot, float* sBC, float* sWL) {
    const int lane = tid & 63, q = tid >> 6;
    const float mu_k = pc.mu_k, kkc = pc.kkc, kac = pc.kac, mu_v = pc.mu_v, mu_r = pc.mu_r, rkc = pc.rkc;
    float lw[8], av[8], zk[8], zr[8], zv[8];
    float pk = bf2f(in.pk), pr = bf2f(in.pr), pv = bf2f(in.pv);
#pragma unroll
    for (int i = 0; i < 8; ++i) {
        const float k0 = bf2f(in.k[i]), v0 = bf2f(in.v[i]);
        zk[i] = k0 + mu_k * (pk - k0); pk = k0;
        zv[i] = v0 + mu_v * (pv - v0); pv = v0;
        { const float r0 = bf2f(in.r[i]); zr[i] = r0 + mu_r * (pr - r0); pr = r0; }
        lw[i] = bf2f(in.lw[i]);
        av[i] = bf2f(in.a[i]);
    }
    float lws[8];
    float cs = 0.f;
#pragma unroll
    for (int i = 0; i < 8; ++i) { cs += lw[i]; lws[i] = cs; }
    sTot[q * 64 + lane] = cs;
    lds_barrier();
    float off = 0.f, tot = 0.f;
#pragma unroll
    for (int qq = 0; qq < 8; ++qq) { float tq = sTot[qq * 64 + lane]; if (qq < q) off += tq; tot += tq; }
    float atv[8], btv[8], ktv[8];
#pragma unroll
    for (int i = 0; i < 8; ++i) {
        const int t = q * 8 + i;
        const float L = lws[i] + off;
        float kk = zk[i] * kkc;
        float ss = wave_sum(kk * kk);
        kk *= rsqrtf(fmaxf(ss, 1e-24f));
        const float e_neg = __expf(-L), e_prev = __expf(L - lw[i]);
        const float a = av[i];
        const float at = -kk * e_prev;
        At[t * RC_LD + lane] = f2bf(at);
        const float bt = kk * a * e_neg;
        Bt[t * RC_LD + lane] = f2bf(bt);
        const float kp = zk[i] * (1.0f + (a - 1.0f) * kac);
        const float kt = kp * e_neg;
        Kt[t * RC_LD + lane] = f2bf(kt);
        atv[i] = at; btv[i] = bt; ktv[i] = kt;
        {
            Rt[t * RC_LD + lane] = f2bf(zr[i] * __expf(L));
            const float bc = wave_sum(zr[i] * kp * rkc);
            if (lane == 0) sBC[t] = bc;
        }
    }
    uint4 w0;
    if (MODE == 1) {
        w0.x = pack2(atv[0], atv[1]); w0.y = pack2(atv[2], atv[3]); w0.z = pack2(atv[4], atv[5]); w0.w = pack2(atv[6], atv[7]);
        *reinterpret_cast<uint4*>(AtT + lane * RC_LD + q * 8) = w0;
        w0.x = pack2(btv[0], btv[1]); w0.y = pack2(btv[2], btv[3]); w0.z = pack2(btv[4], btv[5]); w0.w = pack2(btv[6], btv[7]);
        *reinterpret_cast<uint4*>(BtT + lane * RC_LD + q * 8) = w0;
        w0.x = pack2(ktv[0], ktv[1]); w0.y = pack2(ktv[2], ktv[3]); w0.z = pack2(ktv[4], ktv[5]); w0.w = pack2(ktv[6], ktv[7]);
        *reinterpret_cast<uint4*>(KtT + lane * RC_LD + q * 8) = w0;
        if (q == 0) sWL[lane] = __expf(tot);
    }
    w0.x = pack2(zv[0], zv[1]); w0.y = pack2(zv[2], zv[3]); w0.z = pack2(zv[4], zv[5]); w0.w = pack2(zv[6], zv[7]);
    *reinterpret_cast<uint4*>(VT + lane * RC_LD + q * 8) = w0;
}

__device__ __forceinline__ void phase_rwkv_r1(const Params& p, unsigned char* smem) {
    const int tidx = otid(p.wave);
    const int tid = tidx, wv = tid >> 6, lane = tid & 63, fr = lane & 15, fq = lane >> 4, mt = wv >> 1, nt0 = (wv & 1) * 2;
    bf16_t* base = reinterpret_cast<bf16_t*>(smem);
    bf16_t* At = base; bf16_t* Bt = base + RC_BUF; bf16_t* Kt = base + 2 * RC_BUF; bf16_t* AtT = base + 3 * RC_BUF;
    bf16_t* BtT = base + 4 * RC_BUF; bf16_t* KtT = base + 5 * RC_BUF; bf16_t* VT = base + 6 * RC_BUF;
    bf16_t* Tm = base + 7 * RC_BUF; bf16_t* Aak = base + 8 * RC_BUF; bf16_t* PT = base + 9 * RC_BUF;
    bf16_t* AkVT = base + 10 * RC_BUF; bf16_t* QT = base + 11 * RC_BUF; bf16_t* Arb = base + 12 * RC_BUF;
    bf16_t* Rt = base + 13 * RC_BUF; bf16_t* Ark = base + 14 * RC_BUF;
    float* sTot = reinterpret_cast<float*>(smem + 15 * RC_BYTES);
    float* sWL = sTot + 512;
    float* sBC = sWL + 64;
    bf16_t* PRg = reinterpret_cast<bf16_t*>(p.ws + OFF_AA);
    bf16_t* YQg = reinterpret_cast<bf16_t*>(p.ws + OFF_LOGW);
    float* BCg = reinterpret_cast<float*>(p.ws + OFF_BCB);
    bf16_t* Mg = reinterpret_cast<bf16_t*>(p.ws + OFF_MB);
    bf16_t* Ng = reinterpret_cast<bf16_t*>(p.ws + OFF_NTB);
    float* WLg = reinterpret_cast<float*>(p.ws + OFF_WLB);
    PrepIn cur, nxt;
    if (obid() < 4096) prep_load<1>(cur, p, obid(), tid);
    nxt = cur;
    for (int u = obid(); u < 4096; u += ogdim()) {
        const int h = (u >> 7) & 7, b = u >> 10, n = u & 127;
        PrepC pc = prep_consts<1>(p, h, lane);
        asm volatile("" : "+v"(pc.mu_k), "+v"(pc.kkc), "+v"(pc.kac), "+v"(pc.mu_v), "+v"(pc.mu_r), "+v"(pc.rkc));
        if (u + ogdim() < 4096) prep_load<1>(nxt, p, u + ogdim(), tid);
        bf16_t* R0 = base + 7 * RC_BUF; bf16_t* C0 = base + 8 * RC_BUF; bf16_t* R1 = base + 9 * RC_BUF; bf16_t* C1 = base + 10 * RC_BUF;
        bf16_t* Pm0 = base + 11 * RC_BUF; bf16_t* Pm1 = base + 12 * RC_BUF;
        rwkv_prep<1>(cur, pc, tid, At, Bt, Kt, Rt, AtT, BtT, KtT, VT, sTot, sBC, sWL);
        lds_barrier();
        f32x4 pacc[2];
        {
            f32x4 acc[2];
            zero_acc(acc);
            mm64(acc, At, Bt, mt, nt0, fr, fq);
            store_T<3>(C0, acc, mt, nt0, fr, fq);
            zero_acc(pacc);
            mm64(pacc, Bt, At, mt, nt0, fr, fq);
#pragma unroll
            for (int nn = 0; nn < 2; ++nn)
#pragma unroll
                for (int j = 0; j < 4; ++j) {
                    const int R = mt * 16 + fq * 4 + j, C = (nt0 + nn) * 16 + fr;
                    pacc[nn][j] = (R < C) ? pacc[nn][j] : 0.f;
                }
            store_T<0>(R0, pacc, mt, nt0, fr, fq);
#pragma unroll
            for (int nn = 0; nn < 2; ++nn)
#pragma unroll
                for (int j = 0; j < 4; ++j) {
                    const int R = mt * 16 + fq * 4 + j, C = (nt0 + nn) * 16 + fr;
                    if (R == C) pacc[nn][j] += 1.0f;
                }
            store_T<0>(Pm0, pacc, mt, nt0, fr, fq);
        }
        lds_barrier();
#pragma unroll 1
        for (int j = 1; j <= 5; ++j) {
            f32x4 acc[2];
            if (j < 5) {
                zero_acc(acc);
                mm64(acc, C0, R0, mt, nt0, fr, fq);
                store_T<0>(R1, acc, mt, nt0, fr, fq);
            }
            zero_acc(acc);
            mm64(acc, R0, C0, mt, nt0, fr, fq);
            store_T<0>(C1, acc, mt, nt0, fr, fq);
            lds_barrier();
            zero_acc(acc);
            mm64(acc, C1, Pm0, mt, nt0, fr, fq);
            pacc[0] += acc[0]; pacc[1] += acc[1];
            if (j < 5) store_T<0>(Pm1, pacc, mt, nt0, fr, fq);
            lds_barrier();
            bf16_t* t0 = R0; R0 = R1; R1 = t0;
            t0 = C0; C0 = C1; C1 = t0;
            t0 = Pm0; Pm0 = Pm1; Pm1 = t0;
        }
        store_T<0>(Tm, pacc, mt, nt0, fr, fq);
        {
            f32x4 acc[2];
            zero_acc(acc); mm64(acc, Kt, At, mt, nt0, fr, fq); store_T<1>(Aak, acc, mt, nt0, fr, fq);
            zero_acc(acc); mm64(acc, Bt, Rt, mt, nt0, fr, fq); store_T<2>(Arb, acc, mt, nt0, fr, fq);
            zero_acc(acc); mm64(acc, Kt, Rt, mt, nt0, fr, fq); store_T<2>(Ark, acc, mt, nt0, fr, fq);
        }
        lds_barrier();
        {
            f32x4 acc[2];
            zero_acc(acc); mm64(acc, Tm, AtT, mt, nt0, fr, fq); store_T<0>(PT, acc, mt, nt0, fr, fq);
            zero_acc(acc); mm64(acc, Aak, VT, mt, nt0, fr, fq); store_T<0>(AkVT, acc, mt, nt0, fr, fq);
        }
        lds_barrier();
        {
            f32x4 acc[2];
            zero_acc(acc); mm64(acc, Tm, AkVT, mt, nt0, fr, fq); store_T<0>(QT, acc, mt, nt0, fr, fq);
            zero_acc(acc); mm64(acc, PT, BtT, mt, nt0, fr, fq);
            bf16_t* Mo = Mg + (size_t)u * 4096;
#pragma unroll
            for (int nn = 0; nn < 2; ++nn) {
                const int C = (nt0 + nn) * 16 + fr, Rb = mt * 16 + fq * 4;
                const float wl = sWL[C];
                uint2 w; w.x = pack2(acc[nn][0] * wl, acc[nn][1] * wl); w.y = pack2(acc[nn][2] * wl, acc[nn][3] * wl);
                const int pos = (Rb & ~12) | ((Rb & 4) << 1) | ((Rb & 8) >> 1);
                const int posw = ((((pos >> 3) ^ (C & 7)) << 3) | (pos & 7));
                *reinterpret_cast<uint2*>(Mo + C * 64 + posw) = w;
            }
        }
        lds_barrier();
        {
            f32x4 acc[2];
            zero_acc(acc); mm64(acc, BtT, QT, mt, nt0, fr, fq); mm64(acc, KtT, VT, mt, nt0, fr, fq);
            bf16_t* No = Ng + (size_t)u * 4096;
            float wl[4];
#pragma unroll
            for (int j = 0; j < 4; ++j) wl[j] = sWL[mt * 16 + fq * 4 + j];
#pragma unroll
            for (int nn = 0; nn < 2; ++nn) {
                const int C = (nt0 + nn) * 16 + fr, Rb = mt * 16 + fq * 4;
                uint2 w; w.x = pack2(acc[nn][0] * wl[0], acc[nn][1] * wl[1]); w.y = pack2(acc[nn][2] * wl[2], acc[nn][3] * wl[3]);
                const int posw = ((((Rb >> 3) ^ (C & 7)) << 3) | (Rb & 7));
                *reinterpret_cast<uint2*>(No + C * 64 + posw) = w;
            }
            if (tid < 64) { WLg[(size_t)u * 64 + tid] = sWL[tid]; BCg[(size_t)u * 64 + tid] = sBC[tid]; }
            const size_t tok0 = (size_t)b * SEQ + n * 64;
            zero_acc(acc); mm64(acc, PT, Arb, mt, nt0, fr, fq);
#pragma unroll
            for (int nn = 0; nn < 2; ++nn) {
                const int C = (nt0 + nn) * 16 + fr, Rb = mt * 16 + fq * 4;
                const uint2 rt = *reinterpret_cast<const uint2*>(Rt + C * RC_LD + Rb);
                uint2 w;
                w.x = pack2(acc[nn][0] + __uint_as_float(rt.x << 16), acc[nn][1] + __uint_as_float(rt.x & 0xffff0000u));
                w.y = pack2(acc[nn][2] + __uint_as_float(rt.y << 16), acc[nn][3] + __uint_as_float(rt.y & 0xffff0000u));
                *reinterpret_cast<uint2*>(PRg + (tok0 + C) * 512 + h * 64 + Rb) = w;
            }
            zero_acc(acc); mm64(acc, QT, Arb, mt, nt0, fr, fq); mm64(acc, VT, Ark, mt, nt0, fr, fq);
#pragma unroll
            for (int nn = 0; nn < 2; ++nn) {
                const int C = (nt0 + nn) * 16 + fr, Rb = mt * 16 + fq * 4;
                uint2 w; w.x = pack2(acc[nn][0], acc[nn][1]); w.y = pack2(acc[nn][2], acc[nn][3]);
                *reinterpret_cast<uint2*>(YQg + (tok0 + C) * 512 + h * 64 + Rb) = w;
            }
        }
        cur = nxt;
        lds_barrier();
    }
}

typedef float f32x16 __attribute__((ext_vector_type(16)));
#define R2_SLOT 12800
__device__ __forceinline__ void r2_issue(const unsigned char* Mg, const unsigned char* Ng, const unsigned char* WLg, size_t u, int J, int lane,
                                         unsigned char* slot) {
#pragma unroll
    for (int i = 0; i < 8; ++i)
        __builtin_amdgcn_global_load_lds((const unsigned*)(Mg + u * 8192 + i * 1024 + lane * 16),
                                         (__attribute__((address_space(3))) unsigned*)(slot + i * 1024), 16, 0, 0);
#pragma unroll
    for (int i = 0; i < 4; ++i)
        __builtin_amdgcn_global_load_lds((const unsigned*)(Ng + u * 8192 + J * 4096 + i * 1024 + lane * 16),
                                         (__attribute__((address_space(3))) unsigned*)(slot + 8192 + i * 1024), 16, 0, 0);
    __builtin_amdgcn_global_load_lds((const unsigned*)(WLg + u * 256 + lane * 4),
                                     (__attribute__((address_space(3))) unsigned*)(slot + 12288), 4, 0, 0);
}
__device__ __forceinline__ unsigned lds_addr(const void* p) { return (unsigned)(size_t)(const __attribute__((address_space(3))) unsigned char*)p; }
template <int OFF> __device__ __forceinline__ void ldsr128(bf16x8& d, unsigned a) { asm volatile("ds_read_b128 %0, %1 offset:%2" : "=v"(d) : "v"(a), "n"(OFF)); }
template <int OFF> __device__ __forceinline__ void ldsr128f(float4& d, unsigned a) { asm volatile("ds_read_b128 %0, %1 offset:%2" : "=v"(d) : "v"(a), "n"(OFF)); }
template <int OFF> __device__ __forceinline__ void ldsr64(uint2& d, unsigned a) { asm volatile("ds_read_b64 %0, %1 offset:%2" : "=v"(d) : "v"(a), "n"(OFF)); }
template <int WAITN>
__device__ __forceinline__ void r2_step(f32x16 (&S)[2], const unsigned char* slot, bf16_t* so, int r, int h) {
    if (WAITN == 51) asm volatile("s_waitcnt vmcnt(51)" ::: "memory");
    else if (WAITN == 39) asm volatile("s_waitcnt vmcnt(39)" ::: "memory");
    else asm volatile("s_waitcnt vmcnt(0)" ::: "memory");
    uint2 nv[2][4]; float4 wl[2][4]; bf16x8 af[2][2][2];
    const unsigned sa = lds_addr(slot);
    {
        const unsigned aw = sa + 12288 + h * 16;
        ldsr128f<0>(wl[0][0], aw); ldsr128f<32>(wl[0][1], aw); ldsr128f<64>(wl[0][2], aw); ldsr128f<96>(wl[0][3], aw);
        ldsr128f<128>(wl[1][0], aw); ldsr128f<160>(wl[1][1], aw); ldsr128f<192>(wl[1][2], aw); ldsr128f<224>(wl[1][3], aw);
        const unsigned an = sa + 8192 + r * 128 + h * 8;
        const unsigned x0 = ((0 ^ (r & 7)) * 16), x1 = ((1 ^ (r & 7)) * 16), x2 = ((2 ^ (r & 7)) * 16), x3 = ((3 ^ (r & 7)) * 16);
        ldsr64<0>(nv[0][0], an + x0); ldsr64<0>(nv[0][1], an + x1); ldsr64<0>(nv[0][2], an + x2); ldsr64<0>(nv[0][3], an + x3);
        ldsr64<0>(nv[1][0], an + (x0 ^ 64)); ldsr64<0>(nv[1][1], an + (x1 ^ 64)); ldsr64<0>(nv[1][2], an + (x2 ^ 64)); ldsr64<0>(nv[1][3], an + (x3 ^ 64));
        const unsigned aa = sa + r * 128;
        const unsigned c00 = (((0 + h) ^ (r & 7)) * 16), c01 = (((2 + h) ^ (r & 7)) * 16), c10 = (((4 + h) ^ (r & 7)) * 16), c11 = (((6 + h) ^ (r & 7)) * 16);
        ldsr128<0>(af[0][0][0], aa + c00); ldsr128<0>(af[0][0][1], aa + c01); ldsr128<0>(af[0][1][0], aa + c10); ldsr128<0>(af[0][1][1], aa + c11);
        ldsr128<4096>(af[1][0][0], aa + c00); ldsr128<4096>(af[1][0][1], aa + c01); ldsr128<4096>(af[1][1][0], aa + c10); ldsr128<4096>(af[1][1][1], aa + c11);
    }
    unsigned pk[2][8];
#pragma unroll
    for (int K = 0; K < 2; ++K)
#pragma unroll
        for (int q = 0; q < 8; ++q) pk[K][q] = pack2(S[K][2 * q], S[K][2 * q + 1]);
#pragma unroll
    for (int I = 0; I < 2; ++I) {
        uint4 w0, w1;
        w0.x = pk[I][0]; w0.y = pk[I][1]; w0.z = pk[I][2]; w0.w = pk[I][3];
        w1.x = pk[I][4]; w1.y = pk[I][5]; w1.z = pk[I][6]; w1.w = pk[I][7];
        *reinterpret_cast<uint4*>(so + r * 64 + I * 32 + h * 16) = w0;
        *reinterpret_cast<uint4*>(so + r * 64 + I * 32 + h * 16 + 8) = w1;
    }
    asm volatile("s_waitcnt lgkmcnt(0)" ::: "memory");
    __builtin_amdgcn_sched_barrier(0);
    bf16x8 bfrag[2][2];
#pragma unroll
    for (int K = 0; K < 2; ++K)
#pragma unroll
        for (int s = 0; s < 2; ++s) {
            union { bf16x8 v; unsigned u[4]; } cvt;
#pragma unroll
            for (int q = 0; q < 4; ++q) cvt.u[q] = pk[K][4 * s + q];
            bfrag[K][s] = cvt.v;
        }
#pragma unroll
    for (int I = 0; I < 2; ++I) {
        f32x16 acc;
#pragma unroll
        for (int g = 0; g < 4; ++g) {
            acc[4 * g + 0] = __uint_as_float(nv[I][g].x << 16) + wl[I][g].x * S[I][4 * g + 0];
            acc[4 * g + 1] = __uint_as_float(nv[I][g].x & 0xffff0000u) + wl[I][g].y * S[I][4 * g + 1];
            acc[4 * g + 2] = __uint_as_float(nv[I][g].y << 16) + wl[I][g].z * S[I][4 * g + 2];
            acc[4 * g + 3] = __uint_as_float(nv[I][g].y & 0xffff0000u) + wl[I][g].w * S[I][4 * g + 3];
        }
#pragma unroll
        for (int K = 0; K < 2; ++K)
#pragma unroll
            for (int s = 0; s < 2; ++s) acc = __builtin_amdgcn_mfma_f32_32x32x16_bf16(af[I][K][s], bfrag[K][s], acc, 0, 0, 0);
        S[I] = acc;
    }
}
__device__ __forceinline__ void phase_rwkv_r2(const Params& p, unsigned char* smem) {
    const int tidx = otid(p.wave);
    if (obid() >= 64) { phase_pre(p, smem, 1, obid() - 64, ogdim() - 64); return; }
    if (p.wave != 0) return;
    const int task = obid(), bh = task >> 1, J = task & 1;
    const int lane = tidx & 63, r = lane & 31, h = lane >> 5;
    const unsigned char* Mg = p.ws + OFF_MB;
    const unsigned char* Ng = p.ws + OFF_NTB;
    const unsigned char* WLg = p.ws + OFF_WLB;
    f32x16 S[2];
#pragma unroll
    for (int i = 0; i < 16; ++i) { S[0][i] = 0.f; S[1][i] = 0.f; }
    const size_t ub = (size_t)bh * 128;
    r2_issue(Mg, Ng, WLg, ub + 0, J, lane, smem + 0 * R2_SLOT);
    r2_issue(Mg, Ng, WLg, ub + 1, J, lane, smem + 1 * R2_SLOT);
    r2_issue(Mg, Ng, WLg, ub + 2, J, lane, smem + 2 * R2_SLOT);
#define R2_STEP(n_, SL, W) do { \
        const int n2 = (n_); \
        if (n2 + 3 < 128) r2_issue(Mg, Ng, WLg, ub + n2 + 3, J, lane, smem + (((SL) + 3) & 3) * R2_SLOT); \
        r2_step<W>(S, smem + (SL) * R2_SLOT, s0_ptr(p.ws, (int)ub + n2) + (size_t)J * 32 * 64, r, h); } while (0)
    R2_STEP(0, 0, 39); R2_STEP(1, 1, 39); R2_STEP(2, 2, 39); R2_STEP(3, 3, 51);
#pragma unroll 1
    for (int n = 4; n < 124; n += 4) {
        R2_STEP(n, 0, 51); R2_STEP(n + 1, 1, 51); R2_STEP(n + 2, 2, 51); R2_STEP(n + 3, 3, 51);
    }
    R2_STEP(124, 0, 51); R2_STEP(125, 1, 0); R2_STEP(126, 2, 0); R2_STEP(127, 3, 0);
#undef R2_STEP
}

struct R3In { uint4 pr, s0; uint2 yq[2]; unsigned short v[8], g[8]; unsigned short pv; float bc[8]; };
__device__ __forceinline__ void r3_load(R3In& in, const Params& p, int u, int tid) {
    const int b = u >> 10, h = (u >> 7) & 7, n = u & 127;
    const int wv = tid >> 6, lane = tid & 63, fr = lane & 15, fq = lane >> 4, mt = wv >> 1, nt0 = (wv & 1) * 2;
    const size_t tok0 = (size_t)b * SEQ + n * 64;
    const bf16_t* PRg = reinterpret_cast<const bf16_t*>(p.ws + OFF_AA);
    const bf16_t* YQg = reinterpret_cast<const bf16_t*>(p.ws + OFF_LOGW);
    const bf16_t* GG = reinterpret_cast<const bf16_t*>(p.ws + OFF_GG);
    const bf16_t* P = reinterpret_cast<const bf16_t*>(p.ws + OFF_P);
    const float* BCg = reinterpret_cast<const float*>(p.ws + OFF_BCB);
    const int row = tid >> 3, ch = tid & 7;
    in.pr = *reinterpret_cast<const uint4*>(PRg + (tok0 + row) * 512 + h * 64 + ch * 8);
    in.s0 = reinterpret_cast<const uint4*>(s0_ptr(p.ws, u))[tid];
#pragma unroll
    for (int nn = 0; nn < 2; ++nn) in.yq[nn] = *reinterpret_cast<const uint2*>(YQg + (tok0 + (nt0 + nn) * 16 + fr) * 512 + h * 64 + mt * 16 + fq * 4);
    const int c = h * 64 + lane;
    const int s0i = n * 64 + wv * 8;
    in.pv = (s0i > 0) ? P[(tok0 + wv * 8 - 1) * 2304 + 1024 + c] : (unsigned short)0;
#pragma unroll
    for (int i = 0; i < 8; ++i) {
        in.v[i] = P[(tok0 + wv * 8 + i) * 2304 + 1024 + c];
        in.g[i] = GG[(tok0 + wv * 8 + i) * 512 + c];
        in.bc[i] = BCg[(size_t)u * 64 + wv * 8 + i];
    }
}
__device__ __forceinline__ void phase_rwkv_r3(const Params& p, unsigned char* smem) {
    const int tidx = otid(p.wave);
    const int tid = tidx, wv = tid >> 6, lane = tid & 63, fr = lane & 15, fq = lane >> 4, mt = wv >> 1, nt0 = (wv & 1) * 2;
    bf16_t* base = reinterpret_cast<bf16_t*>(smem);
    bf16_t* Prs = base; bf16_t* Sb = base + RC_BUF;
    float* Yf = reinterpret_cast<float*>(smem + 2 * RC_BYTES);
    bf16_t* YC = reinterpret_cast<bf16_t*>(p.ws + OFF_YCAT);
    R3In cur, nxt;
    if (obid() < 4096) r3_load(cur, p, obid(), tid);
    nxt = cur;
    for (int u = obid(); u < 4096; u += ogdim()) {
        const int b = u >> 10, h = (u >> 7) & 7, n = u & 127;
        const int c = h * 64 + lane;
        float mu_v = p.in[2][1024 + c], lng = p.in[11][c], lnb = p.in[12][c];
        asm volatile("" : "+v"(mu_v), "+v"(lng), "+v"(lnb));
        if (u + ogdim() < 4096) r3_load(nxt, p, u + ogdim(), tid);
        {
            const int row = tid >> 3, ch = tid & 7;
            *reinterpret_cast<uint4*>(Prs + row * RC_LD + ch * 8) = cur.pr;
            const int I = ch >> 2, hh = (ch >> 1) & 1, g0 = (ch & 1) * 2;
            const int k0 = I * 32 + 8 * g0 + 4 * hh;
            uint2 lo; lo.x = cur.s0.x; lo.y = cur.s0.y;
            uint2 hi; hi.x = cur.s0.z; hi.y = cur.s0.w;
            *reinterpret_cast<uint2*>(Sb + row * RC_LD + k0) = lo;
            *reinterpret_cast<uint2*>(Sb + row * RC_LD + k0 + 8) = hi;
        }
        lds_barrier();
        {
            f32x4 acc[2];
            zero_acc(acc);
            mm64(acc, Sb, Prs, mt, nt0, fr, fq);
#pragma unroll
            for (int nn = 0; nn < 2; ++nn) {
                const int C = (nt0 + nn) * 16 + fr, Rb = mt * 16 + fq * 4;
                const uint2 q = cur.yq[nn];
                float4 o;
                o.x = acc[nn][0] + __uint_as_float(q.x << 16); o.y = acc[nn][1] + __uint_as_float(q.x & 0xffff0000u);
                o.z = acc[nn][2] + __uint_as_float(q.y << 16); o.w = acc[nn][3] + __uint_as_float(q.y & 0xffff0000u);
                *reinterpret_cast<float4*>(Yf + C * 68 + Rb) = o;
            }
        }
        lds_barrier();
        {
            float pv = bf2f(cur.pv);
#pragma unroll
            for (int i = 0; i < 8; ++i) {
                const int t = wv * 8 + i;
                const size_t tok = (size_t)b * SEQ + n * 64 + t;
                const float y = Yf[t * 68 + lane];
                const float mean = wave_sum(y) * (1.0f / 64.0f);
                const float d = y - mean;
                const float var = wave_sum(d * d) * (1.0f / 64.0f);
                const float yn = d * rsqrtf(var + 64e-5f) * lng + lnb;
                const float g = bf2f(cur.g[i]);
                const float v0 = bf2f(cur.v[i]);
                const float vv = bf2f(f2bf(v0 + mu_v * (pv - v0)));
                pv = v0;
                YC[tok * 1024 + c] = f2bf((yn + cur.bc[i] * vv) * g);
            }
        }
        cur = nxt;
    }
}

#define LR_LD 1032
__device__ __forceinline__ void phase_ln_route(const Params& p, int layer, unsigned char* smem) {
    const bf16_t* X = reinterpret_cast<const bf16_t*>(p.ws + OFF_P);
    const int tidx = otid(p.wave);
    const int tid = tidx, wv = tid >> 6, lane = tid & 63, fr = lane & 15, fq = lane >> 4;
    const float* g = p.in[24] + layer * DM;
    const float* bb = p.in[25] + layer * DM;
    const float* rgb = p.in[27] + layer * 4;
    const float* reb = p.in[29] + layer * 32;
    const bf16_t* RH = reinterpret_cast<const bf16_t*>(p.ws + OFF_W) + WE_RT_HI + (size_t)layer * 48 * 1024;
    const bf16_t* RL = reinterpret_cast<const bf16_t*>(p.ws + OFF_W) + WE_RT_LO + (size_t)layer * 48 * 1024;
    bf16_t* XB = reinterpret_cast<bf16_t*>(p.ws + OFF_ACTB);
    int* cnt = reinterpret_cast<int*>(p.ws + OFF_CTRL) + layer * 32;
    int* ltok = reinterpret_cast<int*>(p.ws + OFF_LTOK);
    float* lgate = reinterpret_cast<float*>(p.ws + OFF_LGATE);
    bf16_t* sXH = reinterpret_cast<bf16_t*>(smem);
    bf16_t* sXL = sXH + 16 * LR_LD;
    float* sRed = reinterpret_cast<float*>(smem + 2 * 16 * LR_LD * 2);
    float* sLog = sRed + 8 * 16 * 48;
    bf16x8 bh[4][3], bl[4][3];
#pragma unroll
    for (int ks = 0; ks < 4; ++ks)
#pragma unroll
        for (int nt = 0; nt < 3; ++nt) {
            const int k0 = wv * 128 + ks * 32 + fq * 8;
            bh[ks][nt] = *reinterpret_cast<const bf16x8*>(RH + (size_t)(nt * 16 + fr) * 1024 + k0);
            bl[ks][nt] = *reinterpret_cast<const bf16x8*>(RL + (size_t)(nt * 16 + fr) * 1024 + k0);
        }
    float4 gg[4], bv[4];
#pragma unroll
    for (int i = 0; i < 4; ++i) {
        gg[i] = *reinterpret_cast<const float4*>(g + i * 256 + lane * 4);
        bv[i] = *reinterpret_cast<const float4*>(bb + i * 256 + lane * 4);
    }
    int* sCnt = reinterpret_cast<int*>(sLog + 16 * 48);
    int* sBase = sCnt + 32;
    int* sDecE = sBase + 32;
    int* sDecP = sDecE + 256;
    float* sDecG = reinterpret_cast<float*>(sDecP + 256);
    int* sDecR = reinterpret_cast<int*>(sDecG + 256);
    if (tid < 32) sCnt[tid] = 0;
    uint2 pre[2][4];
    {
        const int tile0 = obid();
        if (tile0 < NT / 16) {
#pragma unroll
            for (int rr = 0; rr < 2; ++rr)
#pragma unroll
                for (int i = 0; i < 4; ++i)
                    pre[rr][i] = *reinterpret_cast<const uint2*>(X + (size_t)(tile0 * 16 + wv * 2 + rr) * DM + i * 256 + lane * 4);
        }
    }
    __syncthreads();
    int nloc = 0;
    for (int tile = obid(); tile < NT / 16; tile += ogdim(), ++nloc) {
        uint2 cur[2][4];
#pragma unroll
        for (int rr = 0; rr < 2; ++rr)
#pragma unroll
            for (int i = 0; i < 4; ++i) cur[rr][i] = pre[rr][i];
        {
            const int tn = tile + ogdim();
            if (tn < NT / 16) {
#pragma unroll
                for (int rr = 0; rr < 2; ++rr)
#pragma unroll
                    for (int i = 0; i < 4; ++i)
                        pre[rr][i] = *reinterpret_cast<const uint2*>(X + (size_t)(tn * 16 + wv * 2 + rr) * DM + i * 256 + lane * 4);
            }
        }
#pragma unroll
        for (int rr = 0; rr < 2; ++rr) {
            const int rl = wv * 2 + rr;
            const int row = tile * 16 + rl;
            float v[16];
#pragma unroll
            for (int i = 0; i < 4; ++i) {
                const uint2 t = cur[rr][i];
                v[4 * i] = __uint_as_float(t.x << 16); v[4 * i + 1] = __uint_as_float(t.x & 0xffff0000u);
                v[4 * i + 2] = __uint_as_float(t.y << 16); v[4 * i + 3] = __uint_as_float(t.y & 0xffff0000u);
            }
            float sum = 0.f;
#pragma unroll
            for (int i = 0; i < 16; ++i) sum += v[i];
            const float mean = wave_sum(sum) * (1.0f / DM);
            float sq = 0.f;
#pragma unroll
            for (int i = 0; i < 16; ++i) { float d = v[i] - mean; sq += d * d; }
            const float rstd = rsqrtf(wave_sum(sq) * (1.0f / DM) + 1e-5f);
#pragma unroll
            for (int i = 0; i < 4; ++i) {
                const int col = i * 256 + lane * 4;
                const float o0 = (v[4 * i] - mean) * rstd * gg[i].x + bv[i].x;
                const float o1 = (v[4 * i + 1] - mean) * rstd * gg[i].y + bv[i].y;
                const float o2 = (v[4 * i + 2] - mean) * rstd * gg[i].z + bv[i].z;
                const float o3 = (v[4 * i + 3] - mean) * rstd * gg[i].w + bv[i].w;
                const bf16_t h0 = f2bf(o0), h1 = f2bf(o1), h2 = f2bf(o2), h3 = f2bf(o3);
                uint2 wh; wh.x = (unsigned)h0 | ((unsigned)h1 << 16); wh.y = (unsigned)h2 | ((unsigned)h3 << 16);
                *reinterpret_cast<uint2*>(XB + (size_t)row * DM + col) = wh;
                *reinterpret_cast<uint2*>(sXH + rl * LR_LD + col) = wh;
                uint2 wl; wl.x = pack2(o0 - bf2f(h0), o1 - bf2f(h1)); wl.y = pack2(o2 - bf2f(h2), o3 - bf2f(h3));
                *reinterpret_cast<uint2*>(sXL + rl * LR_LD + col) = wl;
            }
        }
        lds_barrier();
        {
            f32x4 acc[3];
#pragma unroll
            for (int nt = 0; nt < 3; ++nt) acc[nt] = (f32x4){0.f, 0.f, 0.f, 0.f};
#pragma unroll
            for (int ks = 0; ks < 4; ++ks) {
                const int k0 = wv * 128 + ks * 32 + fq * 8;
                const bf16x8 ah = *reinterpret_cast<const bf16x8*>(sXH + fr * LR_LD + k0);
                const bf16x8 al = *reinterpret_cast<const bf16x8*>(sXL + fr * LR_LD + k0);
#pragma unroll
                for (int nt = 0; nt < 3; ++nt) {
                    acc[nt] = __builtin_amdgcn_mfma_f32_16x16x32_bf16(ah, bh[ks][nt], acc[nt], 0, 0, 0);
                    acc[nt] = __builtin_amdgcn_mfma_f32_16x16x32_bf16(al, bh[ks][nt], acc[nt], 0, 0, 0);
                    acc[nt] = __builtin_amdgcn_mfma_f32_16x16x32_bf16(ah, bl[ks][nt], acc[nt], 0, 0, 0);
                }
            }
#pragma unroll
            for (int nt = 0; nt < 3; ++nt)
#pragma unroll
                for (int j = 0; j < 4; ++j) sRed[(wv * 16 + fq * 4 + j) * 48 + nt * 16 + fr] = acc[nt][j];
        }
        lds_barrier();
        for (int idx = tid; idx < 16 * 48; idx += NTHREADS) {
            float s = 0.f;
#pragma unroll
            for (int w = 0; w < 8; ++w) s += sRed[w * 16 * 48 + idx];
            sLog[idx] = s;
        }
        lds_barrier();
        if (tid < 16) {
            const int row = tile * 16 + tid;
            const float* lg = sLog + tid * 48;
            float gl[4];
#pragma unroll
            for (int j = 0; j < 4; ++j) gl[j] = lg[j] + rgb[j];
            int gi = 0; float gm = gl[0];
#pragma unroll
            for (int j = 1; j < 4; ++j) if (gl[j] > gm) { gm = gl[j]; gi = j; }
            float gs = 0.f;
#pragma unroll
            for (int j = 0; j < 4; ++j) gs += __expf(gl[j] - gm);
            const float gw = 1.0f / gs;
            float el[8];
#pragma unroll
            for (int j = 0; j < 8; ++j) el[j] = lg[4 + gi * 8 + j] + reb[gi * 8 + j];
            int i1 = 0; float m1 = el[0];
#pragma unroll
            for (int j = 1; j < 8; ++j) if (el[j] > m1) { m1 = el[j]; i1 = j; }
            int i2 = (i1 == 0) ? 1 : 0; float m2 = el[i2];
#pragma unroll
            for (int j = 0; j < 8; ++j) if (j != i1 && el[j] > m2) { m2 = el[j]; i2 = j; }
            const float e2 = __expf(m2 - m1);
            const float p1 = 1.0f / (1.0f + e2), p2 = e2 / (1.0f + e2);
            const int ex1 = gi * 8 + i1, ex2 = gi * 8 + i2;
            const int d0 = (nloc * 16 + tid) * 2;
            sDecE[d0] = ex1; sDecP[d0] = atomicAdd(&sCnt[ex1], 1); sDecG[d0] = gw * p1; sDecR[d0] = row * 2;
            sDecE[d0 + 1] = ex2; sDecP[d0 + 1] = atomicAdd(&sCnt[ex2], 1); sDecG[d0 + 1] = gw * p2; sDecR[d0 + 1] = row * 2 + 1;
        }
    }
    __syncthreads();
    if (tid < 32) sBase[tid] = atomicAdd(&cnt[tid], sCnt[tid]);
    __syncthreads();
    if (tid < nloc * 32) {
        const int ex = sDecE[tid];
        const size_t pos = (size_t)ex * NT + sBase[ex] + sDecP[tid];
        ltok[pos] = sDecR[tid];
        lgate[pos] = sDecG[tid];
    }
    __syncthreads();
}

__device__ __forceinline__ void phase_exp1(const Params& p, int layer, bf16_t* smem) {
    const int* cnt = reinterpret_cast<const int*>(p.ws + OFF_CTRL) + layer * 32;
    const int* ltok = reinterpret_cast<const int*>(p.ws + OFF_LTOK);
    const bf16_t* XB = reinterpret_cast<const bf16_t*>(p.ws + OFF_ACTB);
    const bf16_t* W13 = reinterpret_cast<const bf16_t*>(p.ws + OFF_W) + WE_W13 + (size_t)layer * 32 * 262144;
    bf16_t* H = reinterpret_cast<bf16_t*>(p.ws + OFF_HBUF);
    int t = obid();
    int base = 0, tbase = 0;
    for (int e = 0; e < 32; ++e) {
        int c = cnt[e];
        int nt = ((c + 255) >> 8) * 2;
        while (t < tbase + nt) {
            int w = t - tbase;
            EpiExp1 epi{H, base, c};
            gemm_tile<true>(XB, DM, ltok + (size_t)e * NT, c, W13 + (size_t)e * 262144, DM, DM, (w >> 1) * 256, (w & 1) * 128, epi, smem, p.wave);
            t += ogdim();
        }
        tbase += nt; base += c;
    }
}
__device__ __forceinline__ void phase_exp2(const Params& p, int layer, bf16_t* smem) {
    const int* cnt = reinterpret_cast<const int*>(p.ws + OFF_CTRL) + layer * 32;
    const int* ltok = reinterpret_cast<const int*>(p.ws + OFF_LTOK);
    const float* lgate = reinterpret_cast<const float*>(p.ws + OFF_LGATE);
    const bf16_t* W2 = reinterpret_cast<const bf16_t*>(p.ws + OFF_W) + WE_W2 + (size_t)layer * 32 * 131072;
    const bf16_t* H = reinterpret_cast<const bf16_t*>(p.ws + OFF_HBUF);
    bf16_t* FS = reinterpret_cast<bf16_t*>(p.ws + OFF_FS);
    int t = obid();
    int base = 0, tbase = 0;
    for (int e = 0; e < 32; ++e) {
        int c = cnt[e];
        int nt = ((c + 255) >> 8) * 8;
        while (t < tbase + nt) {
            int w = t - tbase;
            EpiExp2 epi;
            epi.FS = FS; epi.cnt = c;
            {
                const int tq = otid(p.wave), wq = tq >> 6, lq = tq & 63;
#pragma unroll
                for (int m = 0; m < 4; ++m) {
                    int li = (w >> 3) * 256 + (wq >> 1) * 64 + m * 16 + (lq & 15);
                    li = li < c ? li : c - 1;
                    epi.pk[m] = ltok[(size_t)e * NT + li]; epi.g[m] = lgate[(size_t)e * NT + li];
                }
            }
            gemm_tile<false>(H + (size_t)base * 128, 128, nullptr, 0, W2 + (size_t)e * 131072, 128, 128, (w >> 3) * 256, (w & 7) * 128, epi, smem, p.wave);
            t += ogdim();
        }
        tbase += nt; base += c;
    }
}

__device__ __forceinline__ void phase_ln_ffn(const Params& p, int layer, float* Xout, bool last) {
    const int tidx = otid(p.wave);
    const int tid = tidx, wv = tid >> 6, lane = tid & 63;
    const float* g = p.in[33] + layer * DM;
    const float* bb = p.in[34] + layer * DM;
    const bf16_t* FS = reinterpret_cast<const bf16_t*>(p.ws + OFF_FS);
    bf16_t* XB = reinterpret_cast<bf16_t*>(p.ws + OFF_ACTB);
    for (int row = obid() * NWAVES + wv; row < NT; row += ogdim() * NWAVES) {
        float v[16];
#pragma unroll
        for (int i = 0; i < 4; ++i) {
            int col = i * 256 + lane * 4;
            uint2 t = *reinterpret_cast<const uint2*>(XB + (size_t)row * DM + col);
            uint2 f0 = *reinterpret_cast<const uint2*>(FS + (size_t)row * DM + col);
            uint2 f1 = *reinterpret_cast<const uint2*>(FS + ((size_t)NT + row) * DM + col);
            v[4 * i] = ALPHA_F * __uint_as_float(t.x << 16) + __uint_as_float(f0.x << 16) + __uint_as_float(f1.x << 16);
            v[4 * i + 1] = ALPHA_F * __uint_as_float(t.x & 0xffff0000u) + __uint_as_float(f0.x & 0xffff0000u) + __uint_as_float(f1.x & 0xffff0000u);
            v[4 * i + 2] = ALPHA_F * __uint_as_float(t.y << 16) + __uint_as_float(f0.y << 16) + __uint_as_float(f1.y << 16);
            v[4 * i + 3] = ALPHA_F * __uint_as_float(t.y & 0xffff0000u) + __uint_as_float(f0.y & 0xffff0000u) + __uint_as_float(f1.y & 0xffff0000u);
        }
        float sum = 0.f;
#pragma unroll
        for (int i = 0; i < 16; ++i) sum += v[i];
        float mean = wave_sum(sum) * (1.0f / DM);
        float sq = 0.f;
#pragma unroll
        for (int i = 0; i < 16; ++i) { float d = v[i] - mean; sq += d * d; }
        float rstd = rsqrtf(wave_sum(sq) * (1.0f / DM) + 1e-5f);
#pragma unroll
        for (int i = 0; i < 4; ++i) {
            int col = i * 256 + lane * 4;
            float4 gg = *reinterpret_cast<const float4*>(g + col);
            float4 bv = *reinterpret_cast<const float4*>(bb + col);
            float o0 = (v[4 * i] - mean) * rstd * gg.x + bv.x;
            float o1 = (v[4 * i + 1] - mean) * rstd * gg.y + bv.y;
            float o2 = (v[4 * i + 2] - mean) * rstd * gg.z + bv.z;
            float o3 = (v[4 * i + 3] - mean) * rstd * gg.w + bv.w;
            if (last) {
                *reinterpret_cast<float4*>(Xout + (size_t)row * DM + col) = make_float4(o0, o1, o2, o3);
            } else {
                uint2 w; w.x = pack2(o0, o1); w.y = pack2(o2, o3);
                *reinterpret_cast<uint2*>(XB + (size_t)row * DM + col) = w;
            }
        }
    }
}

#define CV_T 64
#define CV_ROWS (CV_T + 30)
template <int OB>
__device__ __forceinline__ void conv_blk(float (&acc)[CV_T], const bf16_t* sU, int tid, const float (&w0)[31]) {
#pragma unroll
    for (int rr = 0; rr < 38; ++rr) {
        const float uv = bf2f(sU[(OB * 8 + rr) * 512 + tid]);
#pragma unroll
        for (int oo = 0; oo < 8; ++oo) {
            const int j = rr - oo;
            if (j >= 0 && j <= 30) acc[OB * 8 + oo] += uv * w0[j];
        }
    }
}
__device__ __forceinline__ void phase_l1_conv(const Params& p, unsigned char* smem) {
    const int tidx = otid(p.wave);
    const bf16_t* P = reinterpret_cast<const bf16_t*>(p.ws + OFF_P);
    bf16_t* YC = reinterpret_cast<bf16_t*>(p.ws + OFF_YCAT);
    bf16_t* sU = reinterpret_cast<bf16_t*>(smem);
    float* red = reinterpret_cast<float*>(smem + CV_ROWS * 512 * 2);
    float* stat = red + 8 * 64 * 2;
    const int tid = tidx, wv = tid >> 6, lane = tid & 63;
    const float* cw = p.in[17];
    float w0[31];
#pragma unroll
    for (int j = 0; j < 31; ++j) w0[j] = cw[j * 512 + tid];
    const float cb0 = p.in[18][tid], g0 = p.in[19][tid], b0 = p.in[20][tid];
    for (int u = obid(); u < NT / CV_T; u += ogdim()) {
        const int t0 = u * CV_T;
        const int s0 = t0 & (SEQ - 1);
#pragma unroll 1
        for (int base = 0; base < CV_ROWS * 64; base += 6 * NTHREADS) {
            uint4 av[6], gv[6];
#pragma unroll
            for (int j = 0; j < 6; ++j) {
                const int it = base + j * NTHREADS + tid;
                const int r = it >> 6, c8 = (it & 63) * 8;
                av[j] = make_uint4(0u, 0u, 0u, 0u); gv[j] = av[j];
                if (it < CV_ROWS * 64 && s0 - 30 + r >= 0) {
                    const bf16_t* pr = P + (size_t)(t0 - 30 + r) * 3072 + c8;
                    av[j] = *reinterpret_cast<const uint4*>(pr);
                    gv[j] = *reinterpret_cast<const uint4*>(pr + 512);
                }
            }
#pragma unroll
            for (int j = 0; j < 6; ++j) {
                const int it = base + j * NTHREADS + tid;
                if (it < CV_ROWS * 64) {
                    const int r = it >> 6, c8 = (it & 63) * 8;
                    float a[8], gte[8];
                    unpack8(av[j], a); unpack8(gv[j], gte);
#pragma unroll
                    for (int i = 0; i < 8; ++i) a[i] = a[i] * sigmoidf_(gte[i]);
                    uint4 w;
                    w.x = pack2(a[0], a[1]); w.y = pack2(a[2], a[3]); w.z = pack2(a[4], a[5]); w.w = pack2(a[6], a[7]);
                    *reinterpret_cast<uint4*>(sU + r * 512 + c8) = w;
                }
            }
        }
        __syncthreads();
        float acc[CV_T];
#pragma unroll
        for (int o = 0; o < CV_T; ++o) acc[o] = cb0;
        conv_blk<0>(acc, sU, tid, w0); conv_blk<1>(acc, sU, tid, w0); conv_blk<2>(acc, sU, tid, w0); conv_blk<3>(acc, sU, tid, w0);
        conv_blk<4>(acc, sU, tid, w0); conv_blk<5>(acc, sU, tid, w0); conv_blk<6>(acc, sU, tid, w0); conv_blk<7>(acc, sU, tid, w0);
#pragma unroll
        for (int o = 0; o < CV_T; ++o) {
            const float s1 = wave_sum(acc[o]);
            const float s2 = wave_sum(acc[o] * acc[o]);
            if (lane == 0) { red[(wv * 64 + o) * 2] = s1; red[(wv * 64 + o) * 2 + 1] = s2; }
        }
        __syncthreads();
        if (tid < 64) {
            float s1 = 0.f, s2 = 0.f;
#pragma unroll
            for (int w = 0; w < 8; ++w) { s1 += red[(w * 64 + tid) * 2]; s2 += red[(w * 64 + tid) * 2 + 1]; }
            const float mean = s1 * (1.0f / 512.0f);
            const float var = fmaxf(s2 * (1.0f / 512.0f) - mean * mean, 0.f);
            stat[tid * 2] = mean; stat[tid * 2 + 1] = rsqrtf(var + 1e-5f);
        }
        __syncthreads();
#pragma unroll
        for (int o = 0; o < CV_T; ++o) {
            const float mean = stat[o * 2], rstd = stat[o * 2 + 1];
            const float y0 = (acc[o] - mean) * rstd * g0 + b0;
            YC[(size_t)(t0 + o) * 1024 + tid] = f2bf(siluf_(y0));
        }
    }
}

__device__ __forceinline__ float ret_lg(int h) { return log1pf(-exp2f(-5.0f - (float)h)); }

#define KT_LD 136
struct RetIn { uint4 k1, k2, v1, v2; };
__device__ __forceinline__ void ret_load_kv(RetIn& in, const bf16_t* P, int u, int tid) {
    const int n = u & 63, h = (u >> 6) & 7, b = u >> 9;
    const int c = tid >> 2, i0 = (tid & 3) * 8;
    const size_t tok = (size_t)b * SEQ + n * 128 + c;
    const bf16_t* kr = P + tok * 3072 + 1536 + h * 64;
    const bf16_t* vr = P + tok * 3072 + 2048 + h * 64;
    in.k1 = *reinterpret_cast<const uint4*>(kr + i0); in.k2 = *reinterpret_cast<const uint4*>(kr + 32 + i0);
    in.v1 = *reinterpret_cast<const uint4*>(vr + i0); in.v2 = *reinterpret_cast<const uint4*>(vr + 32 + i0);
}
__device__ __forceinline__ void st_col8(bf16_t* dst, int ld, const uint4 v) {
    dst[0 * ld] = (bf16_t)(v.x & 0xffffu); dst[1 * ld] = (bf16_t)(v.x >> 16);
    dst[2 * ld] = (bf16_t)(v.y & 0xffffu); dst[3 * ld] = (bf16_t)(v.y >> 16);
    dst[4 * ld] = (bf16_t)(v.z & 0xffffu); dst[5 * ld] = (bf16_t)(v.z >> 16);
    dst[6 * ld] = (bf16_t)(v.w & 0xffffu); dst[7 * ld] = (bf16_t)(v.w >> 16);
}
__device__ __forceinline__ void phase_ret_kv(const Params& p, unsigned char* smem) {
    const int tidx = otid(p.wave);
    const bf16_t* P = reinterpret_cast<const bf16_t*>(p.ws + OFF_P);
    const float2* rope = reinterpret_cast<const float2*>(p.ws + OFF_ROPE);
    float* KVT = reinterpret_cast<float*>(p.ws + OFF_KVT);
    bf16_t* sKT = reinterpret_cast<bf16_t*>(smem);
    bf16_t* sVT = sKT + 64 * KT_LD;
    const int tid = tidx, wv = tid >> 6, lane = tid & 63, fr = lane & 15, fq = lane >> 4;
    const int et = wv >> 1, dt0 = (wv & 1) * 2;
    RetIn cur, nxt;
    if (obid() < 2048) ret_load_kv(cur, P, obid(), tid);
    nxt = cur;
    for (int u = obid(); u < 2048; u += ogdim()) {
        const int n = u & 63, h = (u >> 6) & 7;
        const float lg = ret_lg(h);
        const int c = tid >> 2, i0 = (tid & 3) * 8;
        const int sidx = n * 128 + c;
        float2 cs[8];
#pragma unroll
        for (int i = 0; i < 8; ++i) cs[i] = rope[sidx * 32 + i0 + i];
        asm volatile("" : "+v"(cs[0].x), "+v"(cs[7].y));
        if (u + ogdim() < 2048) ret_load_kv(nxt, P, u + ogdim(), tid);
        {
            const float zeta = __expf((float)(127 - c) * lg) * 0.125f;
            float k1[8], k2[8];
            unpack8(cur.k1, k1); unpack8(cur.k2, k2);
#pragma unroll
            for (int i = 0; i < 8; ++i) {
                float o1 = (k1[i] * cs[i].x - k2[i] * cs[i].y) * zeta, o2 = (k1[i] * cs[i].y + k2[i] * cs[i].x) * zeta;
                sKT[(i0 + i) * KT_LD + c] = f2bf(o1);
                sKT[(32 + i0 + i) * KT_LD + c] = f2bf(o2);
            }
            st_col8(sVT + i0 * KT_LD + c, KT_LD, cur.v1);
            st_col8(sVT + (32 + i0) * KT_LD + c, KT_LD, cur.v2);
        }
        lds_barrier();
        f32x4 acc[2];
        acc[0] = (f32x4){0.f, 0.f, 0.f, 0.f}; acc[1] = (f32x4){0.f, 0.f, 0.f, 0.f};
#pragma unroll
        for (int ks = 0; ks < 4; ++ks) {
            bf16x8 af = *reinterpret_cast<const bf16x8*>(sVT + (et * 16 + fr) * KT_LD + ks * 32 + fq * 8);
#pragma unroll
            for (int nn = 0; nn < 2; ++nn) {
                bf16x8 bfr = *reinterpret_cast<const bf16x8*>(sKT + ((dt0 + nn) * 16 + fr) * KT_LD + ks * 32 + fq * 8);
                acc[nn] = __builtin_amdgcn_mfma_f32_16x16x32_bf16(af, bfr, acc[nn], 0, 0, 0);
            }
        }
        float* o = KVT + (size_t)u * 4096;
#pragma unroll
        for (int nn = 0; nn < 2; ++nn)
#pragma unroll
            for (int j = 0; j < 4; ++j) o[(et * 16 + fq * 4 + j) * 64 + (dt0 + nn) * 16 + fr] = acc[nn][j];
        cur = nxt;
        lds_barrier();
    }
}
__device__ __forceinline__ void phase_ret_scan(const Params& p) {
    const int tidx = otid(p.wave);
    float* KVT = reinterpret_cast<float*>(p.ws + OFF_KVT);
    for (int i = obid() * NTHREADS + tidx; i < 32 * 4096; i += ogdim() * NTHREADS) {
        int bh = i >> 12, ed = i & 4095, h = bh & 7;
        float gc = __expf(128.0f * ret_lg(h));
        float R = 0.f;
        float* q = KVT + (size_t)bh * 64 * 4096 + ed;
#pragma unroll 1
        for (int n0 = 0; n0 < 64; n0 += 16) {
            float kv[16];
#pragma unroll
            for (int j = 0; j < 16; ++j) kv[j] = q[(size_t)(n0 + j) * 4096];
#pragma unroll
            for (int j = 0; j < 16; ++j) { q[(size_t)(n0 + j) * 4096] = R; R = gc * R + kv[j]; }
        }
    }
}
#define Q_LD 72
struct RetOutIn { uint4 q1, q2, k1, k2, v1, v2; float4 r0, r1; unsigned short gr[16]; };
__device__ __forceinline__ void ret_load_out(RetOutIn& in, const bf16_t* P, const float* KVT, int u, int tid) {
    const int n = u & 63, h = (u >> 6) & 7, b = u >> 9;
    const int c = tid >> 2, i0 = (tid & 3) * 8;
    const size_t tok = (size_t)b * SEQ + n * 128 + c;
    const bf16_t* qr = P + tok * 3072 + 1024 + h * 64;
    in.q1 = *reinterpret_cast<const uint4*>(qr + i0); in.q2 = *reinterpret_cast<const uint4*>(qr + 32 + i0);
    in.k1 = *reinterpret_cast<const uint4*>(qr + 512 + i0); in.k2 = *reinterpret_cast<const uint4*>(qr + 512 + 32 + i0);
    in.v1 = *reinterpret_cast<const uint4*>(qr + 1024 + i0); in.v2 = *reinterpret_cast<const uint4*>(qr + 1024 + 32 + i0);
    const float* rp = KVT + (size_t)u * 4096 + tid * 8;
    in.r0 = *reinterpret_cast<const float4*>(rp); in.r1 = *reinterpret_cast<const float4*>(rp + 4);
    const int wv = tid >> 6, lane = tid & 63, fr = lane & 15, fq = lane >> 4;
#pragma unroll
    for (int j = 0; j < 4; ++j)
#pragma unroll
        for (int nn = 0; nn < 4; ++nn)
            in.gr[j * 4 + nn] = P[((size_t)b * SEQ + n * 128 + wv * 16 + fq * 4 + j) * 3072 + 2560 + h * 64 + nn * 16 + fr];
}
__device__ __forceinline__ void phase_ret_out(const Params& p, unsigned char* smem) {
    const int tidx = otid(p.wave);
    const bf16_t* P = reinterpret_cast<const bf16_t*>(p.ws + OFF_P);
    const float2* rope = reinterpret_cast<const float2*>(p.ws + OFF_ROPE);
    const float* KVT = reinterpret_cast<const float*>(p.ws + OFF_KVT);
    bf16_t* YC = reinterpret_cast<bf16_t*>(p.ws + OFF_YCAT);
    bf16_t* sQ = reinterpret_cast<bf16_t*>(smem);
    bf16_t* sK = sQ + 128 * Q_LD;
    bf16_t* sVT = sK + 128 * Q_LD;
    bf16_t* sRT = sVT + 64 * KT_LD;
    bf16_t* sS = sQ;
    const int tid = tidx, wv = tid >> 6, lane = tid & 63, fr = lane & 15, fq = lane >> 4;
    RetOutIn cur, nxt;
    if (obid() < 2048) ret_load_out(cur, P, KVT, obid(), tid);
    nxt = cur;
    for (int u = obid(); u < 2048; u += ogdim()) {
        const int n = u & 63, h = (u >> 6) & 7, b = u >> 9;
        const float lg = ret_lg(h);
        const int c = tid >> 2, i0 = (tid & 3) * 8;
        const int sidx = n * 128 + c;
        float2 cs[8];
#pragma unroll
        for (int i = 0; i < 8; ++i) cs[i] = rope[sidx * 32 + i0 + i];
        float gng[4], gnb[4];
#pragma unroll
        for (int nn = 0; nn < 4; ++nn) { gng[nn] = p.in[21][h * 64 + nn * 16 + fr]; gnb[nn] = p.in[22][h * 64 + nn * 16 + fr]; }
        asm volatile("" : "+v"(cs[0].x), "+v"(cs[7].y), "+v"(gng[0]), "+v"(gnb[3]));
        if (u + ogdim() < 2048) ret_load_out(nxt, P, KVT, u + ogdim(), tid);
        {
            float qa[8], qb[8], ka[8], kb[8];
            float q1[8], q2[8], k1[8], k2[8];
            unpack8(cur.q1, q1); unpack8(cur.q2, q2); unpack8(cur.k1, k1); unpack8(cur.k2, k2);
#pragma unroll
            for (int i = 0; i < 8; ++i) {
                qa[i] = q1[i] * cs[i].x - q2[i] * cs[i].y; qb[i] = q1[i] * cs[i].y + q2[i] * cs[i].x;
                ka[i] = (k1[i] * cs[i].x - k2[i] * cs[i].y) * 0.125f; kb[i] = (k1[i] * cs[i].y + k2[i] * cs[i].x) * 0.125f;
            }
            st_col8(sVT + i0 * KT_LD + c, KT_LD, cur.v1);
            st_col8(sVT + (32 + i0) * KT_LD + c, KT_LD, cur.v2);
            uint4 w;
            w.x = pack2(qa[0], qa[1]); w.y = pack2(qa[2], qa[3]); w.z = pack2(qa[4], qa[5]); w.w = pack2(qa[6], qa[7]);
            *reinterpret_cast<uint4*>(sQ + c * Q_LD + i0) = w;
            w.x = pack2(qb[0], qb[1]); w.y = pack2(qb[2], qb[3]); w.z = pack2(qb[4], qb[5]); w.w = pack2(qb[6], qb[7]);
            *reinterpret_cast<uint4*>(sQ + c * Q_LD + 32 + i0) = w;
            w.x = pack2(ka[0], ka[1]); w.y = pack2(ka[2], ka[3]); w.z = pack2(ka[4], ka[5]); w.w = pack2(ka[6], ka[7]);
            *reinterpret_cast<uint4*>(sK + c * Q_LD + i0) = w;
            w.x = pack2(kb[0], kb[1]); w.y = pack2(kb[2], kb[3]); w.z = pack2(kb[4], kb[5]); w.w = pack2(kb[6], kb[7]);
            *reinterpret_cast<uint4*>(sK + c * Q_LD + 32 + i0) = w;
            w.x = pack2(cur.r0.x, cur.r0.y); w.y = pack2(cur.r0.z, cur.r0.w); w.z = pack2(cur.r1.x, cur.r1.y); w.w = pack2(cur.r1.z, cur.r1.w);
            *reinterpret_cast<uint4*>(sRT + (tid >> 3) * Q_LD + (tid & 7) * 8) = w;
        }
        lds_barrier();
        f32x4 accs[8], accc[4];
#pragma unroll
        for (int nn = 0; nn < 8; ++nn) accs[nn] = (f32x4){0.f, 0.f, 0.f, 0.f};
#pragma unroll
        for (int nn = 0; nn < 4; ++nn) accc[nn] = (f32x4){0.f, 0.f, 0.f, 0.f};
#pragma unroll
        for (int ks = 0; ks < 2; ++ks) {
            bf16x8 af = *reinterpret_cast<const bf16x8*>(sQ + (wv * 16 + fr) * Q_LD + ks * 32 + fq * 8);
#pragma unroll
            for (int nn = 0; nn < 8; ++nn) {
                bf16x8 bfr = *reinterpret_cast<const bf16x8*>(sK + (nn * 16 + fr) * Q_LD + ks * 32 + fq * 8);
                accs[nn] = __builtin_amdgcn_mfma_f32_16x16x32_bf16(af, bfr, accs[nn], 0, 0, 0);
            }
#pragma unroll
            for (int nn = 0; nn < 4; ++nn) {
                bf16x8 bfr = *reinterpret_cast<const bf16x8*>(sRT + (nn * 16 + fr) * Q_LD + ks * 32 + fq * 8);
                accc[nn] = __builtin_amdgcn_mfma_f32_16x16x32_bf16(af, bfr, accc[nn], 0, 0, 0);
            }
        }
        lds_barrier();
        bf16_t* mS = sS + wv * 16 * KT_LD;
        {
            float e1[4], e1m[4];
#pragma unroll
            for (int j = 0; j < 4; ++j) {
                e1[j] = __expf((float)(fq * 4 + j - fr) * lg);
                e1m[j] = (fq * 4 + j >= fr) ? e1[j] : 0.f;
            }
#pragma unroll
            for (int nn = 0; nn < 8; ++nn) {
                const float e2 = (nn < wv) ? __expf((float)(16 * (wv - nn)) * lg) : 0.f;
                const bool diag = (nn == wv);
                float v[4];
#pragma unroll
                for (int j = 0; j < 4; ++j) v[j] = accs[nn][j] * (diag ? e1m[j] : e2 * e1[j]);
#pragma unroll
                for (int j = 0; j < 4; ++j) mS[(fq * 4 + j) * KT_LD + nn * 16 + fr] = f2bf(v[j]);
            }
        }
        lds_barrier();
        f32x4 acco[4];
#pragma unroll
        for (int nn = 0; nn < 4; ++nn) acco[nn] = (f32x4){0.f, 0.f, 0.f, 0.f};
#pragma unroll
        for (int ks = 0; ks < 4; ++ks) {
            bf16x8 af = *reinterpret_cast<const bf16x8*>(mS + fr * KT_LD + ks * 32 + fq * 8);
#pragma unroll
            for (int nn = 0; nn < 4; ++nn) {
                bf16x8 bfr = *reinterpret_cast<const bf16x8*>(sVT + (nn * 16 + fr) * KT_LD + ks * 32 + fq * 8);
                acco[nn] = __builtin_amdgcn_mfma_f32_16x16x32_bf16(af, bfr, acco[nn], 0, 0, 0);
            }
        }
#pragma unroll
        for (int j = 0; j < 4; ++j) {
            int ig = wv * 16 + fq * 4 + j;
            float xi = __expf((float)(ig + 1) * lg);
            float o[4];
            float sm = 0.f;
#pragma unroll
            for (int nn = 0; nn < 4; ++nn) { o[nn] = acco[nn][j] + xi * accc[nn][j]; sm += o[nn]; }
            sm = row16_sum(sm);
            float mean = sm * (1.0f / 64.0f);
            float sq = 0.f;
#pragma unroll
            for (int nn = 0; nn < 4; ++nn) { float d = o[nn] - mean; sq += d * d; }
            sq = row16_sum(sq);
            float rstd = rsqrtf(sq * (1.0f / 64.0f) + 1e-5f);
            size_t tok = (size_t)b * SEQ + n * 128 + ig;
#pragma unroll
            for (int nn = 0; nn < 4; ++nn) {
                int e = h * 64 + nn * 16 + fr;
                float y = (o[nn] - mean) * rstd * gng[nn] + gnb[nn];
                float gr = bf2f(cur.gr[j * 4 + nn]);
                YC[tok * 1024 + 512 + e] = f2bf(siluf_(gr) * y);
            }
        }
        cur = nxt;
        lds_barrier();
    }
}

#define XB_TMO      128
#define XB_XCNT(j)  (256  + 64 * (j))
#define XB_XSUB(j)  (1280 + 64 * (j))
#define XB_XGEN(j)  (2304 + 64 * (j))
#define XB_TOP      3328
#define XB_TOPGEN   3392
#define XB_SPIN_CAP (1u << 18)

__device__ __forceinline__ unsigned xb_ld(unsigned* p)              { return __hip_atomic_load(p, __ATOMIC_RELAXED, __HIP_MEMORY_SCOPE_AGENT); }
__device__ __forceinline__ unsigned xb_add(unsigned* p, unsigned v) { return __hip_atomic_fetch_add(p, v, __ATOMIC_RELAXED, __HIP_MEMORY_SCOPE_AGENT); }
__device__ __forceinline__ unsigned xb_xcc_id() { return (unsigned)__builtin_amdgcn_s_getreg((3 << 11) | 20) & 0xFu; }
#define XB_SPIN(cond, bar) do { unsigned _sp = 0; while (cond) { __builtin_amdgcn_s_sleep(1); \
    if ((++_sp & 255u) == 0u) { if (xb_ld(&(bar)[XB_TMO])) break; if (_sp > XB_SPIN_CAP) { atomicAdd(&(bar)[XB_TMO], 1u); break; } } } } while (0)

struct XcdBarrier {
    unsigned* bar; unsigned x;
    volatile __attribute__((address_space(3))) unsigned* st;
};

__device__ __forceinline__ XcdBarrier xcd_barrier_post(unsigned* bar, volatile __attribute__((address_space(3))) unsigned* st, int tid) {
    XcdBarrier b; b.bar = bar; b.x = xb_xcc_id(); b.st = st;
    if (tid == 0) (void)xb_add(&bar[XB_XCNT(b.x)], 1u);
    return b;
}
__device__ __forceinline__ void xcd_barrier_complete(unsigned* bar, unsigned x, unsigned& nloc, unsigned& nx) {
    const unsigned G = (unsigned)ogdim();
    unsigned sum, cnt, mine, sp = 0u;
    for (;;) {
        sum = 0u; cnt = 0u; mine = 0u;
#pragma unroll
        for (unsigned j = 0; j < 16; ++j) { const unsigned c = xb_ld(&bar[XB_XCNT(j)]); sum += c; cnt += (c > 0u) ? 1u : 0u; mine = (j == x) ? c : mine; }
        if (sum == G) break;
        __builtin_amdgcn_s_sleep(1);
        if ((++sp & 255u) == 0u) { if (xb_ld(&bar[XB_TMO])) break; if (sp > XB_SPIN_CAP) { atomicAdd(&bar[XB_TMO], 1u); break; } }
    }
    nloc = mine > 0u ? mine : 1u; nx = cnt > 0u ? cnt : 1u;
}

__device__ __forceinline__ void xcd_barrier(const XcdBarrier& b, int tid) {
    asm volatile("s_waitcnt vmcnt(0)" ::: "memory");
    __syncthreads();
    if (tid == 0) {
        unsigned* bar = b.bar;
        __builtin_amdgcn_s_waitcnt(0);
        unsigned nloc = b.st[0], nx = b.st[1];
        if (nloc == 0u) { xcd_barrier_complete(bar, b.x, nloc, nx); b.st[0] = nloc; b.st[1] = nx; }
        const unsigned old = xb_add(&bar[XB_XSUB(b.x)], 1u);
        const unsigned gen = old / nloc;
        if (old + 1u == (gen + 1u) * nloc) {
            __builtin_amdgcn_fence(__ATOMIC_RELEASE, "agent");
            asm volatile("s_waitcnt vmcnt(0)" ::: "memory");
            const unsigned og = xb_add(&bar[XB_TOP], 1u);
            const unsigned tg = og / nx;
            if (og + 1u == (tg + 1u) * nx) xb_add(&bar[XB_TOPGEN], 1u);
            else XB_SPIN(xb_ld(&bar[XB_TOPGEN]) == tg, bar);
            __builtin_amdgcn_fence(__ATOMIC_ACQUIRE, "agent");
            xb_add(&bar[XB_XGEN(b.x)], 1u);
            asm volatile("s_waitcnt vmcnt(0)" ::: "memory");
        } else {
            XB_SPIN(xb_ld(&bar[XB_XGEN(b.x)]) == gen, bar);
            __builtin_amdgcn_fence(__ATOMIC_ACQUIRE, "agent");
            asm volatile("s_waitcnt vmcnt(0)" ::: "memory");
        }
    }
    __syncthreads();
}


#define N_PHASES 22
__device__ __forceinline__ void run_phase(const Params& p, int ph, unsigned char* smem) {
    bf16_t* sm16 = reinterpret_cast<bf16_t*>(smem);
    const bf16_t* W = reinterpret_cast<const bf16_t*>(p.ws + OFF_W);
    bf16_t* ACTB = reinterpret_cast<bf16_t*>(p.ws + OFF_ACTB);
    bf16_t* PB = reinterpret_cast<bf16_t*>(p.ws + OFF_P);
    bf16_t* YC = reinterpret_cast<bf16_t*>(p.ws + OFF_YCAT);
    switch (ph) {
        case 0: phase_pre(p, smem, 0, obid(), ogdim()); break;
        case 1: { PEpiBf16 e{PB, 2304}; big_gemm(ACTB, W + WE_IN0, NT, 2304, DM, e, smem, p.wave); } break;
        case 2: phase_l0_prep(p); break;
        case 3: phase_l0_lora(p, sm16); break;
        case 4: phase_rwkv_r1(p, smem); break;
        case 5: phase_rwkv_r2(p, smem); break;
        case 6: phase_rwkv_r3(p, smem); break;
        case 7: { PEpiOut<false> e{p.in[0], nullptr, PB}; big_gemm(YC, W + WE_OUT0, NT, DM, DM, e, smem, p.wave); } break;
        case 8: phase_ln_route(p, 0, smem); break;
        case 9: phase_exp1(p, 0, sm16); break;
        case 10: phase_exp2(p, 0, sm16); break;
        case 11: phase_ln_ffn(p, 0, p.out, false); break;
        case 12: { PEpiBf16 e{PB, 3072}; big_gemm(ACTB, W + WE_IN1, NT, 3072, DM, e, smem, p.wave); } break;
        case 13: phase_l1_conv(p, smem); break;
        case 14: phase_ret_kv(p, smem); break;
        case 15: phase_ret_scan(p); break;
        case 16: phase_ret_out(p, smem); break;
        case 17: { PEpiOut<true> e{nullptr, ACTB, PB}; big_gemm(YC, W + WE_OUT1, NT, DM, DM, e, smem, p.wave); } break;
        case 18: phase_ln_route(p, 1, smem); break;
        case 19: phase_exp1(p, 1, sm16); break;
        case 20: phase_exp2(p, 1, sm16); break;
        case 21: phase_ln_ffn(p, 1, p.out, true); break;
        default: break;
    }
}

#define SMEM_BYTES 147456
__global__ void __launch_bounds__(NTHREADS) k_mega(Params p) {
    extern __shared__ __attribute__((aligned(16))) unsigned char smem[];
    cg::grid_group grid = cg::this_grid();
    const int wave_s = __builtin_amdgcn_readfirstlane((int)(threadIdx.x >> 6));
    volatile __attribute__((address_space(3))) unsigned* st = (volatile __attribute__((address_space(3))) unsigned*)(smem + 146944);
    {
        const int t0 = otid(wave_s);
        if (t0 < 2) st[t0] = 0u;
    }
    XcdBarrier xb;
#pragma nounroll
    for (int ph = 0; ph < N_PHASES; ++ph) {
        int phv = ph;
        asm volatile("" : "+s"(phv));
        typedef const __attribute__((address_space(4))) Params* KP;
        KP pp = (KP)__builtin_amdgcn_kernarg_segment_ptr();
        asm volatile("" : "+s"(pp));
        Params pl;
        __builtin_memcpy(&pl, (const Params*)pp, sizeof(Params));
        pl.wave = wave_s;
        run_phase(pl, phv, smem);
        if (ph == 0) {
            grid.sync();
            xb = xcd_barrier_post(reinterpret_cast<unsigned*>(pl.ws + OFF_CTRL + 4096), st, otid(wave_s));
        } else if (ph < N_PHASES - 1) {
            xcd_barrier(xb, otid(wave_s));
        }
    }
}

extern "C" void kernel_launch(void* const* d_in, const int* in_sizes, int n_in, void* d_out, int out_size, void* d_ws, size_t ws_size,
                              hipStream_t stream) {
    static int grid_blocks = 0;
    if (!grid_blocks) {
        int dev = 0, cus = 0, per_cu = 0;
        hipGetDevice(&dev);
        hipDeviceGetAttribute(&cus, hipDeviceAttributeMultiprocessorCount, dev);
        hipFuncSetAttribute((const void*)k_mega, hipFuncAttributeMaxDynamicSharedMemorySize, SMEM_BYTES);
        hipOccupancyMaxActiveBlocksPerMultiprocessor(&per_cu, (const void*)k_mega, NTHREADS, SMEM_BYTES);
        if (per_cu < 1) per_cu = 1;
        grid_blocks = cus * per_cu;
    }
    Params p{};
    for (int i = 0; i < 35; ++i) p.in[i] = (const float*)d_in[i];
    p.out = (float*)d_out;
    p.ws = (unsigned char*)d_ws;
    void* args[] = {&p};
    hipError_t e = hipLaunchCooperativeKernel((void*)k_mega, dim3(grid_blocks), dim3(NTHREADS), args, SMEM_BYTES, stream);
    if (e != hipSuccess) fprintf(stderr, "cooperative launch failed: %s (grid %d)\n", hipGetErrorString(e), grid_blocks);
}
```

```cpp
#include <hip/hip_runtime.h>
#include <hip/hip_cooperative_groups.h>
#include <stdint.h>
#include <stdio.h>
namespace cg = cooperative_groups;

typedef unsigned short bf16_t;
typedef short bf16x8 __attribute__((ext_vector_type(8)));
typedef float f32x4 __attribute__((ext_vector_type(4)));

#define NT 32768
#define SEQ 8192
#define DM 1024
#define NTHREADS 512
#define XCD_BAR_WORDS 3456
#define NWAVES 8
#define ALPHA_F 1.41421356237309515f

#define MIB (1024ull * 1024ull)
#define OFF_CTRL 0ull
#define OFF_W (1ull * MIB)
#define OFF_ROPE (65ull * MIB)
#define OFF_ACTB (68ull * MIB)
#define OFF_AA (OFF_ACTB)
#define OFF_GG (OFF_ACTB + 32ull * MIB)
#define OFF_P (132ull * MIB)
#define OFF_LORA (OFF_P + 144ull * MIB)
#define OFF_POOLED (OFF_P + 160ull * MIB)
#define OFF_FS (OFF_P)
#define OFF_HBUF (OFF_P + 128ull * MIB)
#define OFF_YCAT (324ull * MIB)
#define OFF_LOGW (388ull * MIB)
#define OFF_LTOK (452ull * MIB)
#define OFF_LGATE (456ull * MIB)
#define OFF_KVT (460ull * MIB)
#define WE_IN0 0
#define WE_OUT0 2359296
#define WE_IN1 3407872
#define WE_OUT1 6553600
#define WE_W13 7602176
#define WE_W2 24379392
#define WE_LW2 32768000
#define WE_LA2 32800768
#define WE_LG2 32833536
#define WE_POOL 32899072
#define WE_RT_HI 32964608
#define WE_RT_LO 33062912

struct Params {
    const float* in[35];
    float* out;
    unsigned char* ws;
    int wave;
    int pad_;
};

typedef __bf16 hw_bf16x2 __attribute__((ext_vector_type(2)));
typedef float hw_f32x2 __attribute__((ext_vector_type(2)));
__device__ __forceinline__ unsigned pack2(float a, float b) {
    hw_f32x2 v = {a, b};
    hw_bf16x2 r = __builtin_convertvector(v, hw_bf16x2);
    return __builtin_bit_cast(unsigned, r);
}
__device__ __forceinline__ bf16_t f2bf(float f) { return (bf16_t)(pack2(f, 0.f) & 0xffffu); }
__device__ __forceinline__ float bf2f(bf16_t h) { return __uint_as_float(((unsigned)h) << 16); }
__device__ __forceinline__ void unpack8(const uint4 v, float (&o)[8]) {
    o[0] = __uint_as_float(v.x << 16); o[1] = __uint_as_float(v.x & 0xffff0000u);
    o[2] = __uint_as_float(v.y << 16); o[3] = __uint_as_float(v.y & 0xffff0000u);
    o[4] = __uint_as_float(v.z << 16); o[5] = __uint_as_float(v.z & 0xffff0000u);
    o[6] = __uint_as_float(v.w << 16); o[7] = __uint_as_float(v.w & 0xffff0000u);
}
#define DPP_ADD(v, CTRL) ((v) + __int_as_float(__builtin_amdgcn_update_dpp(0, __float_as_int(v), (CTRL), 0xF, 0xF, false)))
__device__ __forceinline__ float row16_sum(float v) {
    v = DPP_ADD(v, 0xB1);
    v = DPP_ADD(v, 0x4E);
    v = DPP_ADD(v, 0x141);
    v = DPP_ADD(v, 0x140);
    return v;
}
__device__ __forceinline__ float wave_sum(float v) {
    v = row16_sum(v);
    const int iv = __float_as_int(v);
    const float s0 = __int_as_float(__builtin_amdgcn_readlane(iv, 0)), s1 = __int_as_float(__builtin_amdgcn_readlane(iv, 16));
    const float s2 = __int_as_float(__builtin_amdgcn_readlane(iv, 32)), s3 = __int_as_float(__builtin_amdgcn_readlane(iv, 48));
    return (s0 + s1) + (s2 + s3);
}
__device__ __forceinline__ float sigmoidf_(float x) { return 1.0f / (1.0f + __expf(-x)); }
__device__ __forceinline__ float siluf_(float x) { return x / (1.0f + __expf(-x)); }
__device__ __forceinline__ float quad_sum(float v) {
    int iv = __float_as_int(v);
    float a = __int_as_float(__builtin_amdgcn_update_dpp(0, iv, 0xB1, 0xF, 0xF, false));
    v += a;
    iv = __float_as_int(v);
    float b = __int_as_float(__builtin_amdgcn_update_dpp(0, iv, 0x4E, 0xF, 0xF, false));
    return v + b;
}

__device__ __forceinline__ void lds_barrier() {
    asm volatile("s_waitcnt lgkmcnt(0)" ::: "memory");
    __builtin_amdgcn_s_barrier();
    asm volatile("" ::: "memory");
}
__device__ __forceinline__ int obid() { int b = (int)blockIdx.x; asm volatile("" : "+s"(b)); return b; }
__device__ __forceinline__ int ogdim() { int b = (int)gridDim.x; asm volatile("" : "+s"(b)); return b; }
__device__ __forceinline__ int otid(int wave) { int t = wave * 64 + (int)__builtin_amdgcn_mbcnt_hi(~0u, __builtin_amdgcn_mbcnt_lo(~0u, 0u)); asm volatile("" : "+v"(t)); return t; }
template <bool GATHER, class Epi>
__device__ __forceinline__ void gemm_tile(const bf16_t* __restrict__ A, int lda, const int* __restrict__ gidx, int gcount,
                                          const bf16_t* __restrict__ Bt, int ldb, int K, int row0, int col0, const Epi& epi,
                                          bf16_t* smem, int wave) {
    const int tidx = otid(wave);
    const int tid = tidx, wid = tid >> 6, lane = tid & 63, wr = wid >> 1, wc = wid & 1, fr = lane & 15, fq = lane >> 4;
    unsigned char* sm = reinterpret_cast<unsigned char*>(smem);
    const bf16_t* ap[4];
    const bf16_t* bp[2];
#pragma unroll
    for (int i = 0; i < 4; ++i) {
        const int pch = tid + i * 512;
        const int r = pch >> 3, c = (pch & 7) ^ (r & 7);
        int ar = row0 + r;
        if (GATHER) {
            int gi = ar < gcount ? ar : gcount - 1;
            ar = gidx[gi] >> 1;
        }
        ap[i] = A + (size_t)ar * lda + c * 8;
    }
#pragma unroll
    for (int i = 0; i < 2; ++i) {
        const int pch = tid + i * 512;
        const int r = pch >> 3, c = (pch & 7) ^ (r & 7);
        bp[i] = Bt + (size_t)(col0 + r) * ldb + c * 8;
    }
    f32x4 acc[4][4];
#pragma unroll
    for (int m = 0; m < 4; ++m)
#pragma unroll
        for (int n = 0; n < 4; ++n) acc[m][n] = (f32x4){0.f, 0.f, 0.f, 0.f};
    const int nk = K >> 6;
#define GT_STAGE(kt, buf) do { _Pragma("unroll") for (int i_ = 0; i_ < 4; ++i_) \
        __builtin_amdgcn_global_load_lds((const unsigned*)(ap[i_] + (kt) * 64), (__attribute__((address_space(3))) unsigned*)(sm + (buf) * 49152 + (tid + i_ * 512) * 16), 16, 0, 0); \
        _Pragma("unroll") for (int i_ = 0; i_ < 2; ++i_) \
        __builtin_amdgcn_global_load_lds((const unsigned*)(bp[i_] + (kt) * 64), (__attribute__((address_space(3))) unsigned*)(sm + (buf) * 49152 + 32768 + (tid + i_ * 512) * 16), 16, 0, 0); } while (0)
    GT_STAGE(0, 0);
    for (int kt = 0; kt < nk; ++kt) {
        const int buf = kt & 1;
        if (kt + 1 < nk) {
            GT_STAGE(kt + 1, buf ^ 1);
            asm volatile("s_waitcnt vmcnt(6)" ::: "memory");
        } else {
            asm volatile("s_waitcnt vmcnt(0)" ::: "memory");
        }
        __builtin_amdgcn_s_barrier();
        asm volatile("" ::: "memory");
        const unsigned char* SA = sm + buf * 49152;
        const unsigned char* SB = SA + 32768;
#pragma unroll
        for (int ks = 0; ks < 2; ++ks) {
            bf16x8 af[4], bfr[4];
            const int cs = ((ks * 4 + fq) ^ (fr & 7)) * 16;
#pragma unroll
            for (int m = 0; m < 4; ++m) af[m] = *reinterpret_cast<const bf16x8*>(SA + (wr * 64 + m * 16 + fr) * 128 + cs);
#pragma unroll
            for (int n = 0; n < 4; ++n) bfr[n] = *reinterpret_cast<const bf16x8*>(SB + (wc * 64 + n * 16 + fr) * 128 + cs);
#pragma unroll
            for (int m = 0; m < 4; ++m)
#pragma unroll
                for (int n = 0; n < 4; ++n) acc[m][n] = __builtin_amdgcn_mfma_f32_16x16x32_bf16(bfr[n], af[m], acc[m][n], 0, 0, 0);
        }
        asm volatile("s_waitcnt lgkmcnt(0)" ::: "memory");
        __builtin_amdgcn_s_barrier();
        asm volatile("" ::: "memory");
    }
#undef GT_STAGE
    epi(acc, row0 + wr * 64, col0 + wc * 64, fr, fq);
}

struct EpiStoreBf16 {
    bf16_t* O; int ldo;
    __device__ __forceinline__ void operator()(f32x4 (&acc)[4][4], int rb, int cb, int fr, int fq) const {
#pragma unroll
        for (int m = 0; m < 4; ++m)
#pragma unroll
            for (int n = 0; n < 4; ++n) {
                int row = rb + m * 16 + fr, col = cb + n * 16 + fq * 4;
                uint2 w; w.x = pack2(acc[m][n][0], acc[m][n][1]); w.y = pack2(acc[m][n][2], acc[m][n][3]);
                *reinterpret_cast<uint2*>(O + (size_t)row * ldo + col) = w;
            }
    }
};
template <int MODE>
struct EpiLora {
    float* Of; bf16_t* Ob; const float* vec; int ldo; int coff;
    __device__ __forceinline__ void operator()(f32x4 (&acc)[4][4], int rb, int cb, int fr, int fq) const {
        float4 pv[4];
#pragma unroll
        for (int n = 0; n < 4; ++n) {
            pv[n] = make_float4(0.f, 0.f, 0.f, 0.f);
            if (MODE == 0 || MODE == 1) pv[n] = *reinterpret_cast<const float4*>(vec + cb + n * 16 + fq * 4);
            else if (MODE == 3) pv[n] = *reinterpret_cast<const float4*>(vec + coff + cb + n * 16 + fq * 4);
        }
#pragma unroll
        for (int m = 0; m < 4; ++m)
#pragma unroll
            for (int n = 0; n < 4; ++n) {
                int row = rb + m * 16 + fr, col = cb + n * 16 + fq * 4;
                const float pvv[4] = {pv[n].x, pv[n].y, pv[n].z, pv[n].w};
                float v[4];
#pragma unroll
                for (int j = 0; j < 4; ++j) {
                    float a = acc[m][n][j];
                    if (MODE == 0) {
                        const float t = -(pvv[j] + a);
                        const float sp = (t > 15.f) ? t : __logf(1.0f + __expf(t));
                        v[j] = -__expf(-sp - 0.5f);
                    } else if (MODE == 1) {
                        v[j] = sigmoidf_(pvv[j] + a);
                    } else if (MODE == 2) {
                        v[j] = a;
                    } else {
                        v[j] = a * pvv[j];
                    }
                }
                uint2 w; w.x = pack2(v[0], v[1]); w.y = pack2(v[2], v[3]);
                *reinterpret_cast<uint2*>(Ob + (size_t)row * ldo + coff + col) = w;
            }
    }
};
struct EpiOut {
    const float* Xprev; float* X;
    __device__ __forceinline__ void operator()(f32x4 (&acc)[4][4], int rb, int cb, int fr, int fq) const {
#pragma unroll
        for (int m = 0; m < 4; ++m)
#pragma unroll
            for (int n = 0; n < 4; ++n) {
                int row = rb + m * 16 + fr, col = cb + n * 16 + fq * 4;
                float4 xp = *reinterpret_cast<const float4*>(Xprev + (size_t)row * DM + col);
                float4 o;
                o.x = ALPHA_F * xp.x + acc[m][n][0]; o.y = ALPHA_F * xp.y + acc[m][n][1];
                o.z = ALPHA_F * xp.z + acc[m][n][2]; o.w = ALPHA_F * xp.w + acc[m][n][3];
                *reinterpret_cast<float4*>(X + (size_t)row * DM + col) = o;
            }
    }
};
struct EpiExp1 {
    bf16_t* H; int base; int cnt;
    __device__ __forceinline__ void operator()(f32x4 (&acc)[4][4], int rb, int cb, int fr, int fq) const {
#pragma unroll
        for (int m = 0; m < 4; ++m) {
            int li = rb + m * 16 + fr;
            if (li < cnt) {
#pragma unroll
                for (int i = 0; i < 2; ++i) {
                    int hcol = (cb >> 1) + i * 16 + fq * 4;
                    float v[4];
#pragma unroll
                    for (int j = 0; j < 4; ++j) v[j] = siluf_(acc[m][2 * i][j]) * acc[m][2 * i + 1][j];
                    uint2 w; w.x = pack2(v[0], v[1]); w.y = pack2(v[2], v[3]);
                    *reinterpret_cast<uint2*>(H + (size_t)(base + li) * 128 + hcol) = w;
                }
            }
        }
    }
};
struct EpiExp2 {
    bf16_t* FS; int pk[4]; float g[4]; int cnt;
    __device__ __forceinline__ void operator()(f32x4 (&acc)[4][4], int rb, int cb, int fr, int fq) const {
#pragma unroll
        for (int m = 0; m < 4; ++m) {
            int li = rb + m * 16 + fr;
            if (li < cnt) {
                const float gg = g[m];
                int tok = pk[m] >> 1, j = pk[m] & 1;
                bf16_t* o = FS + ((size_t)j * NT + tok) * DM;
#pragma unroll
                for (int n = 0; n < 4; ++n) {
                    int col = cb + n * 16 + fq * 4;
                    uint2 w; w.x = pack2(acc[m][n][0] * gg, acc[m][n][1] * gg); w.y = pack2(acc[m][n][2] * gg, acc[m][n][3] * gg);
                    *reinterpret_cast<uint2*>(o + col) = w;
                }
            }
        }
    }
};


namespace pg8 {
#define PG8_LAS __attribute__((address_space(3)))
typedef unsigned short bf16_t;
typedef short bf16x8 __attribute__((ext_vector_type(8)));
typedef float f32x4 __attribute__((ext_vector_type(4)));
typedef unsigned u32x4 __attribute__((ext_vector_type(4)));
constexpr int BM = 256, BK = 64, HALF = 128, HTB = HALF * BK * 2  , STAGE_BYTES = 8 * HTB, NXCD = 8, WGM = 8;

__host__ __device__ __forceinline__ int lds_byte(int r, int c) { const int st = (r >> 4) * 2 + (c >> 5), rr = r & 15, cc = c & 31, ob = rr * 64 + cc * 2; return st * 1024 + (ob ^ (((ob >> 9) & 1) << 5)); }
__host__ __device__ __forceinline__ void stage_rc(int b, int& R, int& C) { const int st = b / 1024, sb = b % 1024, swz = sb ^ (((sb >> 9) & 1) << 5); R = (st >> 1) * 16 + swz / 64; C = (st & 1) * 32 + (swz % 64) / 2; }
__host__ __device__ __forceinline__ int perm32(int rho) { const int n = rho >> 4, i = rho & 15; return 8 * (i >> 2) + 4 * n + (i & 3); }

struct Unit { int pm, pn; };
struct Gemm { const bf16_t* A; const bf16_t* Bt; int M, N, K; };

struct StaticOrder {
    int nM, nN, nwg, G, c;
    __host__ __device__ void init(int M, int N, int G_, int c_) { nM = M / BM; nN = N / BM; nwg = nM * nN; G = G_; c = c_; }
    __host__ __device__ bool next(int i, Unit& u) const {
        const long L = (long)i * G + c; if (L >= nwg) return false;
        int wgid = (int)L; { const int q = nwg / NXCD, r = nwg % NXCD, xcd = wgid % NXCD, off = wgid / NXCD; wgid = (xcd < r ? xcd * (q + 1) : r * (q + 1) + (xcd - r) * q) + off; }
        const int nig = WGM * nN, gid = wgid / nig, fm = gid * WGM, gsz = (nM - fm) < WGM ? (nM - fm) : WGM;
        u.pm = fm + ((wgid % nig) % gsz); u.pn = (wgid % nig) / gsz; return true;
    }
    __device__ __forceinline__ void a_ready(const Unit&) const {}
    __device__ __forceinline__ void done(const Unit&) const {}
};
template <class Epi, class Sched, bool ALIGN_EPI = false, bool SP2 = false>
__device__ __forceinline__ void gemm_phase(PG8_LAS unsigned char* lds, const Gemm g, const Sched& S, const Epi& E, int wave) {
    const int tid = otid(wave), wid = __builtin_amdgcn_readfirstlane(tid >> 6), lane = tid & 63, wr = wid >> 2, wc = wid & 3, fr = lane & 15, fq = lane >> 4;
    const int K = g.K, nt = K / BK;
    unsigned voffA[2], voffB[2];
#pragma unroll
    for (int i = 0; i < 2; ++i) { int R, C; stage_rc(tid * 16 + i * 8192, R, C); const int Rb = Epi::PERM ? ((R & ~31) + perm32(R & 31)) : R;
        voffA[i] = (unsigned)(R * K + C) * 2u; voffB[i] = (unsigned)(Rb * K + C) * 2u; }
    const size_t kstep = (size_t)(BK * 2);
    const size_t hstep = (size_t)HALF * K * 2;
    const size_t tstep = 2 * hstep;
    const unsigned ldsw = (unsigned)wid * 1024u;
    const int aoff = lds_byte(wr * 64 + fr, fq * 8), boff = lds_byte(wc * 32 + fr, fq * 8);
#define PG8_SA(b, h) (((b) * 2 + (h)) * HTB)
#define PG8_SB(b, h) ((4 + (b) * 2 + (h)) * HTB)
#define PG8_STAGE(bufoff, gbase, voff) do { _Pragma("unroll") for (int _i = 0; _i < 2; ++_i) \
        __builtin_amdgcn_global_load_lds((const unsigned*)((const char*)(gbase) + (voff)[_i]), (PG8_LAS unsigned*)(lds + (bufoff) + ldsw + _i * 8192), 16, 0, 0); } while (0)
#define PG8_LDA(dst, b, h) do { _Pragma("unroll") for (int m = 0; m < 4; ++m) _Pragma("unroll") for (int k = 0; k < 2; ++k) dst[m][k] = *(const PG8_LAS bf16x8*)(lds + PG8_SA(b, h) + aoff + m * 2048 + k * 1024); } while (0)
#define PG8_LDB(dst, b, h) do { _Pragma("unroll") for (int n = 0; n < 2; ++n) _Pragma("unroll") for (int k = 0; k < 2; ++k) dst[n][k] = *(const PG8_LAS bf16x8*)(lds + PG8_SB(b, h) + boff + n * 2048 + k * 1024); } while (0)
#define PG8_MMA(ai, bj, At, Bt) do { __builtin_amdgcn_s_setprio(1); _Pragma("unroll") for (int m = 0; m < 4; ++m) _Pragma("unroll") for (int n = 0; n < 2; ++n) _Pragma("unroll") for (int k = 0; k < 2; ++k) \
        acc[ai][bj][m][n] = __builtin_amdgcn_mfma_f32_16x16x32_bf16(Bt[n][k], At[m][k], acc[ai][bj][m][n], 0, 0, 0); __builtin_amdgcn_s_setprio(0); } while (0)
#define PG8_WAIT_V(n) asm volatile("s_waitcnt vmcnt(" #n ")" ::: "memory")
#define PG8_WAIT_L(n) asm volatile("s_waitcnt lgkmcnt(" #n ")" ::: "memory")
#define PG8_BAR __builtin_amdgcn_s_barrier()
#define PG8_SCHED __builtin_amdgcn_sched_barrier(0)
    Unit cur, nxt; int ui = 0;
    if (!S.next(0, cur)) return;
    f32x4 acc[2][2][4][2];
#pragma unroll
    for (int a = 0; a < 2; ++a)
#pragma unroll
        for (int b = 0; b < 2; ++b)
#pragma unroll
            for (int m = 0; m < 4; ++m)
#pragma unroll
                for (int n = 0; n < 2; ++n) acc[a][b][m][n] = (f32x4){0.f, 0.f, 0.f, 0.f};
    bf16x8 At[4][2], B0[2][2], B1[2][2];
    const char* cA = (const char*)g.A + (size_t)cur.pm * tstep; const char* cB = (const char*)g.Bt + (size_t)cur.pn * tstep;
    S.a_ready(cur);
    if constexpr (SP2) {
        PG8_STAGE(PG8_SB(0, 0), cB, voffB); PG8_STAGE(PG8_SB(0, 1), cB + hstep, voffB); PG8_STAGE(PG8_SA(0, 0), cA, voffA); PG8_STAGE(PG8_SA(0, 1), cA + hstep, voffA);
        if (wr == 1) PG8_BAR;
        PG8_WAIT_V(2); PG8_BAR;
        PG8_STAGE(PG8_SB(1, 0), cB + kstep, voffB); PG8_STAGE(PG8_SA(1, 0), cA + kstep, voffA); PG8_STAGE(PG8_SB(1, 1), cB + hstep + kstep, voffB);
        PG8_WAIT_V(6); PG8_BAR;
    } else {
        PG8_STAGE(PG8_SB(0, 0), cB, voffB); PG8_STAGE(PG8_SA(0, 0), cA, voffA); PG8_STAGE(PG8_SB(0, 1), cB + hstep, voffB); PG8_STAGE(PG8_SA(0, 1), cA + hstep, voffA);
        if (wr == 1) PG8_BAR;
        PG8_WAIT_V(4); PG8_BAR;
        PG8_STAGE(PG8_SB(1, 0), cB + kstep, voffB); PG8_STAGE(PG8_SA(1, 0), cA + kstep, voffA); PG8_STAGE(PG8_SB(1, 1), cB + hstep + kstep, voffB);
        PG8_WAIT_V(6); PG8_BAR;
    }
    for (;;) {
        const bool has_next = S.next(ui + 1, nxt);
        const char* nA = has_next ? (const char*)g.A + (size_t)nxt.pm * tstep : cA; const char* nB = has_next ? (const char*)g.Bt + (size_t)nxt.pn * tstep : cB;
        for (int t = 0; t < nt; t += 2) {
            const bool last = (t == nt - 2);
            const char* a1 = cA + (size_t)(t + 1) * kstep;
            const char* a2 = last ? nA : cA + (size_t)(t + 2) * kstep; const char* b2 = last ? nB : cB + (size_t)(t + 2) * kstep;
            const char* a3 = a2 + kstep; const char* b3 = b2 + kstep;
            if (last && has_next) S.a_ready(nxt);
            if constexpr (SP2) {
            PG8_LDB(B0, 0, 0); PG8_LDB(B1, 0, 1); PG8_SCHED; PG8_LDA(At, 0, 0); PG8_STAGE(PG8_SA(1, 1), a1 + hstep, voffA);
            PG8_WAIT_V(8); PG8_WAIT_L(0); PG8_BAR; PG8_MMA(0, 0, At, B0); PG8_MMA(0, 1, At, B1); PG8_BAR; PG8_SCHED;
            PG8_LDA(At, 0, 1); PG8_STAGE(PG8_SB(0, 0), b2, voffB); PG8_STAGE(PG8_SB(0, 1), b2 + hstep, voffB); PG8_STAGE(PG8_SA(0, 0), a2, voffA);
            PG8_WAIT_V(8); PG8_WAIT_L(0); PG8_BAR; PG8_MMA(1, 0, At, B0); PG8_MMA(1, 1, At, B1); PG8_BAR; PG8_SCHED;
            PG8_LDB(B0, 1, 0); PG8_LDB(B1, 1, 1); PG8_SCHED; PG8_LDA(At, 1, 0); PG8_STAGE(PG8_SA(0, 1), a2 + hstep, voffA);
            PG8_WAIT_V(8); PG8_WAIT_L(0); PG8_BAR; PG8_MMA(0, 0, At, B0); PG8_MMA(0, 1, At, B1); PG8_BAR; PG8_SCHED;
            PG8_LDA(At, 1, 1); PG8_STAGE(PG8_SB(1, 0), b3, voffB); PG8_STAGE(PG8_SB(1, 1), b3 + hstep, voffB); PG8_STAGE(PG8_SA(1, 0), a3, voffA);
            PG8_WAIT_V(8); PG8_WAIT_L(0); PG8_BAR; PG8_MMA(1, 0, At, B0); PG8_MMA(1, 1, At, B1); PG8_BAR; PG8_SCHED;
            } else {
            PG8_LDB(B0, 0, 0); PG8_SCHED; PG8_LDA(At, 0, 0); PG8_STAGE(PG8_SA(1, 1), a1 + hstep, voffA);
            PG8_WAIT_L(8); PG8_BAR; PG8_WAIT_L(0); PG8_MMA(0, 0, At, B0); PG8_BAR; PG8_SCHED;
            PG8_LDB(B1, 0, 1); PG8_STAGE(PG8_SB(0, 0), b2, voffB);
            PG8_BAR; PG8_WAIT_L(0); PG8_MMA(0, 1, At, B1); PG8_BAR;
            PG8_LDA(At, 0, 1); PG8_STAGE(PG8_SA(0, 0), a2, voffA);
            PG8_BAR; PG8_WAIT_L(0); PG8_MMA(1, 0, At, B0); PG8_BAR; PG8_SCHED;
            PG8_STAGE(PG8_SB(0, 1), b2 + hstep, voffB);
            PG8_WAIT_V(6); PG8_BAR; PG8_MMA(1, 1, At, B1); PG8_BAR;
            PG8_LDB(B0, 1, 0); PG8_SCHED; PG8_LDA(At, 1, 0); PG8_STAGE(PG8_SA(0, 1), a2 + hstep, voffA);
            PG8_WAIT_L(8); PG8_BAR; PG8_WAIT_L(0); PG8_MMA(0, 0, At, B0); PG8_BAR; PG8_SCHED;
            PG8_LDB(B1, 1, 1); PG8_STAGE(PG8_SB(1, 0), b3, voffB);
            PG8_BAR; PG8_WAIT_L(0); PG8_MMA(0, 1, At, B1); PG8_BAR;
            PG8_LDA(At, 1, 1); PG8_STAGE(PG8_SA(1, 0), a3, voffA);
            PG8_BAR; PG8_WAIT_L(0); PG8_MMA(1, 0, At, B0); PG8_BAR; PG8_SCHED;
            PG8_STAGE(PG8_SB(1, 1), b3 + hstep, voffB);
            PG8_WAIT_V(6); PG8_BAR; PG8_MMA(1, 1, At, B1); PG8_BAR;
            }
        }
        if constexpr (ALIGN_EPI) { if (wr == 0) PG8_BAR; }
        if constexpr (!Epi::AFTER_DRAIN) { E(acc, cur, wr, wc, fr, fq); S.done(cur); }
        if (!has_next) break;
#pragma unroll
        for (int a = 0; a < 2; ++a)
#pragma unroll
            for (int b = 0; b < 2; ++b)
#pragma unroll
                for (int m = 0; m < 4; ++m)
#pragma unroll
                    for (int n = 0; n < 2; ++n) acc[a][b][m][n] = (f32x4){0.f, 0.f, 0.f, 0.f};
        cur = nxt; cA = nA; cB = nB; ++ui;
        if constexpr (ALIGN_EPI) { if (wr == 1) PG8_BAR; }
    }
    PG8_WAIT_V(0);
    if constexpr (!ALIGN_EPI) { if (wr == 0) PG8_BAR; }
    PG8_BAR;
    if constexpr (Epi::AFTER_DRAIN) { E.fused(acc, cur, wr, wc, fr, fq, lds, wid, lane); S.done(cur); }
#undef PG8_SA
#undef PG8_SB
#undef PG8_STAGE
#undef PG8_LDA
#undef PG8_LDB
#undef PG8_MMA
#undef PG8_WAIT_V
#undef PG8_WAIT_L
#undef PG8_BAR
#undef PG8_SCHED
}
}
struct PEpiBf16 {
    static constexpr bool PERM = true, AFTER_DRAIN = false;
    bf16_t* O; int ldo;
    __device__ __forceinline__ void operator()(const pg8::f32x4 (&acc)[2][2][4][2], const pg8::Unit& u, int wr, int wc, int fr, int fq) const {
        const int row0 = u.pm * 256 + wr * 64 + fr, col0 = u.pn * 256 + wc * 32 + 8 * fq;
#pragma unroll
        for (int ai = 0; ai < 2; ++ai)
#pragma unroll
            for (int m = 0; m < 4; ++m) {
                bf16_t* rowp = O + (size_t)(row0 + ai * 128 + m * 16) * ldo + col0;
#pragma unroll
                for (int bj = 0; bj < 2; ++bj) {
                    const pg8::f32x4 v0 = acc[ai][bj][m][0], v1 = acc[ai][bj][m][1];
                    uint4 w; w.x = pack2(v0[0], v0[1]); w.y = pack2(v0[2], v0[3]); w.z = pack2(v1[0], v1[1]); w.w = pack2(v1[2], v1[3]);
                    *reinterpret_cast<uint4*>(rowp + bj * 128) = w;
                }
            }
    }
};
template <bool PREV_BF16>
struct PEpiOut {
    static constexpr bool PERM = true, AFTER_DRAIN = false;
    const float* Xprev; const bf16_t* XprevB; bf16_t* T;
    __device__ __forceinline__ void operator()(const pg8::f32x4 (&acc)[2][2][4][2], const pg8::Unit& u, int wr, int wc, int fr, int fq) const {
        const int row0 = u.pm * 256 + wr * 64 + fr, col0 = u.pn * 256 + wc * 32 + 8 * fq;
#pragma unroll
        for (int ai = 0; ai < 2; ++ai)
#pragma unroll
            for (int m = 0; m < 4; ++m) {
                const size_t ro = (size_t)(row0 + ai * 128 + m * 16) * DM + col0;
#pragma unroll
                for (int bj = 0; bj < 2; ++bj) {
                    const size_t o = ro + bj * 128;
                    float xp[8];
                    if (PREV_BF16) {
                        unpack8(*reinterpret_cast<const uint4*>(XprevB + o), xp);
                    } else {
                        const float4 a = *reinterpret_cast<const float4*>(Xprev + o), b = *reinterpret_cast<const float4*>(Xprev + o + 4);
                        xp[0] = a.x; xp[1] = a.y; xp[2] = a.z; xp[3] = a.w; xp[4] = b.x; xp[5] = b.y; xp[6] = b.z; xp[7] = b.w;
                    }
                    const pg8::f32x4 v0 = acc[ai][bj][m][0], v1 = acc[ai][bj][m][1];
                    uint4 w;
                    w.x = pack2(ALPHA_F * xp[0] + v0[0], ALPHA_F * xp[1] + v0[1]); w.y = pack2(ALPHA_F * xp[2] + v0[2], ALPHA_F * xp[3] + v0[3]);
                    w.z = pack2(ALPHA_F * xp[4] + v1[0], ALPHA_F * xp[5] + v1[1]); w.w = pack2(ALPHA_F * xp[6] + v1[2], ALPHA_F * xp[7] + v1[3]);
                    *reinterpret_cast<uint4*>(T + o) = w;
                }
            }
    }
};
template <class Epi>
__device__ __forceinline__ void big_gemm(const bf16_t* A, const bf16_t* Bt, int M, int N, int K, const Epi& e, unsigned char* smem, int wave) {
    pg8::Gemm g{A, Bt, M, N, K};
    pg8::StaticOrder S;
    S.init(M, N, ogdim(), obid());
    pg8::gemm_phase<Epi, pg8::StaticOrder, true, true>((PG8_LAS unsigned char*)smem, g, S, e, wave);
}

__device__ __forceinline__ void tconv_wave(const float* __restrict__ src, int N, bf16_t* __restrict__ dst, int ldd, int k0, int n0,
                                           int mode, float* tile, int lane) {
#pragma unroll
    for (int i = 0; i < 8; ++i) {
        const int r = i * 8 + (lane >> 3), c4 = (lane & 7) * 4;
        const float4 v = *reinterpret_cast<const float4*>(src + (size_t)(k0 + r) * N + n0 + c4);
        tile[r * 33 + c4] = v.x; tile[r * 33 + c4 + 1] = v.y; tile[r * 33 + c4 + 2] = v.z; tile[r * 33 + c4 + 3] = v.w;
    }
    asm volatile("s_waitcnt lgkmcnt(0)" ::: "memory");
#pragma unroll 8
    for (int nn = 0; nn < 32; ++nn) {
        const int n = n0 + nn;
        int drow = n;
        if (mode == 1) drow = (n >> 4) * 32 + (n & 15);
        else if (mode == 2) drow = (n >> 4) * 32 + 16 + (n & 15);
        dst[(size_t)drow * ldd + k0 + lane] = f2bf(tile[lane * 33 + nn]);
    }
    asm volatile("s_waitcnt lgkmcnt(0)" ::: "memory");
}

__device__ __forceinline__ void phase_pre(const Params& p, unsigned char* smem, int part, int bid, int nb) {
    const int tidx = otid(p.wave);
    const int wv = tidx >> 6, lane = tidx & 63;
    float* tile = reinterpret_cast<float*>(smem) + wv * (64 * 33);
    bf16_t* W = reinterpret_cast<bf16_t*>(p.ws + OFF_W);
    constexpr int T0 = 896, T1 = 512, T7 = 16, T8 = 16, T9 = 32;
    constexpr int T2 = 1536, T3 = 512, T4 = 4096, T5 = 4096, T6 = 4096;
    if (part == 0) {
        if (bid == 0) {
            if (tidx < 64) reinterpret_cast<int*>(p.ws + OFF_CTRL)[tidx] = 0;
            unsigned* bar = reinterpret_cast<unsigned*>(p.ws + OFF_CTRL + 4096);
            for (int i = tidx; i < XCD_BAR_WORDS; i += NTHREADS) bar[i] = 0u;
        }
        constexpr int TOT = T0 + T1 + T7 + T8 + T9;
        for (int u = bid * NWAVES + wv; u < TOT; u += nb * NWAVES) {
            int v = u;
            const float* src; bf16_t* dst; int K, N, tk, tn;
            if (v < T0) { src = p.in[1]; K = 1024; N = 2304; dst = W + WE_IN0; tk = v / 56; tn = v % 56; }
            else if ((v -= T0) < T1) { src = p.in[15]; K = 1024; N = 1024; dst = W + WE_OUT0; tk = v / 32; tn = v % 32; }
            else if ((v -= T1) < T7) { src = p.in[4]; K = 64; N = 512; dst = W + WE_LW2; tk = 0; tn = v; }
            else if ((v -= T7) < T8) { src = p.in[6]; K = 64; N = 512; dst = W + WE_LA2; tk = 0; tn = v; }
            else { v -= T8; src = p.in[7]; K = 128; N = 512; dst = W + WE_LG2; tk = v >> 4; tn = v & 15; }
            tconv_wave(src, N, dst, K, tk * 64, tn * 32, 0, tile, lane);
        }
        __syncthreads();
        {
            float* sWu = reinterpret_cast<float*>(smem);
            float* sPw = sWu + 16 * 128;
            for (int bt = bid; bt < 256; bt += nb) {
                const int g = bt >> 6, k0 = (bt & 63) * 16;
                {
                    const int r = tidx >> 5, c4 = (tidx & 31) * 4;
                    *reinterpret_cast<float4*>(sWu + r * 128 + c4) = *reinterpret_cast<const float4*>(p.in[1] + (size_t)(k0 + r) * 2304 + 1792 + g * 128 + c4);
                }
                for (int i = tidx; i < 128 * 32; i += NTHREADS) {
                    const int r = i >> 5, c4 = (i & 31) * 4;
                    *reinterpret_cast<float4*>(sPw + r * 128 + c4) = *reinterpret_cast<const float4*>(p.in[13] + (size_t)g * 16384 + r * 128 + c4);
                }
                __syncthreads();
                const int k = tidx >> 5, d0 = (tidx & 31) * 4;
                float acc[4] = {0.f, 0.f, 0.f, 0.f};
#pragma unroll 8
                for (int c = 0; c < 128; ++c) {
                    const float a = sWu[k * 128 + c];
                    const float4 bq = *reinterpret_cast<const float4*>(sPw + c * 128 + d0);
                    acc[0] += a * bq.x; acc[1] += a * bq.y; acc[2] += a * bq.z; acc[3] += a * bq.w;
                }
                bf16_t* dstp = W + WE_IN0 + (size_t)(1792 + g * 128 + d0) * 1024 + k0 + k;
#pragma unroll
                for (int j = 0; j < 4; ++j) dstp[(size_t)j * 1024] = f2bf(acc[j]);
                __syncthreads();
            }
        }
        const float4* x4 = reinterpret_cast<const float4*>(p.in[0]);
        uint2* xb = reinterpret_cast<uint2*>(p.ws + OFF_ACTB);
        const size_t n4 = (size_t)NT * DM / 4;
        const size_t stride = (size_t)nb * NTHREADS;
        for (size_t i = (size_t)bid * NTHREADS + tidx; i < n4; i += 8 * stride) {
            float4 v[8];
#pragma unroll
            for (int j = 0; j < 8; ++j) if (i + j * stride < n4) v[j] = x4[i + j * stride];
#pragma unroll
            for (int j = 0; j < 8; ++j) if (i + j * stride < n4) {
                uint2 w; w.x = pack2(v[j].x, v[j].y); w.y = pack2(v[j].z, v[j].w);
                xb[i + j * stride] = w;
            }
        }
    } else {
        constexpr int TOT = T2 + T3 + T4 + T5 + T6;
        for (int u = bid * NWAVES + wv; u < TOT; u += nb * NWAVES) {
            int v = u;
            const float* src; bf16_t* dst; int K, N, mode = 0, tk, tn;
            if (v < T2) { src = p.in[16]; K = 1024; N = 3072; dst = W + WE_IN1; tk = v / 96; tn = v % 96; }
            else if ((v -= T2) < T3) { src = p.in[23]; K = 1024; N = 1024; dst = W + WE_OUT1; tk = v / 32; tn = v % 32; }
            else if ((v -= T3) < T4) { int mat = v >> 6, w = v & 63; src = p.in[30] + (size_t)mat * 131072; K = 1024; N = 128; dst = W + WE_W13 + (size_t)mat * 262144; mode = 1; tk = w >> 2; tn = w & 3; }
            else if ((v -= T4) < T5) { int mat = v >> 6, w = v & 63; src = p.in[31] + (size_t)mat * 131072; K = 1024; N = 128; dst = W + WE_W13 + (size_t)mat * 262144; mode = 2; tk = w >> 2; tn = w & 3; }
            else { v -= T5; int mat = v >> 6, w = v & 63; src = p.in[32] + (size_t)mat * 131072; K = 128; N = 1024; dst = W + WE_W2 + (size_t)mat * 131072; tk = w >> 5; tn = w & 31; }
            tconv_wave(src, N, dst, K, tk * 64, tn * 32, mode, tile, lane);
        }
        {
            bf16_t* RH = W + WE_RT_HI; bf16_t* RL = W + WE_RT_LO;
            for (int i = bid * NTHREADS + tidx; i < 2 * 48 * 1024; i += nb * NTHREADS) {
                const int l = i / (48 * 1024), r = i - l * 48 * 1024, n = r >> 10, k = r & 1023;
                float w = 0.f;
                if (n < 4) w = p.in[26][((size_t)l * 1024 + k) * 4 + n];
                else if (n < 36) w = p.in[28][((size_t)l * 1024 + k) * 32 + (n - 4)];
                const bf16_t h = f2bf(w);
                RH[i] = h; RL[i] = f2bf(w - bf2f(h));
            }
        }
        {
            float2* rope = reinterpret_cast<float2*>(p.ws + OFF_ROPE);
            for (int i = bid * NTHREADS + tidx; i < SEQ * 32; i += nb * NTHREADS) {
                int pos = i >> 5, k = i & 31;
                float inv = powf(10000.0f, -(float)k / 32.0f);
                float ang = (float)pos * inv;
                const double a = (double)ang;
                const double q = rint(a * 0.15915494309189535);
                const float rr = (float)(a - q * 6.283185307179586);
                float s, c;
                sincosf(rr, &s, &c);
                rope[i] = make_float2(c, s);
            }
        }
    }
}

__device__ __forceinline__ void phase_l0_prep(const Params& p) {
    const int tidx = otid(p.wave);
    const bf16_t* P = reinterpret_cast<const bf16_t*>(p.ws + OFF_P);
    bf16_t* LA = reinterpret_cast<bf16_t*>(p.ws + OFF_LORA);
    bf16_t* YC = reinterpret_cast<bf16_t*>(p.ws + OFF_YCAT);
    const float* mu = p.in[2];
    const int nthr = ogdim() * NTHREADS, t0 = obid() * NTHREADS + tidx;
    {
        const int total = NT * 32;
        for (int it0 = t0; it0 < total; it0 += 4 * nthr) {
            uint4 cu[4], pr[4];
#pragma unroll
            for (int q = 0; q < 4; ++q) {
                const int it = it0 + q * nthr;
                cu[q] = make_uint4(0u, 0u, 0u, 0u); pr[q] = cu[q];
                if (it < total) {
                    const int tok = it >> 5, j = it & 31;
                    const bf16_t* src = P + (size_t)tok * 2304 + 1536 + j * 8;
                    cu[q] = *reinterpret_cast<const uint4*>(src);
                    if ((tok & (SEQ - 1)) > 0) pr[q] = *reinterpret_cast<const uint4*>(src - 2304);
                }
            }
#pragma unroll
            for (int q = 0; q < 4; ++q) {
                const int it = it0 + q * nthr;
                if (it < total) {
                    const int tok = it >> 5, j = it & 31, col = 1536 + j * 8;
                    float cur[8], prv[8];
                    unpack8(cu[q], cur); unpack8(pr[q], prv);
                    const float4 m0 = *reinterpret_cast<const float4*>(mu + col), m1 = *reinterpret_cast<const float4*>(mu + col + 4);
                    const float mm[8] = {m0.x, m0.y, m0.z, m0.w, m1.x, m1.y, m1.z, m1.w};
                    float o[8];
#pragma unroll
                    for (int i = 0; i < 8; ++i) {
                        const float z = cur[i] + mm[i] * (prv[i] - cur[i]);
                        o[i] = (j < 8) ? (1.0f - 2.0f / (1.0f + __expf(2.0f * z))) : ((j < 16) ? z : sigmoidf_(z));
                    }
                    uint4 w; w.x = pack2(o[0], o[1]); w.y = pack2(o[2], o[3]); w.z = pack2(o[4], o[5]); w.w = pack2(o[6], o[7]);
                    *reinterpret_cast<uint4*>(LA + (size_t)tok * 256 + j * 8) = w;
                }
            }
        }
    }
    {
        const int total = NT * 64;
        for (int it = t0; it < total; it += nthr) {
            const int tok = it >> 6, cc = (it & 63) * 8;
            const int s = tok & (SEQ - 1);
            const int gi = cc >> 7;
            const int win = 2 << gi;
            const int cnt = (s + 1 < win) ? (s + 1) : win;
            const bf16_t* src = P + (size_t)tok * 2304 + 1792 + cc;
            float u[8], sum[8];
            uint4 rows[16];
#pragma unroll
            for (int r = 0; r < 16; ++r) {
                rows[r] = make_uint4(0u, 0u, 0u, 0u);
                if (r < cnt) rows[r] = *reinterpret_cast<const uint4*>(src - (size_t)r * 2304);
            }
            unpack8(rows[0], u);
#pragma unroll
            for (int i = 0; i < 8; ++i) sum[i] = u[i];
#pragma unroll
            for (int r = 1; r < 16; ++r) {
                float t[8];
                unpack8(rows[r], t);
#pragma unroll
                for (int i = 0; i < 8; ++i) sum[i] += t[i];
            }
            const float inv = 1.0f / (float)cnt;
            const float4 ps0 = *reinterpret_cast<const float4*>(p.in[14] + cc), ps1 = *reinterpret_cast<const float4*>(p.in[14] + cc + 4);
            uint4 w;
            w.x = pack2((sum[0] * inv - u[0]) * ps0.x, (sum[1] * inv - u[1]) * ps0.y); w.y = pack2((sum[2] * inv - u[2]) * ps0.z, (sum[3] * inv - u[3]) * ps0.w);
            w.z = pack2((sum[4] * inv - u[4]) * ps1.x, (sum[5] * inv - u[5]) * ps1.y); w.w = pack2((sum[6] * inv - u[6]) * ps1.z, (sum[7] * inv - u[7]) * ps1.w);
            *reinterpret_cast<uint4*>(YC + (size_t)tok * 1024 + 512 + cc) = w;
        }
    }
}

__device__ __forceinline__ void phase_l0_lora(const Params& p, bf16_t* smem) {
    const bf16_t* W = reinterpret_cast<const bf16_t*>(p.ws + OFF_W);
    const bf16_t* LA = reinterpret_cast<const bf16_t*>(p.ws + OFF_LORA);
    const bf16_t* PO = reinterpret_cast<const bf16_t*>(p.ws + OFF_POOLED);
    for (int t = obid(); t < 1536; t += ogdim()) {
        int job = t >> 9, w = t & 511;
        if (job == 0) {
            EpiLora<0> e{nullptr, reinterpret_cast<bf16_t*>(p.ws + OFF_LOGW), p.in[3], 512, 0};
            gemm_tile<false>(LA, 256, nullptr, 0, W + WE_LW2, 64, 64, (w >> 2) * 256, (w & 3) * 128, e, smem, p.wave);
        } else if (job == 1) {
            EpiLora<1> e{nullptr, reinterpret_cast<bf16_t*>(p.ws + OFF_AA), p.in[5], 512, 0};
            gemm_tile<false>(LA + 64, 256, nullptr, 0, W + WE_LA2, 64, 64, (w >> 2) * 256, (w & 3) * 128, e, smem, p.wave);
        } else {
            EpiLora<2> e{nullptr, reinterpret_cast<bf16_t*>(p.ws + OFF_GG), nullptr, 512, 0};
            gemm_tile<false>(LA + 128, 256, nullptr, 0, W + WE_LG2, 128, 128, (w >> 2) * 256, (w & 3) * 128, e, smem, p.wave);
        }
    }
}

#define RC_LD 72
#define RC_BUF (64 * RC_LD)
#define RC_BYTES (RC_BUF * 2)
#define OFF_TBUF OFF_KVT

__device__ __forceinline__ void mm64(f32x4 (&acc)[2], const bf16_t* A, const bf16_t* Bt, int mt, int nt0, int fr, int fq) {
#pragma unroll
    for (int ks = 0; ks < 2; ++ks) {
        bf16x8 af = *reinterpret_cast<const bf16x8*>(A + (mt * 16 + fr) * RC_LD + ks * 32 + fq * 8);
        bf16x8 bq[2];
#pragma unroll
        for (int n = 0; n < 2; ++n) bq[n] = *reinterpret_cast<const bf16x8*>(Bt + ((nt0 + n) * 16 + fr) * RC_LD + ks * 32 + fq * 8);
#pragma unroll
        for (int n = 0; n < 2; ++n) acc[n] = __builtin_amdgcn_mfma_f32_16x16x32_bf16(af, bq[n], acc[n], 0, 0, 0);
    }
}
template <int MASK>
__device__ __forceinline__ void store_T(bf16_t* dst, const f32x4 (&acc)[2], int mt, int nt0, int fr, int fq) {
#pragma unroll
    for (int n = 0; n < 2; ++n) {
        const int C = (nt0 + n) * 16 + fr, R0 = mt * 16 + fq * 4;
        float v[4];
#pragma unroll
        for (int j = 0; j < 4; ++j) {
            const int R = R0 + j;
            bool keep = true;
            if (MASK == 1) keep = R < C;
            else if (MASK == 2) keep = R <= C;
            else if (MASK == 3) keep = C < R;
            v[j] = keep ? acc[n][j] : 0.f;
        }
        uint2 w; w.x = pack2(v[0], v[1]); w.y = pack2(v[2], v[3]);
        *reinterpret_cast<uint2*>(dst + C * RC_LD + R0) = w;
    }
}
__device__ __forceinline__ void zero_acc(f32x4 (&acc)[2]) {
    acc[0] = (f32x4){0.f, 0.f, 0.f, 0.f};
    acc[1] = (f32x4){0.f, 0.f, 0.f, 0.f};
}

#define OFF_NTB (OFF_P + 144ull * MIB)
#define OFF_S0A (OFF_P + 176ull * MIB)
#define OFF_TB (420ull * MIB)
#define OFF_MB (452ull * MIB)
#define OFF_S0B (484ull * MIB)
#define OFF_WLB (500ull * MIB)
#define OFF_BCB (501ull * MIB)
__device__ __forceinline__ bf16_t* s0_ptr(unsigned char* ws, int u) {
    return reinterpret_cast<bf16_t*>(ws + (u < 2048 ? OFF_S0A : OFF_S0B)) + (size_t)(u & 2047) * 4096;
}

struct PrepIn {
    unsigned short k[8], v[8], r[8], lw[8], a[8];
    unsigned short pk, pv, pr;
};
template <int MODE>
__device__ __forceinline__ void prep_load(PrepIn& in, const Params& p, int u, int tid) {
    const int b = u >> 10, h = (u >> 7) & 7, n = u & 127;
    const int lane = tid & 63, q = tid >> 6;
    const int c = h * 64 + lane;
    const bf16_t* P = reinterpret_cast<const bf16_t*>(p.ws + OFF_P);
    const bf16_t* LOGW = reinterpret_cast<const bf16_t*>(p.ws + OFF_LOGW);
    const bf16_t* AA = reinterpret_cast<const bf16_t*>(p.ws + OFF_AA);
    const int s0 = n * 64 + q * 8;
    const size_t tok0 = (size_t)b * SEQ + s0;
    in.pk = 0; in.pv = 0; in.pr = 0;
    if (s0 > 0) {
        const bf16_t* pp = P + (tok0 - 1) * 2304;
        in.pk = pp[512 + c]; in.pv = pp[1024 + c];
        in.pr = pp[c];
    }
#pragma unroll
    for (int i = 0; i < 8; ++i) {
        const bf16_t* pp = P + (tok0 + i) * 2304;
        in.k[i] = pp[512 + c]; in.v[i] = pp[1024 + c];
        in.r[i] = pp[c];
        in.lw[i] = LOGW[(tok0 + i) * 512 + c];
        in.a[i] = AA[(tok0 + i) * 512 + c];
    }
}
struct PrepC { float mu_k, kkc, kac, mu_v, mu_r, rkc, lng, lnb; };
template <int MODE>
__device__ __forceinline__ PrepC prep_consts(const Params& p, int h, int lane) {
    PrepC c_;
    const int c = h * 64 + lane;
    c_.mu_k = p.in[2][512 + c]; c_.kkc = p.in[8][c]; c_.kac = p.in[9][c]; c_.mu_v = p.in[2][1024 + c];
    c_.mu_r = 0.f; c_.rkc = 0.f; c_.lng = 0.f; c_.lnb = 0.f;
    c_.mu_r = p.in[2][c]; c_.rkc = p.in[10][c];
    if (MODE == 2) { c_.lng = p.in[11][c]; c_.lnb = p.in[12][c]; }
    return c_;
}
template <int MODE>
__device__ __forceinline__ void rwkv_prep(const PrepIn& in, const PrepC& pc, int tid, bf16_t* At, bf16_t* Bt, bf16_t* Kt, bf16_t* Rt,
                                          bf16_t* AtT, bf16_t* BtT, bf16_t* KtT, bf16_t* VT, float* sTot, float* sBC, float* sWL) {
    const int lane = tid & 63, q = tid >> 6;
    const float mu_k = pc.mu_k, kkc = pc.kkc, kac = pc.kac, mu_v = pc.mu_v, mu_r = pc.mu_r, rkc = pc.rkc;
    float lw[8], av[8], zk[8], zr[8], zv[8];
    float pk = bf2f(in.pk), pr = bf2f(in.pr), pv = bf2f(in.pv);
#pragma unroll
    for (int i = 0; i < 8; ++i) {
        const float k0 = bf2f(in.k[i]), v0 = bf2f(in.v[i]);
        zk[i] = k0 + mu_k * (pk - k0); pk = k0;
        zv[i] = v0 + mu_v * (pv - v0); pv = v0;
        { const float r0 = bf2f(in.r[i]); zr[i] = r0 + mu_r * (pr - r0); pr = r0; }
        lw[i] = bf2f(in.lw[i]);
        av[i] = bf2f(in.a[i]);
    }
    float lws[8];
    float cs = 0.f;
#pragma unroll
    for (int i = 0; i < 8; ++i) { cs += lw[i]; lws[i] = cs; }
    sTot[q * 64 + lane] = cs;
    lds_barrier();
    float off = 0.f, tot = 0.f;
#pragma unroll
    for (int qq = 0; qq < 8; ++qq) { float tq = sTot[qq * 64 + lane]; if (qq < q) off += tq; tot += tq; }
    float atv[8], btv[8], ktv[8];
#pragma unroll
    for (int i = 0; i < 8; ++i) {
        const int t = q * 8 + i;
        const float L = lws[i] + off;
        float kk = zk[i] * kkc;
        float ss = wave_sum(kk * kk);
        kk *= rsqrtf(fmaxf(ss, 1e-24f));
        const float e_neg = __expf(-L), e_prev = __expf(L - lw[i]);
        const float a = av[i];
        const float at = -kk * e_prev;
        At[t * RC_LD + lane] = f2bf(at);
        const float bt = kk * a * e_neg;
        Bt[t * RC_LD + lane] = f2bf(bt);
        const float kp = zk[i] * (1.0f + (a - 1.0f) * kac);
        const float kt = kp * e_neg;
        Kt[t * RC_LD + lane] = f2bf(kt);
        atv[i] = at; btv[i] = bt; ktv[i] = kt;
        {
            Rt[t * RC_LD + lane] = f2bf(zr[i] * __expf(L));
            const float bc = wave_sum(zr[i] * kp * rkc);
            if (lane == 0) sBC[t] = bc;
        }
    }
    uint4 w0;
    if (MODE == 1) {
        w0.x = pack2(atv[0], atv[1]); w0.y = pack2(atv[2], atv[3]); w0.z = pack2(atv[4], atv[5]); w0.w = pack2(atv[6], atv[7]);
        *reinterpret_cast<uint4*>(AtT + lane * RC_LD + q * 8) = w0;
        w0.x = pack2(btv[0], btv[1]); w0.y = pack2(btv[2], btv[3]); w0.z = pack2(btv[4], btv[5]); w0.w = pack2(btv[6], btv[7]);
        *reinterpret_cast<uint4*>(BtT + lane * RC_LD + q * 8) = w0;
        w0.x = pack2(ktv[0], ktv[1]); w0.y = pack2(ktv[2], ktv[3]); w0.z = pack2(ktv[4], ktv[5]); w0.w = pack2(ktv[6], ktv[7]);
        *reinterpret_cast<uint4*>(KtT + lane * RC_LD + q * 8) = w0;
        if (q == 0) sWL[lane] = __expf(tot);
    }
    w0.x = pack2(zv[0], zv[1]); w0.y = pack2(zv[2], zv[3]); w0.z = pack2(zv[4], zv[5]); w0.w = pack2(zv[6], zv[7]);
    *reinterpret_cast<uint4*>(VT + lane * RC_LD + q * 8) = w0;
}

__device__ __forceinline__ void phase_rwkv_r1(const Params& p, unsigned char* smem) {
    const int tidx = otid(p.wave);
    const int tid = tidx, wv = tid >> 6, lane = tid & 63, fr = lane & 15, fq = lane >> 4, mt = wv >> 1, nt0 = (wv & 1) * 2;
    bf16_t* base = reinterpret_cast<bf16_t*>(smem);
    bf16_t* At = base; bf16_t* Bt = base + RC_BUF; bf16_t* Kt = base + 2 * RC_BUF; bf16_t* AtT = base + 3 * RC_BUF;
    bf16_t* BtT = base + 4 * RC_BUF; bf16_t* KtT = base + 5 * RC_BUF; bf16_t* VT = base + 6 * RC_BUF;
    bf16_t* Rb0 = base + 7 * RC_BUF; bf16_t* Cb0 = base + 8 * RC_BUF; bf16_t* Rb1 = base + 9 * RC_BUF; bf16_t* Cb1 = base + 10 * RC_BUF;
    bf16_t* Pm0 = base + 11 * RC_BUF; bf16_t* Pm1 = base + 12 * RC_BUF;
    bf16_t* Rt = base + 13 * RC_BUF; bf16_t* Aak = base + 14 * RC_BUF;
    bf16_t* Tm = Rb0; bf16_t* PT = Rb1; bf16_t* AkVT = Cb1; bf16_t* QT = Pm0; bf16_t* Arb = At; bf16_t* Ark = Bt;
    float* sTot = reinterpret_cast<float*>(smem + 15 * RC_BYTES);
    float* sWL = sTot + 512;
    float* sBC = sWL + 64;
    bf16_t* PRg = reinterpret_cast<bf16_t*>(p.ws + OFF_AA);
    bf16_t* YQg = reinterpret_cast<bf16_t*>(p.ws + OFF_LOGW);
    float* BCg = reinterpret_cast<float*>(p.ws + OFF_BCB);
    bf16_t* Mg = reinterpret_cast<bf16_t*>(p.ws + OFF_MB);
    bf16_t* Ng = reinterpret_cast<bf16_t*>(p.ws + OFF_NTB);
    float* WLg = reinterpret_cast<float*>(p.ws + OFF_WLB);
    PrepIn cur, nxt;
    if (obid() < 4096) prep_load<1>(cur, p, obid(), tid);
    nxt = cur;
    for (int u = obid(); u < 4096; u += ogdim()) {
        const int h = (u >> 7) & 7, b = u >> 10, n = u & 127;
        PrepC pc = prep_consts<1>(p, h, lane);
        asm volatile("" : "+v"(pc.mu_k), "+v"(pc.kkc), "+v"(pc.kac), "+v"(pc.mu_v), "+v"(pc.mu_r), "+v"(pc.rkc));
        if (u + ogdim() < 4096) prep_load<1>(nxt, p, u + ogdim(), tid);
        rwkv_prep<1>(cur, pc, tid, At, Bt, Kt, Rt, AtT, BtT, KtT, VT, sTot, sBC, sWL);
        lds_barrier();
        f32x4 pacc[2];
        f32x4 acc[2];
        zero_acc(acc);
        mm64(acc, At, Bt, mt, nt0, fr, fq);
        store_T<3>(Cb0, acc, mt, nt0, fr, fq);
        zero_acc(pacc);
        mm64(pacc, Bt, At, mt, nt0, fr, fq);
#pragma unroll
        for (int nn = 0; nn < 2; ++nn)
#pragma unroll
            for (int j = 0; j < 4; ++j) {
                const int R = mt * 16 + fq * 4 + j, C = (nt0 + nn) * 16 + fr;
                pacc[nn][j] = (R < C) ? pacc[nn][j] : 0.f;
            }
        store_T<0>(Rb0, pacc, mt, nt0, fr, fq);
#pragma unroll
        for (int nn = 0; nn < 2; ++nn)
#pragma unroll
            for (int j = 0; j < 4; ++j) {
                const int R = mt * 16 + fq * 4 + j, C = (nt0 + nn) * 16 + fr;
                if (R == C) pacc[nn][j] += 1.0f;
            }
        store_T<0>(Pm0, pacc, mt, nt0, fr, fq);
        lds_barrier();
        zero_acc(acc); mm64(acc, Cb0, Rb0, mt, nt0, fr, fq); store_T<0>(Rb1, acc, mt, nt0, fr, fq);
        zero_acc(acc); mm64(acc, Rb0, Cb0, mt, nt0, fr, fq); store_T<0>(Cb1, acc, mt, nt0, fr, fq);
        zero_acc(acc); mm64(acc, Kt, At, mt, nt0, fr, fq); store_T<1>(Aak, acc, mt, nt0, fr, fq);
        lds_barrier();
        zero_acc(acc); mm64(acc, Cb1, Rb1, mt, nt0, fr, fq); store_T<0>(Rb0, acc, mt, nt0, fr, fq);
        zero_acc(acc); mm64(acc, Rb1, Cb1, mt, nt0, fr, fq); store_T<0>(Cb0, acc, mt, nt0, fr, fq);
        zero_acc(acc); mm64(acc, Cb1, Pm0, mt, nt0, fr, fq); pacc[0] += acc[0]; pacc[1] += acc[1]; store_T<0>(Pm1, pacc, mt, nt0, fr, fq);
        zero_acc(acc); mm64(acc, Bt, Rt, mt, nt0, fr, fq); store_T<2>(Arb, acc, mt, nt0, fr, fq);
        lds_barrier();
        zero_acc(acc); mm64(acc, Cb0, Rb0, mt, nt0, fr, fq); store_T<0>(Rb1, acc, mt, nt0, fr, fq);
        zero_acc(acc); mm64(acc, Rb0, Cb0, mt, nt0, fr, fq); store_T<0>(Cb1, acc, mt, nt0, fr, fq);
        zero_acc(acc); mm64(acc, Cb0, Pm1, mt, nt0, fr, fq); pacc[0] += acc[0]; pacc[1] += acc[1]; store_T<0>(Pm0, pacc, mt, nt0, fr, fq);
        zero_acc(acc); mm64(acc, Kt, Rt, mt, nt0, fr, fq); store_T<2>(Ark, acc, mt, nt0, fr, fq);
        lds_barrier();
        zero_acc(acc); mm64(acc, Cb1, Rb1, mt, nt0, fr, fq); store_T<0>(Rb0, acc, mt, nt0, fr, fq);
        zero_acc(acc); mm64(acc, Rb1, Cb1, mt, nt0, fr, fq); store_T<0>(Cb0, acc, mt, nt0, fr, fq);
        zero_acc(acc); mm64(acc, Cb1, Pm0, mt, nt0, fr, fq); pacc[0] += acc[0]; pacc[1] += acc[1]; store_T<0>(Pm1, pacc, mt, nt0, fr, fq);
        lds_barrier();
        zero_acc(acc); mm64(acc, Rb0, Cb0, mt, nt0, fr, fq); store_T<0>(Cb1, acc, mt, nt0, fr, fq);
        zero_acc(acc); mm64(acc, Cb0, Pm1, mt, nt0, fr, fq); pacc[0] += acc[0]; pacc[1] += acc[1]; store_T<0>(Pm0, pacc, mt, nt0, fr, fq);
        lds_barrier();
        zero_acc(acc); mm64(acc, Cb1, Pm0, mt, nt0, fr, fq); pacc[0] += acc[0]; pacc[1] += acc[1];
        store_T<0>(Tm, pacc, mt, nt0, fr, fq);
        lds_barrier();
        zero_acc(acc); mm64(acc, Tm, AtT, mt, nt0, fr, fq); store_T<0>(PT, acc, mt, nt0, fr, fq);
        zero_acc(acc); mm64(acc, Aak, VT, mt, nt0, fr, fq); store_T<0>(AkVT, acc, mt, nt0, fr, fq);
        lds_barrier();
        {
            zero_acc(acc); mm64(acc, Tm, AkVT, mt, nt0, fr, fq); store_T<0>(QT, acc, mt, nt0, fr, fq);
            zero_acc(acc); mm64(acc, PT, BtT, mt, nt0, fr, fq);
            bf16_t* Mo = Mg + (size_t)u * 4096;
#pragma unroll
            for (int nn = 0; nn < 2; ++nn) {
                const int C = (nt0 + nn) * 16 + fr, Rb = mt * 16 + fq * 4;
                const float wl = sWL[C];
                uint2 w; w.x = pack2(acc[nn][0] * wl, acc[nn][1] * wl); w.y = pack2(acc[nn][2] * wl, acc[nn][3] * wl);
                const int pos = (Rb & ~12) | ((Rb & 4) << 1) | ((Rb & 8) >> 1);
                const int posw = ((((pos >> 3) ^ (C & 7)) << 3) | (pos & 7));
                *reinterpret_cast<uint2*>(Mo + C * 64 + posw) = w;
            }
        }
        lds_barrier();
        {
            zero_acc(acc); mm64(acc, BtT, QT, mt, nt0, fr, fq); mm64(acc, KtT, VT, mt, nt0, fr, fq);
            bf16_t* No = Ng + (size_t)u * 4096;
            float wl[4];
#pragma unroll
            for (int j = 0; j < 4; ++j) wl[j] = sWL[mt * 16 + fq * 4 + j];
#pragma unroll
            for (int nn = 0; nn < 2; ++nn) {
                const int C = (nt0 + nn) * 16 + fr, Rb = mt * 16 + fq * 4;
                uint2 w; w.x = pack2(acc[nn][0] * wl[0], acc[nn][1] * wl[1]); w.y = pack2(acc[nn][2] * wl[2], acc[nn][3] * wl[3]);
                const int posw = ((((Rb >> 3) ^ (C & 7)) << 3) | (Rb & 7));
                *reinterpret_cast<uint2*>(No + C * 64 + posw) = w;
            }
            if (tid < 64) { WLg[(size_t)u * 64 + tid] = sWL[tid]; BCg[(size_t)u * 64 + tid] = sBC[tid]; }
            const size_t tok0 = (size_t)b * SEQ + n * 64;
            zero_acc(acc); mm64(acc, PT, Arb, mt, nt0, fr, fq);
#pragma unroll
            for (int nn = 0; nn < 2; ++nn) {
                const int C = (nt0 + nn) * 16 + fr, Rb = mt * 16 + fq * 4;
                const uint2 rt = *reinterpret_cast<const uint2*>(Rt + C * RC_LD + Rb);
                uint2 w;
                w.x = pack2(acc[nn][0] + __uint_as_float(rt.x << 16), acc[nn][1] + __uint_as_float(rt.x & 0xffff0000u));
                w.y = pack2(acc[nn][2] + __uint_as_float(rt.y << 16), acc[nn][3] + __uint_as_float(rt.y & 0xffff0000u));
                *reinterpret_cast<uint2*>(PRg + (tok0 + C) * 512 + h * 64 + Rb) = w;
            }
            zero_acc(acc); mm64(acc, QT, Arb, mt, nt0, fr, fq); mm64(acc, VT, Ark, mt, nt0, fr, fq);
#pragma unroll
            for (int nn = 0; nn < 2; ++nn) {
                const int C = (nt0 + nn) * 16 + fr, Rb = mt * 16 + fq * 4;
                uint2 w; w.x = pack2(acc[nn][0], acc[nn][1]); w.y = pack2(acc[nn][2], acc[nn][3]);
                *reinterpret_cast<uint2*>(YQg + (tok0 + C) * 512 + h * 64 + Rb) = w;
            }
        }
        cur = nxt;
        lds_barrier();
    }
}

typedef float f32x16 __attribute__((ext_vector_type(16)));
#define R2_SLOT 12800
__device__ __forceinline__ void r2_issue(const unsigned char* Mg, const unsigned char* Ng, const unsigned char* WLg, size_t u, int J, int lane,
                                         unsigned char* slot) {
#pragma unroll
    for (int i = 0; i < 8; ++i)
        __builtin_amdgcn_global_load_lds((const unsigned*)(Mg + u * 8192 + i * 1024 + lane * 16),
                                         (__attribute__((address_space(3))) unsigned*)(slot + i * 1024), 16, 0, 0);
#pragma unroll
    for (int i = 0; i < 4; ++i)
        __builtin_amdgcn_global_load_lds((const unsigned*)(Ng + u * 8192 + J * 4096 + i * 1024 + lane * 16),
                                         (__attribute__((address_space(3))) unsigned*)(slot + 8192 + i * 1024), 16, 0, 0);
    __builtin_amdgcn_global_load_lds((const unsigned*)(WLg + u * 256 + lane * 4),
                                     (__attribute__((address_space(3))) unsigned*)(slot + 12288), 4, 0, 0);
}
__device__ __forceinline__ unsigned lds_addr(const void* p) { return (unsigned)(size_t)(const __attribute__((address_space(3))) unsigned char*)p; }
template <int OFF> __device__ __forceinline__ void ldsr128(bf16x8& d, unsigned a) { asm volatile("ds_read_b128 %0, %1 offset:%2" : "=v"(d) : "v"(a), "n"(OFF)); }
template <int OFF> __device__ __forceinline__ void ldsr128f(float4& d, unsigned a) { asm volatile("ds_read_b128 %0, %1 offset:%2" : "=v"(d) : "v"(a), "n"(OFF)); }
template <int OFF> __device__ __forceinline__ void ldsr64(uint2& d, unsigned a) { asm volatile("ds_read_b64 %0, %1 offset:%2" : "=v"(d) : "v"(a), "n"(OFF)); }
template <int WAITN>
__device__ __forceinline__ void r2_step(f32x16 (&S)[2], const unsigned char* slot, bf16_t* so, int r, int h) {
    if (WAITN == 51) asm volatile("s_waitcnt vmcnt(51)" ::: "memory");
    else if (WAITN == 39) asm volatile("s_waitcnt vmcnt(39)" ::: "memory");
    else asm volatile("s_waitcnt vmcnt(0)" ::: "memory");
    uint2 nv[2][4]; float4 wl[2][4]; bf16x8 af[2][2][2];
    const unsigned sa = lds_addr(slot);
    {
        const unsigned aw = sa + 12288 + h * 16;
        ldsr128f<0>(wl[0][0], aw); ldsr128f<32>(wl[0][1], aw); ldsr128f<64>(wl[0][2], aw); ldsr128f<96>(wl[0][3], aw);
        ldsr128f<128>(wl[1][0], aw); ldsr128f<160>(wl[1][1], aw); ldsr128f<192>(wl[1][2], aw); ldsr128f<224>(wl[1][3], aw);
        const unsigned an = sa + 8192 + r * 128 + h * 8;
        const unsigned x0 = ((0 ^ (r & 7)) * 16), x1 = ((1 ^ (r & 7)) * 16), x2 = ((2 ^ (r & 7)) * 16), x3 = ((3 ^ (r & 7)) * 16);
        ldsr64<0>(nv[0][0], an + x0); ldsr64<0>(nv[0][1], an + x1); ldsr64<0>(nv[0][2], an + x2); ldsr64<0>(nv[0][3], an + x3);
        ldsr64<0>(nv[1][0], an + (x0 ^ 64)); ldsr64<0>(nv[1][1], an + (x1 ^ 64)); ldsr64<0>(nv[1][2], an + (x2 ^ 64)); ldsr64<0>(nv[1][3], an + (x3 ^ 64));
        const unsigned aa = sa + r * 128;
        const unsigned c00 = (((0 + h) ^ (r & 7)) * 16), c01 = (((2 + h) ^ (r & 7)) * 16), c10 = (((4 + h) ^ (r & 7)) * 16), c11 = (((6 + h) ^ (r & 7)) * 16);
        ldsr128<0>(af[0][0][0], aa + c00); ldsr128<0>(af[0][0][1], aa + c01); ldsr128<0>(af[0][1][0], aa + c10); ldsr128<0>(af[0][1][1], aa + c11);
        ldsr128<4096>(af[1][0][0], aa + c00); ldsr128<4096>(af[1][0][1], aa + c01); ldsr128<4096>(af[1][1][0], aa + c10); ldsr128<4096>(af[1][1][1], aa + c11);
    }
    unsigned pk[2][8];
#pragma unroll
    for (int K = 0; K < 2; ++K)
#pragma unroll
        for (int q = 0; q < 8; ++q) pk[K][q] = pack2(S[K][2 * q], S[K][2 * q + 1]);
#pragma unroll
    for (int I = 0; I < 2; ++I) {
        uint4 w0, w1;
        w0.x = pk[I][0]; w0.y = pk[I][1]; w0.z = pk[I][2]; w0.w = pk[I][3];
        w1.x = pk[I][4]; w1.y = pk[I][5]; w1.z = pk[I][6]; w1.w = pk[I][7];
        *reinterpret_cast<uint4*>(so + r * 64 + I * 32 + h * 16) = w0;
        *reinterpret_cast<uint4*>(so + r * 64 + I * 32 + h * 16 + 8) = w1;
    }
    asm volatile("s_waitcnt lgkmcnt(0)" ::: "memory");
    __builtin_amdgcn_sched_barrier(0);
    bf16x8 bfrag[2][2];
#pragma unroll
    for (int K = 0; K < 2; ++K)
#pragma unroll
        for (int s = 0; s < 2; ++s) {
            union { bf16x8 v; unsigned u[4]; } cvt;
#pragma unroll
            for (int q = 0; q < 4; ++q) cvt.u[q] = pk[K][4 * s + q];
            bfrag[K][s] = cvt.v;
        }
#pragma unroll
    for (int I = 0; I < 2; ++I) {
        f32x16 acc;
#pragma unroll
        for (int g = 0; g < 4; ++g) {
            acc[4 * g + 0] = __uint_as_float(nv[I][g].x << 16) + wl[I][g].x * S[I][4 * g + 0];
            acc[4 * g + 1] = __uint_as_float(nv[I][g].x & 0xffff0000u) + wl[I][g].y * S[I][4 * g + 1];
            acc[4 * g + 2] = __uint_as_float(nv[I][g].y << 16) + wl[I][g].z * S[I][4 * g + 2];
            acc[4 * g + 3] = __uint_as_float(nv[I][g].y & 0xffff0000u) + wl[I][g].w * S[I][4 * g + 3];
        }
#pragma unroll
        for (int K = 0; K < 2; ++K)
#pragma unroll
            for (int s = 0; s < 2; ++s) acc = __builtin_amdgcn_mfma_f32_32x32x16_bf16(af[I][K][s], bfrag[K][s], acc, 0, 0, 0);
        S[I] = acc;
    }
}
__device__ __forceinline__ void phase_rwkv_r2(const Params& p, unsigned char* smem) {
    const int tidx = otid(p.wave);
    if (obid() >= 64) { phase_pre(p, smem, 1, obid() - 64, ogdim() - 64); return; }
    if (p.wave != 0) return;
    const int task = obid(), bh = task >> 1, J = task & 1;
    const int lane = tidx & 63, r = lane & 31, h = lane >> 5;
    const unsigned char* Mg = p.ws + OFF_MB;
    const unsigned char* Ng = p.ws + OFF_NTB;
    const unsigned char* WLg = p.ws + OFF_WLB;
    f32x16 S[2];
#pragma unroll
    for (int i = 0; i < 16; ++i) { S[0][i] = 0.f; S[1][i] = 0.f; }
    const size_t ub = (size_t)bh * 128;
    r2_issue(Mg, Ng, WLg, ub + 0, J, lane, smem + 0 * R2_SLOT);
    r2_issue(Mg, Ng, WLg, ub + 1, J, lane, smem + 1 * R2_SLOT);
    r2_issue(Mg, Ng, WLg, ub + 2, J, lane, smem + 2 * R2_SLOT);
#define R2_STEP(n_, SL, W) do { \
        const int n2 = (n_); \
        if (n2 + 3 < 128) r2_issue(Mg, Ng, WLg, ub + n2 + 3, J, lane, smem + (((SL) + 3) & 3) * R2_SLOT); \
        r2_step<W>(S, smem + (SL) * R2_SLOT, s0_ptr(p.ws, (int)ub + n2) + (size_t)J * 32 * 64, r, h); } while (0)
    R2_STEP(0, 0, 39); R2_STEP(1, 1, 39); R2_STEP(2, 2, 39); R2_STEP(3, 3, 51);
#pragma unroll 1
    for (int n = 4; n < 124; n += 4) {
        R2_STEP(n, 0, 51); R2_STEP(n + 1, 1, 51); R2_STEP(n + 2, 2, 51); R2_STEP(n + 3, 3, 51);
    }
    R2_STEP(124, 0, 51); R2_STEP(125, 1, 0); R2_STEP(126, 2, 0); R2_STEP(127, 3, 0);
#undef R2_STEP
}

struct R3In { uint4 pr, s0; uint2 yq[2]; unsigned short v[8], g[8]; unsigned short pv; float bc[8]; };
__device__ __forceinline__ void r3_load(R3In& in, const Params& p, int u, int tid) {
    const int b = u >> 10, h = (u >> 7) & 7, n = u & 127;
    const int wv = tid >> 6, lane = tid & 63, fr = lane & 15, fq = lane >> 4, mt = wv >> 1, nt0 = (wv & 1) * 2;
    const size_t tok0 = (size_t)b * SEQ + n * 64;
    const bf16_t* PRg = reinterpret_cast<const bf16_t*>(p.ws + OFF_AA);
    const bf16_t* YQg = reinterpret_cast<const bf16_t*>(p.ws + OFF_LOGW);
    const bf16_t* GG = reinterpret_cast<const bf16_t*>(p.ws + OFF_GG);
    const bf16_t* P = reinterpret_cast<const bf16_t*>(p.ws + OFF_P);
    const float* BCg = reinterpret_cast<const float*>(p.ws + OFF_BCB);
    const int row = tid >> 3, ch = tid & 7;
    in.pr = *reinterpret_cast<const uint4*>(PRg + (tok0 + row) * 512 + h * 64 + ch * 8);
    in.s0 = reinterpret_cast<const uint4*>(s0_ptr(p.ws, u))[tid];
#pragma unroll
    for (int nn = 0; nn < 2; ++nn) in.yq[nn] = *reinterpret_cast<const uint2*>(YQg + (tok0 + (nt0 + nn) * 16 + fr) * 512 + h * 64 + mt * 16 + fq * 4);
    const int c = h * 64 + lane;
    const int s0i = n * 64 + wv * 8;
    in.pv = (s0i > 0) ? P[(tok0 + wv * 8 - 1) * 2304 + 1024 + c] : (unsigned short)0;
#pragma unroll
    for (int i = 0; i < 8; ++i) {
        in.v[i] = P[(tok0 + wv * 8 + i) * 2304 + 1024 + c];
        in.g[i] = GG[(tok0 + wv * 8 + i) * 512 + c];
        in.bc[i] = BCg[(size_t)u * 64 + wv * 8 + i];
    }
}
__device__ __forceinline__ void phase_rwkv_r3(const Params& p, unsigned char* smem) {
    const int tidx = otid(p.wave);
    const int tid = tidx, wv = tid >> 6, lane = tid & 63, fr = lane & 15, fq = lane >> 4, mt = wv >> 1, nt0 = (wv & 1) * 2;
    bf16_t* base = reinterpret_cast<bf16_t*>(smem);
    bf16_t* Prs = base; bf16_t* Sb = base + RC_BUF;
    float* Yf = reinterpret_cast<float*>(smem + 2 * RC_BYTES);
    bf16_t* YC = reinterpret_cast<bf16_t*>(p.ws + OFF_YCAT);
    R3In cur, nxt;
    if (obid() < 4096) r3_load(cur, p, obid(), tid);
    nxt = cur;
    for (int u = obid(); u < 4096; u += ogdim()) {
        const int b = u >> 10, h = (u >> 7) & 7, n = u & 127;
        const int c = h * 64 + lane;
        float mu_v = p.in[2][1024 + c], lng = p.in[11][c], lnb = p.in[12][c];
        asm volatile("" : "+v"(mu_v), "+v"(lng), "+v"(lnb));
        if (u + ogdim() < 4096) r3_load(nxt, p, u + ogdim(), tid);
        {
            const int row = tid >> 3, ch = tid & 7;
            *reinterpret_cast<uint4*>(Prs + row * RC_LD + ch * 8) = cur.pr;
            const int I = ch >> 2, hh = (ch >> 1) & 1, g0 = (ch & 1) * 2;
            const int k0 = I * 32 + 8 * g0 + 4 * hh;
            uint2 lo; lo.x = cur.s0.x; lo.y = cur.s0.y;
            uint2 hi; hi.x = cur.s0.z; hi.y = cur.s0.w;
            *reinterpret_cast<uint2*>(Sb + row * RC_LD + k0) = lo;
            *reinterpret_cast<uint2*>(Sb + row * RC_LD + k0 + 8) = hi;
        }
        lds_barrier();
        {
            f32x4 acc[2];
            zero_acc(acc);
            mm64(acc, Sb, Prs, mt, nt0, fr, fq);
#pragma unroll
            for (int nn = 0; nn < 2; ++nn) {
                const int C = (nt0 + nn) * 16 + fr, Rb = mt * 16 + fq * 4;
                const uint2 q = cur.yq[nn];
                float4 o;
                o.x = acc[nn][0] + __uint_as_float(q.x << 16); o.y = acc[nn][1] + __uint_as_float(q.x & 0xffff0000u);
                o.z = acc[nn][2] + __uint_as_float(q.y << 16); o.w = acc[nn][3] + __uint_as_float(q.y & 0xffff0000u);
                *reinterpret_cast<float4*>(Yf + C * 68 + Rb) = o;
            }
        }
        lds_barrier();
        {
            float pv = bf2f(cur.pv);
#pragma unroll
            for (int i = 0; i < 8; ++i) {
                const int t = wv * 8 + i;
                const size_t tok = (size_t)b * SEQ + n * 64 + t;
                const float y = Yf[t * 68 + lane];
                const float mean = wave_sum(y) * (1.0f / 64.0f);
                const float d = y - mean;
                const float var = wave_sum(d * d) * (1.0f / 64.0f);
                const float yn = d * rsqrtf(var + 64e-5f) * lng + lnb;
                const float g = bf2f(cur.g[i]);
                const float v0 = bf2f(cur.v[i]);
                const float vv = bf2f(f2bf(v0 + mu_v * (pv - v0)));
                pv = v0;
                YC[tok * 1024 + c] = f2bf((yn + cur.bc[i] * vv) * g);
            }
        }
        cur = nxt;
    }
}

#define LR_LD 1032
__device__ __forceinline__ void phase_ln_route(const Params& p, int layer, unsigned char* smem) {
    const bf16_t* X = reinterpret_cast<const bf16_t*>(p.ws + OFF_P);
    const int tidx = otid(p.wave);
    const int tid = tidx, wv = tid >> 6, lane = tid & 63, fr = lane & 15, fq = lane >> 4;
    const float* g = p.in[24] + layer * DM;
    const float* bb = p.in[25] + layer * DM;
    const float* rgb = p.in[27] + layer * 4;
    const float* reb = p.in[29] + layer * 32;
    const bf16_t* RH = reinterpret_cast<const bf16_t*>(p.ws + OFF_W) + WE_RT_HI + (size_t)layer * 48 * 1024;
    const bf16_t* RL = reinterpret_cast<const bf16_t*>(p.ws + OFF_W) + WE_RT_LO + (size_t)layer * 48 * 1024;
    bf16_t* XB = reinterpret_cast<bf16_t*>(p.ws + OFF_ACTB);
    int* cnt = reinterpret_cast<int*>(p.ws + OFF_CTRL) + layer * 32;
    int* ltok = reinterpret_cast<int*>(p.ws + OFF_LTOK);
    float* lgate = reinterpret_cast<float*>(p.ws + OFF_LGATE);
    bf16_t* sXH = reinterpret_cast<bf16_t*>(smem);
    bf16_t* sXL = sXH + 16 * LR_LD;
    float* sRed = reinterpret_cast<float*>(smem + 2 * 16 * LR_LD * 2);
    float* sLog = sRed + 8 * 16 * 48;
    bf16x8 bh[4][3], bl[4][3];
#pragma unroll
    for (int ks = 0; ks < 4; ++ks)
#pragma unroll
        for (int nt = 0; nt < 3; ++nt) {
            const int k0 = wv * 128 + ks * 32 + fq * 8;
            bh[ks][nt] = *reinterpret_cast<const bf16x8*>(RH + (size_t)(nt * 16 + fr) * 1024 + k0);
            bl[ks][nt] = *reinterpret_cast<const bf16x8*>(RL + (size_t)(nt * 16 + fr) * 1024 + k0);
        }
    float4 gg[4], bv[4];
#pragma unroll
    for (int i = 0; i < 4; ++i) {
        gg[i] = *reinterpret_cast<const float4*>(g + i * 256 + lane * 4);
        bv[i] = *reinterpret_cast<const float4*>(bb + i * 256 + lane * 4);
    }
    int* sCnt = reinterpret_cast<int*>(sLog + 16 * 48);
    int* sBase = sCnt + 32;
    int* sDecE = sBase + 32;
    int* sDecP = sDecE + 256;
    float* sDecG = reinterpret_cast<float*>(sDecP + 256);
    int* sDecR = reinterpret_cast<int*>(sDecG + 256);
    if (tid < 32) sCnt[tid] = 0;
    uint2 pre[2][4];
    {
        const int tile0 = obid();
        if (tile0 < NT / 16) {
#pragma unroll
            for (int rr = 0; rr < 2; ++rr)
#pragma unroll
                for (int i = 0; i < 4; ++i)
                    pre[rr][i] = *reinterpret_cast<const uint2*>(X + (size_t)(tile0 * 16 + wv * 2 + rr) * DM + i * 256 + lane * 4);
        }
    }
    __syncthreads();
    int nloc = 0;
    for (int tile = obid(); tile < NT / 16; tile += ogdim(), ++nloc) {
        uint2 cur[2][4];
#pragma unroll
        for (int rr = 0; rr < 2; ++rr)
#pragma unroll
            for (int i = 0; i < 4; ++i) cur[rr][i] = pre[rr][i];
        {
            const int tn = tile + ogdim();
            if (tn < NT / 16) {
#pragma unroll
                for (int rr = 0; rr < 2; ++rr)
#pragma unroll
                    for (int i = 0; i < 4; ++i)
                        pre[rr][i] = *reinterpret_cast<const uint2*>(X + (size_t)(tn * 16 + wv * 2 + rr) * DM + i * 256 + lane * 4);
            }
        }
#pragma unroll
        for (int rr = 0; rr < 2; ++rr) {
            const int rl = wv * 2 + rr;
            const int row = tile * 16 + rl;
            float v[16];
#pragma unroll
            for (int i = 0; i < 4; ++i) {
                const uint2 t = cur[rr][i];
                v[4 * i] = __uint_as_float(t.x << 16); v[4 * i + 1] = __uint_as_float(t.x & 0xffff0000u);
                v[4 * i + 2] = __uint_as_float(t.y << 16); v[4 * i + 3] = __uint_as_float(t.y & 0xffff0000u);
            }
            float sum = 0.f;
#pragma unroll
            for (int i = 0; i < 16; ++i) sum += v[i];
            const float mean = wave_sum(sum) * (1.0f / DM);
            float sq = 0.f;
#pragma unroll
            for (int i = 0; i < 16; ++i) { float d = v[i] - mean; sq += d * d; }
            const float rstd = rsqrtf(wave_sum(sq) * (1.0f / DM) + 1e-5f);
#pragma unroll
            for (int i = 0; i < 4; ++i) {
                const int col = i * 256 + lane * 4;
                const float o0 = (v[4 * i] - mean) * rstd * gg[i].x + bv[i].x;
                const float o1 = (v[4 * i + 1] - mean) * rstd * gg[i].y + bv[i].y;
                const float o2 = (v[4 * i + 2] - mean) * rstd * gg[i].z + bv[i].z;
                const float o3 = (v[4 * i + 3] - mean) * rstd * gg[i].w + bv[i].w;
                const bf16_t h0 = f2bf(o0), h1 = f2bf(o1), h2 = f2bf(o2), h3 = f2bf(o3);
                uint2 wh; wh.x = (unsigned)h0 | ((unsigned)h1 << 16); wh.y = (unsigned)h2 | ((unsigned)h3 << 16);
                *reinterpret_cast<uint2*>(XB + (size_t)row * DM + col) = wh;
                *reinterpret_cast<uint2*>(sXH + rl * LR_LD + col) = wh;
                uint2 wl; wl.x = pack2(o0 - bf2f(h0), o1 - bf2f(h1)); wl.y = pack2(o2 - bf2f(h2), o3 - bf2f(h3));
                *reinterpret_cast<uint2*>(sXL + rl * LR_LD + col) = wl;
            }
        }
        lds_barrier();
        {
            f32x4 acc[3];
#pragma unroll
            for (int nt = 0; nt < 3; ++nt) acc[nt] = (f32x4){0.f, 0.f, 0.f, 0.f};
#pragma unroll
            for (int ks = 0; ks < 4; ++ks) {
                const int k0 = wv * 128 + ks * 32 + fq * 8;
                const bf16x8 ah = *reinterpret_cast<const bf16x8*>(sXH + fr * LR_LD + k0);
                const bf16x8 al = *reinterpret_cast<const bf16x8*>(sXL + fr * LR_LD + k0);
#pragma unroll
                for (int nt = 0; nt < 3; ++nt) {
                    acc[nt] = __builtin_amdgcn_mfma_f32_16x16x32_bf16(ah, bh[ks][nt], acc[nt], 0, 0, 0);
                    acc[nt] = __builtin_amdgcn_mfma_f32_16x16x32_bf16(al, bh[ks][nt], acc[nt], 0, 0, 0);
                    acc[nt] = __builtin_amdgcn_mfma_f32_16x16x32_bf16(ah, bl[ks][nt], acc[nt], 0, 0, 0);
                }
            }
#pragma unroll
            for (int nt = 0; nt < 3; ++nt)
#pragma unroll
                for (int j = 0; j < 4; ++j) sRed[(wv * 16 + fq * 4 + j) * 48 + nt * 16 + fr] = acc[nt][j];
        }
        lds_barrier();
        for (int idx = tid; idx < 16 * 48; idx += NTHREADS) {
            float s = 0.f;
#pragma unroll
            for (int w = 0; w < 8; ++w) s += sRed[w * 16 * 48 + idx];
            sLog[idx] = s;
        }
        lds_barrier();
        if (tid < 16) {
            const int row = tile * 16 + tid;
            const float* lg = sLog + tid * 48;
            float gl[4];
#pragma unroll
            for (int j = 0; j < 4; ++j) gl[j] = lg[j] + rgb[j];
            int gi = 0; float gm = gl[0];
#pragma unroll
            for (int j = 1; j < 4; ++j) if (gl[j] > gm) { gm = gl[j]; gi = j; }
            float gs = 0.f;
#pragma unroll
            for (int j = 0; j < 4; ++j) gs += __expf(gl[j] - gm);
            const float gw = 1.0f / gs;
            float el[8];
#pragma unroll
            for (int j = 0; j < 8; ++j) el[j] = lg[4 + gi * 8 + j] + reb[gi * 8 + j];
            int i1 = 0; float m1 = el[0];
#pragma unroll
            for (int j = 1; j < 8; ++j) if (el[j] > m1) { m1 = el[j]; i1 = j; }
            int i2 = (i1 == 0) ? 1 : 0; float m2 = el[i2];
#pragma unroll
            for (int j = 0; j < 8; ++j) if (j != i1 && el[j] > m2) { m2 = el[j]; i2 = j; }
            const float e2 = __expf(m2 - m1);
            const float p1 = 1.0f / (1.0f + e2), p2 = e2 / (1.0f + e2);
            const int ex1 = gi * 8 + i1, ex2 = gi * 8 + i2;
            const int d0 = (nloc * 16 + tid) * 2;
            sDecE[d0] = ex1; sDecP[d0] = atomicAdd(&sCnt[ex1], 1); sDecG[d0] = gw * p1; sDecR[d0] = row * 2;
            sDecE[d0 + 1] = ex2; sDecP[d0 + 1] = atomicAdd(&sCnt[ex2], 1); sDecG[d0 + 1] = gw * p2; sDecR[d0 + 1] = row * 2 + 1;
        }
    }
    __syncthreads();
    if (tid < 32) sBase[tid] = atomicAdd(&cnt[tid], sCnt[tid]);
    __syncthreads();
    if (tid < nloc * 32) {
        const int ex = sDecE[tid];
        const size_t pos = (size_t)ex * NT + sBase[ex] + sDecP[tid];
        ltok[pos] = sDecR[tid];
        lgate[pos] = sDecG[tid];
    }
    __syncthreads();
}

__device__ __forceinline__ void phase_exp1(const Params& p, int layer, bf16_t* smem) {
    const int* cnt = reinterpret_cast<const int*>(p.ws + OFF_CTRL) + layer * 32;
    const int* ltok = reinterpret_cast<const int*>(p.ws + OFF_LTOK);
    const bf16_t* XB = reinterpret_cast<const bf16_t*>(p.ws + OFF_ACTB);
    const bf16_t* W13 = reinterpret_cast<const bf16_t*>(p.ws + OFF_W) + WE_W13 + (size_t)layer * 32 * 262144;
    bf16_t* H = reinterpret_cast<bf16_t*>(p.ws + OFF_HBUF);
    int t = obid();
    int base = 0, tbase = 0;
    for (int e = 0; e < 32; ++e) {
        int c = cnt[e];
        int nt = ((c + 255) >> 8) * 2;
        while (t < tbase + nt) {
            int w = t - tbase;
            EpiExp1 epi{H, base, c};
            gemm_tile<true>(XB, DM, ltok + (size_t)e * NT, c, W13 + (size_t)e * 262144, DM, DM, (w >> 1) * 256, (w & 1) * 128, epi, smem, p.wave);
            t += ogdim();
        }
        tbase += nt; base += c;
    }
}
__device__ __forceinline__ void phase_exp2(const Params& p, int layer, bf16_t* smem) {
    const int* cnt = reinterpret_cast<const int*>(p.ws + OFF_CTRL) + layer * 32;
    const int* ltok = reinterpret_cast<const int*>(p.ws + OFF_LTOK);
    const float* lgate = reinterpret_cast<const float*>(p.ws + OFF_LGATE);
    const bf16_t* W2 = reinterpret_cast<const bf16_t*>(p.ws + OFF_W) + WE_W2 + (size_t)layer * 32 * 131072;
    const bf16_t* H = reinterpret_cast<const bf16_t*>(p.ws + OFF_HBUF);
    bf16_t* FS = reinterpret_cast<bf16_t*>(p.ws + OFF_FS);
    int t = obid();
    int base = 0, tbase = 0;
    for (int e = 0; e < 32; ++e) {
        int c = cnt[e];
        int nt = ((c + 255) >> 8) * 8;
        while (t < tbase + nt) {
            int w = t - tbase;
            EpiExp2 epi;
            epi.FS = FS; epi.cnt = c;
            {
                const int tq = otid(p.wave), wq = tq >> 6, lq = tq & 63;
#pragma unroll
                for (int m = 0; m < 4; ++m) {
                    int li = (w >> 3) * 256 + (wq >> 1) * 64 + m * 16 + (lq & 15);
                    li = li < c ? li : c - 1;
                    epi.pk[m] = ltok[(size_t)e * NT + li]; epi.g[m] = lgate[(size_t)e * NT + li];
                }
            }
            gemm_tile<false>(H + (size_t)base * 128, 128, nullptr, 0, W2 + (size_t)e * 131072, 128, 128, (w >> 3) * 256, (w & 7) * 128, epi, smem, p.wave);
            t += ogdim();
        }
        tbase += nt; base += c;
    }
}

__device__ __forceinline__ void phase_ln_ffn(const Params& p, int layer, float* Xout, bool last) {
    const int tidx = otid(p.wave);
    const int tid = tidx, wv = tid >> 6, lane = tid & 63;
    const float* g = p.in[33] + layer * DM;
    const float* bb = p.in[34] + layer * DM;
    const bf16_t* FS = reinterpret_cast<const bf16_t*>(p.ws + OFF_FS);
    bf16_t* XB = reinterpret_cast<bf16_t*>(p.ws + OFF_ACTB);
    float4 gg[4], bv[4];
#pragma unroll
    for (int i = 0; i < 4; ++i) {
        gg[i] = *reinterpret_cast<const float4*>(g + i * 256 + lane * 4);
        bv[i] = *reinterpret_cast<const float4*>(bb + i * 256 + lane * 4);
    }
    asm volatile("" : "+v"(gg[0].x), "+v"(bv[3].w));
    const int row0 = obid() * NWAVES + wv, rstep = ogdim() * NWAVES;
    uint2 pt[4], pf0[4], pf1[4];
    if (row0 < NT) {
#pragma unroll
        for (int i = 0; i < 4; ++i) {
            const int col = i * 256 + lane * 4;
            pt[i] = *reinterpret_cast<const uint2*>(XB + (size_t)row0 * DM + col);
            pf0[i] = *reinterpret_cast<const uint2*>(FS + (size_t)row0 * DM + col);
            pf1[i] = *reinterpret_cast<const uint2*>(FS + ((size_t)NT + row0) * DM + col);
        }
    }
    for (int row = row0; row < NT; row += rstep) {
        uint2 t[4], f0[4], f1[4];
#pragma unroll
        for (int i = 0; i < 4; ++i) { t[i] = pt[i]; f0[i] = pf0[i]; f1[i] = pf1[i]; }
        if (row + rstep < NT) {
            const size_t rn = (size_t)(row + rstep);
#pragma unroll
            for (int i = 0; i < 4; ++i) {
                const int col = i * 256 + lane * 4;
                pt[i] = *reinterpret_cast<const uint2*>(XB + rn * DM + col);
                pf0[i] = *reinterpret_cast<const uint2*>(FS + rn * DM + col);
                pf1[i] = *reinterpret_cast<const uint2*>(FS + ((size_t)NT + rn) * DM + col);
            }
        }
        float v[16];
#pragma unroll
        for (int i = 0; i < 4; ++i) {
            v[4 * i] = ALPHA_F * __uint_as_float(t[i].x << 16) + __uint_as_float(f0[i].x << 16) + __uint_as_float(f1[i].x << 16);
            v[4 * i + 1] = ALPHA_F * __uint_as_float(t[i].x & 0xffff0000u) + __uint_as_float(f0[i].x & 0xffff0000u) + __uint_as_float(f1[i].x & 0xffff0000u);
            v[4 * i + 2] = ALPHA_F * __uint_as_float(t[i].y << 16) + __uint_as_float(f0[i].y << 16) + __uint_as_float(f1[i].y << 16);
            v[4 * i + 3] = ALPHA_F * __uint_as_float(t[i].y & 0xffff0000u) + __uint_as_float(f0[i].y & 0xffff0000u) + __uint_as_float(f1[i].y & 0xffff0000u);
        }
        float sum = 0.f;
#pragma unroll
        for (int i = 0; i < 16; ++i) sum += v[i];
        float mean = wave_sum(sum) * (1.0f / DM);
        float sq = 0.f;
#pragma unroll
        for (int i = 0; i < 16; ++i) { float d = v[i] - mean; sq += d * d; }
        float rstd = rsqrtf(wave_sum(sq) * (1.0f / DM) + 1e-5f);
#pragma unroll
        for (int i = 0; i < 4; ++i) {
            int col = i * 256 + lane * 4;
            float o0 = (v[4 * i] - mean) * rstd * gg[i].x + bv[i].x;
            float o1 = (v[4 * i + 1] - mean) * rstd * gg[i].y + bv[i].y;
            float o2 = (v[4 * i + 2] - mean) * rstd * gg[i].z + bv[i].z;
            float o3 = (v[4 * i + 3] - mean) * rstd * gg[i].w + bv[i].w;
            if (last) {
                *reinterpret_cast<float4*>(Xout + (size_t)row * DM + col) = make_float4(o0, o1, o2, o3);
            } else {
                uint2 w; w.x = pack2(o0, o1); w.y = pack2(o2, o3);
                *reinterpret_cast<uint2*>(XB + (size_t)row * DM + col) = w;
            }
        }
    }
}

#define CV_T 64
#define CV_ROWS (CV_T + 30)
template <int OB>
__device__ __forceinline__ void conv_blk(float (&acc)[CV_T], const bf16_t* sU, int tid, const float (&w0)[31]) {
#pragma unroll
    for (int rr = 0; rr < 38; ++rr) {
        const float uv = bf2f(sU[(OB * 8 + rr) * 512 + tid]);
#pragma unroll
        for (int oo = 0; oo < 8; ++oo) {
            const int j = rr - oo;
            if (j >= 0 && j <= 30) acc[OB * 8 + oo] += uv * w0[j];
        }
    }
}
__device__ __forceinline__ void phase_l1_conv(const Params& p, unsigned char* smem) {
    const int tidx = otid(p.wave);
    const bf16_t* P = reinterpret_cast<const bf16_t*>(p.ws + OFF_P);
    bf16_t* YC = reinterpret_cast<bf16_t*>(p.ws + OFF_YCAT);
    bf16_t* sU = reinterpret_cast<bf16_t*>(smem);
    float* red = reinterpret_cast<float*>(smem + CV_ROWS * 512 * 2);
    float* stat = red + 8 * 64 * 2;
    const int tid = tidx, wv = tid >> 6, lane = tid & 63;
    const float* cw = p.in[17];
    float w0[31];
#pragma unroll
    for (int j = 0; j < 31; ++j) w0[j] = cw[j * 512 + tid];
    const float cb0 = p.in[18][tid], g0 = p.in[19][tid], b0 = p.in[20][tid];
    for (int u = obid(); u < NT / CV_T; u += ogdim()) {
        const int t0 = u * CV_T;
        const int s0 = t0 & (SEQ - 1);
#pragma unroll 1
        for (int base = 0; base < CV_ROWS * 64; base += 6 * NTHREADS) {
            uint4 av[6], gv[6];
#pragma unroll
            for (int j = 0; j < 6; ++j) {
                const int it = base + j * NTHREADS + tid;
                const int r = it >> 6, c8 = (it & 63) * 8;
                av[j] = make_uint4(0u, 0u, 0u, 0u); gv[j] = av[j];
                if (it < CV_ROWS * 64 && s0 - 30 + r >= 0) {
                    const bf16_t* pr = P + (size_t)(t0 - 30 + r) * 3072 + c8;
                    av[j] = *reinterpret_cast<const uint4*>(pr);
                    gv[j] = *reinterpret_cast<const uint4*>(pr + 512);
                }
            }
#pragma unroll
            for (int j = 0; j < 6; ++j) {
                const int it = base + j * NTHREADS + tid;
                if (it < CV_ROWS * 64) {
                    const int r = it >> 6, c8 = (it & 63) * 8;
                    float a[8], gte[8];
                    unpack8(av[j], a); unpack8(gv[j], gte);
#pragma unroll
                    for (int i = 0; i < 8; ++i) a[i] = a[i] * sigmoidf_(gte[i]);
                    uint4 w;
                    w.x = pack2(a[0], a[1]); w.y = pack2(a[2], a[3]); w.z = pack2(a[4], a[5]); w.w = pack2(a[6], a[7]);
                    *reinterpret_cast<uint4*>(sU + r * 512 + c8) = w;
                }
            }
        }
        __syncthreads();
        float acc[CV_T];
#pragma unroll
        for (int o = 0; o < CV_T; ++o) acc[o] = cb0;
        conv_blk<0>(acc, sU, tid, w0); conv_blk<1>(acc, sU, tid, w0); conv_blk<2>(acc, sU, tid, w0); conv_blk<3>(acc, sU, tid, w0);
        conv_blk<4>(acc, sU, tid, w0); conv_blk<5>(acc, sU, tid, w0); conv_blk<6>(acc, sU, tid, w0); conv_blk<7>(acc, sU, tid, w0);
#pragma unroll
        for (int o = 0; o < CV_T; ++o) {
            const float s1 = wave_sum(acc[o]);
            const float s2 = wave_sum(acc[o] * acc[o]);
            if (lane == 0) { red[(wv * 64 + o) * 2] = s1; red[(wv * 64 + o) * 2 + 1] = s2; }
        }
        __syncthreads();
        if (tid < 64) {
            float s1 = 0.f, s2 = 0.f;
#pragma unroll
            for (int w = 0; w < 8; ++w) { s1 += red[(w * 64 + tid) * 2]; s2 += red[(w * 64 + tid) * 2 + 1]; }
            const float mean = s1 * (1.0f / 512.0f);
            const float var = fmaxf(s2 * (1.0f / 512.0f) - mean * mean, 0.f);
            stat[tid * 2] = mean; stat[tid * 2 + 1] = rsqrtf(var + 1e-5f);
        }
        __syncthreads();
#pragma unroll
        for (int o = 0; o < CV_T; ++o) {
            const float mean = stat[o * 2], rstd = stat[o * 2 + 1];
            const float y0 = (acc[o] - mean) * rstd * g0 + b0;
            YC[(size_t)(t0 + o) * 1024 + tid] = f2bf(siluf_(y0));
        }
    }
}

__device__ __forceinline__ float ret_lg(int h) { return log1pf(-exp2f(-5.0f - (float)h)); }

#define KT_LD 136
struct RetIn { uint4 k1, k2, v1, v2; };
__device__ __forceinline__ void ret_load_kv(RetIn& in, const bf16_t* P, int u, int tid) {
    const int n = u & 63, h = (u >> 6) & 7, b = u >> 9;
    const int c = tid >> 2, i0 = (tid & 3) * 8;
    const size_t tok = (size_t)b * SEQ + n * 128 + c;
    const bf16_t* kr = P + tok * 3072 + 1536 + h * 64;
    const bf16_t* vr = P + tok * 3072 + 2048 + h * 64;
    in.k1 = *reinterpret_cast<const uint4*>(kr + i0); in.k2 = *reinterpret_cast<const uint4*>(kr + 32 + i0);
    in.v1 = *reinterpret_cast<const uint4*>(vr + i0); in.v2 = *reinterpret_cast<const uint4*>(vr + 32 + i0);
}
__device__ __forceinline__ void st_col8(bf16_t* dst, int ld, const uint4 v) {
    dst[0 * ld] = (bf16_t)(v.x & 0xffffu); dst[1 * ld] = (bf16_t)(v.x >> 16);
    dst[2 * ld] = (bf16_t)(v.y & 0xffffu); dst[3 * ld] = (bf16_t)(v.y >> 16);
    dst[4 * ld] = (bf16_t)(v.z & 0xffffu); dst[5 * ld] = (bf16_t)(v.z >> 16);
    dst[6 * ld] = (bf16_t)(v.w & 0xffffu); dst[7 * ld] = (bf16_t)(v.w >> 16);
}
__device__ __forceinline__ void phase_ret_kv(const Params& p, unsigned char* smem) {
    const int tidx = otid(p.wave);
    const bf16_t* P = reinterpret_cast<const bf16_t*>(p.ws + OFF_P);
    const float2* rope = reinterpret_cast<const float2*>(p.ws + OFF_ROPE);
    float* KVT = reinterpret_cast<float*>(p.ws + OFF_KVT);
    bf16_t* sKT = reinterpret_cast<bf16_t*>(smem);
    bf16_t* sVT = sKT + 64 * KT_LD;
    const int tid = tidx, wv = tid >> 6, lane = tid & 63, fr = lane & 15, fq = lane >> 4;
    const int et = wv >> 1, dt0 = (wv & 1) * 2;
    RetIn cur, nxt;
    if (obid() < 2048) ret_load_kv(cur, P, obid(), tid);
    nxt = cur;
    for (int u = obid(); u < 2048; u += ogdim()) {
        const int n = u & 63, h = (u >> 6) & 7;
        const float lg = ret_lg(h);
        const int c = tid >> 2, i0 = (tid & 3) * 8;
        const int sidx = n * 128 + c;
        float2 cs[8];
#pragma unroll
        for (int i = 0; i < 8; ++i) cs[i] = rope[sidx * 32 + i0 + i];
        asm volatile("" : "+v"(cs[0].x), "+v"(cs[7].y));
        if (u + ogdim() < 2048) ret_load_kv(nxt, P, u + ogdim(), tid);
        {
            const float zeta = __expf((float)(127 - c) * lg) * 0.125f;
            float k1[8], k2[8];
            unpack8(cur.k1, k1); unpack8(cur.k2, k2);
#pragma unroll
            for (int i = 0; i < 8; ++i) {
                float o1 = (k1[i] * cs[i].x - k2[i] * cs[i].y) * zeta, o2 = (k1[i] * cs[i].y + k2[i] * cs[i].x) * zeta;
                sKT[(i0 + i) * KT_LD + c] = f2bf(o1);
                sKT[(32 + i0 + i) * KT_LD + c] = f2bf(o2);
            }
            st_col8(sVT + i0 * KT_LD + c, KT_LD, cur.v1);
            st_col8(sVT + (32 + i0) * KT_LD + c, KT_LD, cur.v2);
        }
        lds_barrier();
        f32x4 acc[2];
        acc[0] = (f32x4){0.f, 0.f, 0.f, 0.f}; acc[1] = (f32x4){0.f, 0.f, 0.f, 0.f};
#pragma unroll
        for (int ks = 0; ks < 4; ++ks) {
            bf16x8 af = *reinterpret_cast<const bf16x8*>(sVT + (et * 16 + fr) * KT_LD + ks * 32 + fq * 8);
#pragma unroll
            for (int nn = 0; nn < 2; ++nn) {
                bf16x8 bfr = *reinterpret_cast<const bf16x8*>(sKT + ((dt0 + nn) * 16 + fr) * KT_LD + ks * 32 + fq * 8);
                acc[nn] = __builtin_amdgcn_mfma_f32_16x16x32_bf16(af, bfr, acc[nn], 0, 0, 0);
            }
        }
        float* o = KVT + (size_t)u * 4096;
#pragma unroll
        for (int nn = 0; nn < 2; ++nn)
#pragma unroll
            for (int j = 0; j < 4; ++j) o[(et * 16 + fq * 4 + j) * 64 + (dt0 + nn) * 16 + fr] = acc[nn][j];
        cur = nxt;
        lds_barrier();
    }
}
__device__ __forceinline__ void phase_ret_scan(const Params& p) {
    const int tidx = otid(p.wave);
    float* KVT = reinterpret_cast<float*>(p.ws + OFF_KVT);
    for (int i = obid() * NTHREADS + tidx; i < 32 * 4096; i += ogdim() * NTHREADS) {
        int bh = i >> 12, ed = i & 4095, h = bh & 7;
        float gc = __expf(128.0f * ret_lg(h));
        float R = 0.f;
        float* q = KVT + (size_t)bh * 64 * 4096 + ed;
#pragma unroll 1
        for (int n0 = 0; n0 < 64; n0 += 16) {
            float kv[16];
#pragma unroll
            for (int j = 0; j < 16; ++j) kv[j] = q[(size_t)(n0 + j) * 4096];
#pragma unroll
            for (int j = 0; j < 16; ++j) { q[(size_t)(n0 + j) * 4096] = R; R = gc * R + kv[j]; }
        }
    }
}
#define Q_LD 72
struct RetOutIn { uint4 q1, q2, k1, k2, v1, v2; float4 r0, r1; unsigned short gr[16]; };
__device__ __forceinline__ void ret_load_out(RetOutIn& in, const bf16_t* P, const float* KVT, int u, int tid) {
    const int n = u & 63, h = (u >> 6) & 7, b = u >> 9;
    const int c = tid >> 2, i0 = (tid & 3) * 8;
    const size_t tok = (size_t)b * SEQ + n * 128 + c;
    const bf16_t* qr = P + tok * 3072 + 1024 + h * 64;
    in.q1 = *reinterpret_cast<const uint4*>(qr + i0); in.q2 = *reinterpret_cast<const uint4*>(qr + 32 + i0);
    in.k1 = *reinterpret_cast<const uint4*>(qr + 512 + i0); in.k2 = *reinterpret_cast<const uint4*>(qr + 512 + 32 + i0);
    in.v1 = *reinterpret_cast<const uint4*>(qr + 1024 + i0); in.v2 = *reinterpret_cast<const uint4*>(qr + 1024 + 32 + i0);
    const float* rp = KVT + (size_t)u * 4096 + tid * 8;
    in.r0 = *reinterpret_cast<const float4*>(rp); in.r1 = *reinterpret_cast<const float4*>(rp + 4);
    const int wv = tid >> 6, lane = tid & 63, fr = lane & 15, fq = lane >> 4;
#pragma unroll
    for (int j = 0; j < 4; ++j)
#pragma unroll
        for (int nn = 0; nn < 4; ++nn)
            in.gr[j * 4 + nn] = P[((size_t)b * SEQ + n * 128 + wv * 16 + fq * 4 + j) * 3072 + 2560 + h * 64 + nn * 16 + fr];
}
__device__ __forceinline__ void phase_ret_out(const Params& p, unsigned char* smem) {
    const int tidx = otid(p.wave);
    const bf16_t* P = reinterpret_cast<const bf16_t*>(p.ws + OFF_P);
    const float2* rope = reinterpret_cast<const float2*>(p.ws + OFF_ROPE);
    const float* KVT = reinterpret_cast<const float*>(p.ws + OFF_KVT);
    bf16_t* YC = reinterpret_cast<bf16_t*>(p.ws + OFF_YCAT);
    bf16_t* sQ = reinterpret_cast<bf16_t*>(smem);
    bf16_t* sK = sQ + 128 * Q_LD;
    bf16_t* sVT = sK + 128 * Q_LD;
    bf16_t* sRT = sVT + 64 * KT_LD;
    bf16_t* sS = sQ;
    const int tid = tidx, wv = tid >> 6, lane = tid & 63, fr = lane & 15, fq = lane >> 4;
    RetOutIn cur, nxt;
    if (obid() < 2048) ret_load_out(cur, P, KVT, obid(), tid);
    nxt = cur;
    for (int u = obid(); u < 2048; u += ogdim()) {
        const int n = u & 63, h = (u >> 6) & 7, b = u >> 9;
        const float lg = ret_lg(h);
        const int c = tid >> 2, i0 = (tid & 3) * 8;
        const int sidx = n * 128 + c;
        float2 cs[8];
#pragma unroll
        for (int i = 0; i < 8; ++i) cs[i] = rope[sidx * 32 + i0 + i];
        float gng[4], gnb[4];
#pragma unroll
        for (int nn = 0; nn < 4; ++nn) { gng[nn] = p.in[21][h * 64 + nn * 16 + fr]; gnb[nn] = p.in[22][h * 64 + nn * 16 + fr]; }
        asm volatile("" : "+v"(cs[0].x), "+v"(cs[7].y), "+v"(gng[0]), "+v"(gnb[3]));
        if (u + ogdim() < 2048) ret_load_out(nxt, P, KVT, u + ogdim(), tid);
        {
            float qa[8], qb[8], ka[8], kb[8];
            float q1[8], q2[8], k1[8], k2[8];
            unpack8(cur.q1, q1); unpack8(cur.q2, q2); unpack8(cur.k1, k1); unpack8(cur.k2, k2);
#pragma unroll
            for (int i = 0; i < 8; ++i) {
                qa[i] = q1[i] * cs[i].x - q2[i] * cs[i].y; qb[i] = q1[i] * cs[i].y + q2[i] * cs[i].x;
                ka[i] = (k1[i] * cs[i].x - k2[i] * cs[i].y) * 0.125f; kb[i] = (k1[i] * cs[i].y + k2[i] * cs[i].x) * 0.125f;
            }
            st_col8(sVT + i0 * KT_LD + c, KT_LD, cur.v1);
            st_col8(sVT + (32 + i0) * KT_LD + c, KT_LD, cur.v2);
            uint4 w;
            w.x = pack2(qa[0], qa[1]); w.y = pack2(qa[2], qa[3]); w.z = pack2(qa[4], qa[5]); w.w = pack2(qa[6], qa[7]);
            *reinterpret_cast<uint4*>(sQ + c * Q_LD + i0) = w;
            w.x = pack2(qb[0], qb[1]); w.y = pack2(qb[2], qb[3]); w.z = pack2(qb[4], qb[5]); w.w = pack2(qb[6], qb[7]);
            *reinterpret_cast<uint4*>(sQ + c * Q_LD + 32 + i0) = w;
            w.x = pack2(ka[0], ka[1]); w.y = pack2(ka[2], ka[3]); w.z = pack2(ka[4], ka[5]); w.w = pack2(ka[6], ka[7]);
            *reinterpret_cast<uint4*>(sK + c * Q_LD + i0) = w;
            w.x = pack2(kb[0], kb[1]); w.y = pack2(kb[2], kb[3]); w.z = pack2(kb[4], kb[5]); w.w = pack2(kb[6], kb[7]);
            *reinterpret_cast<uint4*>(sK + c * Q_LD + 32 + i0) = w;
            w.x = pack2(cur.r0.x, cur.r0.y); w.y = pack2(cur.r0.z, cur.r0.w); w.z = pack2(cur.r1.x, cur.r1.y); w.w = pack2(cur.r1.z, cur.r1.w);
            *reinterpret_cast<uint4*>(sRT + (tid >> 3) * Q_LD + (tid & 7) * 8) = w;
        }
        lds_barrier();
        f32x4 accs[8], accc[4];
#pragma unroll
        for (int nn = 0; nn < 8; ++nn) accs[nn] = (f32x4){0.f, 0.f, 0.f, 0.f};
#pragma unroll
        for (int nn = 0; nn < 4; ++nn) accc[nn] = (f32x4){0.f, 0.f, 0.f, 0.f};
#pragma unroll
        for (int ks = 0; ks < 2; ++ks) {
            bf16x8 af = *reinterpret_cast<const bf16x8*>(sQ + (wv * 16 + fr) * Q_LD + ks * 32 + fq * 8);
#pragma unroll
            for (int nn = 0; nn < 8; ++nn) {
                bf16x8 bfr = *reinterpret_cast<const bf16x8*>(sK + (nn * 16 + fr) * Q_LD + ks * 32 + fq * 8);
                accs[nn] = __builtin_amdgcn_mfma_f32_16x16x32_bf16(af, bfr, accs[nn], 0, 0, 0);
            }
#pragma unroll
            for (int nn = 0; nn < 4; ++nn) {
                bf16x8 bfr = *reinterpret_cast<const bf16x8*>(sRT + (nn * 16 + fr) * Q_LD + ks * 32 + fq * 8);
                accc[nn] = __builtin_amdgcn_mfma_f32_16x16x32_bf16(af, bfr, accc[nn], 0, 0, 0);
            }
        }
        lds_barrier();
        bf16_t* mS = sS + wv * 16 * KT_LD;
        {
            float e1[4], e1m[4];
#pragma unroll
            for (int j = 0; j < 4; ++j) {
                e1[j] = __expf((float)(fq * 4 + j - fr) * lg);
                e1m[j] = (fq * 4 + j >= fr) ? e1[j] : 0.f;
            }
#pragma unroll
            for (int nn = 0; nn < 8; ++nn) {
                const float e2 = (nn < wv) ? __expf((float)(16 * (wv - nn)) * lg) : 0.f;
                const bool diag = (nn == wv);
                float v[4];
#pragma unroll
                for (int j = 0; j < 4; ++j) v[j] = accs[nn][j] * (diag ? e1m[j] : e2 * e1[j]);
#pragma unroll
                for (int j = 0; j < 4; ++j) mS[(fq * 4 + j) * KT_LD + nn * 16 + fr] = f2bf(v[j]);
            }
        }
        lds_barrier();
        f32x4 acco[4];
#pragma unroll
        for (int nn = 0; nn < 4; ++nn) acco[nn] = (f32x4){0.f, 0.f, 0.f, 0.f};
#pragma unroll
        for (int ks = 0; ks < 4; ++ks) {
            bf16x8 af = *reinterpret_cast<const bf16x8*>(mS + fr * KT_LD + ks * 32 + fq * 8);
#pragma unroll
            for (int nn = 0; nn < 4; ++nn) {
                bf16x8 bfr = *reinterpret_cast<const bf16x8*>(sVT + (nn * 16 + fr) * KT_LD + ks * 32 + fq * 8);
                acco[nn] = __builtin_amdgcn_mfma_f32_16x16x32_bf16(af, bfr, acco[nn], 0, 0, 0);
            }
        }
#pragma unroll
        for (int j = 0; j < 4; ++j) {
            int ig = wv * 16 + fq * 4 + j;
            float xi = __expf((float)(ig + 1) * lg);
            float o[4];
            float sm = 0.f;
#pragma unroll
            for (int nn = 0; nn < 4; ++nn) { o[nn] = acco[nn][j] + xi * accc[nn][j]; sm += o[nn]; }
            sm = row16_sum(sm);
            float mean = sm * (1.0f / 64.0f);
            float sq = 0.f;
#pragma unroll
            for (int nn = 0; nn < 4; ++nn) { float d = o[nn] - mean; sq += d * d; }
            sq = row16_sum(sq);
            float rstd = rsqrtf(sq * (1.0f / 64.0f) + 1e-5f);
            size_t tok = (size_t)b * SEQ + n * 128 + ig;
#pragma unroll
            for (int nn = 0; nn < 4; ++nn) {
                int e = h * 64 + nn * 16 + fr;
                float y = (o[nn] - mean) * rstd * gng[nn] + gnb[nn];
                float gr = bf2f(cur.gr[j * 4 + nn]);
                YC[tok * 1024 + 512 + e] = f2bf(siluf_(gr) * y);
            }
        }
        cur = nxt;
        lds_barrier();
    }
}

#define XB_TMO      128
#define XB_XCNT(j)  (256  + 64 * (j))
#define XB_XSUB(j)  (1280 + 64 * (j))
#define XB_XGEN(j)  (2304 + 64 * (j))
#define XB_TOP      3328
#define XB_TOPGEN   3392
#define XB_SPIN_CAP (1u << 18)

__device__ __forceinline__ unsigned xb_ld(unsigned* p)              { return __hip_atomic_load(p, __ATOMIC_RELAXED, __HIP_MEMORY_SCOPE_AGENT); }
__device__ __forceinline__ unsigned xb_add(unsigned* p, unsigned v) { return __hip_atomic_fetch_add(p, v, __ATOMIC_RELAXED, __HIP_MEMORY_SCOPE_AGENT); }
__device__ __forceinline__ unsigned xb_xcc_id() { return (unsigned)__builtin_amdgcn_s_getreg((3 << 11) | 20) & 0xFu; }
#define XB_SPIN(cond, bar) do { unsigned _sp = 0; while (cond) { __builtin_amdgcn_s_sleep(1); \
    if ((++_sp & 255u) == 0u) { if (xb_ld(&(bar)[XB_TMO])) break; if (_sp > XB_SPIN_CAP) { atomicAdd(&(bar)[XB_TMO], 1u); break; } } } } while (0)

struct XcdBarrier {
    unsigned* bar; unsigned x;
    volatile __attribute__((address_space(3))) unsigned* st;
};

__device__ __forceinline__ XcdBarrier xcd_barrier_post(unsigned* bar, volatile __attribute__((address_space(3))) unsigned* st, int tid) {
    XcdBarrier b; b.bar = bar; b.x = xb_xcc_id(); b.st = st;
    if (tid == 0) (void)xb_add(&bar[XB_XCNT(b.x)], 1u);
    return b;
}
__device__ __forceinline__ void xcd_barrier_complete(unsigned* bar, unsigned x, unsigned& nloc, unsigned& nx) {
    const unsigned G = (unsigned)ogdim();
    unsigned sum, cnt, mine, sp = 0u;
    for (;;) {
        sum = 0u; cnt = 0u; mine = 0u;
#pragma unroll
        for (unsigned j = 0; j < 16; ++j) { const unsigned c = xb_ld(&bar[XB_XCNT(j)]); sum += c; cnt += (c > 0u) ? 1u : 0u; mine = (j == x) ? c : mine; }
        if (sum == G) break;
        __builtin_amdgcn_s_sleep(1);
        if ((++sp & 255u) == 0u) { if (xb_ld(&bar[XB_TMO])) break; if (sp > XB_SPIN_CAP) { atomicAdd(&bar[XB_TMO], 1u); break; } }
    }
    nloc = mine > 0u ? mine : 1u; nx = cnt > 0u ? cnt : 1u;
}

__device__ __forceinline__ void xcd_barrier(const XcdBarrier& b, int tid) {
    asm volatile("s_waitcnt vmcnt(0)" ::: "memory");
    __syncthreads();
    if (tid == 0) {
        unsigned* bar = b.bar;
        __builtin_amdgcn_s_waitcnt(0);
        unsigned nloc = b.st[0], nx = b.st[1];
        if (nloc == 0u) { xcd_barrier_complete(bar, b.x, nloc, nx); b.st[0] = nloc; b.st[1] = nx; }
        const unsigned old = xb_add(&bar[XB_XSUB(b.x)], 1u);
        const unsigned gen = old / nloc;
        if (old + 1u == (gen + 1u) * nloc) {
            __builtin_amdgcn_fence(__ATOMIC_RELEASE, "agent");
            asm volatile("s_waitcnt vmcnt(0)" ::: "memory");
            const unsigned og = xb_add(&bar[XB_TOP], 1u);
            const unsigned tg = og / nx;
            if (og + 1u == (tg + 1u) * nx) xb_add(&bar[XB_TOPGEN], 1u);
            else XB_SPIN(xb_ld(&bar[XB_TOPGEN]) == tg, bar);
            __builtin_amdgcn_fence(__ATOMIC_ACQUIRE, "agent");
            xb_add(&bar[XB_XGEN(b.x)], 1u);
            asm volatile("s_waitcnt vmcnt(0)" ::: "memory");
        } else {
            XB_SPIN(xb_ld(&bar[XB_XGEN(b.x)]) == gen, bar);
            __builtin_amdgcn_fence(__ATOMIC_ACQUIRE, "agent");
            asm volatile("s_waitcnt vmcnt(0)" ::: "memory");
        }
    }
    __syncthreads();
}


#define N_PHASES 22
__device__ __forceinline__ void run_phase(const Params& p, int ph, unsigned char* smem) {
    bf16_t* sm16 = reinterpret_cast<bf16_t*>(smem);
    const bf16_t* W = reinterpret_cast<const bf16_t*>(p.ws + OFF_W);
    bf16_t* ACTB = reinterpret_cast<bf16_t*>(p.ws + OFF_ACTB);
    bf16_t* PB = reinterpret_cast<bf16_t*>(p.ws + OFF_P);
    bf16_t* YC = reinterpret_cast<bf16_t*>(p.ws + OFF_YCAT);
    switch (ph) {
        case 0: phase_pre(p, smem, 0, obid(), ogdim()); break;
        case 1: { PEpiBf16 e{PB, 2304}; big_gemm(ACTB, W + WE_IN0, NT, 2304, DM, e, smem, p.wave); } break;
        case 2: phase_l0_prep(p); break;
        case 3: phase_l0_lora(p, sm16); break;
        case 4: phase_rwkv_r1(p, smem); break;
        case 5: phase_rwkv_r2(p, smem); break;
        case 6: phase_rwkv_r3(p, smem); break;
        case 7: { PEpiOut<false> e{p.in[0], nullptr, PB}; big_gemm(YC, W + WE_OUT0, NT, DM, DM, e, smem, p.wave); } break;
        case 8: phase_ln_route(p, 0, smem); break;
        case 9: phase_exp1(p, 0, sm16); break;
        case 10: phase_exp2(p, 0, sm16); break;
        case 11: phase_ln_ffn(p, 0, p.out, false); break;
        case 12: { PEpiBf16 e{PB, 3072}; big_gemm(ACTB, W + WE_IN1, NT, 3072, DM, e, smem, p.wave); } break;
        case 13: phase_l1_conv(p, smem); break;
        case 14: phase_ret_kv(p, smem); break;
        case 15: phase_ret_scan(p); break;
        case 16: phase_ret_out(p, smem); break;
        case 17: { PEpiOut<true> e{nullptr, ACTB, PB}; big_gemm(YC, W + WE_OUT1, NT, DM, DM, e, smem, p.wave); } break;
        case 18: phase_ln_route(p, 1, smem); break;
        case 19: phase_exp1(p, 1, sm16); break;
        case 20: phase_exp2(p, 1, sm16); break;
        case 21: phase_ln_ffn(p, 1, p.out, true); break;
        default: break;
    }
}

#define SMEM_BYTES 147456
__global__ void __launch_bounds__(NTHREADS) k_mega(Params p) {
    extern __shared__ __attribute__((aligned(16))) unsigned char smem[];
    cg::grid_group grid = cg::this_grid();
    const int wave_s = __builtin_amdgcn_readfirstlane((int)(threadIdx.x >> 6));
    volatile __attribute__((address_space(3))) unsigned* st = (volatile __attribute__((address_space(3))) unsigned*)(smem + 146944);
    {
        const int t0 = otid(wave_s);
        if (t0 < 2) st[t0] = 0u;
    }
    XcdBarrier xb;
#pragma nounroll
    for (int ph = 0; ph < N_PHASES; ++ph) {
        int phv = ph;
        asm volatile("" : "+s"(phv));
        typedef const __attribute__((address_space(4))) Params* KP;
        KP pp = (KP)__builtin_amdgcn_kernarg_segment_ptr();
        asm volatile("" : "+s"(pp));
        Params pl;
        __builtin_memcpy(&pl, (const Params*)pp, sizeof(Params));
        pl.wave = wave_s;
        run_phase(pl, phv, smem);
        if (ph == 0) {
            grid.sync();
            xb = xcd_barrier_post(reinterpret_cast<unsigned*>(pl.ws + OFF_CTRL + 4096), st, otid(wave_s));
        } else if (ph < N_PHASES - 1) {
            xcd_barrier(xb, otid(wave_s));
        }
    }
}

extern "C" void kernel_launch(void* const* d_in, const int* in_sizes, int n_in, void* d_out, int out_size, void* d_ws, size_t ws_size,
                              hipStream_t stream) {
    static int grid_blocks = 0;
    if (!grid_blocks) {
        int dev = 0, cus = 0, per_cu = 0;
        hipGetDevice(&dev);
        hipDeviceGetAttribute(&cus, hipDeviceAttributeMultiprocessorCount, dev);
        hipFuncSetAttribute((const void*)k_mega, hipFuncAttributeMaxDynamicSharedMemorySize, SMEM_BYTES);
        hipOccupancyMaxActiveBlocksPerMultiprocessor(&per_cu, (const void*)k_mega, NTHREADS, SMEM_BYTES);
        if (per_cu < 1) per_cu = 1;
        grid_blocks = cus * per_cu;
    }
    Params p{};
    for (int i = 0; i < 35; ++i) p.in[i] = (const float*)d_in[i];
    p.out = (float*)d_out;
    p.ws = (unsigned char*)d_ws;
    void* args[] = {&p};
    hipError_t e = hipLaunchCooperativeKernel((void*)k_mega, dim3(grid_blocks), dim3(NTHREADS), args, SMEM_BYTES, stream);
    if (e != hipSuccess) fprintf(stderr, "cooperative launch failed: %s (grid %d)\n", hipGetErrorString(e), grid_blocks);
}
```

```cpp
#include <hip/hip_runtime.h>
#include <hip/hip_cooperative_groups.h>
#include <stdint.h>
#include <stdio.h>
namespace cg = cooperative_groups;

typedef unsigned short bf16_t;
typedef short bf16x8 __attribute__((ext_vector_type(8)));
typedef float f32x4 __attribute__((ext_vector_type(4)));

#define NT 32768
#define SEQ 8192
#define DM 1024
#define NTHREADS 512
#define XCD_BAR_WORDS 3456
#define NWAVES 8
#define ALPHA_F 1.41421356237309515f

#define MIB (1024ull * 1024ull)
#define OFF_CTRL 0ull
#define OFF_W (1ull * MIB)
#define OFF_ROPE (65ull * MIB)
#define OFF_ACTB (68ull * MIB)
#define OFF_AA (OFF_ACTB)
#define OFF_GG (OFF_ACTB + 32ull * MIB)
#define OFF_P (132ull * MIB)
#define OFF_LORA (OFF_P + 144ull * MIB)
#define OFF_POOLED (OFF_P + 160ull * MIB)
#define OFF_FS (OFF_P)
#define OFF_HBUF (OFF_P + 128ull * MIB)
#define OFF_YCAT (324ull * MIB)
#define OFF_LOGW (388ull * MIB)
#define OFF_LTOK (452ull * MIB)
#define OFF_LGATE (456ull * MIB)
#define OFF_KVT (460ull * MIB)
#define WE_IN0 0
#define WE_OUT0 2359296
#define WE_IN1 3407872
#define WE_OUT1 6553600
#define WE_W13 7602176
#define WE_W2 24379392
#define WE_LW2 32768000
#define WE_LA2 32800768
#define WE_LG2 32833536
#define WE_POOL 32899072
#define WE_RT_HI 32964608
#define WE_RT_LO 33062912

struct Params {
    const float* in[35];
    float* out;
    unsigned char* ws;
    int wave;
    int pad_;
};

typedef __bf16 hw_bf16x2 __attribute__((ext_vector_type(2)));
typedef float hw_f32x2 __attribute__((ext_vector_type(2)));
__device__ __forceinline__ unsigned pack2(float a, float b) {
    hw_f32x2 v = {a, b};
    hw_bf16x2 r = __builtin_convertvector(v, hw_bf16x2);
    return __builtin_bit_cast(unsigned, r);
}
__device__ __forceinline__ bf16_t f2bf(float f) { return (bf16_t)(pack2(f, 0.f) & 0xffffu); }
__device__ __forceinline__ float bf2f(bf16_t h) { return __uint_as_float(((unsigned)h) << 16); }
__device__ __forceinline__ void unpack8(const uint4 v, float (&o)[8]) {
    o[0] = __uint_as_float(v.x << 16); o[1] = __uint_as_float(v.x & 0xffff0000u);
    o[2] = __uint_as_float(v.y << 16); o[3] = __uint_as_float(v.y & 0xffff0000u);
    o[4] = __uint_as_float(v.z << 16); o[5] = __uint_as_float(v.z & 0xffff0000u);
    o[6] = __uint_as_float(v.w << 16); o[7] = __uint_as_float(v.w & 0xffff0000u);
}
#define DPP_ADD(v, CTRL) ((v) + __int_as_float(__builtin_amdgcn_update_dpp(0, __float_as_int(v), (CTRL), 0xF, 0xF, false)))
__device__ __forceinline__ float row16_sum(float v) {
    v = DPP_ADD(v, 0xB1);
    v = DPP_ADD(v, 0x4E);
    v = DPP_ADD(v, 0x141);
    v = DPP_ADD(v, 0x140);
    return v;
}
__device__ __forceinline__ float wave_sum(float v) {
    v = row16_sum(v);
    const int iv = __float_as_int(v);
    const float s0 = __int_as_float(__builtin_amdgcn_readlane(iv, 0)), s1 = __int_as_float(__builtin_amdgcn_readlane(iv, 16));
    const float s2 = __int_as_float(__builtin_amdgcn_readlane(iv, 32)), s3 = __int_as_float(__builtin_amdgcn_readlane(iv, 48));
    return (s0 + s1) + (s2 + s3);
}
__device__ __forceinline__ float sigmoidf_(float x) { return 1.0f / (1.0f + __expf(-x)); }
__device__ __forceinline__ float siluf_(float x) { return x / (1.0f + __expf(-x)); }
__device__ __forceinline__ float quad_sum(float v) {
    int iv = __float_as_int(v);
    float a = __int_as_float(__builtin_amdgcn_update_dpp(0, iv, 0xB1, 0xF, 0xF, false));
    v += a;
    iv = __float_as_int(v);
    float b = __int_as_float(__builtin_amdgcn_update_dpp(0, iv, 0x4E, 0xF, 0xF, false));
    return v + b;
}

__device__ __forceinline__ void lds_barrier() {
    asm volatile("s_waitcnt lgkmcnt(0)" ::: "memory");
    __builtin_amdgcn_s_barrier();
    asm volatile("" ::: "memory");
}
__device__ __forceinline__ int obid() { int b = (int)blockIdx.x; asm volatile("" : "+s"(b)); return b; }
__device__ __forceinline__ int ogdim() { int b = (int)gridDim.x; asm volatile("" : "+s"(b)); return b; }
__device__ __forceinline__ int otid(int wave) { int t = wave * 64 + (int)__builtin_amdgcn_mbcnt_hi(~0u, __builtin_amdgcn_mbcnt_lo(~0u, 0u)); asm volatile("" : "+v"(t)); return t; }
template <bool GATHER, class Epi>
__device__ __forceinline__ void gemm_tile(const bf16_t* __restrict__ A, int lda, const int* __restrict__ gidx, int gcount,
                                          const bf16_t* __restrict__ Bt, int ldb, int K, int row0, int col0, const Epi& epi,
                                          bf16_t* smem, int wave) {
    const int tidx = otid(wave);
    const int tid = tidx, wid = tid >> 6, lane = tid & 63, wr = wid >> 1, wc = wid & 1, fr = lane & 15, fq = lane >> 4;
    unsigned char* sm = reinterpret_cast<unsigned char*>(smem);
    const bf16_t* ap[4];
    const bf16_t* bp[2];
#pragma unroll
    for (int i = 0; i < 4; ++i) {
        const int pch = tid + i * 512;
        const int r = pch >> 3, c = (pch & 7) ^ (r & 7);
        int ar = row0 + r;
        if (GATHER) {
            int gi = ar < gcount ? ar : gcount - 1;
            ar = gidx[gi] >> 1;
        }
        ap[i] = A + (size_t)ar * lda + c * 8;
    }
#pragma unroll
    for (int i = 0; i < 2; ++i) {
        const int pch = tid + i * 512;
        const int r = pch >> 3, c = (pch & 7) ^ (r & 7);
        bp[i] = Bt + (size_t)(col0 + r) * ldb + c * 8;
    }
    f32x4 acc[4][4];
#pragma unroll
    for (int m = 0; m < 4; ++m)
#pragma unroll
        for (int n = 0; n < 4; ++n) acc[m][n] = (f32x4){0.f, 0.f, 0.f, 0.f};
    const int nk = K >> 6;
#define GT_STAGE(kt, buf) do { _Pragma("unroll") for (int i_ = 0; i_ < 4; ++i_) \
        __builtin_amdgcn_global_load_lds((const unsigned*)(ap[i_] + (kt) * 64), (__attribute__((address_space(3))) unsigned*)(sm + (buf) * 49152 + (tid + i_ * 512) * 16), 16, 0, 0); \
        _Pragma("unroll") for (int i_ = 0; i_ < 2; ++i_) \
        __builtin_amdgcn_global_load_lds((const unsigned*)(bp[i_] + (kt) * 64), (__attribute__((address_space(3))) unsigned*)(sm + (buf) * 49152 + 32768 + (tid + i_ * 512) * 16), 16, 0, 0); } while (0)
    GT_STAGE(0, 0);
    for (int kt = 0; kt < nk; ++kt) {
        const int buf = kt & 1;
        if (kt + 1 < nk) {
            GT_STAGE(kt + 1, buf ^ 1);
            asm volatile("s_waitcnt vmcnt(6)" ::: "memory");
        } else {
            asm volatile("s_waitcnt vmcnt(0)" ::: "memory");
        }
        __builtin_amdgcn_s_barrier();
        asm volatile("" ::: "memory");
        const unsigned char* SA = sm + buf * 49152;
        const unsigned char* SB = SA + 32768;
#pragma unroll
        for (int ks = 0; ks < 2; ++ks) {
            bf16x8 af[4], bfr[4];
            const int cs = ((ks * 4 + fq) ^ (fr & 7)) * 16;
#pragma unroll
            for (int m = 0; m < 4; ++m) af[m] = *reinterpret_cast<const bf16x8*>(SA + (wr * 64 + m * 16 + fr) * 128 + cs);
#pragma unroll
            for (int n = 0; n < 4; ++n) bfr[n] = *reinterpret_cast<const bf16x8*>(SB + (wc * 64 + n * 16 + fr) * 128 + cs);
#pragma unroll
            for (int m = 0; m < 4; ++m)
#pragma unroll
                for (int n = 0; n < 4; ++n) acc[m][n] = __builtin_amdgcn_mfma_f32_16x16x32_bf16(bfr[n], af[m], acc[m][n], 0, 0, 0);
        }
        asm volatile("s_waitcnt lgkmcnt(0)" ::: "memory");
        __builtin_amdgcn_s_barrier();
        asm volatile("" ::: "memory");
    }
#undef GT_STAGE
    epi(acc, row0 + wr * 64, col0 + wc * 64, fr, fq);
}

struct EpiStoreBf16 {
    bf16_t* O; int ldo;
    __device__ __forceinline__ void operator()(f32x4 (&acc)[4][4], int rb, int cb, int fr, int fq) const {
#pragma unroll
        for (int m = 0; m < 4; ++m)
#pragma unroll
            for (int n = 0; n < 4; ++n) {
                int row = rb + m * 16 + fr, col = cb + n * 16 + fq * 4;
                uint2 w; w.x = pack2(acc[m][n][0], acc[m][n][1]); w.y = pack2(acc[m][n][2], acc[m][n][3]);
                *reinterpret_cast<uint2*>(O + (size_t)row * ldo + col) = w;
            }
    }
};
template <int MODE>
struct EpiLora {
    float* Of; bf16_t* Ob; const float* vec; int ldo; int coff;
    __device__ __forceinline__ void operator()(f32x4 (&acc)[4][4], int rb, int cb, int fr, int fq) const {
        float4 pv[4];
#pragma unroll
        for (int n = 0; n < 4; ++n) {
            pv[n] = make_float4(0.f, 0.f, 0.f, 0.f);
            if (MODE == 0 || MODE == 1) pv[n] = *reinterpret_cast<const float4*>(vec + cb + n * 16 + fq * 4);
            else if (MODE == 3) pv[n] = *reinterpret_cast<const float4*>(vec + coff + cb + n * 16 + fq * 4);
        }
#pragma unroll
        for (int m = 0; m < 4; ++m)
#pragma unroll
            for (int n = 0; n < 4; ++n) {
                int row = rb + m * 16 + fr, col = cb + n * 16 + fq * 4;
                const float pvv[4] = {pv[n].x, pv[n].y, pv[n].z, pv[n].w};
                float v[4];
#pragma unroll
                for (int j = 0; j < 4; ++j) {
                    float a = acc[m][n][j];
                    if (MODE == 0) {
                        const float t = -(pvv[j] + a);
                        const float sp = (t > 15.f) ? t : __logf(1.0f + __expf(t));
                        v[j] = -__expf(-sp - 0.5f);
                    } else if (MODE == 1) {
                        v[j] = sigmoidf_(pvv[j] + a);
                    } else if (MODE == 2) {
                        v[j] = a;
                    } else {
                        v[j] = a * pvv[j];
                    }
                }
                uint2 w; w.x = pack2(v[0], v[1]); w.y = pack2(v[2], v[3]);
                *reinterpret_cast<uint2*>(Ob + (size_t)row * ldo + coff + col) = w;
            }
    }
};
struct EpiOut {
    const float* Xprev; float* X;
    __device__ __forceinline__ void operator()(f32x4 (&acc)[4][4], int rb, int cb, int fr, int fq) const {
#pragma unroll
        for (int m = 0; m < 4; ++m)
#pragma unroll
            for (int n = 0; n < 4; ++n) {
                int row = rb + m * 16 + fr, col = cb + n * 16 + fq * 4;
                float4 xp = *reinterpret_cast<const float4*>(Xprev + (size_t)row * DM + col);
                float4 o;
                o.x = ALPHA_F * xp.x + acc[m][n][0]; o.y = ALPHA_F * xp.y + acc[m][n][1];
                o.z = ALPHA_F * xp.z + acc[m][n][2]; o.w = ALPHA_F * xp.w + acc[m][n][3];
                *reinterpret_cast<float4*>(X + (size_t)row * DM + col) = o;
            }
    }
};
struct EpiExp1 {
    bf16_t* H; int base; int cnt;
    __device__ __forceinline__ void operator()(f32x4 (&acc)[4][4], int rb, int cb, int fr, int fq) const {
#pragma unroll
        for (int m = 0; m < 4; ++m) {
            int li = rb + m * 16 + fr;
            if (li < cnt) {
#pragma unroll
                for (int i = 0; i < 2; ++i) {
                    int hcol = (cb >> 1) + i * 16 + fq * 4;
                    float v[4];
#pragma unroll
                    for (int j = 0; j < 4; ++j) v[j] = siluf_(acc[m][2 * i][j]) * acc[m][2 * i + 1][j];
                    uint2 w; w.x = pack2(v[0], v[1]); w.y = pack2(v[2], v[3]);
                    *reinterpret_cast<uint2*>(H + (size_t)(base + li) * 128 + hcol) = w;
                }
            }
        }
    }
};
struct EpiExp2 {
    bf16_t* FS; int pk[4]; float g[4]; int cnt;
    __device__ __forceinline__ void operator()(f32x4 (&acc)[4][4], int rb, int cb, int fr, int fq) const {
#pragma unroll
        for (int m = 0; m < 4; ++m) {
            int li = rb + m * 16 + fr;
            if (li < cnt) {
                const float gg = g[m];
                int tok = pk[m] >> 1, j = pk[m] & 1;
                bf16_t* o = FS + ((size_t)j * NT + tok) * DM;
#pragma unroll
                for (int n = 0; n < 4; ++n) {
                    int col = cb + n * 16 + fq * 4;
                    uint2 w; w.x = pack2(acc[m][n][0] * gg, acc[m][n][1] * gg); w.y = pack2(acc[m][n][2] * gg, acc[m][n][3] * gg);
                    *reinterpret_cast<uint2*>(o + col) = w;
                }
            }
        }
    }
};


namespace pg8 {
#define PG8_LAS __attribute__((address_space(3)))
typedef unsigned short bf16_t;
typedef short bf16x8 __attribute__((ext_vector_type(8)));
typedef float f32x4 __attribute__((ext_vector_type(4)));
typedef unsigned u32x4 __attribute__((ext_vector_type(4)));
constexpr int BM = 256, BK = 64, HALF = 128, HTB = HALF * BK * 2  , STAGE_BYTES = 8 * HTB, NXCD = 8, WGM = 8;

__host__ __device__ __forceinline__ int lds_byte(int r, int c) { const int st = (r >> 4) * 2 + (c >> 5), rr = r & 15, cc = c & 31, ob = rr * 64 + cc * 2; return st * 1024 + (ob ^ (((ob >> 9) & 1) << 5)); }
__host__ __device__ __forceinline__ void stage_rc(int b, int& R, int& C) { const int st = b / 1024, sb = b % 1024, swz = sb ^ (((sb >> 9) & 1) << 5); R = (st >> 1) * 16 + swz / 64; C = (st & 1) * 32 + (swz % 64) / 2; }
__host__ __device__ __forceinline__ int perm32(int rho) { const int n = rho >> 4, i = rho & 15; return 8 * (i >> 2) + 4 * n + (i & 3); }

struct Unit { int pm, pn; };
struct Gemm { const bf16_t* A; const bf16_t* Bt; int M, N, K; };

struct StaticOrder {
    int nM, nN, nwg, G, c;
    __host__ __device__ void init(int M, int N, int G_, int c_) { nM = M / BM; nN = N / BM; nwg = nM * nN; G = G_; c = c_; }
    __host__ __device__ bool next(int i, Unit& u) const {
        const long L = (long)i * G + c; if (L >= nwg) return false;
        int wgid = (int)L; { const int q = nwg / NXCD, r = nwg % NXCD, xcd = wgid % NXCD, off = wgid / NXCD; wgid = (xcd < r ? xcd * (q + 1) : r * (q + 1) + (xcd - r) * q) + off; }
        const int nig = WGM * nN, gid = wgid / nig, fm = gid * WGM, gsz = (nM - fm) < WGM ? (nM - fm) : WGM;
        u.pm = fm + ((wgid % nig) % gsz); u.pn = (wgid % nig) / gsz; return true;
    }
    __device__ __forceinline__ void a_ready(const Unit&) const {}
    __device__ __forceinline__ void done(const Unit&) const {}
};
template <class Epi, class Sched, bool ALIGN_EPI = false, bool SP2 = false>
__device__ __forceinline__ void gemm_phase(PG8_LAS unsigned char* lds, const Gemm g, const Sched& S, const Epi& E, int wave) {
    const int tid = otid(wave), wid = __builtin_amdgcn_readfirstlane(tid >> 6), lane = tid & 63, wr = wid >> 2, wc = wid & 3, fr = lane & 15, fq = lane >> 4;
    const int K = g.K, nt = K / BK;
    unsigned voffA[2], voffB[2];
#pragma unroll
    for (int i = 0; i < 2; ++i) { int R, C; stage_rc(tid * 16 + i * 8192, R, C); const int Rb = Epi::PERM ? ((R & ~31) + perm32(R & 31)) : R;
        voffA[i] = (unsigned)(R * K + C) * 2u; voffB[i] = (unsigned)(Rb * K + C) * 2u; }
    const size_t kstep = (size_t)(BK * 2);
    const size_t hstep = (size_t)HALF * K * 2;
    const size_t tstep = 2 * hstep;
    const unsigned ldsw = (unsigned)wid * 1024u;
    const int aoff = lds_byte(wr * 64 + fr, fq * 8), boff = lds_byte(wc * 32 + fr, fq * 8);
#define PG8_SA(b, h) (((b) * 2 + (h)) * HTB)
#define PG8_SB(b, h) ((4 + (b) * 2 + (h)) * HTB)
#define PG8_STAGE(bufoff, gbase, voff) do { _Pragma("unroll") for (int _i = 0; _i < 2; ++_i) \
        __builtin_amdgcn_global_load_lds((const unsigned*)((const char*)(gbase) + (voff)[_i]), (PG8_LAS unsigned*)(lds + (bufoff) + ldsw + _i * 8192), 16, 0, 0); } while (0)
#define PG8_LDA(dst, b, h) do { _Pragma("unroll") for (int m = 0; m < 4; ++m) _Pragma("unroll") for (int k = 0; k < 2; ++k) dst[m][k] = *(const PG8_LAS bf16x8*)(lds + PG8_SA(b, h) + aoff + m * 2048 + k * 1024); } while (0)
#define PG8_LDB(dst, b, h) do { _Pragma("unroll") for (int n = 0; n < 2; ++n) _Pragma("unroll") for (int k = 0; k < 2; ++k) dst[n][k] = *(const PG8_LAS bf16x8*)(lds + PG8_SB(b, h) + boff + n * 2048 + k * 1024); } while (0)
#define PG8_MMA(ai, bj, At, Bt) do { __builtin_amdgcn_s_setprio(1); _Pragma("unroll") for (int m = 0; m < 4; ++m) _Pragma("unroll") for (int n = 0; n < 2; ++n) _Pragma("unroll") for (int k = 0; k < 2; ++k) \
        acc[ai][bj][m][n] = __builtin_amdgcn_mfma_f32_16x16x32_bf16(Bt[n][k], At[m][k], acc[ai][bj][m][n], 0, 0, 0); __builtin_amdgcn_s_setprio(0); } while (0)
#define PG8_WAIT_V(n) asm volatile("s_waitcnt vmcnt(" #n ")" ::: "memory")
#define PG8_WAIT_L(n) asm volatile("s_waitcnt lgkmcnt(" #n ")" ::: "memory")
#define PG8_BAR __builtin_amdgcn_s_barrier()
#define PG8_SCHED __builtin_amdgcn_sched_barrier(0)
    Unit cur, nxt; int ui = 0;
    if (!S.next(0, cur)) return;
    f32x4 acc[2][2][4][2];
#pragma unroll
    for (int a = 0; a < 2; ++a)
#pragma unroll
        for (int b = 0; b < 2; ++b)
#pragma unroll
            for (int m = 0; m < 4; ++m)
#pragma unroll
                for (int n = 0; n < 2; ++n) acc[a][b][m][n] = (f32x4){0.f, 0.f, 0.f, 0.f};
    bf16x8 At[4][2], B0[2][2], B1[2][2];
    const char* cA = (const char*)g.A + (size_t)cur.pm * tstep; const char* cB = (const char*)g.Bt + (size_t)cur.pn * tstep;
    S.a_ready(cur);
    if constexpr (SP2) {
        PG8_STAGE(PG8_SB(0, 0), cB, voffB); PG8_STAGE(PG8_SB(0, 1), cB + hstep, voffB); PG8_STAGE(PG8_SA(0, 0), cA, voffA); PG8_STAGE(PG8_SA(0, 1), cA + hstep, voffA);
        if (wr == 1) PG8_BAR;
        PG8_WAIT_V(2); PG8_BAR;
        PG8_STAGE(PG8_SB(1, 0), cB + kstep, voffB); PG8_STAGE(PG8_SA(1, 0), cA + kstep, voffA); PG8_STAGE(PG8_SB(1, 1), cB + hstep + kstep, voffB);
        PG8_WAIT_V(6); PG8_BAR;
    } else {
        PG8_STAGE(PG8_SB(0, 0), cB, voffB); PG8_STAGE(PG8_SA(0, 0), cA, voffA); PG8_STAGE(PG8_SB(0, 1), cB + hstep, voffB); PG8_STAGE(PG8_SA(0, 1), cA + hstep, voffA);
        if (wr == 1) PG8_BAR;
        PG8_WAIT_V(4); PG8_BAR;
        PG8_STAGE(PG8_SB(1, 0), cB + kstep, voffB); PG8_STAGE(PG8_SA(1, 0), cA + kstep, voffA); PG8_STAGE(PG8_SB(1, 1), cB + hstep + kstep, voffB);
        PG8_WAIT_V(6); PG8_BAR;
    }
    for (;;) {
        const bool has_next = S.next(ui + 1, nxt);
        const char* nA = has_next ? (const char*)g.A + (size_t)nxt.pm * tstep : cA; const char* nB = has_next ? (const char*)g.Bt + (size_t)nxt.pn * tstep : cB;
        for (int t = 0; t < nt; t += 2) {
            const bool last = (t == nt - 2);
            const char* a1 = cA + (size_t)(t + 1) * kstep;
            const char* a2 = last ? nA : cA + (size_t)(t + 2) * kstep; const char* b2 = last ? nB : cB + (size_t)(t + 2) * kstep;
            const char* a3 = a2 + kstep; const char* b3 = b2 + kstep;
            if (last && has_next) S.a_ready(nxt);
            if constexpr (SP2) {
            PG8_LDB(B0, 0, 0); PG8_LDB(B1, 0, 1); PG8_SCHED; PG8_LDA(At, 0, 0); PG8_STAGE(PG8_SA(1, 1), a1 + hstep, voffA);
            PG8_WAIT_V(8); PG8_WAIT_L(0); PG8_BAR; PG8_MMA(0, 0, At, B0); PG8_MMA(0, 1, At, B1); PG8_BAR; PG8_SCHED;
            PG8_LDA(At, 0, 1); PG8_STAGE(PG8_SB(0, 0), b2, voffB); PG8_STAGE(PG8_SB(0, 1), b2 + hstep, voffB); PG8_STAGE(PG8_SA(0, 0), a2, voffA);
            PG8_WAIT_V(8); PG8_WAIT_L(0); PG8_BAR; PG8_MMA(1, 0, At, B0); PG8_MMA(1, 1, At, B1); PG8_BAR; PG8_SCHED;
            PG8_LDB(B0, 1, 0); PG8_LDB(B1, 1, 1); PG8_SCHED; PG8_LDA(At, 1, 0); PG8_STAGE(PG8_SA(0, 1), a2 + hstep, voffA);
            PG8_WAIT_V(8); PG8_WAIT_L(0); PG8_BAR; PG8_MMA(0, 0, At, B0); PG8_MMA(0, 1, At, B1); PG8_BAR; PG8_SCHED;
            PG8_LDA(At, 1, 1); PG8_STAGE(PG8_SB(1, 0), b3, voffB); PG8_STAGE(PG8_SB(1, 1), b3 + hstep, voffB); PG8_STAGE(PG8_SA(1, 0), a3, voffA);
            PG8_WAIT_V(8); PG8_WAIT_L(0); PG8_BAR; PG8_MMA(1, 0, At, B0); PG8_MMA(1, 1, At, B1); PG8_BAR; PG8_SCHED;
            } else {
            PG8_LDB(B0, 0, 0); PG8_SCHED; PG8_LDA(At, 0, 0); PG8_STAGE(PG8_SA(1, 1), a1 + hstep, voffA);
            PG8_WAIT_L(8); PG8_BAR; PG8_WAIT_L(0); PG8_MMA(0, 0, At, B0); PG8_BAR; PG8_SCHED;
            PG8_LDB(B1, 0, 1); PG8_STAGE(PG8_SB(0, 0), b2, voffB);
            PG8_BAR; PG8_WAIT_L(0); PG8_MMA(0, 1, At, B1); PG8_BAR;
            PG8_LDA(At, 0, 1); PG8_STAGE(PG8_SA(0, 0), a2, voffA);
            PG8_BAR; PG8_WAIT_L(0); PG8_MMA(1, 0, At, B0); PG8_BAR; PG8_SCHED;
            PG8_STAGE(PG8_SB(0, 1), b2 + hstep, voffB);
            PG8_WAIT_V(6); PG8_BAR; PG8_MMA(1, 1, At, B1); PG8_BAR;
            PG8_LDB(B0, 1, 0); PG8_SCHED; PG8_LDA(At, 1, 0); PG8_STAGE(PG8_SA(0, 1), a2 + hstep, voffA);
            PG8_WAIT_L(8); PG8_BAR; PG8_WAIT_L(0); PG8_MMA(0, 0, At, B0); PG8_BAR; PG8_SCHED;
            PG8_LDB(B1, 1, 1); PG8_STAGE(PG8_SB(1, 0), b3, voffB);
            PG8_BAR; PG8_WAIT_L(0); PG8_MMA(0, 1, At, B1); PG8_BAR;
            PG8_LDA(At, 1, 1); PG8_STAGE(PG8_SA(1, 0), a3, voffA);
            PG8_BAR; PG8_WAIT_L(0); PG8_MMA(1, 0, At, B0); PG8_BAR; PG8_SCHED;
            PG8_STAGE(PG8_SB(1, 1), b3 + hstep, voffB);
            PG8_WAIT_V(6); PG8_BAR; PG8_MMA(1, 1, At, B1); PG8_BAR;
            }
        }
        if constexpr (ALIGN_EPI) { if (wr == 0) PG8_BAR; }
        if constexpr (!Epi::AFTER_DRAIN) { E(acc, cur, wr, wc, fr, fq); S.done(cur); }
        if (!has_next) break;
#pragma unroll
        for (int a = 0; a < 2; ++a)
#pragma unroll
            for (int b = 0; b < 2; ++b)
#pragma unroll
                for (int m = 0; m < 4; ++m)
#pragma unroll
                    for (int n = 0; n < 2; ++n) acc[a][b][m][n] = (f32x4){0.f, 0.f, 0.f, 0.f};
        cur = nxt; cA = nA; cB = nB; ++ui;
        if constexpr (ALIGN_EPI) { if (wr == 1) PG8_BAR; }
    }
    PG8_WAIT_V(0);
    if constexpr (!ALIGN_EPI) { if (wr == 0) PG8_BAR; }
    PG8_BAR;
    if constexpr (Epi::AFTER_DRAIN) { E.fused(acc, cur, wr, wc, fr, fq, lds, wid, lane); S.done(cur); }
#undef PG8_SA
#undef PG8_SB
#undef PG8_STAGE
#undef PG8_LDA
#undef PG8_LDB
#undef PG8_MMA
#undef PG8_WAIT_V
#undef PG8_WAIT_L
#undef PG8_BAR
#undef PG8_SCHED
}
}
struct PEpiBf16 {
    static constexpr bool PERM = true, AFTER_DRAIN = false;
    bf16_t* O; int ldo;
    __device__ __forceinline__ void operator()(const pg8::f32x4 (&acc)[2][2][4][2], const pg8::Unit& u, int wr, int wc, int fr, int fq) const {
        const int row0 = u.pm * 256 + wr * 64 + fr, col0 = u.pn * 256 + wc * 32 + 8 * fq;
#pragma unroll
        for (int ai = 0; ai < 2; ++ai)
#pragma unroll
            for (int m = 0; m < 4; ++m) {
                bf16_t* rowp = O + (size_t)(row0 + ai * 128 + m * 16) * ldo + col0;
#pragma unroll
                for (int bj = 0; bj < 2; ++bj) {
                    const pg8::f32x4 v0 = acc[ai][bj][m][0], v1 = acc[ai][bj][m][1];
                    uint4 w; w.x = pack2(v0[0], v0[1]); w.y = pack2(v0[2], v0[3]); w.z = pack2(v1[0], v1[1]); w.w = pack2(v1[2], v1[3]);
                    *reinterpret_cast<uint4*>(rowp + bj * 128) = w;
                }
            }
    }
};
template <bool PREV_BF16>
struct PEpiOut {
    static constexpr bool PERM = true, AFTER_DRAIN = false;
    const float* Xprev; const bf16_t* XprevB; bf16_t* T;
    __device__ __forceinline__ void operator()(const pg8::f32x4 (&acc)[2][2][4][2], const pg8::Unit& u, int wr, int wc, int fr, int fq) const {
        const int row0 = u.pm * 256 + wr * 64 + fr, col0 = u.pn * 256 + wc * 32 + 8 * fq;
#pragma unroll
        for (int ai = 0; ai < 2; ++ai)
#pragma unroll
            for (int m = 0; m < 4; ++m) {
                const size_t ro = (size_t)(row0 + ai * 128 + m * 16) * DM + col0;
#pragma unroll
                for (int bj = 0; bj < 2; ++bj) {
                    const size_t o = ro + bj * 128;
                    float xp[8];
                    if (PREV_BF16) {
                        unpack8(*reinterpret_cast<const uint4*>(XprevB + o), xp);
                    } else {
                        const float4 a = *reinterpret_cast<const float4*>(Xprev + o), b = *reinterpret_cast<const float4*>(Xprev + o + 4);
                        xp[0] = a.x; xp[1] = a.y; xp[2] = a.z; xp[3] = a.w; xp[4] = b.x; xp[5] = b.y; xp[6] = b.z; xp[7] = b.w;
                    }
                    const pg8::f32x4 v0 = acc[ai][bj][m][0], v1 = acc[ai][bj][m][1];
                    uint4 w;
                    w.x = pack2(ALPHA_F * xp[0] + v0[0], ALPHA_F * xp[1] + v0[1]); w.y = pack2(ALPHA_F * xp[2] + v0[2], ALPHA_F * xp[3] + v0[3]);
                    w.z = pack2(ALPHA_F * xp[4] + v1[0], ALPHA_F * xp[5] + v1[1]); w.w = pack2(ALPHA_F * xp[6] + v1[2], ALPHA_F * xp[7] + v1[3]);
                    *reinterpret_cast<uint4*>(T + o) = w;
                }
            }
    }
};
template <class Epi>
__device__ __forceinline__ void big_gemm(const bf16_t* A, const bf16_t* Bt, int M, int N, int K, const Epi& e, unsigned char* smem, int wave) {
    pg8::Gemm g{A, Bt, M, N, K};
    pg8::StaticOrder S;
    S.init(M, N, ogdim(), obid());
    pg8::gemm_phase<Epi, pg8::StaticOrder, true, true>((PG8_LAS unsigned char*)smem, g, S, e, wave);
}

__device__ __forceinline__ void tconv_wave(const float* __restrict__ src, int N, bf16_t* __restrict__ dst, int ldd, int k0, int n0,
                                           int mode, float* tile, int lane) {
#pragma unroll
    for (int i = 0; i < 8; ++i) {
        const int r = i * 8 + (lane >> 3), c4 = (lane & 7) * 4;
        const float4 v = *reinterpret_cast<const float4*>(src + (size_t)(k0 + r) * N + n0 + c4);
        tile[r * 33 + c4] = v.x; tile[r * 33 + c4 + 1] = v.y; tile[r * 33 + c4 + 2] = v.z; tile[r * 33 + c4 + 3] = v.w;
    }
    asm volatile("s_waitcnt lgkmcnt(0)" ::: "memory");
#pragma unroll 8
    for (int nn = 0; nn < 32; ++nn) {
        const int n = n0 + nn;
        int drow = n;
        if (mode == 1) drow = (n >> 4) * 32 + (n & 15);
        else if (mode == 2) drow = (n >> 4) * 32 + 16 + (n & 15);
        dst[(size_t)drow * ldd + k0 + lane] = f2bf(tile[lane * 33 + nn]);
    }
    asm volatile("s_waitcnt lgkmcnt(0)" ::: "memory");
}

__device__ __forceinline__ void phase_pre(const Params& p, unsigned char* smem, int part, int bid, int nb) {
    const int tidx = otid(p.wave);
    const int wv = tidx >> 6, lane = tidx & 63;
    float* tile = reinterpret_cast<float*>(smem) + wv * (64 * 33);
    bf16_t* W = reinterpret_cast<bf16_t*>(p.ws + OFF_W);
    constexpr int T0 = 896, T1 = 512, T7 = 16, T8 = 16, T9 = 32;
    constexpr int T2 = 1536, T3 = 512, T4 = 4096, T5 = 4096, T6 = 4096;
    if (part == 0) {
        constexpr int TOT = T0 + T1 + T7 + T8 + T9;
        for (int u = bid * NWAVES + wv; u < TOT; u += nb * NWAVES) {
            int v = u;
            const float* src; bf16_t* dst; int K, N, tk, tn;
            if (v < T0) { src = p.in[1]; K = 1024; N = 2304; dst = W + WE_IN0; tk = v / 56; tn = v % 56; }
            else if ((v -= T0) < T1) { src = p.in[15]; K = 1024; N = 1024; dst = W + WE_OUT0; tk = v / 32; tn = v % 32; }
            else if ((v -= T1) < T7) { src = p.in[4]; K = 64; N = 512; dst = W + WE_LW2; tk = 0; tn = v; }
            else if ((v -= T7) < T8) { src = p.in[6]; K = 64; N = 512; dst = W + WE_LA2; tk = 0; tn = v; }
            else { v -= T8; src = p.in[7]; K = 128; N = 512; dst = W + WE_LG2; tk = v >> 4; tn = v & 15; }
            tconv_wave(src, N, dst, K, tk * 64, tn * 32, 0, tile, lane);
        }
        __syncthreads();
        {
            float* sWu = reinterpret_cast<float*>(smem);
            float* sPw = sWu + 16 * 128;
            for (int bt = bid; bt < 256; bt += nb) {
                const int g = bt >> 6, k0 = (bt & 63) * 16;
                {
                    const int r = tidx >> 5, c4 = (tidx & 31) * 4;
                    *reinterpret_cast<float4*>(sWu + r * 128 + c4) = *reinterpret_cast<const float4*>(p.in[1] + (size_t)(k0 + r) * 2304 + 1792 + g * 128 + c4);
                }
                for (int i = tidx; i < 128 * 32; i += NTHREADS) {
                    const int r = i >> 5, c4 = (i & 31) * 4;
                    *reinterpret_cast<float4*>(sPw + r * 128 + c4) = *reinterpret_cast<const float4*>(p.in[13] + (size_t)g * 16384 + r * 128 + c4);
                }
                __syncthreads();
                const int k = tidx >> 5, d0 = (tidx & 31) * 4;
                float acc[4] = {0.f, 0.f, 0.f, 0.f};
#pragma unroll 8
                for (int c = 0; c < 128; ++c) {
                    const float a = sWu[k * 128 + c];
                    const float4 bq = *reinterpret_cast<const float4*>(sPw + c * 128 + d0);
                    acc[0] += a * bq.x; acc[1] += a * bq.y; acc[2] += a * bq.z; acc[3] += a * bq.w;
                }
                bf16_t* dstp = W + WE_IN0 + (size_t)(1792 + g * 128 + d0) * 1024 + k0 + k;
#pragma unroll
                for (int j = 0; j < 4; ++j) dstp[(size_t)j * 1024] = f2bf(acc[j]);
                __syncthreads();
            }
        }
        const float4* x4 = reinterpret_cast<const float4*>(p.in[0]);
        uint2* xb = reinterpret_cast<uint2*>(p.ws + OFF_ACTB);
        const size_t n4 = (size_t)NT * DM / 4;
        const size_t stride = (size_t)nb * NTHREADS;
        for (size_t i = (size_t)bid * NTHREADS + tidx; i < n4; i += 8 * stride) {
            float4 v[8];
#pragma unroll
            for (int j = 0; j < 8; ++j) if (i + j * stride < n4) v[j] = x4[i + j * stride];
#pragma unroll
            for (int j = 0; j < 8; ++j) if (i + j * stride < n4) {
                uint2 w; w.x = pack2(v[j].x, v[j].y); w.y = pack2(v[j].z, v[j].w);
                xb[i + j * stride] = w;
            }
        }
    } else {
        constexpr int TOT = T2 + T3 + T4 + T5 + T6;
        for (int u = bid * NWAVES + wv; u < TOT; u += nb * NWAVES) {
            int v = u;
            const float* src; bf16_t* dst; int K, N, mode = 0, tk, tn;
            if (v < T2) { src = p.in[16]; K = 1024; N = 3072; dst = W + WE_IN1; tk = v / 96; tn = v % 96; }
            else if ((v -= T2) < T3) { src = p.in[23]; K = 1024; N = 1024; dst = W + WE_OUT1; tk = v / 32; tn = v % 32; }
            else if ((v -= T3) < T4) { int mat = v >> 6, w = v & 63; src = p.in[30] + (size_t)mat * 131072; K = 1024; N = 128; dst = W + WE_W13 + (size_t)mat * 262144; mode = 1; tk = w >> 2; tn = w & 3; }
            else if ((v -= T4) < T5) { int mat = v >> 6, w = v & 63; src = p.in[31] + (size_t)mat * 131072; K = 1024; N = 128; dst = W + WE_W13 + (size_t)mat * 262144; mode = 2; tk = w >> 2; tn = w & 3; }
            else { v -= T5; int mat = v >> 6, w = v & 63; src = p.in[32] + (size_t)mat * 131072; K = 128; N = 1024; dst = W + WE_W2 + (size_t)mat * 131072; tk = w >> 5; tn = w & 31; }
            tconv_wave(src, N, dst, K, tk * 64, tn * 32, mode, tile, lane);
        }
        {
            bf16_t* RH = W + WE_RT_HI; bf16_t* RL = W + WE_RT_LO;
            for (int i = bid * NTHREADS + tidx; i < 2 * 48 * 1024; i += nb * NTHREADS) {
                const int l = i / (48 * 1024), r = i - l * 48 * 1024, n = r >> 10, k = r & 1023;
                float w = 0.f;
                if (n < 4) w = p.in[26][((size_t)l * 1024 + k) * 4 + n];
                else if (n < 36) w = p.in[28][((size_t)l * 1024 + k) * 32 + (n - 4)];
                const bf16_t h = f2bf(w);
                RH[i] = h; RL[i] = f2bf(w - bf2f(h));
            }
        }
        {
            float2* rope = reinterpret_cast<float2*>(p.ws + OFF_ROPE);
            for (int i = bid * NTHREADS + tidx; i < SEQ * 32; i += nb * NTHREADS) {
                int pos = i >> 5, k = i & 31;
                float inv = powf(10000.0f, -(float)k / 32.0f);
                float ang = (float)pos * inv;
                const double a = (double)ang;
                const double q = rint(a * 0.15915494309189535);
                const float rr = (float)(a - q * 6.283185307179586);
                float s, c;
                sincosf(rr, &s, &c);
                rope[i] = make_float2(c, s);
            }
        }
    }
}

__device__ __forceinline__ void phase_l0_prep(const Params& p) {
    const int tidx = otid(p.wave);
    const bf16_t* P = reinterpret_cast<const bf16_t*>(p.ws + OFF_P);
    bf16_t* LA = reinterpret_cast<bf16_t*>(p.ws + OFF_LORA);
    bf16_t* YC = reinterpret_cast<bf16_t*>(p.ws + OFF_YCAT);
    const float* mu = p.in[2];
    const int nthr = ogdim() * NTHREADS, t0 = obid() * NTHREADS + tidx;
    {
        const int total = NT * 32;
        for (int it0 = t0; it0 < total; it0 += 4 * nthr) {
            uint4 cu[4], pr[4];
#pragma unroll
            for (int q = 0; q < 4; ++q) {
                const int it = it0 + q * nthr;
                cu[q] = make_uint4(0u, 0u, 0u, 0u); pr[q] = cu[q];
                if (it < total) {
                    const int tok = it >> 5, j = it & 31;
                    const bf16_t* src = P + (size_t)tok * 2304 + 1536 + j * 8;
                    cu[q] = *reinterpret_cast<const uint4*>(src);
                    if ((tok & (SEQ - 1)) > 0) pr[q] = *reinterpret_cast<const uint4*>(src - 2304);
                }
            }
#pragma unroll
            for (int q = 0; q < 4; ++q) {
                const int it = it0 + q * nthr;
                if (it < total) {
                    const int tok = it >> 5, j = it & 31, col = 1536 + j * 8;
                    float cur[8], prv[8];
                    unpack8(cu[q], cur); unpack8(pr[q], prv);
                    const float4 m0 = *reinterpret_cast<const float4*>(mu + col), m1 = *reinterpret_cast<const float4*>(mu + col + 4);
                    const float mm[8] = {m0.x, m0.y, m0.z, m0.w, m1.x, m1.y, m1.z, m1.w};
                    float o[8];
#pragma unroll
                    for (int i = 0; i < 8; ++i) {
                        const float z = cur[i] + mm[i] * (prv[i] - cur[i]);
                        o[i] = (j < 8) ? (1.0f - 2.0f / (1.0f + __expf(2.0f * z))) : ((j < 16) ? z : sigmoidf_(z));
                    }
                    uint4 w; w.x = pack2(o[0], o[1]); w.y = pack2(o[2], o[3]); w.z = pack2(o[4], o[5]); w.w = pack2(o[6], o[7]);
                    *reinterpret_cast<uint4*>(LA + (size_t)tok * 256 + j * 8) = w;
                }
            }
        }
    }
    {
        const int total = NT * 64;
        for (int it = t0; it < total; it += nthr) {
            const int tok = it >> 6, cc = (it & 63) * 8;
            const int s = tok & (SEQ - 1);
            const int gi = cc >> 7;
            const int win = 2 << gi;
            const int cnt = (s + 1 < win) ? (s + 1) : win;
            const bf16_t* src = P + (size_t)tok * 2304 + 1792 + cc;
            float u[8], sum[8];
            uint4 rows[16];
#pragma unroll
            for (int r = 0; r < 16; ++r) {
                rows[r] = make_uint4(0u, 0u, 0u, 0u);
                if (r < cnt) rows[r] = *reinterpret_cast<const uint4*>(src - (size_t)r * 2304);
            }
            unpack8(rows[0], u);
#pragma unroll
            for (int i = 0; i < 8; ++i) sum[i] = u[i];
#pragma unroll
            for (int r = 1; r < 16; ++r) {
                float t[8];
                unpack8(rows[r], t);
#pragma unroll
                for (int i = 0; i < 8; ++i) sum[i] += t[i];
            }
            const float inv = 1.0f / (float)cnt;
            const float4 ps0 = *reinterpret_cast<const float4*>(p.in[14] + cc), ps1 = *reinterpret_cast<const float4*>(p.in[14] + cc + 4);
            uint4 w;
            w.x = pack2((sum[0] * inv - u[0]) * ps0.x, (sum[1] * inv - u[1]) * ps0.y); w.y = pack2((sum[2] * inv - u[2]) * ps0.z, (sum[3] * inv - u[3]) * ps0.w);
            w.z = pack2((sum[4] * inv - u[4]) * ps1.x, (sum[5] * inv - u[5]) * ps1.y); w.w = pack2((sum[6] * inv - u[6]) * ps1.z, (sum[7] * inv - u[7]) * ps1.w);
            *reinterpret_cast<uint4*>(YC + (size_t)tok * 1024 + 512 + cc) = w;
        }
    }
}

__device__ __forceinline__ void phase_l0_lora(const Params& p, bf16_t* smem) {
    const bf16_t* W = reinterpret_cast<const bf16_t*>(p.ws + OFF_W);
    const bf16_t* LA = reinterpret_cast<const bf16_t*>(p.ws + OFF_LORA);
    const bf16_t* PO = reinterpret_cast<const bf16_t*>(p.ws + OFF_POOLED);
    for (int t = obid(); t < 1536; t += ogdim()) {
        int job = t >> 9, w = t & 511;
        if (job == 0) {
            EpiLora<0> e{nullptr, reinterpret_cast<bf16_t*>(p.ws + OFF_LOGW), p.in[3], 512, 0};
            gemm_tile<false>(LA, 256, nullptr, 0, W + WE_LW2, 64, 64, (w >> 2) * 256, (w & 3) * 128, e, smem, p.wave);
        } else if (job == 1) {
            EpiLora<1> e{nullptr, reinterpret_cast<bf16_t*>(p.ws + OFF_AA), p.in[5], 512, 0};
            gemm_tile<false>(LA + 64, 256, nullptr, 0, W + WE_LA2, 64, 64, (w >> 2) * 256, (w & 3) * 128, e, smem, p.wave);
        } else {
            EpiLora<2> e{nullptr, reinterpret_cast<bf16_t*>(p.ws + OFF_GG), nullptr, 512, 0};
            gemm_tile<false>(LA + 128, 256, nullptr, 0, W + WE_LG2, 128, 128, (w >> 2) * 256, (w & 3) * 128, e, smem, p.wave);
        }
    }
}

#define RC_LD 72
#define RC_BUF (64 * RC_LD)
#define RC_BYTES (RC_BUF * 2)
#define OFF_TBUF OFF_KVT

__device__ __forceinline__ void mm64(f32x4 (&acc)[2], const bf16_t* A, const bf16_t* Bt, int mt, int nt0, int fr, int fq) {
#pragma unroll
    for (int ks = 0; ks < 2; ++ks) {
        bf16x8 af = *reinterpret_cast<const bf16x8*>(A + (mt * 16 + fr) * RC_LD + ks * 32 + fq * 8);
        bf16x8 bq[2];
#pragma unroll
        for (int n = 0; n < 2; ++n) bq[n] = *reinterpret_cast<const bf16x8*>(Bt + ((nt0 + n) * 16 + fr) * RC_LD + ks * 32 + fq * 8);
#pragma unroll
        for (int n = 0; n < 2; ++n) acc[n] = __builtin_amdgcn_mfma_f32_16x16x32_bf16(af, bq[n], acc[n], 0, 0, 0);
    }
}
template <int MASK>
__device__ __forceinline__ void store_T(bf16_t* dst, const f32x4 (&acc)[2], int mt, int nt0, int fr, int fq) {
#pragma unroll
    for (int n = 0; n < 2; ++n) {
        const int C = (nt0 + n) * 16 + fr, R0 = mt * 16 + fq * 4;
        float v[4];
#pragma unroll
        for (int j = 0; j < 4; ++j) {
            const int R = R0 + j;
            bool keep = true;
            if (MASK == 1) keep = R < C;
            else if (MASK == 2) keep = R <= C;
            else if (MASK == 3) keep = C < R;
            v[j] = keep ? acc[n][j] : 0.f;
        }
        uint2 w; w.x = pack2(v[0], v[1]); w.y = pack2(v[2], v[3]);
        *reinterpret_cast<uint2*>(dst + C * RC_LD + R0) = w;
    }
}
__device__ __forceinline__ void zero_acc(f32x4 (&acc)[2]) {
    acc[0] = (f32x4){0.f, 0.f, 0.f, 0.f};
    acc[1] = (f32x4){0.f, 0.f, 0.f, 0.f};
}

#define OFF_NTB (OFF_P + 144ull * MIB)
#define OFF_S0A (OFF_P + 176ull * MIB)
#define OFF_TB (420ull * MIB)
#define OFF_MB (452ull * MIB)
#define OFF_S0B (484ull * MIB)
#define OFF_WLB (500ull * MIB)
#define OFF_BCB (501ull * MIB)
__device__ __forceinline__ bf16_t* s0_ptr(unsigned char* ws, int u) {
    return reinterpret_cast<bf16_t*>(ws + (u < 2048 ? OFF_S0A : OFF_S0B)) + (size_t)(u & 2047) * 4096;
}

struct PrepIn {
    unsigned short k[8], v[8], r[8], lw[8], a[8];
    unsigned short pk, pv, pr;
};
template <int MODE>
__device__ __forceinline__ void prep_load(PrepIn& in, const Params& p, int u, int tid) {
    const int b = u >> 10, h = (u >> 7) & 7, n = u & 127;
    const int lane = tid & 63, q = tid >> 6;
    const int c = h * 64 + lane;
    const bf16_t* P = reinterpret_cast<const bf16_t*>(p.ws + OFF_P);
    const bf16_t* LOGW = reinterpret_cast<const bf16_t*>(p.ws + OFF_LOGW);
    const bf16_t* AA = reinterpret_cast<const bf16_t*>(p.ws + OFF_AA);
    const int s0 = n * 64 + q * 8;
    const size_t tok0 = (size_t)b * SEQ + s0;
    in.pk = 0; in.pv = 0; in.pr = 0;
    if (s0 > 0) {
        const bf16_t* pp = P + (tok0 - 1) * 2304;
        in.pk = pp[512 + c]; in.pv = pp[1024 + c];
        in.pr = pp[c];
    }
#pragma unroll
    for (int i = 0; i < 8; ++i) {
        const bf16_t* pp = P + (tok0 + i) * 2304;
        in.k[i] = pp[512 + c]; in.v[i] = pp[1024 + c];
        in.r[i] = pp[c];
        in.lw[i] = LOGW[(tok0 + i) * 512 + c];
        in.a[i] = AA[(tok0 + i) * 512 + c];
    }
}
struct PrepC { float mu_k, kkc, kac, mu_v, mu_r, rkc, lng, lnb; };
template <int MODE>
__device__ __forceinline__ PrepC prep_consts(const Params& p, int h, int lane) {
    PrepC c_;
    const int c = h * 64 + lane;
    c_.mu_k = p.in[2][512 + c]; c_.kkc = p.in[8][c]; c_.kac = p.in[9][c]; c_.mu_v = p.in[2][1024 + c];
    c_.mu_r = 0.f; c_.rkc = 0.f; c_.lng = 0.f; c_.lnb = 0.f;
    c_.mu_r = p.in[2][c]; c_.rkc = p.in[10][c];
    if (MODE == 2) { c_.lng = p.in[11][c]; c_.lnb = p.in[12][c]; }
    return c_;
}
template <int MODE>
__device__ __forceinline__ void rwkv_prep(const PrepIn& in, const PrepC& pc, int tid, bf16_t* At, bf16_t* Bt, bf16_t* Kt, bf16_t* Rt,
                                          bf16_t* AtT, bf16_t* BtT, bf16_t* KtT, bf16_t* VT, float* sTot, float* sBC, float* sWL) {
    const int lane = tid & 63, q = tid >> 6;
    const float mu_k = pc.mu_k, kkc = pc.kkc, kac = pc.kac, mu_v = pc.mu_v, mu_r = pc.mu_r, rkc = pc.rkc;
    float lw[8], av[8], zk[8], zr[8], zv[8];
    float pk = bf2f(in.pk), pr = bf2f(in.pr), pv = bf2f(in.pv);
#pragma unroll
    for (int i = 0; i < 8; ++i) {
        const float k0 = bf2f(in.k[i]), v0 = bf2f(in.v[i]);
        zk[i] = k0 + mu_k * (pk - k0); pk = k0;
        zv[i] = v0 + mu_v * (pv - v0); pv = v0;
        { const float r0 = bf2f(in.r[i]); zr[i] = r0 + mu_r * (pr - r0); pr = r0; }
        lw[i] = bf2f(in.lw[i]);
        av[i] = bf2f(in.a[i]);
    }
    float lws[8];
    float cs = 0.f;
#pragma unroll
    for (int i = 0; i < 8; ++i) { cs += lw[i]; lws[i] = cs; }
    sTot[q * 64 + lane] = cs;
    lds_barrier();
    float off = 0.f, tot = 0.f;
#pragma unroll
    for (int qq = 0; qq < 8; ++qq) { float tq = sTot[qq * 64 + lane]; if (qq < q) off += tq; tot += tq; }
    float atv[8], btv[8], ktv[8];
#pragma unroll
    for (int i = 0; i < 8; ++i) {
        const int t = q * 8 + i;
        const float L = lws[i] + off;
        float kk = zk[i] * kkc;
        float ss = wave_sum(kk * kk);
        kk *= rsqrtf(fmaxf(ss, 1e-24f));
        const float e_neg = __expf(-L), e_prev = __expf(L - lw[i]);
        const float a = av[i];
        const float at = -kk * e_prev;
        At[t * RC_LD + lane] = f2bf(at);
        const float bt = kk * a * e_neg;
        Bt[t * RC_LD + lane] = f2bf(bt);
        const float kp = zk[i] * (1.0f + (a - 1.0f) * kac);
        const float kt = kp * e_neg;
        Kt[t * RC_LD + lane] = f2bf(kt);
        atv[i] = at; btv[i] = bt; ktv[i] = kt;
        {
            Rt[t * RC_LD + lane] = f2bf(zr[i] * __expf(L));
            const float bc = wave_sum(zr[i] * kp * rkc);
            if (lane == 0) sBC[t] = bc;
        }
    }
    uint4 w0;
    if (MODE == 1) {
        w0.x = pack2(atv[0], atv[1]); w0.y = pack2(atv[2], atv[3]); w0.z = pack2(atv[4], atv[5]); w0.w = pack2(atv[6], atv[7]);
        *reinterpret_cast<uint4*>(AtT + lane * RC_LD + q * 8) = w0;
        w0.x = pack2(btv[0], btv[1]); w0.y = pack2(btv[2], btv[3]); w0.z = pack2(btv[4], btv[5]); w0.w = pack2(btv[6], btv[7]);
        *reinterpret_cast<uint4*>(BtT + lane * RC_LD + q * 8) = w0;
        w0.x = pack2(ktv[0], ktv[1]); w0.y = pack2(ktv[2], ktv[3]); w0.z = pack2(ktv[4], ktv[5]); w0.w = pack2(ktv[6], ktv[7]);
        *reinterpret_cast<uint4*>(KtT + lane * RC_LD + q * 8) = w0;
        if (q == 0) sWL[lane] = __expf(tot);
    }
    w0.x = pack2(zv[0], zv[1]); w0.y = pack2(zv[2], zv[3]); w0.z = pack2(zv[4], zv[5]); w0.w = pack2(zv[6], zv[7]);
    *reinterpret_cast<uint4*>(VT + lane * RC_LD + q * 8) = w0;
}

__device__ __forceinline__ void phase_rwkv_r1(const Params& p, unsigned char* smem) {
    const int tidx = otid(p.wave);
    const int tid = tidx, wv = tid >> 6, lane = tid & 63, fr = lane & 15, fq = lane >> 4, mt = wv >> 1, nt0 = (wv & 1) * 2;
    bf16_t* base = reinterpret_cast<bf16_t*>(smem);
    bf16_t* At = base; bf16_t* Bt = base + RC_BUF; bf16_t* Kt = base + 2 * RC_BUF; bf16_t* AtT = base + 3 * RC_BUF;
    bf16_t* BtT = base + 4 * RC_BUF; bf16_t* KtT = base + 5 * RC_BUF; bf16_t* VT = base + 6 * RC_BUF;
    bf16_t* Rb0 = base + 7 * RC_BUF; bf16_t* Cb0 = base + 8 * RC_BUF; bf16_t* Rb1 = base + 9 * RC_BUF; bf16_t* Cb1 = base + 10 * RC_BUF;
    bf16_t* Pm0 = base + 11 * RC_BUF; bf16_t* Pm1 = base + 12 * RC_BUF;
    bf16_t* Rt = base + 13 * RC_BUF; bf16_t* Aak = base + 14 * RC_BUF;
    bf16_t* Tm = Rb0; bf16_t* PT = Rb1; bf16_t* AkVT = Cb1; bf16_t* QT = Pm0; bf16_t* Arb = At; bf16_t* Ark = Bt;
    float* sTot = reinterpret_cast<float*>(smem + 15 * RC_BYTES);
    float* sWL = sTot + 512;
    float* sBC = sWL + 64;
    bf16_t* PRg = reinterpret_cast<bf16_t*>(p.ws + OFF_AA);
    bf16_t* YQg = reinterpret_cast<bf16_t*>(p.ws + OFF_LOGW);
    float* BCg = reinterpret_cast<float*>(p.ws + OFF_BCB);
    bf16_t* Mg = reinterpret_cast<bf16_t*>(p.ws + OFF_MB);
    bf16_t* Ng = reinterpret_cast<bf16_t*>(p.ws + OFF_NTB);
    float* WLg = reinterpret_cast<float*>(p.ws + OFF_WLB);
    PrepIn cur, nxt;
    if (obid() < 4096) prep_load<1>(cur, p, obid(), tid);
    nxt = cur;
    for (int u = obid(); u < 4096; u += ogdim()) {
        const int h = (u >> 7) & 7, b = u >> 10, n = u & 127;
        PrepC pc = prep_consts<1>(p, h, lane);
        asm volatile("" : "+v"(pc.mu_k), "+v"(pc.kkc), "+v"(pc.kac), "+v"(pc.mu_v), "+v"(pc.mu_r), "+v"(pc.rkc));
        if (u + ogdim() < 4096) prep_load<1>(nxt, p, u + ogdim(), tid);
        rwkv_prep<1>(cur, pc, tid, At, Bt, Kt, Rt, AtT, BtT, KtT, VT, sTot, sBC, sWL);
        lds_barrier();
        f32x4 pacc[2];
        f32x4 acc[2];
        zero_acc(acc);
        mm64(acc, At, Bt, mt, nt0, fr, fq);
        store_T<3>(Cb0, acc, mt, nt0, fr, fq);
        zero_acc(pacc);
        mm64(pacc, Bt, At, mt, nt0, fr, fq);
#pragma unroll
        for (int nn = 0; nn < 2; ++nn)
#pragma unroll
            for (int j = 0; j < 4; ++j) {
                const int R = mt * 16 + fq * 4 + j, C = (nt0 + nn) * 16 + fr;
                pacc[nn][j] = (R < C) ? pacc[nn][j] : 0.f;
            }
        store_T<0>(Rb0, pacc, mt, nt0, fr, fq);
#pragma unroll
        for (int nn = 0; nn < 2; ++nn)
#pragma unroll
            for (int j = 0; j < 4; ++j) {
                const int R = mt * 16 + fq * 4 + j, C = (nt0 + nn) * 16 + fr;
                if (R == C) pacc[nn][j] += 1.0f;
            }
        store_T<0>(Pm0, pacc, mt, nt0, fr, fq);
        lds_barrier();
        zero_acc(acc); mm64(acc, Cb0, Rb0, mt, nt0, fr, fq); store_T<0>(Rb1, acc, mt, nt0, fr, fq);
        zero_acc(acc); mm64(acc, Rb0, Cb0, mt, nt0, fr, fq); store_T<0>(Cb1, acc, mt, nt0, fr, fq);
        zero_acc(acc); mm64(acc, Kt, At, mt, nt0, fr, fq); store_T<1>(Aak, acc, mt, nt0, fr, fq);
        lds_barrier();
        zero_acc(acc); mm64(acc, Cb1, Rb1, mt, nt0, fr, fq); store_T<0>(Rb0, acc, mt, nt0, fr, fq);
        zero_acc(acc); mm64(acc, Rb1, Cb1, mt, nt0, fr, fq); store_T<0>(Cb0, acc, mt, nt0, fr, fq);
        zero_acc(acc); mm64(acc, Cb1, Pm0, mt, nt0, fr, fq); pacc[0] += acc[0]; pacc[1] += acc[1]; store_T<0>(Pm1, pacc, mt, nt0, fr, fq);
        zero_acc(acc); mm64(acc, Bt, Rt, mt, nt0, fr, fq); store_T<2>(Arb, acc, mt, nt0, fr, fq);
        lds_barrier();
        zero_acc(acc); mm64(acc, Cb0, Rb0, mt, nt0, fr, fq); store_T<0>(Rb1, acc, mt, nt0, fr, fq);
        zero_acc(acc); mm64(acc, Rb0, Cb0, mt, nt0, fr, fq); store_T<0>(Cb1, acc, mt, nt0, fr, fq);
        zero_acc(acc); mm64(acc, Cb0, Pm1, mt, nt0, fr, fq); pacc[0] += acc[0]; pacc[1] += acc[1]; store_T<0>(Pm0, pacc, mt, nt0, fr, fq);
        zero_acc(acc); mm64(acc, Kt, Rt, mt, nt0, fr, fq); store_T<2>(Ark, acc, mt, nt0, fr, fq);
        lds_barrier();
        zero_acc(acc); mm64(acc, Cb1, Rb1, mt, nt0, fr, fq); store_T<0>(Rb0, acc, mt, nt0, fr, fq);
        zero_acc(acc); mm64(acc, Rb1, Cb1, mt, nt0, fr, fq); store_T<0>(Cb0, acc, mt, nt0, fr, fq);
        zero_acc(acc); mm64(acc, Cb1, Pm0, mt, nt0, fr, fq); pacc[0] += acc[0]; pacc[1] += acc[1]; store_T<0>(Pm1, pacc, mt, nt0, fr, fq);
        lds_barrier();
        zero_acc(acc); mm64(acc, Rb0, Cb0, mt, nt0, fr, fq); store_T<0>(Cb1, acc, mt, nt0, fr, fq);
        zero_acc(acc); mm64(acc, Cb0, Pm1, mt, nt0, fr, fq); pacc[0] += acc[0]; pacc[1] += acc[1]; store_T<0>(Pm0, pacc, mt, nt0, fr, fq);
        lds_barrier();
        zero_acc(acc); mm64(acc, Cb1, Pm0, mt, nt0, fr, fq); pacc[0] += acc[0]; pacc[1] += acc[1];
        store_T<0>(Tm, pacc, mt, nt0, fr, fq);
        lds_barrier();
        zero_acc(acc); mm64(acc, Tm, AtT, mt, nt0, fr, fq); store_T<0>(PT, acc, mt, nt0, fr, fq);
        zero_acc(acc); mm64(acc, Aak, VT, mt, nt0, fr, fq); store_T<0>(AkVT, acc, mt, nt0, fr, fq);
        lds_barrier();
        {
            zero_acc(acc); mm64(acc, Tm, AkVT, mt, nt0, fr, fq); store_T<0>(QT, acc, mt, nt0, fr, fq);
            zero_acc(acc); mm64(acc, PT, BtT, mt, nt0, fr, fq);
            bf16_t* Mo = Mg + (size_t)u * 4096;
#pragma unroll
            for (int nn = 0; nn < 2; ++nn) {
                const int C = (nt0 + nn) * 16 + fr, Rb = mt * 16 + fq * 4;
                const float wl = sWL[C];
                uint2 w; w.x = pack2(acc[nn][0] * wl, acc[nn][1] * wl); w.y = pack2(acc[nn][2] * wl, acc[nn][3] * wl);
                const int pos = (Rb & ~12) | ((Rb & 4) << 1) | ((Rb & 8) >> 1);
                const int posw = ((((pos >> 3) ^ (C & 7)) << 3) | (pos & 7));
                *reinterpret_cast<uint2*>(Mo + C * 64 + posw) = w;
            }
        }
        lds_barrier();
        {
            zero_acc(acc); mm64(acc, BtT, QT, mt, nt0, fr, fq); mm64(acc, KtT, VT, mt, nt0, fr, fq);
            bf16_t* No = Ng + (size_t)u * 4096;
            float wl[4];
#pragma unroll
            for (int j = 0; j < 4; ++j) wl[j] = sWL[mt * 16 + fq * 4 + j];
#pragma unroll
            for (int nn = 0; nn < 2; ++nn) {
                const int C = (nt0 + nn) * 16 + fr, Rb = mt * 16 + fq * 4;
                uint2 w; w.x = pack2(acc[nn][0] * wl[0], acc[nn][1] * wl[1]); w.y = pack2(acc[nn][2] * wl[2], acc[nn][3] * wl[3]);
                const int posw = ((((Rb >> 3) ^ (C & 7)) << 3) | (Rb & 7));
                *reinterpret_cast<uint2*>(No + C * 64 + posw) = w;
            }
            if (tid < 64) { WLg[(size_t)u * 64 + tid] = sWL[tid]; BCg[(size_t)u * 64 + tid] = sBC[tid]; }
            const size_t tok0 = (size_t)b * SEQ + n * 64;
            zero_acc(acc); mm64(acc, PT, Arb, mt, nt0, fr, fq);
#pragma unroll
            for (int nn = 0; nn < 2; ++nn) {
                const int C = (nt0 + nn) * 16 + fr, Rb = mt * 16 + fq * 4;
                const uint2 rt = *reinterpret_cast<const uint2*>(Rt + C * RC_LD + Rb);
                uint2 w;
                w.x = pack2(acc[nn][0] + __uint_as_float(rt.x << 16), acc[nn][1] + __uint_as_float(rt.x & 0xffff0000u));
                w.y = pack2(acc[nn][2] + __uint_as_float(rt.y << 16), acc[nn][3] + __uint_as_float(rt.y & 0xffff0000u));
                *reinterpret_cast<uint2*>(PRg + (tok0 + C) * 512 + h * 64 + Rb) = w;
            }
            zero_acc(acc); mm64(acc, QT, Arb, mt, nt0, fr, fq); mm64(acc, VT, Ark, mt, nt0, fr, fq);
#pragma unroll
            for (int nn = 0; nn < 2; ++nn) {
                const int C = (nt0 + nn) * 16 + fr, Rb = mt * 16 + fq * 4;
                uint2 w; w.x = pack2(acc[nn][0], acc[nn][1]); w.y = pack2(acc[nn][2], acc[nn][3]);
                *reinterpret_cast<uint2*>(YQg + (tok0 + C) * 512 + h * 64 + Rb) = w;
            }
        }
        cur = nxt;
        lds_barrier();
    }
}

typedef float f32x16 __attribute__((ext_vector_type(16)));
#define R2_SLOT 12800
__device__ __forceinline__ void r2_issue(const unsigned char* Mg, const unsigned char* Ng, const unsigned char* WLg, size_t u, int J, int lane,
                                         unsigned char* slot) {
#pragma unroll
    for (int i = 0; i < 8; ++i)
        __builtin_amdgcn_global_load_lds((const unsigned*)(Mg + u * 8192 + i * 1024 + lane * 16),
                                         (__attribute__((address_space(3))) unsigned*)(slot + i * 1024), 16, 0, 0);
#pragma unroll
    for (int i = 0; i < 4; ++i)
        __builtin_amdgcn_global_load_lds((const unsigned*)(Ng + u * 8192 + J * 4096 + i * 1024 + lane * 16),
                                         (__attribute__((address_space(3))) unsigned*)(slot + 8192 + i * 1024), 16, 0, 0);
    __builtin_amdgcn_global_load_lds((const unsigned*)(WLg + u * 256 + lane * 4),
                                     (__attribute__((address_space(3))) unsigned*)(slot + 12288), 4, 0, 0);
}
__device__ __forceinline__ unsigned lds_addr(const void* p) { return (unsigned)(size_t)(const __attribute__((address_space(3))) unsigned char*)p; }
template <int OFF> __device__ __forceinline__ void ldsr128(bf16x8& d, unsigned a) { asm volatile("ds_read_b128 %0, %1 offset:%2" : "=v"(d) : "v"(a), "n"(OFF)); }
template <int OFF> __device__ __forceinline__ void ldsr128f(float4& d, unsigned a) { asm volatile("ds_read_b128 %0, %1 offset:%2" : "=v"(d) : "v"(a), "n"(OFF)); }
template <int OFF> __device__ __forceinline__ void ldsr64(uint2& d, unsigned a) { asm volatile("ds_read_b64 %0, %1 offset:%2" : "=v"(d) : "v"(a), "n"(OFF)); }
template <int WAITN>
__device__ __forceinline__ void r2_step(f32x16 (&S)[2], const unsigned char* slot, bf16_t* so, int r, int h) {
    if (WAITN == 51) asm volatile("s_waitcnt vmcnt(51)" ::: "memory");
    else if (WAITN == 39) asm volatile("s_waitcnt vmcnt(39)" ::: "memory");
    else asm volatile("s_waitcnt vmcnt(0)" ::: "memory");
    uint2 nv[2][4]; float4 wl[2][4]; bf16x8 af[2][2][2];
    const unsigned sa = lds_addr(slot);
    {
        const unsigned aw = sa + 12288 + h * 16;
        ldsr128f<0>(wl[0][0], aw); ldsr128f<32>(wl[0][1], aw); ldsr128f<64>(wl[0][2], aw); ldsr128f<96>(wl[0][3], aw);
        ldsr128f<128>(wl[1][0], aw); ldsr128f<160>(wl[1][1], aw); ldsr128f<192>(wl[1][2], aw); ldsr128f<224>(wl[1][3], aw);
        const unsigned an = sa + 8192 + r * 128 + h * 8;
        const unsigned x0 = ((0 ^ (r & 7)) * 16), x1 = ((1 ^ (r & 7)) * 16), x2 = ((2 ^ (r & 7)) * 16), x3 = ((3 ^ (r & 7)) * 16);
        ldsr64<0>(nv[0][0], an + x0); ldsr64<0>(nv[0][1], an + x1); ldsr64<0>(nv[0][2], an + x2); ldsr64<0>(nv[0][3], an + x3);
        ldsr64<0>(nv[1][0], an + (x0 ^ 64)); ldsr64<0>(nv[1][1], an + (x1 ^ 64)); ldsr64<0>(nv[1][2], an + (x2 ^ 64)); ldsr64<0>(nv[1][3], an + (x3 ^ 64));
        const unsigned aa = sa + r * 128;
        const unsigned c00 = (((0 + h) ^ (r & 7)) * 16), c01 = (((2 + h) ^ (r & 7)) * 16), c10 = (((4 + h) ^ (r & 7)) * 16), c11 = (((6 + h) ^ (r & 7)) * 16);
        ldsr128<0>(af[0][0][0], aa + c00); ldsr128<0>(af[0][0][1], aa + c01); ldsr128<0>(af[0][1][0], aa + c10); ldsr128<0>(af[0][1][1], aa + c11);
        ldsr128<4096>(af[1][0][0], aa + c00); ldsr128<4096>(af[1][0][1], aa + c01); ldsr128<4096>(af[1][1][0], aa + c10); ldsr128<4096>(af[1][1][1], aa + c11);
    }
    unsigned pk[2][8];
#pragma unroll
    for (int K = 0; K < 2; ++K)
#pragma unroll
        for (int q = 0; q < 8; ++q) pk[K][q] = pack2(S[K][2 * q], S[K][2 * q + 1]);
#pragma unroll
    for (int I = 0; I < 2; ++I) {
        uint4 w0, w1;
        w0.x = pk[I][0]; w0.y = pk[I][1]; w0.z = pk[I][2]; w0.w = pk[I][3];
        w1.x = pk[I][4]; w1.y = pk[I][5]; w1.z = pk[I][6]; w1.w = pk[I][7];
        *reinterpret_cast<uint4*>(so + r * 64 + I * 32 + h * 16) = w0;
        *reinterpret_cast<uint4*>(so + r * 64 + I * 32 + h * 16 + 8) = w1;
    }
    asm volatile("s_waitcnt lgkmcnt(0)" ::: "memory");
    __builtin_amdgcn_sched_barrier(0);
    bf16x8 bfrag[2][2];
#pragma unroll
    for (int K = 0; K < 2; ++K)
#pragma unroll
        for (int s = 0; s < 2; ++s) {
            union { bf16x8 v; unsigned u[4]; } cvt;
#pragma unroll
            for (int q = 0; q < 4; ++q) cvt.u[q] = pk[K][4 * s + q];
            bfrag[K][s] = cvt.v;
        }
#pragma unroll
    for (int I = 0; I < 2; ++I) {
        f32x16 acc;
#pragma unroll
        for (int g = 0; g < 4; ++g) {
            acc[4 * g + 0] = __uint_as_float(nv[I][g].x << 16) + wl[I][g].x * S[I][4 * g + 0];
            acc[4 * g + 1] = __uint_as_float(nv[I][g].x & 0xffff0000u) + wl[I][g].y * S[I][4 * g + 1];
            acc[4 * g + 2] = __uint_as_float(nv[I][g].y << 16) + wl[I][g].z * S[I][4 * g + 2];
            acc[4 * g + 3] = __uint_as_float(nv[I][g].y & 0xffff0000u) + wl[I][g].w * S[I][4 * g + 3];
        }
#pragma unroll
        for (int K = 0; K < 2; ++K)
#pragma unroll
            for (int s = 0; s < 2; ++s) acc = __builtin_amdgcn_mfma_f32_32x32x16_bf16(af[I][K][s], bfrag[K][s], acc, 0, 0, 0);
        S[I] = acc;
    }
}
__device__ __forceinline__ void phase_rwkv_r2(const Params& p, unsigned char* smem) {
    const int tidx = otid(p.wave);
    if (obid() >= 64) { phase_pre(p, smem, 1, obid() - 64, ogdim() - 64); return; }
    if (p.wave != 0) return;
    const int task = obid(), bh = task >> 1, J = task & 1;
    const int lane = tidx & 63, r = lane & 31, h = lane >> 5;
    const unsigned char* Mg = p.ws + OFF_MB;
    const unsigned char* Ng = p.ws + OFF_NTB;
    const unsigned char* WLg = p.ws + OFF_WLB;
    f32x16 S[2];
#pragma unroll
    for (int i = 0; i < 16; ++i) { S[0][i] = 0.f; S[1][i] = 0.f; }
    const size_t ub = (size_t)bh * 128;
    r2_issue(Mg, Ng, WLg, ub + 0, J, lane, smem + 0 * R2_SLOT);
    r2_issue(Mg, Ng, WLg, ub + 1, J, lane, smem + 1 * R2_SLOT);
    r2_issue(Mg, Ng, WLg, ub + 2, J, lane, smem + 2 * R2_SLOT);
#define R2_STEP(n_, SL, W) do { \
        const int n2 = (n_); \
        if (n2 + 3 < 128) r2_issue(Mg, Ng, WLg, ub + n2 + 3, J, lane, smem + (((SL) + 3) & 3) * R2_SLOT); \
        r2_step<W>(S, smem + (SL) * R2_SLOT, s0_ptr(p.ws, (int)ub + n2) + (size_t)J * 32 * 64, r, h); } while (0)
    R2_STEP(0, 0, 39); R2_STEP(1, 1, 39); R2_STEP(2, 2, 39); R2_STEP(3, 3, 51);
#pragma unroll 1
    for (int n = 4; n < 124; n += 4) {
        R2_STEP(n, 0, 51); R2_STEP(n + 1, 1, 51); R2_STEP(n + 2, 2, 51); R2_STEP(n + 3, 3, 51);
    }
    R2_STEP(124, 0, 51); R2_STEP(125, 1, 0); R2_STEP(126, 2, 0); R2_STEP(127, 3, 0);
#undef R2_STEP
}

struct R3In { uint4 pr, s0; uint2 yq[2]; unsigned short v[8], g[8]; unsigned short pv; float bc[8]; };
__device__ __forceinline__ void r3_load(R3In& in, const Params& p, int u, int tid) {
    const int b = u >> 10, h = (u >> 7) & 7, n = u & 127;
    const int wv = tid >> 6, lane = tid & 63, fr = lane & 15, fq = lane >> 4, mt = wv >> 1, nt0 = (wv & 1) * 2;
    const size_t tok0 = (size_t)b * SEQ + n * 64;
    const bf16_t* PRg = reinterpret_cast<const bf16_t*>(p.ws + OFF_AA);
    const bf16_t* YQg = reinterpret_cast<const bf16_t*>(p.ws + OFF_LOGW);
    const bf16_t* GG = reinterpret_cast<const bf16_t*>(p.ws + OFF_GG);
    const bf16_t* P = reinterpret_cast<const bf16_t*>(p.ws + OFF_P);
    const float* BCg = reinterpret_cast<const float*>(p.ws + OFF_BCB);
    const int row = tid >> 3, ch = tid & 7;
    in.pr = *reinterpret_cast<const uint4*>(PRg + (tok0 + row) * 512 + h * 64 + ch * 8);
    in.s0 = reinterpret_cast<const uint4*>(s0_ptr(p.ws, u))[tid];
#pragma unroll
    for (int nn = 0; nn < 2; ++nn) in.yq[nn] = *reinterpret_cast<const uint2*>(YQg + (tok0 + (nt0 + nn) * 16 + fr) * 512 + h * 64 + mt * 16 + fq * 4);
    const int c = h * 64 + lane;
    const int s0i = n * 64 + wv * 8;
    in.pv = (s0i > 0) ? P[(tok0 + wv * 8 - 1) * 2304 + 1024 + c] : (unsigned short)0;
#pragma unroll
    for (int i = 0; i < 8; ++i) {
        in.v[i] = P[(tok0 + wv * 8 + i) * 2304 + 1024 + c];
        in.g[i] = GG[(tok0 + wv * 8 + i) * 512 + c];
        in.bc[i] = BCg[(size_t)u * 64 + wv * 8 + i];
    }
}
__device__ __forceinline__ void phase_rwkv_r3(const Params& p, unsigned char* smem) {
    const int tidx = otid(p.wave);
    const int tid = tidx, wv = tid >> 6, lane = tid & 63, fr = lane & 15, fq = lane >> 4, mt = wv >> 1, nt0 = (wv & 1) * 2;
    bf16_t* base = reinterpret_cast<bf16_t*>(smem);
    bf16_t* Prs = base; bf16_t* Sb = base + RC_BUF;
    float* Yf = reinterpret_cast<float*>(smem + 2 * RC_BYTES);
    bf16_t* YC = reinterpret_cast<bf16_t*>(p.ws + OFF_YCAT);
    R3In cur, nxt;
    if (obid() < 4096) r3_load(cur, p, obid(), tid);
    nxt = cur;
    for (int u = obid(); u < 4096; u += ogdim()) {
        const int b = u >> 10, h = (u >> 7) & 7, n = u & 127;
        const int c = h * 64 + lane;
        float mu_v = p.in[2][1024 + c], lng = p.in[11][c], lnb = p.in[12][c];
        asm volatile("" : "+v"(mu_v), "+v"(lng), "+v"(lnb));
        if (u + ogdim() < 4096) r3_load(nxt, p, u + ogdim(), tid);
        {
            const int row = tid >> 3, ch = tid & 7;
            *reinterpret_cast<uint4*>(Prs + row * RC_LD + ch * 8) = cur.pr;
            const int I = ch >> 2, hh = (ch >> 1) & 1, g0 = (ch & 1) * 2;
            const int k0 = I * 32 + 8 * g0 + 4 * hh;
            uint2 lo; lo.x = cur.s0.x; lo.y = cur.s0.y;
            uint2 hi; hi.x = cur.s0.z; hi.y = cur.s0.w;
            *reinterpret_cast<uint2*>(Sb + row * RC_LD + k0) = lo;
            *reinterpret_cast<uint2*>(Sb + row * RC_LD + k0 + 8) = hi;
        }
        lds_barrier();
        {
            f32x4 acc[2];
            zero_acc(acc);
            mm64(acc, Sb, Prs, mt, nt0, fr, fq);
#pragma unroll
            for (int nn = 0; nn < 2; ++nn) {
                const int C = (nt0 + nn) * 16 + fr, Rb = mt * 16 + fq * 4;
                const uint2 q = cur.yq[nn];
                float4 o;
                o.x = acc[nn][0] + __uint_as_float(q.x << 16); o.y = acc[nn][1] + __uint_as_float(q.x & 0xffff0000u);
                o.z = acc[nn][2] + __uint_as_float(q.y << 16); o.w = acc[nn][3] + __uint_as_float(q.y & 0xffff0000u);
                *reinterpret_cast<float4*>(Yf + C * 68 + Rb) = o;
            }
        }
        lds_barrier();
        {
            float pv = bf2f(cur.pv);
#pragma unroll
            for (int i = 0; i < 8; ++i) {
                const int t = wv * 8 + i;
                const size_t tok = (size_t)b * SEQ + n * 64 + t;
                const float y = Yf[t * 68 + lane];
                const float mean = wave_sum(y) * (1.0f / 64.0f);
                const float d = y - mean;
                const float var = wave_sum(d * d) * (1.0f / 64.0f);
                const float yn = d * rsqrtf(var + 64e-5f) * lng + lnb;
                const float g = bf2f(cur.g[i]);
                const float v0 = bf2f(cur.v[i]);
                const float vv = bf2f(f2bf(v0 + mu_v * (pv - v0)));
                pv = v0;
                YC[tok * 1024 + c] = f2bf((yn + cur.bc[i] * vv) * g);
            }
        }
        cur = nxt;
    }
}

#define LR_LD 1032
__device__ __forceinline__ void phase_ln_route(const Params& p, int layer, unsigned char* smem) {
    const bf16_t* X = reinterpret_cast<const bf16_t*>(p.ws + OFF_P);
    const int tidx = otid(p.wave);
    const int tid = tidx, wv = tid >> 6, lane = tid & 63, fr = lane & 15, fq = lane >> 4;
    const float* g = p.in[24] + layer * DM;
    const float* bb = p.in[25] + layer * DM;
    const float* rgb = p.in[27] + layer * 4;
    const float* reb = p.in[29] + layer * 32;
    const bf16_t* RH = reinterpret_cast<const bf16_t*>(p.ws + OFF_W) + WE_RT_HI + (size_t)layer * 48 * 1024;
    const bf16_t* RL = reinterpret_cast<const bf16_t*>(p.ws + OFF_W) + WE_RT_LO + (size_t)layer * 48 * 1024;
    bf16_t* XB = reinterpret_cast<bf16_t*>(p.ws + OFF_ACTB);
    int* cnt = reinterpret_cast<int*>(p.ws + OFF_CTRL) + layer * 32;
    int* ltok = reinterpret_cast<int*>(p.ws + OFF_LTOK);
    float* lgate = reinterpret_cast<float*>(p.ws + OFF_LGATE);
    bf16_t* sXH = reinterpret_cast<bf16_t*>(smem);
    bf16_t* sXL = sXH + 16 * LR_LD;
    float* sRed = reinterpret_cast<float*>(smem + 2 * 16 * LR_LD * 2);
    float* sLog = sRed + 8 * 16 * 48;
    bf16x8 bh[4][3], bl[4][3];
#pragma unroll
    for (int ks = 0; ks < 4; ++ks)
#pragma unroll
        for (int nt = 0; nt < 3; ++nt) {
            const int k0 = wv * 128 + ks * 32 + fq * 8;
            bh[ks][nt] = *reinterpret_cast<const bf16x8*>(RH + (size_t)(nt * 16 + fr) * 1024 + k0);
            bl[ks][nt] = *reinterpret_cast<const bf16x8*>(RL + (size_t)(nt * 16 + fr) * 1024 + k0);
        }
    float4 gg[4], bv[4];
#pragma unroll
    for (int i = 0; i < 4; ++i) {
        gg[i] = *reinterpret_cast<const float4*>(g + i * 256 + lane * 4);
        bv[i] = *reinterpret_cast<const float4*>(bb + i * 256 + lane * 4);
    }
    int* sCnt = reinterpret_cast<int*>(sLog + 16 * 48);
    int* sBase = sCnt + 32;
    int* sDecE = sBase + 32;
    int* sDecP = sDecE + 256;
    float* sDecG = reinterpret_cast<float*>(sDecP + 256);
    int* sDecR = reinterpret_cast<int*>(sDecG + 256);
    if (tid < 32) sCnt[tid] = 0;
    uint2 pre[2][4];
    {
        const int tile0 = obid();
        if (tile0 < NT / 16) {
#pragma unroll
            for (int rr = 0; rr < 2; ++rr)
#pragma unroll
                for (int i = 0; i < 4; ++i)
                    pre[rr][i] = *reinterpret_cast<const uint2*>(X + (size_t)(tile0 * 16 + wv * 2 + rr) * DM + i * 256 + lane * 4);
        }
    }
    __syncthreads();
    int nloc = 0;
    for (int tile = obid(); tile < NT / 16; tile += ogdim(), ++nloc) {
        uint2 cur[2][4];
#pragma unroll
        for (int rr = 0; rr < 2; ++rr)
#pragma unroll
            for (int i = 0; i < 4; ++i) cur[rr][i] = pre[rr][i];
        {
            const int tn = tile + ogdim();
            if (tn < NT / 16) {
#pragma unroll
                for (int rr = 0; rr < 2; ++rr)
#pragma unroll
                    for (int i = 0; i < 4; ++i)
                        pre[rr][i] = *reinterpret_cast<const uint2*>(X + (size_t)(tn * 16 + wv * 2 + rr) * DM + i * 256 + lane * 4);
            }
        }
#pragma unroll
        for (int rr = 0; rr < 2; ++rr) {
            const int rl = wv * 2 + rr;
            const int row = tile * 16 + rl;
            float v[16];
#pragma unroll
            for (int i = 0; i < 4; ++i) {
                const uint2 t = cur[rr][i];
                v[4 * i] = __uint_as_float(t.x << 16); v[4 * i + 1] = __uint_as_float(t.x & 0xffff0000u);
                v[4 * i + 2] = __uint_as_float(t.y << 16); v[4 * i + 3] = __uint_as_float(t.y & 0xffff0000u);
            }
            float sum = 0.f;
#pragma unroll
            for (int i = 0; i < 16; ++i) sum += v[i];
            const float mean = wave_sum(sum) * (1.0f / DM);
            float sq = 0.f;
#pragma unroll
            for (int i = 0; i < 16; ++i) { float d = v[i] - mean; sq += d * d; }
            const float rstd = rsqrtf(wave_sum(sq) * (1.0f / DM) + 1e-5f);
#pragma unroll
            for (int i = 0; i < 4; ++i) {
                const int col = i * 256 + lane * 4;
                const float o0 = (v[4 * i] - mean) * rstd * gg[i].x + bv[i].x;
                const float o1 = (v[4 * i + 1] - mean) * rstd * gg[i].y + bv[i].y;
                const float o2 = (v[4 * i + 2] - mean) * rstd * gg[i].z + bv[i].z;
                const float o3 = (v[4 * i + 3] - mean) * rstd * gg[i].w + bv[i].w;
                const bf16_t h0 = f2bf(o0), h1 = f2bf(o1), h2 = f2bf(o2), h3 = f2bf(o3);
                uint2 wh; wh.x = (unsigned)h0 | ((unsigned)h1 << 16); wh.y = (unsigned)h2 | ((unsigned)h3 << 16);
                *reinterpret_cast<uint2*>(XB + (size_t)row * DM + col) = wh;
                *reinterpret_cast<uint2*>(sXH + rl * LR_LD + col) = wh;
                uint2 wl; wl.x = pack2(o0 - bf2f(h0), o1 - bf2f(h1)); wl.y = pack2(o2 - bf2f(h2), o3 - bf2f(h3));
                *reinterpret_cast<uint2*>(sXL + rl * LR_LD + col) = wl;
            }
        }
        lds_barrier();
        {
            f32x4 acc[3];
#pragma unroll
            for (int nt = 0; nt < 3; ++nt) acc[nt] = (f32x4){0.f, 0.f, 0.f, 0.f};
#pragma unroll
            for (int ks = 0; ks < 4; ++ks) {
                const int k0 = wv * 128 + ks * 32 + fq * 8;
                const bf16x8 ah = *reinterpret_cast<const bf16x8*>(sXH + fr * LR_LD + k0);
                const bf16x8 al = *reinterpret_cast<const bf16x8*>(sXL + fr * LR_LD + k0);
#pragma unroll
                for (int nt = 0; nt < 3; ++nt) {
                    acc[nt] = __builtin_amdgcn_mfma_f32_16x16x32_bf16(ah, bh[ks][nt], acc[nt], 0, 0, 0);
                    acc[nt] = __builtin_amdgcn_mfma_f32_16x16x32_bf16(al, bh[ks][nt], acc[nt], 0, 0, 0);
                    acc[nt] = __builtin_amdgcn_mfma_f32_16x16x32_bf16(ah, bl[ks][nt], acc[nt], 0, 0, 0);
                }
            }
#pragma unroll
            for (int nt = 0; nt < 3; ++nt)
#pragma unroll
                for (int j = 0; j < 4; ++j) sRed[(wv * 16 + fq * 4 + j) * 48 + nt * 16 + fr] = acc[nt][j];
        }
        lds_barrier();
        for (int idx = tid; idx < 16 * 48; idx += NTHREADS) {
            float s = 0.f;
#pragma unroll
            for (int w = 0; w < 8; ++w) s += sRed[w * 16 * 48 + idx];
            sLog[idx] = s;
        }
        lds_barrier();
        if (tid < 16) {
            const int row = tile * 16 + tid;
            const float* lg = sLog + tid * 48;
            float gl[4];
#pragma unroll
            for (int j = 0; j < 4; ++j) gl[j] = lg[j] + rgb[j];
            int gi = 0; float gm = gl[0];
#pragma unroll
            for (int j = 1; j < 4; ++j) if (gl[j] > gm) { gm = gl[j]; gi = j; }
            float gs = 0.f;
#pragma unroll
            for (int j = 0; j < 4; ++j) gs += __expf(gl[j] - gm);
            const float gw = 1.0f / gs;
            float el[8];
#pragma unroll
            for (int j = 0; j < 8; ++j) el[j] = lg[4 + gi * 8 + j] + reb[gi * 8 + j];
            int i1 = 0; float m1 = el[0];
#pragma unroll
            for (int j = 1; j < 8; ++j) if (el[j] > m1) { m1 = el[j]; i1 = j; }
            int i2 = (i1 == 0) ? 1 : 0; float m2 = el[i2];
#pragma unroll
            for (int j = 0; j < 8; ++j) if (j != i1 && el[j] > m2) { m2 = el[j]; i2 = j; }
            const float e2 = __expf(m2 - m1);
            const float p1 = 1.0f / (1.0f + e2), p2 = e2 / (1.0f + e2);
            const int ex1 = gi * 8 + i1, ex2 = gi * 8 + i2;
            const int d0 = (nloc * 16 + tid) * 2;
            sDecE[d0] = ex1; sDecP[d0] = atomicAdd(&sCnt[ex1], 1); sDecG[d0] = gw * p1; sDecR[d0] = row * 2;
            sDecE[d0 + 1] = ex2; sDecP[d0 + 1] = atomicAdd(&sCnt[ex2], 1); sDecG[d0 + 1] = gw * p2; sDecR[d0 + 1] = row * 2 + 1;
        }
    }
    __syncthreads();
    if (tid < 32) sBase[tid] = atomicAdd(&cnt[tid], sCnt[tid]);
    __syncthreads();
    if (tid < nloc * 32) {
        const int ex = sDecE[tid];
        const size_t pos = (size_t)ex * NT + sBase[ex] + sDecP[tid];
        ltok[pos] = sDecR[tid];
        lgate[pos] = sDecG[tid];
    }
    __syncthreads();
}

__device__ __forceinline__ void phase_exp1(const Params& p, int layer, bf16_t* smem) {
    const int* cnt = reinterpret_cast<const int*>(p.ws + OFF_CTRL) + layer * 32;
    const int* ltok = reinterpret_cast<const int*>(p.ws + OFF_LTOK);
    const bf16_t* XB = reinterpret_cast<const bf16_t*>(p.ws + OFF_ACTB);
    const bf16_t* W13 = reinterpret_cast<const bf16_t*>(p.ws + OFF_W) + WE_W13 + (size_t)layer * 32 * 262144;
    bf16_t* H = reinterpret_cast<bf16_t*>(p.ws + OFF_HBUF);
    int t = obid();
    int base = 0, tbase = 0;
    for (int e = 0; e < 32; ++e) {
        int c = cnt[e];
        int nt = ((c + 255) >> 8) * 2;
        while (t < tbase + nt) {
            int w = t - tbase;
            EpiExp1 epi{H, base, c};
            gemm_tile<true>(XB, DM, ltok + (size_t)e * NT, c, W13 + (size_t)e * 262144, DM, DM, (w >> 1) * 256, (w & 1) * 128, epi, smem, p.wave);
            t += ogdim();
        }
        tbase += nt; base += c;
    }
}
__device__ __forceinline__ void phase_exp2(const Params& p, int layer, bf16_t* smem) {
    const int* cnt = reinterpret_cast<const int*>(p.ws + OFF_CTRL) + layer * 32;
    const int* ltok = reinterpret_cast<const int*>(p.ws + OFF_LTOK);
    const float* lgate = reinterpret_cast<const float*>(p.ws + OFF_LGATE);
    const bf16_t* W2 = reinterpret_cast<const bf16_t*>(p.ws + OFF_W) + WE_W2 + (size_t)layer * 32 * 131072;
    const bf16_t* H = reinterpret_cast<const bf16_t*>(p.ws + OFF_HBUF);
    bf16_t* FS = reinterpret_cast<bf16_t*>(p.ws + OFF_FS);
    int t = obid();
    int base = 0, tbase = 0;
    for (int e = 0; e < 32; ++e) {
        int c = cnt[e];
        int nt = ((c + 255) >> 8) * 8;
        while (t < tbase + nt) {
            int w = t - tbase;
            EpiExp2 epi;
            epi.FS = FS; epi.cnt = c;
            {
                const int tq = otid(p.wave), wq = tq >> 6, lq = tq & 63;
#pragma unroll
                for (int m = 0; m < 4; ++m) {
                    int li = (w >> 3) * 256 + (wq >> 1) * 64 + m * 16 + (lq & 15);
                    li = li < c ? li : c - 1;
                    epi.pk[m] = ltok[(size_t)e * NT + li]; epi.g[m] = lgate[(size_t)e * NT + li];
                }
            }
            gemm_tile<false>(H + (size_t)base * 128, 128, nullptr, 0, W2 + (size_t)e * 131072, 128, 128, (w >> 3) * 256, (w & 7) * 128, epi, smem, p.wave);
            t += ogdim();
        }
        tbase += nt; base += c;
    }
}

__device__ __forceinline__ void phase_ln_ffn(const Params& p, int layer, float* Xout, bool last) {
    const int tidx = otid(p.wave);
    const int tid = tidx, wv = tid >> 6, lane = tid & 63;
    const float* g = p.in[33] + layer * DM;
    const float* bb = p.in[34] + layer * DM;
    const bf16_t* FS = reinterpret_cast<const bf16_t*>(p.ws + OFF_FS);
    bf16_t* XB = reinterpret_cast<bf16_t*>(p.ws + OFF_ACTB);
    float4 gg[4], bv[4];
#pragma unroll
    for (int i = 0; i < 4; ++i) {
        gg[i] = *reinterpret_cast<const float4*>(g + i * 256 + lane * 4);
        bv[i] = *reinterpret_cast<const float4*>(bb + i * 256 + lane * 4);
    }
    asm volatile("" : "+v"(gg[0].x), "+v"(bv[3].w));
    const int row0 = obid() * NWAVES + wv, rstep = ogdim() * NWAVES;
    uint2 pt[4], pf0[4], pf1[4];
    if (row0 < NT) {
#pragma unroll
        for (int i = 0; i < 4; ++i) {
            const int col = i * 256 + lane * 4;
            pt[i] = *reinterpret_cast<const uint2*>(XB + (size_t)row0 * DM + col);
            pf0[i] = *reinterpret_cast<const uint2*>(FS + (size_t)row0 * DM + col);
            pf1[i] = *reinterpret_cast<const uint2*>(FS + ((size_t)NT + row0) * DM + col);
        }
    }
    for (int row = row0; row < NT; row += rstep) {
        uint2 t[4], f0[4], f1[4];
#pragma unroll
        for (int i = 0; i < 4; ++i) { t[i] = pt[i]; f0[i] = pf0[i]; f1[i] = pf1[i]; }
        if (row + rstep < NT) {
            const size_t rn = (size_t)(row + rstep);
#pragma unroll
            for (int i = 0; i < 4; ++i) {
                const int col = i * 256 + lane * 4;
                pt[i] = *reinterpret_cast<const uint2*>(XB + rn * DM + col);
                pf0[i] = *reinterpret_cast<const uint2*>(FS + rn * DM + col);
                pf1[i] = *reinterpret_cast<const uint2*>(FS + ((size_t)NT + rn) * DM + col);
            }
        }
        float v[16];
#pragma unroll
        for (int i = 0; i < 4; ++i) {
            v[4 * i] = ALPHA_F * __uint_as_float(t[i].x << 16) + __uint_as_float(f0[i].x << 16) + __uint_as_float(f1[i].x << 16);
            v[4 * i + 1] = ALPHA_F * __uint_as_float(t[i].x & 0xffff0000u) + __uint_as_float(f0[i].x & 0xffff0000u) + __uint_as_float(f1[i].x & 0xffff0000u);
            v[4 * i + 2] = ALPHA_F * __uint_as_float(t[i].y << 16) + __uint_as_float(f0[i].y << 16) + __uint_as_float(f1[i].y << 16);
            v[4 * i + 3] = ALPHA_F * __uint_as_float(t[i].y & 0xffff0000u) + __uint_as_float(f0[i].y & 0xffff0000u) + __uint_as_float(f1[i].y & 0xffff0000u);
        }
        float sum = 0.f;
#pragma unroll
        for (int i = 0; i < 16; ++i) sum += v[i];
        float mean = wave_sum(sum) * (1.0f / DM);
        float sq = 0.f;
#pragma unroll
        for (int i = 0; i < 16; ++i) { float d = v[i] - mean; sq += d * d; }
        float rstd = rsqrtf(wave_sum(sq) * (1.0f / DM) + 1e-5f);
#pragma unroll
        for (int i = 0; i < 4; ++i) {
            int col = i * 256 + lane * 4;
            float o0 = (v[4 * i] - mean) * rstd * gg[i].x + bv[i].x;
            float o1 = (v[4 * i + 1] - mean) * rstd * gg[i].y + bv[i].y;
            float o2 = (v[4 * i + 2] - mean) * rstd * gg[i].z + bv[i].z;
            float o3 = (v[4 * i + 3] - mean) * rstd * gg[i].w + bv[i].w;
            if (last) {
                *reinterpret_cast<float4*>(Xout + (size_t)row * DM + col) = make_float4(o0, o1, o2, o3);
            } else {
                uint2 w; w.x = pack2(o0, o1); w.y = pack2(o2, o3);
                *reinterpret_cast<uint2*>(XB + (size_t)row * DM + col) = w;
            }
        }
    }
}

#define CV_T 64
#define CV_ROWS (CV_T + 30)
template <int OB>
__device__ __forceinline__ void conv_blk(float (&acc)[CV_T], const bf16_t* sU, int tid, const float (&w0)[31]) {
#pragma unroll
    for (int rr = 0; rr < 38; ++rr) {
        const float uv = bf2f(sU[(OB * 8 + rr) * 512 + tid]);
#pragma unroll
        for (int oo = 0; oo < 8; ++oo) {
            const int j = rr - oo;
            if (j >= 0 && j <= 30) acc[OB * 8 + oo] += uv * w0[j];
        }
    }
}
__device__ __forceinline__ void phase_l1_conv(const Params& p, unsigned char* smem) {
    const int tidx = otid(p.wave);
    const bf16_t* P = reinterpret_cast<const bf16_t*>(p.ws + OFF_P);
    bf16_t* YC = reinterpret_cast<bf16_t*>(p.ws + OFF_YCAT);
    bf16_t* sU = reinterpret_cast<bf16_t*>(smem);
    float* red = reinterpret_cast<float*>(smem + CV_ROWS * 512 * 2);
    float* stat = red + 8 * 64 * 2;
    const int tid = tidx, wv = tid >> 6, lane = tid & 63;
    const float* cw = p.in[17];
    float w0[31];
#pragma unroll
    for (int j = 0; j < 31; ++j) w0[j] = cw[j * 512 + tid];
    const float cb0 = p.in[18][tid], g0 = p.in[19][tid], b0 = p.in[20][tid];
    for (int u = obid(); u < NT / CV_T; u += ogdim()) {
        const int t0 = u * CV_T;
        const int s0 = t0 & (SEQ - 1);
#pragma unroll 1
        for (int base = 0; base < CV_ROWS * 64; base += 6 * NTHREADS) {
            uint4 av[6], gv[6];
#pragma unroll
            for (int j = 0; j < 6; ++j) {
                const int it = base + j * NTHREADS + tid;
                const int r = it >> 6, c8 = (it & 63) * 8;
                av[j] = make_uint4(0u, 0u, 0u, 0u); gv[j] = av[j];
                if (it < CV_ROWS * 64 && s0 - 30 + r >= 0) {
                    const bf16_t* pr = P + (size_t)(t0 - 30 + r) * 3072 + c8;
                    av[j] = *reinterpret_cast<const uint4*>(pr);
                    gv[j] = *reinterpret_cast<const uint4*>(pr + 512);
                }
            }
#pragma unroll
            for (int j = 0; j < 6; ++j) {
                const int it = base + j * NTHREADS + tid;
                if (it < CV_ROWS * 64) {
                    const int r = it >> 6, c8 = (it & 63) * 8;
                    float a[8], gte[8];
                    unpack8(av[j], a); unpack8(gv[j], gte);
#pragma unroll
                    for (int i = 0; i < 8; ++i) a[i] = a[i] * sigmoidf_(gte[i]);
                    uint4 w;
                    w.x = pack2(a[0], a[1]); w.y = pack2(a[2], a[3]); w.z = pack2(a[4], a[5]); w.w = pack2(a[6], a[7]);
                    *reinterpret_cast<uint4*>(sU + r * 512 + c8) = w;
                }
            }
        }
        __syncthreads();
        float acc[CV_T];
#pragma unroll
        for (int o = 0; o < CV_T; ++o) acc[o] = cb0;
        conv_blk<0>(acc, sU, tid, w0); conv_blk<1>(acc, sU, tid, w0); conv_blk<2>(acc, sU, tid, w0); conv_blk<3>(acc, sU, tid, w0);
        conv_blk<4>(acc, sU, tid, w0); conv_blk<5>(acc, sU, tid, w0); conv_blk<6>(acc, sU, tid, w0); conv_blk<7>(acc, sU, tid, w0);
#pragma unroll
        for (int o = 0; o < CV_T; ++o) {
            const float s1 = wave_sum(acc[o]);
            const float s2 = wave_sum(acc[o] * acc[o]);
            if (lane == 0) { red[(wv * 64 + o) * 2] = s1; red[(wv * 64 + o) * 2 + 1] = s2; }
        }
        __syncthreads();
        if (tid < 64) {
            float s1 = 0.f, s2 = 0.f;
#pragma unroll
            for (int w = 0; w < 8; ++w) { s1 += red[(w * 64 + tid) * 2]; s2 += red[(w * 64 + tid) * 2 + 1]; }
            const float mean = s1 * (1.0f / 512.0f);
            const float var = fmaxf(s2 * (1.0f / 512.0f) - mean * mean, 0.f);
            stat[tid * 2] = mean; stat[tid * 2 + 1] = rsqrtf(var + 1e-5f);
        }
        __syncthreads();
#pragma unroll
        for (int o = 0; o < CV_T; ++o) {
            const float mean = stat[o * 2], rstd = stat[o * 2 + 1];
            const float y0 = (acc[o] - mean) * rstd * g0 + b0;
            YC[(size_t)(t0 + o) * 1024 + tid] = f2bf(siluf_(y0));
        }
    }
}

__device__ __forceinline__ float ret_lg(int h) { return log1pf(-exp2f(-5.0f - (float)h)); }

#define KT_LD 136
struct RetIn { uint4 k1, k2, v1, v2; };
__device__ __forceinline__ void ret_load_kv(RetIn& in, const bf16_t* P, int u, int tid) {
    const int n = u & 63, h = (u >> 6) & 7, b = u >> 9;
    const int c = tid >> 2, i0 = (tid & 3) * 8;
    const size_t tok = (size_t)b * SEQ + n * 128 + c;
    const bf16_t* kr = P + tok * 3072 + 1536 + h * 64;
    const bf16_t* vr = P + tok * 3072 + 2048 + h * 64;
    in.k1 = *reinterpret_cast<const uint4*>(kr + i0); in.k2 = *reinterpret_cast<const uint4*>(kr + 32 + i0);
    in.v1 = *reinterpret_cast<const uint4*>(vr + i0); in.v2 = *reinterpret_cast<const uint4*>(vr + 32 + i0);
}
__device__ __forceinline__ void st_col8(bf16_t* dst, int ld, const uint4 v) {
    dst[0 * ld] = (bf16_t)(v.x & 0xffffu); dst[1 * ld] = (bf16_t)(v.x >> 16);
    dst[2 * ld] = (bf16_t)(v.y & 0xffffu); dst[3 * ld] = (bf16_t)(v.y >> 16);
    dst[4 * ld] = (bf16_t)(v.z & 0xffffu); dst[5 * ld] = (bf16_t)(v.z >> 16);
    dst[6 * ld] = (bf16_t)(v.w & 0xffffu); dst[7 * ld] = (bf16_t)(v.w >> 16);
}
__device__ __forceinline__ void phase_ret_kv(const Params& p, unsigned char* smem) {
    const int tidx = otid(p.wave);
    const bf16_t* P = reinterpret_cast<const bf16_t*>(p.ws + OFF_P);
    const float2* rope = reinterpret_cast<const float2*>(p.ws + OFF_ROPE);
    float* KVT = reinterpret_cast<float*>(p.ws + OFF_KVT);
    bf16_t* sKT = reinterpret_cast<bf16_t*>(smem);
    bf16_t* sVT = sKT + 64 * KT_LD;
    const int tid = tidx, wv = tid >> 6, lane = tid & 63, fr = lane & 15, fq = lane >> 4;
    const int et = wv >> 1, dt0 = (wv & 1) * 2;
    RetIn cur, nxt;
    if (obid() < 2048) ret_load_kv(cur, P, obid(), tid);
    nxt = cur;
    for (int u = obid(); u < 2048; u += ogdim()) {
        const int n = u & 63, h = (u >> 6) & 7;
        const float lg = ret_lg(h);
        const int c = tid >> 2, i0 = (tid & 3) * 8;
        const int sidx = n * 128 + c;
        float2 cs[8];
#pragma unroll
        for (int i = 0; i < 8; ++i) cs[i] = rope[sidx * 32 + i0 + i];
        asm volatile("" : "+v"(cs[0].x), "+v"(cs[7].y));
        if (u + ogdim() < 2048) ret_load_kv(nxt, P, u + ogdim(), tid);
        {
            const float zeta = __expf((float)(127 - c) * lg) * 0.125f;
            float k1[8], k2[8];
            unpack8(cur.k1, k1); unpack8(cur.k2, k2);
#pragma unroll
            for (int i = 0; i < 8; ++i) {
                float o1 = (k1[i] * cs[i].x - k2[i] * cs[i].y) * zeta, o2 = (k1[i] * cs[i].y + k2[i] * cs[i].x) * zeta;
                sKT[(i0 + i) * KT_LD + c] = f2bf(o1);
                sKT[(32 + i0 + i) * KT_LD + c] = f2bf(o2);
            }
            st_col8(sVT + i0 * KT_LD + c, KT_LD, cur.v1);
            st_col8(sVT + (32 + i0) * KT_LD + c, KT_LD, cur.v2);
        }
        lds_barrier();
        f32x4 acc[2];
        acc[0] = (f32x4){0.f, 0.f, 0.f, 0.f}; acc[1] = (f32x4){0.f, 0.f, 0.f, 0.f};
#pragma unroll
        for (int ks = 0; ks < 4; ++ks) {
            bf16x8 af = *reinterpret_cast<const bf16x8*>(sVT + (et * 16 + fr) * KT_LD + ks * 32 + fq * 8);
#pragma unroll
            for (int nn = 0; nn < 2; ++nn) {
                bf16x8 bfr = *reinterpret_cast<const bf16x8*>(sKT + ((dt0 + nn) * 16 + fr) * KT_LD + ks * 32 + fq * 8);
                acc[nn] = __builtin_amdgcn_mfma_f32_16x16x32_bf16(af, bfr, acc[nn], 0, 0, 0);
            }
        }
        float* o = KVT + (size_t)u * 4096;
#pragma unroll
        for (int nn = 0; nn < 2; ++nn)
#pragma unroll
            for (int j = 0; j < 4; ++j) o[(et * 16 + fq * 4 + j) * 64 + (dt0 + nn) * 16 + fr] = acc[nn][j];
        cur = nxt;
        lds_barrier();
    }
}
__device__ __forceinline__ void phase_ret_scan(const Params& p) {
    const int tidx = otid(p.wave);
    float* KVT = reinterpret_cast<float*>(p.ws + OFF_KVT);
    for (int i = obid() * NTHREADS + tidx; i < 32 * 4096; i += ogdim() * NTHREADS) {
        int bh = i >> 12, ed = i & 4095, h = bh & 7;
        float gc = __expf(128.0f * ret_lg(h));
        float R = 0.f;
        float* q = KVT + (size_t)bh * 64 * 4096 + ed;
#pragma unroll 1
        for (int n0 = 0; n0 < 64; n0 += 16) {
            float kv[16];
#pragma unroll
            for (int j = 0; j < 16; ++j) kv[j] = q[(size_t)(n0 + j) * 4096];
#pragma unroll
            for (int j = 0; j < 16; ++j) { q[(size_t)(n0 + j) * 4096] = R; R = gc * R + kv[j]; }
        }
    }
}
#define Q_LD 72
struct RetOutIn { uint4 q1, q2, k1, k2, v1, v2; float4 r0, r1; unsigned short gr[16]; };
__device__ __forceinline__ void ret_load_out(RetOutIn& in, const bf16_t* P, const float* KVT, int u, int tid) {
    const int n = u & 63, h = (u >> 6) & 7, b = u >> 9;
    const int c = tid >> 2, i0 = (tid & 3) * 8;
    const size_t tok = (size_t)b * SEQ + n * 128 + c;
    const bf16_t* qr = P + tok * 3072 + 1024 + h * 64;
    in.q1 = *reinterpret_cast<const uint4*>(qr + i0); in.q2 = *reinterpret_cast<const uint4*>(qr + 32 + i0);
    in.k1 = *reinterpret_cast<const uint4*>(qr + 512 + i0); in.k2 = *reinterpret_cast<const uint4*>(qr + 512 + 32 + i0);
    in.v1 = *reinterpret_cast<const uint4*>(qr + 1024 + i0); in.v2 = *reinterpret_cast<const uint4*>(qr + 1024 + 32 + i0);
    const float* rp = KVT + (size_t)u * 4096 + tid * 8;
    in.r0 = *reinterpret_cast<const float4*>(rp); in.r1 = *reinterpret_cast<const float4*>(rp + 4);
    const int wv = tid >> 6, lane = tid & 63, fr = lane & 15, fq = lane >> 4;
#pragma unroll
    for (int j = 0; j < 4; ++j)
#pragma unroll
        for (int nn = 0; nn < 4; ++nn)
            in.gr[j * 4 + nn] = P[((size_t)b * SEQ + n * 128 + wv * 16 + fq * 4 + j) * 3072 + 2560 + h * 64 + nn * 16 + fr];
}
__device__ __forceinline__ void phase_ret_out(const Params& p, unsigned char* smem) {
    const int tidx = otid(p.wave);
    const bf16_t* P = reinterpret_cast<const bf16_t*>(p.ws + OFF_P);
    const float2* rope = reinterpret_cast<const float2*>(p.ws + OFF_ROPE);
    const float* KVT = reinterpret_cast<const float*>(p.ws + OFF_KVT);
    bf16_t* YC = reinterpret_cast<bf16_t*>(p.ws + OFF_YCAT);
    bf16_t* sQ = reinterpret_cast<bf16_t*>(smem);
    bf16_t* sK = sQ + 128 * Q_LD;
    bf16_t* sVT = sK + 128 * Q_LD;
    bf16_t* sRT = sVT + 64 * KT_LD;
    bf16_t* sS = sQ;
    const int tid = tidx, wv = tid >> 6, lane = tid & 63, fr = lane & 15, fq = lane >> 4;
    RetOutIn cur, nxt;
    if (obid() < 2048) ret_load_out(cur, P, KVT, obid(), tid);
    nxt = cur;
    for (int u = obid(); u < 2048; u += ogdim()) {
        const int n = u & 63, h = (u >> 6) & 7, b = u >> 9;
        const float lg = ret_lg(h);
        const int c = tid >> 2, i0 = (tid & 3) * 8;
        const int sidx = n * 128 + c;
        float2 cs[8];
#pragma unroll
        for (int i = 0; i < 8; ++i) cs[i] = rope[sidx * 32 + i0 + i];
        float gng[4], gnb[4];
#pragma unroll
        for (int nn = 0; nn < 4; ++nn) { gng[nn] = p.in[21][h * 64 + nn * 16 + fr]; gnb[nn] = p.in[22][h * 64 + nn * 16 + fr]; }
        asm volatile("" : "+v"(cs[0].x), "+v"(cs[7].y), "+v"(gng[0]), "+v"(gnb[3]));
        if (u + ogdim() < 2048) ret_load_out(nxt, P, KVT, u + ogdim(), tid);
        {
            float qa[8], qb[8], ka[8], kb[8];
            float q1[8], q2[8], k1[8], k2[8];
            unpack8(cur.q1, q1); unpack8(cur.q2, q2); unpack8(cur.k1, k1); unpack8(cur.k2, k2);
#pragma unroll
            for (int i = 0; i < 8; ++i) {
                qa[i] = q1[i] * cs[i].x - q2[i] * cs[i].y; qb[i] = q1[i] * cs[i].y + q2[i] * cs[i].x;
                ka[i] = (k1[i] * cs[i].x - k2[i] * cs[i].y) * 0.125f; kb[i] = (k1[i] * cs[i].y + k2[i] * cs[i].x) * 0.125f;
            }
            st_col8(sVT + i0 * KT_LD + c, KT_LD, cur.v1);
            st_col8(sVT + (32 + i0) * KT_LD + c, KT_LD, cur.v2);
            uint4 w;
            w.x = pack2(qa[0], qa[1]); w.y = pack2(qa[2], qa[3]); w.z = pack2(qa[4], qa[5]); w.w = pack2(qa[6], qa[7]);
            *reinterpret_cast<uint4*>(sQ + c * Q_LD + i0) = w;
            w.x = pack2(qb[0], qb[1]); w.y = pack2(qb[2], qb[3]); w.z = pack2(qb[4], qb[5]); w.w = pack2(qb[6], qb[7]);
            *reinterpret_cast<uint4*>(sQ + c * Q_LD + 32 + i0) = w;
            w.x = pack2(ka[0], ka[1]); w.y = pack2(ka[2], ka[3]); w.z = pack2(ka[4], ka[5]); w.w = pack2(ka[6], ka[7]);
            *reinterpret_cast<uint4*>(sK + c * Q_LD + i0) = w;
            w.x = pack2(kb[0], kb[1]); w.y = pack2(kb[2], kb[3]); w.z = pack2(kb[4], kb[5]); w.w = pack2(kb[6], kb[7]);
            *reinterpret_cast<uint4*>(sK + c * Q_LD + 32 + i0) = w;
            w.x = pack2(cur.r0.x, cur.r0.y); w.y = pack2(cur.r0.z, cur.r0.w); w.z = pack2(cur.r1.x, cur.r1.y); w.w = pack2(cur.r1.z, cur.r1.w);
            *reinterpret_cast<uint4*>(sRT + (tid >> 3) * Q_LD + (tid & 7) * 8) = w;
        }
        lds_barrier();
        f32x4 accs[8], accc[4];
#pragma unroll
        for (int nn = 0; nn < 8; ++nn) accs[nn] = (f32x4){0.f, 0.f, 0.f, 0.f};
#pragma unroll
        for (int nn = 0; nn < 4; ++nn) accc[nn] = (f32x4){0.f, 0.f, 0.f, 0.f};
#pragma unroll
        for (int ks = 0; ks < 2; ++ks) {
            bf16x8 af = *reinterpret_cast<const bf16x8*>(sQ + (wv * 16 + fr) * Q_LD + ks * 32 + fq * 8);
#pragma unroll
            for (int nn = 0; nn < 8; ++nn) {
                bf16x8 bfr = *reinterpret_cast<const bf16x8*>(sK + (nn * 16 + fr) * Q_LD + ks * 32 + fq * 8);
                accs[nn] = __builtin_amdgcn_mfma_f32_16x16x32_bf16(af, bfr, accs[nn], 0, 0, 0);
            }
#pragma unroll
            for (int nn = 0; nn < 4; ++nn) {
                bf16x8 bfr = *reinterpret_cast<const bf16x8*>(sRT + (nn * 16 + fr) * Q_LD + ks * 32 + fq * 8);
                accc[nn] = __builtin_amdgcn_mfma_f32_16x16x32_bf16(af, bfr, accc[nn], 0, 0, 0);
            }
        }
        lds_barrier();
        bf16_t* mS = sS + wv * 16 * KT_LD;
        {
            float e1[4], e1m[4];
#pragma unroll
            for (int j = 0; j < 4; ++j) {
                e1[j] = __expf((float)(fq * 4 + j - fr) * lg);
                e1m[j] = (fq * 4 + j >= fr) ? e1[j] : 0.f;
            }
#pragma unroll
            for (int nn = 0; nn < 8; ++nn) {
                const float e2 = (nn < wv) ? __expf((float)(16 * (wv - nn)) * lg) : 0.f;
                const bool diag = (nn == wv);
                float v[4];
#pragma unroll
                for (int j = 0; j < 4; ++j) v[j] = accs[nn][j] * (diag ? e1m[j] : e2 * e1[j]);
#pragma unroll
                for (int j = 0; j < 4; ++j) mS[(fq * 4 + j) * KT_LD + nn * 16 + fr] = f2bf(v[j]);
            }
        }
        lds_barrier();
        f32x4 acco[4];
#pragma unroll
        for (int nn = 0; nn < 4; ++nn) acco[nn] = (f32x4){0.f, 0.f, 0.f, 0.f};
#pragma unroll
        for (int ks = 0; ks < 4; ++ks) {
            bf16x8 af = *reinterpret_cast<const bf16x8*>(mS + fr * KT_LD + ks * 32 + fq * 8);
#pragma unroll
            for (int nn = 0; nn < 4; ++nn) {
                bf16x8 bfr = *reinterpret_cast<const bf16x8*>(sVT + (nn * 16 + fr) * KT_LD + ks * 32 + fq * 8);
                acco[nn] = __builtin_amdgcn_mfma_f32_16x16x32_bf16(af, bfr, acco[nn], 0, 0, 0);
            }
        }
#pragma unroll
        for (int j = 0; j < 4; ++j) {
            int ig = wv * 16 + fq * 4 + j;
            float xi = __expf((float)(ig + 1) * lg);
            float o[4];
            float sm = 0.f;
#pragma unroll
            for (int nn = 0; nn < 4; ++nn) { o[nn] = acco[nn][j] + xi * accc[nn][j]; sm += o[nn]; }
            sm = row16_sum(sm);
            float mean = sm * (1.0f / 64.0f);
            float sq = 0.f;
#pragma unroll
            for (int nn = 0; nn < 4; ++nn) { float d = o[nn] - mean; sq += d * d; }
            sq = row16_sum(sq);
            float rstd = rsqrtf(sq * (1.0f / 64.0f) + 1e-5f);
            size_t tok = (size_t)b * SEQ + n * 128 + ig;
#pragma unroll
            for (int nn = 0; nn < 4; ++nn) {
                int e = h * 64 + nn * 16 + fr;
                float y = (o[nn] - mean) * rstd * gng[nn] + gnb[nn];
                float gr = bf2f(cur.gr[j * 4 + nn]);
                YC[tok * 1024 + 512 + e] = f2bf(siluf_(gr) * y);
            }
        }
        cur = nxt;
        lds_barrier();
    }
}

#define XB_TMO      128
#define XB_XCNT(j)  (256  + 64 * (j))
#define XB_XSUB(j)  (1280 + 64 * (j))
#define XB_XGEN(j)  (2304 + 64 * (j))
#define XB_TOP      3328
#define XB_TOPGEN   3392
#define XB_SPIN_CAP (1u << 18)

__device__ __forceinline__ unsigned xb_ld(unsigned* p)              { return __hip_atomic_load(p, __ATOMIC_RELAXED, __HIP_MEMORY_SCOPE_AGENT); }
__device__ __forceinline__ unsigned xb_add(unsigned* p, unsigned v) { return __hip_atomic_fetch_add(p, v, __ATOMIC_RELAXED, __HIP_MEMORY_SCOPE_AGENT); }
__device__ __forceinline__ unsigned xb_xcc_id() { return (unsigned)__builtin_amdgcn_s_getreg((3 << 11) | 20) & 0xFu; }
#define XB_SPIN(cond, bar) do { unsigned _sp = 0; while (cond) { __builtin_amdgcn_s_sleep(1); \
    if ((++_sp & 255u) == 0u) { if (xb_ld(&(bar)[XB_TMO])) break; if (_sp > XB_SPIN_CAP) { atomicAdd(&(bar)[XB_TMO], 1u); break; } } } } while (0)

struct XcdBarrier {
    unsigned* bar; unsigned x;
    volatile __attribute__((address_space(3))) unsigned* st;
};

__device__ __forceinline__ XcdBarrier xcd_barrier_post(unsigned* bar, volatile __attribute__((address_space(3))) unsigned* st, int tid) {
    XcdBarrier b; b.bar = bar; b.x = xb_xcc_id(); b.st = st;
    if (tid == 0) (void)xb_add(&bar[XB_XCNT(b.x)], 1u);
    return b;
}
__device__ __forceinline__ void xcd_barrier_complete(unsigned* bar, unsigned x, unsigned& nloc, unsigned& nx) {
    const unsigned G = (unsigned)ogdim();
    unsigned sum, cnt, mine, sp = 0u;
    for (;;) {
        sum = 0u; cnt = 0u; mine = 0u;
#pragma unroll
        for (unsigned j = 0; j < 16; ++j) { const unsigned c = xb_ld(&bar[XB_XCNT(j)]); sum += c; cnt += (c > 0u) ? 1u : 0u; mine = (j == x) ? c : mine; }
        if (sum == G) break;
        __builtin_amdgcn_s_sleep(1);
        if ((++sp & 255u) == 0u) { if (xb_ld(&bar[XB_TMO])) break; if (sp > XB_SPIN_CAP) { atomicAdd(&bar[XB_TMO], 1u); break; } }
    }
    nloc = mine > 0u ? mine : 1u; nx = cnt > 0u ? cnt : 1u;
}

__device__ __forceinline__ void xcd_barrier(const XcdBarrier& b, int tid) {
    asm volatile("s_waitcnt vmcnt(0)" ::: "memory");
    __syncthreads();
    if (tid == 0) {
        unsigned* bar = b.bar;
        __builtin_amdgcn_s_waitcnt(0);
        unsigned nloc = b.st[0], nx = b.st[1];
        if (nloc == 0u) { xcd_barrier_complete(bar, b.x, nloc, nx); b.st[0] = nloc; b.st[1] = nx; }
        const unsigned old = xb_add(&bar[XB_XSUB(b.x)], 1u);
        const unsigned gen = old / nloc;
        if (old + 1u == (gen + 1u) * nloc) {
            __builtin_amdgcn_fence(__ATOMIC_RELEASE, "agent");
            asm volatile("s_waitcnt vmcnt(0)" ::: "memory");
            const unsigned og = xb_add(&bar[XB_TOP], 1u);
            const unsigned tg = og / nx;
            if (og + 1u == (tg + 1u) * nx) xb_add(&bar[XB_TOPGEN], 1u);
            else XB_SPIN(xb_ld(&bar[XB_TOPGEN]) == tg, bar);
            __builtin_amdgcn_fence(__ATOMIC_ACQUIRE, "agent");
            xb_add(&bar[XB_XGEN(b.x)], 1u);
            asm volatile("s_waitcnt vmcnt(0)" ::: "memory");
        } else {
            XB_SPIN(xb_ld(&bar[XB_XGEN(b.x)]) == gen, bar);
            __builtin_amdgcn_fence(__ATOMIC_ACQUIRE, "agent");
            asm volatile("s_waitcnt vmcnt(0)" ::: "memory");
        }
    }
    __syncthreads();
}


#define N_PHASES 22
__device__ __forceinline__ void run_phase(const Params& p, int ph, unsigned char* smem) {
    bf16_t* sm16 = reinterpret_cast<bf16_t*>(smem);
    const bf16_t* W = reinterpret_cast<const bf16_t*>(p.ws + OFF_W);
    bf16_t* ACTB = reinterpret_cast<bf16_t*>(p.ws + OFF_ACTB);
    bf16_t* PB = reinterpret_cast<bf16_t*>(p.ws + OFF_P);
    bf16_t* YC = reinterpret_cast<bf16_t*>(p.ws + OFF_YCAT);
    switch (ph) {
        case 0: phase_pre(p, smem, 0, obid(), ogdim()); break;
        case 1: { PEpiBf16 e{PB, 2304}; big_gemm(ACTB, W + WE_IN0, NT, 2304, DM, e, smem, p.wave); } break;
        case 2: phase_l0_prep(p); break;
        case 3: phase_l0_lora(p, sm16); break;
        case 4: phase_rwkv_r1(p, smem); break;
        case 5: phase_rwkv_r2(p, smem); break;
        case 6: phase_rwkv_r3(p, smem); break;
        case 7: { PEpiOut<false> e{p.in[0], nullptr, PB}; big_gemm(YC, W + WE_OUT0, NT, DM, DM, e, smem, p.wave); } break;
        case 8: phase_ln_route(p, 0, smem); break;
        case 9: phase_exp1(p, 0, sm16); break;
        case 10: phase_exp2(p, 0, sm16); break;
        case 11: phase_ln_ffn(p, 0, p.out, false); break;
        case 12: { PEpiBf16 e{PB, 3072}; big_gemm(ACTB, W + WE_IN1, NT, 3072, DM, e, smem, p.wave); } break;
        case 13: phase_l1_conv(p, smem); break;
        case 14: phase_ret_kv(p, smem); break;
        case 15: phase_ret_scan(p); break;
        case 16: phase_ret_out(p, smem); break;
        case 17: { PEpiOut<true> e{nullptr, ACTB, PB}; big_gemm(YC, W + WE_OUT1, NT, DM, DM, e, smem, p.wave); } break;
        case 18: phase_ln_route(p, 1, smem); break;
        case 19: phase_exp1(p, 1, sm16); break;
        case 20: phase_exp2(p, 1, sm16); break;
        case 21: phase_ln_ffn(p, 1, p.out, true); break;
        default: break;
    }
}

#define SMEM_BYTES 147456
__global__ void __launch_bounds__(NTHREADS) k_mega(Params p) {
    extern __shared__ __attribute__((aligned(16))) unsigned char smem[];
    cg::grid_group grid = cg::this_grid();
    const int wave_s = __builtin_amdgcn_readfirstlane((int)(threadIdx.x >> 6));
    volatile __attribute__((address_space(3))) unsigned* st = (volatile __attribute__((address_space(3))) unsigned*)(smem + 146944);
    {
        const int t0 = otid(wave_s);
        if (t0 < 2) st[t0] = 0u;
    }
    __syncthreads();
    XcdBarrier xb;
#pragma nounroll
    for (int ph = 0; ph < N_PHASES; ++ph) {
        int phv = ph;
        asm volatile("" : "+s"(phv));
        typedef const __attribute__((address_space(4))) Params* KP;
        KP pp = (KP)__builtin_amdgcn_kernarg_segment_ptr();
        asm volatile("" : "+s"(pp));
        Params pl;
        __builtin_memcpy(&pl, (const Params*)pp, sizeof(Params));
        pl.wave = wave_s;
        run_phase(pl, phv, smem);
        if (ph == 0) {
            if (pl.ws == nullptr) grid.sync();
            xb = xcd_barrier_post(reinterpret_cast<unsigned*>(pl.ws + OFF_CTRL + 4096), st, otid(wave_s));
        }
        if (ph < N_PHASES - 1) xcd_barrier(xb, otid(wave_s));
    }
}

extern "C" void kernel_launch(void* const* d_in, const int* in_sizes, int n_in, void* d_out, int out_size, void* d_ws, size_t ws_size,
                              hipStream_t stream) {
    static int grid_blocks = 0;
    if (!grid_blocks) {
        int dev = 0, cus = 0, per_cu = 0;
        hipGetDevice(&dev);
        hipDeviceGetAttribute(&cus, hipDeviceAttributeMultiprocessorCount, dev);
        hipFuncSetAttribute((const void*)k_mega, hipFuncAttributeMaxDynamicSharedMemorySize, SMEM_BYTES);
        hipOccupancyMaxActiveBlocksPerMultiprocessor(&per_cu, (const void*)k_mega, NTHREADS, SMEM_BYTES);
        if (per_cu < 1) per_cu = 1;
        grid_blocks = cus * per_cu;
    }
    Params p{};
    for (int i = 0; i < 35; ++i) p.in[i] = (const float*)d_in[i];
    p.out = (float*)d_out;
    p.ws = (unsigned char*)d_ws;
    hipMemsetAsync((unsigned char*)d_ws + OFF_CTRL, 0, 65536, stream);
    void* args[] = {&p};
    hipError_t e = hipLaunchCooperativeKernel((void*)k_mega, dim3(grid_blocks), dim3(NTHREADS), args, SMEM_BYTES, stream);
    if (e != hipSuccess) fprintf(stderr, "cooperative launch failed: %s (grid %d)\n", hipGetErrorString(e), grid_blocks);
}
```

```cpp
#include <hip/hip_runtime.h>
#include <hip/hip_cooperative_groups.h>
#include <stdint.h>
#include <stdio.h>
namespace cg = cooperative_groups;

typedef unsigned short bf16_t;
typedef short bf16x8 __attribute__((ext_vector_type(8)));
typedef float f32x4 __attribute__((ext_vector_type(4)));

#define NT 32768
#define SEQ 8192
#define DM 1024
#define NTHREADS 512
#define XCD_BAR_WORDS 3456
#define NWAVES 8
#define ALPHA_F 1.41421356237309515f

#define MIB (1024ull * 1024ull)
#define OFF_CTRL 0ull
#define OFF_W (1ull * MIB)
#define OFF_ROPE (65ull * MIB)
#define OFF_ACTB (68ull * MIB)
#define OFF_AA (OFF_ACTB)
#define OFF_GG (OFF_ACTB + 32ull * MIB)
#define OFF_P (132ull * MIB)
#define OFF_LORA (OFF_P + 144ull * MIB)
#define OFF_POOLED (OFF_P + 160ull * MIB)
#define OFF_FS (OFF_P)
#define OFF_HBUF (OFF_P + 128ull * MIB)
#define OFF_YCAT (324ull * MIB)
#define OFF_LOGW (388ull * MIB)
#define OFF_LTOK (452ull * MIB)
#define OFF_LGATE (456ull * MIB)
#define OFF_KVT (460ull * MIB)
#define WE_IN0 0
#define WE_OUT0 2359296
#define WE_IN1 3407872
#define WE_OUT1 6553600
#define WE_W13 7602176
#define WE_W2 24379392
#define WE_LW2 32768000
#define WE_LA2 32800768
#define WE_LG2 32833536
#define WE_POOL 32899072
#define WE_RT_HI 32964608
#define WE_RT_LO 33062912

struct Params {
    const float* in[35];
    float* out;
    unsigned char* ws;
    int wave;
    int pad_;
};

typedef __bf16 hw_bf16x2 __attribute__((ext_vector_type(2)));
typedef float hw_f32x2 __attribute__((ext_vector_type(2)));
__device__ __forceinline__ unsigned pack2(float a, float b) {
    hw_f32x2 v = {a, b};
    hw_bf16x2 r = __builtin_convertvector(v, hw_bf16x2);
    return __builtin_bit_cast(unsigned, r);
}
__device__ __forceinline__ bf16_t f2bf(float f) { return (bf16_t)(pack2(f, 0.f) & 0xffffu); }
__device__ __forceinline__ float bf2f(bf16_t h) { return __uint_as_float(((unsigned)h) << 16); }
__device__ __forceinline__ void unpack8(const uint4 v, float (&o)[8]) {
    o[0] = __uint_as_float(v.x << 16); o[1] = __uint_as_float(v.x & 0xffff0000u);
    o[2] = __uint_as_float(v.y << 16); o[3] = __uint_as_float(v.y & 0xffff0000u);
    o[4] = __uint_as_float(v.z << 16); o[5] = __uint_as_float(v.z & 0xffff0000u);
    o[6] = __uint_as_float(v.w << 16); o[7] = __uint_as_float(v.w & 0xffff0000u);
}
#define DPP_ADD(v, CTRL) ((v) + __int_as_float(__builtin_amdgcn_update_dpp(0, __float_as_int(v), (CTRL), 0xF, 0xF, false)))
__device__ __forceinline__ float row16_sum(float v) {
    v = DPP_ADD(v, 0xB1);
    v = DPP_ADD(v, 0x4E);
    v = DPP_ADD(v, 0x141);
    v = DPP_ADD(v, 0x140);
    return v;
}
__device__ __forceinline__ float wave_sum(float v) {
    v = row16_sum(v);
    const int iv = __float_as_int(v);
    const float s0 = __int_as_float(__builtin_amdgcn_readlane(iv, 0)), s1 = __int_as_float(__builtin_amdgcn_readlane(iv, 16));
    const float s2 = __int_as_float(__builtin_amdgcn_readlane(iv, 32)), s3 = __int_as_float(__builtin_amdgcn_readlane(iv, 48));
    return (s0 + s1) + (s2 + s3);
}
__device__ __forceinline__ float sigmoidf_(float x) { return 1.0f / (1.0f + __expf(-x)); }
__device__ __forceinline__ float siluf_(float x) { return x / (1.0f + __expf(-x)); }
__device__ __forceinline__ void lds_barrier() {
    asm volatile("s_waitcnt lgkmcnt(0)" ::: "memory");
    __builtin_amdgcn_s_barrier();
    asm volatile("" ::: "memory");
}
__device__ __forceinline__ int obid() { int b = (int)blockIdx.x; asm volatile("" : "+s"(b)); return b; }
__device__ __forceinline__ int ogdim() { int b = (int)gridDim.x; asm volatile("" : "+s"(b)); return b; }
__device__ __forceinline__ int otid(int wave) { int t = wave * 64 + (int)__builtin_amdgcn_mbcnt_hi(~0u, __builtin_amdgcn_mbcnt_lo(~0u, 0u)); asm volatile("" : "+v"(t)); return t; }
template <bool GATHER, class Epi>
__device__ __forceinline__ void gemm_tile(const bf16_t* __restrict__ A, int lda, const int* __restrict__ gidx, int gcount,
                                          const bf16_t* __restrict__ Bt, int ldb, int K, int row0, int col0, const Epi& epi,
                                          bf16_t* smem, int wave) {
    const int tidx = otid(wave);
    const int tid = tidx, wid = tid >> 6, lane = tid & 63, wr = wid >> 1, wc = wid & 1, fr = lane & 15, fq = lane >> 4;
    unsigned char* sm = reinterpret_cast<unsigned char*>(smem);
    const bf16_t* ap[4];
    const bf16_t* bp[2];
#pragma unroll
    for (int i = 0; i < 4; ++i) {
        const int pch = tid + i * 512;
        const int r = pch >> 3, c = (pch & 7) ^ (r & 7);
        int ar = row0 + r;
        if (GATHER) {
            int gi = ar < gcount ? ar : gcount - 1;
            ar = gidx[gi] >> 1;
        }
        ap[i] = A + (size_t)ar * lda + c * 8;
    }
#pragma unroll
    for (int i = 0; i < 2; ++i) {
        const int pch = tid + i * 512;
        const int r = pch >> 3, c = (pch & 7) ^ (r & 7);
        bp[i] = Bt + (size_t)(col0 + r) * ldb + c * 8;
    }
    f32x4 acc[4][4];
#pragma unroll
    for (int m = 0; m < 4; ++m)
#pragma unroll
        for (int n = 0; n < 4; ++n) acc[m][n] = (f32x4){0.f, 0.f, 0.f, 0.f};
    const int nk = K >> 6;
#define GT_STAGE(kt, buf) do { _Pragma("unroll") for (int i_ = 0; i_ < 4; ++i_) \
        __builtin_amdgcn_global_load_lds((const unsigned*)(ap[i_] + (kt) * 64), (__attribute__((address_space(3))) unsigned*)(sm + (buf) * 49152 + (tid + i_ * 512) * 16), 16, 0, 0); \
        _Pragma("unroll") for (int i_ = 0; i_ < 2; ++i_) \
        __builtin_amdgcn_global_load_lds((const unsigned*)(bp[i_] + (kt) * 64), (__attribute__((address_space(3))) unsigned*)(sm + (buf) * 49152 + 32768 + (tid + i_ * 512) * 16), 16, 0, 0); } while (0)
    GT_STAGE(0, 0);
    for (int kt = 0; kt < nk; ++kt) {
        const int buf = kt & 1;
        if (kt + 1 < nk) {
            GT_STAGE(kt + 1, buf ^ 1);
            asm volatile("s_waitcnt vmcnt(6)" ::: "memory");
        } else {
            asm volatile("s_waitcnt vmcnt(0)" ::: "memory");
        }
        __builtin_amdgcn_s_barrier();
        asm volatile("" ::: "memory");
        const unsigned char* SA = sm + buf * 49152;
        const unsigned char* SB = SA + 32768;
#pragma unroll
        for (int ks = 0; ks < 2; ++ks) {
            bf16x8 af[4], bfr[4];
            const int cs = ((ks * 4 + fq) ^ (fr & 7)) * 16;
#pragma unroll
            for (int m = 0; m < 4; ++m) af[m] = *reinterpret_cast<const bf16x8*>(SA + (wr * 64 + m * 16 + fr) * 128 + cs);
#pragma unroll
            for (int n = 0; n < 4; ++n) bfr[n] = *reinterpret_cast<const bf16x8*>(SB + (wc * 64 + n * 16 + fr) * 128 + cs);
#pragma unroll
            for (int m = 0; m < 4; ++m)
#pragma unroll
                for (int n = 0; n < 4; ++n) acc[m][n] = __builtin_amdgcn_mfma_f32_16x16x32_bf16(bfr[n], af[m], acc[m][n], 0, 0, 0);
        }
        asm volatile("s_waitcnt lgkmcnt(0)" ::: "memory");
        __builtin_amdgcn_s_barrier();
        asm volatile("" ::: "memory");
    }
#undef GT_STAGE
    epi(acc, row0 + wr * 64, col0 + wc * 64, fr, fq);
}

template <int MODE>
struct EpiLora {
    float* Of; bf16_t* Ob; const float* vec; int ldo; int coff;
    __device__ __forceinline__ void operator()(f32x4 (&acc)[4][4], int rb, int cb, int fr, int fq) const {
        float4 pv[4];
#pragma unroll
        for (int n = 0; n < 4; ++n) {
            pv[n] = make_float4(0.f, 0.f, 0.f, 0.f);
            if (MODE == 0 || MODE == 1) pv[n] = *reinterpret_cast<const float4*>(vec + cb + n * 16 + fq * 4);
            else if (MODE == 3) pv[n] = *reinterpret_cast<const float4*>(vec + coff + cb + n * 16 + fq * 4);
        }
#pragma unroll
        for (int m = 0; m < 4; ++m)
#pragma unroll
            for (int n = 0; n < 4; ++n) {
                int row = rb + m * 16 + fr, col = cb + n * 16 + fq * 4;
                const float pvv[4] = {pv[n].x, pv[n].y, pv[n].z, pv[n].w};
                float v[4];
#pragma unroll
                for (int j = 0; j < 4; ++j) {
                    float a = acc[m][n][j];
                    if (MODE == 0) {
                        const float t = -(pvv[j] + a);
                        const float sp = (t > 15.f) ? t : __logf(1.0f + __expf(t));
                        v[j] = -__expf(-sp - 0.5f);
                    } else if (MODE == 1) {
                        v[j] = sigmoidf_(pvv[j] + a);
                    } else if (MODE == 2) {
                        v[j] = a;
                    } else {
                        v[j] = a * pvv[j];
                    }
                }
                uint2 w; w.x = pack2(v[0], v[1]); w.y = pack2(v[2], v[3]);
                *reinterpret_cast<uint2*>(Ob + (size_t)row * ldo + coff + col) = w;
            }
    }
};
struct EpiExp1 {
    bf16_t* H; int base; int cnt;
    __device__ __forceinline__ void operator()(f32x4 (&acc)[4][4], int rb, int cb, int fr, int fq) const {
#pragma unroll
        for (int m = 0; m < 4; ++m) {
            int li = rb + m * 16 + fr;
            if (li < cnt) {
#pragma unroll
                for (int i = 0; i < 2; ++i) {
                    int hcol = (cb >> 1) + i * 16 + fq * 4;
                    float v[4];
#pragma unroll
                    for (int j = 0; j < 4; ++j) v[j] = siluf_(acc[m][2 * i][j]) * acc[m][2 * i + 1][j];
                    uint2 w; w.x = pack2(v[0], v[1]); w.y = pack2(v[2], v[3]);
                    *reinterpret_cast<uint2*>(H + (size_t)(base + li) * 128 + hcol) = w;
                }
            }
        }
    }
};
struct EpiExp2 {
    bf16_t* FS; int pk[4]; float g[4]; int cnt;
    __device__ __forceinline__ void operator()(f32x4 (&acc)[4][4], int rb, int cb, int fr, int fq) const {
#pragma unroll
        for (int m = 0; m < 4; ++m) {
            int li = rb + m * 16 + fr;
            if (li < cnt) {
                const float gg = g[m];
                int tok = pk[m] >> 1, j = pk[m] & 1;
                bf16_t* o = FS + ((size_t)j * NT + tok) * DM;
#pragma unroll
                for (int n = 0; n < 4; ++n) {
                    int col = cb + n * 16 + fq * 4;
                    uint2 w; w.x = pack2(acc[m][n][0] * gg, acc[m][n][1] * gg); w.y = pack2(acc[m][n][2] * gg, acc[m][n][3] * gg);
                    *reinterpret_cast<uint2*>(o + col) = w;
                }
            }
        }
    }
};


namespace pg8 {
#define PG8_LAS __attribute__((address_space(3)))
typedef unsigned short bf16_t;
typedef short bf16x8 __attribute__((ext_vector_type(8)));
typedef float f32x4 __attribute__((ext_vector_type(4)));
typedef unsigned u32x4 __attribute__((ext_vector_type(4)));
constexpr int BM = 256, BK = 64, HALF = 128, HTB = HALF * BK * 2  , STAGE_BYTES = 8 * HTB, NXCD = 8, WGM = 8;

__host__ __device__ __forceinline__ int lds_byte(int r, int c) { const int st = (r >> 4) * 2 + (c >> 5), rr = r & 15, cc = c & 31, ob = rr * 64 + cc * 2; return st * 1024 + (ob ^ (((ob >> 9) & 1) << 5)); }
__host__ __device__ __forceinline__ void stage_rc(int b, int& R, int& C) { const int st = b / 1024, sb = b % 1024, swz = sb ^ (((sb >> 9) & 1) << 5); R = (st >> 1) * 16 + swz / 64; C = (st & 1) * 32 + (swz % 64) / 2; }
__host__ __device__ __forceinline__ int perm32(int rho) { const int n = rho >> 4, i = rho & 15; return 8 * (i >> 2) + 4 * n + (i & 3); }

struct Unit { int pm, pn; };
struct Gemm { const bf16_t* A; const bf16_t* Bt; int M, N, K; };

struct StaticOrder {
    int nM, nN, nwg, G, c;
    __host__ __device__ void init(int M, int N, int G_, int c_) { nM = M / BM; nN = N / BM; nwg = nM * nN; G = G_; c = c_; }
    __host__ __device__ bool next(int i, Unit& u) const {
        const long L = (long)i * G + c; if (L >= nwg) return false;
        int wgid = (int)L; { const int q = nwg / NXCD, r = nwg % NXCD, xcd = wgid % NXCD, off = wgid / NXCD; wgid = (xcd < r ? xcd * (q + 1) : r * (q + 1) + (xcd - r) * q) + off; }
        const int nig = WGM * nN, gid = wgid / nig, fm = gid * WGM, gsz = (nM - fm) < WGM ? (nM - fm) : WGM;
        u.pm = fm + ((wgid % nig) % gsz); u.pn = (wgid % nig) / gsz; return true;
    }
    __device__ __forceinline__ void a_ready(const Unit&) const {}
    __device__ __forceinline__ void done(const Unit&) const {}
};
template <class Epi, class Sched, bool ALIGN_EPI = false, bool SP2 = false>
__device__ __forceinline__ void gemm_phase(PG8_LAS unsigned char* lds, const Gemm g, const Sched& S, const Epi& E, int wave) {
    const int tid = otid(wave), wid = __builtin_amdgcn_readfirstlane(tid >> 6), lane = tid & 63, wr = wid >> 2, wc = wid & 3, fr = lane & 15, fq = lane >> 4;
    const int K = g.K, nt = K / BK;
    unsigned voffA[2], voffB[2];
#pragma unroll
    for (int i = 0; i < 2; ++i) { int R, C; stage_rc(tid * 16 + i * 8192, R, C); const int Rb = Epi::PERM ? ((R & ~31) + perm32(R & 31)) : R;
        voffA[i] = (unsigned)(R * K + C) * 2u; voffB[i] = (unsigned)(Rb * K + C) * 2u; }
    const size_t kstep = (size_t)(BK * 2);
    const size_t hstep = (size_t)HALF * K * 2;
    const size_t tstep = 2 * hstep;
    const unsigned ldsw = (unsigned)wid * 1024u;
    const int aoff = lds_byte(wr * 64 + fr, fq * 8), boff = lds_byte(wc * 32 + fr, fq * 8);
#define PG8_SA(b, h) (((b) * 2 + (h)) * HTB)
#define PG8_SB(b, h) ((4 + (b) * 2 + (h)) * HTB)
#define PG8_STAGE(bufoff, gbase, voff) do { _Pragma("unroll") for (int _i = 0; _i < 2; ++_i) \
        __builtin_amdgcn_global_load_lds((const unsigned*)((const char*)(gbase) + (voff)[_i]), (PG8_LAS unsigned*)(lds + (bufoff) + ldsw + _i * 8192), 16, 0, 0); } while (0)
#define PG8_LDA(dst, b, h) do { _Pragma("unroll") for (int m = 0; m < 4; ++m) _Pragma("unroll") for (int k = 0; k < 2; ++k) dst[m][k] = *(const PG8_LAS bf16x8*)(lds + PG8_SA(b, h) + aoff + m * 2048 + k * 1024); } while (0)
#define PG8_LDB(dst, b, h) do { _Pragma("unroll") for (int n = 0; n < 2; ++n) _Pragma("unroll") for (int k = 0; k < 2; ++k) dst[n][k] = *(const PG8_LAS bf16x8*)(lds + PG8_SB(b, h) + boff + n * 2048 + k * 1024); } while (0)
#define PG8_MMA(ai, bj, At, Bt) do { __builtin_amdgcn_s_setprio(1); _Pragma("unroll") for (int m = 0; m < 4; ++m) _Pragma("unroll") for (int n = 0; n < 2; ++n) _Pragma("unroll") for (int k = 0; k < 2; ++k) \
        acc[ai][bj][m][n] = __builtin_amdgcn_mfma_f32_16x16x32_bf16(Bt[n][k], At[m][k], acc[ai][bj][m][n], 0, 0, 0); __builtin_amdgcn_s_setprio(0); } while (0)
#define PG8_WAIT_V(n) asm volatile("s_waitcnt vmcnt(" #n ")" ::: "memory")
#define PG8_WAIT_L(n) asm volatile("s_waitcnt lgkmcnt(" #n ")" ::: "memory")
#define PG8_BAR __builtin_amdgcn_s_barrier()
#define PG8_SCHED __builtin_amdgcn_sched_barrier(0)
    Unit cur, nxt; int ui = 0;
    if (!S.next(0, cur)) return;
    f32x4 acc[2][2][4][2];
#pragma unroll
    for (int a = 0; a < 2; ++a)
#pragma unroll
        for (int b = 0; b < 2; ++b)
#pragma unroll
            for (int m = 0; m < 4; ++m)
#pragma unroll
                for (int n = 0; n < 2; ++n) acc[a][b][m][n] = (f32x4){0.f, 0.f, 0.f, 0.f};
    bf16x8 At[4][2], B0[2][2], B1[2][2];
    const char* cA = (const char*)g.A + (size_t)cur.pm * tstep; const char* cB = (const char*)g.Bt + (size_t)cur.pn * tstep;
    S.a_ready(cur);
    if constexpr (SP2) {
        PG8_STAGE(PG8_SB(0, 0), cB, voffB); PG8_STAGE(PG8_SB(0, 1), cB + hstep, voffB); PG8_STAGE(PG8_SA(0, 0), cA, voffA); PG8_STAGE(PG8_SA(0, 1), cA + hstep, voffA);
        if (wr == 1) PG8_BAR;
        PG8_WAIT_V(2); PG8_BAR;
        PG8_STAGE(PG8_SB(1, 0), cB + kstep, voffB); PG8_STAGE(PG8_SA(1, 0), cA + kstep, voffA); PG8_STAGE(PG8_SB(1, 1), cB + hstep + kstep, voffB);
        PG8_WAIT_V(6); PG8_BAR;
    } else {
        PG8_STAGE(PG8_SB(0, 0), cB, voffB); PG8_STAGE(PG8_SA(0, 0), cA, voffA); PG8_STAGE(PG8_SB(0, 1), cB + hstep, voffB); PG8_STAGE(PG8_SA(0, 1), cA + hstep, voffA);
        if (wr == 1) PG8_BAR;
        PG8_WAIT_V(4); PG8_BAR;
        PG8_STAGE(PG8_SB(1, 0), cB + kstep, voffB); PG8_STAGE(PG8_SA(1, 0), cA + kstep, voffA); PG8_STAGE(PG8_SB(1, 1), cB + hstep + kstep, voffB);
        PG8_WAIT_V(6); PG8_BAR;
    }
    for (;;) {
        const bool has_next = S.next(ui + 1, nxt);
        const char* nA = has_next ? (const char*)g.A + (size_t)nxt.pm * tstep : cA; const char* nB = has_next ? (const char*)g.Bt + (size_t)nxt.pn * tstep : cB;
        for (int t = 0; t < nt; t += 2) {
            const bool last = (t == nt - 2);
            const char* a1 = cA + (size_t)(t + 1) * kstep;
            const char* a2 = last ? nA : cA + (size_t)(t + 2) * kstep; const char* b2 = last ? nB : cB + (size_t)(t + 2) * kstep;
            const char* a3 = a2 + kstep; const char* b3 = b2 + kstep;
            if (last && has_next) S.a_ready(nxt);
            if constexpr (SP2) {
            PG8_LDB(B0, 0, 0); PG8_LDB(B1, 0, 1); PG8_SCHED; PG8_LDA(At, 0, 0); PG8_STAGE(PG8_SA(1, 1), a1 + hstep, voffA);
            PG8_WAIT_V(8); PG8_WAIT_L(0); PG8_BAR; PG8_MMA(0, 0, At, B0); PG8_MMA(0, 1, At, B1); PG8_BAR; PG8_SCHED;
            PG8_LDA(At, 0, 1); PG8_STAGE(PG8_SB(0, 0), b2, voffB); PG8_STAGE(PG8_SB(0, 1), b2 + hstep, voffB); PG8_STAGE(PG8_SA(0, 0), a2, voffA);
            PG8_WAIT_V(8); PG8_WAIT_L(0); PG8_BAR; PG8_MMA(1, 0, At, B0); PG8_MMA(1, 1, At, B1); PG8_BAR; PG8_SCHED;
            PG8_LDB(B0, 1, 0); PG8_LDB(B1, 1, 1); PG8_SCHED; PG8_LDA(At, 1, 0); PG8_STAGE(PG8_SA(0, 1), a2 + hstep, voffA);
            PG8_WAIT_V(8); PG8_WAIT_L(0); PG8_BAR; PG8_MMA(0, 0, At, B0); PG8_MMA(0, 1, At, B1); PG8_BAR; PG8_SCHED;
            PG8_LDA(At, 1, 1); PG8_STAGE(PG8_SB(1, 0), b3, voffB); PG8_STAGE(PG8_SB(1, 1), b3 + hstep, voffB); PG8_STAGE(PG8_SA(1, 0), a3, voffA);
            PG8_WAIT_V(8); PG8_WAIT_L(0); PG8_BAR; PG8_MMA(1, 0, At, B0); PG8_MMA(1, 1, At, B1); PG8_BAR; PG8_SCHED;
            } else {
            PG8_LDB(B0, 0, 0); PG8_SCHED; PG8_LDA(At, 0, 0); PG8_STAGE(PG8_SA(1, 1), a1 + hstep, voffA);
            PG8_WAIT_L(8); PG8_BAR; PG8_WAIT_L(0); PG8_MMA(0, 0, At, B0); PG8_BAR; PG8_SCHED;
            PG8_LDB(B1, 0, 1); PG8_STAGE(PG8_SB(0, 0), b2, voffB);
            PG8_BAR; PG8_WAIT_L(0); PG8_MMA(0, 1, At, B1); PG8_BAR;
            PG8_LDA(At, 0, 1); PG8_STAGE(PG8_SA(0, 0), a2, voffA);
            PG8_BAR; PG8_WAIT_L(0); PG8_MMA(1, 0, At, B0); PG8_BAR; PG8_SCHED;
            PG8_STAGE(PG8_SB(0, 1), b2 + hstep, voffB);
            PG8_WAIT_V(6); PG8_BAR; PG8_MMA(1, 1, At, B1); PG8_BAR;
            PG8_LDB(B0, 1, 0); PG8_SCHED; PG8_LDA(At, 1, 0); PG8_STAGE(PG8_SA(0, 1), a2 + hstep, voffA);
            PG8_WAIT_L(8); PG8_BAR; PG8_WAIT_L(0); PG8_MMA(0, 0, At, B0); PG8_BAR; PG8_SCHED;
            PG8_LDB(B1, 1, 1); PG8_STAGE(PG8_SB(1, 0), b3, voffB);
            PG8_BAR; PG8_WAIT_L(0); PG8_MMA(0, 1, At, B1); PG8_BAR;
            PG8_LDA(At, 1, 1); PG8_STAGE(PG8_SA(1, 0), a3, voffA);
            PG8_BAR; PG8_WAIT_L(0); PG8_MMA(1, 0, At, B0); PG8_BAR; PG8_SCHED;
            PG8_STAGE(PG8_SB(1, 1), b3 + hstep, voffB);
            PG8_WAIT_V(6); PG8_BAR; PG8_MMA(1, 1, At, B1); PG8_BAR;
            }
        }
        if constexpr (ALIGN_EPI) { if (wr == 0) PG8_BAR; }
        if constexpr (!Epi::AFTER_DRAIN) { E(acc, cur, wr, wc, fr, fq); S.done(cur); }
        if (!has_next) break;
#pragma unroll
        for (int a = 0; a < 2; ++a)
#pragma unroll
            for (int b = 0; b < 2; ++b)
#pragma unroll
                for (int m = 0; m < 4; ++m)
#pragma unroll
                    for (int n = 0; n < 2; ++n) acc[a][b][m][n] = (f32x4){0.f, 0.f, 0.f, 0.f};
        cur = nxt; cA = nA; cB = nB; ++ui;
        if constexpr (ALIGN_EPI) { if (wr == 1) PG8_BAR; }
    }
    PG8_WAIT_V(0);
    if constexpr (!ALIGN_EPI) { if (wr == 0) PG8_BAR; }
    PG8_BAR;
    if constexpr (Epi::AFTER_DRAIN) { E.fused(acc, cur, wr, wc, fr, fq, lds, wid, lane); S.done(cur); }
#undef PG8_SA
#undef PG8_SB
#undef PG8_STAGE
#undef PG8_LDA
#undef PG8_LDB
#undef PG8_MMA
#undef PG8_WAIT_V
#undef PG8_WAIT_L
#undef PG8_BAR
#undef PG8_SCHED
}
}
struct PEpiBf16 {
    static constexpr bool PERM = true, AFTER_DRAIN = false;
    bf16_t* O; int ldo;
    __device__ __forceinline__ void operator()(const pg8::f32x4 (&acc)[2][2][4][2], const pg8::Unit& u, int wr, int wc, int fr, int fq) const {
        const int row0 = u.pm * 256 + wr * 64 + fr, col0 = u.pn * 256 + wc * 32 + 8 * fq;
#pragma unroll
        for (int ai = 0; ai < 2; ++ai)
#pragma unroll
            for (int m = 0; m < 4; ++m) {
                bf16_t* rowp = O + (size_t)(row0 + ai * 128 + m * 16) * ldo + col0;
#pragma unroll
                for (int bj = 0; bj < 2; ++bj) {
                    const pg8::f32x4 v0 = acc[ai][bj][m][0], v1 = acc[ai][bj][m][1];
                    uint4 w; w.x = pack2(v0[0], v0[1]); w.y = pack2(v0[2], v0[3]); w.z = pack2(v1[0], v1[1]); w.w = pack2(v1[2], v1[3]);
                    *reinterpret_cast<uint4*>(rowp + bj * 128) = w;
                }
            }
    }
};
template <bool PREV_BF16>
struct PEpiOut {
    static constexpr bool PERM = true, AFTER_DRAIN = false;
    const float* Xprev; const bf16_t* XprevB; bf16_t* T;
    __device__ __forceinline__ void operator()(const pg8::f32x4 (&acc)[2][2][4][2], const pg8::Unit& u, int wr, int wc, int fr, int fq) const {
        const int row0 = u.pm * 256 + wr * 64 + fr, col0 = u.pn * 256 + wc * 32 + 8 * fq;
#pragma unroll
        for (int ai = 0; ai < 2; ++ai)
#pragma unroll
            for (int m = 0; m < 4; ++m) {
                const size_t ro = (size_t)(row0 + ai * 128 + m * 16) * DM + col0;
#pragma unroll
                for (int bj = 0; bj < 2; ++bj) {
                    const size_t o = ro + bj * 128;
                    float xp[8];
                    if (PREV_BF16) {
                        unpack8(*reinterpret_cast<const uint4*>(XprevB + o), xp);
                    } else {
                        const float4 a = *reinterpret_cast<const float4*>(Xprev + o), b = *reinterpret_cast<const float4*>(Xprev + o + 4);
                        xp[0] = a.x; xp[1] = a.y; xp[2] = a.z; xp[3] = a.w; xp[4] = b.x; xp[5] = b.y; xp[6] = b.z; xp[7] = b.w;
                    }
                    const pg8::f32x4 v0 = acc[ai][bj][m][0], v1 = acc[ai][bj][m][1];
                    uint4 w;
                    w.x = pack2(ALPHA_F * xp[0] + v0[0], ALPHA_F * xp[1] + v0[1]); w.y = pack2(ALPHA_F * xp[2] + v0[2], ALPHA_F * xp[3] + v0[3]);
                    w.z = pack2(ALPHA_F * xp[4] + v1[0], ALPHA_F * xp[5] + v1[1]); w.w = pack2(ALPHA_F * xp[6] + v1[2], ALPHA_F * xp[7] + v1[3]);
                    *reinterpret_cast<uint4*>(T + o) = w;
                }
            }
    }
};
template <class Epi>
__device__ __forceinline__ void big_gemm(const bf16_t* A, const bf16_t* Bt, int M, int N, int K, const Epi& e, unsigned char* smem, int wave) {
    pg8::Gemm g{A, Bt, M, N, K};
    pg8::StaticOrder S;
    S.init(M, N, ogdim(), obid());
    pg8::gemm_phase<Epi, pg8::StaticOrder, true, true>((PG8_LAS unsigned char*)smem, g, S, e, wave);
}

__device__ __forceinline__ void tconv_wave(const float* __restrict__ src, int N, bf16_t* __restrict__ dst, int ldd, int k0, int n0,
                                           int mode, float* tile, int lane) {
#pragma unroll
    for (int i = 0; i < 8; ++i) {
        const int r = i * 8 + (lane >> 3), c4 = (lane & 7) * 4;
        const float4 v = *reinterpret_cast<const float4*>(src + (size_t)(k0 + r) * N + n0 + c4);
        tile[r * 33 + c4] = v.x; tile[r * 33 + c4 + 1] = v.y; tile[r * 33 + c4 + 2] = v.z; tile[r * 33 + c4 + 3] = v.w;
    }
    asm volatile("s_waitcnt lgkmcnt(0)" ::: "memory");
#pragma unroll 8
    for (int nn = 0; nn < 32; ++nn) {
        const int n = n0 + nn;
        int drow = n;
        if (mode == 1) drow = (n >> 4) * 32 + (n & 15);
        else if (mode == 2) drow = (n >> 4) * 32 + 16 + (n & 15);
        dst[(size_t)drow * ldd + k0 + lane] = f2bf(tile[lane * 33 + nn]);
    }
    asm volatile("s_waitcnt lgkmcnt(0)" ::: "memory");
}

__device__ __forceinline__ void phase_pre(const Params& p, unsigned char* smem, int part, int bid, int nb) {
    const int tidx = otid(p.wave);
    const int wv = tidx >> 6, lane = tidx & 63;
    float* tile = reinterpret_cast<float*>(smem) + wv * (64 * 33);
    bf16_t* W = reinterpret_cast<bf16_t*>(p.ws + OFF_W);
    constexpr int T0 = 896, T1 = 512, T7 = 16, T8 = 16, T9 = 32;
    constexpr int T2 = 1536, T3 = 512, T4 = 4096, T5 = 4096, T6 = 4096;
    if (part == 0) {
        constexpr int TOT = T0 + T1 + T7 + T8 + T9;
        for (int u = bid * NWAVES + wv; u < TOT; u += nb * NWAVES) {
            int v = u;
            const float* src; bf16_t* dst; int K, N, tk, tn;
            if (v < T0) { src = p.in[1]; K = 1024; N = 2304; dst = W + WE_IN0; tk = v / 56; tn = v % 56; }
            else if ((v -= T0) < T1) { src = p.in[15]; K = 1024; N = 1024; dst = W + WE_OUT0; tk = v / 32; tn = v % 32; }
            else if ((v -= T1) < T7) { src = p.in[4]; K = 64; N = 512; dst = W + WE_LW2; tk = 0; tn = v; }
            else if ((v -= T7) < T8) { src = p.in[6]; K = 64; N = 512; dst = W + WE_LA2; tk = 0; tn = v; }
            else { v -= T8; src = p.in[7]; K = 128; N = 512; dst = W + WE_LG2; tk = v >> 4; tn = v & 15; }
            tconv_wave(src, N, dst, K, tk * 64, tn * 32, 0, tile, lane);
        }
        __syncthreads();
        {
            float* sWu = reinterpret_cast<float*>(smem);
            float* sPw = sWu + 16 * 128;
            for (int bt = bid; bt < 256; bt += nb) {
                const int g = bt >> 6, k0 = (bt & 63) * 16;
                {
                    const int r = tidx >> 5, c4 = (tidx & 31) * 4;
                    *reinterpret_cast<float4*>(sWu + r * 128 + c4) = *reinterpret_cast<const float4*>(p.in[1] + (size_t)(k0 + r) * 2304 + 1792 + g * 128 + c4);
                }
                for (int i = tidx; i < 128 * 32; i += NTHREADS) {
                    const int r = i >> 5, c4 = (i & 31) * 4;
                    *reinterpret_cast<float4*>(sPw + r * 128 + c4) = *reinterpret_cast<const float4*>(p.in[13] + (size_t)g * 16384 + r * 128 + c4);
                }
                __syncthreads();
                const int k = tidx >> 5, d0 = (tidx & 31) * 4;
                float acc[4] = {0.f, 0.f, 0.f, 0.f};
#pragma unroll 8
                for (int c = 0; c < 128; ++c) {
                    const float a = sWu[k * 128 + c];
                    const float4 bq = *reinterpret_cast<const float4*>(sPw + c * 128 + d0);
                    acc[0] += a * bq.x; acc[1] += a * bq.y; acc[2] += a * bq.z; acc[3] += a * bq.w;
                }
                bf16_t* dstp = W + WE_IN0 + (size_t)(1792 + g * 128 + d0) * 1024 + k0 + k;
#pragma unroll
                for (int j = 0; j < 4; ++j) dstp[(size_t)j * 1024] = f2bf(acc[j]);
                __syncthreads();
            }
        }
        const float4* x4 = reinterpret_cast<const float4*>(p.in[0]);
        uint2* xb = reinterpret_cast<uint2*>(p.ws + OFF_ACTB);
        const size_t n4 = (size_t)NT * DM / 4;
        const size_t stride = (size_t)nb * NTHREADS;
        for (size_t i = (size_t)bid * NTHREADS + tidx; i < n4; i += 8 * stride) {
            float4 v[8];
#pragma unroll
            for (int j = 0; j < 8; ++j) if (i + j * stride < n4) v[j] = x4[i + j * stride];
#pragma unroll
            for (int j = 0; j < 8; ++j) if (i + j * stride < n4) {
                uint2 w; w.x = pack2(v[j].x, v[j].y); w.y = pack2(v[j].z, v[j].w);
                xb[i + j * stride] = w;
            }
        }
    } else {
        constexpr int TOT = T2 + T3 + T4 + T5 + T6;
        for (int u = bid * NWAVES + wv; u < TOT; u += nb * NWAVES) {
            int v = u;
            const float* src; bf16_t* dst; int K, N, mode = 0, tk, tn;
            if (v < T2) { src = p.in[16]; K = 1024; N = 3072; dst = W + WE_IN1; tk = v / 96; tn = v % 96; }
            else if ((v -= T2) < T3) { src = p.in[23]; K = 1024; N = 1024; dst = W + WE_OUT1; tk = v / 32; tn = v % 32; }
            else if ((v -= T3) < T4) { int mat = v >> 6, w = v & 63; src = p.in[30] + (size_t)mat * 131072; K = 1024; N = 128; dst = W + WE_W13 + (size_t)mat * 262144; mode = 1; tk = w >> 2; tn = w & 3; }
            else if ((v -= T4) < T5) { int mat = v >> 6, w = v & 63; src = p.in[31] + (size_t)mat * 131072; K = 1024; N = 128; dst = W + WE_W13 + (size_t)mat * 262144; mode = 2; tk = w >> 2; tn = w & 3; }
            else { v -= T5; int mat = v >> 6, w = v & 63; src = p.in[32] + (size_t)mat * 131072; K = 128; N = 1024; dst = W + WE_W2 + (size_t)mat * 131072; tk = w >> 5; tn = w & 31; }
            tconv_wave(src, N, dst, K, tk * 64, tn * 32, mode, tile, lane);
        }
        {
            bf16_t* RH = W + WE_RT_HI; bf16_t* RL = W + WE_RT_LO;
            for (int i = bid * NTHREADS + tidx; i < 2 * 48 * 1024; i += nb * NTHREADS) {
                const int l = i / (48 * 1024), r = i - l * 48 * 1024, n = r >> 10, k = r & 1023;
                float w = 0.f;
                if (n < 4) w = p.in[26][((size_t)l * 1024 + k) * 4 + n];
                else if (n < 36) w = p.in[28][((size_t)l * 1024 + k) * 32 + (n - 4)];
                const bf16_t h = f2bf(w);
                RH[i] = h; RL[i] = f2bf(w - bf2f(h));
            }
        }
        {
            float2* rope = reinterpret_cast<float2*>(p.ws + OFF_ROPE);
            for (int i = bid * NTHREADS + tidx; i < SEQ * 32; i += nb * NTHREADS) {
                int pos = i >> 5, k = i & 31;
                float inv = powf(10000.0f, -(float)k / 32.0f);
                float ang = (float)pos * inv;
                const double a = (double)ang;
                const double q = rint(a * 0.15915494309189535);
                const float rr = (float)(a - q * 6.283185307179586);
                float s, c;
                sincosf(rr, &s, &c);
                rope[i] = make_float2(c, s);
            }
        }
    }
}

__device__ __forceinline__ void phase_l0_prep(const Params& p) {
    const int tidx = otid(p.wave);
    const bf16_t* P = reinterpret_cast<const bf16_t*>(p.ws + OFF_P);
    bf16_t* LA = reinterpret_cast<bf16_t*>(p.ws + OFF_LORA);
    bf16_t* YC = reinterpret_cast<bf16_t*>(p.ws + OFF_YCAT);
    const float* mu = p.in[2];
    const int nthr = ogdim() * NTHREADS, t0 = obid() * NTHREADS + tidx;
    {
        const int total = NT * 32;
        for (int it0 = t0; it0 < total; it0 += 4 * nthr) {
            uint4 cu[4], pr[4];
#pragma unroll
            for (int q = 0; q < 4; ++q) {
                const int it = it0 + q * nthr;
                cu[q] = make_uint4(0u, 0u, 0u, 0u); pr[q] = cu[q];
                if (it < total) {
                    const int tok = it >> 5, j = it & 31;
                    const bf16_t* src = P + (size_t)tok * 2304 + 1536 + j * 8;
                    cu[q] = *reinterpret_cast<const uint4*>(src);
                    if ((tok & (SEQ - 1)) > 0) pr[q] = *reinterpret_cast<const uint4*>(src - 2304);
                }
            }
#pragma unroll
            for (int q = 0; q < 4; ++q) {
                const int it = it0 + q * nthr;
                if (it < total) {
                    const int tok = it >> 5, j = it & 31, col = 1536 + j * 8;
                    float cur[8], prv[8];
                    unpack8(cu[q], cur); unpack8(pr[q], prv);
                    const float4 m0 = *reinterpret_cast<const float4*>(mu + col), m1 = *reinterpret_cast<const float4*>(mu + col + 4);
                    const float mm[8] = {m0.x, m0.y, m0.z, m0.w, m1.x, m1.y, m1.z, m1.w};
                    float o[8];
#pragma unroll
                    for (int i = 0; i < 8; ++i) {
                        const float z = cur[i] + mm[i] * (prv[i] - cur[i]);
                        o[i] = (j < 8) ? (1.0f - 2.0f / (1.0f + __expf(2.0f * z))) : ((j < 16) ? z : sigmoidf_(z));
                    }
                    uint4 w; w.x = pack2(o[0], o[1]); w.y = pack2(o[2], o[3]); w.z = pack2(o[4], o[5]); w.w = pack2(o[6], o[7]);
                    *reinterpret_cast<uint4*>(LA + (size_t)tok * 256 + j * 8) = w;
                }
            }
        }
    }
    {
        const int total = NT * 64;
        for (int it = t0; it < total; it += nthr) {
            const int tok = it >> 6, cc = (it & 63) * 8;
            const int s = tok & (SEQ - 1);
            const int gi = cc >> 7;
            const int win = 2 << gi;
            const int cnt = (s + 1 < win) ? (s + 1) : win;
            const bf16_t* src = P + (size_t)tok * 2304 + 1792 + cc;
            float u[8], sum[8];
            uint4 rows[16];
#pragma unroll
            for (int r = 0; r < 16; ++r) {
                rows[r] = make_uint4(0u, 0u, 0u, 0u);
                if (r < cnt) rows[r] = *reinterpret_cast<const uint4*>(src - (size_t)r * 2304);
            }
            unpack8(rows[0], u);
#pragma unroll
            for (int i = 0; i < 8; ++i) sum[i] = u[i];
#pragma unroll
            for (int r = 1; r < 16; ++r) {
                float t[8];
                unpack8(rows[r], t);
#pragma unroll
                for (int i = 0; i < 8; ++i) sum[i] += t[i];
            }
            const float inv = 1.0f / (float)cnt;
            const float4 ps0 = *reinterpret_cast<const float4*>(p.in[14] + cc), ps1 = *reinterpret_cast<const float4*>(p.in[14] + cc + 4);
            uint4 w;
            w.x = pack2((sum[0] * inv - u[0]) * ps0.x, (sum[1] * inv - u[1]) * ps0.y); w.y = pack2((sum[2] * inv - u[2]) * ps0.z, (sum[3] * inv - u[3]) * ps0.w);
            w.z = pack2((sum[4] * inv - u[4]) * ps1.x, (sum[5] * inv - u[5]) * ps1.y); w.w = pack2((sum[6] * inv - u[6]) * ps1.z, (sum[7] * inv - u[7]) * ps1.w);
            *reinterpret_cast<uint4*>(YC + (size_t)tok * 1024 + 512 + cc) = w;
        }
    }
}

__device__ __forceinline__ void phase_l0_lora(const Params& p, bf16_t* smem) {
    const bf16_t* W = reinterpret_cast<const bf16_t*>(p.ws + OFF_W);
    const bf16_t* LA = reinterpret_cast<const bf16_t*>(p.ws + OFF_LORA);
    const bf16_t* PO = reinterpret_cast<const bf16_t*>(p.ws + OFF_POOLED);
    for (int t = obid(); t < 1536; t += ogdim()) {
        int job = t >> 9, w = t & 511;
        if (job == 0) {
            EpiLora<0> e{nullptr, reinterpret_cast<bf16_t*>(p.ws + OFF_LOGW), p.in[3], 512, 0};
            gemm_tile<false>(LA, 256, nullptr, 0, W + WE_LW2, 64, 64, (w >> 2) * 256, (w & 3) * 128, e, smem, p.wave);
        } else if (job == 1) {
            EpiLora<1> e{nullptr, reinterpret_cast<bf16_t*>(p.ws + OFF_AA), p.in[5], 512, 0};
            gemm_tile<false>(LA + 64, 256, nullptr, 0, W + WE_LA2, 64, 64, (w >> 2) * 256, (w & 3) * 128, e, smem, p.wave);
        } else {
            EpiLora<2> e{nullptr, reinterpret_cast<bf16_t*>(p.ws + OFF_GG), nullptr, 512, 0};
            gemm_tile<false>(LA + 128, 256, nullptr, 0, W + WE_LG2, 128, 128, (w >> 2) * 256, (w & 3) * 128, e, smem, p.wave);
        }
    }
}

#define RC_LD 72
#define RC_BUF (64 * RC_LD)
#define RC_BYTES (RC_BUF * 2)
#define OFF_TBUF OFF_KVT

__device__ __forceinline__ void mm64(f32x4 (&acc)[2], const bf16_t* A, const bf16_t* Bt, int mt, int nt0, int fr, int fq) {
#pragma unroll
    for (int ks = 0; ks < 2; ++ks) {
        bf16x8 af = *reinterpret_cast<const bf16x8*>(A + (mt * 16 + fr) * RC_LD + ks * 32 + fq * 8);
        bf16x8 bq[2];
#pragma unroll
        for (int n = 0; n < 2; ++n) bq[n] = *reinterpret_cast<const bf16x8*>(Bt + ((nt0 + n) * 16 + fr) * RC_LD + ks * 32 + fq * 8);
#pragma unroll
        for (int n = 0; n < 2; ++n) acc[n] = __builtin_amdgcn_mfma_f32_16x16x32_bf16(af, bq[n], acc[n], 0, 0, 0);
    }
}
template <int MASK>
__device__ __forceinline__ void store_T(bf16_t* dst, const f32x4 (&acc)[2], int mt, int nt0, int fr, int fq) {
#pragma unroll
    for (int n = 0; n < 2; ++n) {
        const int C = (nt0 + n) * 16 + fr, R0 = mt * 16 + fq * 4;
        float v[4];
#pragma unroll
        for (int j = 0; j < 4; ++j) {
            const int R = R0 + j;
            bool keep = true;
            if (MASK == 1) keep = R < C;
            else if (MASK == 2) keep = R <= C;
            else if (MASK == 3) keep = C < R;
            v[j] = keep ? acc[n][j] : 0.f;
        }
        uint2 w; w.x = pack2(v[0], v[1]); w.y = pack2(v[2], v[3]);
        *reinterpret_cast<uint2*>(dst + C * RC_LD + R0) = w;
    }
}
__device__ __forceinline__ void zero_acc(f32x4 (&acc)[2]) {
    acc[0] = (f32x4){0.f, 0.f, 0.f, 0.f};
    acc[1] = (f32x4){0.f, 0.f, 0.f, 0.f};
}

#define OFF_NTB (OFF_P + 144ull * MIB)
#define OFF_S0A (OFF_P + 176ull * MIB)
#define OFF_TB (420ull * MIB)
#define OFF_MB (452ull * MIB)
#define OFF_S0B (484ull * MIB)
#define OFF_WLB (500ull * MIB)
#define OFF_BCB (501ull * MIB)
__device__ __forceinline__ bf16_t* s0_ptr(unsigned char* ws, int u) {
    return reinterpret_cast<bf16_t*>(ws + (u < 2048 ? OFF_S0A : OFF_S0B)) + (size_t)(u & 2047) * 4096;
}

struct PrepIn {
    unsigned short k[8], v[8], r[8], lw[8], a[8];
    unsigned short pk, pv, pr;
};
template <int MODE>
__device__ __forceinline__ void prep_load(PrepIn& in, const Params& p, int u, int tid) {
    const int b = u >> 10, h = (u >> 7) & 7, n = u & 127;
    const int lane = tid & 63, q = tid >> 6;
    const int c = h * 64 + lane;
    const bf16_t* P = reinterpret_cast<const bf16_t*>(p.ws + OFF_P);
    const bf16_t* LOGW = reinterpret_cast<const bf16_t*>(p.ws + OFF_LOGW);
    const bf16_t* AA = reinterpret_cast<const bf16_t*>(p.ws + OFF_AA);
    const int s0 = n * 64 + q * 8;
    const size_t tok0 = (size_t)b * SEQ + s0;
    in.pk = 0; in.pv = 0; in.pr = 0;
    if (s0 > 0) {
        const bf16_t* pp = P + (tok0 - 1) * 2304;
        in.pk = pp[512 + c]; in.pv = pp[1024 + c];
        in.pr = pp[c];
    }
#pragma unroll
    for (int i = 0; i < 8; ++i) {
        const bf16_t* pp = P + (tok0 + i) * 2304;
        in.k[i] = pp[512 + c]; in.v[i] = pp[1024 + c];
        in.r[i] = pp[c];
        in.lw[i] = LOGW[(tok0 + i) * 512 + c];
        in.a[i] = AA[(tok0 + i) * 512 + c];
    }
}
struct PrepC { float mu_k, kkc, kac, mu_v, mu_r, rkc, lng, lnb; };
template <int MODE>
__device__ __forceinline__ PrepC prep_consts(const Params& p, int h, int lane) {
    PrepC c_;
    const int c = h * 64 + lane;
    c_.mu_k = p.in[2][512 + c]; c_.kkc = p.in[8][c]; c_.kac = p.in[9][c]; c_.mu_v = p.in[2][1024 + c];
    c_.mu_r = 0.f; c_.rkc = 0.f; c_.lng = 0.f; c_.lnb = 0.f;
    c_.mu_r = p.in[2][c]; c_.rkc = p.in[10][c];
    if (MODE == 2) { c_.lng = p.in[11][c]; c_.lnb = p.in[12][c]; }
    return c_;
}
template <int MODE>
__device__ __forceinline__ void rwkv_prep(const PrepIn& in, const PrepC& pc, int tid, bf16_t* At, bf16_t* Bt, bf16_t* Kt, bf16_t* Rt,
                                          bf16_t* AtT, bf16_t* BtT, bf16_t* KtT, bf16_t* VT, float* sTot, float* sBC, float* sWL) {
    const int lane = tid & 63, q = tid >> 6;
    const float mu_k = pc.mu_k, kkc = pc.kkc, kac = pc.kac, mu_v = pc.mu_v, mu_r = pc.mu_r, rkc = pc.rkc;
    float lw[8], av[8], zk[8], zr[8], zv[8];
    float pk = bf2f(in.pk), pr = bf2f(in.pr), pv = bf2f(in.pv);
#pragma unroll
    for (int i = 0; i < 8; ++i) {
        const float k0 = bf2f(in.k[i]), v0 = bf2f(in.v[i]);
        zk[i] = k0 + mu_k * (pk - k0); pk = k0;
        zv[i] = v0 + mu_v * (pv - v0); pv = v0;
        { const float r0 = bf2f(in.r[i]); zr[i] = r0 + mu_r * (pr - r0); pr = r0; }
        lw[i] = bf2f(in.lw[i]);
        av[i] = bf2f(in.a[i]);
    }
    float lws[8];
    float cs = 0.f;
#pragma unroll
    for (int i = 0; i < 8; ++i) { cs += lw[i]; lws[i] = cs; }
    sTot[q * 64 + lane] = cs;
    lds_barrier();
    float off = 0.f, tot = 0.f;
#pragma unroll
    for (int qq = 0; qq < 8; ++qq) { float tq = sTot[qq * 64 + lane]; if (qq < q) off += tq; tot += tq; }
    float atv[8], btv[8], ktv[8];
#pragma unroll
    for (int i = 0; i < 8; ++i) {
        const int t = q * 8 + i;
        const float L = lws[i] + off;
        float kk = zk[i] * kkc;
        float ss = wave_sum(kk * kk);
        kk *= rsqrtf(fmaxf(ss, 1e-24f));
        const float e_neg = __expf(-L), e_prev = __expf(L - lw[i]);
        const float a = av[i];
        const float at = -kk * e_prev;
        At[t * RC_LD + lane] = f2bf(at);
        const float bt = kk * a * e_neg;
        Bt[t * RC_LD + lane] = f2bf(bt);
        const float kp = zk[i] * (1.0f + (a - 1.0f) * kac);
        const float kt = kp * e_neg;
        Kt[t * RC_LD + lane] = f2bf(kt);
        atv[i] = at; btv[i] = bt; ktv[i] = kt;
        {
            Rt[t * RC_LD + lane] = f2bf(zr[i] * __expf(L));
            const float bc = wave_sum(zr[i] * kp * rkc);
            if (lane == 0) sBC[t] = bc;
        }
    }
    uint4 w0;
    if (MODE == 1) {
        w0.x = pack2(atv[0], atv[1]); w0.y = pack2(atv[2], atv[3]); w0.z = pack2(atv[4], atv[5]); w0.w = pack2(atv[6], atv[7]);
        *reinterpret_cast<uint4*>(AtT + lane * RC_LD + q * 8) = w0;
        w0.x = pack2(btv[0], btv[1]); w0.y = pack2(btv[2], btv[3]); w0.z = pack2(btv[4], btv[5]); w0.w = pack2(btv[6], btv[7]);
        *reinterpret_cast<uint4*>(BtT + lane * RC_LD + q * 8) = w0;
        w0.x = pack2(ktv[0], ktv[1]); w0.y = pack2(ktv[2], ktv[3]); w0.z = pack2(ktv[4], ktv[5]); w0.w = pack2(ktv[6], ktv[7]);
        *reinterpret_cast<uint4*>(KtT + lane * RC_LD + q * 8) = w0;
        if (q == 0) sWL[lane] = __expf(tot);
    }
    w0.x = pack2(zv[0], zv[1]); w0.y = pack2(zv[2], zv[3]); w0.z = pack2(zv[4], zv[5]); w0.w = pack2(zv[6], zv[7]);
    *reinterpret_cast<uint4*>(VT + lane * RC_LD + q * 8) = w0;
}

__device__ __forceinline__ void phase_rwkv_r1(const Params& p, unsigned char* smem) {
    const int tidx = otid(p.wave);
    const int tid = tidx, wv = tid >> 6, lane = tid & 63, fr = lane & 15, fq = lane >> 4, mt = wv >> 1, nt0 = (wv & 1) * 2;
    bf16_t* base = reinterpret_cast<bf16_t*>(smem);
    bf16_t* At = base; bf16_t* Bt = base + RC_BUF; bf16_t* Kt = base + 2 * RC_BUF; bf16_t* AtT = base + 3 * RC_BUF;
    bf16_t* BtT = base + 4 * RC_BUF; bf16_t* KtT = base + 5 * RC_BUF; bf16_t* VT = base + 6 * RC_BUF;
    bf16_t* Rb0 = base + 7 * RC_BUF; bf16_t* Cb0 = base + 8 * RC_BUF; bf16_t* Rb1 = base + 9 * RC_BUF; bf16_t* Cb1 = base + 10 * RC_BUF;
    bf16_t* Pm0 = base + 11 * RC_BUF; bf16_t* Pm1 = base + 12 * RC_BUF;
    bf16_t* Rt = base + 13 * RC_BUF; bf16_t* Aak = base + 14 * RC_BUF;
    bf16_t* Tm = Rb0; bf16_t* PT = Rb1; bf16_t* AkVT = Cb1; bf16_t* QT = Pm0; bf16_t* Arb = At; bf16_t* Ark = Bt;
    float* sTot = reinterpret_cast<float*>(smem + 15 * RC_BYTES);
    float* sWL = sTot + 512;
    float* sBC = sWL + 64;
    bf16_t* PRg = reinterpret_cast<bf16_t*>(p.ws + OFF_AA);
    bf16_t* YQg = reinterpret_cast<bf16_t*>(p.ws + OFF_LOGW);
    float* BCg = reinterpret_cast<float*>(p.ws + OFF_BCB);
    bf16_t* Mg = reinterpret_cast<bf16_t*>(p.ws + OFF_MB);
    bf16_t* Ng = reinterpret_cast<bf16_t*>(p.ws + OFF_NTB);
    float* WLg = reinterpret_cast<float*>(p.ws + OFF_WLB);
    PrepIn cur, nxt;
    if (obid() < 4096) prep_load<1>(cur, p, obid(), tid);
    nxt = cur;
    for (int u = obid(); u < 4096; u += ogdim()) {
        const int h = (u >> 7) & 7, b = u >> 10, n = u & 127;
        PrepC pc = prep_consts<1>(p, h, lane);
        asm volatile("" : "+v"(pc.mu_k), "+v"(pc.kkc), "+v"(pc.kac), "+v"(pc.mu_v), "+v"(pc.mu_r), "+v"(pc.rkc));
        if (u + ogdim() < 4096) prep_load<1>(nxt, p, u + ogdim(), tid);
        rwkv_prep<1>(cur, pc, tid, At, Bt, Kt, Rt, AtT, BtT, KtT, VT, sTot, sBC, sWL);
        lds_barrier();
        f32x4 pacc[2];
        f32x4 acc[2];
        zero_acc(acc);
        mm64(acc, At, Bt, mt, nt0, fr, fq);
        store_T<3>(Cb0, acc, mt, nt0, fr, fq);
        zero_acc(pacc);
        mm64(pacc, Bt, At, mt, nt0, fr, fq);
#pragma unroll
        for (int nn = 0; nn < 2; ++nn)
#pragma unroll
            for (int j = 0; j < 4; ++j) {
                const int R = mt * 16 + fq * 4 + j, C = (nt0 + nn) * 16 + fr;
                pacc[nn][j] = (R < C) ? pacc[nn][j] : 0.f;
            }
        store_T<0>(Rb0, pacc, mt, nt0, fr, fq);
#pragma unroll
        for (int nn = 0; nn < 2; ++nn)
#pragma unroll
            for (int j = 0; j < 4; ++j) {
                const int R = mt * 16 + fq * 4 + j, C = (nt0 + nn) * 16 + fr;
                if (R == C) pacc[nn][j] += 1.0f;
            }
        store_T<0>(Pm0, pacc, mt, nt0, fr, fq);
        lds_barrier();
        zero_acc(acc); mm64(acc, Cb0, Rb0, mt, nt0, fr, fq); store_T<0>(Rb1, acc, mt, nt0, fr, fq);
        zero_acc(acc); mm64(acc, Rb0, Cb0, mt, nt0, fr, fq); store_T<0>(Cb1, acc, mt, nt0, fr, fq);
        zero_acc(acc); mm64(acc, Kt, At, mt, nt0, fr, fq); store_T<1>(Aak, acc, mt, nt0, fr, fq);
        lds_barrier();
        zero_acc(acc); mm64(acc, Cb1, Rb1, mt, nt0, fr, fq); store_T<0>(Rb0, acc, mt, nt0, fr, fq);
        zero_acc(acc); mm64(acc, Rb1, Cb1, mt, nt0, fr, fq); store_T<0>(Cb0, acc, mt, nt0, fr, fq);
        zero_acc(acc); mm64(acc, Cb1, Pm0, mt, nt0, fr, fq); pacc[0] += acc[0]; pacc[1] += acc[1]; store_T<0>(Pm1, pacc, mt, nt0, fr, fq);
        zero_acc(acc); mm64(acc, Bt, Rt, mt, nt0, fr, fq); store_T<2>(Arb, acc, mt, nt0, fr, fq);
        lds_barrier();
        zero_acc(acc); mm64(acc, Cb0, Rb0, mt, nt0, fr, fq); store_T<0>(Rb1, acc, mt, nt0, fr, fq);
        zero_acc(acc); mm64(acc, Rb0, Cb0, mt, nt0, fr, fq); store_T<0>(Cb1, acc, mt, nt0, fr, fq);
        zero_acc(acc); mm64(acc, Cb0, Pm1, mt, nt0, fr, fq); pacc[0] += acc[0]; pacc[1] += acc[1]; store_T<0>(Pm0, pacc, mt, nt0, fr, fq);
        zero_acc(acc); mm64(acc, Kt, Rt, mt, nt0, fr, fq); store_T<2>(Ark, acc, mt, nt0, fr, fq);
        lds_barrier();
        zero_acc(acc); mm64(acc, Cb1, Rb1, mt, nt0, fr, fq); store_T<0>(Rb0, acc, mt, nt0, fr, fq);
        zero_acc(acc); mm64(acc, Rb1, Cb1, mt, nt0, fr, fq); store_T<0>(Cb0, acc, mt, nt0, fr, fq);
        zero_acc(acc); mm64(acc, Cb1, Pm0, mt, nt0, fr, fq); pacc[0] += acc[0]; pacc[1] += acc[1]; store_T<0>(Pm1, pacc, mt, nt0, fr, fq);
        lds_barrier();
        zero_acc(acc); mm64(acc, Rb0, Cb0, mt, nt0, fr, fq); store_T<0>(Cb1, acc, mt, nt0, fr, fq);
        zero_acc(acc); mm64(acc, Cb0, Pm1, mt, nt0, fr, fq); pacc[0] += acc[0]; pacc[1] += acc[1]; store_T<0>(Pm0, pacc, mt, nt0, fr, fq);
        lds_barrier();
        zero_acc(acc); mm64(acc, Cb1, Pm0, mt, nt0, fr, fq); pacc[0] += acc[0]; pacc[1] += acc[1];
        store_T<0>(Tm, pacc, mt, nt0, fr, fq);
        lds_barrier();
        zero_acc(acc); mm64(acc, Tm, AtT, mt, nt0, fr, fq); store_T<0>(PT, acc, mt, nt0, fr, fq);
        zero_acc(acc); mm64(acc, Aak, VT, mt, nt0, fr, fq); store_T<0>(AkVT, acc, mt, nt0, fr, fq);
        lds_barrier();
        {
            zero_acc(acc); mm64(acc, Tm, AkVT, mt, nt0, fr, fq); store_T<0>(QT, acc, mt, nt0, fr, fq);
            zero_acc(acc); mm64(acc, PT, BtT, mt, nt0, fr, fq);
            bf16_t* Mo = Mg + (size_t)u * 4096;
#pragma unroll
            for (int nn = 0; nn < 2; ++nn) {
                const int C = (nt0 + nn) * 16 + fr, Rb = mt * 16 + fq * 4;
                const float wl = sWL[C];
                uint2 w; w.x = pack2(acc[nn][0] * wl, acc[nn][1] * wl); w.y = pack2(acc[nn][2] * wl, acc[nn][3] * wl);
                const int pos = (Rb & ~12) | ((Rb & 4) << 1) | ((Rb & 8) >> 1);
                const int posw = ((((pos >> 3) ^ (C & 7)) << 3) | (pos & 7));
                *reinterpret_cast<uint2*>(Mo + C * 64 + posw) = w;
            }
        }
        lds_barrier();
        {
            zero_acc(acc); mm64(acc, BtT, QT, mt, nt0, fr, fq); mm64(acc, KtT, VT, mt, nt0, fr, fq);
            bf16_t* No = Ng + (size_t)u * 4096;
            float wl[4];
#pragma unroll
            for (int j = 0; j < 4; ++j) wl[j] = sWL[mt * 16 + fq * 4 + j];
#pragma unroll
            for (int nn = 0; nn < 2; ++nn) {
                const int C = (nt0 + nn) * 16 + fr, Rb = mt * 16 + fq * 4;
                uint2 w; w.x = pack2(acc[nn][0] * wl[0], acc[nn][1] * wl[1]); w.y = pack2(acc[nn][2] * wl[2], acc[nn][3] * wl[3]);
                const int posw = ((((Rb >> 3) ^ (C & 7)) << 3) | (Rb & 7));
                *reinterpret_cast<uint2*>(No + C * 64 + posw) = w;
            }
            if (tid < 64) { WLg[(size_t)u * 64 + tid] = sWL[tid]; BCg[(size_t)u * 64 + tid] = sBC[tid]; }
            const size_t tok0 = (size_t)b * SEQ + n * 64;
            zero_acc(acc); mm64(acc, PT, Arb, mt, nt0, fr, fq);
#pragma unroll
            for (int nn = 0; nn < 2; ++nn) {
                const int C = (nt0 + nn) * 16 + fr, Rb = mt * 16 + fq * 4;
                const uint2 rt = *reinterpret_cast<const uint2*>(Rt + C * RC_LD + Rb);
                uint2 w;
                w.x = pack2(acc[nn][0] + __uint_as_float(rt.x << 16), acc[nn][1] + __uint_as_float(rt.x & 0xffff0000u));
                w.y = pack2(acc[nn][2] + __uint_as_float(rt.y << 16), acc[nn][3] + __uint_as_float(rt.y & 0xffff0000u));
                *reinterpret_cast<uint2*>(PRg + (tok0 + C) * 512 + h * 64 + Rb) = w;
            }
            zero_acc(acc); mm64(acc, QT, Arb, mt, nt0, fr, fq); mm64(acc, VT, Ark, mt, nt0, fr, fq);
#pragma unroll
            for (int nn = 0; nn < 2; ++nn) {
                const int C = (nt0 + nn) * 16 + fr, Rb = mt * 16 + fq * 4;
                uint2 w; w.x = pack2(acc[nn][0], acc[nn][1]); w.y = pack2(acc[nn][2], acc[nn][3]);
                *reinterpret_cast<uint2*>(YQg + (tok0 + C) * 512 + h * 64 + Rb) = w;
            }
        }
        cur = nxt;
        lds_barrier();
    }
}

typedef float f32x16 __attribute__((ext_vector_type(16)));
#define R2_SLOT 12800
__device__ __forceinline__ void r2_issue(const unsigned char* Mg, const unsigned char* Ng, const unsigned char* WLg, size_t u, int J, int lane,
                                         unsigned char* slot) {
#pragma unroll
    for (int i = 0; i < 8; ++i)
        __builtin_amdgcn_global_load_lds((const unsigned*)(Mg + u * 8192 + i * 1024 + lane * 16),
                                         (__attribute__((address_space(3))) unsigned*)(slot + i * 1024), 16, 0, 0);
#pragma unroll
    for (int i = 0; i < 4; ++i)
        __builtin_amdgcn_global_load_lds((const unsigned*)(Ng + u * 8192 + J * 4096 + i * 1024 + lane * 16),
                                         (__attribute__((address_space(3))) unsigned*)(slot + 8192 + i * 1024), 16, 0, 0);
    __builtin_amdgcn_global_load_lds((const unsigned*)(WLg + u * 256 + lane * 4),
                                     (__attribute__((address_space(3))) unsigned*)(slot + 12288), 4, 0, 0);
}
__device__ __forceinline__ unsigned lds_addr(const void* p) { return (unsigned)(size_t)(const __attribute__((address_space(3))) unsigned char*)p; }
template <int OFF> __device__ __forceinline__ void ldsr128(bf16x8& d, unsigned a) { asm volatile("ds_read_b128 %0, %1 offset:%2" : "=v"(d) : "v"(a), "n"(OFF)); }
template <int OFF> __device__ __forceinline__ void ldsr128f(float4& d, unsigned a) { asm volatile("ds_read_b128 %0, %1 offset:%2" : "=v"(d) : "v"(a), "n"(OFF)); }
template <int OFF> __device__ __forceinline__ void ldsr64(uint2& d, unsigned a) { asm volatile("ds_read_b64 %0, %1 offset:%2" : "=v"(d) : "v"(a), "n"(OFF)); }
template <int WAITN>
__device__ __forceinline__ void r2_step(f32x16 (&S)[2], const unsigned char* slot, bf16_t* so, int r, int h) {
    if (WAITN == 51) asm volatile("s_waitcnt vmcnt(51)" ::: "memory");
    else if (WAITN == 39) asm volatile("s_waitcnt vmcnt(39)" ::: "memory");
    else asm volatile("s_waitcnt vmcnt(0)" ::: "memory");
    uint2 nv[2][4]; float4 wl[2][4]; bf16x8 af[2][2][2];
    const unsigned sa = lds_addr(slot);
    {
        const unsigned aw = sa + 12288 + h * 16;
        ldsr128f<0>(wl[0][0], aw); ldsr128f<32>(wl[0][1], aw); ldsr128f<64>(wl[0][2], aw); ldsr128f<96>(wl[0][3], aw);
        ldsr128f<128>(wl[1][0], aw); ldsr128f<160>(wl[1][1], aw); ldsr128f<192>(wl[1][2], aw); ldsr128f<224>(wl[1][3], aw);
        const unsigned an = sa + 8192 + r * 128 + h * 8;
        const unsigned x0 = ((0 ^ (r & 7)) * 16), x1 = ((1 ^ (r & 7)) * 16), x2 = ((2 ^ (r & 7)) * 16), x3 = ((3 ^ (r & 7)) * 16);
        ldsr64<0>(nv[0][0], an + x0); ldsr64<0>(nv[0][1], an + x1); ldsr64<0>(nv[0][2], an + x2); ldsr64<0>(nv[0][3], an + x3);
        ldsr64<0>(nv[1][0], an + (x0 ^ 64)); ldsr64<0>(nv[1][1], an + (x1 ^ 64)); ldsr64<0>(nv[1][2], an + (x2 ^ 64)); ldsr64<0>(nv[1][3], an + (x3 ^ 64));
        const unsigned aa = sa + r * 128;
        const unsigned c00 = (((0 + h) ^ (r & 7)) * 16), c01 = (((2 + h) ^ (r & 7)) * 16), c10 = (((4 + h) ^ (r & 7)) * 16), c11 = (((6 + h) ^ (r & 7)) * 16);
        ldsr128<0>(af[0][0][0], aa + c00); ldsr128<0>(af[0][0][1], aa + c01); ldsr128<0>(af[0][1][0], aa + c10); ldsr128<0>(af[0][1][1], aa + c11);
        ldsr128<4096>(af[1][0][0], aa + c00); ldsr128<4096>(af[1][0][1], aa + c01); ldsr128<4096>(af[1][1][0], aa + c10); ldsr128<4096>(af[1][1][1], aa + c11);
    }
    unsigned pk[2][8];
#pragma unroll
    for (int K = 0; K < 2; ++K)
#pragma unroll
        for (int q = 0; q < 8; ++q) pk[K][q] = pack2(S[K][2 * q], S[K][2 * q + 1]);
#pragma unroll
    for (int I = 0; I < 2; ++I) {
        uint4 w0, w1;
        w0.x = pk[I][0]; w0.y = pk[I][1]; w0.z = pk[I][2]; w0.w = pk[I][3];
        w1.x = pk[I][4]; w1.y = pk[I][5]; w1.z = pk[I][6]; w1.w = pk[I][7];
        *reinterpret_cast<uint4*>(so + r * 64 + I * 32 + h * 16) = w0;
        *reinterpret_cast<uint4*>(so + r * 64 + I * 32 + h * 16 + 8) = w1;
    }
    asm volatile("s_waitcnt lgkmcnt(0)" ::: "memory");
    __builtin_amdgcn_sched_barrier(0);
    bf16x8 bfrag[2][2];
#pragma unroll
    for (int K = 0; K < 2; ++K)
#pragma unroll
        for (int s = 0; s < 2; ++s) {
            union { bf16x8 v; unsigned u[4]; } cvt;
#pragma unroll
            for (int q = 0; q < 4; ++q) cvt.u[q] = pk[K][4 * s + q];
            bfrag[K][s] = cvt.v;
        }
#pragma unroll
    for (int I = 0; I < 2; ++I) {
        f32x16 acc;
#pragma unroll
        for (int g = 0; g < 4; ++g) {
            acc[4 * g + 0] = __uint_as_float(nv[I][g].x << 16) + wl[I][g].x * S[I][4 * g + 0];
            acc[4 * g + 1] = __uint_as_float(nv[I][g].x & 0xffff0000u) + wl[I][g].y * S[I][4 * g + 1];
            acc[4 * g + 2] = __uint_as_float(nv[I][g].y << 16) + wl[I][g].z * S[I][4 * g + 2];
            acc[4 * g + 3] = __uint_as_float(nv[I][g].y & 0xffff0000u) + wl[I][g].w * S[I][4 * g + 3];
        }
#pragma unroll
        for (int K = 0; K < 2; ++K)
#pragma unroll
            for (int s = 0; s < 2; ++s) acc = __builtin_amdgcn_mfma_f32_32x32x16_bf16(af[I][K][s], bfrag[K][s], acc, 0, 0, 0);
        S[I] = acc;
    }
}
__device__ __forceinline__ void phase_rwkv_r2(const Params& p, unsigned char* smem) {
    const int tidx = otid(p.wave);
    if (obid() >= 64) { phase_pre(p, smem, 1, obid() - 64, ogdim() - 64); return; }
    if (p.wave != 0) return;
    const int task = obid(), bh = task >> 1, J = task & 1;
    const int lane = tidx & 63, r = lane & 31, h = lane >> 5;
    const unsigned char* Mg = p.ws + OFF_MB;
    const unsigned char* Ng = p.ws + OFF_NTB;
    const unsigned char* WLg = p.ws + OFF_WLB;
    f32x16 S[2];
#pragma unroll
    for (int i = 0; i < 16; ++i) { S[0][i] = 0.f; S[1][i] = 0.f; }
    const size_t ub = (size_t)bh * 128;
    r2_issue(Mg, Ng, WLg, ub + 0, J, lane, smem + 0 * R2_SLOT);
    r2_issue(Mg, Ng, WLg, ub + 1, J, lane, smem + 1 * R2_SLOT);
    r2_issue(Mg, Ng, WLg, ub + 2, J, lane, smem + 2 * R2_SLOT);
#define R2_STEP(n_, SL, W) do { \
        const int n2 = (n_); \
        if (n2 + 3 < 128) r2_issue(Mg, Ng, WLg, ub + n2 + 3, J, lane, smem + (((SL) + 3) & 3) * R2_SLOT); \
        r2_step<W>(S, smem + (SL) * R2_SLOT, s0_ptr(p.ws, (int)ub + n2) + (size_t)J * 32 * 64, r, h); } while (0)
    R2_STEP(0, 0, 39); R2_STEP(1, 1, 39); R2_STEP(2, 2, 39); R2_STEP(3, 3, 51);
#pragma unroll 1
    for (int n = 4; n < 124; n += 4) {
        R2_STEP(n, 0, 51); R2_STEP(n + 1, 1, 51); R2_STEP(n + 2, 2, 51); R2_STEP(n + 3, 3, 51);
    }
    R2_STEP(124, 0, 51); R2_STEP(125, 1, 0); R2_STEP(126, 2, 0); R2_STEP(127, 3, 0);
#undef R2_STEP
}

struct R3In { uint4 pr, s0; uint2 yq[2]; unsigned short v[8], g[8]; unsigned short pv; float bc[8]; };
__device__ __forceinline__ void r3_load(R3In& in, const Params& p, int u, int tid) {
    const int b = u >> 10, h = (u >> 7) & 7, n = u & 127;
    const int wv = tid >> 6, lane = tid & 63, fr = lane & 15, fq = lane >> 4, mt = wv >> 1, nt0 = (wv & 1) * 2;
    const size_t tok0 = (size_t)b * SEQ + n * 64;
    const bf16_t* PRg = reinterpret_cast<const bf16_t*>(p.ws + OFF_AA);
    const bf16_t* YQg = reinterpret_cast<const bf16_t*>(p.ws + OFF_LOGW);
    const bf16_t* GG = reinterpret_cast<const bf16_t*>(p.ws + OFF_GG);
    const bf16_t* P = reinterpret_cast<const bf16_t*>(p.ws + OFF_P);
    const float* BCg = reinterpret_cast<const float*>(p.ws + OFF_BCB);
    const int row = tid >> 3, ch = tid & 7;
    in.pr = *reinterpret_cast<const uint4*>(PRg + (tok0 + row) * 512 + h * 64 + ch * 8);
    in.s0 = reinterpret_cast<const uint4*>(s0_ptr(p.ws, u))[tid];
#pragma unroll
    for (int nn = 0; nn < 2; ++nn) in.yq[nn] = *reinterpret_cast<const uint2*>(YQg + (tok0 + (nt0 + nn) * 16 + fr) * 512 + h * 64 + mt * 16 + fq * 4);
    const int c = h * 64 + lane;
    const int s0i = n * 64 + wv * 8;
    in.pv = (s0i > 0) ? P[(tok0 + wv * 8 - 1) * 2304 + 1024 + c] : (unsigned short)0;
#pragma unroll
    for (int i = 0; i < 8; ++i) {
        in.v[i] = P[(tok0 + wv * 8 + i) * 2304 + 1024 + c];
        in.g[i] = GG[(tok0 + wv * 8 + i) * 512 + c];
        in.bc[i] = BCg[(size_t)u * 64 + wv * 8 + i];
    }
}
__device__ __forceinline__ void phase_rwkv_r3(const Params& p, unsigned char* smem) {
    const int tidx = otid(p.wave);
    const int tid = tidx, wv = tid >> 6, lane = tid & 63, fr = lane & 15, fq = lane >> 4, mt = wv >> 1, nt0 = (wv & 1) * 2;
    bf16_t* base = reinterpret_cast<bf16_t*>(smem);
    bf16_t* Prs = base; bf16_t* Sb = base + RC_BUF;
    float* Yf = reinterpret_cast<float*>(smem + 2 * RC_BYTES);
    bf16_t* YC = reinterpret_cast<bf16_t*>(p.ws + OFF_YCAT);
    R3In cur, nxt;
    if (obid() < 4096) r3_load(cur, p, obid(), tid);
    nxt = cur;
    for (int u = obid(); u < 4096; u += ogdim()) {
        const int b = u >> 10, h = (u >> 7) & 7, n = u & 127;
        const int c = h * 64 + lane;
        float mu_v = p.in[2][1024 + c], lng = p.in[11][c], lnb = p.in[12][c];
        asm volatile("" : "+v"(mu_v), "+v"(lng), "+v"(lnb));
        if (u + ogdim() < 4096) r3_load(nxt, p, u + ogdim(), tid);
        {
            const int row = tid >> 3, ch = tid & 7;
            *reinterpret_cast<uint4*>(Prs + row * RC_LD + ch * 8) = cur.pr;
            const int I = ch >> 2, hh = (ch >> 1) & 1, g0 = (ch & 1) * 2;
            const int k0 = I * 32 + 8 * g0 + 4 * hh;
            uint2 lo; lo.x = cur.s0.x; lo.y = cur.s0.y;
            uint2 hi; hi.x = cur.s0.z; hi.y = cur.s0.w;
            *reinterpret_cast<uint2*>(Sb + row * RC_LD + k0) = lo;
            *reinterpret_cast<uint2*>(Sb + row * RC_LD + k0 + 8) = hi;
        }
        lds_barrier();
        {
            f32x4 acc[2];
            zero_acc(acc);
            mm64(acc, Sb, Prs, mt, nt0, fr, fq);
#pragma unroll
            for (int nn = 0; nn < 2; ++nn) {
                const int C = (nt0 + nn) * 16 + fr, Rb = mt * 16 + fq * 4;
                const uint2 q = cur.yq[nn];
                float4 o;
                o.x = acc[nn][0] + __uint_as_float(q.x << 16); o.y = acc[nn][1] + __uint_as_float(q.x & 0xffff0000u);
                o.z = acc[nn][2] + __uint_as_float(q.y << 16); o.w = acc[nn][3] + __uint_as_float(q.y & 0xffff0000u);
                *reinterpret_cast<float4*>(Yf + C * 68 + Rb) = o;
            }
        }
        lds_barrier();
        {
            float pv = bf2f(cur.pv);
#pragma unroll
            for (int i = 0; i < 8; ++i) {
                const int t = wv * 8 + i;
                const size_t tok = (size_t)b * SEQ + n * 64 + t;
                const float y = Yf[t * 68 + lane];
                const float mean = wave_sum(y) * (1.0f / 64.0f);
                const float d = y - mean;
                const float var = wave_sum(d * d) * (1.0f / 64.0f);
                const float yn = d * rsqrtf(var + 64e-5f) * lng + lnb;
                const float g = bf2f(cur.g[i]);
                const float v0 = bf2f(cur.v[i]);
                const float vv = bf2f(f2bf(v0 + mu_v * (pv - v0)));
                pv = v0;
                YC[tok * 1024 + c] = f2bf((yn + cur.bc[i] * vv) * g);
            }
        }
        cur = nxt;
    }
}

#define LR_LD 1032
__device__ __forceinline__ void phase_ln_route(const Params& p, int layer, unsigned char* smem) {
    const bf16_t* X = reinterpret_cast<const bf16_t*>(p.ws + OFF_P);
    const int tidx = otid(p.wave);
    const int tid = tidx, wv = tid >> 6, lane = tid & 63, fr = lane & 15, fq = lane >> 4;
    const float* g = p.in[24] + layer * DM;
    const float* bb = p.in[25] + layer * DM;
    const float* rgb = p.in[27] + layer * 4;
    const float* reb = p.in[29] + layer * 32;
    const bf16_t* RH = reinterpret_cast<const bf16_t*>(p.ws + OFF_W) + WE_RT_HI + (size_t)layer * 48 * 1024;
    const bf16_t* RL = reinterpret_cast<const bf16_t*>(p.ws + OFF_W) + WE_RT_LO + (size_t)layer * 48 * 1024;
    bf16_t* XB = reinterpret_cast<bf16_t*>(p.ws + OFF_ACTB);
    int* cnt = reinterpret_cast<int*>(p.ws + OFF_CTRL) + layer * 32;
    int* ltok = reinterpret_cast<int*>(p.ws + OFF_LTOK);
    float* lgate = reinterpret_cast<float*>(p.ws + OFF_LGATE);
    bf16_t* sXH = reinterpret_cast<bf16_t*>(smem);
    bf16_t* sXL = sXH + 16 * LR_LD;
    float* sRed = reinterpret_cast<float*>(smem + 2 * 16 * LR_LD * 2);
    float* sLog = sRed + 8 * 16 * 48;
    bf16x8 bh[4][3], bl[4][3];
#pragma unroll
    for (int ks = 0; ks < 4; ++ks)
#pragma unroll
        for (int nt = 0; nt < 3; ++nt) {
            const int k0 = wv * 128 + ks * 32 + fq * 8;
            bh[ks][nt] = *reinterpret_cast<const bf16x8*>(RH + (size_t)(nt * 16 + fr) * 1024 + k0);
            bl[ks][nt] = *reinterpret_cast<const bf16x8*>(RL + (size_t)(nt * 16 + fr) * 1024 + k0);
        }
    float4 gg[4], bv[4];
#pragma unroll
    for (int i = 0; i < 4; ++i) {
        gg[i] = *reinterpret_cast<const float4*>(g + i * 256 + lane * 4);
        bv[i] = *reinterpret_cast<const float4*>(bb + i * 256 + lane * 4);
    }
    int* sCnt = reinterpret_cast<int*>(sLog + 16 * 48);
    int* sBase = sCnt + 32;
    int* sDecE = sBase + 32;
    int* sDecP = sDecE + 256;
    float* sDecG = reinterpret_cast<float*>(sDecP + 256);
    int* sDecR = reinterpret_cast<int*>(sDecG + 256);
    if (tid < 32) sCnt[tid] = 0;
    uint2 pre[2][4];
    {
        const int tile0 = obid();
        if (tile0 < NT / 16) {
#pragma unroll
            for (int rr = 0; rr < 2; ++rr)
#pragma unroll
                for (int i = 0; i < 4; ++i)
                    pre[rr][i] = *reinterpret_cast<const uint2*>(X + (size_t)(tile0 * 16 + wv * 2 + rr) * DM + i * 256 + lane * 4);
        }
    }
    __syncthreads();
    int nloc = 0;
    for (int tile = obid(); tile < NT / 16; tile += ogdim(), ++nloc) {
        uint2 cur[2][4];
#pragma unroll
        for (int rr = 0; rr < 2; ++rr)
#pragma unroll
            for (int i = 0; i < 4; ++i) cur[rr][i] = pre[rr][i];
        {
            const int tn = tile + ogdim();
            if (tn < NT / 16) {
#pragma unroll
                for (int rr = 0; rr < 2; ++rr)
#pragma unroll
                    for (int i = 0; i < 4; ++i)
                        pre[rr][i] = *reinterpret_cast<const uint2*>(X + (size_t)(tn * 16 + wv * 2 + rr) * DM + i * 256 + lane * 4);
            }
        }
#pragma unroll
        for (int rr = 0; rr < 2; ++rr) {
            const int rl = wv * 2 + rr;
            const int row = tile * 16 + rl;
            float v[16];
#pragma unroll
            for (int i = 0; i < 4; ++i) {
                const uint2 t = cur[rr][i];
                v[4 * i] = __uint_as_float(t.x << 16); v[4 * i + 1] = __uint_as_float(t.x & 0xffff0000u);
                v[4 * i + 2] = __uint_as_float(t.y << 16); v[4 * i + 3] = __uint_as_float(t.y & 0xffff0000u);
            }
            float sum = 0.f;
#pragma unroll
            for (int i = 0; i < 16; ++i) sum += v[i];
            const float mean = wave_sum(sum) * (1.0f / DM);
            float sq = 0.f;
#pragma unroll
            for (int i = 0; i < 16; ++i) { float d = v[i] - mean; sq += d * d; }
            const float rstd = rsqrtf(wave_sum(sq) * (1.0f / DM) + 1e-5f);
#pragma unroll
            for (int i = 0; i < 4; ++i) {
                const int col = i * 256 + lane * 4;
                const float o0 = (v[4 * i] - mean) * rstd * gg[i].x + bv[i].x;
                const float o1 = (v[4 * i + 1] - mean) * rstd * gg[i].y + bv[i].y;
                const float o2 = (v[4 * i + 2] - mean) * rstd * gg[i].z + bv[i].z;
                const float o3 = (v[4 * i + 3] - mean) * rstd * gg[i].w + bv[i].w;
                const bf16_t h0 = f2bf(o0), h1 = f2bf(o1), h2 = f2bf(o2), h3 = f2bf(o3);
                uint2 wh; wh.x = (unsigned)h0 | ((unsigned)h1 << 16); wh.y = (unsigned)h2 | ((unsigned)h3 << 16);
                *reinterpret_cast<uint2*>(XB + (size_t)row * DM + col) = wh;
                *reinterpret_cast<uint2*>(sXH + rl * LR_LD + col) = wh;
                uint2 wl; wl.x = pack2(o0 - bf2f(h0), o1 - bf2f(h1)); wl.y = pack2(o2 - bf2f(h2), o3 - bf2f(h3));
                *reinterpret_cast<uint2*>(sXL + rl * LR_LD + col) = wl;
            }
        }
        lds_barrier();
        {
            f32x4 acc[3];
#pragma unroll
            for (int nt = 0; nt < 3; ++nt) acc[nt] = (f32x4){0.f, 0.f, 0.f, 0.f};
#pragma unroll
            for (int ks = 0; ks < 4; ++ks) {
                const int k0 = wv * 128 + ks * 32 + fq * 8;
                const bf16x8 ah = *reinterpret_cast<const bf16x8*>(sXH + fr * LR_LD + k0);
                const bf16x8 al = *reinterpret_cast<const bf16x8*>(sXL + fr * LR_LD + k0);
#pragma unroll
                for (int nt = 0; nt < 3; ++nt) {
                    acc[nt] = __builtin_amdgcn_mfma_f32_16x16x32_bf16(ah, bh[ks][nt], acc[nt], 0, 0, 0);
                    acc[nt] = __builtin_amdgcn_mfma_f32_16x16x32_bf16(al, bh[ks][nt], acc[nt], 0, 0, 0);
                    acc[nt] = __builtin_amdgcn_mfma_f32_16x16x32_bf16(ah, bl[ks][nt], acc[nt], 0, 0, 0);
                }
            }
#pragma unroll
            for (int nt = 0; nt < 3; ++nt)
#pragma unroll
                for (int j = 0; j < 4; ++j) sRed[(wv * 16 + fq * 4 + j) * 48 + nt * 16 + fr] = acc[nt][j];
        }
        lds_barrier();
        for (int idx = tid; idx < 16 * 48; idx += NTHREADS) {
            float s = 0.f;
#pragma unroll
            for (int w = 0; w < 8; ++w) s += sRed[w * 16 * 48 + idx];
            sLog[idx] = s;
        }
        lds_barrier();
        if (tid < 16) {
            const int row = tile * 16 + tid;
            const float* lg = sLog + tid * 48;
            float gl[4];
#pragma unroll
            for (int j = 0; j < 4; ++j) gl[j] = lg[j] + rgb[j];
            int gi = 0; float gm = gl[0];
#pragma unroll
            for (int j = 1; j < 4; ++j) if (gl[j] > gm) { gm = gl[j]; gi = j; }
            float gs = 0.f;
#pragma unroll
            for (int j = 0; j < 4; ++j) gs += __expf(gl[j] - gm);
            const float gw = 1.0f / gs;
            float el[8];
#pragma unroll
            for (int j = 0; j < 8; ++j) el[j] = lg[4 + gi * 8 + j] + reb[gi * 8 + j];
            int i1 = 0; float m1 = el[0];
#pragma unroll
            for (int j = 1; j < 8; ++j) if (el[j] > m1) { m1 = el[j]; i1 = j; }
            int i2 = (i1 == 0) ? 1 : 0; float m2 = el[i2];
#pragma unroll
            for (int j = 0; j < 8; ++j) if (j != i1 && el[j] > m2) { m2 = el[j]; i2 = j; }
            const float e2 = __expf(m2 - m1);
            const float p1 = 1.0f / (1.0f + e2), p2 = e2 / (1.0f + e2);
            const int ex1 = gi * 8 + i1, ex2 = gi * 8 + i2;
            const int d0 = (nloc * 16 + tid) * 2;
            sDecE[d0] = ex1; sDecP[d0] = atomicAdd(&sCnt[ex1], 1); sDecG[d0] = gw * p1; sDecR[d0] = row * 2;
            sDecE[d0 + 1] = ex2; sDecP[d0 + 1] = atomicAdd(&sCnt[ex2], 1); sDecG[d0 + 1] = gw * p2; sDecR[d0 + 1] = row * 2 + 1;
        }
    }
    __syncthreads();
    if (tid < 32) sBase[tid] = atomicAdd(&cnt[tid], sCnt[tid]);
    __syncthreads();
    if (tid < nloc * 32) {
        const int ex = sDecE[tid];
        const size_t pos = (size_t)ex * NT + sBase[ex] + sDecP[tid];
        ltok[pos] = sDecR[tid];
        lgate[pos] = sDecG[tid];
    }
    __syncthreads();
}

__device__ __forceinline__ void phase_exp1(const Params& p, int layer, bf16_t* smem) {
    const int* cnt = reinterpret_cast<const int*>(p.ws + OFF_CTRL) + layer * 32;
    const int* ltok = reinterpret_cast<const int*>(p.ws + OFF_LTOK);
    const bf16_t* XB = reinterpret_cast<const bf16_t*>(p.ws + OFF_ACTB);
    const bf16_t* W13 = reinterpret_cast<const bf16_t*>(p.ws + OFF_W) + WE_W13 + (size_t)layer * 32 * 262144;
    bf16_t* H = reinterpret_cast<bf16_t*>(p.ws + OFF_HBUF);
    int t = obid();
    int base = 0, tbase = 0;
    for (int e = 0; e < 32; ++e) {
        int c = cnt[e];
        int nt = ((c + 255) >> 8) * 2;
        while (t < tbase + nt) {
            int w = t - tbase;
            EpiExp1 epi{H, base, c};
            gemm_tile<true>(XB, DM, ltok + (size_t)e * NT, c, W13 + (size_t)e * 262144, DM, DM, (w >> 1) * 256, (w & 1) * 128, epi, smem, p.wave);
            t += ogdim();
        }
        tbase += nt; base += c;
    }
}
__device__ __forceinline__ void phase_exp2(const Params& p, int layer, bf16_t* smem) {
    const int* cnt = reinterpret_cast<const int*>(p.ws + OFF_CTRL) + layer * 32;
    const int* ltok = reinterpret_cast<const int*>(p.ws + OFF_LTOK);
    const float* lgate = reinterpret_cast<const float*>(p.ws + OFF_LGATE);
    const bf16_t* W2 = reinterpret_cast<const bf16_t*>(p.ws + OFF_W) + WE_W2 + (size_t)layer * 32 * 131072;
    const bf16_t* H = reinterpret_cast<const bf16_t*>(p.ws + OFF_HBUF);
    bf16_t* FS = reinterpret_cast<bf16_t*>(p.ws + OFF_FS);
    int t = obid();
    int base = 0, tbase = 0;
    for (int e = 0; e < 32; ++e) {
        int c = cnt[e];
        int nt = ((c + 255) >> 8) * 8;
        while (t < tbase + nt) {
            int w = t - tbase;
            EpiExp2 epi;
            epi.FS = FS; epi.cnt = c;
            {
                const int tq = otid(p.wave), wq = tq >> 6, lq = tq & 63;
#pragma unroll
                for (int m = 0; m < 4; ++m) {
                    int li = (w >> 3) * 256 + (wq >> 1) * 64 + m * 16 + (lq & 15);
                    li = li < c ? li : c - 1;
                    epi.pk[m] = ltok[(size_t)e * NT + li]; epi.g[m] = lgate[(size_t)e * NT + li];
                }
            }
            gemm_tile<false>(H + (size_t)base * 128, 128, nullptr, 0, W2 + (size_t)e * 131072, 128, 128, (w >> 3) * 256, (w & 7) * 128, epi, smem, p.wave);
            t += ogdim();
        }
        tbase += nt; base += c;
    }
}

__device__ __forceinline__ void phase_ln_ffn(const Params& p, int layer, float* Xout, bool last) {
    const int tidx = otid(p.wave);
    const int tid = tidx, wv = tid >> 6, lane = tid & 63;
    const float* g = p.in[33] + layer * DM;
    const float* bb = p.in[34] + layer * DM;
    const bf16_t* FS = reinterpret_cast<const bf16_t*>(p.ws + OFF_FS);
    bf16_t* XB = reinterpret_cast<bf16_t*>(p.ws + OFF_ACTB);
    float4 gg[4], bv[4];
#pragma unroll
    for (int i = 0; i < 4; ++i) {
        gg[i] = *reinterpret_cast<const float4*>(g + i * 256 + lane * 4);
        bv[i] = *reinterpret_cast<const float4*>(bb + i * 256 + lane * 4);
    }
    asm volatile("" : "+v"(gg[0].x), "+v"(bv[3].w));
    const int row0 = obid() * NWAVES + wv, rstep = ogdim() * NWAVES;
    uint2 pt[4], pf0[4], pf1[4];
    if (row0 < NT) {
#pragma unroll
        for (int i = 0; i < 4; ++i) {
            const int col = i * 256 + lane * 4;
            pt[i] = *reinterpret_cast<const uint2*>(XB + (size_t)row0 * DM + col);
            pf0[i] = *reinterpret_cast<const uint2*>(FS + (size_t)row0 * DM + col);
            pf1[i] = *reinterpret_cast<const uint2*>(FS + ((size_t)NT + row0) * DM + col);
        }
    }
    for (int row = row0; row < NT; row += rstep) {
        uint2 t[4], f0[4], f1[4];
#pragma unroll
        for (int i = 0; i < 4; ++i) { t[i] = pt[i]; f0[i] = pf0[i]; f1[i] = pf1[i]; }
        if (row + rstep < NT) {
            const size_t rn = (size_t)(row + rstep);
#pragma unroll
            for (int i = 0; i < 4; ++i) {
                const int col = i * 256 + lane * 4;
                pt[i] = *reinterpret_cast<const uint2*>(XB + rn * DM + col);
                pf0[i] = *reinterpret_cast<const uint2*>(FS + rn * DM + col);
                pf1[i] = *reinterpret_cast<const uint2*>(FS + ((size_t)NT + rn) * DM + col);
            }
        }
        float v[16];
#pragma unroll
        for (int i = 0; i < 4; ++i) {
            v[4 * i] = ALPHA_F * __uint_as_float(t[i].x << 16) + __uint_as_float(f0[i].x << 16) + __uint_as_float(f1[i].x << 16);
            v[4 * i + 1] = ALPHA_F * __uint_as_float(t[i].x & 0xffff0000u) + __uint_as_float(f0[i].x & 0xffff0000u) + __uint_as_float(f1[i].x & 0xffff0000u);
            v[4 * i + 2] = ALPHA_F * __uint_as_float(t[i].y << 16) + __uint_as_float(f0[i].y << 16) + __uint_as_float(f1[i].y << 16);
            v[4 * i + 3] = ALPHA_F * __uint_as_float(t[i].y & 0xffff0000u) + __uint_as_float(f0[i].y & 0xffff0000u) + __uint_as_float(f1[i].y & 0xffff0000u);
        }
        float sum = 0.f;
#pragma unroll
        for (int i = 0; i < 16; ++i) sum += v[i];
        float mean = wave_sum(sum) * (1.0f / DM);
        float sq = 0.f;
#pragma unroll
        for (int i = 0; i < 16; ++i) { float d = v[i] - mean; sq += d * d; }
        float rstd = rsqrtf(wave_sum(sq) * (1.0f / DM) + 1e-5f);
#pragma unroll
        for (int i = 0; i < 4; ++i) {
            int col = i * 256 + lane * 4;
            float o0 = (v[4 * i] - mean) * rstd * gg[i].x + bv[i].x;
            float o1 = (v[4 * i + 1] - mean) * rstd * gg[i].y + bv[i].y;
            float o2 = (v[4 * i + 2] - mean) * rstd * gg[i].z + bv[i].z;
            float o3 = (v[4 * i + 3] - mean) * rstd * gg[i].w + bv[i].w;
            if (last) {
                *reinterpret_cast<float4*>(Xout + (size_t)row * DM + col) = make_float4(o0, o1, o2, o3);
            } else {
                uint2 w; w.x = pack2(o0, o1); w.y = pack2(o2, o3);
                *reinterpret_cast<uint2*>(XB + (size_t)row * DM + col) = w;
            }
        }
    }
}

#define CV_T 64
#define CV_ROWS (CV_T + 30)
template <int OB>
__device__ __forceinline__ void conv_blk(float (&acc)[CV_T], const bf16_t* sU, int tid, const float (&w0)[31]) {
#pragma unroll
    for (int rr = 0; rr < 38; ++rr) {
        const float uv = bf2f(sU[(OB * 8 + rr) * 512 + tid]);
#pragma unroll
        for (int oo = 0; oo < 8; ++oo) {
            const int j = rr - oo;
            if (j >= 0 && j <= 30) acc[OB * 8 + oo] += uv * w0[j];
        }
    }
}
__device__ __forceinline__ void phase_l1_conv(const Params& p, unsigned char* smem) {
    const int tidx = otid(p.wave);
    const bf16_t* P = reinterpret_cast<const bf16_t*>(p.ws + OFF_P);
    bf16_t* YC = reinterpret_cast<bf16_t*>(p.ws + OFF_YCAT);
    bf16_t* sU = reinterpret_cast<bf16_t*>(smem);
    float* red = reinterpret_cast<float*>(smem + CV_ROWS * 512 * 2);
    float* stat = red + 8 * 64 * 2;
    const int tid = tidx, wv = tid >> 6, lane = tid & 63;
    const float* cw = p.in[17];
    float w0[31];
#pragma unroll
    for (int j = 0; j < 31; ++j) w0[j] = cw[j * 512 + tid];
    const float cb0 = p.in[18][tid], g0 = p.in[19][tid], b0 = p.in[20][tid];
    for (int u = obid(); u < NT / CV_T; u += ogdim()) {
        const int t0 = u * CV_T;
        const int s0 = t0 & (SEQ - 1);
#pragma unroll 1
        for (int base = 0; base < CV_ROWS * 64; base += 6 * NTHREADS) {
            uint4 av[6], gv[6];
#pragma unroll
            for (int j = 0; j < 6; ++j) {
                const int it = base + j * NTHREADS + tid;
                const int r = it >> 6, c8 = (it & 63) * 8;
                av[j] = make_uint4(0u, 0u, 0u, 0u); gv[j] = av[j];
                if (it < CV_ROWS * 64 && s0 - 30 + r >= 0) {
                    const bf16_t* pr = P + (size_t)(t0 - 30 + r) * 3072 + c8;
                    av[j] = *reinterpret_cast<const uint4*>(pr);
                    gv[j] = *reinterpret_cast<const uint4*>(pr + 512);
                }
            }
#pragma unroll
            for (int j = 0; j < 6; ++j) {
                const int it = base + j * NTHREADS + tid;
                if (it < CV_ROWS * 64) {
                    const int r = it >> 6, c8 = (it & 63) * 8;
                    float a[8], gte[8];
                    unpack8(av[j], a); unpack8(gv[j], gte);
#pragma unroll
                    for (int i = 0; i < 8; ++i) a[i] = a[i] * sigmoidf_(gte[i]);
                    uint4 w;
                    w.x = pack2(a[0], a[1]); w.y = pack2(a[2], a[3]); w.z = pack2(a[4], a[5]); w.w = pack2(a[6], a[7]);
                    *reinterpret_cast<uint4*>(sU + r * 512 + c8) = w;
                }
            }
        }
        __syncthreads();
        float acc[CV_T];
#pragma unroll
        for (int o = 0; o < CV_T; ++o) acc[o] = cb0;
        conv_blk<0>(acc, sU, tid, w0); conv_blk<1>(acc, sU, tid, w0); conv_blk<2>(acc, sU, tid, w0); conv_blk<3>(acc, sU, tid, w0);
        conv_blk<4>(acc, sU, tid, w0); conv_blk<5>(acc, sU, tid, w0); conv_blk<6>(acc, sU, tid, w0); conv_blk<7>(acc, sU, tid, w0);
#pragma unroll
        for (int o = 0; o < CV_T; ++o) {
            const float s1 = wave_sum(acc[o]);
            const float s2 = wave_sum(acc[o] * acc[o]);
            if (lane == 0) { red[(wv * 64 + o) * 2] = s1; red[(wv * 64 + o) * 2 + 1] = s2; }
        }
        __syncthreads();
        if (tid < 64) {
            float s1 = 0.f, s2 = 0.f;
#pragma unroll
            for (int w = 0; w < 8; ++w) { s1 += red[(w * 64 + tid) * 2]; s2 += red[(w * 64 + tid) * 2 + 1]; }
            const float mean = s1 * (1.0f / 512.0f);
            const float var = fmaxf(s2 * (1.0f / 512.0f) - mean * mean, 0.f);
            stat[tid * 2] = mean; stat[tid * 2 + 1] = rsqrtf(var + 1e-5f);
        }
        __syncthreads();
#pragma unroll
        for (int o = 0; o < CV_T; ++o) {
            const float mean = stat[o * 2], rstd = stat[o * 2 + 1];
            const float y0 = (acc[o] - mean) * rstd * g0 + b0;
            YC[(size_t)(t0 + o) * 1024 + tid] = f2bf(siluf_(y0));
        }
    }
}

__device__ __forceinline__ float ret_lg(int h) { return log1pf(-exp2f(-5.0f - (float)h)); }

#define KT_LD 136
struct RetIn { uint4 k1, k2, v1, v2; };
__device__ __forceinline__ void ret_load_kv(RetIn& in, const bf16_t* P, int u, int tid) {
    const int n = u & 63, h = (u >> 6) & 7, b = u >> 9;
    const int c = tid >> 2, i0 = (tid & 3) * 8;
    const size_t tok = (size_t)b * SEQ + n * 128 + c;
    const bf16_t* kr = P + tok * 3072 + 1536 + h * 64;
    const bf16_t* vr = P + tok * 3072 + 2048 + h * 64;
    in.k1 = *reinterpret_cast<const uint4*>(kr + i0); in.k2 = *reinterpret_cast<const uint4*>(kr + 32 + i0);
    in.v1 = *reinterpret_cast<const uint4*>(vr + i0); in.v2 = *reinterpret_cast<const uint4*>(vr + 32 + i0);
}
__device__ __forceinline__ void st_col8(bf16_t* dst, int ld, const uint4 v) {
    dst[0 * ld] = (bf16_t)(v.x & 0xffffu); dst[1 * ld] = (bf16_t)(v.x >> 16);
    dst[2 * ld] = (bf16_t)(v.y & 0xffffu); dst[3 * ld] = (bf16_t)(v.y >> 16);
    dst[4 * ld] = (bf16_t)(v.z & 0xffffu); dst[5 * ld] = (bf16_t)(v.z >> 16);
    dst[6 * ld] = (bf16_t)(v.w & 0xffffu); dst[7 * ld] = (bf16_t)(v.w >> 16);
}
__device__ __forceinline__ void phase_ret_kv(const Params& p, unsigned char* smem) {
    const int tidx = otid(p.wave);
    const bf16_t* P = reinterpret_cast<const bf16_t*>(p.ws + OFF_P);
    const float2* rope = reinterpret_cast<const float2*>(p.ws + OFF_ROPE);
    float* KVT = reinterpret_cast<float*>(p.ws + OFF_KVT);
    bf16_t* sKT = reinterpret_cast<bf16_t*>(smem);
    bf16_t* sVT = sKT + 64 * KT_LD;
    const int tid = tidx, wv = tid >> 6, lane = tid & 63, fr = lane & 15, fq = lane >> 4;
    const int et = wv >> 1, dt0 = (wv & 1) * 2;
    RetIn cur, nxt;
    if (obid() < 2048) ret_load_kv(cur, P, obid(), tid);
    nxt = cur;
    for (int u = obid(); u < 2048; u += ogdim()) {
        const int n = u & 63, h = (u >> 6) & 7;
        const float lg = ret_lg(h);
        const int c = tid >> 2, i0 = (tid & 3) * 8;
        const int sidx = n * 128 + c;
        float2 cs[8];
#pragma unroll
        for (int i = 0; i < 8; ++i) cs[i] = rope[sidx * 32 + i0 + i];
        asm volatile("" : "+v"(cs[0].x), "+v"(cs[7].y));
        if (u + ogdim() < 2048) ret_load_kv(nxt, P, u + ogdim(), tid);
        {
            const float zeta = __expf((float)(127 - c) * lg) * 0.125f;
            float k1[8], k2[8];
            unpack8(cur.k1, k1); unpack8(cur.k2, k2);
#pragma unroll
            for (int i = 0; i < 8; ++i) {
                float o1 = (k1[i] * cs[i].x - k2[i] * cs[i].y) * zeta, o2 = (k1[i] * cs[i].y + k2[i] * cs[i].x) * zeta;
                sKT[(i0 + i) * KT_LD + c] = f2bf(o1);
                sKT[(32 + i0 + i) * KT_LD + c] = f2bf(o2);
            }
            st_col8(sVT + i0 * KT_LD + c, KT_LD, cur.v1);
            st_col8(sVT + (32 + i0) * KT_LD + c, KT_LD, cur.v2);
        }
        lds_barrier();
        f32x4 acc[2];
        acc[0] = (f32x4){0.f, 0.f, 0.f, 0.f}; acc[1] = (f32x4){0.f, 0.f, 0.f, 0.f};
#pragma unroll
        for (int ks = 0; ks < 4; ++ks) {
            bf16x8 af = *reinterpret_cast<const bf16x8*>(sVT + (et * 16 + fr) * KT_LD + ks * 32 + fq * 8);
#pragma unroll
            for (int nn = 0; nn < 2; ++nn) {
                bf16x8 bfr = *reinterpret_cast<const bf16x8*>(sKT + ((dt0 + nn) * 16 + fr) * KT_LD + ks * 32 + fq * 8);
                acc[nn] = __builtin_amdgcn_mfma_f32_16x16x32_bf16(af, bfr, acc[nn], 0, 0, 0);
            }
        }
        float* o = KVT + (size_t)u * 4096;
#pragma unroll
        for (int nn = 0; nn < 2; ++nn)
#pragma unroll
            for (int j = 0; j < 4; ++j) o[(et * 16 + fq * 4 + j) * 64 + (dt0 + nn) * 16 + fr] = acc[nn][j];
        cur = nxt;
        lds_barrier();
    }
}
__device__ __forceinline__ void phase_ret_scan(const Params& p) {
    const int tidx = otid(p.wave);
    float* KVT = reinterpret_cast<float*>(p.ws + OFF_KVT);
    for (int i = obid() * NTHREADS + tidx; i < 32 * 4096; i += ogdim() * NTHREADS) {
        int bh = i >> 12, ed = i & 4095, h = bh & 7;
        float gc = __expf(128.0f * ret_lg(h));
        float R = 0.f;
        float* q = KVT + (size_t)bh * 64 * 4096 + ed;
#pragma unroll 1
        for (int n0 = 0; n0 < 64; n0 += 16) {
            float kv[16];
#pragma unroll
            for (int j = 0; j < 16; ++j) kv[j] = q[(size_t)(n0 + j) * 4096];
#pragma unroll
            for (int j = 0; j < 16; ++j) { q[(size_t)(n0 + j) * 4096] = R; R = gc * R + kv[j]; }
        }
    }
}
#define Q_LD 72
struct RetOutIn { uint4 q1, q2, k1, k2, v1, v2; float4 r0, r1; unsigned short gr[16]; };
__device__ __forceinline__ void ret_load_out(RetOutIn& in, const bf16_t* P, const float* KVT, int u, int tid) {
    const int n = u & 63, h = (u >> 6) & 7, b = u >> 9;
    const int c = tid >> 2, i0 = (tid & 3) * 8;
    const size_t tok = (size_t)b * SEQ + n * 128 + c;
    const bf16_t* qr = P + tok * 3072 + 1024 + h * 64;
    in.q1 = *reinterpret_cast<const uint4*>(qr + i0); in.q2 = *reinterpret_cast<const uint4*>(qr + 32 + i0);
    in.k1 = *reinterpret_cast<const uint4*>(qr + 512 + i0); in.k2 = *reinterpret_cast<const uint4*>(qr + 512 + 32 + i0);
    in.v1 = *reinterpret_cast<const uint4*>(qr + 1024 + i0); in.v2 = *reinterpret_cast<const uint4*>(qr + 1024 + 32 + i0);
    const float* rp = KVT + (size_t)u * 4096 + tid * 8;
    in.r0 = *reinterpret_cast<const float4*>(rp); in.r1 = *reinterpret_cast<const float4*>(rp + 4);
    const int wv = tid >> 6, lane = tid & 63, fr = lane & 15, fq = lane >> 4;
#pragma unroll
    for (int j = 0; j < 4; ++j)
#pragma unroll
        for (int nn = 0; nn < 4; ++nn)
            in.gr[j * 4 + nn] = P[((size_t)b * SEQ + n * 128 + wv * 16 + fq * 4 + j) * 3072 + 2560 + h * 64 + nn * 16 + fr];
}
__device__ __forceinline__ void phase_ret_out(const Params& p, unsigned char* smem) {
    const int tidx = otid(p.wave);
    const bf16_t* P = reinterpret_cast<const bf16_t*>(p.ws + OFF_P);
    const float2* rope = reinterpret_cast<const float2*>(p.ws + OFF_ROPE);
    const float* KVT = reinterpret_cast<const float*>(p.ws + OFF_KVT);
    bf16_t* YC = reinterpret_cast<bf16_t*>(p.ws + OFF_YCAT);
    bf16_t* sQ = reinterpret_cast<bf16_t*>(smem);
    bf16_t* sK = sQ + 128 * Q_LD;
    bf16_t* sVT = sK + 128 * Q_LD;
    bf16_t* sRT = sVT + 64 * KT_LD;
    bf16_t* sS = sQ;
    const int tid = tidx, wv = tid >> 6, lane = tid & 63, fr = lane & 15, fq = lane >> 4;
    RetOutIn cur, nxt;
    if (obid() < 2048) ret_load_out(cur, P, KVT, obid(), tid);
    nxt = cur;
    for (int u = obid(); u < 2048; u += ogdim()) {
        const int n = u & 63, h = (u >> 6) & 7, b = u >> 9;
        const float lg = ret_lg(h);
        const int c = tid >> 2, i0 = (tid & 3) * 8;
        const int sidx = n * 128 + c;
        float2 cs[8];
#pragma unroll
        for (int i = 0; i < 8; ++i) cs[i] = rope[sidx * 32 + i0 + i];
        float gng[4], gnb[4];
#pragma unroll
        for (int nn = 0; nn < 4; ++nn) { gng[nn] = p.in[21][h * 64 + nn * 16 + fr]; gnb[nn] = p.in[22][h * 64 + nn * 16 + fr]; }
        asm volatile("" : "+v"(cs[0].x), "+v"(cs[7].y), "+v"(gng[0]), "+v"(gnb[3]));
        if (u + ogdim() < 2048) ret_load_out(nxt, P, KVT, u + ogdim(), tid);
        {
            float qa[8], qb[8], ka[8], kb[8];
            float q1[8], q2[8], k1[8], k2[8];
            unpack8(cur.q1, q1); unpack8(cur.q2, q2); unpack8(cur.k1, k1); unpack8(cur.k2, k2);
#pragma unroll
            for (int i = 0; i < 8; ++i) {
                qa[i] = q1[i] * cs[i].x - q2[i] * cs[i].y; qb[i] = q1[i] * cs[i].y + q2[i] * cs[i].x;
                ka[i] = (k1[i] * cs[i].x - k2[i] * cs[i].y) * 0.125f; kb[i] = (k1[i] * cs[i].y + k2[i] * cs[i].x) * 0.125f;
            }
            st_col8(sVT + i0 * KT_LD + c, KT_LD, cur.v1);
            st_col8(sVT + (32 + i0) * KT_LD + c, KT_LD, cur.v2);
            uint4 w;
            w.x = pack2(qa[0], qa[1]); w.y = pack2(qa[2], qa[3]); w.z = pack2(qa[4], qa[5]); w.w = pack2(qa[6], qa[7]);
            *reinterpret_cast<uint4*>(sQ + c * Q_LD + i0) = w;
            w.x = pack2(qb[0], qb[1]); w.y = pack2(qb[2], qb[3]); w.z = pack2(qb[4], qb[5]); w.w = pack2(qb[6], qb[7]);
            *reinterpret_cast<uint4*>(sQ + c * Q_LD + 32 + i0) = w;
            w.x = pack2(ka[0], ka[1]); w.y = pack2(ka[2], ka[3]); w.z = pack2(ka[4], ka[5]); w.w = pack2(ka[6], ka[7]);
            *reinterpret_cast<uint4*>(sK + c * Q_LD + i0) = w;
            w.x = pack2(kb[0], kb[1]); w.y = pack2(kb[2], kb[3]); w.z = pack2(kb[4], kb[5]); w.w = pack2(kb[6], kb[7]);
            *reinterpret_cast<uint4*>(sK + c * Q_LD + 32 + i0) = w;
            w.x = pack2(cur.r0.x, cur.r0.y); w.y = pack2(cur.r0.z, cur.r0.w); w.z = pack2(cur.r1.x, cur.r1.y); w.w = pack2(cur.r1.z, cur.r1.w);
            *reinterpret_cast<uint4*>(sRT + (tid >> 3) * Q_LD + (tid & 7) * 8) = w;
        }
        lds_barrier();
        f32x4 accs[8], accc[4];
#pragma unroll
        for (int nn = 0; nn < 8; ++nn) accs[nn] = (f32x4){0.f, 0.f, 0.f, 0.f};
#pragma unroll
        for (int nn = 0; nn < 4; ++nn) accc[nn] = (f32x4){0.f, 0.f, 0.f, 0.f};
#pragma unroll
        for (int ks = 0; ks < 2; ++ks) {
            bf16x8 af = *reinterpret_cast<const bf16x8*>(sQ + (wv * 16 + fr) * Q_LD + ks * 32 + fq * 8);
#pragma unroll
            for (int nn = 0; nn < 8; ++nn) {
                bf16x8 bfr = *reinterpret_cast<const bf16x8*>(sK + (nn * 16 + fr) * Q_LD + ks * 32 + fq * 8);
                accs[nn] = __builtin_amdgcn_mfma_f32_16x16x32_bf16(af, bfr, accs[nn], 0, 0, 0);
            }
#pragma unroll
            for (int nn = 0; nn < 4; ++nn) {
                bf16x8 bfr = *reinterpret_cast<const bf16x8*>(sRT + (nn * 16 + fr) * Q_LD + ks * 32 + fq * 8);
                accc[nn] = __builtin_amdgcn_mfma_f32_16x16x32_bf16(af, bfr, accc[nn], 0, 0, 0);
            }
        }
        lds_barrier();
        bf16_t* mS = sS + wv * 16 * KT_LD;
        {
            float e1[4], e1m[4];
#pragma unroll
            for (int j = 0; j < 4; ++j) {
                e1[j] = __expf((float)(fq * 4 + j - fr) * lg);
                e1m[j] = (fq * 4 + j >= fr) ? e1[j] : 0.f;
            }
#pragma unroll
            for (int nn = 0; nn < 8; ++nn) {
                const float e2 = (nn < wv) ? __expf((float)(16 * (wv - nn)) * lg) : 0.f;
                const bool diag = (nn == wv);
                float v[4];
#pragma unroll
                for (int j = 0; j < 4; ++j) v[j] = accs[nn][j] * (diag ? e1m[j] : e2 * e1[j]);
#pragma unroll
                for (int j = 0; j < 4; ++j) mS[(fq * 4 + j) * KT_LD + nn * 16 + fr] = f2bf(v[j]);
            }
        }
        lds_barrier();
        f32x4 acco[4];
#pragma unroll
        for (int nn = 0; nn < 4; ++nn) acco[nn] = (f32x4){0.f, 0.f, 0.f, 0.f};
#pragma unroll
        for (int ks = 0; ks < 4; ++ks) {
            bf16x8 af = *reinterpret_cast<const bf16x8*>(mS + fr * KT_LD + ks * 32 + fq * 8);
#pragma unroll
            for (int nn = 0; nn < 4; ++nn) {
                bf16x8 bfr = *reinterpret_cast<const bf16x8*>(sVT + (nn * 16 + fr) * KT_LD + ks * 32 + fq * 8);
                acco[nn] = __builtin_amdgcn_mfma_f32_16x16x32_bf16(af, bfr, acco[nn], 0, 0, 0);
            }
        }
#pragma unroll
        for (int j = 0; j < 4; ++j) {
            int ig = wv * 16 + fq * 4 + j;
            float xi = __expf((float)(ig + 1) * lg);
            float o[4];
            float sm = 0.f;
#pragma unroll
            for (int nn = 0; nn < 4; ++nn) { o[nn] = acco[nn][j] + xi * accc[nn][j]; sm += o[nn]; }
            sm = row16_sum(sm);
            float mean = sm * (1.0f / 64.0f);
            float sq = 0.f;
#pragma unroll
            for (int nn = 0; nn < 4; ++nn) { float d = o[nn] - mean; sq += d * d; }
            sq = row16_sum(sq);
            float rstd = rsqrtf(sq * (1.0f / 64.0f) + 1e-5f);
            size_t tok = (size_t)b * SEQ + n * 128 + ig;
#pragma unroll
            for (int nn = 0; nn < 4; ++nn) {
                int e = h * 64 + nn * 16 + fr;
                float y = (o[nn] - mean) * rstd * gng[nn] + gnb[nn];
                float gr = bf2f(cur.gr[j * 4 + nn]);
                YC[tok * 1024 + 512 + e] = f2bf(siluf_(gr) * y);
            }
        }
        cur = nxt;
        lds_barrier();
    }
}

#define XB_TMO      128
#define XB_XCNT(j)  (256  + 64 * (j))
#define XB_XSUB(j)  (1280 + 64 * (j))
#define XB_XGEN(j)  (2304 + 64 * (j))
#define XB_TOP      3328
#define XB_TOPGEN   3392
#define XB_SPIN_CAP (1u << 18)

__device__ __forceinline__ unsigned xb_ld(unsigned* p)              { return __hip_atomic_load(p, __ATOMIC_RELAXED, __HIP_MEMORY_SCOPE_AGENT); }
__device__ __forceinline__ unsigned xb_add(unsigned* p, unsigned v) { return __hip_atomic_fetch_add(p, v, __ATOMIC_RELAXED, __HIP_MEMORY_SCOPE_AGENT); }
__device__ __forceinline__ unsigned xb_xcc_id() { return (unsigned)__builtin_amdgcn_s_getreg((3 << 11) | 20) & 0xFu; }
#define XB_SPIN(cond, bar) do { unsigned _sp = 0; while (cond) { __builtin_amdgcn_s_sleep(1); \
    if ((++_sp & 255u) == 0u) { if (xb_ld(&(bar)[XB_TMO])) break; if (_sp > XB_SPIN_CAP) { atomicAdd(&(bar)[XB_TMO], 1u); break; } } } } while (0)

struct XcdBarrier {
    unsigned* bar; unsigned x;
    volatile __attribute__((address_space(3))) unsigned* st;
};

__device__ __forceinline__ XcdBarrier xcd_barrier_post(unsigned* bar, volatile __attribute__((address_space(3))) unsigned* st, int tid) {
    XcdBarrier b; b.bar = bar; b.x = xb_xcc_id(); b.st = st;
    if (tid == 0) (void)xb_add(&bar[XB_XCNT(b.x)], 1u);
    return b;
}
__device__ __forceinline__ void xcd_barrier_complete(unsigned* bar, unsigned x, unsigned& nloc, unsigned& nx) {
    const unsigned G = (unsigned)ogdim();
    unsigned sum, cnt, mine, sp = 0u;
    for (;;) {
        sum = 0u; cnt = 0u; mine = 0u;
#pragma unroll
        for (unsigned j = 0; j < 16; ++j) { const unsigned c = xb_ld(&bar[XB_XCNT(j)]); sum += c; cnt += (c > 0u) ? 1u : 0u; mine = (j == x) ? c : mine; }
        if (sum == G) break;
        __builtin_amdgcn_s_sleep(1);
        if ((++sp & 255u) == 0u) { if (xb_ld(&bar[XB_TMO])) break; if (sp > XB_SPIN_CAP) { atomicAdd(&bar[XB_TMO], 1u); break; } }
    }
    nloc = mine > 0u ? mine : 1u; nx = cnt > 0u ? cnt : 1u;
}

__device__ __forceinline__ void xcd_barrier(const XcdBarrier& b, int tid) {
    asm volatile("s_waitcnt vmcnt(0)" ::: "memory");
    __syncthreads();
    if (tid == 0) {
        unsigned* bar = b.bar;
        __builtin_amdgcn_s_waitcnt(0);
        unsigned nloc = b.st[0], nx = b.st[1];
        if (nloc == 0u) { xcd_barrier_complete(bar, b.x, nloc, nx); b.st[0] = nloc; b.st[1] = nx; }
        const unsigned old = xb_add(&bar[XB_XSUB(b.x)], 1u);
        const unsigned gen = old / nloc;
        if (old + 1u == (gen + 1u) * nloc) {
            __builtin_amdgcn_fence(__ATOMIC_RELEASE, "agent");
            asm volatile("s_waitcnt vmcnt(0)" ::: "memory");
            const unsigned og = xb_add(&bar[XB_TOP], 1u);
            const unsigned tg = og / nx;
            if (og + 1u == (tg + 1u) * nx) xb_add(&bar[XB_TOPGEN], 1u);
            else XB_SPIN(xb_ld(&bar[XB_TOPGEN]) == tg, bar);
            __builtin_amdgcn_fence(__ATOMIC_ACQUIRE, "agent");
            xb_add(&bar[XB_XGEN(b.x)], 1u);
            asm volatile("s_waitcnt vmcnt(0)" ::: "memory");
        } else {
            XB_SPIN(xb_ld(&bar[XB_XGEN(b.x)]) == gen, bar);
            __builtin_amdgcn_fence(__ATOMIC_ACQUIRE, "agent");
            asm volatile("s_waitcnt vmcnt(0)" ::: "memory");
        }
    }
    __syncthreads();
}


#define N_PHASES 22
__device__ __forceinline__ void run_phase(const Params& p, int ph, unsigned char* smem) {
    bf16_t* sm16 = reinterpret_cast<bf16_t*>(smem);
    const bf16_t* W = reinterpret_cast<const bf16_t*>(p.ws + OFF_W);
    bf16_t* ACTB = reinterpret_cast<bf16_t*>(p.ws + OFF_ACTB);
    bf16_t* PB = reinterpret_cast<bf16_t*>(p.ws + OFF_P);
    bf16_t* YC = reinterpret_cast<bf16_t*>(p.ws + OFF_YCAT);
    switch (ph) {
        case 0: phase_pre(p, smem, 0, obid(), ogdim()); break;
        case 1: { PEpiBf16 e{PB, 2304}; big_gemm(ACTB, W + WE_IN0, NT, 2304, DM, e, smem, p.wave); } break;
        case 2: phase_l0_prep(p); break;
        case 3: phase_l0_lora(p, sm16); break;
        case 4: phase_rwkv_r1(p, smem); break;
        case 5: phase_rwkv_r2(p, smem); break;
        case 6: phase_rwkv_r3(p, smem); break;
        case 7: { PEpiOut<false> e{p.in[0], nullptr, PB}; big_gemm(YC, W + WE_OUT0, NT, DM, DM, e, smem, p.wave); } break;
        case 8: phase_ln_route(p, 0, smem); break;
        case 9: phase_exp1(p, 0, sm16); break;
        case 10: phase_exp2(p, 0, sm16); break;
        case 11: phase_ln_ffn(p, 0, p.out, false); break;
        case 12: { PEpiBf16 e{PB, 3072}; big_gemm(ACTB, W + WE_IN1, NT, 3072, DM, e, smem, p.wave); } break;
        case 13: phase_l1_conv(p, smem); break;
        case 14: phase_ret_kv(p, smem); break;
        case 15: phase_ret_scan(p); break;
        case 16: phase_ret_out(p, smem); break;
        case 17: { PEpiOut<true> e{nullptr, ACTB, PB}; big_gemm(YC, W + WE_OUT1, NT, DM, DM, e, smem, p.wave); } break;
        case 18: phase_ln_route(p, 1, smem); break;
        case 19: phase_exp1(p, 1, sm16); break;
        case 20: phase_exp2(p, 1, sm16); break;
        case 21: phase_ln_ffn(p, 1, p.out, true); break;
        default: break;
    }
}

#define SMEM_BYTES 147456
__global__ void __launch_bounds__(NTHREADS) k_mega(Params p) {
    extern __shared__ __attribute__((aligned(16))) unsigned char smem[];
    cg::grid_group grid = cg::this_grid();
    const int wave_s = __builtin_amdgcn_readfirstlane((int)(threadIdx.x >> 6));
    volatile __attribute__((address_space(3))) unsigned* st = (volatile __attribute__((address_space(3))) unsigned*)(smem + 146944);
    {
        const int t0 = otid(wave_s);
        if (t0 < 2) st[t0] = 0u;
    }
    __syncthreads();
    XcdBarrier xb;
#pragma nounroll
    for (int ph = 0; ph < N_PHASES; ++ph) {
        int phv = ph;
        asm volatile("" : "+s"(phv));
        typedef const __attribute__((address_space(4))) Params* KP;
        KP pp = (KP)__builtin_amdgcn_kernarg_segment_ptr();
        asm volatile("" : "+s"(pp));
        Params pl;
        __builtin_memcpy(&pl, (const Params*)pp, sizeof(Params));
        pl.wave = wave_s;
        run_phase(pl, phv, smem);
        if (ph == 0) {
            if (pl.ws == nullptr) grid.sync();
            xb = xcd_barrier_post(reinterpret_cast<unsigned*>(pl.ws + OFF_CTRL + 4096), st, otid(wave_s));
        }
        if (ph < N_PHASES - 1) xcd_barrier(xb, otid(wave_s));
    }
}

extern "C" void kernel_launch(void* const* d_in, const int* in_sizes, int n_in, void* d_out, int out_size, void* d_ws, size_t ws_size,
                              hipStream_t stream) {
    static int grid_blocks = 0;
    if (!grid_blocks) {
        int dev = 0, cus = 0, per_cu = 0;
        hipGetDevice(&dev);
        hipDeviceGetAttribute(&cus, hipDeviceAttributeMultiprocessorCount, dev);
        hipFuncSetAttribute((const void*)k_mega, hipFuncAttributeMaxDynamicSharedMemorySize, SMEM_BYTES);
        hipOccupancyMaxActiveBlocksPerMultiprocessor(&per_cu, (const void*)k_mega, NTHREADS, SMEM_BYTES);
        if (per_cu < 1) per_cu = 1;
        grid_blocks = cus * per_cu;
    }
    Params p{};
    for (int i = 0; i < 35; ++i) p.in[i] = (const float*)d_in[i];
    p.out = (float*)d_out;
    p.ws = (unsigned char*)d_ws;
    hipMemsetAsync((unsigned char*)d_ws + OFF_CTRL, 0, 65536, stream);
    void* args[] = {&p};
    hipError_t e = hipLaunchCooperativeKernel((void*)k_mega, dim3(grid_blocks), dim3(NTHREADS), args, SMEM_BYTES, stream);
    if (e != hipSuccess) fprintf(stderr, "cooperative launch failed: %s (grid %d)\n", hipGetErrorString(e), grid_blocks);
}
```

```cpp
#include <hip/hip_runtime.h>
#include <hip/hip_cooperative_groups.h>
#include <stdint.h>
#include <stdio.h>
namespace cg = cooperative_groups;

typedef unsigned short bf16_t;
typedef short bf16x8 __attribute__((ext_vector_type(8)));
typedef float f32x4 __attribute__((ext_vector_type(4)));

#define NT 32768
#define SEQ 8192
#define DM 1024
#define NTHREADS 512
#define XCD_BAR_WORDS 3456
#define NWAVES 8
#define ALPHA_F 1.41421356237309515f

#define MIB (1024ull * 1024ull)
#define OFF_CTRL 0ull
#define OFF_W (1ull * MIB)
#define OFF_ROPE (65ull * MIB)
#define OFF_ACTB (68ull * MIB)
#define OFF_AA (OFF_ACTB)
#define OFF_GG (OFF_ACTB + 32ull * MIB)
#define OFF_P (132ull * MIB)
#define OFF_LORA (OFF_P + 144ull * MIB)
#define OFF_POOLED (OFF_P + 160ull * MIB)
#define OFF_FS (OFF_P)
#define OFF_HBUF (OFF_P + 128ull * MIB)
#define OFF_YCAT (324ull * MIB)
#define OFF_LOGW (388ull * MIB)
#define OFF_LTOK (452ull * MIB)
#define OFF_LGATE (456ull * MIB)
#define OFF_KVT (460ull * MIB)
#define WE_IN0 0
#define WE_OUT0 2359296
#define WE_IN1 3407872
#define WE_OUT1 6553600
#define WE_W13 7602176
#define WE_W2 24379392
#define WE_LW2 32768000
#define WE_LA2 32800768
#define WE_LG2 32833536
#define WE_POOL 32899072
#define WE_RT_HI 32964608
#define WE_RT_LO 33062912

struct Params {
    const float* in[35];
    float* out;
    unsigned char* ws;
    int wave;
    int pad_;
};

typedef __bf16 hw_bf16x2 __attribute__((ext_vector_type(2)));
typedef float hw_f32x2 __attribute__((ext_vector_type(2)));
__device__ __forceinline__ unsigned pack2(float a, float b) {
    hw_f32x2 v = {a, b};
    hw_bf16x2 r = __builtin_convertvector(v, hw_bf16x2);
    return __builtin_bit_cast(unsigned, r);
}
__device__ __forceinline__ bf16_t f2bf(float f) { return (bf16_t)(pack2(f, 0.f) & 0xffffu); }
__device__ __forceinline__ float bf2f(bf16_t h) { return __uint_as_float(((unsigned)h) << 16); }
__device__ __forceinline__ void unpack8(const uint4 v, float (&o)[8]) {
    o[0] = __uint_as_float(v.x << 16); o[1] = __uint_as_float(v.x & 0xffff0000u);
    o[2] = __uint_as_float(v.y << 16); o[3] = __uint_as_float(v.y & 0xffff0000u);
    o[4] = __uint_as_float(v.z << 16); o[5] = __uint_as_float(v.z & 0xffff0000u);
    o[6] = __uint_as_float(v.w << 16); o[7] = __uint_as_float(v.w & 0xffff0000u);
}
#define DPP_ADD(v, CTRL) ((v) + __int_as_float(__builtin_amdgcn_update_dpp(0, __float_as_int(v), (CTRL), 0xF, 0xF, false)))
__device__ __forceinline__ float row16_sum(float v) {
    v = DPP_ADD(v, 0xB1);
    v = DPP_ADD(v, 0x4E);
    v = DPP_ADD(v, 0x141);
    v = DPP_ADD(v, 0x140);
    return v;
}
__device__ __forceinline__ float wave_sum(float v) {
    v = row16_sum(v);
    const int iv = __float_as_int(v);
    const float s0 = __int_as_float(__builtin_amdgcn_readlane(iv, 0)), s1 = __int_as_float(__builtin_amdgcn_readlane(iv, 16));
    const float s2 = __int_as_float(__builtin_amdgcn_readlane(iv, 32)), s3 = __int_as_float(__builtin_amdgcn_readlane(iv, 48));
    return (s0 + s1) + (s2 + s3);
}
__device__ __forceinline__ float sigmoidf_(float x) { return 1.0f / (1.0f + __expf(-x)); }
__device__ __forceinline__ float siluf_(float x) { return x / (1.0f + __expf(-x)); }
__device__ __forceinline__ void lds_barrier() {
    asm volatile("s_waitcnt lgkmcnt(0)" ::: "memory");
    __builtin_amdgcn_s_barrier();
    asm volatile("" ::: "memory");
}
__device__ __forceinline__ int obid() { int b = (int)blockIdx.x; asm volatile("" : "+s"(b)); return b; }
__device__ __forceinline__ int ogdim() { int b = (int)gridDim.x; asm volatile("" : "+s"(b)); return b; }
__device__ __forceinline__ int otid(int wave) { int t = wave * 64 + (int)__builtin_amdgcn_mbcnt_hi(~0u, __builtin_amdgcn_mbcnt_lo(~0u, 0u)); asm volatile("" : "+v"(t)); return t; }
template <bool GATHER, class Epi>
__device__ __forceinline__ void gemm_tile(const bf16_t* __restrict__ A, int lda, const int* __restrict__ gidx, int gcount,
                                          const bf16_t* __restrict__ Bt, int ldb, int K, int row0, int col0, const Epi& epi,
                                          bf16_t* smem, int wave) {
    const int tidx = otid(wave);
    const int tid = tidx, wid = tid >> 6, lane = tid & 63, wr = wid >> 1, wc = wid & 1, fr = lane & 15, fq = lane >> 4;
    unsigned char* sm = reinterpret_cast<unsigned char*>(smem);
    const bf16_t* ap[4];
    const bf16_t* bp[2];
#pragma unroll
    for (int i = 0; i < 4; ++i) {
        const int pch = tid + i * 512;
        const int r = pch >> 3, c = (pch & 7) ^ (r & 7);
        int ar = row0 + r;
        if (GATHER) {
            int gi = ar < gcount ? ar : gcount - 1;
            ar = gidx[gi] >> 1;
        }
        ap[i] = A + (size_t)ar * lda + c * 8;
    }
#pragma unroll
    for (int i = 0; i < 2; ++i) {
        const int pch = tid + i * 512;
        const int r = pch >> 3, c = (pch & 7) ^ (r & 7);
        bp[i] = Bt + (size_t)(col0 + r) * ldb + c * 8;
    }
    f32x4 acc[4][4];
#pragma unroll
    for (int m = 0; m < 4; ++m)
#pragma unroll
        for (int n = 0; n < 4; ++n) acc[m][n] = (f32x4){0.f, 0.f, 0.f, 0.f};
    const int nk = K >> 6;
#define GT_STAGE(kt, buf) do { _Pragma("unroll") for (int i_ = 0; i_ < 4; ++i_) \
        __builtin_amdgcn_global_load_lds((const unsigned*)(ap[i_] + (kt) * 64), (__attribute__((address_space(3))) unsigned*)(sm + (buf) * 49152 + (tid + i_ * 512) * 16), 16, 0, 0); \
        _Pragma("unroll") for (int i_ = 0; i_ < 2; ++i_) \
        __builtin_amdgcn_global_load_lds((const unsigned*)(bp[i_] + (kt) * 64), (__attribute__((address_space(3))) unsigned*)(sm + (buf) * 49152 + 32768 + (tid + i_ * 512) * 16), 16, 0, 0); } while (0)
    GT_STAGE(0, 0);
    for (int kt = 0; kt < nk; ++kt) {
        const int buf = kt & 1;
        if (kt + 1 < nk) {
            GT_STAGE(kt + 1, buf ^ 1);
            asm volatile("s_waitcnt vmcnt(6)" ::: "memory");
        } else {
            asm volatile("s_waitcnt vmcnt(0)" ::: "memory");
        }
        __builtin_amdgcn_s_barrier();
        asm volatile("" ::: "memory");
        const unsigned char* SA = sm + buf * 49152;
        const unsigned char* SB = SA + 32768;
#pragma unroll
        for (int ks = 0; ks < 2; ++ks) {
            bf16x8 af[4], bfr[4];
            const int cs = ((ks * 4 + fq) ^ (fr & 7)) * 16;
#pragma unroll
            for (int m = 0; m < 4; ++m) af[m] = *reinterpret_cast<const bf16x8*>(SA + (wr * 64 + m * 16 + fr) * 128 + cs);
#pragma unroll
            for (int n = 0; n < 4; ++n) bfr[n] = *reinterpret_cast<const bf16x8*>(SB + (wc * 64 + n * 16 + fr) * 128 + cs);
#pragma unroll
            for (int m = 0; m < 4; ++m)
#pragma unroll
                for (int n = 0; n < 4; ++n) acc[m][n] = __builtin_amdgcn_mfma_f32_16x16x32_bf16(bfr[n], af[m], acc[m][n], 0, 0, 0);
        }
        asm volatile("s_waitcnt lgkmcnt(0)" ::: "memory");
        __builtin_amdgcn_s_barrier();
        asm volatile("" ::: "memory");
    }
#undef GT_STAGE
    epi(acc, row0 + wr * 64, col0 + wc * 64, fr, fq);
}

template <int MODE>
struct EpiLora {
    float* Of; bf16_t* Ob; const float* vec; int ldo; int coff;
    __device__ __forceinline__ void operator()(f32x4 (&acc)[4][4], int rb, int cb, int fr, int fq) const {
        float4 pv[4];
#pragma unroll
        for (int n = 0; n < 4; ++n) {
            pv[n] = make_float4(0.f, 0.f, 0.f, 0.f);
            if (MODE == 0 || MODE == 1) pv[n] = *reinterpret_cast<const float4*>(vec + cb + n * 16 + fq * 4);
            else if (MODE == 3) pv[n] = *reinterpret_cast<const float4*>(vec + coff + cb + n * 16 + fq * 4);
        }
#pragma unroll
        for (int m = 0; m < 4; ++m)
#pragma unroll
            for (int n = 0; n < 4; ++n) {
                int row = rb + m * 16 + fr, col = cb + n * 16 + fq * 4;
                const float pvv[4] = {pv[n].x, pv[n].y, pv[n].z, pv[n].w};
                float v[4];
#pragma unroll
                for (int j = 0; j < 4; ++j) {
                    float a = acc[m][n][j];
                    if (MODE == 0) {
                        const float t = -(pvv[j] + a);
                        const float sp = (t > 15.f) ? t : __logf(1.0f + __expf(t));
                        v[j] = -__expf(-sp - 0.5f);
                    } else if (MODE == 1) {
                        v[j] = sigmoidf_(pvv[j] + a);
                    } else if (MODE == 2) {
                        v[j] = a;
                    } else {
                        v[j] = a * pvv[j];
                    }
                }
                uint2 w; w.x = pack2(v[0], v[1]); w.y = pack2(v[2], v[3]);
                *reinterpret_cast<uint2*>(Ob + (size_t)row * ldo + coff + col) = w;
            }
    }
};
struct EpiExp1 {
    bf16_t* H; int base; int cnt;
    __device__ __forceinline__ void operator()(f32x4 (&acc)[4][4], int rb, int cb, int fr, int fq) const {
#pragma unroll
        for (int m = 0; m < 4; ++m) {
            int li = rb + m * 16 + fr;
            if (li < cnt) {
#pragma unroll
                for (int i = 0; i < 2; ++i) {
                    int hcol = (cb >> 1) + i * 16 + fq * 4;
                    float v[4];
#pragma unroll
                    for (int j = 0; j < 4; ++j) v[j] = siluf_(acc[m][2 * i][j]) * acc[m][2 * i + 1][j];
                    uint2 w; w.x = pack2(v[0], v[1]); w.y = pack2(v[2], v[3]);
                    *reinterpret_cast<uint2*>(H + (size_t)(base + li) * 128 + hcol) = w;
                }
            }
        }
    }
};
struct EpiExp2 {
    bf16_t* FS; int pk[4]; float g[4]; int cnt;
    __device__ __forceinline__ void operator()(f32x4 (&acc)[4][4], int rb, int cb, int fr, int fq) const {
#pragma unroll
        for (int m = 0; m < 4; ++m) {
            int li = rb + m * 16 + fr;
            if (li < cnt) {
                const float gg = g[m];
                int tok = pk[m] >> 1, j = pk[m] & 1;
                bf16_t* o = FS + ((size_t)j * NT + tok) * DM;
#pragma unroll
                for (int n = 0; n < 4; ++n) {
                    int col = cb + n * 16 + fq * 4;
                    uint2 w; w.x = pack2(acc[m][n][0] * gg, acc[m][n][1] * gg); w.y = pack2(acc[m][n][2] * gg, acc[m][n][3] * gg);
                    *reinterpret_cast<uint2*>(o + col) = w;
                }
            }
        }
    }
};


namespace pg8 {
#define PG8_LAS __attribute__((address_space(3)))
typedef unsigned short bf16_t;
typedef short bf16x8 __attribute__((ext_vector_type(8)));
typedef float f32x4 __attribute__((ext_vector_type(4)));
typedef unsigned u32x4 __attribute__((ext_vector_type(4)));
constexpr int BM = 256, BK = 64, HALF = 128, HTB = HALF * BK * 2  , STAGE_BYTES = 8 * HTB, NXCD = 8, WGM = 8;

__host__ __device__ __forceinline__ int lds_byte(int r, int c) { const int st = (r >> 4) * 2 + (c >> 5), rr = r & 15, cc = c & 31, ob = rr * 64 + cc * 2; return st * 1024 + (ob ^ (((ob >> 9) & 1) << 5)); }
__host__ __device__ __forceinline__ void stage_rc(int b, int& R, int& C) { const int st = b / 1024, sb = b % 1024, swz = sb ^ (((sb >> 9) & 1) << 5); R = (st >> 1) * 16 + swz / 64; C = (st & 1) * 32 + (swz % 64) / 2; }
__host__ __device__ __forceinline__ int perm32(int rho) { const int n = rho >> 4, i = rho & 15; return 8 * (i >> 2) + 4 * n + (i & 3); }

struct Unit { int pm, pn; };
struct Gemm { const bf16_t* A; const bf16_t* Bt; int M, N, K; };

struct StaticOrder {
    int nM, nN, nwg, G, c;
    __host__ __device__ void init(int M, int N, int G_, int c_) { nM = M / BM; nN = N / BM; nwg = nM * nN; G = G_; c = c_; }
    __host__ __device__ bool next(int i, Unit& u) const {
        const long L = (long)i * G + c; if (L >= nwg) return false;
        int wgid = (int)L; { const int q = nwg / NXCD, r = nwg % NXCD, xcd = wgid % NXCD, off = wgid / NXCD; wgid = (xcd < r ? xcd * (q + 1) : r * (q + 1) + (xcd - r) * q) + off; }
        const int nig = WGM * nN, gid = wgid / nig, fm = gid * WGM, gsz = (nM - fm) < WGM ? (nM - fm) : WGM;
        u.pm = fm + ((wgid % nig) % gsz); u.pn = (wgid % nig) / gsz; return true;
    }
    __device__ __forceinline__ void a_ready(const Unit&) const {}
    __device__ __forceinline__ void done(const Unit&) const {}
};
template <class Epi, class Sched, bool ALIGN_EPI = false, bool SP2 = false>
__device__ __forceinline__ void gemm_phase(PG8_LAS unsigned char* lds, const Gemm g, const Sched& S, const Epi& E, int wave) {
    const int tid = otid(wave), wid = __builtin_amdgcn_readfirstlane(tid >> 6), lane = tid & 63, wr = wid >> 2, wc = wid & 3, fr = lane & 15, fq = lane >> 4;
    const int K = g.K, nt = K / BK;
    unsigned voffA[2], voffB[2];
#pragma unroll
    for (int i = 0; i < 2; ++i) { int R, C; stage_rc(tid * 16 + i * 8192, R, C); const int Rb = Epi::PERM ? ((R & ~31) + perm32(R & 31)) : R;
        voffA[i] = (unsigned)(R * K + C) * 2u; voffB[i] = (unsigned)(Rb * K + C) * 2u; }
    const size_t kstep = (size_t)(BK * 2);
    const size_t hstep = (size_t)HALF * K * 2;
    const size_t tstep = 2 * hstep;
    const unsigned ldsw = (unsigned)wid * 1024u;
    const int aoff = lds_byte(wr * 64 + fr, fq * 8), boff = lds_byte(wc * 32 + fr, fq * 8);
#define PG8_SA(b, h) (((b) * 2 + (h)) * HTB)
#define PG8_SB(b, h) ((4 + (b) * 2 + (h)) * HTB)
#define PG8_STAGE(bufoff, gbase, voff) do { _Pragma("unroll") for (int _i = 0; _i < 2; ++_i) \
        __builtin_amdgcn_global_load_lds((const unsigned*)((const char*)(gbase) + (voff)[_i]), (PG8_LAS unsigned*)(lds + (bufoff) + ldsw + _i * 8192), 16, 0, 0); } while (0)
#define PG8_LDA(dst, b, h) do { _Pragma("unroll") for (int m = 0; m < 4; ++m) _Pragma("unroll") for (int k = 0; k < 2; ++k) dst[m][k] = *(const PG8_LAS bf16x8*)(lds + PG8_SA(b, h) + aoff + m * 2048 + k * 1024); } while (0)
#define PG8_LDB(dst, b, h) do { _Pragma("unroll") for (int n = 0; n < 2; ++n) _Pragma("unroll") for (int k = 0; k < 2; ++k) dst[n][k] = *(const PG8_LAS bf16x8*)(lds + PG8_SB(b, h) + boff + n * 2048 + k * 1024); } while (0)
#define PG8_MMA(ai, bj, At, Bt) do { __builtin_amdgcn_s_setprio(1); _Pragma("unroll") for (int m = 0; m < 4; ++m) _Pragma("unroll") for (int n = 0; n < 2; ++n) _Pragma("unroll") for (int k = 0; k < 2; ++k) \
        acc[ai][bj][m][n] = __builtin_amdgcn_mfma_f32_16x16x32_bf16(Bt[n][k], At[m][k], acc[ai][bj][m][n], 0, 0, 0); __builtin_amdgcn_s_setprio(0); } while (0)
#define PG8_WAIT_V(n) asm volatile("s_waitcnt vmcnt(" #n ")" ::: "memory")
#define PG8_WAIT_L(n) asm volatile("s_waitcnt lgkmcnt(" #n ")" ::: "memory")
#define PG8_BAR __builtin_amdgcn_s_barrier()
#define PG8_SCHED __builtin_amdgcn_sched_barrier(0)
    Unit cur, nxt; int ui = 0;
    if (!S.next(0, cur)) return;
    f32x4 acc[2][2][4][2];
#pragma unroll
    for (int a = 0; a < 2; ++a)
#pragma unroll
        for (int b = 0; b < 2; ++b)
#pragma unroll
            for (int m = 0; m < 4; ++m)
#pragma unroll
                for (int n = 0; n < 2; ++n) acc[a][b][m][n] = (f32x4){0.f, 0.f, 0.f, 0.f};
    bf16x8 At[4][2], B0[2][2], B1[2][2];
    const char* cA = (const char*)g.A + (size_t)cur.pm * tstep; const char* cB = (const char*)g.Bt + (size_t)cur.pn * tstep;
    S.a_ready(cur);
    if constexpr (SP2) {
        PG8_STAGE(PG8_SB(0, 0), cB, voffB); PG8_STAGE(PG8_SB(0, 1), cB + hstep, voffB); PG8_STAGE(PG8_SA(0, 0), cA, voffA); PG8_STAGE(PG8_SA(0, 1), cA + hstep, voffA);
        if (wr == 1) PG8_BAR;
        PG8_WAIT_V(2); PG8_BAR;
        PG8_STAGE(PG8_SB(1, 0), cB + kstep, voffB); PG8_STAGE(PG8_SA(1, 0), cA + kstep, voffA); PG8_STAGE(PG8_SB(1, 1), cB + hstep + kstep, voffB);
        PG8_WAIT_V(6); PG8_BAR;
    } else {
        PG8_STAGE(PG8_SB(0, 0), cB, voffB); PG8_STAGE(PG8_SA(0, 0), cA, voffA); PG8_STAGE(PG8_SB(0, 1), cB + hstep, voffB); PG8_STAGE(PG8_SA(0, 1), cA + hstep, voffA);
        if (wr == 1) PG8_BAR;
        PG8_WAIT_V(4); PG8_BAR;
        PG8_STAGE(PG8_SB(1, 0), cB + kstep, voffB); PG8_STAGE(PG8_SA(1, 0), cA + kstep, voffA); PG8_STAGE(PG8_SB(1, 1), cB + hstep + kstep, voffB);
        PG8_WAIT_V(6); PG8_BAR;
    }
    for (;;) {
        const bool has_next = S.next(ui + 1, nxt);
        const char* nA = has_next ? (const char*)g.A + (size_t)nxt.pm * tstep : cA; const char* nB = has_next ? (const char*)g.Bt + (size_t)nxt.pn * tstep : cB;
        for (int t = 0; t < nt; t += 2) {
            const bool last = (t == nt - 2);
            const char* a1 = cA + (size_t)(t + 1) * kstep;
            const char* a2 = last ? nA : cA + (size_t)(t + 2) * kstep; const char* b2 = last ? nB : cB + (size_t)(t + 2) * kstep;
            const char* a3 = a2 + kstep; const char* b3 = b2 + kstep;
            if (last && has_next) S.a_ready(nxt);
            if constexpr (SP2) {
            PG8_LDB(B0, 0, 0); PG8_LDB(B1, 0, 1); PG8_SCHED; PG8_LDA(At, 0, 0); PG8_STAGE(PG8_SA(1, 1), a1 + hstep, voffA);
            PG8_WAIT_V(8); PG8_WAIT_L(0); PG8_BAR; PG8_MMA(0, 0, At, B0); PG8_MMA(0, 1, At, B1); PG8_BAR; PG8_SCHED;
            PG8_LDA(At, 0, 1); PG8_STAGE(PG8_SB(0, 0), b2, voffB); PG8_STAGE(PG8_SB(0, 1), b2 + hstep, voffB); PG8_STAGE(PG8_SA(0, 0), a2, voffA);
            PG8_WAIT_V(8); PG8_WAIT_L(0); PG8_BAR; PG8_MMA(1, 0, At, B0); PG8_MMA(1, 1, At, B1); PG8_BAR; PG8_SCHED;
            PG8_LDB(B0, 1, 0); PG8_LDB(B1, 1, 1); PG8_SCHED; PG8_LDA(At, 1, 0); PG8_STAGE(PG8_SA(0, 1), a2 + hstep, voffA);
            PG8_WAIT_V(8); PG8_WAIT_L(0); PG8_BAR; PG8_MMA(0, 0, At, B0); PG8_MMA(0, 1, At, B1); PG8_BAR; PG8_SCHED;
            PG8_LDA(At, 1, 1); PG8_STAGE(PG8_SB(1, 0), b3, voffB); PG8_STAGE(PG8_SB(1, 1), b3 + hstep, voffB); PG8_STAGE(PG8_SA(1, 0), a3, voffA);
            PG8_WAIT_V(8); PG8_WAIT_L(0); PG8_BAR; PG8_MMA(1, 0, At, B0); PG8_MMA(1, 1, At, B1); PG8_BAR; PG8_SCHED;
            } else {
            PG8_LDB(B0, 0, 0); PG8_SCHED; PG8_LDA(At, 0, 0); PG8_STAGE(PG8_SA(1, 1), a1 + hstep, voffA);
            PG8_WAIT_L(8); PG8_BAR; PG8_WAIT_L(0); PG8_MMA(0, 0, At, B0); PG8_BAR; PG8_SCHED;
            PG8_LDB(B1, 0, 1); PG8_STAGE(PG8_SB(0, 0), b2, voffB);
            PG8_BAR; PG8_WAIT_L(0); PG8_MMA(0, 1, At, B1); PG8_BAR;
            PG8_LDA(At, 0, 1); PG8_STAGE(PG8_SA(0, 0), a2, voffA);
            PG8_BAR; PG8_WAIT_L(0); PG8_MMA(1, 0, At, B0); PG8_BAR; PG8_SCHED;
            PG8_STAGE(PG8_SB(0, 1), b2 + hstep, voffB);
            PG8_WAIT_V(6); PG8_BAR; PG8_MMA(1, 1, At, B1); PG8_BAR;
            PG8_LDB(B0, 1, 0); PG8_SCHED; PG8_LDA(At, 1, 0); PG8_STAGE(PG8_SA(0, 1), a2 + hstep, voffA);
            PG8_WAIT_L(8); PG8_BAR; PG8_WAIT_L(0); PG8_MMA(0, 0, At, B0); PG8_BAR; PG8_SCHED;
            PG8_LDB(B1, 1, 1); PG8_STAGE(PG8_SB(1, 0), b3, voffB);
            PG8_BAR; PG8_WAIT_L(0); PG8_MMA(0, 1, At, B1); PG8_BAR;
            PG8_LDA(At, 1, 1); PG8_STAGE(PG8_SA(1, 0), a3, voffA);
            PG8_BAR; PG8_WAIT_L(0); PG8_MMA(1, 0, At, B0); PG8_BAR; PG8_SCHED;
            PG8_STAGE(PG8_SB(1, 1), b3 + hstep, voffB);
            PG8_WAIT_V(6); PG8_BAR; PG8_MMA(1, 1, At, B1); PG8_BAR;
            }
        }
        if constexpr (ALIGN_EPI) { if (wr == 0) PG8_BAR; }
        if constexpr (!Epi::AFTER_DRAIN) { E(acc, cur, wr, wc, fr, fq); S.done(cur); }
        if (!has_next) break;
#pragma unroll
        for (int a = 0; a < 2; ++a)
#pragma unroll
            for (int b = 0; b < 2; ++b)
#pragma unroll
                for (int m = 0; m < 4; ++m)
#pragma unroll
                    for (int n = 0; n < 2; ++n) acc[a][b][m][n] = (f32x4){0.f, 0.f, 0.f, 0.f};
        cur = nxt; cA = nA; cB = nB; ++ui;
        if constexpr (ALIGN_EPI) { if (wr == 1) PG8_BAR; }
    }
    PG8_WAIT_V(0);
    if constexpr (!ALIGN_EPI) { if (wr == 0) PG8_BAR; }
    PG8_BAR;
    if constexpr (Epi::AFTER_DRAIN) { E.fused(acc, cur, wr, wc, fr, fq, lds, wid, lane); S.done(cur); }
#undef PG8_SA
#undef PG8_SB
#undef PG8_STAGE
#undef PG8_LDA
#undef PG8_LDB
#undef PG8_MMA
#undef PG8_WAIT_V
#undef PG8_WAIT_L
#undef PG8_BAR
#undef PG8_SCHED
}
}
struct PEpiBf16 {
    static constexpr bool PERM = true, AFTER_DRAIN = false;
    bf16_t* O; int ldo;
    __device__ __forceinline__ void operator()(const pg8::f32x4 (&acc)[2][2][4][2], const pg8::Unit& u, int wr, int wc, int fr, int fq) const {
        const int row0 = u.pm * 256 + wr * 64 + fr, col0 = u.pn * 256 + wc * 32 + 8 * fq;
#pragma unroll
        for (int ai = 0; ai < 2; ++ai)
#pragma unroll
            for (int m = 0; m < 4; ++m) {
                bf16_t* rowp = O + (size_t)(row0 + ai * 128 + m * 16) * ldo + col0;
#pragma unroll
                for (int bj = 0; bj < 2; ++bj) {
                    const pg8::f32x4 v0 = acc[ai][bj][m][0], v1 = acc[ai][bj][m][1];
                    uint4 w; w.x = pack2(v0[0], v0[1]); w.y = pack2(v0[2], v0[3]); w.z = pack2(v1[0], v1[1]); w.w = pack2(v1[2], v1[3]);
                    *reinterpret_cast<uint4*>(rowp + bj * 128) = w;
                }
            }
    }
};
template <bool PREV_BF16>
struct PEpiOut {
    static constexpr bool PERM = true, AFTER_DRAIN = false;
    const float* Xprev; const bf16_t* XprevB; bf16_t* T;
    __device__ __forceinline__ void operator()(const pg8::f32x4 (&acc)[2][2][4][2], const pg8::Unit& u, int wr, int wc, int fr, int fq) const {
        const int row0 = u.pm * 256 + wr * 64 + fr, col0 = u.pn * 256 + wc * 32 + 8 * fq;
#pragma unroll
        for (int ai = 0; ai < 2; ++ai)
#pragma unroll
            for (int m = 0; m < 4; ++m) {
                const size_t ro = (size_t)(row0 + ai * 128 + m * 16) * DM + col0;
#pragma unroll
                for (int bj = 0; bj < 2; ++bj) {
                    const size_t o = ro + bj * 128;
                    float xp[8];
                    if (PREV_BF16) {
                        unpack8(*reinterpret_cast<const uint4*>(XprevB + o), xp);
                    } else {
                        const float4 a = *reinterpret_cast<const float4*>(Xprev + o), b = *reinterpret_cast<const float4*>(Xprev + o + 4);
                        xp[0] = a.x; xp[1] = a.y; xp[2] = a.z; xp[3] = a.w; xp[4] = b.x; xp[5] = b.y; xp[6] = b.z; xp[7] = b.w;
                    }
                    const pg8::f32x4 v0 = acc[ai][bj][m][0], v1 = acc[ai][bj][m][1];
                    uint4 w;
                    w.x = pack2(ALPHA_F * xp[0] + v0[0], ALPHA_F * xp[1] + v0[1]); w.y = pack2(ALPHA_F * xp[2] + v0[2], ALPHA_F * xp[3] + v0[3]);
                    w.z = pack2(ALPHA_F * xp[4] + v1[0], ALPHA_F * xp[5] + v1[1]); w.w = pack2(ALPHA_F * xp[6] + v1[2], ALPHA_F * xp[7] + v1[3]);
                    *reinterpret_cast<uint4*>(T + o) = w;
                }
            }
    }
};
template <class Epi>
__device__ __forceinline__ void big_gemm(const bf16_t* A, const bf16_t* Bt, int M, int N, int K, const Epi& e, unsigned char* smem, int wave) {
    pg8::Gemm g{A, Bt, M, N, K};
    pg8::StaticOrder S;
    S.init(M, N, ogdim(), obid());
    pg8::gemm_phase<Epi, pg8::StaticOrder, true, true>((PG8_LAS unsigned char*)smem, g, S, e, wave);
}

__device__ __forceinline__ void tconv_wave(const float* __restrict__ src, int N, bf16_t* __restrict__ dst, int ldd, int k0, int n0,
                                           int mode, float* tile, int lane) {
#pragma unroll
    for (int i = 0; i < 8; ++i) {
        const int r = i * 8 + (lane >> 3), c4 = (lane & 7) * 4;
        const float4 v = *reinterpret_cast<const float4*>(src + (size_t)(k0 + r) * N + n0 + c4);
        tile[r * 33 + c4] = v.x; tile[r * 33 + c4 + 1] = v.y; tile[r * 33 + c4 + 2] = v.z; tile[r * 33 + c4 + 3] = v.w;
    }
    asm volatile("s_waitcnt lgkmcnt(0)" ::: "memory");
#pragma unroll 8
    for (int nn = 0; nn < 32; ++nn) {
        const int n = n0 + nn;
        int drow = n;
        if (mode == 1) drow = (n >> 4) * 32 + (n & 15);
        else if (mode == 2) drow = (n >> 4) * 32 + 16 + (n & 15);
        dst[(size_t)drow * ldd + k0 + lane] = f2bf(tile[lane * 33 + nn]);
    }
    asm volatile("s_waitcnt lgkmcnt(0)" ::: "memory");
}

__device__ __forceinline__ void phase_pre(const Params& p, unsigned char* smem, int part, int bid, int nb) {
    const int tidx = otid(p.wave);
    const int wv = tidx >> 6, lane = tidx & 63;
    float* tile = reinterpret_cast<float*>(smem) + wv * (64 * 33);
    bf16_t* W = reinterpret_cast<bf16_t*>(p.ws + OFF_W);
    constexpr int T0 = 896, T1 = 512, T7 = 16, T8 = 16, T9 = 32;
    constexpr int T2 = 1536, T3 = 512, T4 = 4096, T5 = 4096, T6 = 4096;
    if (part == 0) {
        constexpr int TOT = T0 + T1 + T7 + T8 + T9;
        for (int u = bid * NWAVES + wv; u < TOT; u += nb * NWAVES) {
            int v = u;
            const float* src; bf16_t* dst; int K, N, tk, tn;
            if (v < T0) { src = p.in[1]; K = 1024; N = 2304; dst = W + WE_IN0; tk = v / 56; tn = v % 56; }
            else if ((v -= T0) < T1) { src = p.in[15]; K = 1024; N = 1024; dst = W + WE_OUT0; tk = v / 32; tn = v % 32; }
            else if ((v -= T1) < T7) { src = p.in[4]; K = 64; N = 512; dst = W + WE_LW2; tk = 0; tn = v; }
            else if ((v -= T7) < T8) { src = p.in[6]; K = 64; N = 512; dst = W + WE_LA2; tk = 0; tn = v; }
            else { v -= T8; src = p.in[7]; K = 128; N = 512; dst = W + WE_LG2; tk = v >> 4; tn = v & 15; }
            tconv_wave(src, N, dst, K, tk * 64, tn * 32, 0, tile, lane);
        }
        __syncthreads();
        {
            float* sWu = reinterpret_cast<float*>(smem);
            float* sPw = sWu + 16 * 128;
            for (int bt = bid; bt < 256; bt += nb) {
                const int g = bt >> 6, k0 = (bt & 63) * 16;
                {
                    const int r = tidx >> 5, c4 = (tidx & 31) * 4;
                    *reinterpret_cast<float4*>(sWu + r * 128 + c4) = *reinterpret_cast<const float4*>(p.in[1] + (size_t)(k0 + r) * 2304 + 1792 + g * 128 + c4);
                }
                for (int i = tidx; i < 128 * 32; i += NTHREADS) {
                    const int r = i >> 5, c4 = (i & 31) * 4;
                    *reinterpret_cast<float4*>(sPw + r * 128 + c4) = *reinterpret_cast<const float4*>(p.in[13] + (size_t)g * 16384 + r * 128 + c4);
                }
                __syncthreads();
                const int k = tidx >> 5, d0 = (tidx & 31) * 4;
                float acc[4] = {0.f, 0.f, 0.f, 0.f};
#pragma unroll 8
                for (int c = 0; c < 128; ++c) {
                    const float a = sWu[k * 128 + c];
                    const float4 bq = *reinterpret_cast<const float4*>(sPw + c * 128 + d0);
                    acc[0] += a * bq.x; acc[1] += a * bq.y; acc[2] += a * bq.z; acc[3] += a * bq.w;
                }
                bf16_t* dstp = W + WE_IN0 + (size_t)(1792 + g * 128 + d0) * 1024 + k0 + k;
#pragma unroll
                for (int j = 0; j < 4; ++j) dstp[(size_t)j * 1024] = f2bf(acc[j]);
                __syncthreads();
            }
        }
        const float4* x4 = reinterpret_cast<const float4*>(p.in[0]);
        uint2* xb = reinterpret_cast<uint2*>(p.ws + OFF_ACTB);
        const size_t n4 = (size_t)NT * DM / 4;
        const size_t stride = (size_t)nb * NTHREADS;
        for (size_t i = (size_t)bid * NTHREADS + tidx; i < n4; i += 8 * stride) {
            float4 v[8];
#pragma unroll
            for (int j = 0; j < 8; ++j) if (i + j * stride < n4) v[j] = x4[i + j * stride];
#pragma unroll
            for (int j = 0; j < 8; ++j) if (i + j * stride < n4) {
                uint2 w; w.x = pack2(v[j].x, v[j].y); w.y = pack2(v[j].z, v[j].w);
                xb[i + j * stride] = w;
            }
        }
    } else {
        constexpr int TOT = T2 + T3 + T4 + T5 + T6;
        for (int u = bid * NWAVES + wv; u < TOT; u += nb * NWAVES) {
            int v = u;
            const float* src; bf16_t* dst; int K, N, mode = 0, tk, tn;
            if (v < T2) { src = p.in[16]; K = 1024; N = 3072; dst = W + WE_IN1; tk = v / 96; tn = v % 96; }
            else if ((v -= T2) < T3) { src = p.in[23]; K = 1024; N = 1024; dst = W + WE_OUT1; tk = v / 32; tn = v % 32; }
            else if ((v -= T3) < T4) { int mat = v >> 6, w = v & 63; src = p.in[30] + (size_t)mat * 131072; K = 1024; N = 128; dst = W + WE_W13 + (size_t)mat * 262144; mode = 1; tk = w >> 2; tn = w & 3; }
            else if ((v -= T4) < T5) { int mat = v >> 6, w = v & 63; src = p.in[31] + (size_t)mat * 131072; K = 1024; N = 128; dst = W + WE_W13 + (size_t)mat * 262144; mode = 2; tk = w >> 2; tn = w & 3; }
            else { v -= T5; int mat = v >> 6, w = v & 63; src = p.in[32] + (size_t)mat * 131072; K = 128; N = 1024; dst = W + WE_W2 + (size_t)mat * 131072; tk = w >> 5; tn = w & 31; }
            tconv_wave(src, N, dst, K, tk * 64, tn * 32, mode, tile, lane);
        }
        {
            bf16_t* RH = W + WE_RT_HI; bf16_t* RL = W + WE_RT_LO;
            for (int i = bid * NTHREADS + tidx; i < 2 * 48 * 1024; i += nb * NTHREADS) {
                const int l = i / (48 * 1024), r = i - l * 48 * 1024, n = r >> 10, k = r & 1023;
                float w = 0.f;
                if (n < 4) w = p.in[26][((size_t)l * 1024 + k) * 4 + n];
                else if (n < 36) w = p.in[28][((size_t)l * 1024 + k) * 32 + (n - 4)];
                const bf16_t h = f2bf(w);
                RH[i] = h; RL[i] = f2bf(w - bf2f(h));
            }
        }
        {
            float2* rope = reinterpret_cast<float2*>(p.ws + OFF_ROPE);
            for (int i = bid * NTHREADS + tidx; i < SEQ * 32; i += nb * NTHREADS) {
                int pos = i >> 5, k = i & 31;
                float inv = powf(10000.0f, -(float)k / 32.0f);
                float ang = (float)pos * inv;
                const double a = (double)ang;
                const double q = rint(a * 0.15915494309189535);
                const float rr = (float)(a - q * 6.283185307179586);
                float s, c;
                sincosf(rr, &s, &c);
                rope[i] = make_float2(c, s);
            }
        }
    }
}

__device__ __forceinline__ void phase_l0_prep(const Params& p) {
    const int tidx = otid(p.wave);
    const bf16_t* P = reinterpret_cast<const bf16_t*>(p.ws + OFF_P);
    bf16_t* LA = reinterpret_cast<bf16_t*>(p.ws + OFF_LORA);
    bf16_t* YC = reinterpret_cast<bf16_t*>(p.ws + OFF_YCAT);
    const float* mu = p.in[2];
    const int nthr = ogdim() * NTHREADS, t0 = obid() * NTHREADS + tidx;
    {
        const int total = NT * 32;
        for (int it0 = t0; it0 < total; it0 += 4 * nthr) {
            uint4 cu[4], pr[4];
#pragma unroll
            for (int q = 0; q < 4; ++q) {
                const int it = it0 + q * nthr;
                cu[q] = make_uint4(0u, 0u, 0u, 0u); pr[q] = cu[q];
                if (it < total) {
                    const int tok = it >> 5, j = it & 31;
                    const bf16_t* src = P + (size_t)tok * 2304 + 1536 + j * 8;
                    cu[q] = *reinterpret_cast<const uint4*>(src);
                    if ((tok & (SEQ - 1)) > 0) pr[q] = *reinterpret_cast<const uint4*>(src - 2304);
                }
            }
#pragma unroll
            for (int q = 0; q < 4; ++q) {
                const int it = it0 + q * nthr;
                if (it < total) {
                    const int tok = it >> 5, j = it & 31, col = 1536 + j * 8;
                    float cur[8], prv[8];
                    unpack8(cu[q], cur); unpack8(pr[q], prv);
                    const float4 m0 = *reinterpret_cast<const float4*>(mu + col), m1 = *reinterpret_cast<const float4*>(mu + col + 4);
                    const float mm[8] = {m0.x, m0.y, m0.z, m0.w, m1.x, m1.y, m1.z, m1.w};
                    float o[8];
#pragma unroll
                    for (int i = 0; i < 8; ++i) {
                        const float z = cur[i] + mm[i] * (prv[i] - cur[i]);
                        o[i] = (j < 8) ? (1.0f - 2.0f / (1.0f + __expf(2.0f * z))) : ((j < 16) ? z : sigmoidf_(z));
                    }
                    uint4 w; w.x = pack2(o[0], o[1]); w.y = pack2(o[2], o[3]); w.z = pack2(o[4], o[5]); w.w = pack2(o[6], o[7]);
                    *reinterpret_cast<uint4*>(LA + (size_t)tok * 256 + j * 8) = w;
                }
            }
        }
    }
    {
        const int total = NT * 64;
        for (int it = t0; it < total; it += nthr) {
            const int tok = it >> 6, cc = (it & 63) * 8;
            const int s = tok & (SEQ - 1);
            const int gi = cc >> 7;
            const int win = 2 << gi;
            const int cnt = (s + 1 < win) ? (s + 1) : win;
            const bf16_t* src = P + (size_t)tok * 2304 + 1792 + cc;
            float u[8], sum[8];
            uint4 rows[16];
#pragma unroll
            for (int r = 0; r < 16; ++r) {
                rows[r] = make_uint4(0u, 0u, 0u, 0u);
                if (r < cnt) rows[r] = *reinterpret_cast<const uint4*>(src - (size_t)r * 2304);
            }
            unpack8(rows[0], u);
#pragma unroll
            for (int i = 0; i < 8; ++i) sum[i] = u[i];
#pragma unroll
            for (int r = 1; r < 16; ++r) {
                float t[8];
                unpack8(rows[r], t);
#pragma unroll
                for (int i = 0; i < 8; ++i) sum[i] += t[i];
            }
            const float inv = 1.0f / (float)cnt;
            const float4 ps0 = *reinterpret_cast<const float4*>(p.in[14] + cc), ps1 = *reinterpret_cast<const float4*>(p.in[14] + cc + 4);
            uint4 w;
            w.x = pack2((sum[0] * inv - u[0]) * ps0.x, (sum[1] * inv - u[1]) * ps0.y); w.y = pack2((sum[2] * inv - u[2]) * ps0.z, (sum[3] * inv - u[3]) * ps0.w);
            w.z = pack2((sum[4] * inv - u[4]) * ps1.x, (sum[5] * inv - u[5]) * ps1.y); w.w = pack2((sum[6] * inv - u[6]) * ps1.z, (sum[7] * inv - u[7]) * ps1.w);
            *reinterpret_cast<uint4*>(YC + (size_t)tok * 1024 + 512 + cc) = w;
        }
    }
}

__device__ __forceinline__ void phase_l0_lora(const Params& p, bf16_t* smem) {
    const bf16_t* W = reinterpret_cast<const bf16_t*>(p.ws + OFF_W);
    const bf16_t* LA = reinterpret_cast<const bf16_t*>(p.ws + OFF_LORA);
    const bf16_t* PO = reinterpret_cast<const bf16_t*>(p.ws + OFF_POOLED);
    for (int t = obid(); t < 1536; t += ogdim()) {
        int job = t >> 9, w = t & 511;
        if (job == 0) {
            EpiLora<0> e{nullptr, reinterpret_cast<bf16_t*>(p.ws + OFF_LOGW), p.in[3], 512, 0};
            gemm_tile<false>(LA, 256, nullptr, 0, W + WE_LW2, 64, 64, (w >> 2) * 256, (w & 3) * 128, e, smem, p.wave);
        } else if (job == 1) {
            EpiLora<1> e{nullptr, reinterpret_cast<bf16_t*>(p.ws + OFF_AA), p.in[5], 512, 0};
            gemm_tile<false>(LA + 64, 256, nullptr, 0, W + WE_LA2, 64, 64, (w >> 2) * 256, (w & 3) * 128, e, smem, p.wave);
        } else {
            EpiLora<2> e{nullptr, reinterpret_cast<bf16_t*>(p.ws + OFF_GG), nullptr, 512, 0};
            gemm_tile<false>(LA + 128, 256, nullptr, 0, W + WE_LG2, 128, 128, (w >> 2) * 256, (w & 3) * 128, e, smem, p.wave);
        }
    }
}

#define RC_LD 72
#define RC_BUF (64 * RC_LD)
#define RC_BYTES (RC_BUF * 2)
#define OFF_TBUF OFF_KVT

__device__ __forceinline__ void mm64(f32x4 (&acc)[2], const bf16_t* A, const bf16_t* Bt, int mt, int nt0, int fr, int fq) {
#pragma unroll
    for (int ks = 0; ks < 2; ++ks) {
        bf16x8 af = *reinterpret_cast<const bf16x8*>(A + (mt * 16 + fr) * RC_LD + ks * 32 + fq * 8);
        bf16x8 bq[2];
#pragma unroll
        for (int n = 0; n < 2; ++n) bq[n] = *reinterpret_cast<const bf16x8*>(Bt + ((nt0 + n) * 16 + fr) * RC_LD + ks * 32 + fq * 8);
#pragma unroll
        for (int n = 0; n < 2; ++n) acc[n] = __builtin_amdgcn_mfma_f32_16x16x32_bf16(af, bq[n], acc[n], 0, 0, 0);
    }
}
template <int MASK>
__device__ __forceinline__ void store_T(bf16_t* dst, const f32x4 (&acc)[2], int mt, int nt0, int fr, int fq) {
#pragma unroll
    for (int n = 0; n < 2; ++n) {
        const int C = (nt0 + n) * 16 + fr, R0 = mt * 16 + fq * 4;
        float v[4];
#pragma unroll
        for (int j = 0; j < 4; ++j) {
            const int R = R0 + j;
            bool keep = true;
            if (MASK == 1) keep = R < C;
            else if (MASK == 2) keep = R <= C;
            else if (MASK == 3) keep = C < R;
            v[j] = keep ? acc[n][j] : 0.f;
        }
        uint2 w; w.x = pack2(v[0], v[1]); w.y = pack2(v[2], v[3]);
        *reinterpret_cast<uint2*>(dst + C * RC_LD + R0) = w;
    }
}
__device__ __forceinline__ void zero_acc(f32x4 (&acc)[2]) {
    acc[0] = (f32x4){0.f, 0.f, 0.f, 0.f};
    acc[1] = (f32x4){0.f, 0.f, 0.f, 0.f};
}

#define OFF_NTB (OFF_P + 144ull * MIB)
#define OFF_S0A (OFF_P + 176ull * MIB)
#define OFF_TB (420ull * MIB)
#define OFF_MB (452ull * MIB)
#define OFF_S0B (484ull * MIB)
#define OFF_WLB (500ull * MIB)
#define OFF_BCB (501ull * MIB)
__device__ __forceinline__ bf16_t* s0_ptr(unsigned char* ws, int u) {
    return reinterpret_cast<bf16_t*>(ws + (u < 2048 ? OFF_S0A : OFF_S0B)) + (size_t)(u & 2047) * 4096;
}

struct PrepIn {
    unsigned short k[8], v[8], r[8], lw[8], a[8];
    unsigned short pk, pv, pr;
};
template <int MODE>
__device__ __forceinline__ void prep_load(PrepIn& in, const Params& p, int u, int tid) {
    const int b = u >> 10, h = (u >> 7) & 7, n = u & 127;
    const int lane = tid & 63, q = tid >> 6;
    const int c = h * 64 + lane;
    const bf16_t* P = reinterpret_cast<const bf16_t*>(p.ws + OFF_P);
    const bf16_t* LOGW = reinterpret_cast<const bf16_t*>(p.ws + OFF_LOGW);
    const bf16_t* AA = reinterpret_cast<const bf16_t*>(p.ws + OFF_AA);
    const int s0 = n * 64 + q * 8;
    const size_t tok0 = (size_t)b * SEQ + s0;
    in.pk = 0; in.pv = 0; in.pr = 0;
    if (s0 > 0) {
        const bf16_t* pp = P + (tok0 - 1) * 2304;
        in.pk = pp[512 + c]; in.pv = pp[1024 + c];
        in.pr = pp[c];
    }
#pragma unroll
    for (int i = 0; i < 8; ++i) {
        const bf16_t* pp = P + (tok0 + i) * 2304;
        in.k[i] = pp[512 + c]; in.v[i] = pp[1024 + c];
        in.r[i] = pp[c];
        in.lw[i] = LOGW[(tok0 + i) * 512 + c];
        in.a[i] = AA[(tok0 + i) * 512 + c];
    }
}
struct PrepC { float mu_k, kkc, kac, mu_v, mu_r, rkc, lng, lnb; };
template <int MODE>
__device__ __forceinline__ PrepC prep_consts(const Params& p, int h, int lane) {
    PrepC c_;
    const int c = h * 64 + lane;
    c_.mu_k = p.in[2][512 + c]; c_.kkc = p.in[8][c]; c_.kac = p.in[9][c]; c_.mu_v = p.in[2][1024 + c];
    c_.mu_r = 0.f; c_.rkc = 0.f; c_.lng = 0.f; c_.lnb = 0.f;
    c_.mu_r = p.in[2][c]; c_.rkc = p.in[10][c];
    if (MODE == 2) { c_.lng = p.in[11][c]; c_.lnb = p.in[12][c]; }
    return c_;
}
template <int MODE>
__device__ __forceinline__ void rwkv_prep(const PrepIn& in, const PrepC& pc, int tid, bf16_t* At, bf16_t* Bt, bf16_t* Kt, bf16_t* Rt,
                                          bf16_t* AtT, bf16_t* BtT, bf16_t* KtT, bf16_t* VT, float* sTot, float* sBC, float* sWL) {
    const int lane = tid & 63, q = tid >> 6;
    const float mu_k = pc.mu_k, kkc = pc.kkc, kac = pc.kac, mu_v = pc.mu_v, mu_r = pc.mu_r, rkc = pc.rkc;
    float lw[8], av[8], zk[8], zr[8], zv[8];
    float pk = bf2f(in.pk), pr = bf2f(in.pr), pv = bf2f(in.pv);
#pragma unroll
    for (int i = 0; i < 8; ++i) {
        const float k0 = bf2f(in.k[i]), v0 = bf2f(in.v[i]);
        zk[i] = k0 + mu_k * (pk - k0); pk = k0;
        zv[i] = v0 + mu_v * (pv - v0); pv = v0;
        { const float r0 = bf2f(in.r[i]); zr[i] = r0 + mu_r * (pr - r0); pr = r0; }
        lw[i] = bf2f(in.lw[i]);
        av[i] = bf2f(in.a[i]);
    }
    float lws[8];
    float cs = 0.f;
#pragma unroll
    for (int i = 0; i < 8; ++i) { cs += lw[i]; lws[i] = cs; }
    sTot[q * 64 + lane] = cs;
    lds_barrier();
    float off = 0.f, tot = 0.f;
#pragma unroll
    for (int qq = 0; qq < 8; ++qq) { float tq = sTot[qq * 64 + lane]; if (qq < q) off += tq; tot += tq; }
    float atv[8], btv[8], ktv[8];
#pragma unroll
    for (int i = 0; i < 8; ++i) {
        const int t = q * 8 + i;
        const float L = lws[i] + off;
        float kk = zk[i] * kkc;
        float ss = wave_sum(kk * kk);
        kk *= rsqrtf(fmaxf(ss, 1e-24f));
        const float e_neg = __expf(-L), e_prev = __expf(L - lw[i]);
        const float a = av[i];
        const float at = -kk * e_prev;
        At[t * RC_LD + lane] = f2bf(at);
        const float bt = kk * a * e_neg;
        Bt[t * RC_LD + lane] = f2bf(bt);
        const float kp = zk[i] * (1.0f + (a - 1.0f) * kac);
        const float kt = kp * e_neg;
        Kt[t * RC_LD + lane] = f2bf(kt);
        atv[i] = at; btv[i] = bt; ktv[i] = kt;
        {
            Rt[t * RC_LD + lane] = f2bf(zr[i] * __expf(L));
            const float bc = wave_sum(zr[i] * kp * rkc);
            if (lane == 0) sBC[t] = bc;
        }
    }
    uint4 w0;
    if (MODE == 1) {
        w0.x = pack2(atv[0], atv[1]); w0.y = pack2(atv[2], atv[3]); w0.z = pack2(atv[4], atv[5]); w0.w = pack2(atv[6], atv[7]);
        *reinterpret_cast<uint4*>(AtT + lane * RC_LD + q * 8) = w0;
        w0.x = pack2(btv[0], btv[1]); w0.y = pack2(btv[2], btv[3]); w0.z = pack2(btv[4], btv[5]); w0.w = pack2(btv[6], btv[7]);
        *reinterpret_cast<uint4*>(BtT + lane * RC_LD + q * 8) = w0;
        w0.x = pack2(ktv[0], ktv[1]); w0.y = pack2(ktv[2], ktv[3]); w0.z = pack2(ktv[4], ktv[5]); w0.w = pack2(ktv[6], ktv[7]);
        *reinterpret_cast<uint4*>(KtT + lane * RC_LD + q * 8) = w0;
        if (q == 0) sWL[lane] = __expf(tot);
    }
    w0.x = pack2(zv[0], zv[1]); w0.y = pack2(zv[2], zv[3]); w0.z = pack2(zv[4], zv[5]); w0.w = pack2(zv[6], zv[7]);
    *reinterpret_cast<uint4*>(VT + lane * RC_LD + q * 8) = w0;
}

__device__ __forceinline__ void phase_rwkv_r1(const Params& p, unsigned char* smem) {
    const int tidx = otid(p.wave);
    const int tid = tidx, wv = tid >> 6, lane = tid & 63, fr = lane & 15, fq = lane >> 4, mt = wv >> 1, nt0 = (wv & 1) * 2;
    bf16_t* base = reinterpret_cast<bf16_t*>(smem);
    bf16_t* At = base; bf16_t* Bt = base + RC_BUF; bf16_t* Kt = base + 2 * RC_BUF; bf16_t* AtT = base + 3 * RC_BUF;
    bf16_t* BtT = base + 4 * RC_BUF; bf16_t* KtT = base + 5 * RC_BUF; bf16_t* VT = base + 6 * RC_BUF;
    bf16_t* Rb0 = base + 7 * RC_BUF; bf16_t* Cb0 = base + 8 * RC_BUF; bf16_t* Rb1 = base + 9 * RC_BUF; bf16_t* Cb1 = base + 10 * RC_BUF;
    bf16_t* Pm0 = base + 11 * RC_BUF; bf16_t* Pm1 = base + 12 * RC_BUF;
    bf16_t* Rt = base + 13 * RC_BUF; bf16_t* Aak = base + 14 * RC_BUF;
    bf16_t* Tm = Rb0; bf16_t* PT = Rb1; bf16_t* AkVT = Cb1; bf16_t* QT = Pm0; bf16_t* Arb = At; bf16_t* Ark = Bt;
    float* sTot = reinterpret_cast<float*>(smem + 15 * RC_BYTES);
    float* sWL = sTot + 512;
    float* sBC = sWL + 64;
    bf16_t* PRg = reinterpret_cast<bf16_t*>(p.ws + OFF_AA);
    bf16_t* YQg = reinterpret_cast<bf16_t*>(p.ws + OFF_LOGW);
    float* BCg = reinterpret_cast<float*>(p.ws + OFF_BCB);
    bf16_t* Mg = reinterpret_cast<bf16_t*>(p.ws + OFF_MB);
    bf16_t* Ng = reinterpret_cast<bf16_t*>(p.ws + OFF_NTB);
    float* WLg = reinterpret_cast<float*>(p.ws + OFF_WLB);
    PrepIn cur, nxt;
    if (obid() < 4096) prep_load<1>(cur, p, obid(), tid);
    nxt = cur;
    for (int u = obid(); u < 4096; u += ogdim()) {
        const int h = (u >> 7) & 7, b = u >> 10, n = u & 127;
        PrepC pc = prep_consts<1>(p, h, lane);
        asm volatile("" : "+v"(pc.mu_k), "+v"(pc.kkc), "+v"(pc.kac), "+v"(pc.mu_v), "+v"(pc.mu_r), "+v"(pc.rkc));
        if (u + ogdim() < 4096) prep_load<1>(nxt, p, u + ogdim(), tid);
        rwkv_prep<1>(cur, pc, tid, At, Bt, Kt, Rt, AtT, BtT, KtT, VT, sTot, sBC, sWL);
        lds_barrier();
        f32x4 pacc[2];
        f32x4 acc[2];
        zero_acc(acc);
        mm64(acc, At, Bt, mt, nt0, fr, fq);
        store_T<3>(Cb0, acc, mt, nt0, fr, fq);
        zero_acc(pacc);
        mm64(pacc, Bt, At, mt, nt0, fr, fq);
#pragma unroll
        for (int nn = 0; nn < 2; ++nn)
#pragma unroll
            for (int j = 0; j < 4; ++j) {
                const int R = mt * 16 + fq * 4 + j, C = (nt0 + nn) * 16 + fr;
                pacc[nn][j] = (R < C) ? pacc[nn][j] : 0.f;
            }
        store_T<0>(Rb0, pacc, mt, nt0, fr, fq);
#pragma unroll
        for (int nn = 0; nn < 2; ++nn)
#pragma unroll
            for (int j = 0; j < 4; ++j) {
                const int R = mt * 16 + fq * 4 + j, C = (nt0 + nn) * 16 + fr;
                if (R == C) pacc[nn][j] += 1.0f;
            }
        store_T<0>(Pm0, pacc, mt, nt0, fr, fq);
        lds_barrier();
        zero_acc(acc); mm64(acc, Cb0, Rb0, mt, nt0, fr, fq); store_T<0>(Rb1, acc, mt, nt0, fr, fq);
        zero_acc(acc); mm64(acc, Rb0, Cb0, mt, nt0, fr, fq); store_T<0>(Cb1, acc, mt, nt0, fr, fq);
        zero_acc(acc); mm64(acc, Kt, At, mt, nt0, fr, fq); store_T<1>(Aak, acc, mt, nt0, fr, fq);
        lds_barrier();
        zero_acc(acc); mm64(acc, Cb1, Rb1, mt, nt0, fr, fq); store_T<0>(Rb0, acc, mt, nt0, fr, fq);
        zero_acc(acc); mm64(acc, Rb1, Cb1, mt, nt0, fr, fq); store_T<0>(Cb0, acc, mt, nt0, fr, fq);
        zero_acc(acc); mm64(acc, Cb1, Pm0, mt, nt0, fr, fq); pacc[0] += acc[0]; pacc[1] += acc[1]; store_T<0>(Pm1, pacc, mt, nt0, fr, fq);
        zero_acc(acc); mm64(acc, Bt, Rt, mt, nt0, fr, fq); store_T<2>(Arb, acc, mt, nt0, fr, fq);
        lds_barrier();
        zero_acc(acc); mm64(acc, Cb0, Rb0, mt, nt0, fr, fq); store_T<0>(Rb1, acc, mt, nt0, fr, fq);
        zero_acc(acc); mm64(acc, Rb0, Cb0, mt, nt0, fr, fq); store_T<0>(Cb1, acc, mt, nt0, fr, fq);
        zero_acc(acc); mm64(acc, Cb0, Pm1, mt, nt0, fr, fq); pacc[0] += acc[0]; pacc[1] += acc[1]; store_T<0>(Pm0, pacc, mt, nt0, fr, fq);
        zero_acc(acc); mm64(acc, Kt, Rt, mt, nt0, fr, fq); store_T<2>(Ark, acc, mt, nt0, fr, fq);
        lds_barrier();
        zero_acc(acc); mm64(acc, Cb1, Rb1, mt, nt0, fr, fq); store_T<0>(Rb0, acc, mt, nt0, fr, fq);
        zero_acc(acc); mm64(acc, Rb1, Cb1, mt, nt0, fr, fq); store_T<0>(Cb0, acc, mt, nt0, fr, fq);
        zero_acc(acc); mm64(acc, Cb1, Pm0, mt, nt0, fr, fq); pacc[0] += acc[0]; pacc[1] += acc[1]; store_T<0>(Pm1, pacc, mt, nt0, fr, fq);
        lds_barrier();
        zero_acc(acc); mm64(acc, Rb0, Cb0, mt, nt0, fr, fq); store_T<0>(Cb1, acc, mt, nt0, fr, fq);
        zero_acc(acc); mm64(acc, Cb0, Pm1, mt, nt0, fr, fq); pacc[0] += acc[0]; pacc[1] += acc[1]; store_T<0>(Pm0, pacc, mt, nt0, fr, fq);
        lds_barrier();
        zero_acc(acc); mm64(acc, Cb1, Pm0, mt, nt0, fr, fq); pacc[0] += acc[0]; pacc[1] += acc[1];
        store_T<0>(Tm, pacc, mt, nt0, fr, fq);
        lds_barrier();
        zero_acc(acc); mm64(acc, Tm, AtT, mt, nt0, fr, fq); store_T<0>(PT, acc, mt, nt0, fr, fq);
        zero_acc(acc); mm64(acc, Aak, VT, mt, nt0, fr, fq); store_T<0>(AkVT, acc, mt, nt0, fr, fq);
        lds_barrier();
        {
            zero_acc(acc); mm64(acc, Tm, AkVT, mt, nt0, fr, fq); store_T<0>(QT, acc, mt, nt0, fr, fq);
            zero_acc(acc); mm64(acc, PT, BtT, mt, nt0, fr, fq);
            bf16_t* Mo = Mg + (size_t)u * 4096;
#pragma unroll
            for (int nn = 0; nn < 2; ++nn) {
                const int C = (nt0 + nn) * 16 + fr, Rb = mt * 16 + fq * 4;
                const float wl = sWL[C];
                uint2 w; w.x = pack2(acc[nn][0] * wl, acc[nn][1] * wl); w.y = pack2(acc[nn][2] * wl, acc[nn][3] * wl);
                const int pos = (Rb & ~12) | ((Rb & 4) << 1) | ((Rb & 8) >> 1);
                const int posw = ((((pos >> 3) ^ (C & 7)) << 3) | (pos & 7));
                *reinterpret_cast<uint2*>(Mo + C * 64 + posw) = w;
            }
        }
        lds_barrier();
        {
            zero_acc(acc); mm64(acc, BtT, QT, mt, nt0, fr, fq); mm64(acc, KtT, VT, mt, nt0, fr, fq);
            bf16_t* No = Ng + (size_t)u * 4096;
            float wl[4];
#pragma unroll
            for (int j = 0; j < 4; ++j) wl[j] = sWL[mt * 16 + fq * 4 + j];
#pragma unroll
            for (int nn = 0; nn < 2; ++nn) {
                const int C = (nt0 + nn) * 16 + fr, Rb = mt * 16 + fq * 4;
                uint2 w; w.x = pack2(acc[nn][0] * wl[0], acc[nn][1] * wl[1]); w.y = pack2(acc[nn][2] * wl[2], acc[nn][3] * wl[3]);
                const int posw = ((((Rb >> 3) ^ (C & 7)) << 3) | (Rb & 7));
                *reinterpret_cast<uint2*>(No + C * 64 + posw) = w;
            }
            if (tid < 64) { WLg[(size_t)u * 64 + tid] = sWL[tid]; BCg[(size_t)u * 64 + tid] = sBC[tid]; }
            const size_t tok0 = (size_t)b * SEQ + n * 64;
            zero_acc(acc); mm64(acc, PT, Arb, mt, nt0, fr, fq);
#pragma unroll
            for (int nn = 0; nn < 2; ++nn) {
                const int C = (nt0 + nn) * 16 + fr, Rb = mt * 16 + fq * 4;
                const uint2 rt = *reinterpret_cast<const uint2*>(Rt + C * RC_LD + Rb);
                uint2 w;
                w.x = pack2(acc[nn][0] + __uint_as_float(rt.x << 16), acc[nn][1] + __uint_as_float(rt.x & 0xffff0000u));
                w.y = pack2(acc[nn][2] + __uint_as_float(rt.y << 16), acc[nn][3] + __uint_as_float(rt.y & 0xffff0000u));
                *reinterpret_cast<uint2*>(PRg + (tok0 + C) * 512 + h * 64 + Rb) = w;
            }
            zero_acc(acc); mm64(acc, QT, Arb, mt, nt0, fr, fq); mm64(acc, VT, Ark, mt, nt0, fr, fq);
#pragma unroll
            for (int nn = 0; nn < 2; ++nn) {
                const int C = (nt0 + nn) * 16 + fr, Rb = mt * 16 + fq * 4;
                uint2 w; w.x = pack2(acc[nn][0], acc[nn][1]); w.y = pack2(acc[nn][2], acc[nn][3]);
                *reinterpret_cast<uint2*>(YQg + (tok0 + C) * 512 + h * 64 + Rb) = w;
            }
        }
        cur = nxt;
        lds_barrier();
    }
}

typedef float f32x16 __attribute__((ext_vector_type(16)));
#define R2_SLOT 12800
__device__ __forceinline__ void r2_issue(const unsigned char* Mg, const unsigned char* Ng, const unsigned char* WLg, size_t u, int J, int lane,
                                         unsigned char* slot) {
#pragma unroll
    for (int i = 0; i < 8; ++i)
        __builtin_amdgcn_global_load_lds((const unsigned*)(Mg + u * 8192 + i * 1024 + lane * 16),
                                         (__attribute__((address_space(3))) unsigned*)(slot + i * 1024), 16, 0, 0);
#pragma unroll
    for (int i = 0; i < 4; ++i)
        __builtin_amdgcn_global_load_lds((const unsigned*)(Ng + u * 8192 + J * 4096 + i * 1024 + lane * 16),
                                         (__attribute__((address_space(3))) unsigned*)(slot + 8192 + i * 1024), 16, 0, 0);
    __builtin_amdgcn_global_load_lds((const unsigned*)(WLg + u * 256 + lane * 4),
                                     (__attribute__((address_space(3))) unsigned*)(slot + 12288), 4, 0, 0);
}
__device__ __forceinline__ unsigned lds_addr(const void* p) { return (unsigned)(size_t)(const __attribute__((address_space(3))) unsigned char*)p; }
template <int OFF> __device__ __forceinline__ void ldsr128(bf16x8& d, unsigned a) { asm volatile("ds_read_b128 %0, %1 offset:%2" : "=v"(d) : "v"(a), "n"(OFF)); }
template <int OFF> __device__ __forceinline__ void ldsr128f(float4& d, unsigned a) { asm volatile("ds_read_b128 %0, %1 offset:%2" : "=v"(d) : "v"(a), "n"(OFF)); }
template <int OFF> __device__ __forceinline__ void ldsr64(uint2& d, unsigned a) { asm volatile("ds_read_b64 %0, %1 offset:%2" : "=v"(d) : "v"(a), "n"(OFF)); }
template <int WAITN>
__device__ __forceinline__ void r2_step(f32x16 (&S)[2], const unsigned char* slot, bf16_t* so, int r, int h) {
    if (WAITN == 51) asm volatile("s_waitcnt vmcnt(51)" ::: "memory");
    else if (WAITN == 39) asm volatile("s_waitcnt vmcnt(39)" ::: "memory");
    else asm volatile("s_waitcnt vmcnt(0)" ::: "memory");
    uint2 nv[2][4]; float4 wl[2][4]; bf16x8 af[2][2][2];
    const unsigned sa = lds_addr(slot);
    {
        const unsigned aw = sa + 12288 + h * 16;
        ldsr128f<0>(wl[0][0], aw); ldsr128f<32>(wl[0][1], aw); ldsr128f<64>(wl[0][2], aw); ldsr128f<96>(wl[0][3], aw);
        ldsr128f<128>(wl[1][0], aw); ldsr128f<160>(wl[1][1], aw); ldsr128f<192>(wl[1][2], aw); ldsr128f<224>(wl[1][3], aw);
        const unsigned an = sa + 8192 + r * 128 + h * 8;
        const unsigned x0 = ((0 ^ (r & 7)) * 16), x1 = ((1 ^ (r & 7)) * 16), x2 = ((2 ^ (r & 7)) * 16), x3 = ((3 ^ (r & 7)) * 16);
        ldsr64<0>(nv[0][0], an + x0); ldsr64<0>(nv[0][1], an + x1); ldsr64<0>(nv[0][2], an + x2); ldsr64<0>(nv[0][3], an + x3);
        ldsr64<0>(nv[1][0], an + (x0 ^ 64)); ldsr64<0>(nv[1][1], an + (x1 ^ 64)); ldsr64<0>(nv[1][2], an + (x2 ^ 64)); ldsr64<0>(nv[1][3], an + (x3 ^ 64));
        const unsigned aa = sa + r * 128;
        const unsigned c00 = (((0 + h) ^ (r & 7)) * 16), c01 = (((2 + h) ^ (r & 7)) * 16), c10 = (((4 + h) ^ (r & 7)) * 16), c11 = (((6 + h) ^ (r & 7)) * 16);
        ldsr128<0>(af[0][0][0], aa + c00); ldsr128<0>(af[0][0][1], aa + c01); ldsr128<0>(af[0][1][0], aa + c10); ldsr128<0>(af[0][1][1], aa + c11);
        ldsr128<4096>(af[1][0][0], aa + c00); ldsr128<4096>(af[1][0][1], aa + c01); ldsr128<4096>(af[1][1][0], aa + c10); ldsr128<4096>(af[1][1][1], aa + c11);
    }
    unsigned pk[2][8];
#pragma unroll
    for (int K = 0; K < 2; ++K)
#pragma unroll
        for (int q = 0; q < 8; ++q) pk[K][q] = pack2(S[K][2 * q], S[K][2 * q + 1]);
#pragma unroll
    for (int I = 0; I < 2; ++I) {
        uint4 w0, w1;
        w0.x = pk[I][0]; w0.y = pk[I][1]; w0.z = pk[I][2]; w0.w = pk[I][3];
        w1.x = pk[I][4]; w1.y = pk[I][5]; w1.z = pk[I][6]; w1.w = pk[I][7];
        *reinterpret_cast<uint4*>(so + r * 64 + I * 32 + h * 16) = w0;
        *reinterpret_cast<uint4*>(so + r * 64 + I * 32 + h * 16 + 8) = w1;
    }
    asm volatile("s_waitcnt lgkmcnt(0)" ::: "memory");
    __builtin_amdgcn_sched_barrier(0);
    bf16x8 bfrag[2][2];
#pragma unroll
    for (int K = 0; K < 2; ++K)
#pragma unroll
        for (int s = 0; s < 2; ++s) {
            union { bf16x8 v; unsigned u[4]; } cvt;
#pragma unroll
            for (int q = 0; q < 4; ++q) cvt.u[q] = pk[K][4 * s + q];
            bfrag[K][s] = cvt.v;
        }
#pragma unroll
    for (int I = 0; I < 2; ++I) {
        f32x16 acc;
#pragma unroll
        for (int g = 0; g < 4; ++g) {
            acc[4 * g + 0] = __uint_as_float(nv[I][g].x << 16) + wl[I][g].x * S[I][4 * g + 0];
            acc[4 * g + 1] = __uint_as_float(nv[I][g].x & 0xffff0000u) + wl[I][g].y * S[I][4 * g + 1];
            acc[4 * g + 2] = __uint_as_float(nv[I][g].y << 16) + wl[I][g].z * S[I][4 * g + 2];
            acc[4 * g + 3] = __uint_as_float(nv[I][g].y & 0xffff0000u) + wl[I][g].w * S[I][4 * g + 3];
        }
#pragma unroll
        for (int K = 0; K < 2; ++K)
#pragma unroll
            for (int s = 0; s < 2; ++s) acc = __builtin_amdgcn_mfma_f32_32x32x16_bf16(af[I][K][s], bfrag[K][s], acc, 0, 0, 0);
        S[I] = acc;
    }
}
__device__ __forceinline__ void phase_rwkv_r2(const Params& p, unsigned char* smem) {
    const int tidx = otid(p.wave);
    if (obid() >= 64) { phase_pre(p, smem, 1, obid() - 64, ogdim() - 64); return; }
    if (p.wave != 0) return;
    const int task = obid(), bh = task >> 1, J = task & 1;
    const int lane = tidx & 63, r = lane & 31, h = lane >> 5;
    const unsigned char* Mg = p.ws + OFF_MB;
    const unsigned char* Ng = p.ws + OFF_NTB;
    const unsigned char* WLg = p.ws + OFF_WLB;
    f32x16 S[2];
#pragma unroll
    for (int i = 0; i < 16; ++i) { S[0][i] = 0.f; S[1][i] = 0.f; }
    const size_t ub = (size_t)bh * 128;
    r2_issue(Mg, Ng, WLg, ub + 0, J, lane, smem + 0 * R2_SLOT);
    r2_issue(Mg, Ng, WLg, ub + 1, J, lane, smem + 1 * R2_SLOT);
    r2_issue(Mg, Ng, WLg, ub + 2, J, lane, smem + 2 * R2_SLOT);
#define R2_STEP(n_, SL, W) do { \
        const int n2 = (n_); \
        if (n2 + 3 < 128) r2_issue(Mg, Ng, WLg, ub + n2 + 3, J, lane, smem + (((SL) + 3) & 3) * R2_SLOT); \
        r2_step<W>(S, smem + (SL) * R2_SLOT, s0_ptr(p.ws, (int)ub + n2) + (size_t)J * 32 * 64, r, h); } while (0)
    R2_STEP(0, 0, 39); R2_STEP(1, 1, 39); R2_STEP(2, 2, 39); R2_STEP(3, 3, 51);
#pragma unroll 1
    for (int n = 4; n < 124; n += 4) {
        R2_STEP(n, 0, 51); R2_STEP(n + 1, 1, 51); R2_STEP(n + 2, 2, 51); R2_STEP(n + 3, 3, 51);
    }
    R2_STEP(124, 0, 51); R2_STEP(125, 1, 0); R2_STEP(126, 2, 0); R2_STEP(127, 3, 0);
#undef R2_STEP
}

struct R3In { uint4 pr, s0; uint2 yq[2]; unsigned short v[8], g[8]; unsigned short pv; float bc[8]; };
__device__ __forceinline__ void r3_load(R3In& in, const Params& p, int u, int tid) {
    const int b = u >> 10, h = (u >> 7) & 7, n = u & 127;
    const int wv = tid >> 6, lane = tid & 63, fr = lane & 15, fq = lane >> 4, mt = wv >> 1, nt0 = (wv & 1) * 2;
    const size_t tok0 = (size_t)b * SEQ + n * 64;
    const bf16_t* PRg = reinterpret_cast<const bf16_t*>(p.ws + OFF_AA);
    const bf16_t* YQg = reinterpret_cast<const bf16_t*>(p.ws + OFF_LOGW);
    const bf16_t* GG = reinterpret_cast<const bf16_t*>(p.ws + OFF_GG);
    const bf16_t* P = reinterpret_cast<const bf16_t*>(p.ws + OFF_P);
    const float* BCg = reinterpret_cast<const float*>(p.ws + OFF_BCB);
    const int row = tid >> 3, ch = tid & 7;
    in.pr = *reinterpret_cast<const uint4*>(PRg + (tok0 + row) * 512 + h * 64 + ch * 8);
    in.s0 = reinterpret_cast<const uint4*>(s0_ptr(p.ws, u))[tid];
#pragma unroll
    for (int nn = 0; nn < 2; ++nn) in.yq[nn] = *reinterpret_cast<const uint2*>(YQg + (tok0 + (nt0 + nn) * 16 + fr) * 512 + h * 64 + mt * 16 + fq * 4);
    const int c = h * 64 + lane;
    const int s0i = n * 64 + wv * 8;
    in.pv = (s0i > 0) ? P[(tok0 + wv * 8 - 1) * 2304 + 1024 + c] : (unsigned short)0;
#pragma unroll
    for (int i = 0; i < 8; ++i) {
        in.v[i] = P[(tok0 + wv * 8 + i) * 2304 + 1024 + c];
        in.g[i] = GG[(tok0 + wv * 8 + i) * 512 + c];
        in.bc[i] = BCg[(size_t)u * 64 + wv * 8 + i];
    }
}
__device__ __forceinline__ void phase_rwkv_r3(const Params& p, unsigned char* smem) {
    const int tidx = otid(p.wave);
    const int tid = tidx, wv = tid >> 6, lane = tid & 63, fr = lane & 15, fq = lane >> 4, mt = wv >> 1, nt0 = (wv & 1) * 2;
    bf16_t* base = reinterpret_cast<bf16_t*>(smem);
    bf16_t* Prs = base; bf16_t* Sb = base + RC_BUF;
    float* Yf = reinterpret_cast<float*>(smem + 2 * RC_BYTES);
    bf16_t* YC = reinterpret_cast<bf16_t*>(p.ws + OFF_YCAT);
    R3In cur, nxt;
    if (obid() < 4096) r3_load(cur, p, obid(), tid);
    nxt = cur;
    for (int u = obid(); u < 4096; u += ogdim()) {
        const int b = u >> 10, h = (u >> 7) & 7, n = u & 127;
        const int c = h * 64 + lane;
        float mu_v = p.in[2][1024 + c], lng = p.in[11][c], lnb = p.in[12][c];
        asm volatile("" : "+v"(mu_v), "+v"(lng), "+v"(lnb));
        if (u + ogdim() < 4096) r3_load(nxt, p, u + ogdim(), tid);
        {
            const int row = tid >> 3, ch = tid & 7;
            *reinterpret_cast<uint4*>(Prs + row * RC_LD + ch * 8) = cur.pr;
            const int I = ch >> 2, hh = (ch >> 1) & 1, g0 = (ch & 1) * 2;
            const int k0 = I * 32 + 8 * g0 + 4 * hh;
            uint2 lo; lo.x = cur.s0.x; lo.y = cur.s0.y;
            uint2 hi; hi.x = cur.s0.z; hi.y = cur.s0.w;
            *reinterpret_cast<uint2*>(Sb + row * RC_LD + k0) = lo;
            *reinterpret_cast<uint2*>(Sb + row * RC_LD + k0 + 8) = hi;
        }
        lds_barrier();
        {
            f32x4 acc[2];
            zero_acc(acc);
            mm64(acc, Sb, Prs, mt, nt0, fr, fq);
#pragma unroll
            for (int nn = 0; nn < 2; ++nn) {
                const int C = (nt0 + nn) * 16 + fr, Rb = mt * 16 + fq * 4;
                const uint2 q = cur.yq[nn];
                float4 o;
                o.x = acc[nn][0] + __uint_as_float(q.x << 16); o.y = acc[nn][1] + __uint_as_float(q.x & 0xffff0000u);
                o.z = acc[nn][2] + __uint_as_float(q.y << 16); o.w = acc[nn][3] + __uint_as_float(q.y & 0xffff0000u);
                *reinterpret_cast<float4*>(Yf + C * 68 + Rb) = o;
            }
        }
        lds_barrier();
        {
            float pv = bf2f(cur.pv);
#pragma unroll
            for (int i = 0; i < 8; ++i) {
                const int t = wv * 8 + i;
                const size_t tok = (size_t)b * SEQ + n * 64 + t;
                const float y = Yf[t * 68 + lane];
                const float mean = wave_sum(y) * (1.0f / 64.0f);
                const float d = y - mean;
                const float var = wave_sum(d * d) * (1.0f / 64.0f);
                const float yn = d * rsqrtf(var + 64e-5f) * lng + lnb;
                const float g = bf2f(cur.g[i]);
                const float v0 = bf2f(cur.v[i]);
                const float vv = bf2f(f2bf(v0 + mu_v * (pv - v0)));
                pv = v0;
                YC[tok * 1024 + c] = f2bf((yn + cur.bc[i] * vv) * g);
            }
        }
        cur = nxt;
    }
}

#define LR_LD 1032
__device__ __forceinline__ void phase_ln_route(const Params& p, int layer, unsigned char* smem) {
    const bf16_t* X = reinterpret_cast<const bf16_t*>(p.ws + OFF_P);
    const int tidx = otid(p.wave);
    const int tid = tidx, wv = tid >> 6, lane = tid & 63, fr = lane & 15, fq = lane >> 4;
    const float* g = p.in[24] + layer * DM;
    const float* bb = p.in[25] + layer * DM;
    const float* rgb = p.in[27] + layer * 4;
    const float* reb = p.in[29] + layer * 32;
    const bf16_t* RH = reinterpret_cast<const bf16_t*>(p.ws + OFF_W) + WE_RT_HI + (size_t)layer * 48 * 1024;
    const bf16_t* RL = reinterpret_cast<const bf16_t*>(p.ws + OFF_W) + WE_RT_LO + (size_t)layer * 48 * 1024;
    bf16_t* XB = reinterpret_cast<bf16_t*>(p.ws + OFF_ACTB);
    int* cnt = reinterpret_cast<int*>(p.ws + OFF_CTRL) + layer * 32;
    int* ltok = reinterpret_cast<int*>(p.ws + OFF_LTOK);
    float* lgate = reinterpret_cast<float*>(p.ws + OFF_LGATE);
    bf16_t* sXH = reinterpret_cast<bf16_t*>(smem);
    bf16_t* sXL = sXH + 16 * LR_LD;
    float* sRed = reinterpret_cast<float*>(smem + 2 * 16 * LR_LD * 2);
    float* sLog = sRed + 8 * 16 * 48;
    bf16x8 bh[4][3], bl[4][3];
#pragma unroll
    for (int ks = 0; ks < 4; ++ks)
#pragma unroll
        for (int nt = 0; nt < 3; ++nt) {
            const int k0 = wv * 128 + ks * 32 + fq * 8;
            bh[ks][nt] = *reinterpret_cast<const bf16x8*>(RH + (size_t)(nt * 16 + fr) * 1024 + k0);
            bl[ks][nt] = *reinterpret_cast<const bf16x8*>(RL + (size_t)(nt * 16 + fr) * 1024 + k0);
        }
    float4 gg[4], bv[4];
#pragma unroll
    for (int i = 0; i < 4; ++i) {
        gg[i] = *reinterpret_cast<const float4*>(g + i * 256 + lane * 4);
        bv[i] = *reinterpret_cast<const float4*>(bb + i * 256 + lane * 4);
    }
    int* sCnt = reinterpret_cast<int*>(sLog + 16 * 48);
    int* sBase = sCnt + 32;
    int* sDecE = sBase + 32;
    int* sDecP = sDecE + 256;
    float* sDecG = reinterpret_cast<float*>(sDecP + 256);
    int* sDecR = reinterpret_cast<int*>(sDecG + 256);
    if (tid < 32) sCnt[tid] = 0;
    uint2 pre[2][4];
    {
        const int tile0 = obid();
        if (tile0 < NT / 16) {
#pragma unroll
            for (int rr = 0; rr < 2; ++rr)
#pragma unroll
                for (int i = 0; i < 4; ++i)
                    pre[rr][i] = *reinterpret_cast<const uint2*>(X + (size_t)(tile0 * 16 + wv * 2 + rr) * DM + i * 256 + lane * 4);
        }
    }
    __syncthreads();
    int nloc = 0;
    for (int tile = obid(); tile < NT / 16; tile += ogdim(), ++nloc) {
        uint2 cur[2][4];
#pragma unroll
        for (int rr = 0; rr < 2; ++rr)
#pragma unroll
            for (int i = 0; i < 4; ++i) cur[rr][i] = pre[rr][i];
        {
            const int tn = tile + ogdim();
            if (tn < NT / 16) {
#pragma unroll
                for (int rr = 0; rr < 2; ++rr)
#pragma unroll
                    for (int i = 0; i < 4; ++i)
                        pre[rr][i] = *reinterpret_cast<const uint2*>(X + (size_t)(tn * 16 + wv * 2 + rr) * DM + i * 256 + lane * 4);
            }
        }
#pragma unroll
        for (int rr = 0; rr < 2; ++rr) {
            const int rl = wv * 2 + rr;
            const int row = tile * 16 + rl;
            float v[16];
#pragma unroll
            for (int i = 0; i < 4; ++i) {
                const uint2 t = cur[rr][i];
                v[4 * i] = __uint_as_float(t.x << 16); v[4 * i + 1] = __uint_as_float(t.x & 0xffff0000u);
                v[4 * i + 2] = __uint_as_float(t.y << 16); v[4 * i + 3] = __uint_as_float(t.y & 0xffff0000u);
            }
            float sum = 0.f;
#pragma unroll
            for (int i = 0; i < 16; ++i) sum += v[i];
            const float mean = wave_sum(sum) * (1.0f / DM);
            float sq = 0.f;
#pragma unroll
            for (int i = 0; i < 16; ++i) { float d = v[i] - mean; sq += d * d; }
            const float rstd = rsqrtf(wave_sum(sq) * (1.0f / DM) + 1e-5f);
#pragma unroll
            for (int i = 0; i < 4; ++i) {
                const int col = i * 256 + lane * 4;
                const float o0 = (v[4 * i] - mean) * rstd * gg[i].x + bv[i].x;
                const float o1 = (v[4 * i + 1] - mean) * rstd * gg[i].y + bv[i].y;
                const float o2 = (v[4 * i + 2] - mean) * rstd * gg[i].z + bv[i].z;
                const float o3 = (v[4 * i + 3] - mean) * rstd * gg[i].w + bv[i].w;
                const bf16_t h0 = f2bf(o0), h1 = f2bf(o1), h2 = f2bf(o2), h3 = f2bf(o3);
                uint2 wh; wh.x = (unsigned)h0 | ((unsigned)h1 << 16); wh.y = (unsigned)h2 | ((unsigned)h3 << 16);
                *reinterpret_cast<uint2*>(XB + (size_t)row * DM + col) = wh;
                *reinterpret_cast<uint2*>(sXH + rl * LR_LD + col) = wh;
                uint2 wl; wl.x = pack2(o0 - bf2f(h0), o1 - bf2f(h1)); wl.y = pack2(o2 - bf2f(h2), o3 - bf2f(h3));
                *reinterpret_cast<uint2*>(sXL + rl * LR_LD + col) = wl;
            }
        }
        lds_barrier();
        {
            f32x4 acc[3];
#pragma unroll
            for (int nt = 0; nt < 3; ++nt) acc[nt] = (f32x4){0.f, 0.f, 0.f, 0.f};
#pragma unroll
            for (int ks = 0; ks < 4; ++ks) {
                const int k0 = wv * 128 + ks * 32 + fq * 8;
                const bf16x8 ah = *reinterpret_cast<const bf16x8*>(sXH + fr * LR_LD + k0);
                const bf16x8 al = *reinterpret_cast<const bf16x8*>(sXL + fr * LR_LD + k0);
#pragma unroll
                for (int nt = 0; nt < 3; ++nt) {
                    acc[nt] = __builtin_amdgcn_mfma_f32_16x16x32_bf16(ah, bh[ks][nt], acc[nt], 0, 0, 0);
                    acc[nt] = __builtin_amdgcn_mfma_f32_16x16x32_bf16(al, bh[ks][nt], acc[nt], 0, 0, 0);
                    acc[nt] = __builtin_amdgcn_mfma_f32_16x16x32_bf16(ah, bl[ks][nt], acc[nt], 0, 0, 0);
                }
            }
#pragma unroll
            for (int nt = 0; nt < 3; ++nt)
#pragma unroll
                for (int j = 0; j < 4; ++j) sRed[(wv * 16 + fq * 4 + j) * 48 + nt * 16 + fr] = acc[nt][j];
        }
        lds_barrier();
        for (int idx = tid; idx < 16 * 48; idx += NTHREADS) {
            float s = 0.f;
#pragma unroll
            for (int w = 0; w < 8; ++w) s += sRed[w * 16 * 48 + idx];
            sLog[idx] = s;
        }
        lds_barrier();
        if (tid < 16) {
            const int row = tile * 16 + tid;
            const float* lg = sLog + tid * 48;
            float gl[4];
#pragma unroll
            for (int j = 0; j < 4; ++j) gl[j] = lg[j] + rgb[j];
            int gi = 0; float gm = gl[0];
#pragma unroll
            for (int j = 1; j < 4; ++j) if (gl[j] > gm) { gm = gl[j]; gi = j; }
            float gs = 0.f;
#pragma unroll
            for (int j = 0; j < 4; ++j) gs += __expf(gl[j] - gm);
            const float gw = 1.0f / gs;
            float el[8];
#pragma unroll
            for (int j = 0; j < 8; ++j) el[j] = lg[4 + gi * 8 + j] + reb[gi * 8 + j];
            int i1 = 0; float m1 = el[0];
#pragma unroll
            for (int j = 1; j < 8; ++j) if (el[j] > m1) { m1 = el[j]; i1 = j; }
            int i2 = (i1 == 0) ? 1 : 0; float m2 = el[i2];
#pragma unroll
            for (int j = 0; j < 8; ++j) if (j != i1 && el[j] > m2) { m2 = el[j]; i2 = j; }
            const float e2 = __expf(m2 - m1);
            const float p1 = 1.0f / (1.0f + e2), p2 = e2 / (1.0f + e2);
            const int ex1 = gi * 8 + i1, ex2 = gi * 8 + i2;
            const int d0 = (nloc * 16 + tid) * 2;
            sDecE[d0] = ex1; sDecP[d0] = atomicAdd(&sCnt[ex1], 1); sDecG[d0] = gw * p1; sDecR[d0] = row * 2;
            sDecE[d0 + 1] = ex2; sDecP[d0 + 1] = atomicAdd(&sCnt[ex2], 1); sDecG[d0 + 1] = gw * p2; sDecR[d0 + 1] = row * 2 + 1;
        }
    }
    __syncthreads();
    if (tid < 32) sBase[tid] = atomicAdd(&cnt[tid], sCnt[tid]);
    __syncthreads();
    if (tid < nloc * 32) {
        const int ex = sDecE[tid];
        const size_t pos = (size_t)ex * NT + sBase[ex] + sDecP[tid];
        ltok[pos] = sDecR[tid];
        lgate[pos] = sDecG[tid];
    }
    __syncthreads();
}

__device__ __forceinline__ void phase_exp1(const Params& p, int layer, bf16_t* smem) {
    const int* cnt = reinterpret_cast<const int*>(p.ws + OFF_CTRL) + layer * 32;
    const int* ltok = reinterpret_cast<const int*>(p.ws + OFF_LTOK);
    const bf16_t* XB = reinterpret_cast<const bf16_t*>(p.ws + OFF_ACTB);
    const bf16_t* W13 = reinterpret_cast<const bf16_t*>(p.ws + OFF_W) + WE_W13 + (size_t)layer * 32 * 262144;
    bf16_t* H = reinterpret_cast<bf16_t*>(p.ws + OFF_HBUF);
    int t = obid();
    int base = 0, tbase = 0;
    for (int e = 0; e < 32; ++e) {
        int c = cnt[e];
        int nt = ((c + 255) >> 8) * 2;
        while (t < tbase + nt) {
            int w = t - tbase;
            EpiExp1 epi{H, base, c};
            gemm_tile<true>(XB, DM, ltok + (size_t)e * NT, c, W13 + (size_t)e * 262144, DM, DM, (w >> 1) * 256, (w & 1) * 128, epi, smem, p.wave);
            t += ogdim();
        }
        tbase += nt; base += c;
    }
}
__device__ __forceinline__ void phase_exp2(const Params& p, int layer, bf16_t* smem) {
    const int* cnt = reinterpret_cast<const int*>(p.ws + OFF_CTRL) + layer * 32;
    const int* ltok = reinterpret_cast<const int*>(p.ws + OFF_LTOK);
    const float* lgate = reinterpret_cast<const float*>(p.ws + OFF_LGATE);
    const bf16_t* W2 = reinterpret_cast<const bf16_t*>(p.ws + OFF_W) + WE_W2 + (size_t)layer * 32 * 131072;
    const bf16_t* H = reinterpret_cast<const bf16_t*>(p.ws + OFF_HBUF);
    bf16_t* FS = reinterpret_cast<bf16_t*>(p.ws + OFF_FS);
    int t = obid();
    int base = 0, tbase = 0;
    for (int e = 0; e < 32; ++e) {
        int c = cnt[e];
        int nt = ((c + 255) >> 8) * 8;
        while (t < tbase + nt) {
            int w = t - tbase;
            EpiExp2 epi;
            epi.FS = FS; epi.cnt = c;
            {
                const int tq = otid(p.wave), wq = tq >> 6, lq = tq & 63;
#pragma unroll
                for (int m = 0; m < 4; ++m) {
                    int li = (w >> 3) * 256 + (wq >> 1) * 64 + m * 16 + (lq & 15);
                    li = li < c ? li : c - 1;
                    epi.pk[m] = ltok[(size_t)e * NT + li]; epi.g[m] = lgate[(size_t)e * NT + li];
                }
            }
            gemm_tile<false>(H + (size_t)base * 128, 128, nullptr, 0, W2 + (size_t)e * 131072, 128, 128, (w >> 3) * 256, (w & 7) * 128, epi, smem, p.wave);
            t += ogdim();
        }
        tbase += nt; base += c;
    }
}

__device__ __forceinline__ void phase_ln_ffn(const Params& p, int layer, float* Xout, bool last) {
    const int tidx = otid(p.wave);
    const int tid = tidx, wv = tid >> 6, lane = tid & 63;
    const float* g = p.in[33] + layer * DM;
    const float* bb = p.in[34] + layer * DM;
    const bf16_t* FS = reinterpret_cast<const bf16_t*>(p.ws + OFF_FS);
    bf16_t* XB = reinterpret_cast<bf16_t*>(p.ws + OFF_ACTB);
    float4 gg[4], bv[4];
#pragma unroll
    for (int i = 0; i < 4; ++i) {
        gg[i] = *reinterpret_cast<const float4*>(g + i * 256 + lane * 4);
        bv[i] = *reinterpret_cast<const float4*>(bb + i * 256 + lane * 4);
    }
    asm volatile("" : "+v"(gg[0].x), "+v"(bv[3].w));
    const int row0 = obid() * NWAVES + wv, rstep = ogdim() * NWAVES;
    uint2 pt[4], pf0[4], pf1[4];
    if (row0 < NT) {
#pragma unroll
        for (int i = 0; i < 4; ++i) {
            const int col = i * 256 + lane * 4;
            pt[i] = *reinterpret_cast<const uint2*>(XB + (size_t)row0 * DM + col);
            pf0[i] = *reinterpret_cast<const uint2*>(FS + (size_t)row0 * DM + col);
            pf1[i] = *reinterpret_cast<const uint2*>(FS + ((size_t)NT + row0) * DM + col);
        }
    }
    for (int row = row0; row < NT; row += rstep) {
        uint2 t[4], f0[4], f1[4];
#pragma unroll
        for (int i = 0; i < 4; ++i) { t[i] = pt[i]; f0[i] = pf0[i]; f1[i] = pf1[i]; }
        if (row + rstep < NT) {
            const size_t rn = (size_t)(row + rstep);
#pragma unroll
            for (int i = 0; i < 4; ++i) {
                const int col = i * 256 + lane * 4;
                pt[i] = *reinterpret_cast<const uint2*>(XB + rn * DM + col);
                pf0[i] = *reinterpret_cast<const uint2*>(FS + rn * DM + col);
                pf1[i] = *reinterpret_cast<const uint2*>(FS + ((size_t)NT + rn) * DM + col);
            }
        }
        float v[16];
#pragma unroll
        for (int i = 0; i < 4; ++i) {
            v[4 * i] = ALPHA_F * __uint_as_float(t[i].x << 16) + __uint_as_float(f0[i].x << 16) + __uint_as_float(f1[i].x << 16);
            v[4 * i + 1] = ALPHA_F * __uint_as_float(t[i].x & 0xffff0000u) + __uint_as_float(f0[i].x & 0xffff0000u) + __uint_as_float(f1[i].x & 0xffff0000u);
            v[4 * i + 2] = ALPHA_F * __uint_as_float(t[i].y << 16) + __uint_as_float(f0[i].y << 16) + __uint_as_float(f1[i].y << 16);
            v[4 * i + 3] = ALPHA_F * __uint_as_float(t[i].y & 0xffff0000u) + __uint_as_float(f0[i].y & 0xffff0000u) + __uint_as_float(f1[i].y & 0xffff0000u);
        }
        float sum = 0.f;
#pragma unroll
        for (int i = 0; i < 16; ++i) sum += v[i];
        float mean = wave_sum(sum) * (1.0f / DM);
        float sq = 0.f;
#pragma unroll
        for (int i = 0; i < 16; ++i) { float d = v[i] - mean; sq += d * d; }
        float rstd = rsqrtf(wave_sum(sq) * (1.0f / DM) + 1e-5f);
#pragma unroll
        for (int i = 0; i < 4; ++i) {
            int col = i * 256 + lane * 4;
            float o0 = (v[4 * i] - mean) * rstd * gg[i].x + bv[i].x;
            float o1 = (v[4 * i + 1] - mean) * rstd * gg[i].y + bv[i].y;
            float o2 = (v[4 * i + 2] - mean) * rstd * gg[i].z + bv[i].z;
            float o3 = (v[4 * i + 3] - mean) * rstd * gg[i].w + bv[i].w;
            if (last) {
                *reinterpret_cast<float4*>(Xout + (size_t)row * DM + col) = make_float4(o0, o1, o2, o3);
            } else {
                uint2 w; w.x = pack2(o0, o1); w.y = pack2(o2, o3);
                *reinterpret_cast<uint2*>(XB + (size_t)row * DM + col) = w;
            }
        }
    }
}

#define CV_T 64
#define CV_ROWS (CV_T + 30)
template <int OB>
__device__ __forceinline__ void conv_blk(float (&acc)[CV_T], const bf16_t* sU, int tid, const float (&w0)[31]) {
#pragma unroll
    for (int rr = 0; rr < 38; ++rr) {
        const float uv = bf2f(sU[(OB * 8 + rr) * 512 + tid]);
#pragma unroll
        for (int oo = 0; oo < 8; ++oo) {
            const int j = rr - oo;
            if (j >= 0 && j <= 30) acc[OB * 8 + oo] += uv * w0[j];
        }
    }
}
__device__ __forceinline__ void phase_l1_conv(const Params& p, unsigned char* smem) {
    const int tidx = otid(p.wave);
    const bf16_t* P = reinterpret_cast<const bf16_t*>(p.ws + OFF_P);
    bf16_t* YC = reinterpret_cast<bf16_t*>(p.ws + OFF_YCAT);
    bf16_t* sU = reinterpret_cast<bf16_t*>(smem);
    float* red = reinterpret_cast<float*>(smem + CV_ROWS * 512 * 2);
    float* stat = red + 8 * 64 * 2;
    const int tid = tidx, wv = tid >> 6, lane = tid & 63;
    const float* cw = p.in[17];
    float w0[31];
#pragma unroll
    for (int j = 0; j < 31; ++j) w0[j] = cw[j * 512 + tid];
    const float cb0 = p.in[18][tid], g0 = p.in[19][tid], b0 = p.in[20][tid];
    for (int u = obid(); u < NT / CV_T; u += ogdim()) {
        const int t0 = u * CV_T;
        const int s0 = t0 & (SEQ - 1);
#pragma unroll 1
        for (int base = 0; base < CV_ROWS * 64; base += 6 * NTHREADS) {
            uint4 av[6], gv[6];
#pragma unroll
            for (int j = 0; j < 6; ++j) {
                const int it = base + j * NTHREADS + tid;
                const int r = it >> 6, c8 = (it & 63) * 8;
                av[j] = make_uint4(0u, 0u, 0u, 0u); gv[j] = av[j];
                if (it < CV_ROWS * 64 && s0 - 30 + r >= 0) {
                    const bf16_t* pr = P + (size_t)(t0 - 30 + r) * 3072 + c8;
                    av[j] = *reinterpret_cast<const uint4*>(pr);
                    gv[j] = *reinterpret_cast<const uint4*>(pr + 512);
                }
            }
#pragma unroll
            for (int j = 0; j < 6; ++j) {
                const int it = base + j * NTHREADS + tid;
                if (it < CV_ROWS * 64) {
                    const int r = it >> 6, c8 = (it & 63) * 8;
                    float a[8], gte[8];
                    unpack8(av[j], a); unpack8(gv[j], gte);
#pragma unroll
                    for (int i = 0; i < 8; ++i) a[i] = a[i] * sigmoidf_(gte[i]);
                    uint4 w;
                    w.x = pack2(a[0], a[1]); w.y = pack2(a[2], a[3]); w.z = pack2(a[4], a[5]); w.w = pack2(a[6], a[7]);
                    *reinterpret_cast<uint4*>(sU + r * 512 + c8) = w;
                }
            }
        }
        __syncthreads();
        float acc[CV_T];
#pragma unroll
        for (int o = 0; o < CV_T; ++o) acc[o] = cb0;
        conv_blk<0>(acc, sU, tid, w0); conv_blk<1>(acc, sU, tid, w0); conv_blk<2>(acc, sU, tid, w0); conv_blk<3>(acc, sU, tid, w0);
        conv_blk<4>(acc, sU, tid, w0); conv_blk<5>(acc, sU, tid, w0); conv_blk<6>(acc, sU, tid, w0); conv_blk<7>(acc, sU, tid, w0);
#pragma unroll
        for (int o = 0; o < CV_T; ++o) {
            const float s1 = wave_sum(acc[o]);
            const float s2 = wave_sum(acc[o] * acc[o]);
            if (lane == 0) { red[(wv * 64 + o) * 2] = s1; red[(wv * 64 + o) * 2 + 1] = s2; }
        }
        __syncthreads();
        if (tid < 64) {
            float s1 = 0.f, s2 = 0.f;
#pragma unroll
            for (int w = 0; w < 8; ++w) { s1 += red[(w * 64 + tid) * 2]; s2 += red[(w * 64 + tid) * 2 + 1]; }
            const float mean = s1 * (1.0f / 512.0f);
            const float var = fmaxf(s2 * (1.0f / 512.0f) - mean * mean, 0.f);
            stat[tid * 2] = mean; stat[tid * 2 + 1] = rsqrtf(var + 1e-5f);
        }
        __syncthreads();
#pragma unroll
        for (int o = 0; o < CV_T; ++o) {
            const float mean = stat[o * 2], rstd = stat[o * 2 + 1];
            const float y0 = (acc[o] - mean) * rstd * g0 + b0;
            YC[(size_t)(t0 + o) * 1024 + tid] = f2bf(siluf_(y0));
        }
    }
}

__device__ __forceinline__ float ret_lg(int h) { return log1pf(-exp2f(-5.0f - (float)h)); }

#define KT_LD 136
struct RetIn { uint4 k1, k2, v1, v2; };
__device__ __forceinline__ void ret_load_kv(RetIn& in, const bf16_t* P, int u, int tid) {
    const int n = u & 63, h = (u >> 6) & 7, b = u >> 9;
    const int c = tid >> 2, i0 = (tid & 3) * 8;
    const size_t tok = (size_t)b * SEQ + n * 128 + c;
    const bf16_t* kr = P + tok * 3072 + 1536 + h * 64;
    const bf16_t* vr = P + tok * 3072 + 2048 + h * 64;
    in.k1 = *reinterpret_cast<const uint4*>(kr + i0); in.k2 = *reinterpret_cast<const uint4*>(kr + 32 + i0);
    in.v1 = *reinterpret_cast<const uint4*>(vr + i0); in.v2 = *reinterpret_cast<const uint4*>(vr + 32 + i0);
}
__device__ __forceinline__ void st_col8(bf16_t* dst, int ld, const uint4 v) {
    dst[0 * ld] = (bf16_t)(v.x & 0xffffu); dst[1 * ld] = (bf16_t)(v.x >> 16);
    dst[2 * ld] = (bf16_t)(v.y & 0xffffu); dst[3 * ld] = (bf16_t)(v.y >> 16);
    dst[4 * ld] = (bf16_t)(v.z & 0xffffu); dst[5 * ld] = (bf16_t)(v.z >> 16);
    dst[6 * ld] = (bf16_t)(v.w & 0xffffu); dst[7 * ld] = (bf16_t)(v.w >> 16);
}
__device__ __forceinline__ void phase_ret_kv(const Params& p, unsigned char* smem) {
    const int tidx = otid(p.wave);
    const bf16_t* P = reinterpret_cast<const bf16_t*>(p.ws + OFF_P);
    const float2* rope = reinterpret_cast<const float2*>(p.ws + OFF_ROPE);
    float* KVT = reinterpret_cast<float*>(p.ws + OFF_KVT);
    bf16_t* sKT = reinterpret_cast<bf16_t*>(smem);
    bf16_t* sVT = sKT + 64 * KT_LD;
    const int tid = tidx, wv = tid >> 6, lane = tid & 63, fr = lane & 15, fq = lane >> 4;
    const int et = wv >> 1, dt0 = (wv & 1) * 2;
    RetIn cur, nxt;
    if (obid() < 2048) ret_load_kv(cur, P, obid(), tid);
    nxt = cur;
    for (int u = obid(); u < 2048; u += ogdim()) {
        const int n = u & 63, h = (u >> 6) & 7;
        const float lg = ret_lg(h);
        const int c = tid >> 2, i0 = (tid & 3) * 8;
        const int sidx = n * 128 + c;
        float2 cs[8];
#pragma unroll
        for (int i = 0; i < 8; ++i) cs[i] = rope[sidx * 32 + i0 + i];
        asm volatile("" : "+v"(cs[0].x), "+v"(cs[7].y));
        if (u + ogdim() < 2048) ret_load_kv(nxt, P, u + ogdim(), tid);
        {
            const float zeta = __expf((float)(127 - c) * lg) * 0.125f;
            float k1[8], k2[8];
            unpack8(cur.k1, k1); unpack8(cur.k2, k2);
#pragma unroll
            for (int i = 0; i < 8; ++i) {
                float o1 = (k1[i] * cs[i].x - k2[i] * cs[i].y) * zeta, o2 = (k1[i] * cs[i].y + k2[i] * cs[i].x) * zeta;
                sKT[(i0 + i) * KT_LD + c] = f2bf(o1);
                sKT[(32 + i0 + i) * KT_LD + c] = f2bf(o2);
            }
            st_col8(sVT + i0 * KT_LD + c, KT_LD, cur.v1);
            st_col8(sVT + (32 + i0) * KT_LD + c, KT_LD, cur.v2);
        }
        lds_barrier();
        f32x4 acc[2];
        acc[0] = (f32x4){0.f, 0.f, 0.f, 0.f}; acc[1] = (f32x4){0.f, 0.f, 0.f, 0.f};
#pragma unroll
        for (int ks = 0; ks < 4; ++ks) {
            bf16x8 af = *reinterpret_cast<const bf16x8*>(sVT + (et * 16 + fr) * KT_LD + ks * 32 + fq * 8);
#pragma unroll
            for (int nn = 0; nn < 2; ++nn) {
                bf16x8 bfr = *reinterpret_cast<const bf16x8*>(sKT + ((dt0 + nn) * 16 + fr) * KT_LD + ks * 32 + fq * 8);
                acc[nn] = __builtin_amdgcn_mfma_f32_16x16x32_bf16(af, bfr, acc[nn], 0, 0, 0);
            }
        }
        float* o = KVT + (size_t)u * 4096;
#pragma unroll
        for (int nn = 0; nn < 2; ++nn)
#pragma unroll
            for (int j = 0; j < 4; ++j) o[(et * 16 + fq * 4 + j) * 64 + (dt0 + nn) * 16 + fr] = acc[nn][j];
        cur = nxt;
        lds_barrier();
    }
}
__device__ __forceinline__ void phase_ret_scan(const Params& p) {
    const int tidx = otid(p.wave);
    float* KVT = reinterpret_cast<float*>(p.ws + OFF_KVT);
    for (int i = obid() * NTHREADS + tidx; i < 32 * 4096; i += ogdim() * NTHREADS) {
        int bh = i >> 12, ed = i & 4095, h = bh & 7;
        float gc = __expf(128.0f * ret_lg(h));
        float R = 0.f;
        float* q = KVT + (size_t)bh * 64 * 4096 + ed;
#pragma unroll 1
        for (int n0 = 0; n0 < 64; n0 += 16) {
            float kv[16];
#pragma unroll
            for (int j = 0; j < 16; ++j) kv[j] = q[(size_t)(n0 + j) * 4096];
#pragma unroll
            for (int j = 0; j < 16; ++j) { q[(size_t)(n0 + j) * 4096] = R; R = gc * R + kv[j]; }
        }
    }
}
#define Q_LD 72
struct RetOutIn { uint4 q1, q2, k1, k2, v1, v2; float4 r0, r1; unsigned short gr[16]; };
__device__ __forceinline__ void ret_load_out(RetOutIn& in, const bf16_t* P, const float* KVT, int u, int tid) {
    const int n = u & 63, h = (u >> 6) & 7, b = u >> 9;
    const int c = tid >> 2, i0 = (tid & 3) * 8;
    const size_t tok = (size_t)b * SEQ + n * 128 + c;
    const bf16_t* qr = P + tok * 3072 + 1024 + h * 64;
    in.q1 = *reinterpret_cast<const uint4*>(qr + i0); in.q2 = *reinterpret_cast<const uint4*>(qr + 32 + i0);
    in.k1 = *reinterpret_cast<const uint4*>(qr + 512 + i0); in.k2 = *reinterpret_cast<const uint4*>(qr + 512 + 32 + i0);
    in.v1 = *reinterpret_cast<const uint4*>(qr + 1024 + i0); in.v2 = *reinterpret_cast<const uint4*>(qr + 1024 + 32 + i0);
    const float* rp = KVT + (size_t)u * 4096 + tid * 8;
    in.r0 = *reinterpret_cast<const float4*>(rp); in.r1 = *reinterpret_cast<const float4*>(rp + 4);
    const int wv = tid >> 6, lane = tid & 63, fr = lane & 15, fq = lane >> 4;
#pragma unroll
    for (int j = 0; j < 4; ++j)
#pragma unroll
        for (int nn = 0; nn < 4; ++nn)
            in.gr[j * 4 + nn] = P[((size_t)b * SEQ + n * 128 + wv * 16 + fq * 4 + j) * 3072 + 2560 + h * 64 + nn * 16 + fr];
}
__device__ __forceinline__ void phase_ret_out(const Params& p, unsigned char* smem) {
    const int tidx = otid(p.wave);
    const bf16_t* P = reinterpret_cast<const bf16_t*>(p.ws + OFF_P);
    const float2* rope = reinterpret_cast<const float2*>(p.ws + OFF_ROPE);
    const float* KVT = reinterpret_cast<const float*>(p.ws + OFF_KVT);
    bf16_t* YC = reinterpret_cast<bf16_t*>(p.ws + OFF_YCAT);
    bf16_t* sQ = reinterpret_cast<bf16_t*>(smem);
    bf16_t* sK = sQ + 128 * Q_LD;
    bf16_t* sVT = sK + 128 * Q_LD;
    bf16_t* sRT = sVT + 64 * KT_LD;
    bf16_t* sS = sQ;
    const int tid = tidx, wv = tid >> 6, lane = tid & 63, fr = lane & 15, fq = lane >> 4;
    RetOutIn cur, nxt;
    if (obid() < 2048) ret_load_out(cur, P, KVT, obid(), tid);
    nxt = cur;
    for (int u = obid(); u < 2048; u += ogdim()) {
        const int n = u & 63, h = (u >> 6) & 7, b = u >> 9;
        const float lg = ret_lg(h);
        const int c = tid >> 2, i0 = (tid & 3) * 8;
        const int sidx = n * 128 + c;
        float2 cs[8];
#pragma unroll
        for (int i = 0; i < 8; ++i) cs[i] = rope[sidx * 32 + i0 + i];
        float gng[4], gnb[4];
#pragma unroll
        for (int nn = 0; nn < 4; ++nn) { gng[nn] = p.in[21][h * 64 + nn * 16 + fr]; gnb[nn] = p.in[22][h * 64 + nn * 16 + fr]; }
        asm volatile("" : "+v"(cs[0].x), "+v"(cs[7].y), "+v"(gng[0]), "+v"(gnb[3]));
        if (u + ogdim() < 2048) ret_load_out(nxt, P, KVT, u + ogdim(), tid);
        {
            float qa[8], qb[8], ka[8], kb[8];
            float q1[8], q2[8], k1[8], k2[8];
            unpack8(cur.q1, q1); unpack8(cur.q2, q2); unpack8(cur.k1, k1); unpack8(cur.k2, k2);
#pragma unroll
            for (int i = 0; i < 8; ++i) {
                qa[i] = q1[i] * cs[i].x - q2[i] * cs[i].y; qb[i] = q1[i] * cs[i].y + q2[i] * cs[i].x;
                ka[i] = (k1[i] * cs[i].x - k2[i] * cs[i].y) * 0.125f; kb[i] = (k1[i] * cs[i].y + k2[i] * cs[i].x) * 0.125f;
            }
            st_col8(sVT + i0 * KT_LD + c, KT_LD, cur.v1);
            st_col8(sVT + (32 + i0) * KT_LD + c, KT_LD, cur.v2);
            uint4 w;
            w.x = pack2(qa[0], qa[1]); w.y = pack2(qa[2], qa[3]); w.z = pack2(qa[4], qa[5]); w.w = pack2(qa[6], qa[7]);
            *reinterpret_cast<uint4*>(sQ + c * Q_LD + i0) = w;
            w.x = pack2(qb[0], qb[1]); w.y = pack2(qb[2], qb[3]); w.z = pack2(qb[4], qb[5]); w.w = pack2(qb[6], qb[7]);
            *reinterpret_cast<uint4*>(sQ + c * Q_LD + 32 + i0) = w;
            w.x = pack2(ka[0], ka[1]); w.y = pack2(ka[2], ka[3]); w.z = pack2(ka[4], ka[5]); w.w = pack2(ka[6], ka[7]);
            *reinterpret_cast<uint4*>(sK + c * Q_LD + i0) = w;
            w.x = pack2(kb[0], kb[1]); w.y = pack2(kb[2], kb[3]); w.z = pack2(kb[4], kb[5]); w.w = pack2(kb[6], kb[7]);
            *reinterpret_cast<uint4*>(sK + c * Q_LD + 32 + i0) = w;
            w.x = pack2(cur.r0.x, cur.r0.y); w.y = pack2(cur.r0.z, cur.r0.w); w.z = pack2(cur.r1.x, cur.r1.y); w.w = pack2(cur.r1.z, cur.r1.w);
            *reinterpret_cast<uint4*>(sRT + (tid >> 3) * Q_LD + (tid & 7) * 8) = w;
        }
        lds_barrier();
        f32x4 accs[8], accc[4];
#pragma unroll
        for (int nn = 0; nn < 8; ++nn) accs[nn] = (f32x4){0.f, 0.f, 0.f, 0.f};
#pragma unroll
        for (int nn = 0; nn < 4; ++nn) accc[nn] = (f32x4){0.f, 0.f, 0.f, 0.f};
#pragma unroll
        for (int ks = 0; ks < 2; ++ks) {
            bf16x8 af = *reinterpret_cast<const bf16x8*>(sQ + (wv * 16 + fr) * Q_LD + ks * 32 + fq * 8);
#pragma unroll
            for (int nn = 0; nn < 8; ++nn) {
                bf16x8 bfr = *reinterpret_cast<const bf16x8*>(sK + (nn * 16 + fr) * Q_LD + ks * 32 + fq * 8);
                accs[nn] = __builtin_amdgcn_mfma_f32_16x16x32_bf16(af, bfr, accs[nn], 0, 0, 0);
            }
#pragma unroll
            for (int nn = 0; nn < 4; ++nn) {
                bf16x8 bfr = *reinterpret_cast<const bf16x8*>(sRT + (nn * 16 + fr) * Q_LD + ks * 32 + fq * 8);
                accc[nn] = __builtin_amdgcn_mfma_f32_16x16x32_bf16(af, bfr, accc[nn], 0, 0, 0);
            }
        }
        lds_barrier();
        bf16_t* mS = sS + wv * 16 * KT_LD;
        {
            float e1[4], e1m[4];
#pragma unroll
            for (int j = 0; j < 4; ++j) {
                e1[j] = __expf((float)(fq * 4 + j - fr) * lg);
                e1m[j] = (fq * 4 + j >= fr) ? e1[j] : 0.f;
            }
#pragma unroll
            for (int nn = 0; nn < 8; ++nn) {
                const float e2 = (nn < wv) ? __expf((float)(16 * (wv - nn)) * lg) : 0.f;
                const bool diag = (nn == wv);
                float v[4];
#pragma unroll
                for (int j = 0; j < 4; ++j) v[j] = accs[nn][j] * (diag ? e1m[j] : e2 * e1[j]);
#pragma unroll
                for (int j = 0; j < 4; ++j) mS[(fq * 4 + j) * KT_LD + nn * 16 + fr] = f2bf(v[j]);
            }
        }
        lds_barrier();
        f32x4 acco[4];
#pragma unroll
        for (int nn = 0; nn < 4; ++nn) acco[nn] = (f32x4){0.f, 0.f, 0.f, 0.f};
#pragma unroll
        for (int ks = 0; ks < 4; ++ks) {
            bf16x8 af = *reinterpret_cast<const bf16x8*>(mS + fr * KT_LD + ks * 32 + fq * 8);
#pragma unroll
            for (int nn = 0; nn < 4; ++nn) {
                bf16x8 bfr = *reinterpret_cast<const bf16x8*>(sVT + (nn * 16 + fr) * KT_LD + ks * 32 + fq * 8);
                acco[nn] = __builtin_amdgcn_mfma_f32_16x16x32_bf16(af, bfr, acco[nn], 0, 0, 0);
            }
        }
#pragma unroll
        for (int j = 0; j < 4; ++j) {
            int ig = wv * 16 + fq * 4 + j;
            float xi = __expf((float)(ig + 1) * lg);
            float o[4];
            float sm = 0.f;
#pragma unroll
            for (int nn = 0; nn < 4; ++nn) { o[nn] = acco[nn][j] + xi * accc[nn][j]; sm += o[nn]; }
            sm = row16_sum(sm);
            float mean = sm * (1.0f / 64.0f);
            float sq = 0.f;
#pragma unroll
            for (int nn = 0; nn < 4; ++nn) { float d = o[nn] - mean; sq += d * d; }
            sq = row16_sum(sq);
            float rstd = rsqrtf(sq * (1.0f / 64.0f) + 1e-5f);
            size_t tok = (size_t)b * SEQ + n * 128 + ig;
#pragma unroll
            for (int nn = 0; nn < 4; ++nn) {
                int e = h * 64 + nn * 16 + fr;
                float y = (o[nn] - mean) * rstd * gng[nn] + gnb[nn];
                float gr = bf2f(cur.gr[j * 4 + nn]);
                YC[tok * 1024 + 512 + e] = f2bf(siluf_(gr) * y);
            }
        }
        cur = nxt;
        lds_barrier();
    }
}

#define XB_TMO      128
#define XB_XCNT(j)  (256  + 64 * (j))
#define XB_XSUB(j)  (1280 + 64 * (j))
#define XB_XGEN(j)  (2304 + 64 * (j))
#define XB_TOP      3328
#define XB_TOPGEN   3392
#define XB_SPIN_CAP (1u << 18)

__device__ __forceinline__ unsigned xb_ld(unsigned* p)              { return __hip_atomic_load(p, __ATOMIC_RELAXED, __HIP_MEMORY_SCOPE_AGENT); }
__device__ __forceinline__ unsigned xb_add(unsigned* p, unsigned v) { return __hip_atomic_fetch_add(p, v, __ATOMIC_RELAXED, __HIP_MEMORY_SCOPE_AGENT); }
__device__ __forceinline__ unsigned xb_xcc_id() { return (unsigned)__builtin_amdgcn_s_getreg((3 << 11) | 20) & 0xFu; }
#define XB_SPIN(cond, bar) do { unsigned _sp = 0; while (cond) { __builtin_amdgcn_s_sleep(1); \
    if ((++_sp & 255u) == 0u) { if (xb_ld(&(bar)[XB_TMO])) break; if (_sp > XB_SPIN_CAP) { atomicAdd(&(bar)[XB_TMO], 1u); break; } } } } while (0)

struct XcdBarrier {
    unsigned* bar; unsigned x;
    volatile __attribute__((address_space(3))) unsigned* st;
};

__device__ __forceinline__ XcdBarrier xcd_barrier_post(unsigned* bar, volatile __attribute__((address_space(3))) unsigned* st, int tid) {
    XcdBarrier b; b.bar = bar; b.x = xb_xcc_id(); b.st = st;
    if (tid == 0) (void)xb_add(&bar[XB_XCNT(b.x)], 1u);
    return b;
}
__device__ __forceinline__ void xcd_barrier_complete(unsigned* bar, unsigned x, unsigned& nloc, unsigned& nx) {
    const unsigned G = (unsigned)ogdim();
    unsigned sum, cnt, mine, sp = 0u;
    for (;;) {
        sum = 0u; cnt = 0u; mine = 0u;
#pragma unroll
        for (unsigned j = 0; j < 16; ++j) { const unsigned c = xb_ld(&bar[XB_XCNT(j)]); sum += c; cnt += (c > 0u) ? 1u : 0u; mine = (j == x) ? c : mine; }
        if (sum == G) break;
        __builtin_amdgcn_s_sleep(1);
        if ((++sp & 255u) == 0u) { if (xb_ld(&bar[XB_TMO])) break; if (sp > XB_SPIN_CAP) { atomicAdd(&bar[XB_TMO], 1u); break; } }
    }
    nloc = mine > 0u ? mine : 1u; nx = cnt > 0u ? cnt : 1u;
}

__device__ __forceinline__ void xcd_barrier(const XcdBarrier& b, int tid) {
    asm volatile("s_waitcnt vmcnt(0)" ::: "memory");
    __syncthreads();
    if (tid == 0) {
        unsigned* bar = b.bar;
        __builtin_amdgcn_s_waitcnt(0);
        unsigned nloc = b.st[0], nx = b.st[1];
        if (nloc == 0u) { xcd_barrier_complete(bar, b.x, nloc, nx); b.st[0] = nloc; b.st[1] = nx; }
        const unsigned old = xb_add(&bar[XB_XSUB(b.x)], 1u);
        const unsigned gen = old / nloc;
        if (old + 1u == (gen + 1u) * nloc) {
            __builtin_amdgcn_fence(__ATOMIC_RELEASE, "agent");
            asm volatile("s_waitcnt vmcnt(0)" ::: "memory");
            const unsigned og = xb_add(&bar[XB_TOP], 1u);
            const unsigned tg = og / nx;
            if (og + 1u == (tg + 1u) * nx) xb_add(&bar[XB_TOPGEN], 1u);
            else XB_SPIN(xb_ld(&bar[XB_TOPGEN]) == tg, bar);
            __builtin_amdgcn_fence(__ATOMIC_ACQUIRE, "agent");
            xb_add(&bar[XB_XGEN(b.x)], 1u);
            asm volatile("s_waitcnt vmcnt(0)" ::: "memory");
        } else {
            XB_SPIN(xb_ld(&bar[XB_XGEN(b.x)]) == gen, bar);
            __builtin_amdgcn_fence(__ATOMIC_ACQUIRE, "agent");
            asm volatile("s_waitcnt vmcnt(0)" ::: "memory");
        }
    }
    __syncthreads();
}


#define N_PHASES 21
__device__ __forceinline__ void run_phase(const Params& p, int ph, unsigned char* smem) {
    bf16_t* sm16 = reinterpret_cast<bf16_t*>(smem);
    const bf16_t* W = reinterpret_cast<const bf16_t*>(p.ws + OFF_W);
    bf16_t* ACTB = reinterpret_cast<bf16_t*>(p.ws + OFF_ACTB);
    bf16_t* PB = reinterpret_cast<bf16_t*>(p.ws + OFF_P);
    bf16_t* YC = reinterpret_cast<bf16_t*>(p.ws + OFF_YCAT);
    switch (ph) {
        case 0: phase_pre(p, smem, 0, obid(), ogdim()); break;
        case 1: { PEpiBf16 e{PB, 2304}; big_gemm(ACTB, W + WE_IN0, NT, 2304, DM, e, smem, p.wave); } break;
        case 2: phase_l0_prep(p); break;
        case 3: phase_l0_lora(p, sm16); break;
        case 4: phase_rwkv_r1(p, smem); break;
        case 5: phase_rwkv_r2(p, smem); break;
        case 6: phase_rwkv_r3(p, smem); break;
        case 7: { PEpiOut<false> e{p.in[0], nullptr, PB}; big_gemm(YC, W + WE_OUT0, NT, DM, DM, e, smem, p.wave); } break;
        case 8: phase_ln_route(p, 0, smem); break;
        case 9: phase_exp1(p, 0, sm16); break;
        case 10: phase_exp2(p, 0, sm16); break;
        case 11: phase_ln_ffn(p, 0, p.out, false); break;
        case 12: { PEpiBf16 e{PB, 3072}; big_gemm(ACTB, W + WE_IN1, NT, 3072, DM, e, smem, p.wave); } break;
        case 13: phase_l1_conv(p, smem); __syncthreads(); phase_ret_kv(p, smem); break;
        case 14: phase_ret_scan(p); break;
        case 15: phase_ret_out(p, smem); break;
        case 16: { PEpiOut<true> e{nullptr, ACTB, PB}; big_gemm(YC, W + WE_OUT1, NT, DM, DM, e, smem, p.wave); } break;
        case 17: phase_ln_route(p, 1, smem); break;
        case 18: phase_exp1(p, 1, sm16); break;
        case 19: phase_exp2(p, 1, sm16); break;
        case 20: phase_ln_ffn(p, 1, p.out, true); break;
        default: break;
    }
}

#define SMEM_BYTES 147456
__global__ void __launch_bounds__(NTHREADS) k_mega(Params p) {
    extern __shared__ __attribute__((aligned(16))) unsigned char smem[];
    cg::grid_group grid = cg::this_grid();
    const int wave_s = __builtin_amdgcn_readfirstlane((int)(threadIdx.x >> 6));
    volatile __attribute__((address_space(3))) unsigned* st = (volatile __attribute__((address_space(3))) unsigned*)(smem + 146944);
    {
        const int t0 = otid(wave_s);
        if (t0 < 2) st[t0] = 0u;
    }
    __syncthreads();
    XcdBarrier xb;
#pragma nounroll
    for (int ph = 0; ph < N_PHASES; ++ph) {
        int phv = ph;
        asm volatile("" : "+s"(phv));
        typedef const __attribute__((address_space(4))) Params* KP;
        KP pp = (KP)__builtin_amdgcn_kernarg_segment_ptr();
        asm volatile("" : "+s"(pp));
        Params pl;
        __builtin_memcpy(&pl, (const Params*)pp, sizeof(Params));
        pl.wave = wave_s;
        run_phase(pl, phv, smem);
        if (ph == 0) {
            if (pl.ws == nullptr) grid.sync();
            xb = xcd_barrier_post(reinterpret_cast<unsigned*>(pl.ws + OFF_CTRL + 4096), st, otid(wave_s));
        }
        if (ph < N_PHASES - 1) xcd_barrier(xb, otid(wave_s));
    }
}

extern "C" void kernel_launch(void* const* d_in, const int* in_sizes, int n_in, void* d_out, int out_size, void* d_ws, size_t ws_size,
                              hipStream_t stream) {
    static int grid_blocks = 0;
    if (!grid_blocks) {
        int dev = 0, cus = 0, per_cu = 0;
        hipGetDevice(&dev);
        hipDeviceGetAttribute(&cus, hipDeviceAttributeMultiprocessorCount, dev);
        hipFuncSetAttribute((const void*)k_mega, hipFuncAttributeMaxDynamicSharedMemorySize, SMEM_BYTES);
        hipOccupancyMaxActiveBlocksPerMultiprocessor(&per_cu, (const void*)k_mega, NTHREADS, SMEM_BYTES);
        if (per_cu < 1) per_cu = 1;
        grid_blocks = cus * per_cu;
    }
    Params p{};
    for (int i = 0; i < 35; ++i) p.in[i] = (const float*)d_in[i];
    p.out = (float*)d_out;
    p.ws = (unsigned char*)d_ws;
    hipMemsetAsync((unsigned char*)d_ws + OFF_CTRL, 0, 65536, stream);
    void* args[] = {&p};
    hipError_t e = hipLaunchCooperativeKernel((void*)k_mega, dim3(grid_blocks), dim3(NTHREADS), args, SMEM_BYTES, stream);
    if (e != hipSuccess) fprintf(stderr, "cooperative launch failed: %s (grid %d)\n", hipGetErrorString(e), grid_blocks);
}
```

```cpp
#include <hip/hip_runtime.h>
#include <hip/hip_cooperative_groups.h>
#include <stdint.h>
#include <stdio.h>
namespace cg = cooperative_groups;

typedef unsigned short bf16_t;
typedef short bf16x8 __attribute__((ext_vector_type(8)));
typedef float f32x4 __attribute__((ext_vector_type(4)));

#define NT 32768
#define SEQ 8192
#define DM 1024
#define NTHREADS 512
#define XCD_BAR_WORDS 3456
#define NWAVES 8
#define ALPHA_F 1.41421356237309515f

#define MIB (1024ull * 1024ull)
#define OFF_CTRL 0ull
#define OFF_W (1ull * MIB)
#define OFF_ROPE (65ull * MIB)
#define OFF_ACTB (68ull * MIB)
#define AA_BASE(p) (reinterpret_cast<unsigned char*>((p).out))
#define GG_BASE(p) (reinterpret_cast<unsigned char*>((p).out) + 32ull * MIB)
#define OFF_P (132ull * MIB)
#define OFF_LORA (OFF_P + 144ull * MIB)
#define OFF_POOLED (OFF_P + 160ull * MIB)
#define OFF_FS (OFF_P)
#define OFF_HBUF (OFF_P + 128ull * MIB)
#define OFF_YCAT (324ull * MIB)
#define OFF_LOGW (388ull * MIB)
#define OFF_LTOK (452ull * MIB)
#define OFF_LGATE (456ull * MIB)
#define OFF_KVT (460ull * MIB)
#define WE_IN0 0
#define WE_OUT0 2359296
#define WE_IN1 3407872
#define WE_OUT1 6553600
#define WE_W13 7602176
#define WE_W2 24379392
#define WE_LW2 32768000
#define WE_LA2 32800768
#define WE_LG2 32833536
#define WE_POOL 32899072
#define WE_RT_HI 32964608
#define WE_RT_LO 33062912

struct Params {
    const float* in[35];
    float* out;
    unsigned char* ws;
    int wave;
    int pad_;
};

typedef __bf16 hw_bf16x2 __attribute__((ext_vector_type(2)));
typedef float hw_f32x2 __attribute__((ext_vector_type(2)));
__device__ __forceinline__ unsigned pack2(float a, float b) {
    hw_f32x2 v = {a, b};
    hw_bf16x2 r = __builtin_convertvector(v, hw_bf16x2);
    return __builtin_bit_cast(unsigned, r);
}
__device__ __forceinline__ bf16_t f2bf(float f) { return (bf16_t)(pack2(f, 0.f) & 0xffffu); }
__device__ __forceinline__ float bf2f(bf16_t h) { return __uint_as_float(((unsigned)h) << 16); }
__device__ __forceinline__ void unpack8(const uint4 v, float (&o)[8]) {
    o[0] = __uint_as_float(v.x << 16); o[1] = __uint_as_float(v.x & 0xffff0000u);
    o[2] = __uint_as_float(v.y << 16); o[3] = __uint_as_float(v.y & 0xffff0000u);
    o[4] = __uint_as_float(v.z << 16); o[5] = __uint_as_float(v.z & 0xffff0000u);
    o[6] = __uint_as_float(v.w << 16); o[7] = __uint_as_float(v.w & 0xffff0000u);
}
#define DPP_ADD(v, CTRL) ((v) + __int_as_float(__builtin_amdgcn_update_dpp(0, __float_as_int(v), (CTRL), 0xF, 0xF, false)))
__device__ __forceinline__ float row16_sum(float v) {
    v = DPP_ADD(v, 0xB1);
    v = DPP_ADD(v, 0x4E);
    v = DPP_ADD(v, 0x141);
    v = DPP_ADD(v, 0x140);
    return v;
}
__device__ __forceinline__ float wave_sum(float v) {
    v = row16_sum(v);
    const int iv = __float_as_int(v);
    const float s0 = __int_as_float(__builtin_amdgcn_readlane(iv, 0)), s1 = __int_as_float(__builtin_amdgcn_readlane(iv, 16));
    const float s2 = __int_as_float(__builtin_amdgcn_readlane(iv, 32)), s3 = __int_as_float(__builtin_amdgcn_readlane(iv, 48));
    return (s0 + s1) + (s2 + s3);
}
#define DPP_MOVF(v, CTRL) __int_as_float(__builtin_amdgcn_update_dpp(0, __float_as_int(v), (CTRL), 0xF, 0xF, false))
__device__ __forceinline__ float wave_sum4(const float (&x)[4], int lane) {
    const bool s1 = (lane & 8) != 0, s2 = (lane & 4) != 0;
    const float y0 = (s1 ? x[2] : x[0]) + DPP_MOVF(s1 ? x[0] : x[2], 0x140);
    const float y1 = (s1 ? x[3] : x[1]) + DPP_MOVF(s1 ? x[1] : x[3], 0x140);
    float r = (s2 ? y1 : y0) + DPP_MOVF(s2 ? y0 : y1, 0x141);
    r = DPP_ADD(r, 0x4E);
    r = DPP_ADD(r, 0xB1);
    {
        auto t = __builtin_amdgcn_permlane16_swap(__float_as_uint(r), __float_as_uint(r), false, false);
        r = __uint_as_float(t[0]) + __uint_as_float(t[1]);
    }
    {
        auto t = __builtin_amdgcn_permlane32_swap(__float_as_uint(r), __float_as_uint(r), false, false);
        r = __uint_as_float(t[0]) + __uint_as_float(t[1]);
    }
    return r;
}
__device__ __forceinline__ float wave_sum16(const float (&x)[16], int lane) {
    float y[8], z[4], w[2];
    const bool s1 = (lane & 8) != 0, s2 = (lane & 4) != 0, s3 = (lane & 2) != 0, s4 = (lane & 1) != 0;
#pragma unroll
    for (int p = 0; p < 8; ++p) { const float keep = s1 ? x[8 + p] : x[p], send = s1 ? x[p] : x[8 + p]; y[p] = keep + DPP_MOVF(send, 0x140); }
#pragma unroll
    for (int p = 0; p < 4; ++p) { const float keep = s2 ? y[4 + p] : y[p], send = s2 ? y[p] : y[4 + p]; z[p] = keep + DPP_MOVF(send, 0x141); }
#pragma unroll
    for (int p = 0; p < 2; ++p) { const float keep = s3 ? z[2 + p] : z[p], send = s3 ? z[p] : z[2 + p]; w[p] = keep + DPP_MOVF(send, 0x4E); }
    float r = (s4 ? w[1] : w[0]) + DPP_MOVF(s4 ? w[0] : w[1], 0xB1);
    {
        auto t = __builtin_amdgcn_permlane16_swap(__float_as_uint(r), __float_as_uint(r), false, false);
        r = __uint_as_float(t[0]) + __uint_as_float(t[1]);
    }
    {
        auto t = __builtin_amdgcn_permlane32_swap(__float_as_uint(r), __float_as_uint(r), false, false);
        r = __uint_as_float(t[0]) + __uint_as_float(t[1]);
    }
    return r;
}
__device__ __forceinline__ float frcp(float x) { return __builtin_amdgcn_rcpf(x); }
typedef float nt_f32x4 __attribute__((ext_vector_type(4)));
__device__ __forceinline__ float4 nt_ld4(const float4* p) { const nt_f32x4 t = __builtin_nontemporal_load(reinterpret_cast<const nt_f32x4*>(p)); return make_float4(t.x, t.y, t.z, t.w); }
__device__ __forceinline__ void nt_st4(float4* p, const float4 v) { nt_f32x4 t = {v.x, v.y, v.z, v.w}; __builtin_nontemporal_store(t, reinterpret_cast<nt_f32x4*>(p)); }
__device__ __forceinline__ float sigmoidf_(float x) { return frcp(1.0f + __expf(-x)); }
__device__ __forceinline__ float siluf_(float x) { return x * frcp(1.0f + __expf(-x)); }
__device__ __forceinline__ void lds_barrier() {
    asm volatile("s_waitcnt lgkmcnt(0)" ::: "memory");
    __builtin_amdgcn_s_barrier();
    asm volatile("" ::: "memory");
}
__device__ __forceinline__ int obid() { int b = (int)blockIdx.x; asm volatile("" : "+s"(b)); return b; }
__device__ __forceinline__ int vbid() {
    int b = (int)blockIdx.x, g = (int)gridDim.x;
    int v = ((g & 7) == 0) ? ((b & 7) * (g >> 3) + (b >> 3)) : b;
    asm volatile("" : "+s"(v)); return v;
}
__device__ __forceinline__ int ogdim() { int b = (int)gridDim.x; asm volatile("" : "+s"(b)); return b; }
__device__ __forceinline__ int otid(int wave) { int t = wave * 64 + (int)__builtin_amdgcn_mbcnt_hi(~0u, __builtin_amdgcn_mbcnt_lo(~0u, 0u)); asm volatile("" : "+v"(t)); return t; }
template <bool GATHER, class Epi, int MFR = 4, int NFR = 4, bool BPERM = false>
__device__ __forceinline__ void gemm_tile(const bf16_t* __restrict__ A, int lda, const int* __restrict__ gidx, int gcount,
                                          const bf16_t* __restrict__ Bt, int ldb, int K, int row0, int col0, const Epi& epi,
                                          bf16_t* smem, int wave) {
    const int tidx = otid(wave);
    const int tid = tidx, wid = tid >> 6, lane = tid & 63, wr = wid >> 1, wc = wid & 1, fr = lane & 15, fq = lane >> 4;
    unsigned char* sm = reinterpret_cast<unsigned char*>(smem);
    const bf16_t* ap[MFR];
    const bf16_t* bp[NFR / 2];
#pragma unroll
    for (int i = 0; i < MFR; ++i) {
        const int pch = tid + i * 512;
        const int r = pch >> 3, c = (pch & 7) ^ (r & 7);
        int ar = row0 + r;
        if (GATHER) {
            int gi = ar < gcount ? ar : gcount - 1;
            ar = gidx[gi] >> 1;
        }
        ap[i] = A + (size_t)ar * lda + c * 8;
    }
#pragma unroll
    for (int i = 0; i < NFR / 2; ++i) {
        const int pch = tid + i * 512;
        const int r = pch >> 3, c = (pch & 7) ^ (r & 7);
        const int rp = BPERM ? ((r & ~31) + ((r >> 2) & 3) * 8 + ((r >> 4) & 1) * 4 + (r & 3)) : r;
        bp[i] = Bt + (size_t)(col0 + rp) * ldb + c * 8;
    }
    constexpr int STG = (NFR == 4) ? 49152 : 65536;
    f32x4 acc[MFR][NFR];
#pragma unroll
    for (int m = 0; m < MFR; ++m)
#pragma unroll
        for (int n = 0; n < NFR; ++n) acc[m][n] = (f32x4){0.f, 0.f, 0.f, 0.f};
    const int nk = K >> 6;
#define GT_STAGE(kt, buf) do { _Pragma("unroll") for (int i_ = 0; i_ < MFR; ++i_) \
        __builtin_amdgcn_global_load_lds((const unsigned*)(ap[i_] + (kt) * 64), (__attribute__((address_space(3))) unsigned*)(sm + (buf) * STG + (tid + i_ * 512) * 16), 16, 0, 0); \
        _Pragma("unroll") for (int i_ = 0; i_ < NFR / 2; ++i_) \
        __builtin_amdgcn_global_load_lds((const unsigned*)(bp[i_] + (kt) * 64), (__attribute__((address_space(3))) unsigned*)(sm + (buf) * STG + 32768 + (tid + i_ * 512) * 16), 16, 0, 0); } while (0)
    GT_STAGE(0, 0);
    for (int kt = 0; kt < nk; ++kt) {
        const int buf = kt & 1;
        if (kt + 1 < nk) {
            GT_STAGE(kt + 1, buf ^ 1);
            if (MFR == 4 && NFR == 4) asm volatile("s_waitcnt vmcnt(6)" ::: "memory"); else if (NFR == 8) asm volatile("s_waitcnt vmcnt(8)" ::: "memory"); else asm volatile("s_waitcnt vmcnt(3)" ::: "memory");
        } else {
            asm volatile("s_waitcnt vmcnt(0)" ::: "memory");
        }
        __builtin_amdgcn_s_barrier();
        asm volatile("" ::: "memory");
        const unsigned char* SA = sm + buf * STG;
        const unsigned char* SB = SA + 32768;
#pragma unroll
        for (int ks = 0; ks < 2; ++ks) {
            bf16x8 af[MFR], bfr[NFR];
            const int cs = ((ks * 4 + fq) ^ (fr & 7)) * 16;
#pragma unroll
            for (int m = 0; m < MFR; ++m) af[m] = *reinterpret_cast<const bf16x8*>(SA + (wr * (MFR * 16) + m * 16 + fr) * 128 + cs);
#pragma unroll
            for (int n = 0; n < NFR; ++n) bfr[n] = *reinterpret_cast<const bf16x8*>(SB + (wc * (NFR * 16) + n * 16 + fr) * 128 + cs);
#pragma unroll
            for (int m = 0; m < MFR; ++m)
#pragma unroll
                for (int n = 0; n < NFR; ++n) acc[m][n] = __builtin_amdgcn_mfma_f32_16x16x32_bf16(bfr[n], af[m], acc[m][n], 0, 0, 0);
        }
        asm volatile("s_waitcnt lgkmcnt(0)" ::: "memory");
        __builtin_amdgcn_s_barrier();
        asm volatile("" ::: "memory");
    }
#undef GT_STAGE
    epi(acc, row0 + wr * (MFR * 16), col0 + wc * (NFR * 16), fr, fq);
}

template <class Epi>
__device__ __forceinline__ void gemm_tile_q(const bf16_t* __restrict__ A, int lda, const int* __restrict__ gidx, int gcount,
                                            const bf16_t* __restrict__ Bt, int ldb, int K, int row0, int col0, const Epi& epi,
                                            bf16_t* smem, int wave) {
    const int tidx = otid(wave);
    const int tid = tidx, wid = tid >> 6, lane = tid & 63, wr = wid >> 1, wc = wid & 1, fr = lane & 15, fq = lane >> 4;
    unsigned char* sm = reinterpret_cast<unsigned char*>(smem);
    const bf16_t* ap;
    const bf16_t* bp[2];
    {
        const int r = tid >> 3, c = (tid & 7) ^ (r & 7);
        int ar = row0 + r;
        int gi = ar < gcount ? ar : gcount - 1;
        ar = gidx[gi] >> 1;
        ap = A + (size_t)ar * lda + c * 8;
    }
#pragma unroll
    for (int i = 0; i < 2; ++i) {
        const int pch = tid + i * 512;
        const int r = pch >> 3, c = (pch & 7) ^ (r & 7);
        const int ir = col0 + r;
        const int wrow = ((ir >> 4) & 1) * 128 + ((ir >> 5) << 4) + (ir & 15);
        bp[i] = Bt + (size_t)wrow * ldb + c * 8;
    }
    f32x4 acc[1][4];
#pragma unroll
    for (int n = 0; n < 4; ++n) acc[0][n] = (f32x4){0.f, 0.f, 0.f, 0.f};
    const int nk = K >> 6;
#define GQ_STAGE(kt, buf) do { \
        __builtin_amdgcn_global_load_lds((const unsigned*)(ap + (kt) * 64), (__attribute__((address_space(3))) unsigned*)(sm + (buf) * 24576 + tid * 16), 16, 0, 0); \
        _Pragma("unroll") for (int i_ = 0; i_ < 2; ++i_) \
        __builtin_amdgcn_global_load_lds((const unsigned*)(bp[i_] + (kt) * 64), (__attribute__((address_space(3))) unsigned*)(sm + (buf) * 24576 + 8192 + (tid + i_ * 512) * 16), 16, 0, 0); } while (0)
    GQ_STAGE(0, 0);
    if (nk > 1) GQ_STAGE(1, 1);
    if (nk > 2) GQ_STAGE(2, 2);
    int buf = 0;
    for (int kt = 0; kt < nk; ++kt) {
        if (kt + 2 < nk) asm volatile("s_waitcnt vmcnt(6)" ::: "memory");
        else if (kt + 1 < nk) asm volatile("s_waitcnt vmcnt(3)" ::: "memory");
        else asm volatile("s_waitcnt vmcnt(0)" ::: "memory");
        __builtin_amdgcn_s_barrier();
        asm volatile("" ::: "memory");
        if (kt + 3 < nk) { const int nb = (buf + 3) & 3; GQ_STAGE(kt + 3, nb); }
        const unsigned char* SA = sm + buf * 24576;
        const unsigned char* SB = SA + 8192;
#pragma unroll
        for (int ks = 0; ks < 2; ++ks) {
            bf16x8 af, bfr[4];
            const int cs = ((ks * 4 + fq) ^ (fr & 7)) * 16;
            af = *reinterpret_cast<const bf16x8*>(SA + (wr * 16 + fr) * 128 + cs);
#pragma unroll
            for (int n = 0; n < 4; ++n) bfr[n] = *reinterpret_cast<const bf16x8*>(SB + (wc * 64 + n * 16 + fr) * 128 + cs);
#pragma unroll
            for (int n = 0; n < 4; ++n) acc[0][n] = __builtin_amdgcn_mfma_f32_16x16x32_bf16(bfr[n], af, acc[0][n], 0, 0, 0);
        }
        buf = (buf + 1) & 3;
    }
#undef GQ_STAGE
    asm volatile("s_waitcnt lgkmcnt(0)" ::: "memory");
    __builtin_amdgcn_s_barrier();
    asm volatile("" ::: "memory");
    epi(acc, row0 + wr * 16, col0 + wc * 64, fr, fq);
}

template <int MODE>
struct EpiLora {
    float* Of; bf16_t* Ob; const float* vec; int ldo; int coff;
    __device__ __forceinline__ void operator()(f32x4 (&acc)[4][4], int rb, int cb, int fr, int fq) const {
        float pvv[2][8];
#pragma unroll
        for (int np = 0; np < 2; ++np) {
#pragma unroll
            for (int k = 0; k < 8; ++k) pvv[np][k] = 0.f;
            if (MODE == 0 || MODE == 1) {
                const float4 a = *reinterpret_cast<const float4*>(vec + cb + np * 32 + fq * 8), b = *reinterpret_cast<const float4*>(vec + cb + np * 32 + fq * 8 + 4);
                pvv[np][0] = a.x; pvv[np][1] = a.y; pvv[np][2] = a.z; pvv[np][3] = a.w; pvv[np][4] = b.x; pvv[np][5] = b.y; pvv[np][6] = b.z; pvv[np][7] = b.w;
            }
        }
#pragma unroll
        for (int m = 0; m < 4; ++m)
#pragma unroll
            for (int np = 0; np < 2; ++np) {
                const int row = rb + m * 16 + fr, col = cb + np * 32 + fq * 8;
                float v[8];
#pragma unroll
                for (int k = 0; k < 8; ++k) {
                    const float a = acc[m][2 * np + (k >> 2)][k & 3];
                    if (MODE == 0) {
                        v[k] = -0.60653065971f * sigmoidf_(pvv[np][k] + a);
                    } else if (MODE == 1) {
                        v[k] = sigmoidf_(pvv[np][k] + a);
                    } else {
                        v[k] = a;
                    }
                }
                uint4 w; w.x = pack2(v[0], v[1]); w.y = pack2(v[2], v[3]); w.z = pack2(v[4], v[5]); w.w = pack2(v[6], v[7]);
                *reinterpret_cast<uint4*>(Ob + (size_t)row * ldo + coff + col) = w;
            }
    }
};
struct EpiExp1 {
    bf16_t* H; int base; int cnt;
    template <int MFR, int NFR>
    __device__ __forceinline__ void operator()(f32x4 (&acc)[MFR][NFR], int rb, int cb, int fr, int fq) const {
#pragma unroll
        for (int m = 0; m < MFR; ++m) {
            int li = rb + m * 16 + fr;
            if (li < cnt) {
#pragma unroll
                for (int i = 0; i < NFR / 2; ++i) {
                    int hcol = (cb >> 1) + i * 16 + fq * 4;
                    float v[4];
#pragma unroll
                    for (int j = 0; j < 4; ++j) v[j] = siluf_(acc[m][2 * i][j]) * acc[m][2 * i + 1][j];
                    uint2 w; w.x = pack2(v[0], v[1]); w.y = pack2(v[2], v[3]);
                    *reinterpret_cast<uint2*>(H + (size_t)(base + li) * 128 + hcol) = w;
                }
            }
        }
    }
};
struct EpiExp2 {
    bf16_t* FS; int pk[4]; float g[4]; int cnt;
    __device__ __forceinline__ void operator()(f32x4 (&acc)[4][4], int rb, int cb, int fr, int fq) const {
#pragma unroll
        for (int m = 0; m < 4; ++m) {
            int li = rb + m * 16 + fr;
            if (li < cnt) {
                const float gg = g[m];
                int tok = pk[m] >> 1, j = pk[m] & 1;
                bf16_t* o = FS + ((size_t)j * NT + tok) * DM;
#pragma unroll
                for (int n = 0; n < 4; ++n) {
                    int col = cb + n * 16 + fq * 4;
                    uint2 w; w.x = pack2(acc[m][n][0] * gg, acc[m][n][1] * gg); w.y = pack2(acc[m][n][2] * gg, acc[m][n][3] * gg);
                    *reinterpret_cast<uint2*>(o + col) = w;
                }
            }
        }
    }
};


namespace pg8 {
#define PG8_LAS __attribute__((address_space(3)))
typedef unsigned short bf16_t;
typedef short bf16x8 __attribute__((ext_vector_type(8)));
typedef float f32x4 __attribute__((ext_vector_type(4)));
typedef unsigned u32x4 __attribute__((ext_vector_type(4)));
constexpr int BM = 256, BK = 64, HALF = 128, HTB = HALF * BK * 2  , STAGE_BYTES = 8 * HTB, NXCD = 8, WGM = 8;

__host__ __device__ __forceinline__ int lds_byte(int r, int c) { const int st = (r >> 4) * 2 + (c >> 5), rr = r & 15, cc = c & 31, ob = rr * 64 + cc * 2; return st * 1024 + (ob ^ (((ob >> 9) & 1) << 5)); }
__host__ __device__ __forceinline__ void stage_rc(int b, int& R, int& C) { const int st = b / 1024, sb = b % 1024, swz = sb ^ (((sb >> 9) & 1) << 5); R = (st >> 1) * 16 + swz / 64; C = (st & 1) * 32 + (swz % 64) / 2; }
__host__ __device__ __forceinline__ int perm32(int rho) { const int n = rho >> 4, i = rho & 15; return 8 * (i >> 2) + 4 * n + (i & 3); }

struct Unit { int pm, pn; };
struct Gemm { const bf16_t* A; const bf16_t* Bt; int M, N, K; const int* gidx = nullptr; int gcount = 0, grow0 = 0; };
struct OneUnit { __host__ __device__ bool next(int i, Unit& u) const { if (i != 0) return false; u.pm = 0; u.pn = 0; return true; }
    __device__ __forceinline__ void a_ready(const Unit&) const {} __device__ __forceinline__ void done(const Unit&) const {} };

struct StaticOrder {
    int nM, nN, nwg, G, c;
    __host__ __device__ void init(int M, int N, int G_, int c_) { nM = M / BM; nN = N / BM; nwg = nM * nN; G = G_; c = c_; }
    __host__ __device__ bool next(int i, Unit& u) const {
        const long L = (long)i * G + c; if (L >= nwg) return false;
        int wgid = (int)L; { const int q = nwg / NXCD, r = nwg % NXCD, xcd = wgid % NXCD, off = wgid / NXCD; wgid = (xcd < r ? xcd * (q + 1) : r * (q + 1) + (xcd - r) * q) + off; }
        const int nig = WGM * nN, gid = wgid / nig, fm = gid * WGM, gsz = (nM - fm) < WGM ? (nM - fm) : WGM;
        u.pm = fm + ((wgid % nig) % gsz); u.pn = (wgid % nig) / gsz; return true;
    }
    __device__ __forceinline__ void a_ready(const Unit&) const {}
    __device__ __forceinline__ void done(const Unit&) const {}
};
template <class Epi, class Sched, bool ALIGN_EPI = false, bool SP2 = false, bool GATH = false>
__device__ __forceinline__ void gemm_phase(PG8_LAS unsigned char* lds, const Gemm g, const Sched& S, const Epi& E, int wave) {
    const int tid = otid(wave), wid = __builtin_amdgcn_readfirstlane(tid >> 6), lane = tid & 63, wr = wid >> 2, wc = wid & 3, fr = lane & 15, fq = lane >> 4;
    const int K = g.K, nt = K / BK;
    unsigned voffA[2], voffB[2];
#pragma unroll
    for (int i = 0; i < 2; ++i) { int R, C; stage_rc(tid * 16 + i * 8192, R, C); const int Rb = Epi::PERM ? ((R & ~31) + perm32(R & 31)) : R;
        voffA[i] = (unsigned)(R * K + C) * 2u; voffB[i] = (unsigned)(Rb * K + C) * 2u; }
    unsigned vA0[2], vA1[2];
#pragma unroll
    for (int i = 0; i < 2; ++i) {
        vA0[i] = voffA[i]; vA1[i] = voffA[i];
        if (GATH) {
            int R, C; stage_rc(tid * 16 + i * 8192, R, C);
            int l0 = g.grow0 + R, l1 = g.grow0 + 128 + R;
            l0 = l0 < g.gcount ? l0 : g.gcount - 1; l1 = l1 < g.gcount ? l1 : g.gcount - 1;
            vA0[i] = (unsigned)((g.gidx[l0] >> 1) * K + C) * 2u; vA1[i] = (unsigned)((g.gidx[l1] >> 1) * K + C) * 2u;
        }
    }
    const size_t kstep = (size_t)(BK * 2);
    const size_t hstep = (size_t)HALF * K * 2;
    const size_t hstepA = GATH ? 0 : hstep;
    const unsigned kmask = (unsigned)K * 2u - 1u;
    const unsigned rotb = GATH ? 0u : (((unsigned)blockIdx.x * 10u * (unsigned)kstep) & kmask);
#define PG8_KT(x_) ((size_t)(((unsigned)(x_) * (unsigned)kstep + rotb) & kmask))
    const size_t tstep = 2 * hstep;
    const unsigned ldsw = (unsigned)wid * 1024u;
    const int aoff = lds_byte(wr * 64 + fr, fq * 8), boff = lds_byte(wc * 32 + fr, fq * 8);
#define PG8_SA(b, h) (((b) * 2 + (h)) * HTB)
#define PG8_SB(b, h) ((4 + (b) * 2 + (h)) * HTB)
#define PG8_STAGE(bufoff, gbase, voff) do { _Pragma("unroll") for (int _i = 0; _i < 2; ++_i) \
        __builtin_amdgcn_global_load_lds((const unsigned*)((const char*)(gbase) + (voff)[_i]), (PG8_LAS unsigned*)(lds + (bufoff) + ldsw + _i * 8192), 16, 0, 0); } while (0)
#define PG8_LDA(dst, b, h) do { _Pragma("unroll") for (int m = 0; m < 4; ++m) _Pragma("unroll") for (int k = 0; k < 2; ++k) dst[m][k] = *(const PG8_LAS bf16x8*)(lds + PG8_SA(b, h) + aoff + m * 2048 + k * 1024); } while (0)
#define PG8_LDB(dst, b, h) do { _Pragma("unroll") for (int n = 0; n < 2; ++n) _Pragma("unroll") for (int k = 0; k < 2; ++k) dst[n][k] = *(const PG8_LAS bf16x8*)(lds + PG8_SB(b, h) + boff + n * 2048 + k * 1024); } while (0)
#define PG8_MMA(ai, bj, At, Bt) do { __builtin_amdgcn_s_setprio(1); _Pragma("unroll") for (int m = 0; m < 4; ++m) _Pragma("unroll") for (int n = 0; n < 2; ++n) _Pragma("unroll") for (int k = 0; k < 2; ++k) \
        acc[ai][bj][m][n] = __builtin_amdgcn_mfma_f32_16x16x32_bf16(Bt[n][k], At[m][k], acc[ai][bj][m][n], 0, 0, 0); __builtin_amdgcn_s_setprio(0); } while (0)
#define PG8_WAIT_V(n) asm volatile("s_waitcnt vmcnt(" #n ")" ::: "memory")
#define PG8_WAIT_L(n) asm volatile("s_waitcnt lgkmcnt(" #n ")" ::: "memory")
#define PG8_BAR __builtin_amdgcn_s_barrier()
#define PG8_SCHED __builtin_amdgcn_sched_barrier(0)
    Unit cur, nxt; int ui = 0;
    if (!S.next(0, cur)) return;
    f32x4 acc[2][2][4][2];
#pragma unroll
    for (int a = 0; a < 2; ++a)
#pragma unroll
        for (int b = 0; b < 2; ++b)
#pragma unroll
            for (int m = 0; m < 4; ++m)
#pragma unroll
                for (int n = 0; n < 2; ++n) acc[a][b][m][n] = (f32x4){0.f, 0.f, 0.f, 0.f};
    bf16x8 At[4][2], B0[2][2], B1[2][2];
    const char* cA = (const char*)g.A + (size_t)cur.pm * tstep; const char* cB = (const char*)g.Bt + (size_t)cur.pn * tstep;
    S.a_ready(cur);
    if constexpr (SP2) {
        PG8_STAGE(PG8_SB(0, 0), cB + PG8_KT(0), voffB); PG8_STAGE(PG8_SB(0, 1), cB + hstep + PG8_KT(0), voffB); PG8_STAGE(PG8_SA(0, 0), cA + PG8_KT(0), vA0); PG8_STAGE(PG8_SA(0, 1), cA + hstepA + PG8_KT(0), vA1);
        if (wr == 1) PG8_BAR;
        PG8_WAIT_V(2); PG8_BAR;
        PG8_STAGE(PG8_SB(1, 0), cB + PG8_KT(1), voffB); PG8_STAGE(PG8_SA(1, 0), cA + PG8_KT(1), vA0); PG8_STAGE(PG8_SB(1, 1), cB + hstep + PG8_KT(1), voffB);
        PG8_WAIT_V(6); PG8_BAR;
    } else {
        PG8_STAGE(PG8_SB(0, 0), cB, voffB); PG8_STAGE(PG8_SA(0, 0), cA, vA0); PG8_STAGE(PG8_SB(0, 1), cB + hstep, voffB); PG8_STAGE(PG8_SA(0, 1), cA + hstepA, vA1);
        if (wr == 1) PG8_BAR;
        PG8_WAIT_V(4); PG8_BAR;
        PG8_STAGE(PG8_SB(1, 0), cB + kstep, voffB); PG8_STAGE(PG8_SA(1, 0), cA + kstep, vA0); PG8_STAGE(PG8_SB(1, 1), cB + hstep + kstep, voffB);
        PG8_WAIT_V(6); PG8_BAR;
    }
    for (;;) {
        const bool has_next = S.next(ui + 1, nxt);
        const char* nA = has_next ? (const char*)g.A + (size_t)nxt.pm * tstep : cA; const char* nB = has_next ? (const char*)g.Bt + (size_t)nxt.pn * tstep : cB;
        for (int t = 0; t < nt; t += 2) {
            const bool last = (t == nt - 2);
            const size_t k2 = PG8_KT(t + 2);
            const char* a1 = cA + PG8_KT(t) + kstep;
            const char* a2 = (last ? nA : cA) + k2; const char* b2 = (last ? nB : cB) + k2;
            const char* a3 = a2 + kstep; const char* b3 = b2 + kstep;
            if (last && has_next) S.a_ready(nxt);
            if constexpr (SP2) {
            PG8_LDB(B0, 0, 0); PG8_LDB(B1, 0, 1); PG8_SCHED; PG8_LDA(At, 0, 0); PG8_STAGE(PG8_SA(1, 1), a1 + hstepA, vA1);
            PG8_WAIT_V(8); PG8_WAIT_L(0); PG8_BAR; PG8_MMA(0, 0, At, B0); PG8_MMA(0, 1, At, B1); PG8_BAR; PG8_SCHED;
            PG8_LDA(At, 0, 1); PG8_STAGE(PG8_SB(0, 0), b2, voffB); PG8_STAGE(PG8_SB(0, 1), b2 + hstep, voffB); PG8_STAGE(PG8_SA(0, 0), a2, vA0);
            PG8_WAIT_V(8); PG8_WAIT_L(0); PG8_BAR; PG8_MMA(1, 0, At, B0); PG8_MMA(1, 1, At, B1); PG8_BAR; PG8_SCHED;
            PG8_LDB(B0, 1, 0); PG8_LDB(B1, 1, 1); PG8_SCHED; PG8_LDA(At, 1, 0); PG8_STAGE(PG8_SA(0, 1), a2 + hstepA, vA1);
            PG8_WAIT_V(8); PG8_WAIT_L(0); PG8_BAR; PG8_MMA(0, 0, At, B0); PG8_MMA(0, 1, At, B1); PG8_BAR; PG8_SCHED;
            PG8_LDA(At, 1, 1); PG8_STAGE(PG8_SB(1, 0), b3, voffB); PG8_STAGE(PG8_SB(1, 1), b3 + hstep, voffB); PG8_STAGE(PG8_SA(1, 0), a3, vA0);
            PG8_WAIT_V(8); PG8_WAIT_L(0); PG8_BAR; PG8_MMA(1, 0, At, B0); PG8_MMA(1, 1, At, B1); PG8_BAR; PG8_SCHED;
            } else {
            PG8_LDB(B0, 0, 0); PG8_SCHED; PG8_LDA(At, 0, 0); PG8_STAGE(PG8_SA(1, 1), a1 + hstepA, vA1);
            PG8_WAIT_L(8); PG8_BAR; PG8_WAIT_L(0); PG8_MMA(0, 0, At, B0); PG8_BAR; PG8_SCHED;
            PG8_LDB(B1, 0, 1); PG8_STAGE(PG8_SB(0, 0), b2, voffB);
            PG8_BAR; PG8_WAIT_L(0); PG8_MMA(0, 1, At, B1); PG8_BAR;
            PG8_LDA(At, 0, 1); PG8_STAGE(PG8_SA(0, 0), a2, vA0);
            PG8_BAR; PG8_WAIT_L(0); PG8_MMA(1, 0, At, B0); PG8_BAR; PG8_SCHED;
            PG8_STAGE(PG8_SB(0, 1), b2 + hstep, voffB);
            PG8_WAIT_V(6); PG8_BAR; PG8_MMA(1, 1, At, B1); PG8_BAR;
            PG8_LDB(B0, 1, 0); PG8_SCHED; PG8_LDA(At, 1, 0); PG8_STAGE(PG8_SA(0, 1), a2 + hstepA, vA1);
            PG8_WAIT_L(8); PG8_BAR; PG8_WAIT_L(0); PG8_MMA(0, 0, At, B0); PG8_BAR; PG8_SCHED;
            PG8_LDB(B1, 1, 1); PG8_STAGE(PG8_SB(1, 0), b3, voffB);
            PG8_BAR; PG8_WAIT_L(0); PG8_MMA(0, 1, At, B1); PG8_BAR;
            PG8_LDA(At, 1, 1); PG8_STAGE(PG8_SA(1, 0), a3, vA0);
            PG8_BAR; PG8_WAIT_L(0); PG8_MMA(1, 0, At, B0); PG8_BAR; PG8_SCHED;
            PG8_STAGE(PG8_SB(1, 1), b3 + hstep, voffB);
            PG8_WAIT_V(6); PG8_BAR; PG8_MMA(1, 1, At, B1); PG8_BAR;
            }
        }
        if constexpr (ALIGN_EPI) { if (wr == 0) PG8_BAR; }
        if constexpr (!Epi::AFTER_DRAIN) { E(acc, cur, wr, wc, fr, fq); S.done(cur); }
        if (!has_next) break;
#pragma unroll
        for (int a = 0; a < 2; ++a)
#pragma unroll
            for (int b = 0; b < 2; ++b)
#pragma unroll
                for (int m = 0; m < 4; ++m)
#pragma unroll
                    for (int n = 0; n < 2; ++n) acc[a][b][m][n] = (f32x4){0.f, 0.f, 0.f, 0.f};
        cur = nxt; cA = nA; cB = nB; ++ui;
        if constexpr (ALIGN_EPI) { if (wr == 1) PG8_BAR; }
    }
    PG8_WAIT_V(0);
    if constexpr (!ALIGN_EPI) { if (wr == 0) PG8_BAR; }
    PG8_BAR;
    if constexpr (Epi::AFTER_DRAIN) { E.fused(acc, cur, wr, wc, fr, fq, lds, wid, lane); S.done(cur); }
#undef PG8_KT
#undef PG8_SA
#undef PG8_SB
#undef PG8_STAGE
#undef PG8_LDA
#undef PG8_LDB
#undef PG8_MMA
#undef PG8_WAIT_V
#undef PG8_WAIT_L
#undef PG8_BAR
#undef PG8_SCHED
}
}
struct PEpiBf16 {
    static constexpr bool PERM = true, AFTER_DRAIN = false;
    bf16_t* O; int ldo;
    __device__ __forceinline__ void operator()(const pg8::f32x4 (&acc)[2][2][4][2], const pg8::Unit& u, int wr, int wc, int fr, int fq) const {
        const int row0 = u.pm * 256 + wr * 64 + fr, col0 = u.pn * 256 + wc * 32 + 8 * fq;
#pragma unroll
        for (int ai = 0; ai < 2; ++ai)
#pragma unroll
            for (int m = 0; m < 4; ++m) {
                bf16_t* rowp = O + (size_t)(row0 + ai * 128 + m * 16) * ldo + col0;
#pragma unroll
                for (int bj = 0; bj < 2; ++bj) {
                    const pg8::f32x4 v0 = acc[ai][bj][m][0], v1 = acc[ai][bj][m][1];
                    uint4 w; w.x = pack2(v0[0], v0[1]); w.y = pack2(v0[2], v0[3]); w.z = pack2(v1[0], v1[1]); w.w = pack2(v1[2], v1[3]);
                    *reinterpret_cast<uint4*>(rowp + bj * 128) = w;
                }
            }
    }
};
template <bool PREV_BF16>
struct PEpiOut {
    static constexpr bool PERM = true, AFTER_DRAIN = false;
    const float* Xprev; const bf16_t* XprevB; bf16_t* T;
    __device__ __forceinline__ void operator()(const pg8::f32x4 (&acc)[2][2][4][2], const pg8::Unit& u, int wr, int wc, int fr, int fq) const {
        const int row0 = u.pm * 256 + wr * 64 + fr, col0 = u.pn * 256 + wc * 32 + 8 * fq;
#pragma unroll
        for (int ai = 0; ai < 2; ++ai)
#pragma unroll
            for (int m = 0; m < 4; ++m) {
                const size_t ro = (size_t)(row0 + ai * 128 + m * 16) * DM + col0;
#pragma unroll
                for (int bj = 0; bj < 2; ++bj) {
                    const size_t o = ro + bj * 128;
                    float xp[8];
                    if (PREV_BF16) {
                        unpack8(*reinterpret_cast<const uint4*>(XprevB + o), xp);
                    } else {
                        const float4 a = *reinterpret_cast<const float4*>(Xprev + o), b = *reinterpret_cast<const float4*>(Xprev + o + 4);
                        xp[0] = a.x; xp[1] = a.y; xp[2] = a.z; xp[3] = a.w; xp[4] = b.x; xp[5] = b.y; xp[6] = b.z; xp[7] = b.w;
                    }
                    const pg8::f32x4 v0 = acc[ai][bj][m][0], v1 = acc[ai][bj][m][1];
                    uint4 w;
                    w.x = pack2(ALPHA_F * xp[0] + v0[0], ALPHA_F * xp[1] + v0[1]); w.y = pack2(ALPHA_F * xp[2] + v0[2], ALPHA_F * xp[3] + v0[3]);
                    w.z = pack2(ALPHA_F * xp[4] + v1[0], ALPHA_F * xp[5] + v1[1]); w.w = pack2(ALPHA_F * xp[6] + v1[2], ALPHA_F * xp[7] + v1[3]);
                    *reinterpret_cast<uint4*>(T + o) = w;
                }
            }
    }
};
struct PEpiSwi {
    static constexpr bool PERM = true, AFTER_DRAIN = false;
    bf16_t* H; int base, cnt, row0;
    __device__ __forceinline__ void operator()(const pg8::f32x4 (&acc)[2][2][4][2], const pg8::Unit&, int wr, int wc, int fr, int fq) const {
        const int hc = wc * 32 + 8 * fq;
#pragma unroll
        for (int ai = 0; ai < 2; ++ai)
#pragma unroll
            for (int m = 0; m < 4; ++m) {
                const int li = row0 + wr * 64 + fr + ai * 128 + m * 16;
                if (li < cnt) {
                    const pg8::f32x4 a0 = acc[ai][0][m][0], a1 = acc[ai][0][m][1], b0 = acc[ai][1][m][0], b1 = acc[ai][1][m][1];
                    uint4 w;
                    w.x = pack2(siluf_(a0[0]) * b0[0], siluf_(a0[1]) * b0[1]); w.y = pack2(siluf_(a0[2]) * b0[2], siluf_(a0[3]) * b0[3]);
                    w.z = pack2(siluf_(a1[0]) * b1[0], siluf_(a1[1]) * b1[1]); w.w = pack2(siluf_(a1[2]) * b1[2], siluf_(a1[3]) * b1[3]);
                    *reinterpret_cast<uint4*>(H + (size_t)(base + li) * 128 + hc) = w;
                }
            }
    }
};
struct PEpiIn1 {
    static constexpr bool PERM = true, AFTER_DRAIN = false;
    bf16_t* O; int ldo;
    __device__ __forceinline__ void operator()(const pg8::f32x4 (&acc)[2][2][4][2], const pg8::Unit& u, int wr, int wc, int fr, int fq) const {
        const int row0 = u.pm * 256 + wr * 64 + fr;
        if (u.pn < 4) {
            const int col0 = u.pn * 128 + wc * 32 + 8 * fq;
#pragma unroll
            for (int ai = 0; ai < 2; ++ai)
#pragma unroll
                for (int m = 0; m < 4; ++m) {
                    const pg8::f32x4 a0 = acc[ai][0][m][0], a1 = acc[ai][0][m][1], g0 = acc[ai][1][m][0], g1 = acc[ai][1][m][1];
                    uint4 w;
                    w.x = pack2(a0[0] * sigmoidf_(g0[0]), a0[1] * sigmoidf_(g0[1])); w.y = pack2(a0[2] * sigmoidf_(g0[2]), a0[3] * sigmoidf_(g0[3]));
                    w.z = pack2(a1[0] * sigmoidf_(g1[0]), a1[1] * sigmoidf_(g1[1])); w.w = pack2(a1[2] * sigmoidf_(g1[2]), a1[3] * sigmoidf_(g1[3]));
                    *reinterpret_cast<uint4*>(O + (size_t)(row0 + ai * 128 + m * 16) * ldo + col0) = w;
                }
        } else {
            const int col0 = u.pn * 256 + wc * 32 + 8 * fq;
#pragma unroll
            for (int ai = 0; ai < 2; ++ai)
#pragma unroll
                for (int m = 0; m < 4; ++m) {
                    bf16_t* rowp = O + (size_t)(row0 + ai * 128 + m * 16) * ldo + col0;
#pragma unroll
                    for (int bj = 0; bj < 2; ++bj) {
                        const pg8::f32x4 v0 = acc[ai][bj][m][0], v1 = acc[ai][bj][m][1];
                        uint4 w; w.x = pack2(v0[0], v0[1]); w.y = pack2(v0[2], v0[3]); w.z = pack2(v1[0], v1[1]); w.w = pack2(v1[2], v1[3]);
                        *reinterpret_cast<uint4*>(rowp + bj * 128) = w;
                    }
                }
        }
    }
};
template <class Epi>
__device__ __forceinline__ void big_gemm(const bf16_t* A, const bf16_t* Bt, int M, int N, int K, const Epi& e, unsigned char* smem, int wave) {
    pg8::Gemm g{A, Bt, M, N, K};
    pg8::StaticOrder S;
    S.init(M, N, ogdim(), obid());
    pg8::gemm_phase<Epi, pg8::StaticOrder, true, true>((PG8_LAS unsigned char*)smem, g, S, e, wave);
}

__device__ __forceinline__ void tconv_wave(const float* __restrict__ src, int N, bf16_t* __restrict__ dst, int ldd, int k0, int n0,
                                           int mode, float* tile, int lane) {
#pragma unroll
    for (int i = 0; i < 8; ++i) {
        const int r = i * 8 + (lane >> 3), c4 = (lane & 7) * 4;
        const float4 v = nt_ld4(reinterpret_cast<const float4*>(src + (size_t)(k0 + r) * N + n0 + c4));
        tile[r * 33 + c4] = v.x; tile[r * 33 + c4 + 1] = v.y; tile[r * 33 + c4 + 2] = v.z; tile[r * 33 + c4 + 3] = v.w;
    }
    asm volatile("s_waitcnt lgkmcnt(0)" ::: "memory");
#pragma unroll 8
    for (int nn = 0; nn < 32; ++nn) {
        const int n = n0 + nn;
        int drow = n;
        if (mode == 2) drow = 128 + n;
        else if (mode == 3 && n < 1024) drow = (n < 512) ? ((n >> 7) * 256 + (n & 127)) : (((n - 512) >> 7) * 256 + 128 + ((n - 512) & 127));
        dst[(size_t)drow * ldd + k0 + lane] = f2bf(tile[lane * 33 + nn]);
    }
    asm volatile("s_waitcnt lgkmcnt(0)" ::: "memory");
}

__device__ __forceinline__ void phase_pre(const Params& p, unsigned char* smem, int part, int bid, int nb) {
    const int tidx = otid(p.wave);
    const int wv = tidx >> 6, lane = tidx & 63;
    float* tile = reinterpret_cast<float*>(smem) + wv * (64 * 33);
    bf16_t* W = reinterpret_cast<bf16_t*>(p.ws + OFF_W);
    constexpr int T0 = 896, T1 = 512, T7 = 16, T8 = 16, T9 = 32;
    constexpr int T2 = 1536, T3 = 512, T4 = 4096, T5 = 4096, T6 = 4096;
    if (part == 0) {
        constexpr int TOT = T0 + T1 + T7 + T8 + T9;
        for (int u = bid * NWAVES + wv; u < TOT; u += nb * NWAVES) {
            int v = u;
            const float* src; bf16_t* dst; int K, N, tk, tn;
            if (v < T0) { src = p.in[1]; K = 1024; N = 2304; dst = W + WE_IN0; tk = v / 56; tn = v % 56; }
            else if ((v -= T0) < T1) { src = p.in[15]; K = 1024; N = 1024; dst = W + WE_OUT0; tk = v / 32; tn = v % 32; }
            else if ((v -= T1) < T7) { src = p.in[4]; K = 64; N = 512; dst = W + WE_LW2; tk = 0; tn = v; }
            else if ((v -= T7) < T8) { src = p.in[6]; K = 64; N = 512; dst = W + WE_LA2; tk = 0; tn = v; }
            else { v -= T8; src = p.in[7]; K = 128; N = 512; dst = W + WE_LG2; tk = v >> 4; tn = v & 15; }
            tconv_wave(src, N, dst, K, tk * 64, tn * 32, 0, tile, lane);
        }
        __syncthreads();
        {
            float* sWu = reinterpret_cast<float*>(smem);
            float* sPw = sWu + 16 * 128;
            for (int bt = bid; bt < 256; bt += nb) {
                const int g = bt >> 6, k0 = (bt & 63) * 16;
                {
                    const int r = tidx >> 5, c4 = (tidx & 31) * 4;
                    *reinterpret_cast<float4*>(sWu + r * 128 + c4) = *reinterpret_cast<const float4*>(p.in[1] + (size_t)(k0 + r) * 2304 + 1792 + g * 128 + c4);
                }
                for (int i = tidx; i < 128 * 32; i += NTHREADS) {
                    const int r = i >> 5, c4 = (i & 31) * 4;
                    *reinterpret_cast<float4*>(sPw + r * 128 + c4) = *reinterpret_cast<const float4*>(p.in[13] + (size_t)g * 16384 + r * 128 + c4);
                }
                __syncthreads();
                const int k = tidx >> 5, d0 = (tidx & 31) * 4;
                float acc[4] = {0.f, 0.f, 0.f, 0.f};
#pragma unroll 8
                for (int c = 0; c < 128; ++c) {
                    const float a = sWu[k * 128 + c];
                    const float4 bq = *reinterpret_cast<const float4*>(sPw + c * 128 + d0);
                    acc[0] += a * bq.x; acc[1] += a * bq.y; acc[2] += a * bq.z; acc[3] += a * bq.w;
                }
                bf16_t* dstp = W + WE_IN0 + (size_t)(1792 + g * 128 + d0) * 1024 + k0 + k;
#pragma unroll
                for (int j = 0; j < 4; ++j) dstp[(size_t)j * 1024] = f2bf(acc[j]);
                __syncthreads();
            }
        }
        const float4* x4 = reinterpret_cast<const float4*>(p.in[0]);
        uint2* xb = reinterpret_cast<uint2*>(p.ws + OFF_ACTB);
        const size_t n4 = (size_t)NT * DM / 4;
        const size_t stride = (size_t)nb * NTHREADS;
        for (size_t i = (size_t)bid * NTHREADS + tidx; i < n4; i += 8 * stride) {
            float4 v[8];
#pragma unroll
            for (int j = 0; j < 8; ++j) if (i + j * stride < n4) v[j] = nt_ld4(x4 + i + j * stride);
#pragma unroll
            for (int j = 0; j < 8; ++j) if (i + j * stride < n4) {
                uint2 w; w.x = pack2(v[j].x, v[j].y); w.y = pack2(v[j].z, v[j].w);
                xb[i + j * stride] = w;
            }
        }
    } else {
        constexpr int TOT = T2 + T3 + T4 + T5 + T6;
        for (int u = bid * NWAVES + wv; u < TOT; u += nb * NWAVES) {
            int v = u;
            const float* src; bf16_t* dst; int K, N, mode = 0, tk, tn;
            if (v < T2) { src = p.in[16]; K = 1024; N = 3072; dst = W + WE_IN1; mode = 3; tk = v / 96; tn = v % 96; }
            else if ((v -= T2) < T3) { src = p.in[23]; K = 1024; N = 1024; dst = W + WE_OUT1; tk = v / 32; tn = v % 32; }
            else if ((v -= T3) < T4) { int mat = v >> 6, w = v & 63; src = p.in[30] + (size_t)mat * 131072; K = 1024; N = 128; dst = W + WE_W13 + (size_t)mat * 262144; mode = 1; tk = w >> 2; tn = w & 3; }
            else if ((v -= T4) < T5) { int mat = v >> 6, w = v & 63; src = p.in[31] + (size_t)mat * 131072; K = 1024; N = 128; dst = W + WE_W13 + (size_t)mat * 262144; mode = 2; tk = w >> 2; tn = w & 3; }
            else { v -= T5; int mat = v >> 6, w = v & 63; src = p.in[32] + (size_t)mat * 131072; K = 128; N = 1024; dst = W + WE_W2 + (size_t)mat * 131072; tk = w >> 5; tn = w & 31; }
            tconv_wave(src, N, dst, K, tk * 64, tn * 32, mode, tile, lane);
        }
        {
            bf16_t* RH = W + WE_RT_HI; bf16_t* RL = W + WE_RT_LO;
            for (int i = bid * NTHREADS + tidx; i < 2 * 48 * 1024; i += nb * NTHREADS) {
                const int l = i / (48 * 1024), r = i - l * 48 * 1024, n = r >> 10, k = r & 1023;
                float w = 0.f;
                if (n < 4) w = p.in[26][((size_t)l * 1024 + k) * 4 + n];
                else if (n < 36) w = p.in[28][((size_t)l * 1024 + k) * 32 + (n - 4)];
                const bf16_t h = f2bf(w);
                RH[i] = h; RL[i] = f2bf(w - bf2f(h));
            }
        }
        {
            float2* rope = reinterpret_cast<float2*>(p.ws + OFF_ROPE);
            for (int i = bid * NTHREADS + tidx; i < SEQ * 32; i += nb * NTHREADS) {
                int pos = i >> 5, k = i & 31;
                float inv = powf(10000.0f, -(float)k / 32.0f);
                float ang = (float)pos * inv;
                const double a = (double)ang;
                const double q = rint(a * 0.15915494309189535);
                const float rr = (float)(a - q * 6.283185307179586);
                float s, c;
                sincosf(rr, &s, &c);
                rope[i] = make_float2(c, s);
            }
        }
    }
}

template <int WIN>
__device__ __forceinline__ void pool_item(const bf16_t* src, bf16_t* dst, int s0, const float4 ps0, const float4 ps1) {
    uint4 rows[WIN + 3];
#pragma unroll
    for (int r = 0; r < WIN + 3; ++r) {
        rows[r] = make_uint4(0u, 0u, 0u, 0u);
        if (s0 + 3 - r >= 0) rows[r] = *reinterpret_cast<const uint4*>(src - (size_t)r * 2304);
    }
    float S[8];
    unpack8(rows[3], S);
#pragma unroll
    for (int r = 4; r < WIN + 3; ++r) {
        float t[8];
        unpack8(rows[r], t);
#pragma unroll
        for (int i = 0; i < 8; ++i) S[i] += t[i];
    }
#pragma unroll
    for (int k = 0; k < 4; ++k) {
        float u[8];
        unpack8(rows[3 - k], u);
        if (k > 0) {
            float od[8];
            unpack8(rows[3 - k + WIN], od);
#pragma unroll
            for (int i = 0; i < 8; ++i) S[i] += u[i] - od[i];
        }
        const int cnt = (s0 + k + 1 < WIN) ? (s0 + k + 1) : WIN;
        const float inv = frcp((float)cnt);
        uint4 w;
        w.x = pack2((S[0] * inv - u[0]) * ps0.x, (S[1] * inv - u[1]) * ps0.y); w.y = pack2((S[2] * inv - u[2]) * ps0.z, (S[3] * inv - u[3]) * ps0.w);
        w.z = pack2((S[4] * inv - u[4]) * ps1.x, (S[5] * inv - u[5]) * ps1.y); w.w = pack2((S[6] * inv - u[6]) * ps1.z, (S[7] * inv - u[7]) * ps1.w);
        *reinterpret_cast<uint4*>(dst + (size_t)k * 1024) = w;
    }
}
__device__ __forceinline__ void phase_l0_prep(const Params& p) {
    const int tidx = otid(p.wave);
    const bf16_t* P = reinterpret_cast<const bf16_t*>(p.ws + OFF_P);
    bf16_t* LA = reinterpret_cast<bf16_t*>(p.ws + OFF_LORA);
    bf16_t* YC = reinterpret_cast<bf16_t*>(p.ws + OFF_YCAT);
    const float* mu = p.in[2];
    const int nthr = ogdim() * NTHREADS, t0 = obid() * NTHREADS + tidx;
    {
        const int total = NT * 32;
        for (int it0 = t0; it0 < total; it0 += 4 * nthr) {
            uint4 cu[4], pr[4];
#pragma unroll
            for (int q = 0; q < 4; ++q) {
                const int it = it0 + q * nthr;
                cu[q] = make_uint4(0u, 0u, 0u, 0u); pr[q] = cu[q];
                if (it < total) {
                    const int tok = it >> 5, j = it & 31;
                    const bf16_t* src = P + (size_t)tok * 2304 + 1536 + j * 8;
                    cu[q] = *reinterpret_cast<const uint4*>(src);
                    if ((tok & (SEQ - 1)) > 0) pr[q] = *reinterpret_cast<const uint4*>(src - 2304);
                }
            }
#pragma unroll
            for (int q = 0; q < 4; ++q) {
                const int it = it0 + q * nthr;
                if (it < total) {
                    const int tok = it >> 5, j = it & 31, col = 1536 + j * 8;
                    float cur[8], prv[8];
                    unpack8(cu[q], cur); unpack8(pr[q], prv);
                    const float4 m0 = *reinterpret_cast<const float4*>(mu + col), m1 = *reinterpret_cast<const float4*>(mu + col + 4);
                    const float mm[8] = {m0.x, m0.y, m0.z, m0.w, m1.x, m1.y, m1.z, m1.w};
                    float o[8];
                    const float ks = (j < 8) ? 2.0f : 1.0f;
#pragma unroll
                    for (int i = 0; i < 8; ++i) {
                        const float z = cur[i] + mm[i] * (prv[i] - cur[i]);
                        const float s = sigmoidf_(ks * z);
                        o[i] = (j < 8) ? (2.0f * s - 1.0f) : ((j < 16) ? z : s);
                    }
                    uint4 w; w.x = pack2(o[0], o[1]); w.y = pack2(o[2], o[3]); w.z = pack2(o[4], o[5]); w.w = pack2(o[6], o[7]);
                    *reinterpret_cast<uint4*>(LA + (size_t)tok * 256 + j * 8) = w;
                }
            }
        }
    }
    {
        const int total = (NT / 4) * 64;
        for (int it = t0; it < total; it += nthr) {
            const int lane_ = it & 63, w_ = it >> 6;
            const int gi = w_ & 3, tg = (w_ >> 2) * 4 + (lane_ >> 4);
            const int cc = gi * 128 + (lane_ & 15) * 8;
            const int tok0 = tg * 4, s0 = tok0 & (SEQ - 1);
            const bf16_t* src = P + (size_t)(tok0 + 3) * 2304 + 1792 + cc;
            const float4 ps0 = *reinterpret_cast<const float4*>(p.in[14] + cc), ps1 = *reinterpret_cast<const float4*>(p.in[14] + cc + 4);
            bf16_t* dst = YC + (size_t)tok0 * 1024 + 512 + cc;
            switch (__builtin_amdgcn_readfirstlane(gi)) {
                case 0: pool_item<2>(src, dst, s0, ps0, ps1); break;
                case 1: pool_item<4>(src, dst, s0, ps0, ps1); break;
                case 2: pool_item<8>(src, dst, s0, ps0, ps1); break;
                default: pool_item<16>(src, dst, s0, ps0, ps1); break;
            }
        }
    }
}

__device__ __forceinline__ void phase_l0_lora(const Params& p, bf16_t* smem) {
    const bf16_t* W = reinterpret_cast<const bf16_t*>(p.ws + OFF_W);
    const bf16_t* LA = reinterpret_cast<const bf16_t*>(p.ws + OFF_LORA);
    const bf16_t* PO = reinterpret_cast<const bf16_t*>(p.ws + OFF_POOLED);
    for (int t = vbid(); t < 1536; t += ogdim()) {
        int job = t >> 9, w = t & 511;
        if (job == 0) {
            EpiLora<0> e{nullptr, reinterpret_cast<bf16_t*>(p.ws + OFF_LOGW), p.in[3], 512, 0};
            gemm_tile<false, EpiLora<0>, 4, 4, true>(LA, 256, nullptr, 0, W + WE_LW2, 64, 64, (w >> 2) * 256, (w & 3) * 128, e, smem, p.wave);
        } else if (job == 1) {
            EpiLora<1> e{nullptr, reinterpret_cast<bf16_t*>(AA_BASE(p)), p.in[5], 512, 0};
            gemm_tile<false, EpiLora<1>, 4, 4, true>(LA + 64, 256, nullptr, 0, W + WE_LA2, 64, 64, (w >> 2) * 256, (w & 3) * 128, e, smem, p.wave);
        } else {
            EpiLora<2> e{nullptr, reinterpret_cast<bf16_t*>(GG_BASE(p)), nullptr, 512, 0};
            gemm_tile<false, EpiLora<2>, 4, 4, true>(LA + 128, 256, nullptr, 0, W + WE_LG2, 128, 128, (w >> 2) * 256, (w & 3) * 128, e, smem, p.wave);
        }
    }
}

#define RC_LD 64
#define RC_SW(row, chunk) ((((chunk) ^ ((row) >> 1)) & 7) << 3)
#define RC_BUF (64 * RC_LD)
#define RC_BYTES (RC_BUF * 2)
#define OFF_TBUF OFF_KVT

__device__ __forceinline__ void mm64(f32x4 (&acc)[2], const bf16_t* A, const bf16_t* Bt, int mt, int nt0, int fr, int fq) {
#pragma unroll
    for (int ks = 0; ks < 2; ++ks) {
        const int sc = ((ks * 4 + fq) ^ (fr >> 1)) << 3;
        bf16x8 af = *reinterpret_cast<const bf16x8*>(A + (mt * 16 + fr) * RC_LD + sc);
        bf16x8 bq[2];
#pragma unroll
        for (int n = 0; n < 2; ++n) bq[n] = *reinterpret_cast<const bf16x8*>(Bt + ((nt0 + n) * 16 + fr) * RC_LD + sc);
#pragma unroll
        for (int n = 0; n < 2; ++n) acc[n] = __builtin_amdgcn_mfma_f32_16x16x32_bf16(af, bq[n], acc[n], 0, 0, 0);
    }
}
template <int MASK>
__device__ __forceinline__ void store_T(bf16_t* dst, const f32x4 (&acc)[2], int mt, int nt0, int fr, int fq) {
#pragma unroll
    for (int n = 0; n < 2; ++n) {
        const int C = (nt0 + n) * 16 + fr, R0 = mt * 16 + fq * 4;
        float v[4];
#pragma unroll
        for (int j = 0; j < 4; ++j) {
            const int R = R0 + j;
            bool keep = true;
            if (MASK == 1) keep = R < C;
            else if (MASK == 2) keep = R <= C;
            else if (MASK == 3) keep = C < R;
            v[j] = keep ? acc[n][j] : 0.f;
        }
        uint2 w; w.x = pack2(v[0], v[1]); w.y = pack2(v[2], v[3]);
        *reinterpret_cast<uint2*>(dst + C * RC_LD + RC_SW(fr, R0 >> 3) + (R0 & 7)) = w;
    }
}
__device__ __forceinline__ void store_Q(bf16_t* dst, const f32x4 (&q)[2], int mt, int nt0, int fr, int fq) {
#pragma unroll
    for (int n = 0; n < 2; ++n) {
        const int row = mt * 16 + fr, c0 = (nt0 + n) * 16 + fq * 4;
        uint2 w; w.x = pack2(q[n][0], q[n][1]); w.y = pack2(q[n][2], q[n][3]);
        *reinterpret_cast<uint2*>(dst + row * RC_LD + RC_SW(fr, c0 >> 3) + (c0 & 7)) = w;
    }
}
#define RC_A(buf, ks) (*reinterpret_cast<const bf16x8*>((buf) + offA + sc##ks))
#define RC_B(buf, n, ks) (*reinterpret_cast<const bf16x8*>((buf) + offB + (n) * 16 * RC_LD + sc##ks))
#define MF(a, b, c) __builtin_amdgcn_mfma_f32_16x16x32_bf16(a, b, c, 0, 0, 0)
#define RC_H(buf, off) (*reinterpret_cast<const bf16x8*>((buf) + (off)))
__device__ __forceinline__ void st4(bf16_t* dst, const f32x4 v) {
    uint2 w; w.x = pack2(v[0], v[1]); w.y = pack2(v[2], v[3]);
    *reinterpret_cast<uint2*>(dst) = w;
}
#define Z4 ((f32x4){0.f, 0.f, 0.f, 0.f})
__device__ __forceinline__ void zero_acc(f32x4 (&acc)[2]) {
    acc[0] = (f32x4){0.f, 0.f, 0.f, 0.f};
    acc[1] = (f32x4){0.f, 0.f, 0.f, 0.f};
}

#define OFF_NTB (OFF_P + 144ull * MIB)
#define OFF_S0A (OFF_P + 176ull * MIB)
#define OFF_TB (420ull * MIB)
#define OFF_MB (452ull * MIB)
#define OFF_S0B (484ull * MIB)
#define OFF_WLB (500ull * MIB)
#define OFF_BCB (501ull * MIB)
__device__ __forceinline__ bf16_t* s0_ptr(unsigned char* ws, int u) {
    return reinterpret_cast<bf16_t*>(ws + (u < 2048 ? OFF_S0A : OFF_S0B)) + (size_t)(u & 2047) * 4096;
}

struct PrepIn {
    unsigned short k[8], v[8], r[8], lw[8], a[8];
    unsigned short pk, pv, pr;
};
template <int MODE>
__device__ __forceinline__ void prep_load(PrepIn& in, const Params& p, int u, int tid) {
    const int b = u >> 10, h = (u >> 7) & 7, n = u & 127;
    const unsigned lane = (unsigned)(tid & 63);
    const int q = p.wave;
    const int s0 = n * 64 + q * 8;
    const size_t tok0 = (size_t)b * SEQ + s0;
    const bf16_t* Pr = reinterpret_cast<const bf16_t*>(p.ws + OFF_P) + tok0 * 2304 + h * 64;
    const bf16_t* Lr = reinterpret_cast<const bf16_t*>(p.ws + OFF_LOGW) + tok0 * 512 + h * 64;
    const bf16_t* Ar = reinterpret_cast<const bf16_t*>(AA_BASE(p)) + tok0 * 512 + h * 64;
    in.pk = 0; in.pv = 0; in.pr = 0;
    if (s0 > 0) {
        const bf16_t* pp = Pr - 2304;
        in.pk = pp[512 + lane]; in.pv = pp[1024 + lane];
        in.pr = pp[lane];
    }
#pragma unroll
    for (int i = 0; i < 8; ++i) {
        const bf16_t* pp = Pr + i * 2304;
        in.k[i] = pp[512 + lane]; in.v[i] = pp[1024 + lane];
        in.r[i] = pp[lane];
        in.lw[i] = Lr[i * 512 + lane];
        in.a[i] = Ar[i * 512 + lane];
    }
}
struct PrepC { float mu_k, kkc, kac, mu_v, mu_r, rkc, lng, lnb; };
template <int MODE>
__device__ __forceinline__ PrepC prep_consts(const Params& p, int h, int lane) {
    PrepC c_;
    const int c = h * 64 + lane;
    c_.mu_k = p.in[2][512 + c]; c_.kkc = p.in[8][c]; c_.kac = p.in[9][c]; c_.mu_v = p.in[2][1024 + c];
    c_.mu_r = 0.f; c_.rkc = 0.f; c_.lng = 0.f; c_.lnb = 0.f;
    c_.mu_r = p.in[2][c]; c_.rkc = p.in[10][c];
    if (MODE == 2) { c_.lng = p.in[11][c]; c_.lnb = p.in[12][c]; }
    return c_;
}
template <int MODE>
__device__ __forceinline__ void rwkv_prep(const PrepIn& in, const PrepC& pc, int tid, int q, bf16_t* At, bf16_t* Bt, bf16_t* Kt, bf16_t* Rt,
                                          bf16_t* AtT, bf16_t* BtT, bf16_t* KtT, bf16_t* VT, float* sTot, float* sBC, float* sWL) {
    const int lane = tid & 63;
    const float mu_k = pc.mu_k, kkc = pc.kkc, kac = pc.kac, mu_v = pc.mu_v, mu_r = pc.mu_r, rkc = pc.rkc;
    float lw[8], av[8], zk[8], zr[8], zv[8];
    float pk = bf2f(in.pk), pr = bf2f(in.pr), pv = bf2f(in.pv);
#pragma unroll
    for (int i = 0; i < 8; ++i) {
        const float k0 = bf2f(in.k[i]), v0 = bf2f(in.v[i]);
        zk[i] = k0 + mu_k * (pk - k0); pk = k0;
        zv[i] = v0 + mu_v * (pv - v0); pv = v0;
        { const float r0 = bf2f(in.r[i]); zr[i] = r0 + mu_r * (pr - r0); pr = r0; }
        lw[i] = bf2f(in.lw[i]);
        av[i] = bf2f(in.a[i]);
    }
    float lws[8];
    float cs = 0.f;
#pragma unroll
    for (int i = 0; i < 8; ++i) { cs += lw[i]; lws[i] = cs; }
    sTot[q * 64 + lane] = cs;
    lds_barrier();
    float off = 0.f, tot = 0.f;
#pragma unroll
    for (int qq = 0; qq < 8; ++qq) { float tq = sTot[qq * 64 + lane]; if (qq < q) off += tq; tot += tq; }
    float atv[8], btv[8], ktv[8];
    float e_prev = __expf(off);
    float xr[16];
#pragma unroll
    for (int i = 0; i < 8; ++i) {
        const float kk0 = zk[i] * kkc;
        xr[i] = kk0 * kk0;
        xr[8 + i] = zr[i] * (zk[i] * (1.0f + (av[i] - 1.0f) * kac)) * rkc;
    }
    const float red = wave_sum16(xr, lane);
    const float rsq = rsqrtf(fmaxf(red, 1e-24f));
    if ((lane & 56) == 8) sBC[q * 8 + (lane & 7)] = red;
#pragma unroll
    for (int i = 0; i < 8; ++i) {
        const int t = q * 8 + i;
        const float L = lws[i] + off;
        float kk = zk[i] * kkc;
        kk *= __int_as_float(__builtin_amdgcn_readlane(__float_as_int(rsq), i));
        const float e_neg = __expf(-L), e_pos = __expf(L);
        const float a = av[i];
        const float at = -kk * e_prev;
        const int cs_ = lane ^ (((t >> 1) & 7) << 3);
        At[t * RC_LD + cs_] = f2bf(at);
        const float bt = kk * a * e_neg;
        Bt[t * RC_LD + cs_] = f2bf(bt);
        const float kp = zk[i] * (1.0f + (a - 1.0f) * kac);
        const float kt = kp * e_neg;
        Kt[t * RC_LD + cs_] = f2bf(kt);
        atv[i] = at; btv[i] = bt; ktv[i] = kt;
        {
            Rt[t * RC_LD + cs_] = f2bf(zr[i] * e_pos);
        }
        e_prev = e_pos;
    }
    uint4 w0;
    if (MODE == 1) {
        w0.x = pack2(atv[0], atv[1]); w0.y = pack2(atv[2], atv[3]); w0.z = pack2(atv[4], atv[5]); w0.w = pack2(atv[6], atv[7]);
        *reinterpret_cast<uint4*>(AtT + lane * RC_LD + RC_SW(lane, q)) = w0;
        w0.x = pack2(btv[0], btv[1]); w0.y = pack2(btv[2], btv[3]); w0.z = pack2(btv[4], btv[5]); w0.w = pack2(btv[6], btv[7]);
        *reinterpret_cast<uint4*>(BtT + lane * RC_LD + RC_SW(lane, q)) = w0;
        w0.x = pack2(ktv[0], ktv[1]); w0.y = pack2(ktv[2], ktv[3]); w0.z = pack2(ktv[4], ktv[5]); w0.w = pack2(ktv[6], ktv[7]);
        *reinterpret_cast<uint4*>(KtT + lane * RC_LD + RC_SW(lane, q)) = w0;
        if (q == 0) sWL[lane] = __expf(tot);
    }
    w0.x = pack2(zv[0], zv[1]); w0.y = pack2(zv[2], zv[3]); w0.z = pack2(zv[4], zv[5]); w0.w = pack2(zv[6], zv[7]);
    *reinterpret_cast<uint4*>(VT + lane * RC_LD + RC_SW(lane, q)) = w0;
}

__device__ __forceinline__ void phase_rwkv_r1(const Params& p, unsigned char* smem) {
    const int tidx = otid(p.wave);
    const int tid = tidx, wv = tid >> 6, lane = tid & 63, fr = lane & 15, fq = lane >> 4, mt = wv >> 1, nt0 = (wv & 1) * 2;
    bf16_t* base = reinterpret_cast<bf16_t*>(smem);
    bf16_t* At = base; bf16_t* Bt = base + RC_BUF; bf16_t* Kt = base + 2 * RC_BUF; bf16_t* AtT = base + 3 * RC_BUF;
    bf16_t* BtT = base + 4 * RC_BUF; bf16_t* KtT = base + 5 * RC_BUF; bf16_t* VT = base + 6 * RC_BUF;
    bf16_t* Rb0 = base + 7 * RC_BUF; bf16_t* Cb0 = base + 8 * RC_BUF; bf16_t* Rb1 = base + 9 * RC_BUF; bf16_t* Cb1 = base + 10 * RC_BUF;
    bf16_t* Pm0 = base + 11 * RC_BUF; bf16_t* Pm1 = base + 12 * RC_BUF;
    bf16_t* Rt = base + 13 * RC_BUF; bf16_t* Aak = base + 14 * RC_BUF;
    bf16_t* Tm = Rb0; bf16_t* PT = Rb1; bf16_t* AkVT = Cb1; bf16_t* QT = Pm0; bf16_t* Arb = At; bf16_t* Ark = Bt;
    float* sTot = reinterpret_cast<float*>(smem + 15 * RC_BYTES);
    float* sWL = sTot + 512;
    float* sBC = sWL + 64;
    bf16_t* PRg = reinterpret_cast<bf16_t*>(AA_BASE(p));
    bf16_t* YQg = reinterpret_cast<bf16_t*>(p.ws + OFF_LOGW);
    float* BCg = reinterpret_cast<float*>(p.ws + OFF_BCB);
    bf16_t* Mg = reinterpret_cast<bf16_t*>(p.ws + OFF_MB);
    bf16_t* Ng = reinterpret_cast<bf16_t*>(p.ws + OFF_NTB);
    float* WLg = reinterpret_cast<float*>(p.ws + OFF_WLB);
    const int offA = (mt * 16 + fr) * RC_LD, offB = (nt0 * 16 + fr) * RC_LD;
    const int sc0 = (fq ^ (fr >> 1)) << 3, sc1 = ((4 + fq) ^ (fr >> 1)) << 3;
    const int hh = p.wave >> 2, bMT = 2 * hh + ((p.wave >> 1) & 1), bNT = 2 * hh + (p.wave & 1);
    const int scH = hh ? sc1 : sc0;
    const int oHA = (bMT * 16 + fr) * RC_LD + scH, oHB = (bNT * 16 + fr) * RC_LD + scH;
    const int oSQ = (bMT * 16 + fr) * RC_LD + RC_SW(fr, (bNT * 16 + fq * 4) >> 3) + ((fq * 4) & 7);
    const int oST = (bNT * 16 + fr) * RC_LD + RC_SW(fr, (bMT * 16 + fq * 4) >> 3) + ((fq * 4) & 7);
    const int xm = 2 + ((p.wave >> 1) & 1), xn = p.wave & 1;
    const int oXA1 = (xm * 16 + fr) * RC_LD + sc1, oXB1 = (xn * 16 + fr) * RC_LD + sc1;
    const int oXA0 = (xm * 16 + fr) * RC_LD + sc0, oXB0 = (xn * 16 + fr) * RC_LD + sc0;
    const int oXS = (xm * 16 + fr) * RC_LD + RC_SW(fr, (xn * 16 + fq * 4) >> 3) + ((fq * 4) & 7);
    PrepIn cur, nxt;
    if (obid() < 4096) prep_load<1>(cur, p, obid(), tid);
    nxt = cur;
    for (int u = obid(); u < 4096; u += ogdim()) {
        const int h = (u >> 7) & 7, b = u >> 10, n = u & 127;
        PrepC pc = prep_consts<1>(p, h, lane);
        asm volatile("" : "+v"(pc.mu_k), "+v"(pc.kkc), "+v"(pc.kac), "+v"(pc.mu_v), "+v"(pc.mu_r), "+v"(pc.rkc));
        if (u + ogdim() < 4096) prep_load<1>(nxt, p, u + ogdim(), tid);
        rwkv_prep<1>(cur, pc, tid, p.wave, At, Bt, Kt, Rt, AtT, BtT, KtT, VT, sTot, sBC, sWL);
        lds_barrier();
        f32x4 q[2];
        {
            const bf16x8 a0 = RC_A(At, 0), a1 = RC_A(At, 1);
            const bf16x8 b00 = RC_B(Bt, 0, 0), b01 = RC_B(Bt, 0, 1), b10 = RC_B(Bt, 1, 0), b11 = RC_B(Bt, 1, 1);
            __builtin_amdgcn_sched_barrier(0);
            f32x4 acc[2];
            acc[0] = MF(a0, b00, Z4); acc[1] = MF(a0, b10, Z4); q[0] = MF(b00, a0, Z4); q[1] = MF(b10, a0, Z4);
            acc[0] = MF(a1, b01, acc[0]); acc[1] = MF(a1, b11, acc[1]); q[0] = MF(b01, a1, q[0]); q[1] = MF(b11, a1, q[1]);
            store_T<3>(Cb0, acc, mt, nt0, fr, fq);
#pragma unroll
            for (int nn = 0; nn < 2; ++nn)
#pragma unroll
                for (int j = 0; j < 4; ++j) {
                    const int ti = mt * 16 + fr, ii = (nt0 + nn) * 16 + fq * 4 + j;
                    q[nn][j] = (ii < ti) ? q[nn][j] : 0.f;
                }
            store_Q(Rb0, q, mt, nt0, fr, fq);
#pragma unroll
            for (int nn = 0; nn < 2; ++nn)
#pragma unroll
                for (int j = 0; j < 4; ++j) {
                    const int ti = mt * 16 + fr, ii = (nt0 + nn) * 16 + fq * 4 + j;
                    if (ii == ti) q[nn][j] += 1.0f;
                }
            store_Q(Pm0, q, mt, nt0, fr, fq);
        }
        lds_barrier();
        f32x4 qd, qt;
        {
            const bf16x8 r0 = RC_H(Rb0, oHA), c0 = RC_H(Cb0, oHB);
            const bf16x8 k0 = RC_A(Kt, 0), k1 = RC_A(Kt, 1);
            const bf16x8 a00 = RC_B(At, 0, 0), a01 = RC_B(At, 0, 1), a10 = RC_B(At, 1, 0), a11 = RC_B(At, 1, 1);
            const uint2 pq = *reinterpret_cast<const uint2*>(Pm0 + oSQ);
            const uint2 pt = *reinterpret_cast<const uint2*>(Cb0 + oST);
            __builtin_amdgcn_sched_barrier(0);
            const f32x4 acc = MF(r0, c0, Z4), sw = MF(c0, r0, Z4);
            f32x4 ak[2];
            ak[0] = MF(k0, a00, Z4); ak[1] = MF(k0, a10, Z4);
            ak[0] = MF(k1, a01, ak[0]); ak[1] = MF(k1, a11, ak[1]);
            qd = (f32x4){__uint_as_float(pq.x << 16), __uint_as_float(pq.x & 0xffff0000u), __uint_as_float(pq.y << 16), __uint_as_float(pq.y & 0xffff0000u)};
            qt = (f32x4){__uint_as_float(pt.x << 16), __uint_as_float(pt.x & 0xffff0000u), __uint_as_float(pt.y << 16), __uint_as_float(pt.y & 0xffff0000u)};
#pragma unroll
            for (int j = 0; j < 4; ++j) if (bMT == bNT && fq * 4 + j == fr) qt[j] += 1.0f;
            st4(Cb1 + oST, acc); st4(Rb1 + oSQ, sw);
            store_T<1>(Aak, ak, mt, nt0, fr, fq);
        }
        lds_barrier();
        {
            const bf16x8 r0 = RC_H(Rb1, oHA), c0 = RC_H(Cb1, oHB), p0 = RC_H(Pm0, oHA);
            const bf16x8 x0 = RC_A(Bt, 0), x1 = RC_A(Bt, 1);
            const bf16x8 y00 = RC_B(Rt, 0, 0), y01 = RC_B(Rt, 0, 1), y10 = RC_B(Rt, 1, 0), y11 = RC_B(Rt, 1, 1);
            __builtin_amdgcn_sched_barrier(0);
            const f32x4 acc = MF(r0, c0, Z4), sw = MF(c0, r0, Z4);
            qd = MF(c0, p0, qd); qt = MF(p0, c0, qt);
            f32x4 ar[2];
            ar[0] = MF(x0, y00, Z4); ar[1] = MF(x0, y10, Z4);
            ar[0] = MF(x1, y01, ar[0]); ar[1] = MF(x1, y11, ar[1]);
            st4(Cb0 + oST, acc); st4(Rb0 + oSQ, sw); st4(Pm1 + oSQ, qd);
            store_T<2>(Arb, ar, mt, nt0, fr, fq);
        }
        lds_barrier();
        {
            const bf16x8 r0 = RC_H(Rb0, oHA), c0 = RC_H(Cb0, oHB), p0 = RC_H(Pm1, oHA);
            const bf16x8 x0 = RC_A(Kt, 0), x1 = RC_A(Kt, 1);
            const bf16x8 y00 = RC_B(Rt, 0, 0), y01 = RC_B(Rt, 0, 1), y10 = RC_B(Rt, 1, 0), y11 = RC_B(Rt, 1, 1);
            __builtin_amdgcn_sched_barrier(0);
            const f32x4 acc = MF(r0, c0, Z4), sw = MF(c0, r0, Z4);
            qd = MF(c0, p0, qd); qt = MF(p0, c0, qt);
            f32x4 ar[2];
            ar[0] = MF(x0, y00, Z4); ar[1] = MF(x0, y10, Z4);
            ar[0] = MF(x1, y01, ar[0]); ar[1] = MF(x1, y11, ar[1]);
            st4(Cb1 + oST, acc); st4(Rb1 + oSQ, sw); st4(Pm0 + oSQ, qd);
            store_T<2>(Ark, ar, mt, nt0, fr, fq);
        }
        lds_barrier();
        {
            const bf16x8 r0 = RC_H(Rb1, oHA), c0 = RC_H(Cb1, oHB), p0 = RC_H(Pm0, oHA);
            __builtin_amdgcn_sched_barrier(0);
            const f32x4 acc = MF(r0, c0, Z4);
            qd = MF(c0, p0, qd); qt = MF(p0, c0, qt);
            st4(Cb0 + oST, acc); st4(Pm1 + oSQ, qd);
        }
        lds_barrier();
        {
            const bf16x8 c0 = RC_H(Cb0, oHB), p0 = RC_H(Pm1, oHA);
            __builtin_amdgcn_sched_barrier(0);
            qd = MF(c0, p0, qd); qt = MF(p0, c0, qt);
            st4(Tm + oSQ, qd); st4(Cb1 + oST, qt);
        }
        lds_barrier();
        if (p.wave < 4) {
            const bf16x8 a0 = RC_H(Tm, oXA1), b0 = RC_H(Cb0, oXB1);
            __builtin_amdgcn_sched_barrier(0);
            const f32x4 y = MF(b0, a0, Z4);
            st4(Pm0 + oXS, y);
        }
        lds_barrier();
        if (p.wave < 4) {
            const bf16x8 a0 = RC_H(Pm0, oXA0), b0 = RC_H(Cb1, oXB0);
            __builtin_amdgcn_sched_barrier(0);
            const f32x4 y = MF(b0, a0, Z4);
            st4(Tm + oXS, y);
        }
        lds_barrier();
        bf16x8 t0, t1;
        {
            t0 = RC_A(Tm, 0); t1 = RC_A(Tm, 1);
            const bf16x8 a00 = RC_B(AtT, 0, 0), a01 = RC_B(AtT, 0, 1), a10 = RC_B(AtT, 1, 0), a11 = RC_B(AtT, 1, 1);
            const bf16x8 k0 = RC_A(Aak, 0), k1 = RC_A(Aak, 1);
            const bf16x8 v00 = RC_B(VT, 0, 0), v01 = RC_B(VT, 0, 1), v10 = RC_B(VT, 1, 0), v11 = RC_B(VT, 1, 1);
            __builtin_amdgcn_sched_barrier(0);
            f32x4 acc[2], av[2];
            acc[0] = MF(t0, a00, Z4); acc[1] = MF(t0, a10, Z4); av[0] = MF(k0, v00, Z4); av[1] = MF(k0, v10, Z4);
            acc[0] = MF(t1, a01, acc[0]); acc[1] = MF(t1, a11, acc[1]); av[0] = MF(k1, v01, av[0]); av[1] = MF(k1, v11, av[1]);
            store_T<0>(PT, acc, mt, nt0, fr, fq);
            store_T<0>(AkVT, av, mt, nt0, fr, fq);
        }
        lds_barrier();
        {
            const bf16x8 v00 = RC_B(AkVT, 0, 0), v01 = RC_B(AkVT, 0, 1), v10 = RC_B(AkVT, 1, 0), v11 = RC_B(AkVT, 1, 1);
            const bf16x8 p0 = RC_A(PT, 0), p1 = RC_A(PT, 1);
            const bf16x8 b00 = RC_B(BtT, 0, 0), b01 = RC_B(BtT, 0, 1), b10 = RC_B(BtT, 1, 0), b11 = RC_B(BtT, 1, 1);
            __builtin_amdgcn_sched_barrier(0);
            f32x4 qa[2], acc[2];
            qa[0] = MF(t0, v00, Z4); qa[1] = MF(t0, v10, Z4); acc[0] = MF(p0, b00, Z4); acc[1] = MF(p0, b10, Z4);
            qa[0] = MF(t1, v01, qa[0]); qa[1] = MF(t1, v11, qa[1]); acc[0] = MF(p1, b01, acc[0]); acc[1] = MF(p1, b11, acc[1]);
            store_T<0>(QT, qa, mt, nt0, fr, fq);
            bf16_t* Mo = Mg + (size_t)u * 4096;
#pragma unroll
            for (int nn = 0; nn < 2; ++nn) {
                const int C = (nt0 + nn) * 16 + fr, Rb = mt * 16 + fq * 4;
                const float wl = sWL[C];
                uint2 w; w.x = pack2(acc[nn][0] * wl, acc[nn][1] * wl); w.y = pack2(acc[nn][2] * wl, acc[nn][3] * wl);
                const int pos = (Rb & ~12) | ((Rb & 4) << 1) | ((Rb & 8) >> 1);
                const int posw = ((((pos >> 3) ^ (C & 7)) << 3) | (pos & 7));
                *reinterpret_cast<uint2*>(Mo + C * 64 + posw) = w;
            }
        }
        lds_barrier();
        {
            const size_t tok0 = (size_t)b * SEQ + n * 64;
            {
                const bf16x8 x0 = RC_A(BtT, 0), x1 = RC_A(BtT, 1);
                const bf16x8 y00 = RC_B(QT, 0, 0), y01 = RC_B(QT, 0, 1), y10 = RC_B(QT, 1, 0), y11 = RC_B(QT, 1, 1);
                const bf16x8 k0 = RC_A(KtT, 0), k1 = RC_A(KtT, 1);
                const bf16x8 v00 = RC_B(VT, 0, 0), v01 = RC_B(VT, 0, 1), v10 = RC_B(VT, 1, 0), v11 = RC_B(VT, 1, 1);
                __builtin_amdgcn_sched_barrier(0);
                f32x4 acc[2];
                acc[0] = MF(x0, y00, Z4); acc[1] = MF(x0, y10, Z4);
                acc[0] = MF(x1, y01, acc[0]); acc[1] = MF(x1, y11, acc[1]);
                acc[0] = MF(k0, v00, acc[0]); acc[1] = MF(k0, v10, acc[1]);
                acc[0] = MF(k1, v01, acc[0]); acc[1] = MF(k1, v11, acc[1]);
                bf16_t* No = Ng + (size_t)u * 4096;
                float wl[4];
#pragma unroll
                for (int j = 0; j < 4; ++j) wl[j] = sWL[mt * 16 + fq * 4 + j];
#pragma unroll
                for (int nn = 0; nn < 2; ++nn) {
                    const int C = (nt0 + nn) * 16 + fr, Rb = mt * 16 + fq * 4;
                    uint2 w; w.x = pack2(acc[nn][0] * wl[0], acc[nn][1] * wl[1]); w.y = pack2(acc[nn][2] * wl[2], acc[nn][3] * wl[3]);
                    const int posw = ((((Rb >> 3) ^ (C & 7)) << 3) | (Rb & 7));
                    *reinterpret_cast<uint2*>(No + C * 64 + posw) = w;
                }
                if (tid < 64) { WLg[(size_t)u * 64 + tid] = sWL[tid]; BCg[(size_t)u * 64 + tid] = sBC[tid]; }
            }
            {
                const bf16x8 p0 = RC_A(PT, 0), p1 = RC_A(PT, 1);
                const bf16x8 b00 = RC_B(Arb, 0, 0), b01 = RC_B(Arb, 0, 1), b10 = RC_B(Arb, 1, 0), b11 = RC_B(Arb, 1, 1);
                const bf16x8 q0 = RC_A(QT, 0), q1 = RC_A(QT, 1);
                const bf16x8 v0 = RC_A(VT, 0), v1 = RC_A(VT, 1);
                const bf16x8 k00 = RC_B(Ark, 0, 0), k01 = RC_B(Ark, 0, 1), k10 = RC_B(Ark, 1, 0), k11 = RC_B(Ark, 1, 1);
                uint2 rt[2];
#pragma unroll
                for (int nn = 0; nn < 2; ++nn) rt[nn] = *reinterpret_cast<const uint2*>(Rt + ((nt0 + nn) * 16 + fr) * RC_LD + RC_SW(fr, (mt * 16 + fq * 4) >> 3) + ((fq * 4) & 7));
                __builtin_amdgcn_sched_barrier(0);
                f32x4 pr[2], yq[2];
                pr[0] = MF(p0, b00, Z4); pr[1] = MF(p0, b10, Z4); yq[0] = MF(q0, b00, Z4); yq[1] = MF(q0, b10, Z4);
                pr[0] = MF(p1, b01, pr[0]); pr[1] = MF(p1, b11, pr[1]); yq[0] = MF(q1, b01, yq[0]); yq[1] = MF(q1, b11, yq[1]);
                yq[0] = MF(v0, k00, yq[0]); yq[1] = MF(v0, k10, yq[1]);
                yq[0] = MF(v1, k01, yq[0]); yq[1] = MF(v1, k11, yq[1]);
#pragma unroll
                for (int nn = 0; nn < 2; ++nn) {
                    const int C = (nt0 + nn) * 16 + fr, Rb = mt * 16 + fq * 4;
                    uint2 w;
                    w.x = pack2(pr[nn][0] + __uint_as_float(rt[nn].x << 16), pr[nn][1] + __uint_as_float(rt[nn].x & 0xffff0000u));
                    w.y = pack2(pr[nn][2] + __uint_as_float(rt[nn].y << 16), pr[nn][3] + __uint_as_float(rt[nn].y & 0xffff0000u));
                    *reinterpret_cast<uint2*>(PRg + (tok0 + C) * 512 + h * 64 + Rb) = w;
                    uint2 w2; w2.x = pack2(yq[nn][0], yq[nn][1]); w2.y = pack2(yq[nn][2], yq[nn][3]);
                    *reinterpret_cast<uint2*>(YQg + (tok0 + C) * 512 + h * 64 + Rb) = w2;
                }
            }
        }
        cur = nxt;
        lds_barrier();
    }
}

typedef float f32x16 __attribute__((ext_vector_type(16)));
#define R2_SLOT 12800
__device__ __forceinline__ void r2_issue(const unsigned char* Mg, const unsigned char* Ng, const unsigned char* WLg, size_t u, int J, int lane,
                                         unsigned char* slot) {
#pragma unroll
    for (int i = 0; i < 8; ++i)
        __builtin_amdgcn_global_load_lds((const unsigned*)(Mg + u * 8192 + i * 1024 + lane * 16),
                                         (__attribute__((address_space(3))) unsigned*)(slot + i * 1024), 16, 0, 0);
#pragma unroll
    for (int i = 0; i < 4; ++i)
        __builtin_amdgcn_global_load_lds((const unsigned*)(Ng + u * 8192 + J * 4096 + i * 1024 + lane * 16),
                                         (__attribute__((address_space(3))) unsigned*)(slot + 8192 + i * 1024), 16, 0, 0);
    __builtin_amdgcn_global_load_lds((const unsigned*)(WLg + u * 256 + lane * 4),
                                     (__attribute__((address_space(3))) unsigned*)(slot + 12288), 4, 0, 0);
}
__device__ __forceinline__ unsigned lds_addr(const void* p) { return (unsigned)(size_t)(const __attribute__((address_space(3))) unsigned char*)p; }
template <int OFF> __device__ __forceinline__ void ldsr128(bf16x8& d, unsigned a) { asm volatile("ds_read_b128 %0, %1 offset:%2" : "=v"(d) : "v"(a), "n"(OFF)); }
template <int OFF> __device__ __forceinline__ void ldsr128f(float4& d, unsigned a) { asm volatile("ds_read_b128 %0, %1 offset:%2" : "=v"(d) : "v"(a), "n"(OFF)); }
template <int OFF> __device__ __forceinline__ void ldsr64(uint2& d, unsigned a) { asm volatile("ds_read_b64 %0, %1 offset:%2" : "=v"(d) : "v"(a), "n"(OFF)); }
template <int WAITN>
__device__ __forceinline__ void r2_step(f32x16 (&S)[2], const unsigned char* slot, bf16_t* so, int r, int h) {
    if (WAITN == 51) asm volatile("s_waitcnt vmcnt(51)" ::: "memory");
    else if (WAITN == 39) asm volatile("s_waitcnt vmcnt(39)" ::: "memory");
    else asm volatile("s_waitcnt vmcnt(0)" ::: "memory");
    uint2 nv[2][4]; float4 wl[2][4]; bf16x8 af[2][2][2];
    const unsigned sa = lds_addr(slot);
    {
        const unsigned aw = sa + 12288 + h * 16;
        ldsr128f<0>(wl[0][0], aw); ldsr128f<32>(wl[0][1], aw); ldsr128f<64>(wl[0][2], aw); ldsr128f<96>(wl[0][3], aw);
        ldsr128f<128>(wl[1][0], aw); ldsr128f<160>(wl[1][1], aw); ldsr128f<192>(wl[1][2], aw); ldsr128f<224>(wl[1][3], aw);
        const unsigned an = sa + 8192 + r * 128 + h * 8;
        const unsigned x0 = ((0 ^ (r & 7)) * 16), x1 = ((1 ^ (r & 7)) * 16), x2 = ((2 ^ (r & 7)) * 16), x3 = ((3 ^ (r & 7)) * 16);
        ldsr64<0>(nv[0][0], an + x0); ldsr64<0>(nv[0][1], an + x1); ldsr64<0>(nv[0][2], an + x2); ldsr64<0>(nv[0][3], an + x3);
        ldsr64<0>(nv[1][0], an + (x0 ^ 64)); ldsr64<0>(nv[1][1], an + (x1 ^ 64)); ldsr64<0>(nv[1][2], an + (x2 ^ 64)); ldsr64<0>(nv[1][3], an + (x3 ^ 64));
        const unsigned aa = sa + r * 128;
        const unsigned c00 = (((0 + h) ^ (r & 7)) * 16), c01 = (((2 + h) ^ (r & 7)) * 16), c10 = (((4 + h) ^ (r & 7)) * 16), c11 = (((6 + h) ^ (r & 7)) * 16);
        ldsr128<0>(af[0][0][0], aa + c00); ldsr128<0>(af[0][0][1], aa + c01); ldsr128<0>(af[0][1][0], aa + c10); ldsr128<0>(af[0][1][1], aa + c11);
        ldsr128<4096>(af[1][0][0], aa + c00); ldsr128<4096>(af[1][0][1], aa + c01); ldsr128<4096>(af[1][1][0], aa + c10); ldsr128<4096>(af[1][1][1], aa + c11);
    }
    unsigned pk[2][8];
#pragma unroll
    for (int K = 0; K < 2; ++K)
#pragma unroll
        for (int q = 0; q < 8; ++q) pk[K][q] = pack2(S[K][2 * q], S[K][2 * q + 1]);
#pragma unroll
    for (int I = 0; I < 2; ++I) {
        uint4 w0, w1;
        w0.x = pk[I][0]; w0.y = pk[I][1]; w0.z = pk[I][2]; w0.w = pk[I][3];
        w1.x = pk[I][4]; w1.y = pk[I][5]; w1.z = pk[I][6]; w1.w = pk[I][7];
        *reinterpret_cast<uint4*>(so + r * 64 + I * 32 + h * 16) = w0;
        *reinterpret_cast<uint4*>(so + r * 64 + I * 32 + h * 16 + 8) = w1;
    }
    asm volatile("s_waitcnt lgkmcnt(0)" ::: "memory");
    __builtin_amdgcn_sched_barrier(0);
    bf16x8 bfrag[2][2];
#pragma unroll
    for (int K = 0; K < 2; ++K)
#pragma unroll
        for (int s = 0; s < 2; ++s) {
            union { bf16x8 v; unsigned u[4]; } cvt;
#pragma unroll
            for (int q = 0; q < 4; ++q) cvt.u[q] = pk[K][4 * s + q];
            bfrag[K][s] = cvt.v;
        }
#pragma unroll
    for (int I = 0; I < 2; ++I) {
        f32x16 acc;
#pragma unroll
        for (int g = 0; g < 4; ++g) {
            acc[4 * g + 0] = __uint_as_float(nv[I][g].x << 16) + wl[I][g].x * S[I][4 * g + 0];
            acc[4 * g + 1] = __uint_as_float(nv[I][g].x & 0xffff0000u) + wl[I][g].y * S[I][4 * g + 1];
            acc[4 * g + 2] = __uint_as_float(nv[I][g].y << 16) + wl[I][g].z * S[I][4 * g + 2];
            acc[4 * g + 3] = __uint_as_float(nv[I][g].y & 0xffff0000u) + wl[I][g].w * S[I][4 * g + 3];
        }
#pragma unroll
        for (int K = 0; K < 2; ++K)
#pragma unroll
            for (int s = 0; s < 2; ++s) acc = __builtin_amdgcn_mfma_f32_32x32x16_bf16(af[I][K][s], bfrag[K][s], acc, 0, 0, 0);
        S[I] = acc;
    }
}
__device__ __forceinline__ void phase_rwkv_r2(const Params& p, unsigned char* smem) {
    const int tidx = otid(p.wave);
    if (obid() >= 64) { phase_pre(p, smem, 1, obid() - 64, ogdim() - 64); return; }
    if (p.wave != 0) return;
    const int task = obid(), bh = task >> 1, J = task & 1;
    const int lane = tidx & 63, r = lane & 31, h = lane >> 5;
    const unsigned char* Mg = p.ws + OFF_MB;
    const unsigned char* Ng = p.ws + OFF_NTB;
    const unsigned char* WLg = p.ws + OFF_WLB;
    f32x16 S[2];
#pragma unroll
    for (int i = 0; i < 16; ++i) { S[0][i] = 0.f; S[1][i] = 0.f; }
    const size_t ub = (size_t)bh * 128;
    r2_issue(Mg, Ng, WLg, ub + 0, J, lane, smem + 0 * R2_SLOT);
    r2_issue(Mg, Ng, WLg, ub + 1, J, lane, smem + 1 * R2_SLOT);
    r2_issue(Mg, Ng, WLg, ub + 2, J, lane, smem + 2 * R2_SLOT);
#define R2_STEP(n_, SL, W) do { \
        const int n2 = (n_); \
        if (n2 + 3 < 128) r2_issue(Mg, Ng, WLg, ub + n2 + 3, J, lane, smem + (((SL) + 3) & 3) * R2_SLOT); \
        r2_step<W>(S, smem + (SL) * R2_SLOT, s0_ptr(p.ws, (int)ub + n2) + (size_t)J * 32 * 64, r, h); } while (0)
    R2_STEP(0, 0, 39); R2_STEP(1, 1, 39); R2_STEP(2, 2, 39); R2_STEP(3, 3, 39);
#pragma unroll 1
    for (int n = 4; n < 124; n += 4) {
        R2_STEP(n, 0, 39); R2_STEP(n + 1, 1, 39); R2_STEP(n + 2, 2, 39); R2_STEP(n + 3, 3, 39);
    }
    R2_STEP(124, 0, 39); R2_STEP(125, 1, 0); R2_STEP(126, 2, 0); R2_STEP(127, 3, 0);
#undef R2_STEP
}

struct R3In { uint4 pr, s0; uint2 yq[2]; unsigned short v[8], g[8]; unsigned short pv; float bc[8]; };
__device__ __forceinline__ void r3_load(R3In& in, const Params& p, int u, int tid) {
    const int b = u >> 10, h = (u >> 7) & 7, n = u & 127;
    const int wv = p.wave, lane = tid & 63, fr = lane & 15, fq = lane >> 4, mt = wv >> 1, nt0 = (wv & 1) * 2;
    const size_t tok0 = (size_t)b * SEQ + n * 64;
    const bf16_t* PRg = reinterpret_cast<const bf16_t*>(AA_BASE(p));
    const bf16_t* YQg = reinterpret_cast<const bf16_t*>(p.ws + OFF_LOGW);
    const bf16_t* GG = reinterpret_cast<const bf16_t*>(GG_BASE(p));
    const bf16_t* P = reinterpret_cast<const bf16_t*>(p.ws + OFF_P);
    const float* BCg = reinterpret_cast<const float*>(p.ws + OFF_BCB);
    const int row = tid >> 3, ch = tid & 7;
    in.pr = *reinterpret_cast<const uint4*>(PRg + (tok0 + row) * 512 + h * 64 + ch * 8);
    in.s0 = reinterpret_cast<const uint4*>(s0_ptr(p.ws, u))[tid];
#pragma unroll
    for (int nn = 0; nn < 2; ++nn) in.yq[nn] = *reinterpret_cast<const uint2*>(YQg + (tok0 + (nt0 + nn) * 16 + fr) * 512 + h * 64 + mt * 16 + fq * 4);
    const int c = h * 64 + lane;
    const int s0i = n * 64 + wv * 8;
    in.pv = (s0i > 0) ? P[(tok0 + wv * 8 - 1) * 2304 + 1024 + c] : (unsigned short)0;
#pragma unroll
    for (int i = 0; i < 8; ++i) {
        in.v[i] = P[(tok0 + wv * 8 + i) * 2304 + 1024 + c];
        in.g[i] = GG[(tok0 + wv * 8 + i) * 512 + c];
        in.bc[i] = BCg[(size_t)u * 64 + wv * 8 + i];
    }
}
__device__ __forceinline__ void phase_rwkv_r3(const Params& p, unsigned char* smem) {
    const int tidx = otid(p.wave);
    const int tid = tidx, wv = tid >> 6, lane = tid & 63, fr = lane & 15, fq = lane >> 4, mt = wv >> 1, nt0 = (wv & 1) * 2;
    bf16_t* base = reinterpret_cast<bf16_t*>(smem);
    bf16_t* Prs = base; bf16_t* Sb = base + RC_BUF;
    float* Yf = reinterpret_cast<float*>(smem + 2 * RC_BYTES);
    bf16_t* YC = reinterpret_cast<bf16_t*>(p.ws + OFF_YCAT);
    R3In cur, nxt;
    if (obid() < 4096) r3_load(cur, p, obid(), tid);
    nxt = cur;
    for (int u = obid(); u < 4096; u += ogdim()) {
        const int b = u >> 10, h = (u >> 7) & 7, n = u & 127;
        const int c = h * 64 + lane;
        float mu_v = p.in[2][1024 + c], lng = p.in[11][c], lnb = p.in[12][c];
        asm volatile("" : "+v"(mu_v), "+v"(lng), "+v"(lnb));
        if (u + ogdim() < 4096) r3_load(nxt, p, u + ogdim(), tid);
        {
            const int row = tid >> 3, ch = tid & 7;
            *reinterpret_cast<uint4*>(Prs + row * RC_LD + RC_SW(row, ch)) = cur.pr;
            const int I = ch >> 2, hh = (ch >> 1) & 1, g0 = (ch & 1) * 2;
            const int k0 = I * 32 + 8 * g0 + 4 * hh;
            uint2 lo; lo.x = cur.s0.x; lo.y = cur.s0.y;
            uint2 hi; hi.x = cur.s0.z; hi.y = cur.s0.w;
            *reinterpret_cast<uint2*>(Sb + row * RC_LD + RC_SW(row, k0 >> 3) + (k0 & 7)) = lo;
            *reinterpret_cast<uint2*>(Sb + row * RC_LD + RC_SW(row, (k0 >> 3) + 1) + (k0 & 7)) = hi;
        }
        lds_barrier();
        {
            f32x4 acc[2];
            zero_acc(acc);
            mm64(acc, Sb, Prs, mt, nt0, fr, fq);
#pragma unroll
            for (int nn = 0; nn < 2; ++nn) {
                const int C = (nt0 + nn) * 16 + fr, Rb = mt * 16 + fq * 4;
                const uint2 q = cur.yq[nn];
                float4 o;
                o.x = acc[nn][0] + __uint_as_float(q.x << 16); o.y = acc[nn][1] + __uint_as_float(q.x & 0xffff0000u);
                o.z = acc[nn][2] + __uint_as_float(q.y << 16); o.w = acc[nn][3] + __uint_as_float(q.y & 0xffff0000u);
                *reinterpret_cast<float4*>(Yf + C * 68 + Rb) = o;
            }
        }
        lds_barrier();
        {
            float pv = bf2f(cur.pv);
            float yv[8], xr[16];
#pragma unroll
            for (int i = 0; i < 8; ++i) { yv[i] = Yf[(wv * 8 + i) * 68 + lane]; xr[i] = yv[i]; xr[8 + i] = yv[i] * yv[i]; }
            const float red = wave_sum16(xr, lane);
            const float mvec = red * (1.0f / 64.0f);
            const float qvec = DPP_MOVF(red, 0x128) * (1.0f / 64.0f);
            const float rvec = rsqrtf(fmaxf(qvec - mvec * mvec, 0.f) + 64e-5f);
#pragma unroll
            for (int i = 0; i < 8; ++i) {
                const int t = wv * 8 + i;
                const size_t tok = (size_t)b * SEQ + n * 64 + t;
                const float mean = __int_as_float(__builtin_amdgcn_readlane(__float_as_int(mvec), i));
                const float rstd = __int_as_float(__builtin_amdgcn_readlane(__float_as_int(rvec), i));
                const float yn = (yv[i] - mean) * rstd * lng + lnb;
                const float g = bf2f(cur.g[i]);
                const float v0 = bf2f(cur.v[i]);
                const float vv = bf2f(f2bf(v0 + mu_v * (pv - v0)));
                pv = v0;
                YC[tok * 1024 + c] = f2bf((yn + cur.bc[i] * vv) * g);
            }
        }
        cur = nxt;
    }
}

#define LR_LD 1040
__device__ __forceinline__ void phase_ln_route(const Params& p, int layer, unsigned char* smem) {
    const bf16_t* X = reinterpret_cast<const bf16_t*>(p.ws + OFF_P);
    const int tidx = otid(p.wave);
    const int tid = tidx, wv = tid >> 6, lane = tid & 63, fr = lane & 15, fq = lane >> 4;
    const float* g = p.in[24] + layer * DM;
    const float* bb = p.in[25] + layer * DM;
    const float* rgb = p.in[27] + layer * 4;
    const float* reb = p.in[29] + layer * 32;
    const bf16_t* RH = reinterpret_cast<const bf16_t*>(p.ws + OFF_W) + WE_RT_HI + (size_t)layer * 48 * 1024;
    const bf16_t* RL = reinterpret_cast<const bf16_t*>(p.ws + OFF_W) + WE_RT_LO + (size_t)layer * 48 * 1024;
    bf16_t* XB = reinterpret_cast<bf16_t*>(p.ws + OFF_ACTB);
    int* cnt = reinterpret_cast<int*>(p.ws + OFF_CTRL) + layer * 32;
    int* ltok = reinterpret_cast<int*>(p.ws + OFF_LTOK);
    float* lgate = reinterpret_cast<float*>(p.ws + OFF_LGATE);
    bf16_t* sXH = reinterpret_cast<bf16_t*>(smem);
    bf16_t* sXL = sXH + 16 * LR_LD;
    float* sRed = reinterpret_cast<float*>(smem + 2 * 16 * LR_LD * 2);
    float* sLog = sRed + 8 * 16 * 48;
    bf16x8 bh[4][3], bl[4][3];
#pragma unroll
    for (int ks = 0; ks < 4; ++ks)
#pragma unroll
        for (int nt = 0; nt < 3; ++nt) {
            const int k0 = wv * 128 + ks * 32 + fq * 8;
            bh[ks][nt] = *reinterpret_cast<const bf16x8*>(RH + (size_t)(nt * 16 + fr) * 1024 + k0);
            bl[ks][nt] = *reinterpret_cast<const bf16x8*>(RL + (size_t)(nt * 16 + fr) * 1024 + k0);
        }
    float4 gg[4], bv[4];
#pragma unroll
    for (int i = 0; i < 4; ++i) {
        gg[i] = *reinterpret_cast<const float4*>(g + (i >> 1) * 512 + lane * 8 + (i & 1) * 4);
        bv[i] = *reinterpret_cast<const float4*>(bb + (i >> 1) * 512 + lane * 8 + (i & 1) * 4);
    }
    int* sCnt = reinterpret_cast<int*>(sLog + 16 * 48);
    int* sBase = sCnt + 32;
    int* sDecE = sBase + 32;
    int* sDecP = sDecE + 256;
    float* sDecG = reinterpret_cast<float*>(sDecP + 256);
    int* sDecR = reinterpret_cast<int*>(sDecG + 256);
    if (tid < 32) sCnt[tid] = 0;
    uint2 pre[2][4];
    {
        const int tile0 = obid();
        if (tile0 < NT / 16) {
#pragma unroll
            for (int rr = 0; rr < 2; ++rr)
#pragma unroll
                for (int i = 0; i < 2; ++i) {
                    const uint4 t_ = *reinterpret_cast<const uint4*>(X + (size_t)(tile0 * 16 + wv * 2 + rr) * DM + i * 512 + lane * 8);
                    pre[rr][2 * i] = make_uint2(t_.x, t_.y); pre[rr][2 * i + 1] = make_uint2(t_.z, t_.w);
                }
        }
    }
    __syncthreads();
    int nloc = 0;
    for (int tile = obid(); tile < NT / 16; tile += ogdim(), ++nloc) {
        uint2 cur[2][4];
#pragma unroll
        for (int rr = 0; rr < 2; ++rr)
#pragma unroll
            for (int i = 0; i < 4; ++i) cur[rr][i] = pre[rr][i];
        {
            const int tn = tile + ogdim();
            if (tn < NT / 16) {
#pragma unroll
                for (int rr = 0; rr < 2; ++rr)
#pragma unroll
                    for (int i = 0; i < 2; ++i) {
                        const uint4 t_ = *reinterpret_cast<const uint4*>(X + (size_t)(tn * 16 + wv * 2 + rr) * DM + i * 512 + lane * 8);
                        pre[rr][2 * i] = make_uint2(t_.x, t_.y); pre[rr][2 * i + 1] = make_uint2(t_.z, t_.w);
                    }
            }
        }
        {
            hw_f32x2 v[2][8];
            float st[4];
#pragma unroll
            for (int rr = 0; rr < 2; ++rr) {
#pragma unroll
                for (int i = 0; i < 4; ++i) {
                    const uint2 t = cur[rr][i];
                    v[rr][2 * i] = (hw_f32x2){__uint_as_float(t.x << 16), __uint_as_float(t.x & 0xffff0000u)};
                    v[rr][2 * i + 1] = (hw_f32x2){__uint_as_float(t.y << 16), __uint_as_float(t.y & 0xffff0000u)};
                }
                hw_f32x2 s2 = v[rr][0], q2 = v[rr][0] * v[rr][0];
#pragma unroll
                for (int i = 1; i < 8; ++i) { s2 += v[rr][i]; q2 += v[rr][i] * v[rr][i]; }
                st[2 * rr] = s2.x + s2.y; st[2 * rr + 1] = q2.x + q2.y;
            }
            const float red = wave_sum4(st, lane) * (1.0f / DM);
#pragma unroll
            for (int rr = 0; rr < 2; ++rr) {
                const int rl = wv * 2 + rr;
                const int row = tile * 16 + rl;
                const float mean = __int_as_float(__builtin_amdgcn_readlane(__float_as_int(red), 8 * rr));
                const float msq = __int_as_float(__builtin_amdgcn_readlane(__float_as_int(red), 8 * rr + 4));
                const float rstd = rsqrtf(fmaxf(msq - mean * mean, 0.f) + 1e-5f);
                uint2 whp = make_uint2(0u, 0u), wlp = whp;
#pragma unroll
                for (int i = 0; i < 4; ++i) {
                    const int col = (i >> 1) * 512 + lane * 8 + (i & 1) * 4;
                    const hw_f32x2 g0 = (hw_f32x2){gg[i].x, gg[i].y} * rstd, g1 = (hw_f32x2){gg[i].z, gg[i].w} * rstd;
                    const hw_f32x2 c0 = (hw_f32x2){bv[i].x, bv[i].y} - g0 * mean, c1 = (hw_f32x2){bv[i].z, bv[i].w} - g1 * mean;
                    const hw_f32x2 o0 = v[rr][2 * i] * g0 + c0, o1 = v[rr][2 * i + 1] * g1 + c1;
                    uint2 wh; wh.x = pack2(o0.x, o0.y); wh.y = pack2(o1.x, o1.y);
                    if (i & 1) {
                        *reinterpret_cast<uint4*>(XB + (size_t)row * DM + col - 4) = make_uint4(whp.x, whp.y, wh.x, wh.y);
                        *reinterpret_cast<uint4*>(sXH + rl * LR_LD + col - 4) = make_uint4(whp.x, whp.y, wh.x, wh.y);
                    }
                    const hw_f32x2 h0 = (hw_f32x2){__uint_as_float(wh.x << 16), __uint_as_float(wh.x & 0xffff0000u)};
                    const hw_f32x2 h1 = (hw_f32x2){__uint_as_float(wh.y << 16), __uint_as_float(wh.y & 0xffff0000u)};
                    const hw_f32x2 l0 = o0 - h0, l1 = o1 - h1;
                    uint2 wl; wl.x = pack2(l0.x, l0.y); wl.y = pack2(l1.x, l1.y);
                    if (i & 1) *reinterpret_cast<uint4*>(sXL + rl * LR_LD + col - 4) = make_uint4(wlp.x, wlp.y, wl.x, wl.y);
                    whp = wh; wlp = wl;
                }
            }
        }
        lds_barrier();
        {
            f32x4 acc[3];
#pragma unroll
            for (int nt = 0; nt < 3; ++nt) acc[nt] = (f32x4){0.f, 0.f, 0.f, 0.f};
#pragma unroll
            for (int ks = 0; ks < 4; ++ks) {
                const int k0 = wv * 128 + ks * 32 + fq * 8;
                const bf16x8 ah = *reinterpret_cast<const bf16x8*>(sXH + fr * LR_LD + k0);
                const bf16x8 al = *reinterpret_cast<const bf16x8*>(sXL + fr * LR_LD + k0);
#pragma unroll
                for (int nt = 0; nt < 3; ++nt) {
                    acc[nt] = __builtin_amdgcn_mfma_f32_16x16x32_bf16(ah, bh[ks][nt], acc[nt], 0, 0, 0);
                    acc[nt] = __builtin_amdgcn_mfma_f32_16x16x32_bf16(al, bh[ks][nt], acc[nt], 0, 0, 0);
                    acc[nt] = __builtin_amdgcn_mfma_f32_16x16x32_bf16(ah, bl[ks][nt], acc[nt], 0, 0, 0);
                }
            }
#pragma unroll
            for (int nt = 0; nt < 3; ++nt)
#pragma unroll
                for (int j = 0; j < 4; ++j) sRed[(wv * 16 + fq * 4 + j) * 48 + nt * 16 + fr] = acc[nt][j];
        }
        lds_barrier();
        for (int idx = tid; idx < 16 * 48; idx += NTHREADS) {
            float s = 0.f;
#pragma unroll
            for (int w = 0; w < 8; ++w) s += sRed[w * 16 * 48 + idx];
            sLog[idx] = s;
        }
        lds_barrier();
        if (tid < 16) {
            const int row = tile * 16 + tid;
            const float* lg = sLog + tid * 48;
            float gl[4];
#pragma unroll
            for (int j = 0; j < 4; ++j) gl[j] = lg[j] + rgb[j];
            int gi = 0; float gm = gl[0];
#pragma unroll
            for (int j = 1; j < 4; ++j) if (gl[j] > gm) { gm = gl[j]; gi = j; }
            float gs = 0.f;
#pragma unroll
            for (int j = 0; j < 4; ++j) gs += __expf(gl[j] - gm);
            const float gw = 1.0f / gs;
            float el[8];
#pragma unroll
            for (int j = 0; j < 8; ++j) el[j] = lg[4 + gi * 8 + j] + reb[gi * 8 + j];
            int i1 = 0; float m1 = el[0];
#pragma unroll
            for (int j = 1; j < 8; ++j) if (el[j] > m1) { m1 = el[j]; i1 = j; }
            int i2 = (i1 == 0) ? 1 : 0; float m2 = el[i2];
#pragma unroll
            for (int j = 0; j < 8; ++j) if (j != i1 && el[j] > m2) { m2 = el[j]; i2 = j; }
            const float e2 = __expf(m2 - m1);
            const float p1 = 1.0f / (1.0f + e2), p2 = e2 / (1.0f + e2);
            const int ex1 = gi * 8 + i1, ex2 = gi * 8 + i2;
            const int d0 = (nloc * 16 + tid) * 2;
            sDecE[d0] = ex1; sDecP[d0] = atomicAdd(&sCnt[ex1], 1); sDecG[d0] = gw * p1; sDecR[d0] = row * 2;
            sDecE[d0 + 1] = ex2; sDecP[d0 + 1] = atomicAdd(&sCnt[ex2], 1); sDecG[d0 + 1] = gw * p2; sDecR[d0 + 1] = row * 2 + 1;
        }
    }
    __syncthreads();
    if (tid < 32) sBase[tid] = atomicAdd(&cnt[tid], sCnt[tid]);
    __syncthreads();
    if (tid < nloc * 32) {
        const int ex = sDecE[tid];
        const size_t pos = (size_t)ex * NT + sBase[ex] + sDecP[tid];
        ltok[pos] = sDecR[tid];
        lgate[pos] = sDecG[tid];
    }
    __syncthreads();
}

__device__ __forceinline__ void phase_exp1(const Params& p, int layer, bf16_t* smem) {
    const int* cnt = reinterpret_cast<const int*>(p.ws + OFF_CTRL) + layer * 32;
    const int* ltok = reinterpret_cast<const int*>(p.ws + OFF_LTOK);
    const bf16_t* XB = reinterpret_cast<const bf16_t*>(p.ws + OFF_ACTB);
    const bf16_t* W13 = reinterpret_cast<const bf16_t*>(p.ws + OFF_W) + WE_W13 + (size_t)layer * 32 * 262144;
    bf16_t* H = reinterpret_cast<bf16_t*>(p.ws + OFF_HBUF);
    const int G = ogdim();
    int total_rt = 0;
    for (int e = 0; e < 32; ++e) total_rt += (cnt[e] + 255) >> 8;
    int full_rt = (total_rt / G) * G;
    if (total_rt - full_rt > (G * 5) / 8) full_rt = total_rt;
    {
        int t = vbid();
        int base = 0, tbase = 0;
        for (int e = 0; e < 32; ++e) {
            const int c = cnt[e];
            const int nrt = (c + 255) >> 8;
            while (t < tbase + nrt && t < full_rt) {
                const int w = t - tbase;
                PEpiSwi epi{H, base, c, w * 256};
                pg8::Gemm gm{XB, W13 + (size_t)e * 262144, 256, 256, DM, ltok + (size_t)e * NT, c, w * 256};
                pg8::gemm_phase<PEpiSwi, pg8::OneUnit, true, true, true>((PG8_LAS unsigned char*)smem, gm, pg8::OneUnit{}, epi, p.wave);
                t += G;
            }
            tbase += nrt; base += c;
        }
    }
    if (full_rt < total_rt) {
        int q = full_rt * 8 + vbid();
        int base = 0, tbase = 0;
        for (int e = 0; e < 32; ++e) {
            const int c = cnt[e];
            const int nrt = (c + 255) >> 8;
            while ((q >> 3) < tbase + nrt) {
                const int w = (q >> 3) - tbase;
                const int r0 = w * 256 + (q & 3) * 64;
                if (r0 < c) {
                    EpiExp1 epi{H, base, c};
                    gemm_tile_q(XB, DM, ltok + (size_t)e * NT, c, W13 + (size_t)e * 262144, DM, DM, r0, ((q >> 2) & 1) * 128, epi, smem, p.wave);
                }
                q += G;
            }
            tbase += nrt; base += c;
        }
    }
}
__device__ __forceinline__ void exp2_rowtile(const bf16_t* __restrict__ A, const bf16_t* __restrict__ Bt, bf16_t* __restrict__ FS,
                                             const int* __restrict__ ltok_e, const float* __restrict__ lgate_e, int row0, int cnt,
                                             bf16_t* smem, int wave) {
    const int tidx = otid(wave);
    const int tid = tidx, wid = tid >> 6, lane = tid & 63, wr = wid >> 1, wc = wid & 1, fr = lane & 15, fq = lane >> 4;
    unsigned char* sm = reinterpret_cast<unsigned char*>(smem);
    int pk[4]; float gg[4];
#pragma unroll
    for (int m = 0; m < 4; ++m) {
        int li = row0 + wr * 64 + m * 16 + fr;
        li = li < cnt ? li : cnt - 1;
        pk[m] = ltok_e[li]; gg[m] = lgate_e[li];
    }
#pragma unroll
    for (int i = 0; i < 8; ++i) {
        const int pch = tid + i * 512, kt = pch >> 11, q = pch & 2047;
        const int r = q >> 3, c = (q & 7) ^ (r & 7);
        __builtin_amdgcn_global_load_lds((const unsigned*)(A + (size_t)(row0 + r) * 128 + kt * 64 + c * 8),
                                         (__attribute__((address_space(3))) unsigned*)(sm + pch * 16), 16, 0, 0);
    }
    const bf16_t* bsrc[4];
#pragma unroll
    for (int i = 0; i < 4; ++i) {
        const int pch = tid + i * 512, kt = pch >> 10, q = pch & 1023;
        const int r = q >> 3, c = (q & 7) ^ (r & 7);
        const int rp = (r & ~31) + ((r >> 2) & 3) * 8 + ((r >> 4) & 1) * 4 + (r & 3);
        bsrc[i] = Bt + (size_t)rp * 128 + kt * 64 + c * 8;
    }
#define X2_BLOAD(ct, b) do { _Pragma("unroll") for (int i_ = 0; i_ < 4; ++i_) \
        __builtin_amdgcn_global_load_lds((const unsigned*)(bsrc[i_] + (size_t)(ct) * 128 * 128), \
            (__attribute__((address_space(3))) unsigned*)(sm + 65536 + (b) * 32768 + (tid + i_ * 512) * 16), 16, 0, 0); } while (0)
    const int rot = (row0 >> 8) + (int)(((size_t)Bt >> 18) & 7);
#define X2_CC(c_) (((c_) + rot) & 7)
    X2_BLOAD(X2_CC(0), 0);
    X2_BLOAD(X2_CC(1), 1);
    uint2 pkd[4][4];
#pragma unroll
    for (int m = 0; m < 4; ++m)
#pragma unroll
        for (int n = 0; n < 4; ++n) pkd[m][n] = make_uint2(0u, 0u);
#pragma unroll 1
    for (int ct = 0; ct < 8; ++ct) {
        if (ct < 7) asm volatile("s_waitcnt vmcnt(4)" ::: "memory");
        else asm volatile("s_waitcnt vmcnt(0)" ::: "memory");
        if (ct > 0) {
#pragma unroll
            for (int m = 0; m < 4; ++m) {
                const int li = row0 + wr * 64 + m * 16 + fr;
                if (li < cnt) {
                    bf16_t* o = FS + ((size_t)(pk[m] & 1) * NT + (pk[m] >> 1)) * DM + X2_CC(ct - 1) * 128 + wc * 64 + fq * 8;
#pragma unroll
                    for (int np = 0; np < 2; ++np) *reinterpret_cast<uint4*>(o + np * 32) = make_uint4(pkd[m][2 * np].x, pkd[m][2 * np].y, pkd[m][2 * np + 1].x, pkd[m][2 * np + 1].y);
                }
            }
        }
        __builtin_amdgcn_s_barrier();
        asm volatile("" ::: "memory");
        f32x4 acc[4][4];
#pragma unroll
        for (int m = 0; m < 4; ++m)
#pragma unroll
            for (int n = 0; n < 4; ++n) acc[m][n] = (f32x4){0.f, 0.f, 0.f, 0.f};
        const unsigned char* SBb = sm + 65536 + (ct & 1) * 32768;
#pragma unroll
        for (int kt = 0; kt < 2; ++kt) {
            const unsigned char* SA = sm + kt * 32768;
            const unsigned char* SB = SBb + kt * 16384;
#pragma unroll
            for (int ks = 0; ks < 2; ++ks) {
                bf16x8 af[4], bfr[4];
                const int cs = ((ks * 4 + fq) ^ (fr & 7)) * 16;
#pragma unroll
                for (int m = 0; m < 4; ++m) af[m] = *reinterpret_cast<const bf16x8*>(SA + (wr * 64 + m * 16 + fr) * 128 + cs);
#pragma unroll
                for (int n = 0; n < 4; ++n) bfr[n] = *reinterpret_cast<const bf16x8*>(SB + (wc * 64 + n * 16 + fr) * 128 + cs);
#pragma unroll
                for (int m = 0; m < 4; ++m)
#pragma unroll
                    for (int n = 0; n < 4; ++n) acc[m][n] = __builtin_amdgcn_mfma_f32_16x16x32_bf16(bfr[n], af[m], acc[m][n], 0, 0, 0);
            }
        }
        asm volatile("s_waitcnt lgkmcnt(0)" ::: "memory");
        __builtin_amdgcn_s_barrier();
        asm volatile("" ::: "memory");
        if (ct + 2 < 8) X2_BLOAD(X2_CC(ct + 2), ct & 1);
#pragma unroll
        for (int m = 0; m < 4; ++m)
#pragma unroll
            for (int n = 0; n < 4; ++n) {
                pkd[m][n].x = pack2(acc[m][n][0] * gg[m], acc[m][n][1] * gg[m]);
                pkd[m][n].y = pack2(acc[m][n][2] * gg[m], acc[m][n][3] * gg[m]);
            }
    }
#undef X2_BLOAD
#pragma unroll
    for (int m = 0; m < 4; ++m) {
        const int li = row0 + wr * 64 + m * 16 + fr;
        if (li < cnt) {
            bf16_t* o = FS + ((size_t)(pk[m] & 1) * NT + (pk[m] >> 1)) * DM + X2_CC(7) * 128 + wc * 64 + fq * 8;
#pragma unroll
            for (int np = 0; np < 2; ++np) *reinterpret_cast<uint4*>(o + np * 32) = make_uint4(pkd[m][2 * np].x, pkd[m][2 * np].y, pkd[m][2 * np + 1].x, pkd[m][2 * np + 1].y);
        }
    }
#undef X2_CC
}

__device__ __forceinline__ void phase_exp2(const Params& p, int layer, bf16_t* smem) {
    const int* cnt = reinterpret_cast<const int*>(p.ws + OFF_CTRL) + layer * 32;
    const int* ltok = reinterpret_cast<const int*>(p.ws + OFF_LTOK);
    const float* lgate = reinterpret_cast<const float*>(p.ws + OFF_LGATE);
    const bf16_t* W2 = reinterpret_cast<const bf16_t*>(p.ws + OFF_W) + WE_W2 + (size_t)layer * 32 * 131072;
    const bf16_t* H = reinterpret_cast<const bf16_t*>(p.ws + OFF_HBUF);
    bf16_t* FS = reinterpret_cast<bf16_t*>(p.ws + OFF_FS);
    const int G = ogdim();
    int total_rt = 0;
    for (int e = 0; e < 32; ++e) total_rt += (cnt[e] + 255) >> 8;
    const int full_rt = (total_rt / G) * G;
    {
        int t = vbid();
        int base = 0, tbase = 0;
        for (int e = 0; e < 32; ++e) {
            const int c = cnt[e];
            const int nrt = (c + 255) >> 8;
            while (t < tbase + nrt && t < full_rt) {
                const int w = t - tbase;
                exp2_rowtile(H + (size_t)base * 128, W2 + (size_t)e * 131072, FS, ltok + (size_t)e * NT, lgate + (size_t)e * NT, w * 256, c, smem, p.wave);
                t += G;
            }
            tbase += nrt; base += c;
        }
    }
    if (full_rt < total_rt) {
        int t = full_rt * 8 + vbid();
        int base = 0, tbase = 0;
        for (int e = 0; e < 32; ++e) {
            int c = cnt[e];
            int nt = ((c + 255) >> 8) * 8;
            while (t < tbase + nt) {
                int w = t - tbase;
                EpiExp2 epi;
                epi.FS = FS; epi.cnt = c;
                {
                    const int tq = otid(p.wave), wq = tq >> 6, lq = tq & 63;
#pragma unroll
                    for (int m = 0; m < 4; ++m) {
                        int li = (w >> 3) * 256 + (wq >> 1) * 64 + m * 16 + (lq & 15);
                        li = li < c ? li : c - 1;
                        epi.pk[m] = ltok[(size_t)e * NT + li]; epi.g[m] = lgate[(size_t)e * NT + li];
                    }
                }
                gemm_tile<false>(H + (size_t)base * 128, 128, nullptr, 0, W2 + (size_t)e * 131072, 128, 128, (w >> 3) * 256, (w & 7) * 128, epi, smem, p.wave);
                t += G;
            }
            tbase += nt; base += c;
        }
    }
}

__device__ __forceinline__ void phase_ln_ffn(const Params& p, int layer, float* Xout, bool last) {
    const int tidx = otid(p.wave);
    const int tid = tidx, wv = tid >> 6, lane = tid & 63;
    const float* g = p.in[33] + layer * DM;
    const float* bb = p.in[34] + layer * DM;
    const bf16_t* FS = reinterpret_cast<const bf16_t*>(p.ws + OFF_FS);
    bf16_t* XB = reinterpret_cast<bf16_t*>(p.ws + OFF_ACTB);
    float4 gg[4], bv[4];
#pragma unroll
    for (int i = 0; i < 4; ++i) {
        gg[i] = *reinterpret_cast<const float4*>(g + i * 256 + lane * 4);
        bv[i] = *reinterpret_cast<const float4*>(bb + i * 256 + lane * 4);
    }
    asm volatile("" : "+v"(gg[0].x), "+v"(bv[3].w));
    const int row0 = obid() * NWAVES + wv, rstep = ogdim() * NWAVES;
    uint2 pt[4], pf0[4], pf1[4];
    if (row0 < NT) {
#pragma unroll
        for (int i = 0; i < 4; ++i) {
            const int col = i * 256 + lane * 4;
            pt[i] = *reinterpret_cast<const uint2*>(XB + (size_t)row0 * DM + col);
            pf0[i] = *reinterpret_cast<const uint2*>(FS + (size_t)row0 * DM + col);
            pf1[i] = *reinterpret_cast<const uint2*>(FS + ((size_t)NT + row0) * DM + col);
        }
    }
    for (int row = row0; row < NT; row += rstep) {
        uint2 t[4], f0[4], f1[4];
#pragma unroll
        for (int i = 0; i < 4; ++i) { t[i] = pt[i]; f0[i] = pf0[i]; f1[i] = pf1[i]; }
        if (row + rstep < NT) {
            const size_t rn = (size_t)(row + rstep);
#pragma unroll
            for (int i = 0; i < 4; ++i) {
                const int col = i * 256 + lane * 4;
                pt[i] = *reinterpret_cast<const uint2*>(XB + rn * DM + col);
                pf0[i] = *reinterpret_cast<const uint2*>(FS + rn * DM + col);
                pf1[i] = *reinterpret_cast<const uint2*>(FS + ((size_t)NT + rn) * DM + col);
            }
        }
        float v[16];
#pragma unroll
        for (int i = 0; i < 4; ++i) {
            v[4 * i] = ALPHA_F * __uint_as_float(t[i].x << 16) + __uint_as_float(f0[i].x << 16) + __uint_as_float(f1[i].x << 16);
            v[4 * i + 1] = ALPHA_F * __uint_as_float(t[i].x & 0xffff0000u) + __uint_as_float(f0[i].x & 0xffff0000u) + __uint_as_float(f1[i].x & 0xffff0000u);
            v[4 * i + 2] = ALPHA_F * __uint_as_float(t[i].y << 16) + __uint_as_float(f0[i].y << 16) + __uint_as_float(f1[i].y << 16);
            v[4 * i + 3] = ALPHA_F * __uint_as_float(t[i].y & 0xffff0000u) + __uint_as_float(f0[i].y & 0xffff0000u) + __uint_as_float(f1[i].y & 0xffff0000u);
        }
        float sum = 0.f;
#pragma unroll
        for (int i = 0; i < 16; ++i) sum += v[i];
        float mean = wave_sum(sum) * (1.0f / DM);
        float sq = 0.f;
#pragma unroll
        for (int i = 0; i < 16; ++i) { float d = v[i] - mean; sq += d * d; }
        float rstd = rsqrtf(wave_sum(sq) * (1.0f / DM) + 1e-5f);
#pragma unroll
        for (int i = 0; i < 4; ++i) {
            int col = i * 256 + lane * 4;
            float o0 = (v[4 * i] - mean) * rstd * gg[i].x + bv[i].x;
            float o1 = (v[4 * i + 1] - mean) * rstd * gg[i].y + bv[i].y;
            float o2 = (v[4 * i + 2] - mean) * rstd * gg[i].z + bv[i].z;
            float o3 = (v[4 * i + 3] - mean) * rstd * gg[i].w + bv[i].w;
            if (last) {
                nt_st4(reinterpret_cast<float4*>(Xout + (size_t)row * DM + col), make_float4(o0, o1, o2, o3));
            } else {
                uint2 w; w.x = pack2(o0, o1); w.y = pack2(o2, o3);
                *reinterpret_cast<uint2*>(XB + (size_t)row * DM + col) = w;
            }
        }
    }
}

#define CV_T 64
#define CV_ROWS (CV_T + 30)
template <int OB>
__device__ __forceinline__ void conv_blk(float (&acc)[CV_T], const bf16_t* sU, int tid, const float (&w0)[31]) {
#pragma unroll
    for (int rr = 0; rr < 38; ++rr) {
        const float uv = bf2f(sU[(OB * 8 + rr) * 512 + tid]);
#pragma unroll
        for (int oo = 0; oo < 8; ++oo) {
            const int j = rr - oo;
            if (j >= 0 && j <= 30) acc[OB * 8 + oo] += uv * w0[j];
        }
    }
}
__device__ __forceinline__ void phase_l1_conv(const Params& p, unsigned char* smem) {
    const int tidx = otid(p.wave);
    const bf16_t* P = reinterpret_cast<const bf16_t*>(p.ws + OFF_P);
    bf16_t* YC = reinterpret_cast<bf16_t*>(p.ws + OFF_YCAT);
    bf16_t* sU = reinterpret_cast<bf16_t*>(smem);
    float* red = reinterpret_cast<float*>(smem + CV_ROWS * 512 * 2);
    float* stat = red + 8 * 64 * 2;
    const int tid = tidx, wv = tid >> 6, lane = tid & 63;
    const float* cw = p.in[17];
    float w0[31];
#pragma unroll
    for (int j = 0; j < 31; ++j) w0[j] = cw[j * 512 + tid];
    const float cb0 = p.in[18][tid], g0 = p.in[19][tid], b0 = p.in[20][tid];
    for (int u = obid(); u < NT / CV_T; u += ogdim()) {
        const int t0 = u * CV_T;
        const int s0 = t0 & (SEQ - 1);
#pragma unroll 1
        for (int base = 0; base < CV_ROWS * 64; base += 6 * NTHREADS) {
            uint4 av[6], gv[6];
#pragma unroll
            for (int j = 0; j < 6; ++j) {
                const int it = base + j * NTHREADS + tid;
                const int r = it >> 6, c8 = (it & 63) * 8;
                av[j] = make_uint4(0u, 0u, 0u, 0u); gv[j] = av[j];
                if (it < CV_ROWS * 64 && s0 - 30 + r >= 0) {
                    const bf16_t* pr = P + (size_t)(t0 - 30 + r) * 3072 + c8;
                    av[j] = *reinterpret_cast<const uint4*>(pr);
                }
            }
#pragma unroll
            for (int j = 0; j < 6; ++j) {
                const int it = base + j * NTHREADS + tid;
                if (it < CV_ROWS * 64) {
                    const int r = it >> 6, c8 = (it & 63) * 8;
                    *reinterpret_cast<uint4*>(sU + r * 512 + c8) = av[j];
                }
            }
        }
        __syncthreads();
        float acc[CV_T];
#pragma unroll
        for (int o = 0; o < CV_T; ++o) acc[o] = cb0;
        conv_blk<0>(acc, sU, tid, w0); conv_blk<1>(acc, sU, tid, w0); conv_blk<2>(acc, sU, tid, w0); conv_blk<3>(acc, sU, tid, w0);
        conv_blk<4>(acc, sU, tid, w0); conv_blk<5>(acc, sU, tid, w0); conv_blk<6>(acc, sU, tid, w0); conv_blk<7>(acc, sU, tid, w0);
#pragma unroll
        for (int o0 = 0; o0 < CV_T; o0 += 8) {
            float xr[16];
#pragma unroll
            for (int j = 0; j < 8; ++j) { xr[j] = acc[o0 + j]; xr[8 + j] = acc[o0 + j] * acc[o0 + j]; }
            const float r = wave_sum16(xr, lane);
            if (lane < 16) red[(wv * 64 + o0 + (lane & 7)) * 2 + (lane >> 3)] = r;
        }
        __syncthreads();
        if (tid < 64) {
            float s1 = 0.f, s2 = 0.f;
#pragma unroll
            for (int w = 0; w < 8; ++w) { s1 += red[(w * 64 + tid) * 2]; s2 += red[(w * 64 + tid) * 2 + 1]; }
            const float mean = s1 * (1.0f / 512.0f);
            const float var = fmaxf(s2 * (1.0f / 512.0f) - mean * mean, 0.f);
            stat[tid * 2] = mean; stat[tid * 2 + 1] = rsqrtf(var + 1e-5f);
        }
        __syncthreads();
#pragma unroll
        for (int o = 0; o < CV_T; ++o) {
            const float mean = stat[o * 2], rstd = stat[o * 2 + 1];
            const float y0 = (acc[o] - mean) * rstd * g0 + b0;
            YC[(size_t)(t0 + o) * 1024 + tid] = f2bf(siluf_(y0));
        }
    }
}

__device__ __forceinline__ float ret_lg(int h) { return log1pf(-exp2f(-5.0f - (float)h)); }

#define KT_LD 144
struct RetIn { uint4 k1, k2, v1, v2; };
__device__ __forceinline__ void ret_load_kv(RetIn& in, const bf16_t* P, int u, int tid) {
    const int n = u & 63, h = (u >> 6) & 7, b = u >> 9;
    const int c = tid >> 2, i0 = (tid & 3) * 8;
    const size_t tok = (size_t)b * SEQ + n * 128 + c;
    const bf16_t* kr = P + tok * 3072 + 1536 + h * 64;
    const bf16_t* vr = P + tok * 3072 + 2048 + h * 64;
    in.k1 = *reinterpret_cast<const uint4*>(kr + i0); in.k2 = *reinterpret_cast<const uint4*>(kr + 32 + i0);
    in.v1 = *reinterpret_cast<const uint4*>(vr + i0); in.v2 = *reinterpret_cast<const uint4*>(vr + 32 + i0);
}
__device__ __forceinline__ void st_col8(bf16_t* dst, int ld, const uint4 v) {
    dst[0 * ld] = (bf16_t)(v.x & 0xffffu); dst[1 * ld] = (bf16_t)(v.x >> 16);
    dst[2 * ld] = (bf16_t)(v.y & 0xffffu); dst[3 * ld] = (bf16_t)(v.y >> 16);
    dst[4 * ld] = (bf16_t)(v.z & 0xffffu); dst[5 * ld] = (bf16_t)(v.z >> 16);
    dst[6 * ld] = (bf16_t)(v.w & 0xffffu); dst[7 * ld] = (bf16_t)(v.w >> 16);
}
#define KVT_GROUPS (2048ull * 4096ull)
__device__ __forceinline__ void phase_ret_kv(const Params& p, unsigned char* smem) {
    const int tidx = otid(p.wave);
    const bf16_t* P = reinterpret_cast<const bf16_t*>(p.ws + OFF_P);
    const float2* rope = reinterpret_cast<const float2*>(p.ws + OFF_ROPE);
    bf16_t* KVT = reinterpret_cast<bf16_t*>(p.ws + OFF_KVT);
    bf16_t* sKT = reinterpret_cast<bf16_t*>(smem);
    bf16_t* sVT = sKT + 64 * KT_LD;
    const int tid = tidx, wv = tid >> 6, lane = tid & 63, fr = lane & 15, fq = lane >> 4;
    const int et = wv >> 1, dt0 = (wv & 1) * 2;
    RetIn cur, nxt;
    if (obid() < 256) ret_load_kv(cur, P, (obid() >> 3) * 64 + (obid() & 7) * 8, tid);
    nxt = cur;
    for (int U = obid(); U < 256; U += ogdim()) {
        const int bh = U >> 3, g = U & 7, h = bh & 7;
        const float lg = ret_lg(h);
        const float gc = __expf(128.0f * lg);
        f32x4 run[2];
        run[0] = (f32x4){0.f, 0.f, 0.f, 0.f}; run[1] = (f32x4){0.f, 0.f, 0.f, 0.f};
#pragma unroll 1
        for (int j = 0; j < 8; ++j) {
            const int n = g * 8 + j, u = bh * 64 + n;
            const int c = tid >> 2, i0 = (tid & 3) * 8;
            const int sidx = n * 128 + c;
            float2 cs[8];
#pragma unroll
            for (int i = 0; i < 8; ++i) cs[i] = rope[sidx * 32 + i0 + i];
            asm volatile("" : "+v"(cs[0].x), "+v"(cs[7].y));
            if (j < 7) ret_load_kv(nxt, P, u + 1, tid);
            else if (U + ogdim() < 256) { const int U2 = U + ogdim(); ret_load_kv(nxt, P, (U2 >> 3) * 64 + (U2 & 7) * 8, tid); }
            {
                const float zeta = __expf((float)(127 - c) * lg) * 0.125f;
                float k1[8], k2[8];
                unpack8(cur.k1, k1); unpack8(cur.k2, k2);
#pragma unroll
                for (int i = 0; i < 8; ++i) {
                    float o1 = (k1[i] * cs[i].x - k2[i] * cs[i].y) * zeta, o2 = (k1[i] * cs[i].y + k2[i] * cs[i].x) * zeta;
                    sKT[(i0 + i) * KT_LD + c] = f2bf(o1);
                    sKT[(32 + i0 + i) * KT_LD + c] = f2bf(o2);
                }
                st_col8(sVT + i0 * KT_LD + c, KT_LD, cur.v1);
                st_col8(sVT + (32 + i0) * KT_LD + c, KT_LD, cur.v2);
            }
            lds_barrier();
            f32x4 acc[2];
            acc[0] = (f32x4){0.f, 0.f, 0.f, 0.f}; acc[1] = (f32x4){0.f, 0.f, 0.f, 0.f};
#pragma unroll
            for (int ks = 0; ks < 4; ++ks) {
                bf16x8 af = *reinterpret_cast<const bf16x8*>(sVT + (et * 16 + fr) * KT_LD + ks * 32 + fq * 8);
#pragma unroll
                for (int nn = 0; nn < 2; ++nn) {
                    bf16x8 bfr = *reinterpret_cast<const bf16x8*>(sKT + ((dt0 + nn) * 16 + fr) * KT_LD + ks * 32 + fq * 8);
                    acc[nn] = __builtin_amdgcn_mfma_f32_16x16x32_bf16(bfr, af, acc[nn], 0, 0, 0);
                }
            }
            bf16_t* o = KVT + (size_t)u * 4096;
#pragma unroll
            for (int nn = 0; nn < 2; ++nn) {
                uint2 w; w.x = pack2(run[nn][0], run[nn][1]); w.y = pack2(run[nn][2], run[nn][3]);
                *reinterpret_cast<uint2*>(o + (et * 16 + fr) * 64 + (dt0 + nn) * 16 + fq * 4) = w;
#pragma unroll
                for (int jj = 0; jj < 4; ++jj) run[nn][jj] = gc * run[nn][jj] + acc[nn][jj];
            }
            cur = nxt;
            lds_barrier();
        }
        bf16_t* og = KVT + KVT_GROUPS + (size_t)U * 4096;
#pragma unroll
        for (int nn = 0; nn < 2; ++nn) {
            uint2 w; w.x = pack2(run[nn][0], run[nn][1]); w.y = pack2(run[nn][2], run[nn][3]);
            *reinterpret_cast<uint2*>(og + (et * 16 + fr) * 64 + (dt0 + nn) * 16 + fq * 4) = w;
        }
    }
}
__device__ __forceinline__ void phase_ret_scan(const Params& p) {
    const int tidx = otid(p.wave);
    unsigned* G2 = reinterpret_cast<unsigned*>(p.ws + OFF_KVT) + KVT_GROUPS / 2;
    for (int i = obid() * NTHREADS + tidx; i < 32 * 2048; i += ogdim() * NTHREADS) {
        const int bh = i >> 11, ed = i & 2047, h = bh & 7;
        const float gg = __expf(1024.0f * ret_lg(h));
        unsigned* q = G2 + (size_t)bh * 8 * 2048 + ed;
        unsigned t[8];
#pragma unroll
        for (int j = 0; j < 8; ++j) t[j] = q[(size_t)j * 2048];
        float C0 = 0.f, C1 = 0.f;
#pragma unroll
        for (int j = 0; j < 8; ++j) {
            q[(size_t)j * 2048] = pack2(C0, C1);
            C0 = gg * C0 + __uint_as_float(t[j] << 16);
            C1 = gg * C1 + __uint_as_float(t[j] & 0xffff0000u);
        }
    }
}
#define Q_LD 80
struct RetOutIn { uint4 q1, q2, k1, k2, v1, v2, rr; unsigned short gr[16]; };
__device__ __forceinline__ void ret_load_out(RetOutIn& in, const bf16_t* P, const bf16_t* KVT, int u, int tid) {
    const int n = u & 63, h = (u >> 6) & 7, b = u >> 9;
    const int c = tid >> 2, i0 = (tid & 3) * 8;
    const size_t tok = (size_t)b * SEQ + n * 128 + c;
    const bf16_t* qr = P + tok * 3072 + 1024 + h * 64;
    in.q1 = *reinterpret_cast<const uint4*>(qr + i0); in.q2 = *reinterpret_cast<const uint4*>(qr + 32 + i0);
    in.k1 = *reinterpret_cast<const uint4*>(qr + 512 + i0); in.k2 = *reinterpret_cast<const uint4*>(qr + 512 + 32 + i0);
    in.v1 = *reinterpret_cast<const uint4*>(qr + 1024 + i0); in.v2 = *reinterpret_cast<const uint4*>(qr + 1024 + 32 + i0);
    in.rr = *reinterpret_cast<const uint4*>(KVT + (size_t)u * 4096 + tid * 8);
    const int wv = tid >> 6, lane = tid & 63, fr = lane & 15, fq = lane >> 4;
#pragma unroll
    for (int j = 0; j < 4; ++j)
#pragma unroll
        for (int nn = 0; nn < 4; ++nn)
            in.gr[j * 4 + nn] = P[((size_t)b * SEQ + n * 128 + wv * 16 + fq * 4 + j) * 3072 + 2560 + h * 64 + nn * 16 + fr];
}
__device__ __forceinline__ void phase_ret_out(const Params& p, unsigned char* smem) {
    const int tidx = otid(p.wave);
    const bf16_t* P = reinterpret_cast<const bf16_t*>(p.ws + OFF_P);
    const float2* rope = reinterpret_cast<const float2*>(p.ws + OFF_ROPE);
    const bf16_t* KVT = reinterpret_cast<const bf16_t*>(p.ws + OFF_KVT);
    bf16_t* YC = reinterpret_cast<bf16_t*>(p.ws + OFF_YCAT);
    bf16_t* sQ = reinterpret_cast<bf16_t*>(smem);
    bf16_t* sK = sQ + 128 * Q_LD;
    bf16_t* sVT = sK + 128 * Q_LD;
    bf16_t* sRT = sVT + 64 * KT_LD;
    bf16_t* sS = sQ;
    const int tid = tidx, wv = tid >> 6, lane = tid & 63, fr = lane & 15, fq = lane >> 4;
    RetOutIn cur, nxt;
    if (obid() < 2048) ret_load_out(cur, P, KVT, obid(), tid);
    nxt = cur;
    for (int u = obid(); u < 2048; u += ogdim()) {
        const int n = u & 63, h = (u >> 6) & 7, b = u >> 9;
        const float lg = ret_lg(h);
        const int c = tid >> 2, i0 = (tid & 3) * 8;
        const int sidx = n * 128 + c;
        const int gq = n >> 3;
        uint4 tg[7];
        {
            const bf16_t* Tb = KVT + KVT_GROUPS + (size_t)((u >> 6) * 8) * 4096 + tid * 8;
#pragma unroll
            for (int q = 0; q < 7; ++q) { tg[q] = make_uint4(0u, 0u, 0u, 0u); if (q < gq) tg[q] = *reinterpret_cast<const uint4*>(Tb + (size_t)q * 4096); }
        }
        float2 cs[8];
#pragma unroll
        for (int i = 0; i < 8; ++i) cs[i] = rope[sidx * 32 + i0 + i];
        float gng[4], gnb[4];
#pragma unroll
        for (int nn = 0; nn < 4; ++nn) { gng[nn] = p.in[21][h * 64 + nn * 16 + fr]; gnb[nn] = p.in[22][h * 64 + nn * 16 + fr]; }
        asm volatile("" : "+v"(cs[0].x), "+v"(cs[7].y), "+v"(gng[0]), "+v"(gnb[3]));
        if (u + ogdim() < 2048) ret_load_out(nxt, P, KVT, u + ogdim(), tid);
        {
            float qa[8], qb[8], ka[8], kb[8];
            float q1[8], q2[8], k1[8], k2[8];
            unpack8(cur.q1, q1); unpack8(cur.q2, q2); unpack8(cur.k1, k1); unpack8(cur.k2, k2);
            const float gq = __expf((float)c * lg), gk = __expf(-(float)c * lg) * 0.125f;
#pragma unroll
            for (int i = 0; i < 8; ++i) {
                qa[i] = (q1[i] * cs[i].x - q2[i] * cs[i].y) * gq; qb[i] = (q1[i] * cs[i].y + q2[i] * cs[i].x) * gq;
                ka[i] = (k1[i] * cs[i].x - k2[i] * cs[i].y) * gk; kb[i] = (k1[i] * cs[i].y + k2[i] * cs[i].x) * gk;
            }
            st_col8(sVT + i0 * KT_LD + c, KT_LD, cur.v1);
            st_col8(sVT + (32 + i0) * KT_LD + c, KT_LD, cur.v2);
            uint4 w;
            w.x = pack2(qa[0], qa[1]); w.y = pack2(qa[2], qa[3]); w.z = pack2(qa[4], qa[5]); w.w = pack2(qa[6], qa[7]);
            *reinterpret_cast<uint4*>(sQ + c * Q_LD + i0) = w;
            w.x = pack2(qb[0], qb[1]); w.y = pack2(qb[2], qb[3]); w.z = pack2(qb[4], qb[5]); w.w = pack2(qb[6], qb[7]);
            *reinterpret_cast<uint4*>(sQ + c * Q_LD + 32 + i0) = w;
            w.x = pack2(ka[0], ka[1]); w.y = pack2(ka[2], ka[3]); w.z = pack2(ka[4], ka[5]); w.w = pack2(ka[6], ka[7]);
            *reinterpret_cast<uint4*>(sK + c * Q_LD + i0) = w;
            w.x = pack2(kb[0], kb[1]); w.y = pack2(kb[2], kb[3]); w.z = pack2(kb[4], kb[5]); w.w = pack2(kb[6], kb[7]);
            *reinterpret_cast<uint4*>(sK + c * Q_LD + 32 + i0) = w;
        }
        lds_barrier();
        f32x4 accs[8], accc[4];
#pragma unroll
        for (int nn = 0; nn < 8; ++nn) accs[nn] = (f32x4){0.f, 0.f, 0.f, 0.f};
#pragma unroll
        for (int nn = 0; nn < 4; ++nn) accc[nn] = (f32x4){0.f, 0.f, 0.f, 0.f};
        bf16x8 aq[2];
#pragma unroll
        for (int ks = 0; ks < 2; ++ks) {
            aq[ks] = *reinterpret_cast<const bf16x8*>(sQ + (wv * 16 + fr) * Q_LD + ks * 32 + fq * 8);
#pragma unroll
            for (int nn = 0; nn < 8; ++nn) {
                bf16x8 bfr = *reinterpret_cast<const bf16x8*>(sK + (nn * 16 + fr) * Q_LD + ks * 32 + fq * 8);
                accs[nn] = __builtin_amdgcn_mfma_f32_16x16x32_bf16(aq[ks], bfr, accs[nn], 0, 0, 0);
            }
        }
        lds_barrier();
        bf16_t* mS = sS + wv * 16 * KT_LD;
        {
            float e1m[4];
#pragma unroll
            for (int j = 0; j < 4; ++j) e1m[j] = (fq * 4 + j >= fr) ? 1.0f : 0.f;
#pragma unroll
            for (int nn = 0; nn < 8; ++nn) {
                const float e2 = (nn < wv) ? 1.0f : 0.f;
                const bool diag = (nn == wv);
                float v[4];
#pragma unroll
                for (int j = 0; j < 4; ++j) v[j] = accs[nn][j] * (diag ? e1m[j] : e2);
#pragma unroll
                for (int j = 0; j < 4; ++j) mS[(fq * 4 + j) * KT_LD + nn * 16 + fr] = f2bf(v[j]);
            }
        }
        {
            float l8[8];
            unpack8(cur.rr, l8);
#pragma unroll
            for (int q = 0; q < 7; ++q) {
                const float cf = (q < gq) ? __expf((float)(128 * (n - 8 * q - 8)) * lg) : 0.f;
                float c8[8];
                unpack8(tg[q], c8);
#pragma unroll
                for (int i = 0; i < 8; ++i) l8[i] += cf * c8[i];
            }
            uint4 wr_;
            wr_.x = pack2(l8[0], l8[1]); wr_.y = pack2(l8[2], l8[3]); wr_.z = pack2(l8[4], l8[5]); wr_.w = pack2(l8[6], l8[7]);
            *reinterpret_cast<uint4*>(sRT + (tid >> 3) * Q_LD + (tid & 7) * 8) = wr_;
        }
        lds_barrier();
        f32x4 acco[4];
#pragma unroll
        for (int nn = 0; nn < 4; ++nn) acco[nn] = (f32x4){0.f, 0.f, 0.f, 0.f};
#pragma unroll
        for (int ks = 0; ks < 2; ++ks)
#pragma unroll
            for (int nn = 0; nn < 4; ++nn) {
                bf16x8 bfr = *reinterpret_cast<const bf16x8*>(sRT + (nn * 16 + fr) * Q_LD + ks * 32 + fq * 8);
                accc[nn] = __builtin_amdgcn_mfma_f32_16x16x32_bf16(aq[ks], bfr, accc[nn], 0, 0, 0);
            }
#pragma unroll
        for (int ks = 0; ks < 4; ++ks) {
            bf16x8 af = *reinterpret_cast<const bf16x8*>(mS + fr * KT_LD + ks * 32 + fq * 8);
#pragma unroll
            for (int nn = 0; nn < 4; ++nn) {
                bf16x8 bfr = *reinterpret_cast<const bf16x8*>(sVT + (nn * 16 + fr) * KT_LD + ks * 32 + fq * 8);
                acco[nn] = __builtin_amdgcn_mfma_f32_16x16x32_bf16(af, bfr, acco[nn], 0, 0, 0);
            }
        }
#pragma unroll
        for (int j = 0; j < 4; ++j) {
            int ig = wv * 16 + fq * 4 + j;
            const float xi = __expf(lg);
            float o[4];
            float sm = 0.f;
#pragma unroll
            for (int nn = 0; nn < 4; ++nn) { o[nn] = acco[nn][j] + xi * accc[nn][j]; sm += o[nn]; }
            sm = row16_sum(sm);
            float mean = sm * (1.0f / 64.0f);
            float sq = 0.f;
#pragma unroll
            for (int nn = 0; nn < 4; ++nn) { float d = o[nn] - mean; sq += d * d; }
            sq = row16_sum(sq);
            float rstd = rsqrtf(sq * (1.0f / 64.0f) + 1e-5f);
            size_t tok = (size_t)b * SEQ + n * 128 + ig;
#pragma unroll
            for (int nn = 0; nn < 4; ++nn) {
                int e = h * 64 + nn * 16 + fr;
                float y = (o[nn] - mean) * rstd * gng[nn] + gnb[nn];
                float gr = bf2f(cur.gr[j * 4 + nn]);
                YC[tok * 1024 + 512 + e] = f2bf(siluf_(gr) * y);
            }
        }
        cur = nxt;
        lds_barrier();
    }
}

#define XB_TMO      128
#define XB_XCNT(j)  (256  + 64 * (j))
#define XB_XSUB(j)  (1280 + 64 * (j))
#define XB_XGEN(j)  (2304 + 64 * (j))
#define XB_TOP      3328
#define XB_TOPGEN   3392
#define XB_SPIN_CAP (1u << 18)

__device__ __forceinline__ unsigned xb_ld(unsigned* p)              { return __hip_atomic_load(p, __ATOMIC_RELAXED, __HIP_MEMORY_SCOPE_AGENT); }
__device__ __forceinline__ unsigned xb_add(unsigned* p, unsigned v) { return __hip_atomic_fetch_add(p, v, __ATOMIC_RELAXED, __HIP_MEMORY_SCOPE_AGENT); }
__device__ __forceinline__ unsigned xb_xcc_id() { return (unsigned)__builtin_amdgcn_s_getreg((3 << 11) | 20) & 0xFu; }
#define XB_SPIN(cond, bar) do { unsigned _sp = 0; while (cond) { __builtin_amdgcn_s_sleep(1); \
    if ((++_sp & 255u) == 0u) { if (xb_ld(&(bar)[XB_TMO])) break; if (_sp > XB_SPIN_CAP) { atomicAdd(&(bar)[XB_TMO], 1u); break; } } } } while (0)

struct XcdBarrier {
    unsigned* bar; unsigned x;
    volatile __attribute__((address_space(3))) unsigned* st;
};

__device__ __forceinline__ XcdBarrier xcd_barrier_post(unsigned* bar, volatile __attribute__((address_space(3))) unsigned* st, int tid) {
    XcdBarrier b; b.bar = bar; b.x = xb_xcc_id(); b.st = st;
    if (tid == 0) (void)xb_add(&bar[XB_XCNT(b.x)], 1u);
    return b;
}
__device__ __forceinline__ void xcd_barrier_complete(unsigned* bar, unsigned x, unsigned& nloc, unsigned& nx) {
    const unsigned G = (unsigned)ogdim();
    unsigned sum, cnt, mine, sp = 0u;
    for (;;) {
        sum = 0u; cnt = 0u; mine = 0u;
#pragma unroll
        for (unsigned j = 0; j < 16; ++j) { const unsigned c = xb_ld(&bar[XB_XCNT(j)]); sum += c; cnt += (c > 0u) ? 1u : 0u; mine = (j == x) ? c : mine; }
        if (sum == G) break;
        __builtin_amdgcn_s_sleep(1);
        if ((++sp & 255u) == 0u) { if (xb_ld(&bar[XB_TMO])) break; if (sp > XB_SPIN_CAP) { atomicAdd(&bar[XB_TMO], 1u); break; } }
    }
    nloc = mine > 0u ? mine : 1u; nx = cnt > 0u ? cnt : 1u;
}

__device__ __forceinline__ void xcd_barrier(const XcdBarrier& b, int tid) {
    asm volatile("s_waitcnt vmcnt(0)" ::: "memory");
    __syncthreads();
    if (tid == 0) {
        unsigned* bar = b.bar;
        __builtin_amdgcn_s_waitcnt(0);
        unsigned nloc = b.st[0], nx = b.st[1];
        if (nloc == 0u) { xcd_barrier_complete(bar, b.x, nloc, nx); b.st[0] = nloc; b.st[1] = nx; }
        const unsigned old = xb_add(&bar[XB_XSUB(b.x)], 1u);
        const unsigned gen = old / nloc;
        if (old + 1u == (gen + 1u) * nloc) {
            __builtin_amdgcn_fence(__ATOMIC_RELEASE, "agent");
            asm volatile("s_waitcnt vmcnt(0)" ::: "memory");
            const unsigned og = xb_add(&bar[XB_TOP], 1u);
            const unsigned tg = og / nx;
            if (og + 1u == (tg + 1u) * nx) xb_add(&bar[XB_TOPGEN], 1u);
            else XB_SPIN(xb_ld(&bar[XB_TOPGEN]) == tg, bar);
            __builtin_amdgcn_fence(__ATOMIC_ACQUIRE, "agent");
            xb_add(&bar[XB_XGEN(b.x)], 1u);
            asm volatile("s_waitcnt vmcnt(0)" ::: "memory");
        } else {
            XB_SPIN(xb_ld(&bar[XB_XGEN(b.x)]) == gen, bar);
            __builtin_amdgcn_fence(__ATOMIC_ACQUIRE, "agent");
            asm volatile("s_waitcnt vmcnt(0)" ::: "memory");
        }
    }
    __syncthreads();
}


#define N_PHASES 21
__device__ __forceinline__ void run_phase(const Params& p, int ph, unsigned char* smem) {
    bf16_t* sm16 = reinterpret_cast<bf16_t*>(smem);
    const bf16_t* W = reinterpret_cast<const bf16_t*>(p.ws + OFF_W);
    bf16_t* ACTB = reinterpret_cast<bf16_t*>(p.ws + OFF_ACTB);
    bf16_t* PB = reinterpret_cast<bf16_t*>(p.ws + OFF_P);
    bf16_t* YC = reinterpret_cast<bf16_t*>(p.ws + OFF_YCAT);
    switch (ph) {
        case 0: phase_pre(p, smem, 0, obid(), ogdim()); break;
        case 1: { PEpiBf16 e{PB, 2304}; big_gemm(ACTB, W + WE_IN0, NT, 2304, DM, e, smem, p.wave); } break;
        case 2: phase_l0_prep(p); break;
        case 3: phase_l0_lora(p, sm16); break;
        case 4: phase_rwkv_r1(p, smem); break;
        case 5: phase_rwkv_r2(p, smem); break;
        case 6: phase_rwkv_r3(p, smem); break;
        case 7: { PEpiOut<true> e{nullptr, ACTB, PB}; big_gemm(YC, W + WE_OUT0, NT, DM, DM, e, smem, p.wave); } break;
        case 8: phase_ln_route(p, 0, smem); break;
        case 9: phase_exp1(p, 0, sm16); break;
        case 10: phase_exp2(p, 0, sm16); break;
        case 11: phase_ln_ffn(p, 0, p.out, false); break;
        case 12: { PEpiIn1 e{PB, 3072}; big_gemm(ACTB, W + WE_IN1, NT, 3072, DM, e, smem, p.wave); } break;
        case 13: phase_l1_conv(p, smem); __syncthreads(); phase_ret_kv(p, smem); break;
        case 14: break;
        case 15: phase_ret_out(p, smem); break;
        case 16: { PEpiOut<true> e{nullptr, ACTB, PB}; big_gemm(YC, W + WE_OUT1, NT, DM, DM, e, smem, p.wave); } break;
        case 17: phase_ln_route(p, 1, smem); break;
        case 18: phase_exp1(p, 1, sm16); break;
        case 19: phase_exp2(p, 1, sm16); break;
        case 20: phase_ln_ffn(p, 1, p.out, true); break;
        default: break;
    }
}

#define SMEM_BYTES 147456
__global__ void __launch_bounds__(NTHREADS) k_mega(Params p) {
    extern __shared__ __attribute__((aligned(16))) unsigned char smem[];
    cg::grid_group grid = cg::this_grid();
    const int wave_s = __builtin_amdgcn_readfirstlane((int)(threadIdx.x >> 6));
    volatile __attribute__((address_space(3))) unsigned* st = (volatile __attribute__((address_space(3))) unsigned*)(smem + 146944);
    {
        const int t0 = otid(wave_s);
        if (t0 < 2) st[t0] = 0u;
    }
    __syncthreads();
    XcdBarrier xb;
#pragma nounroll
    for (int ph = 0; ph < N_PHASES; ++ph) {
        if (ph == 14) continue;
        int phv = ph;
        asm volatile("" : "+s"(phv));
        typedef const __attribute__((address_space(4))) Params* KP;
        KP pp = (KP)__builtin_amdgcn_kernarg_segment_ptr();
        asm volatile("" : "+s"(pp));
        Params pl;
        __builtin_memcpy(&pl, (const Params*)pp, sizeof(Params));
        pl.wave = wave_s;
        run_phase(pl, phv, smem);
        if (ph == 0) {
            if (pl.ws == nullptr) grid.sync();
            xb = xcd_barrier_post(reinterpret_cast<unsigned*>(pl.ws + OFF_CTRL + 4096), st, otid(wave_s));
        }
        if (ph < N_PHASES - 1) xcd_barrier(xb, otid(wave_s));
    }
}

extern "C" void kernel_launch(void* const* d_in, const int* in_sizes, int n_in, void* d_out, int out_size, void* d_ws, size_t ws_size,
                              hipStream_t stream) {
    static int grid_blocks = 0;
    if (!grid_blocks) {
        int dev = 0, cus = 0, per_cu = 0;
        hipGetDevice(&dev);
        hipDeviceGetAttribute(&cus, hipDeviceAttributeMultiprocessorCount, dev);
        hipFuncSetAttribute((const void*)k_mega, hipFuncAttributeMaxDynamicSharedMemorySize, SMEM_BYTES);
        hipOccupancyMaxActiveBlocksPerMultiprocessor(&per_cu, (const void*)k_mega, NTHREADS, SMEM_BYTES);
        if (per_cu < 1) per_cu = 1;
        grid_blocks = cus * per_cu;
    }
    Params p{};
    for (int i = 0; i < 35; ++i) p.in[i] = (const float*)d_in[i];
    p.out = (float*)d_out;
    p.ws = (unsigned char*)d_ws;
    hipMemsetAsync((unsigned char*)d_ws + OFF_CTRL, 0, 65536, stream);
    void* args[] = {&p};
    hipError_t e = hipLaunchCooperativeKernel((void*)k_mega, dim3(grid_blocks), dim3(NTHREADS), args, SMEM_BYTES, stream);
    if (e != hipSuccess) fprintf(stderr, "cooperative launch failed: %s (grid %d)\n", hipGetErrorString(e), grid_blocks);
}
```
